# Optimizing an MI355X kernel written in HIP

```python
import jax, jax.numpy as jnp
from jax import lax
import numpy as np

D_MODEL = 2048
BATCH = 4
SEQ = 2048
DEPTH = 1
DEC_BATCH = 128
DEC_SEQ = 8
PAST_LEN = 16384
PAGE_SIZE = 128

N_META = 16
D_A = 1536
LRU_BLOCK = 128
N_LRU_BLOCKS = D_A // LRU_BLOCK
CONV_A = 4
LRU_C = 8.0
D_B = 1024
N_SC_GROUPS = 8
CONV_B = 3
D_MIX = D_A + D_B
D_IN = 2 * D_A + 3 * D_B
D_FF = 3 * D_MODEL
CONV_F = 3
EPS = 1e-6

kernel_name = "hymba_rglru_shortconv_convffn_step"


def rmsnorm(x, g):
    xf = x.astype(jnp.float32)
    ms = jnp.mean(xf * xf, axis=-1, keepdims=True)
    return (xf * lax.rsqrt(ms + EPS) * g.astype(jnp.float32)).astype(x.dtype)


def group_rmsnorm(y, g, n_groups):
    shp = y.shape
    yf = y.astype(jnp.float32).reshape(shp[:-1] + (n_groups, shp[-1] // n_groups))
    ms = jnp.mean(yf * yf, axis=-1, keepdims=True)
    yn = (yf * lax.rsqrt(ms + EPS)).reshape(shp)
    return (yn * g.astype(jnp.float32)).astype(y.dtype)


def causal_dwconv(x, buf, w):
    width = w.shape[0]
    t_len = x.shape[1]
    xp = jnp.concatenate([buf.astype(x.dtype), x], axis=1)
    w = w.astype(x.dtype)
    y = xp[:, 0:t_len] * w[0]
    for k in range(1, width):
        y = y + xp[:, k:k + t_len] * w[k]
    return y, xp[:, t_len:]


def rg_lru(x, h0, w_gate_a, b_gate_a, w_gate_x, b_gate_x, lam):
    bsz, t_len, _ = x.shape
    xf = x.astype(jnp.float32)
    xb = xf.reshape(bsz, t_len, N_LRU_BLOCKS, LRU_BLOCK)
    r = jax.nn.sigmoid(jnp.einsum("btnk,nkj->btnj", xb, w_gate_a.astype(jnp.float32)).reshape(bsz, t_len, D_A)
                       + b_gate_a.astype(jnp.float32))
    i = jax.nn.sigmoid(jnp.einsum("btnk,nkj->btnj", xb, w_gate_x.astype(jnp.float32)).reshape(bsz, t_len, D_A)
                       + b_gate_x.astype(jnp.float32))
    log_a = -LRU_C * r * jax.nn.softplus(-lam.astype(jnp.float32))
    a = jnp.exp(log_a)
    u = jnp.sqrt(-jnp.expm1(2.0 * log_a)) * (i * xf)

    def step(h, au):
        a_t, u_t = au
        h = a_t * h + u_t
        return h, h

    h_last, hs = lax.scan(step, h0.astype(jnp.float32),
                          (jnp.swapaxes(a, 0, 1), jnp.swapaxes(u, 0, 1)))
    return jnp.swapaxes(hs, 0, 1), h_last


def hybrid_layer(x, st_h, st_rconv, st_sconv, st_fconv,
                 g_mix, w_in, conv_a_w, conv_a_b, w_gate_a, b_gate_a, w_gate_x, b_gate_x,
                 lru_lambda, conv_b_w, g_out_a, g_out_b, w_o, g_ffn, w_up, conv_f_w,
                 conv_f_b, w_down):
    xn = rmsnorm(x, g_mix)
    z = jnp.einsum("btd,de->bte", xn, w_in)
    xa, ga, gb, gc, vb = jnp.split(z, [D_A, 2 * D_A, 2 * D_A + D_B, 2 * D_A + 2 * D_B], axis=-1)
    xa_c, new_rconv = causal_dwconv(xa, st_rconv, conv_a_w)
    xa_c = xa_c + conv_a_b
    hs, new_h = rg_lru(xa_c, st_h, w_gate_a, b_gate_a, w_gate_x, b_gate_x, lru_lambda)
    y_a = jax.nn.gelu(ga) * hs.astype(x.dtype)
    u = gc * vb
    uc, new_sconv = causal_dwconv(u, st_sconv, conv_b_w)
    y_b = gb * uc
    y_mix = jnp.concatenate([group_rmsnorm(y_a, g_out_a, N_LRU_BLOCKS),
                             group_rmsnorm(y_b, g_out_b, N_SC_GROUPS)], axis=-1)
    x = x + jnp.einsum("bte,ed->btd", y_mix, w_o)
    xn2 = rmsnorm(x, g_ffn)
    up = jnp.einsum("btd,df->btf", xn2, w_up)
    gate, val = jnp.split(up, [D_FF], axis=-1)
    gate_c, new_fconv = causal_dwconv(gate, st_fconv, conv_f_w)
    hid = jax.nn.gelu(gate_c + conv_f_b) * val
    x = x + jnp.einsum("btf,fd->btd", hid, w_down)
    return x, new_h, new_rconv, new_sconv, new_fconv


def setup_inputs(seed: int = 0) -> dict:
    key = jax.random.key(seed)
    ks = jax.random.split(key, 32)
    f32 = jnp.float32
    L = DEPTH

    def nrm(k, shape, scale):
        return jax.random.normal(k, shape, f32) * scale

    a0 = jax.random.uniform(ks[15], (L, D_A), f32, 0.9, 0.999)
    return {
        "x_prompt": nrm(ks[0], (BATCH, SEQ, D_MODEL), 1.0),
        "x_sample": nrm(ks[1], (DEC_BATCH, DEC_SEQ, D_MODEL), 1.0),
        "state_lru_h": nrm(ks[2], (L, DEC_BATCH, D_A), 0.5),
        "state_lru_conv": nrm(ks[3], (L, DEC_BATCH, CONV_A - 1, D_A), 1.0),
        "state_sconv": nrm(ks[4], (L, DEC_BATCH, CONV_B - 1, D_B), 1.0),
        "state_ffn_conv": nrm(ks[5], (L, DEC_BATCH, CONV_F - 1, D_FF), 1.0),
        "meta_tokens": nrm(ks[6], (N_META, D_MODEL), 1.0),
        "g_mix": 1.0 + nrm(ks[7], (L, D_MODEL), 0.02),
        "w_in": nrm(ks[8], (L, D_MODEL, D_IN), D_MODEL ** -0.5),
        "conv_a_w": nrm(ks[9], (L, CONV_A, D_A), CONV_A ** -0.5),
        "conv_a_b": nrm(ks[10], (L, D_A), 0.02),
        "w_gate_a": nrm(ks[11], (L, N_LRU_BLOCKS, LRU_BLOCK, LRU_BLOCK), LRU_BLOCK ** -0.5),
        "b_gate_a": nrm(ks[12], (L, D_A), 0.02),
        "w_gate_x": nrm(ks[13], (L, N_LRU_BLOCKS, LRU_BLOCK, LRU_BLOCK), LRU_BLOCK ** -0.5),
        "b_gate_x": nrm(ks[14], (L, D_A), 0.02),
        "lru_lambda": jnp.log(a0) - jnp.log1p(-a0),
        "conv_b_w": nrm(ks[16], (L, CONV_B, D_B), CONV_B ** -0.5),
        "g_out_a": 1.0 + nrm(ks[17], (L, D_A), 0.02),
        "g_out_b": 1.0 + nrm(ks[18], (L, D_B), 0.02),
        "w_o": nrm(ks[19], (L, D_MIX, D_MODEL), D_MIX ** -0.5),
        "g_ffn": 1.0 + nrm(ks[20], (L, D_MODEL), 0.02),
        "w_up": nrm(ks[21], (L, D_MODEL, 2 * D_FF), D_MODEL ** -0.5),
        "conv_f_w": nrm(ks[22], (L, CONV_F, D_FF), CONV_F ** -0.5),
        "conv_f_b": nrm(ks[23], (L, D_FF), 0.02),
        "w_down": nrm(ks[24], (L, D_FF, D_MODEL), D_FF ** -0.5),
        "g_final": 1.0 + nrm(ks[25], (D_MODEL,), 0.02),
    }


def reference(x_prompt, x_sample, state_lru_h, state_lru_conv, state_sconv, state_ffn_conv,
              meta_tokens, g_mix, w_in, conv_a_w, conv_a_b, w_gate_a, b_gate_a, w_gate_x,
              b_gate_x, lru_lambda, conv_b_w, g_out_a, g_out_b, w_o, g_ffn, w_up, conv_f_w,
              conv_f_b, w_down, g_final):
    dt = x_prompt.dtype
    meta = jnp.broadcast_to(meta_tokens.astype(dt)[None], (BATCH, N_META, D_MODEL))
    xp = jnp.concatenate([meta, x_prompt], axis=1)
    xs = x_sample
    zero_h = jnp.zeros((BATCH, D_A), jnp.float32)
    zero_rconv = jnp.zeros((BATCH, CONV_A - 1, D_A), dt)
    zero_sconv = jnp.zeros((BATCH, CONV_B - 1, D_B), dt)
    zero_fconv = jnp.zeros((BATCH, CONV_F - 1, D_FF), dt)

    p_h, p_rc, p_sc, p_fc = [], [], [], []
    s_h, s_rc, s_sc, s_fc = [], [], [], []
    for l in range(DEPTH):
        lw = (g_mix[l], w_in[l], conv_a_w[l], conv_a_b[l], w_gate_a[l], b_gate_a[l],
              w_gate_x[l], b_gate_x[l], lru_lambda[l], conv_b_w[l], g_out_a[l], g_out_b[l],
              w_o[l], g_ffn[l], w_up[l], conv_f_w[l], conv_f_b[l], w_down[l])
        xp, h1, rc1, sc1, fc1 = hybrid_layer(xp, zero_h, zero_rconv, zero_sconv, zero_fconv, *lw)
        xs, h2, rc2, sc2, fc2 = hybrid_layer(xs, state_lru_h[l], state_lru_conv[l],
                                             state_sconv[l], state_ffn_conv[l], *lw)
        p_h.append(h1); p_rc.append(rc1); p_sc.append(sc1); p_fc.append(fc1)
        s_h.append(h2); s_rc.append(rc2); s_sc.append(sc2); s_fc.append(fc2)

    y_prompt = rmsnorm(xp, g_final)[:, N_META:]
    y_sample = rmsnorm(xs, g_final)
    return (y_prompt, y_sample,
            jnp.stack(p_h), jnp.stack(p_rc), jnp.stack(p_sc), jnp.stack(p_fc),
            jnp.stack(s_h), jnp.stack(s_rc), jnp.stack(s_sc), jnp.stack(s_fc))
```

```cpp
#include <hip/hip_runtime.h>
#include <hip/hip_cooperative_groups.h>
#include <cstdio>
namespace cg = cooperative_groups;

#ifndef MK_N_LAUNCHES
#define MK_N_LAUNCHES 1
#endif

#define LAS __attribute__((address_space(3)))
typedef unsigned short bf16_t;
typedef short bf16x8 __attribute__((ext_vector_type(8)));
typedef float f32x4 __attribute__((ext_vector_type(4)));
typedef unsigned u32x4 __attribute__((ext_vector_type(4)));
typedef unsigned u32x2 __attribute__((ext_vector_type(2)));

constexpr int D = 2048, NMETA = 16, SEQ = 2048, TP = SEQ + NMETA, NB = 4, MPR = NB * TP;
constexpr int NS = 128, TS = 8, MSR = NS * TS, M = MPR + MSR;
constexpr int MP = 9472;
constexpr int DA = 1536, DB = 1024, DIN = 6144, DMIX = 2560, DFF = 6144, NH = 12;
constexpr float EPS = 1e-6f;
constexpr int NCH = 33, CH = 64;
constexpr size_t O_YP = 0, O_YS = O_YP + (size_t)NB * SEQ * D, O_PH = O_YS + (size_t)MSR * D, O_PRC = O_PH + NB * DA,
                 O_PSC = O_PRC + NB * 3 * DA, O_PFC = O_PSC + NB * 2 * DB, O_SH = O_PFC + NB * 2 * DFF, O_SRC = O_SH + NS * DA,
                 O_SSC = O_SRC + (size_t)NS * 3 * DA, O_SFC = O_SSC + (size_t)NS * 2 * DB, O_END = O_SFC + (size_t)NS * 2 * DFF;
constexpr size_t MiB = 1u << 20;
constexpr size_t WS_WIN = 1 * MiB;
constexpr size_t WS_WO = WS_WIN + (size_t)DIN * D * 2;
constexpr size_t WS_WUP = WS_WO + (size_t)D * DMIX * 2;
constexpr size_t WS_WDN = WS_WUP + (size_t)2 * DFF * D * 2;
constexpr size_t WS_WG = WS_WDN + (size_t)D * DFF * 2;
constexpr size_t WS_XB = WS_WG + (size_t)2 * NH * 128 * 128 * 2;
constexpr size_t XB_ROWS = 9600;
constexpr size_t WS_Z = WS_XB + XB_ROWS * D * 2;
constexpr size_t WS_YM = WS_Z + (size_t)MP * DIN * 2;
constexpr size_t WS_RS1 = WS_YM + (size_t)MP * DMIX * 2;
constexpr size_t WS_SSQ = WS_RS1 + (size_t)MP * 4;
constexpr size_t WS_TOT = WS_SSQ + (size_t)MP * 32 * 4;
constexpr size_t WS_END = WS_TOT + (size_t)NB * NCH * DA * 2 * 4;

struct Params {
    const float *x_prompt, *x_sample, *st_h, *st_rc, *st_sc, *st_fc, *meta, *g_mix, *w_in, *conv_a_w, *conv_a_b, *w_gate_a, *b_gate_a,
        *w_gate_x, *b_gate_x, *lam, *conv_b_w, *g_out_a, *g_out_b, *w_o, *g_ffn, *w_up, *conv_f_w, *conv_f_b, *w_down, *g_final;
    float* out; unsigned char* ws; int ph_lo, ph_hi;
};

__device__ __forceinline__ unsigned cvt_pk_bf16(float lo, float hi) { unsigned r; asm volatile("v_cvt_pk_bf16_f32 %0, %1, %2" : "=v"(r) : "v"(lo), "v"(hi)); return r; }
__device__ __forceinline__ float bf_lo(unsigned w) { return __builtin_bit_cast(float, w << 16); }
__device__ __forceinline__ float bf_hi(unsigned w) { return __builtin_bit_cast(float, w & 0xffff0000u); }
__device__ __forceinline__ void unpack8(const u32x4 w, float (&f)[8]) { f[0] = bf_lo(w.x); f[1] = bf_hi(w.x); f[2] = bf_lo(w.y); f[3] = bf_hi(w.y); f[4] = bf_lo(w.z); f[5] = bf_hi(w.z); f[6] = bf_lo(w.w); f[7] = bf_hi(w.w); }
__device__ __forceinline__ u32x4 pack8(const float (&f)[8]) { u32x4 w; w.x = cvt_pk_bf16(f[0], f[1]); w.y = cvt_pk_bf16(f[2], f[3]); w.z = cvt_pk_bf16(f[4], f[5]); w.w = cvt_pk_bf16(f[6], f[7]); return w; }
__device__ __forceinline__ float wave_sum(float v) {
#pragma unroll
    for (int o = 1; o < 64; o <<= 1) v += __shfl_xor(v, o);
    return v;
}
__device__ __forceinline__ float sum16(float v) {
    v += __shfl_xor(v, 1); v += __shfl_xor(v, 2); v += __shfl_xor(v, 4); v += __shfl_xor(v, 8); return v;
}
__device__ __forceinline__ float sigmoidf_(float x) { return __builtin_amdgcn_rcpf(1.0f + __expf(-x)); }
__device__ __forceinline__ float gelu_tanh(float x) {
    const float t = x * (1.0f + 0.044715f * x * x) * (-2.0f * 0.7978845608028654f * 1.4426950408889634f);
    return x * __builtin_amdgcn_rcpf(1.0f + __builtin_amdgcn_exp2f(t));
}
template <int CTRL> __device__ __forceinline__ float dppf(float old, float src) {
    return __builtin_bit_cast(float, __builtin_amdgcn_update_dpp(__builtin_bit_cast(int, old), __builtin_bit_cast(int, src), CTRL, 0xF, 0xF, false));
}
__device__ __forceinline__ void row_decode(int r, int& is_s, int& seq, int& t) {
    if (r < MPR) { seq = (r >= TP) + (r >= 2 * TP) + (r >= 3 * TP); t = r - seq * TP; is_s = 0; }
    else { const int q = r - MPR; seq = q >> 3; t = q & 7; is_s = 1; }
}
__device__ __forceinline__ const float* x_row_ptr(const float* xp, const float* xs, const float* meta, int r) {
    int is_s, seq, t; row_decode(r, is_s, seq, t);
    if (is_s) return xs + (size_t)(r - MPR) * D;
    return t < NMETA ? meta + (size_t)t * D : xp + ((size_t)seq * SEQ + (t - NMETA)) * D;
}
__device__ __forceinline__ float* y_row_ptr(float* out, int r) {
    if (r >= M) return nullptr;
    int is_s, seq, t; row_decode(r, is_s, seq, t);
    if (is_s) return out + O_YS + (size_t)(r - MPR) * D;
    return t < NMETA ? nullptr : out + O_YP + ((size_t)seq * SEQ + (t - NMETA)) * D;
}

namespace pg8 {
constexpr int BM = 256, BK = 64, HALF = 128, HTB = HALF * BK * 2, STAGE_BYTES = 8 * HTB, NXCD = 8, WGM = 8;
__host__ __device__ __forceinline__ int lds_byte(int r, int c) { const int st = (r >> 4) * 2 + (c >> 5), rr = r & 15, cc = c & 31, ob = rr * 64 + cc * 2; return st * 1024 + (ob ^ (((ob >> 9) & 1) << 5)); }
__host__ __device__ __forceinline__ void stage_rc(int b, int& R, int& C) { const int st = b / 1024, sb = b % 1024, swz = sb ^ (((sb >> 9) & 1) << 5); R = (st >> 1) * 16 + swz / 64; C = (st & 1) * 32 + (swz % 64) / 2; }
struct Unit { int pm, pn; };
struct Gemm { const bf16_t* A; const bf16_t* Bt; int nM, nN, K; size_t a_tstep, a_hstep; };
struct StaticOrder {
    int nM, nN, nwg, G, c;
    __device__ void init(int nM_, int nN_, int G_, int c_) { nM = nM_; nN = nN_; nwg = nM * nN; G = G_; c = c_; }
    __device__ bool next(int i, Unit& u) const {
        const long L = (long)i * G + c; if (L >= nwg) return false;
        int wgid = (int)L; { const int q = nwg / NXCD, r = nwg % NXCD, xcd = wgid % NXCD, off = wgid / NXCD; wgid = (xcd < r ? xcd * (q + 1) : r * (q + 1) + (xcd - r) * q) + off; }
        const int nig = WGM * nN, gid = wgid / nig, fm = gid * WGM, gsz = (nM - fm) < WGM ? (nM - fm) : WGM;
        u.pm = fm + ((wgid % nig) % gsz); u.pn = (wgid % nig) / gsz; return true;
    }
};

template <class Epi, bool FFNMAP, bool ALIGN_EPI, bool SP2>
__device__ __forceinline__ void gemm_phase(LAS unsigned char* lds, const Gemm g, const StaticOrder& S, const Epi& E) {
    int tid = threadIdx.x; asm volatile("" : "+v"(tid));
    const int wid = __builtin_amdgcn_readfirstlane(tid >> 6), lane = tid & 63, wr = wid >> 2, wc = wid & 3, fr = lane & 15, fq = lane >> 4;
    const int K = g.K, nt = K / BK;
    unsigned voffA[2], voffB[2];
#pragma unroll
    for (int i = 0; i < 2; ++i) { int R, C; stage_rc(tid * 16 + i * 8192, R, C); const int Ra = FFNMAP ? (126 * (R >> 6) + (R & 63)) : R;
        voffA[i] = (unsigned)(Ra * K + C) * 2u; voffB[i] = (unsigned)(R * K + C) * 2u; }
    const size_t kstep = (size_t)(BK * 2);
    const size_t hstepA = g.a_hstep, tstepA = g.a_tstep;
    const size_t hstepB = (size_t)HALF * K * 2, tstepB = 2 * hstepB;
    const unsigned ldsw = (unsigned)wid * 1024u;
    const int aoff = lds_byte(wr * 64 + fr, fq * 8), boff = lds_byte(wc * 32 + fr, fq * 8);
#define PG8_SA(b, h) (((b) * 2 + (h)) * HTB)
#define PG8_SB(b, h) ((4 + (b) * 2 + (h)) * HTB)
#define PG8_STAGE(bufoff, gbase, voff) do { _Pragma("unroll") for (int _i = 0; _i < 2; ++_i) \
        __builtin_amdgcn_global_load_lds((const unsigned*)((const char*)(gbase) + (voff)[_i]), (LAS unsigned*)(lds + (bufoff) + ldsw + _i * 8192), 16, 0, 0); } while (0)
#define PG8_LDA(dst, b, h) do { _Pragma("unroll") for (int m = 0; m < 4; ++m) _Pragma("unroll") for (int k = 0; k < 2; ++k) dst[m][k] = *(const LAS bf16x8*)(lds + PG8_SA(b, h) + aoff + m * 2048 + k * 1024); } while (0)
#define PG8_LDB(dst, b, h) do { _Pragma("unroll") for (int n = 0; n < 2; ++n) _Pragma("unroll") for (int k = 0; k < 2; ++k) dst[n][k] = *(const LAS bf16x8*)(lds + PG8_SB(b, h) + boff + n * 2048 + k * 1024); } while (0)
#define PG8_MMA(ai, bj, At, Bt) do { __builtin_amdgcn_s_setprio(1); _Pragma("unroll") for (int m = 0; m < 4; ++m) _Pragma("unroll") for (int n = 0; n < 2; ++n) _Pragma("unroll") for (int k = 0; k < 2; ++k) \
        acc[ai][bj][m][n] = __builtin_amdgcn_mfma_f32_16x16x32_bf16(Bt[n][k], At[m][k], acc[ai][bj][m][n], 0, 0, 0); __builtin_amdgcn_s_setprio(0); } while (0)
#define PG8_WAIT_V(n) asm volatile("s_waitcnt vmcnt(" #n ")" ::: "memory")
#define PG8_WAIT_L(n) asm volatile("s_waitcnt lgkmcnt(" #n ")" ::: "memory")
#define PG8_BAR __builtin_amdgcn_s_barrier()
#define PG8_SCHED __builtin_amdgcn_sched_barrier(0)
    Unit cur, nxt; int ui = 0;
    if (!S.next(0, cur)) return;
    f32x4 acc[2][2][4][2];
#pragma unroll
    for (int a = 0; a < 2; ++a)
#pragma unroll
        for (int b = 0; b < 2; ++b)
#pragma unroll
            for (int m = 0; m < 4; ++m)
#pragma unroll
                for (int n = 0; n < 2; ++n) acc[a][b][m][n] = (f32x4){0.f, 0.f, 0.f, 0.f};
    bf16x8 At[4][2], B0[2][2], B1[2][2];
    const char* cA = (const char*)g.A + (size_t)cur.pm * tstepA; const char* cB = (const char*)g.Bt + (size_t)cur.pn * tstepB;
    if constexpr (SP2) {
        PG8_STAGE(PG8_SB(0, 0), cB, voffB); PG8_STAGE(PG8_SB(0, 1), cB + hstepB, voffB); PG8_STAGE(PG8_SA(0, 0), cA, voffA); PG8_STAGE(PG8_SA(0, 1), cA + hstepA, voffA);
        if (wr == 1) PG8_BAR;
        PG8_WAIT_V(2); PG8_BAR;
        PG8_STAGE(PG8_SB(1, 0), cB + kstep, voffB); PG8_STAGE(PG8_SA(1, 0), cA + kstep, voffA); PG8_STAGE(PG8_SB(1, 1), cB + hstepB + kstep, voffB);
        PG8_WAIT_V(6); PG8_BAR;
    } else {
        PG8_STAGE(PG8_SB(0, 0), cB, voffB); PG8_STAGE(PG8_SA(0, 0), cA, voffA); PG8_STAGE(PG8_SB(0, 1), cB + hstepB, voffB); PG8_STAGE(PG8_SA(0, 1), cA + hstepA, voffA);
        if (wr == 1) PG8_BAR;
        PG8_WAIT_V(4); PG8_BAR;
        PG8_STAGE(PG8_SB(1, 0), cB + kstep, voffB); PG8_STAGE(PG8_SA(1, 0), cA + kstep, voffA); PG8_STAGE(PG8_SB(1, 1), cB + hstepB + kstep, voffB);
        PG8_WAIT_V(6); PG8_BAR;
    }
    for (;;) {
        const bool has_next = S.next(ui + 1, nxt);
        const char* nA = has_next ? (const char*)g.A + (size_t)nxt.pm * tstepA : cA; const char* nB = has_next ? (const char*)g.Bt + (size_t)nxt.pn * tstepB : cB;
        for (int t = 0; t < nt; t += 2) {
            const bool last = (t == nt - 2);
            const char* a1 = cA + (size_t)(t + 1) * kstep;
            const char* a2 = last ? nA : cA + (size_t)(t + 2) * kstep; const char* b2 = last ? nB : cB + (size_t)(t + 2) * kstep;
            const char* a3 = a2 + kstep; const char* b3 = b2 + kstep;
            if constexpr (SP2) {
            PG8_LDB(B0, 0, 0); PG8_LDB(B1, 0, 1); PG8_SCHED; PG8_LDA(At, 0, 0); PG8_STAGE(PG8_SA(1, 1), a1 + hstepA, voffA);
            PG8_WAIT_V(8); PG8_WAIT_L(0); PG8_BAR; PG8_MMA(0, 0, At, B0); PG8_MMA(0, 1, At, B1); PG8_BAR; PG8_SCHED;
            PG8_LDA(At, 0, 1); PG8_STAGE(PG8_SB(0, 0), b2, voffB); PG8_STAGE(PG8_SB(0, 1), b2 + hstepB, voffB); PG8_STAGE(PG8_SA(0, 0), a2, voffA);
            PG8_WAIT_V(8); PG8_WAIT_L(0); PG8_BAR; PG8_MMA(1, 0, At, B0); PG8_MMA(1, 1, At, B1); PG8_BAR; PG8_SCHED;
            PG8_LDB(B0, 1, 0); PG8_LDB(B1, 1, 1); PG8_SCHED; PG8_LDA(At, 1, 0); PG8_STAGE(PG8_SA(0, 1), a2 + hstepA, voffA);
            PG8_WAIT_V(8); PG8_WAIT_L(0); PG8_BAR; PG8_MMA(0, 0, At, B0); PG8_MMA(0, 1, At, B1); PG8_BAR; PG8_SCHED;
            PG8_LDA(At, 1, 1); PG8_STAGE(PG8_SB(1, 0), b3, voffB); PG8_STAGE(PG8_SB(1, 1), b3 + hstepB, voffB); PG8_STAGE(PG8_SA(1, 0), a3, voffA);
            PG8_WAIT_V(8); PG8_WAIT_L(0); PG8_BAR; PG8_MMA(1, 0, At, B0); PG8_MMA(1, 1, At, B1); PG8_BAR; PG8_SCHED;
            } else {
            PG8_LDB(B0, 0, 0); PG8_SCHED; PG8_LDA(At, 0, 0); PG8_STAGE(PG8_SA(1, 1), a1 + hstepA, voffA);
            PG8_WAIT_L(8); PG8_BAR; PG8_WAIT_L(0); PG8_MMA(0, 0, At, B0); PG8_BAR; PG8_SCHED;
            PG8_LDB(B1, 0, 1); PG8_STAGE(PG8_SB(0, 0), b2, voffB);
            PG8_BAR; PG8_WAIT_L(0); PG8_MMA(0, 1, At, B1); PG8_BAR;
            PG8_LDA(At, 0, 1); PG8_STAGE(PG8_SA(0, 0), a2, voffA);
            PG8_BAR; PG8_WAIT_L(0); PG8_MMA(1, 0, At, B0); PG8_BAR; PG8_SCHED;
            PG8_STAGE(PG8_SB(0, 1), b2 + hstepB, voffB);
            PG8_WAIT_V(6); PG8_BAR; PG8_MMA(1, 1, At, B1); PG8_BAR;
            PG8_LDB(B0, 1, 0); PG8_SCHED; PG8_LDA(At, 1, 0); PG8_STAGE(PG8_SA(0, 1), a2 + hstepA, voffA);
            PG8_WAIT_L(8); PG8_BAR; PG8_WAIT_L(0); PG8_MMA(0, 0, At, B0); PG8_BAR; PG8_SCHED;
            PG8_LDB(B1, 1, 1); PG8_STAGE(PG8_SB(1, 0), b3, voffB);
            PG8_BAR; PG8_WAIT_L(0); PG8_MMA(0, 1, At, B1); PG8_BAR;
            PG8_LDA(At, 1, 1); PG8_STAGE(PG8_SA(1, 0), a3, voffA);
            PG8_BAR; PG8_WAIT_L(0); PG8_MMA(1, 0, At, B0); PG8_BAR; PG8_SCHED;
            PG8_STAGE(PG8_SB(1, 1), b3 + hstepB, voffB);
            PG8_WAIT_V(6); PG8_BAR; PG8_MMA(1, 1, At, B1); PG8_BAR;
            }
        }
        if constexpr (ALIGN_EPI) { if (wr == 0) PG8_BAR; }
        E(acc, cur, wr, wc, fr, fq);
        if (!has_next) break;
#pragma unroll
        for (int a = 0; a < 2; ++a)
#pragma unroll
            for (int b = 0; b < 2; ++b)
#pragma unroll
                for (int m = 0; m < 4; ++m)
#pragma unroll
                    for (int n = 0; n < 2; ++n) acc[a][b][m][n] = (f32x4){0.f, 0.f, 0.f, 0.f};
        cur = nxt; cA = nA; cB = nB; ++ui;
        if constexpr (ALIGN_EPI) { if (wr == 1) PG8_BAR; }
    }
    PG8_WAIT_V(0);
    if constexpr (!ALIGN_EPI) { if (wr == 0) PG8_BAR; }
    PG8_BAR;
#undef PG8_SA
#undef PG8_SB
#undef PG8_STAGE
#undef PG8_LDA
#undef PG8_LDB
#undef PG8_MMA
#undef PG8_WAIT_V
#undef PG8_WAIT_L
#undef PG8_BAR
#undef PG8_SCHED
}
}

typedef f32x4 Acc[2][2][4][2];

struct EpiZ {
    const float* rstd1; bf16_t* z; float* out;
    __device__ __forceinline__ void operator()(const Acc& acc, const pg8::Unit& u, int wr, int wc, int fr, int fq) const {
        const int col0 = u.pn * 256 + wc * 32 + 8 * fq;
#pragma unroll
        for (int ai = 0; ai < 2; ++ai)
#pragma unroll
            for (int m = 0; m < 4; ++m) {
                const int r = u.pm * 256 + ai * 128 + wr * 64 + m * 16 + fr;
                if (r < M) {
                    const float rs = rstd1[r];
                    int is_s, seq, t; row_decode(r, is_s, seq, t);
                    float* so = nullptr;
                    if (u.pn < 6) { if (is_s) { if (t >= TS - 3) so = out + O_SRC + ((size_t)seq * 3 + (t - (TS - 3))) * DA; } else { if (t >= TP - 3) so = out + O_PRC + ((size_t)seq * 3 + (t - (TP - 3))) * DA; } }
#pragma unroll
                    for (int bj = 0; bj < 2; ++bj) {
                        const f32x4 v0 = acc[ai][bj][m][0] * rs, v1 = acc[ai][bj][m][1] * rs;
                        u32x4 w; w.x = cvt_pk_bf16(v0[0], v0[1]); w.y = cvt_pk_bf16(v0[2], v0[3]); w.z = cvt_pk_bf16(v1[0], v1[1]); w.w = cvt_pk_bf16(v1[2], v1[3]);
                        *(u32x4*)(z + (size_t)r * DIN + col0 + bj * 128) = w;
                        if (so) { *(f32x4*)(so + col0 + bj * 128) = v0; *(f32x4*)(so + col0 + bj * 128 + 4) = v1; }
                    }
                }
            }
    }
};
struct EpiX1 {
    const float *xp, *xs, *meta; float* out; bf16_t* x1b; float* ssq;
    __device__ __forceinline__ void operator()(const Acc& acc, const pg8::Unit& u, int wr, int wc, int fr, int fq) const {
        const int col0 = u.pn * 256 + wc * 32 + 8 * fq;
#pragma unroll
        for (int ai = 0; ai < 2; ++ai)
#pragma unroll
            for (int m = 0; m < 4; ++m) {
                const int r = u.pm * 256 + ai * 128 + wr * 64 + m * 16 + fr;
                const bool valid = r < M;
                const float* xr = x_row_ptr(xp, xs, meta, valid ? r : 0);
                float* yd = y_row_ptr(out, r);
                float ss = 0.f;
#pragma unroll
                for (int bj = 0; bj < 2; ++bj) {
                    const int c = col0 + bj * 128;
                    const f32x4 v0 = acc[ai][bj][m][0] + *(const f32x4*)(xr + c), v1 = acc[ai][bj][m][1] + *(const f32x4*)(xr + c + 4);
                    ss += (v0[0] * v0[0] + v0[1] * v0[1]) + (v0[2] * v0[2] + v0[3] * v0[3]) + (v1[0] * v1[0] + v1[1] * v1[1]) + (v1[2] * v1[2] + v1[3] * v1[3]);
                    if (yd) { *(f32x4*)(yd + c) = v0; *(f32x4*)(yd + c + 4) = v1; }
                    if (valid) { u32x4 w; w.x = cvt_pk_bf16(v0[0], v0[1]); w.y = cvt_pk_bf16(v0[2], v0[3]); w.z = cvt_pk_bf16(v1[0], v1[1]); w.w = cvt_pk_bf16(v1[2], v1[3]);
                        *(u32x4*)(x1b + (size_t)r * D + c) = w; }
                }
                ss += __shfl_xor(ss, 16); ss += __shfl_xor(ss, 32);
                if (valid && fq == 0) ssq[(size_t)r * 32 + u.pn * 4 + wc] = ss;
            }
    }
};
struct EpiOut {
    float* out;
    __device__ __forceinline__ void operator()(const Acc& acc, const pg8::Unit& u, int wr, int wc, int fr, int fq) const {
        const int col0 = u.pn * 256 + wc * 32 + 8 * fq;
#pragma unroll
        for (int ai = 0; ai < 2; ++ai)
#pragma unroll
            for (int m = 0; m < 4; ++m) {
                const int r = u.pm * 256 + ai * 128 + wr * 64 + m * 16 + fr;
                float* yd = y_row_ptr(out, r);
                if (yd) {
#pragma unroll
                    for (int bj = 0; bj < 2; ++bj) {
                        const int c = col0 + bj * 128;
                        const f32x4 v0 = acc[ai][bj][m][0] + *(const f32x4*)(yd + c), v1 = acc[ai][bj][m][1] + *(const f32x4*)(yd + c + 4);
                        *(f32x4*)(yd + c) = v0; *(f32x4*)(yd + c + 4) = v1;
                    }
                }
            }
    }
};
struct EpiFFN {
    const float *ssq, *cw, *cb, *st_fc; bf16_t* hid; float* out;
    __device__ __forceinline__ void operator()(Acc& acc, const pg8::Unit& u, int wr, int wc, int fr, int fq) const {
        const int gbase = 252 * u.pm - 2 + 126 * wr;
        const int f0 = 128 * u.pn + 32 * wc + 8 * fq;
#pragma unroll
        for (int ai = 0; ai < 2; ++ai)
#pragma unroll
            for (int m = 0; m < 4; ++m) {
                int r = gbase + 64 * ai + 16 * m + fr; r = r < 0 ? 0 : (r >= M ? M - 1 : r);
                const float* sp = ssq + (size_t)r * 32 + 8 * fq;
                const f32x4 a = *(const f32x4*)sp, b = *(const f32x4*)(sp + 4);
                float s = ((a[0] + a[1]) + (a[2] + a[3])) + ((b[0] + b[1]) + (b[2] + b[3]));
                s += __shfl_xor(s, 16); s += __shfl_xor(s, 32);
                const float rs = __builtin_amdgcn_rsqf(s * (1.0f / D) + EPS);
#pragma unroll
                for (int bj = 0; bj < 2; ++bj)
#pragma unroll
                    for (int n = 0; n < 2; ++n) acc[ai][bj][m][n] *= rs;
                if (m & 1) __builtin_amdgcn_sched_barrier(0);
            }
        const f32x4 w0a = *(const f32x4*)(cw + f0), w0b = *(const f32x4*)(cw + f0 + 4);
        const f32x4 w1a = *(const f32x4*)(cw + DFF + f0), w1b = *(const f32x4*)(cw + DFF + f0 + 4);
        const f32x4 w2a = *(const f32x4*)(cw + 2 * DFF + f0), w2b = *(const f32x4*)(cw + 2 * DFF + f0 + 4);
        const f32x4 bba = *(const f32x4*)(cb + f0), bbb = *(const f32x4*)(cb + f0 + 4);
#pragma unroll
        for (int ai = 0; ai < 2; ++ai)
#pragma unroll
            for (int m = 0; m < 4; ++m) {
                const int j = 64 * ai + 16 * m + fr, r = gbase + j;
                const bool valid = (j >= 2) && (r < M);
                const f32x4 c0 = acc[ai][0][m][0], c1 = acc[ai][0][m][1];
                const int pai = (m == 0) ? (ai == 0 ? 0 : ai - 1) : ai, pm_ = (m == 0) ? (ai == 0 ? 0 : 3) : m - 1;
                const f32x4 q0 = acc[pai][0][pm_][0], q1 = acc[pai][0][pm_][1];
                f32x4 p1a, p1b, p2a, p2b;
#pragma unroll
                for (int e = 0; e < 4; ++e) {
                    p1a[e] = dppf<0x111>(dppf<0x121>(0.f, q0[e]), c0[e]); p1b[e] = dppf<0x111>(dppf<0x121>(0.f, q1[e]), c1[e]);
                    p2a[e] = dppf<0x112>(dppf<0x122>(0.f, q0[e]), c0[e]); p2b[e] = dppf<0x112>(dppf<0x122>(0.f, q1[e]), c1[e]);
                }
                int is_s, seq, t; row_decode(valid ? r : 0, is_s, seq, t);
                if (valid && t < 2) {
                    f32x4 s0a = (f32x4){0.f, 0.f, 0.f, 0.f}, s0b = s0a, s1a = s0a, s1b = s0a;
                    if (is_s) { const float* sp = st_fc + (size_t)seq * 2 * DFF + f0; s0a = *(const f32x4*)sp; s0b = *(const f32x4*)(sp + 4); s1a = *(const f32x4*)(sp + DFF); s1b = *(const f32x4*)(sp + DFF + 4); }
                    if (t == 0) { p1a = s1a; p1b = s1b; p2a = s0a; p2b = s0b; } else { p2a = s1a; p2b = s1b; }
                }
                const f32x4 ga = w0a * p2a + w1a * p1a + w2a * c0 + bba, gb = w0b * p2b + w1b * p1b + w2b * c1 + bbb;
                const f32x4 va = acc[ai][1][m][0], vb = acc[ai][1][m][1];
                if (valid) {
                    u32x4 w;
                    w.x = cvt_pk_bf16(gelu_tanh(ga[0]) * va[0], gelu_tanh(ga[1]) * va[1]); w.y = cvt_pk_bf16(gelu_tanh(ga[2]) * va[2], gelu_tanh(ga[3]) * va[3]);
                    w.z = cvt_pk_bf16(gelu_tanh(gb[0]) * vb[0], gelu_tanh(gb[1]) * vb[1]); w.w = cvt_pk_bf16(gelu_tanh(gb[2]) * vb[2], gelu_tanh(gb[3]) * vb[3]);
                    *(u32x4*)(hid + (size_t)r * DFF + f0) = w;
                    const int T = is_s ? TS : TP;
                    if (t >= T - 2) { float* so = out + (is_s ? O_SFC : O_PFC) + ((size_t)seq * 2 + (t - (T - 2))) * DFF + f0; *(f32x4*)so = c0; *(f32x4*)(so + 4) = c1; }
                }
                __builtin_amdgcn_sched_barrier(0);
            }
    }
};

__device__ __forceinline__ int invperm32(int q) { return 16 * ((q >> 2) & 1) + 4 * (q >> 3) + (q & 3); }
__device__ __forceinline__ void p0_transpose_item(const float* W, int K, int N, const float* kscale, bf16_t* WT, bool ffn, LAS float* scr, int item, int lane) {
    const int nblk = N / 32, kb = item / nblk, nb = item % nblk, k0 = 64 * kb, n0 = 32 * nb;
#pragma unroll 8
    for (int i = 0; i < 32; ++i) { const int kk = 2 * i + (lane >> 5); float v = W[(size_t)(k0 + kk) * N + n0 + (lane & 31)]; if (kscale) v *= kscale[k0 + kk]; scr[kk * 33 + (lane & 31)] = v; }
    asm volatile("s_waitcnt lgkmcnt(0)" ::: "memory");
    int rbase = n0;
    if (ffn) { const int bj = n0 >= DFF ? 1 : 0, f = n0 - bj * DFF; rbase = 256 * (f >> 7) + 128 * bj + (f & 96); }
    const int c = lane & 7;
#pragma unroll
    for (int j = 0; j < 4; ++j) { const int n = (lane >> 3) + 8 * j; const LAS float* s = scr + (8 * c) * 33 + n;
        u32x4 o; o.x = cvt_pk_bf16(s[0 * 33], s[1 * 33]); o.y = cvt_pk_bf16(s[2 * 33], s[3 * 33]); o.z = cvt_pk_bf16(s[4 * 33], s[5 * 33]); o.w = cvt_pk_bf16(s[6 * 33], s[7 * 33]);
        *(u32x4*)(WT + (size_t)(rbase + invperm32(n)) * K + k0 + 8 * c) = o; }
    asm volatile("s_waitcnt lgkmcnt(0)" ::: "memory");
}
__device__ __forceinline__ void phase0(const Params& p, LAS unsigned char* lds, int G) {
    const int tid = threadIdx.x, lane = tid & 63, wave = tid >> 6;
    unsigned char* ws = p.ws;
    LAS float* scr = (LAS float*)(lds + wave * 16384);
    const int gw = blockIdx.x * 8 + wave, NGW = G * 8;
    constexpr int I_IN = (D / 64) * (DIN / 32), I_O = (DMIX / 64) * (D / 32), I_UP = (D / 64) * (2 * DFF / 32), I_DN = (DFF / 64) * (D / 32);
    constexpr int NITEMS = I_IN + I_O + I_UP + I_DN;
    for (int it = gw; it < NITEMS; it += NGW) {
        int r = it;
        if (r < I_IN) { p0_transpose_item(p.w_in, D, DIN, p.g_mix, (bf16_t*)(ws + WS_WIN), false, scr, r, lane); continue; } r -= I_IN;
        if (r < I_O) { p0_transpose_item(p.w_o, DMIX, D, nullptr, (bf16_t*)(ws + WS_WO), false, scr, r, lane); continue; } r -= I_O;
        if (r < I_UP) { p0_transpose_item(p.w_up, D, 2 * DFF, p.g_ffn, (bf16_t*)(ws + WS_WUP), true, scr, r, lane); continue; } r -= I_UP;
        p0_transpose_item(p.w_down, DFF, D, nullptr, (bf16_t*)(ws + WS_WDN), false, scr, r, lane);
    }
    { bf16_t* wg = (bf16_t*)(ws + WS_WG);
      for (int e = blockIdx.x * 512 + tid; e < 2 * NH * 128 * 128; e += G * 512) {
          const int j = e & 127, k = (e >> 7) & 127, n = (e >> 14) % NH, gsel = e / (NH * 128 * 128);
          const float v = (gsel ? p.w_gate_x : p.w_gate_a)[((size_t)n * 128 + k) * 128 + j];
          wg[(((size_t)gsel * NH + n) * 128 + j) * 128 + k] = (bf16_t)(cvt_pk_bf16(v, 0.f) & 0xffffu);
      } }
    { bf16_t* xb = (bf16_t*)(ws + WS_XB) + (size_t)16 * D; float* rstd1 = (float*)(ws + WS_RS1);
      for (int m = gw; m < M; m += NGW) {
          const f32x4* xr = (const f32x4*)x_row_ptr(p.x_prompt, p.x_sample, p.meta, m) + lane;
          f32x4 v[8]; float s = 0.f;
#pragma unroll
          for (int j = 0; j < 8; ++j) { v[j] = xr[64 * j]; s += (v[j][0] * v[j][0] + v[j][1] * v[j][1]) + (v[j][2] * v[j][2] + v[j][3] * v[j][3]); }
          s = wave_sum(s);
          if (lane == 0) rstd1[m] = __builtin_amdgcn_rsqf(s * (1.0f / D) + EPS);
          u32x2* o = (u32x2*)(xb + (size_t)m * D) + lane;
#pragma unroll
          for (int j = 0; j < 8; ++j) { u32x2 w; w.x = cvt_pk_bf16(v[j][0], v[j][1]); w.y = cvt_pk_bf16(v[j][2], v[j][3]); o[64 * j] = w; }
      } }
}

constexpr int XC_LD = 132, XB_LD = 136;
constexpr int L_XC = 0, L_XB = L_XC + 64 * XC_LD * 4, L_AA = L_XB + 64 * XB_LD * 2, L_UU = L_AA + 64 * XC_LD * 4, L_TOT = L_UU + 64 * XC_LD * 4, L_MIX_END = L_TOT + 4 * 128 * 2 * 4;
static_assert(L_MIX_END <= 131072, "mixer LDS");

__device__ __forceinline__ void branch_b(const Params& p, int G) {
    const bf16_t* z = (const bf16_t*)(p.ws + WS_Z); bf16_t* ym = (bf16_t*)(p.ws + WS_YM);
    const int total = M * 128;
    for (int idx = blockIdx.x * 512 + threadIdx.x; idx < total; idx += G * 512) {
        const int m = idx >> 7, g = idx & 127, ch = 8 * g;
        int is_s, seq, t; row_decode(m, is_s, seq, t);
        float u[3][8];
#pragma unroll
        for (int k = 0; k < 3; ++k) {
            const int tt = t - 2 + k;
            if (tt >= 0) {
                float a[8], b[8];
                unpack8(*(const u32x4*)(z + (size_t)(m - 2 + k) * DIN + 4096 + ch), a); unpack8(*(const u32x4*)(z + (size_t)(m - 2 + k) * DIN + 5120 + ch), b);
#pragma unroll
                for (int e = 0; e < 8; ++e) u[k][e] = a[e] * b[e];
            } else if (is_s) {
                const float* sp = p.st_sc + ((size_t)seq * 2 + (tt + 2)) * DB + ch; const f32x4 a = *(const f32x4*)sp, b = *(const f32x4*)(sp + 4);
#pragma unroll
                for (int e = 0; e < 4; ++e) { u[k][e] = a[e]; u[k][4 + e] = b[e]; }
            } else {
#pragma unroll
                for (int e = 0; e < 8; ++e) u[k][e] = 0.f;
            }
        }
        float gb[8]; unpack8(*(const u32x4*)(z + (size_t)m * DIN + 3072 + ch), gb);
        float y[8]; float ss = 0.f;
#pragma unroll
        for (int e = 0; e < 8; ++e) {
            const float uc = p.conv_b_w[ch + e] * u[0][e] + p.conv_b_w[DB + ch + e] * u[1][e] + p.conv_b_w[2 * DB + ch + e] * u[2][e];
            y[e] = gb[e] * uc; ss += y[e] * y[e];
        }
        ss = sum16(ss);
        const float rn = __builtin_amdgcn_rsqf(ss * (1.0f / 128.0f) + EPS);
#pragma unroll
        for (int e = 0; e < 8; ++e) y[e] = y[e] * rn * p.g_out_b[ch + e];
        *(u32x4*)(ym + (size_t)m * DMIX + DA + ch) = pack8(y);
        const int T = is_s ? TS : TP;
        if (t >= T - 2) { float* so = p.out + (is_s ? O_SSC : O_PSC) + ((size_t)seq * 2 + (t - (T - 2))) * DB + ch;
            *(f32x4*)so = (f32x4){u[2][0], u[2][1], u[2][2], u[2][3]}; *(f32x4*)(so + 4) = (f32x4){u[2][4], u[2][5], u[2][6], u[2][7]}; }
    }
}

template <int PASS>
__device__ __forceinline__ void lru_item(const Params& p, LAS unsigned char* lds, int is_s, int seq0, int chunk, int n) {
    const int tid = threadIdx.x, lane = tid & 63, wave = __builtin_amdgcn_readfirstlane(tid >> 6);
    const bf16_t* z = (const bf16_t*)(p.ws + WS_Z);
    LAS float* XC = (LAS float*)(lds + L_XC); LAS bf16_t* XBF = (LAS bf16_t*)(lds + L_XB); LAS float* AA = (LAS float*)(lds + L_AA); LAS float* UU = (LAS float*)(lds + L_UU); LAS float* TOT = (LAS float*)(lds + L_TOT);
    const int t0 = is_s ? 0 : chunk * CH;
    const int m0 = is_s ? MPR + seq0 * TS : seq0 * TP + t0;
    const int nrows = is_s ? 64 : (TP - t0 < CH ? TP - t0 : CH);
    {
        const int grp = tid & 15, ch = n * 128 + 8 * grp;
        float w[4][8], bias[8];
#pragma unroll
        for (int k = 0; k < 4; ++k) { const f32x4 a = *(const f32x4*)(p.conv_a_w + k * DA + ch), b = *(const f32x4*)(p.conv_a_w + k * DA + ch + 4);
#pragma unroll
            for (int e = 0; e < 4; ++e) { w[k][e] = a[e]; w[k][4 + e] = b[e]; } }
        { const f32x4 a = *(const f32x4*)(p.conv_a_b + ch), b = *(const f32x4*)(p.conv_a_b + ch + 4);
#pragma unroll
            for (int e = 0; e < 4; ++e) { bias[e] = a[e]; bias[4 + e] = b[e]; } }
#pragma unroll
        for (int it = 0; it < 2; ++it) {
            const int row = (tid >> 4) + 32 * it;
            const int rr = row < nrows ? row : nrows - 1;
            const int m = m0 + rr;
            const int t = is_s ? (rr & 7) : t0 + rr;
            const int sq = is_s ? seq0 + (rr >> 3) : seq0;
            float accv[8];
#pragma unroll
            for (int e = 0; e < 8; ++e) accv[e] = bias[e];
#pragma unroll
            for (int k = 0; k < 4; ++k) {
                const int tt = t - 3 + k;
                float xv[8];
                if (tt >= 0) unpack8(*(const u32x4*)(z + (size_t)(m - 3 + k) * DIN + ch), xv);
                else if (is_s) { const float* sp = p.st_rc + ((size_t)sq * 3 + (tt + 3)) * DA + ch; const f32x4 a = *(const f32x4*)sp, b = *(const f32x4*)(sp + 4);
#pragma unroll
                    for (int e = 0; e < 4; ++e) { xv[e] = a[e]; xv[4 + e] = b[e]; } }
                else {
#pragma unroll
                    for (int e = 0; e < 8; ++e) xv[e] = 0.f; }
#pragma unroll
                for (int e = 0; e < 8; ++e) accv[e] += w[k][e] * xv[e];
            }
            *(LAS f32x4*)(XC + row * XC_LD + 8 * grp) = (f32x4){accv[0], accv[1], accv[2], accv[3]};
            *(LAS f32x4*)(XC + row * XC_LD + 8 * grp + 4) = (f32x4){accv[4], accv[5], accv[6], accv[7]};
            *(LAS u32x4*)(XBF + row * XB_LD + 8 * grp) = pack8(accv);
        }
    }
    __syncthreads();
    {
        const int rb = wave & 3, chh = wave >> 2, fr = lane & 15, fq = lane >> 4;
        const bf16_t* wga = (const bf16_t*)(p.ws + WS_WG) + (size_t)n * 128 * 128;
        const bf16_t* wgx = wga + (size_t)NH * 128 * 128;
        f32x4 ca[4], cx[4];
#pragma unroll
        for (int nb = 0; nb < 4; ++nb) { ca[nb] = (f32x4){0.f, 0.f, 0.f, 0.f}; cx[nb] = (f32x4){0.f, 0.f, 0.f, 0.f}; }
#pragma unroll
        for (int ks = 0; ks < 4; ++ks) {
            const bf16x8 af = *(const LAS bf16x8*)(XBF + (16 * rb + fr) * XB_LD + 32 * ks + 8 * fq);
#pragma unroll
            for (int nb = 0; nb < 4; ++nb) {
                const size_t bo = (size_t)(64 * chh + 16 * nb + fr) * 128 + 32 * ks + 8 * fq;
                const bf16x8 ba = *(const bf16x8*)(wga + bo), bx = *(const bf16x8*)(wgx + bo);
                ca[nb] = __builtin_amdgcn_mfma_f32_16x16x32_bf16(af, ba, ca[nb], 0, 0, 0);
                cx[nb] = __builtin_amdgcn_mfma_f32_16x16x32_bf16(af, bx, cx[nb], 0, 0, 0);
            }
        }
#pragma unroll
        for (int nb = 0; nb < 4; ++nb) {
            const int j = 64 * chh + 16 * nb + fr, chn = n * 128 + j;
            const float bga = p.b_gate_a[chn], bgx = p.b_gate_x[chn];
            const float sp = log1pf(__expf(-p.lam[chn]));
#pragma unroll
            for (int rg = 0; rg < 4; ++rg) {
                const int row = 16 * rb + 4 * fq + rg;
                const float r = sigmoidf_(ca[nb][rg] + bga), ig = sigmoidf_(cx[nb][rg] + bgx);
                const float la = -8.0f * r * sp;
                const float a = __expf(la);
                const float x2 = 2.0f * la;
                const float em1 = x2 > -0.1f ? x2 * (1.0f + 0.5f * x2 * (1.0f + (1.0f / 3.0f) * x2 * (1.0f + 0.25f * x2 * (1.0f + 0.2f * x2)))) : (a * a - 1.0f);
                const float uu = sqrtf(-em1) * (ig * XC[row * XC_LD + j]);
                AA[row * XC_LD + j] = a; UU[row * XC_LD + j] = uu;
            }
        }
    }
    __syncthreads();
    {
        const int j = tid & 127, seg = tid >> 7, chn = n * 128 + j;
        if (is_s) {
            if (PASS == 2) {
#pragma unroll
                for (int q = 0; q < 2; ++q) {
                    const int sq = seq0 + 2 * seg + q;
                    float h = p.st_h[(size_t)sq * DA + chn];
#pragma unroll
                    for (int i = 0; i < 8; ++i) { const int row = 16 * seg + 8 * q + i; h = AA[row * XC_LD + j] * h + UU[row * XC_LD + j]; UU[row * XC_LD + j] = h; }
                    p.out[O_SH + (size_t)sq * DA + chn] = h;
                }
            }
        } else {
            float P = 1.f, S = 0.f;
#pragma unroll
            for (int i = 0; i < 16; ++i) { const int row = 16 * seg + i; const float a = AA[row * XC_LD + j], u = UU[row * XC_LD + j]; S = a * S + u; P = P * a; UU[row * XC_LD + j] = S; AA[row * XC_LD + j] = P; }
            TOT[(seg * 128 + j) * 2] = P; TOT[(seg * 128 + j) * 2 + 1] = S;
            __syncthreads();
            float* tot = (float*)(p.ws + WS_TOT);
            if (PASS == 1) {
                if (seg == 0) { float Pt = 1.f, St = 0.f;
#pragma unroll
                    for (int s2 = 0; s2 < 4; ++s2) { const float Ps = TOT[(s2 * 128 + j) * 2], Ss = TOT[(s2 * 128 + j) * 2 + 1]; St = Ps * St + Ss; Pt = Pt * Ps; }
                    float* o = tot + (((size_t)seq0 * NCH + chunk) * DA + chn) * 2; o[0] = Pt; o[1] = St; }
            } else {
                float h = 0.f;
                for (int c2 = 0; c2 < chunk; ++c2) { const float* o = tot + (((size_t)seq0 * NCH + c2) * DA + chn) * 2; h = o[0] * h + o[1]; }
                for (int s2 = 0; s2 < seg; ++s2) h = TOT[(s2 * 128 + j) * 2] * h + TOT[(s2 * 128 + j) * 2 + 1];
#pragma unroll
                for (int i = 0; i < 16; ++i) { const int row = 16 * seg + i; const float hf = UU[row * XC_LD + j] + AA[row * XC_LD + j] * h; UU[row * XC_LD + j] = hf;
                    if (t0 + row == TP - 1) p.out[O_PH + (size_t)seq0 * DA + chn] = hf; }
            }
        }
    }
    __syncthreads();
    if (PASS == 2) {
        bf16_t* ym = (bf16_t*)(p.ws + WS_YM);
        const int grp = tid & 15, ch = n * 128 + 8 * grp;
        float go[8];
        { const f32x4 a = *(const f32x4*)(p.g_out_a + ch), b = *(const f32x4*)(p.g_out_a + ch + 4);
#pragma unroll
            for (int e = 0; e < 4; ++e) { go[e] = a[e]; go[4 + e] = b[e]; } }
#pragma unroll
        for (int it = 0; it < 2; ++it) {
            const int row = (tid >> 4) + 32 * it;
            const int rr = row < nrows ? row : nrows - 1;
            const int m = m0 + rr;
            float gav[8]; unpack8(*(const u32x4*)(z + (size_t)m * DIN + DA + ch), gav);
            const f32x4 h0 = *(const LAS f32x4*)(UU + rr * XC_LD + 8 * grp), h1 = *(const LAS f32x4*)(UU + rr * XC_LD + 8 * grp + 4);
            float y[8]; float ss = 0.f;
#pragma unroll
            for (int e = 0; e < 8; ++e) { y[e] = gelu_tanh(gav[e]) * (e < 4 ? h0[e] : h1[e - 4]); ss += y[e] * y[e]; }
            ss = sum16(ss);
            const float rn = __builtin_amdgcn_rsqf(ss * (1.0f / 128.0f) + EPS);
#pragma unroll
            for (int e = 0; e < 8; ++e) y[e] = y[e] * rn * go[e];
            if (row < nrows) *(u32x4*)(ym + (size_t)m * DMIX + ch) = pack8(y);
        }
    }
    __syncthreads();
}
template <int PASS>
__device__ __forceinline__ void mixer_phase(const Params& p, LAS unsigned char* lds, int G) {
    constexpr int NPI = NB * NCH * NH;
    constexpr int NSI = (NS / 8) * NH;
    const int nitems = PASS == 1 ? NPI : NPI + NSI;
    for (int it = blockIdx.x; it < nitems; it += G) {
        if (it < NPI) { const int n = it % NH, q = it / NH, c = q % NCH, b = q / NCH; lru_item<PASS>(p, lds, 0, b, c, n); }
        else { const int i2 = it - NPI, n = i2 % NH, sb = i2 / NH; lru_item<PASS>(p, lds, 1, sb * 8, 0, n); }
    }
    if (PASS == 1) branch_b(p, G);
}

__device__ __forceinline__ void final_phase(const Params& p, int G) {
    const int lane = threadIdx.x & 63, gw = blockIdx.x * 8 + (threadIdx.x >> 6), NGW = G * 8;
    f32x4 gf[8];
#pragma unroll
    for (int j = 0; j < 8; ++j) gf[j] = ((const f32x4*)p.g_final)[lane + 64 * j];
    for (int r = gw; r < NB * SEQ + MSR; r += NGW) {
        f32x4* yr = (f32x4*)(p.out + (size_t)r * D) + lane;
        f32x4 v[8]; float s = 0.f;
#pragma unroll
        for (int j = 0; j < 8; ++j) { v[j] = yr[64 * j]; s += (v[j][0] * v[j][0] + v[j][1] * v[j][1]) + (v[j][2] * v[j][2] + v[j][3] * v[j][3]); }
        s = wave_sum(s);
        const float rs = __builtin_amdgcn_rsqf(s * (1.0f / D) + EPS);
#pragma unroll
        for (int j = 0; j < 8; ++j) yr[64 * j] = v[j] * rs * gf[j];
    }
}

constexpr int LDS_BYTES = 132096;
constexpr int N_PHASES = 8;
__global__ void __launch_bounds__(512, 2) hymba_fwd(Params p) {
    extern __shared__ __attribute__((aligned(16))) unsigned char lds_raw[];
    LAS unsigned char* lds = (LAS unsigned char*)lds_raw;
    cg::grid_group grid = cg::this_grid();
    const int G = gridDim.x;
    unsigned char* ws = p.ws;
    const int lo = p.ph_lo, hi = p.ph_hi;
#ifndef PH_MASK
#define PH_MASK 0xff
#endif
#define IN(k) (((PH_MASK >> (k)) & 1) && lo <= (k) && (k) < hi)
#define SEAM(k) do { if (IN(k) && IN((k) + 1)) grid.sync(); } while (0)
    if (IN(0)) phase0(p, lds, G);
    SEAM(0);
    if (IN(1)) {
        pg8::Gemm g{(const bf16_t*)(ws + WS_XB) + (size_t)16 * D, (const bf16_t*)(ws + WS_WIN), MP / 256, DIN / 256, D, (size_t)256 * D * 2, (size_t)128 * D * 2};
        pg8::StaticOrder S; S.init(g.nM, g.nN, G, (int)blockIdx.x);
        EpiZ E{(const float*)(ws + WS_RS1), (bf16_t*)(ws + WS_Z), p.out};
        pg8::gemm_phase<EpiZ, false, true, true>(lds, g, S, E);
    }
    SEAM(1);
    if (IN(2)) mixer_phase<1>(p, lds, G);
    SEAM(2);
    if (IN(3)) mixer_phase<2>(p, lds, G);
    SEAM(3);
    if (IN(4)) {
        pg8::Gemm g{(const bf16_t*)(ws + WS_YM), (const bf16_t*)(ws + WS_WO), MP / 256, D / 256, DMIX, (size_t)256 * DMIX * 2, (size_t)128 * DMIX * 2};
        pg8::StaticOrder S; S.init(g.nM, g.nN, G, (int)blockIdx.x);
        EpiX1 E{p.x_prompt, p.x_sample, p.meta, p.out, (bf16_t*)(ws + WS_XB) + (size_t)16 * D, (float*)(ws + WS_SSQ)};
        pg8::gemm_phase<EpiX1, false, true, true>(lds, g, S, E);
    }
    SEAM(4);
    if (IN(5)) {
        pg8::Gemm g{(const bf16_t*)(ws + WS_XB) + (size_t)14 * D, (const bf16_t*)(ws + WS_WUP), 37, 2 * DFF / 256, D, (size_t)252 * D * 2, (size_t)64 * D * 2};
        pg8::StaticOrder S; S.init(g.nM, g.nN, G, (int)blockIdx.x);
        EpiFFN E{(const float*)(ws + WS_SSQ), p.conv_f_w, p.conv_f_b, p.st_fc, (bf16_t*)(ws + WS_Z), p.out};
        pg8::gemm_phase<EpiFFN, true, true, true>(lds, g, S, E);
    }
    SEAM(5);
    if (IN(6)) {
        pg8::Gemm g{(const bf16_t*)(ws + WS_Z), (const bf16_t*)(ws + WS_WDN), MP / 256, D / 256, DFF, (size_t)256 * DFF * 2, (size_t)128 * DFF * 2};
        pg8::StaticOrder S; S.init(g.nM, g.nN, G, (int)blockIdx.x);
        EpiOut E{p.out};
        pg8::gemm_phase<EpiOut, false, true, true>(lds, g, S, E);
    }
    SEAM(6);
    if (IN(7)) final_phase(p, G);
#undef IN
#undef SEAM
}

extern "C" void kernel_launch(void* const* d_in, const int* in_sizes, int n_in, void* d_out, int out_size, void* d_ws, size_t ws_size, hipStream_t stream) {
    static int grid = 0;
    if (grid == 0) {
        if (n_in != 26 || (size_t)out_size != O_END || ws_size < WS_END) { fprintf(stderr, "kernel_launch: unexpected problem (n_in %d, out %d, ws %zu; need ws >= %zu)\n", n_in, out_size, ws_size, (size_t)WS_END); grid = -1; return; }
        int dev = 0, cus = 0, per_cu = 0;
        hipGetDevice(&dev); hipDeviceGetAttribute(&cus, hipDeviceAttributeMultiprocessorCount, dev);
        if (hipFuncSetAttribute((const void*)hymba_fwd, hipFuncAttributeMaxDynamicSharedMemorySize, LDS_BYTES) != hipSuccess) { fprintf(stderr, "kernel_launch: hipFuncSetAttribute failed\n"); grid = -1; return; }
        if (hipOccupancyMaxActiveBlocksPerMultiprocessor(&per_cu, (const void*)hymba_fwd, 512, LDS_BYTES) != hipSuccess || per_cu < 1) { fprintf(stderr, "kernel_launch: occupancy query says %d\n", per_cu); grid = -1; return; }
        grid = cus;
    }
    if (grid < 0) return;
    Params p{};
    const float** f = (const float**)&p;
    for (int i = 0; i < 26; ++i) f[i] = (const float*)d_in[i];
    p.out = (float*)d_out; p.ws = (unsigned char*)d_ws;
    if (MK_N_LAUNCHES == 1) {
        p.ph_lo = 0; p.ph_hi = N_PHASES;
        void* args[] = {&p};
        hipError_t e = hipLaunchCooperativeKernel((const void*)hymba_fwd, dim3(grid), dim3(512), args, LDS_BYTES, stream);
        if (e != hipSuccess) fprintf(stderr, "cooperative launch failed: %s (grid %d)\n", hipGetErrorString(e), grid);
    } else {
        for (int k = 0; k < N_PHASES; ++k) { p.ph_lo = k; p.ph_hi = k + 1; hipLaunchKernelGGL(hymba_fwd, dim3(grid), dim3(512), LDS_BYTES, stream, p); }
    }
}
```

```cpp
#include <hip/hip_runtime.h>
#include <cstdio>

#ifndef MK_N_LAUNCHES
#define MK_N_LAUNCHES 1
#endif

#define LAS __attribute__((address_space(3)))
typedef unsigned short bf16_t;
typedef short bf16x8 __attribute__((ext_vector_type(8)));
typedef float f32x4 __attribute__((ext_vector_type(4)));
typedef unsigned u32x4 __attribute__((ext_vector_type(4)));
typedef unsigned u32x2 __attribute__((ext_vector_type(2)));

constexpr int D = 2048, NMETA = 16, SEQ = 2048, TP = SEQ + NMETA, NB = 4, MPR = NB * TP;
constexpr int NS = 128, TS = 8, MSR = NS * TS, M = MPR + MSR;
constexpr int MP = 9472;
constexpr int DA = 1536, DB = 1024, DIN = 6144, DMIX = 2560, DFF = 6144, NH = 12;
constexpr float EPS = 1e-6f;
constexpr int NCH = 33, CH = 64;
constexpr size_t O_YP = 0, O_YS = O_YP + (size_t)NB * SEQ * D, O_PH = O_YS + (size_t)MSR * D, O_PRC = O_PH + NB * DA,
                 O_PSC = O_PRC + NB * 3 * DA, O_PFC = O_PSC + NB * 2 * DB, O_SH = O_PFC + NB * 2 * DFF, O_SRC = O_SH + NS * DA,
                 O_SSC = O_SRC + (size_t)NS * 3 * DA, O_SFC = O_SSC + (size_t)NS * 2 * DB, O_END = O_SFC + (size_t)NS * 2 * DFF;
constexpr size_t MiB = 1u << 20;
constexpr size_t WS_WIN = 1 * MiB;
constexpr size_t WS_WO = WS_WIN + (size_t)DIN * D * 2;
constexpr size_t WS_WUP = WS_WO + (size_t)D * DMIX * 2;
constexpr size_t WS_WDN = WS_WUP + (size_t)2 * DFF * D * 2;
constexpr size_t WS_WG = WS_WDN + (size_t)D * DFF * 2;
constexpr size_t WS_XB = WS_WG + (size_t)2 * NH * 128 * 128 * 2;
constexpr size_t XB_ROWS = 9600;
constexpr size_t WS_Z = WS_XB + XB_ROWS * D * 2;
constexpr size_t WS_YM = WS_Z + (size_t)MP * DIN * 2;
constexpr size_t WS_RS1 = WS_YM + (size_t)MP * DMIX * 2;
constexpr size_t WS_SSQ = WS_RS1 + (size_t)MP * 4;
constexpr size_t WS_TOT = WS_SSQ + (size_t)MP * 32 * 4;
constexpr size_t WS_END = WS_TOT + (size_t)NB * NCH * DA * 2 * 4;

struct Params {
    const float *x_prompt, *x_sample, *st_h, *st_rc, *st_sc, *st_fc, *meta, *g_mix, *w_in, *conv_a_w, *conv_a_b, *w_gate_a, *b_gate_a,
        *w_gate_x, *b_gate_x, *lam, *conv_b_w, *g_out_a, *g_out_b, *w_o, *g_ffn, *w_up, *conv_f_w, *conv_f_b, *w_down, *g_final;
    float* out; unsigned char* ws; int ph_lo, ph_hi;
};

__device__ __forceinline__ unsigned cvt_pk_bf16(float lo, float hi) { unsigned r; asm volatile("v_cvt_pk_bf16_f32 %0, %1, %2" : "=v"(r) : "v"(lo), "v"(hi)); return r; }
__device__ __forceinline__ float bf_lo(unsigned w) { return __builtin_bit_cast(float, w << 16); }
__device__ __forceinline__ float bf_hi(unsigned w) { return __builtin_bit_cast(float, w & 0xffff0000u); }
__device__ __forceinline__ void unpack8(const u32x4 w, float (&f)[8]) { f[0] = bf_lo(w.x); f[1] = bf_hi(w.x); f[2] = bf_lo(w.y); f[3] = bf_hi(w.y); f[4] = bf_lo(w.z); f[5] = bf_hi(w.z); f[6] = bf_lo(w.w); f[7] = bf_hi(w.w); }
__device__ __forceinline__ u32x4 pack8(const float (&f)[8]) { u32x4 w; w.x = cvt_pk_bf16(f[0], f[1]); w.y = cvt_pk_bf16(f[2], f[3]); w.z = cvt_pk_bf16(f[4], f[5]); w.w = cvt_pk_bf16(f[6], f[7]); return w; }
__device__ __forceinline__ float wave_sum(float v) {
#pragma unroll
    for (int o = 1; o < 64; o <<= 1) v += __shfl_xor(v, o);
    return v;
}
__device__ __forceinline__ float sum16(float v) {
    v += __shfl_xor(v, 1); v += __shfl_xor(v, 2); v += __shfl_xor(v, 4); v += __shfl_xor(v, 8); return v;
}
__device__ __forceinline__ float sigmoidf_(float x) { return __builtin_amdgcn_rcpf(1.0f + __expf(-x)); }
__device__ __forceinline__ float gelu_tanh(float x) {
    const float t = x * (1.0f + 0.044715f * x * x) * (-2.0f * 0.7978845608028654f * 1.4426950408889634f);
    return x * __builtin_amdgcn_rcpf(1.0f + __builtin_amdgcn_exp2f(t));
}
template <int CTRL> __device__ __forceinline__ float dppf(float old, float src) {
    return __builtin_bit_cast(float, __builtin_amdgcn_update_dpp(__builtin_bit_cast(int, old), __builtin_bit_cast(int, src), CTRL, 0xF, 0xF, false));
}
__device__ __forceinline__ void row_decode(int r, int& is_s, int& seq, int& t) {
    if (r < MPR) { seq = (r >= TP) + (r >= 2 * TP) + (r >= 3 * TP); t = r - seq * TP; is_s = 0; }
    else { const int q = r - MPR; seq = q >> 3; t = q & 7; is_s = 1; }
}
__device__ __forceinline__ const float* x_row_ptr(const float* xp, const float* xs, const float* meta, int r) {
    int is_s, seq, t; row_decode(r, is_s, seq, t);
    if (is_s) return xs + (size_t)(r - MPR) * D;
    return t < NMETA ? meta + (size_t)t * D : xp + ((size_t)seq * SEQ + (t - NMETA)) * D;
}
__device__ __forceinline__ float* y_row_ptr(float* out, int r) {
    if (r >= M) return nullptr;
    int is_s, seq, t; row_decode(r, is_s, seq, t);
    if (is_s) return out + O_YS + (size_t)(r - MPR) * D;
    return t < NMETA ? nullptr : out + O_YP + ((size_t)seq * SEQ + (t - NMETA)) * D;
}

namespace pg8 {
constexpr int BM = 256, BK = 64, HALF = 128, HTB = HALF * BK * 2, STAGE_BYTES = 8 * HTB, NXCD = 8, WGM = 8;
__host__ __device__ __forceinline__ int lds_byte(int r, int c) { const int st = (r >> 4) * 2 + (c >> 5), rr = r & 15, cc = c & 31, ob = rr * 64 + cc * 2; return st * 1024 + (ob ^ (((ob >> 9) & 1) << 5)); }
__host__ __device__ __forceinline__ void stage_rc(int b, int& R, int& C) { const int st = b / 1024, sb = b % 1024, swz = sb ^ (((sb >> 9) & 1) << 5); R = (st >> 1) * 16 + swz / 64; C = (st & 1) * 32 + (swz % 64) / 2; }
struct Unit { int pm, pn; };
struct Gemm { const bf16_t* A; const bf16_t* Bt; int nM, nN, K; size_t a_tstep, a_hstep; };
struct StaticOrder {
    int nM, nN, nwg, G, c;
    __device__ void init(int nM_, int nN_, int G_, int c_) { nM = nM_; nN = nN_; nwg = nM * nN; G = G_; c = c_; }
    __device__ bool next(int i, Unit& u) const {
        const long L = (long)i * G + c; if (L >= nwg) return false;
        int wgid = (int)L; { const int q = nwg / NXCD, r = nwg % NXCD, xcd = wgid % NXCD, off = wgid / NXCD; wgid = (xcd < r ? xcd * (q + 1) : r * (q + 1) + (xcd - r) * q) + off; }
        const int nig = WGM * nN, gid = wgid / nig, fm = gid * WGM, gsz = (nM - fm) < WGM ? (nM - fm) : WGM;
        u.pm = fm + ((wgid % nig) % gsz); u.pn = (wgid % nig) / gsz; return true;
    }
};

template <class Epi, bool FFNMAP, bool ALIGN_EPI, bool SP2>
__device__ __forceinline__ void gemm_phase(LAS unsigned char* lds, const Gemm g, const StaticOrder& S, const Epi& E) {
    int tid = threadIdx.x; asm volatile("" : "+v"(tid));
    const int wid = __builtin_amdgcn_readfirstlane(tid >> 6), lane = tid & 63, wr = wid >> 2, wc = wid & 3, fr = lane & 15, fq = lane >> 4;
    const int K = g.K, nt = K / BK;
    unsigned voffA[2], voffB[2];
#pragma unroll
    for (int i = 0; i < 2; ++i) { int R, C; stage_rc(tid * 16 + i * 8192, R, C); const int Ra = FFNMAP ? (126 * (R >> 6) + (R & 63)) : R;
        voffA[i] = (unsigned)(Ra * K + C) * 2u; voffB[i] = (unsigned)(R * K + C) * 2u; }
    const size_t kstep = (size_t)(BK * 2);
    const size_t hstepA = g.a_hstep, tstepA = g.a_tstep;
    const size_t hstepB = (size_t)HALF * K * 2, tstepB = 2 * hstepB;
    const unsigned ldsw = (unsigned)wid * 1024u;
    const int aoff = lds_byte(wr * 64 + fr, fq * 8), boff = lds_byte(wc * 32 + fr, fq * 8);
#define PG8_SA(b, h) (((b) * 2 + (h)) * HTB)
#define PG8_SB(b, h) ((4 + (b) * 2 + (h)) * HTB)
#define PG8_STAGE(bufoff, gbase, voff) do { _Pragma("unroll") for (int _i = 0; _i < 2; ++_i) \
        __builtin_amdgcn_global_load_lds((const unsigned*)((const char*)(gbase) + (voff)[_i]), (LAS unsigned*)(lds + (bufoff) + ldsw + _i * 8192), 16, 0, 0); } while (0)
#define PG8_LDA(dst, b, h) do { _Pragma("unroll") for (int m = 0; m < 4; ++m) _Pragma("unroll") for (int k = 0; k < 2; ++k) dst[m][k] = *(const LAS bf16x8*)(lds + PG8_SA(b, h) + aoff + m * 2048 + k * 1024); } while (0)
#define PG8_LDB(dst, b, h) do { _Pragma("unroll") for (int n = 0; n < 2; ++n) _Pragma("unroll") for (int k = 0; k < 2; ++k) dst[n][k] = *(const LAS bf16x8*)(lds + PG8_SB(b, h) + boff + n * 2048 + k * 1024); } while (0)
#define PG8_MMA(ai, bj, At, Bt) do { __builtin_amdgcn_s_setprio(1); _Pragma("unroll") for (int m = 0; m < 4; ++m) _Pragma("unroll") for (int n = 0; n < 2; ++n) _Pragma("unroll") for (int k = 0; k < 2; ++k) \
        acc[ai][bj][m][n] = __builtin_amdgcn_mfma_f32_16x16x32_bf16(Bt[n][k], At[m][k], acc[ai][bj][m][n], 0, 0, 0); __builtin_amdgcn_s_setprio(0); } while (0)
#define PG8_WAIT_V(n) asm volatile("s_waitcnt vmcnt(" #n ")" ::: "memory")
#define PG8_WAIT_L(n) asm volatile("s_waitcnt lgkmcnt(" #n ")" ::: "memory")
#define PG8_BAR __builtin_amdgcn_s_barrier()
#define PG8_SCHED __builtin_amdgcn_sched_barrier(0)
    Unit cur, nxt; int ui = 0;
    if (!S.next(0, cur)) return;
    f32x4 acc[2][2][4][2];
#pragma unroll
    for (int a = 0; a < 2; ++a)
#pragma unroll
        for (int b = 0; b < 2; ++b)
#pragma unroll
            for (int m = 0; m < 4; ++m)
#pragma unroll
                for (int n = 0; n < 2; ++n) acc[a][b][m][n] = (f32x4){0.f, 0.f, 0.f, 0.f};
    bf16x8 At[4][2], B0[2][2], B1[2][2];
    const char* cA = (const char*)g.A + (size_t)cur.pm * tstepA; const char* cB = (const char*)g.Bt + (size_t)cur.pn * tstepB;
    if constexpr (SP2) {
        PG8_STAGE(PG8_SB(0, 0), cB, voffB); PG8_STAGE(PG8_SB(0, 1), cB + hstepB, voffB); PG8_STAGE(PG8_SA(0, 0), cA, voffA); PG8_STAGE(PG8_SA(0, 1), cA + hstepA, voffA);
        if (wr == 1) PG8_BAR;
        PG8_WAIT_V(2); PG8_BAR;
        PG8_STAGE(PG8_SB(1, 0), cB + kstep, voffB); PG8_STAGE(PG8_SA(1, 0), cA + kstep, voffA); PG8_STAGE(PG8_SB(1, 1), cB + hstepB + kstep, voffB);
        PG8_WAIT_V(6); PG8_BAR;
    } else {
        PG8_STAGE(PG8_SB(0, 0), cB, voffB); PG8_STAGE(PG8_SA(0, 0), cA, voffA); PG8_STAGE(PG8_SB(0, 1), cB + hstepB, voffB); PG8_STAGE(PG8_SA(0, 1), cA + hstepA, voffA);
        if (wr == 1) PG8_BAR;
        PG8_WAIT_V(4); PG8_BAR;
        PG8_STAGE(PG8_SB(1, 0), cB + kstep, voffB); PG8_STAGE(PG8_SA(1, 0), cA + kstep, voffA); PG8_STAGE(PG8_SB(1, 1), cB + hstepB + kstep, voffB);
        PG8_WAIT_V(6); PG8_BAR;
    }
    for (;;) {
        const bool has_next = S.next(ui + 1, nxt);
        const char* nA = has_next ? (const char*)g.A + (size_t)nxt.pm * tstepA : cA; const char* nB = has_next ? (const char*)g.Bt + (size_t)nxt.pn * tstepB : cB;
        for (int t = 0; t < nt; t += 2) {
            const bool last = (t == nt - 2);
            const char* a1 = cA + (size_t)(t + 1) * kstep;
            const char* a2 = last ? nA : cA + (size_t)(t + 2) * kstep; const char* b2 = last ? nB : cB + (size_t)(t + 2) * kstep;
            const char* a3 = a2 + kstep; const char* b3 = b2 + kstep;
            if constexpr (SP2) {
            PG8_LDB(B0, 0, 0); PG8_LDB(B1, 0, 1); PG8_SCHED; PG8_LDA(At, 0, 0); PG8_STAGE(PG8_SA(1, 1), a1 + hstepA, voffA);
            PG8_WAIT_V(8); PG8_WAIT_L(0); PG8_BAR; PG8_MMA(0, 0, At, B0); PG8_MMA(0, 1, At, B1); PG8_BAR; PG8_SCHED;
            PG8_LDA(At, 0, 1); PG8_STAGE(PG8_SB(0, 0), b2, voffB); PG8_STAGE(PG8_SB(0, 1), b2 + hstepB, voffB); PG8_STAGE(PG8_SA(0, 0), a2, voffA);
            PG8_WAIT_V(8); PG8_WAIT_L(0); PG8_BAR; PG8_MMA(1, 0, At, B0); PG8_MMA(1, 1, At, B1); PG8_BAR; PG8_SCHED;
            PG8_LDB(B0, 1, 0); PG8_LDB(B1, 1, 1); PG8_SCHED; PG8_LDA(At, 1, 0); PG8_STAGE(PG8_SA(0, 1), a2 + hstepA, voffA);
            PG8_WAIT_V(8); PG8_WAIT_L(0); PG8_BAR; PG8_MMA(0, 0, At, B0); PG8_MMA(0, 1, At, B1); PG8_BAR; PG8_SCHED;
            PG8_LDA(At, 1, 1); PG8_STAGE(PG8_SB(1, 0), b3, voffB); PG8_STAGE(PG8_SB(1, 1), b3 + hstepB, voffB); PG8_STAGE(PG8_SA(1, 0), a3, voffA);
            PG8_WAIT_V(8); PG8_WAIT_L(0); PG8_BAR; PG8_MMA(1, 0, At, B0); PG8_MMA(1, 1, At, B1); PG8_BAR; PG8_SCHED;
            } else {
            PG8_LDB(B0, 0, 0); PG8_SCHED; PG8_LDA(At, 0, 0); PG8_STAGE(PG8_SA(1, 1), a1 + hstepA, voffA);
            PG8_WAIT_L(8); PG8_BAR; PG8_WAIT_L(0); PG8_MMA(0, 0, At, B0); PG8_BAR; PG8_SCHED;
            PG8_LDB(B1, 0, 1); PG8_STAGE(PG8_SB(0, 0), b2, voffB);
            PG8_BAR; PG8_WAIT_L(0); PG8_MMA(0, 1, At, B1); PG8_BAR;
            PG8_LDA(At, 0, 1); PG8_STAGE(PG8_SA(0, 0), a2, voffA);
            PG8_BAR; PG8_WAIT_L(0); PG8_MMA(1, 0, At, B0); PG8_BAR; PG8_SCHED;
            PG8_STAGE(PG8_SB(0, 1), b2 + hstepB, voffB);
            PG8_WAIT_V(6); PG8_BAR; PG8_MMA(1, 1, At, B1); PG8_BAR;
            PG8_LDB(B0, 1, 0); PG8_SCHED; PG8_LDA(At, 1, 0); PG8_STAGE(PG8_SA(0, 1), a2 + hstepA, voffA);
            PG8_WAIT_L(8); PG8_BAR; PG8_WAIT_L(0); PG8_MMA(0, 0, At, B0); PG8_BAR; PG8_SCHED;
            PG8_LDB(B1, 1, 1); PG8_STAGE(PG8_SB(1, 0), b3, voffB);
            PG8_BAR; PG8_WAIT_L(0); PG8_MMA(0, 1, At, B1); PG8_BAR;
            PG8_LDA(At, 1, 1); PG8_STAGE(PG8_SA(1, 0), a3, voffA);
            PG8_BAR; PG8_WAIT_L(0); PG8_MMA(1, 0, At, B0); PG8_BAR; PG8_SCHED;
            PG8_STAGE(PG8_SB(1, 1), b3 + hstepB, voffB);
            PG8_WAIT_V(6); PG8_BAR; PG8_MMA(1, 1, At, B1); PG8_BAR;
            }
        }
        if constexpr (ALIGN_EPI) { if (wr == 0) PG8_BAR; }
        E(acc, cur, wr, wc, fr, fq);
        if (!has_next) break;
#pragma unroll
        for (int a = 0; a < 2; ++a)
#pragma unroll
            for (int b = 0; b < 2; ++b)
#pragma unroll
                for (int m = 0; m < 4; ++m)
#pragma unroll
                    for (int n = 0; n < 2; ++n) acc[a][b][m][n] = (f32x4){0.f, 0.f, 0.f, 0.f};
        cur = nxt; cA = nA; cB = nB; ++ui;
        if constexpr (ALIGN_EPI) { if (wr == 1) PG8_BAR; }
    }
    PG8_WAIT_V(0);
    if constexpr (!ALIGN_EPI) { if (wr == 0) PG8_BAR; }
    PG8_BAR;
#undef PG8_SA
#undef PG8_SB
#undef PG8_STAGE
#undef PG8_LDA
#undef PG8_LDB
#undef PG8_MMA
#undef PG8_WAIT_V
#undef PG8_WAIT_L
#undef PG8_BAR
#undef PG8_SCHED
}
}

typedef f32x4 Acc[2][2][4][2];

struct EpiZ {
    const float* rstd1; bf16_t* z; float* out;
    __device__ __forceinline__ void operator()(const Acc& acc, const pg8::Unit& u, int wr, int wc, int fr, int fq) const {
        const int col0 = u.pn * 256 + wc * 32 + 8 * fq;
#pragma unroll
        for (int ai = 0; ai < 2; ++ai)
#pragma unroll
            for (int m = 0; m < 4; ++m) {
                const int r = u.pm * 256 + ai * 128 + wr * 64 + m * 16 + fr;
                if (r < M) {
                    const float rs = rstd1[r];
                    int is_s, seq, t; row_decode(r, is_s, seq, t);
                    float* so = nullptr;
                    if (u.pn < 6) { if (is_s) { if (t >= TS - 3) so = out + O_SRC + ((size_t)seq * 3 + (t - (TS - 3))) * DA; } else { if (t >= TP - 3) so = out + O_PRC + ((size_t)seq * 3 + (t - (TP - 3))) * DA; } }
#pragma unroll
                    for (int bj = 0; bj < 2; ++bj) {
                        const f32x4 v0 = acc[ai][bj][m][0] * rs, v1 = acc[ai][bj][m][1] * rs;
                        u32x4 w; w.x = cvt_pk_bf16(v0[0], v0[1]); w.y = cvt_pk_bf16(v0[2], v0[3]); w.z = cvt_pk_bf16(v1[0], v1[1]); w.w = cvt_pk_bf16(v1[2], v1[3]);
                        *(u32x4*)(z + (size_t)r * DIN + col0 + bj * 128) = w;
                        if (so) { *(f32x4*)(so + col0 + bj * 128) = v0; *(f32x4*)(so + col0 + bj * 128 + 4) = v1; }
                    }
                }
            }
    }
};
struct EpiX1 {
    const float *xp, *xs, *meta; float* out; bf16_t* x1b; float* ssq;
    __device__ __forceinline__ void operator()(const Acc& acc, const pg8::Unit& u, int wr, int wc, int fr, int fq) const {
        const int col0 = u.pn * 256 + wc * 32 + 8 * fq;
#pragma unroll
        for (int ai = 0; ai < 2; ++ai)
#pragma unroll
            for (int m = 0; m < 4; ++m) {
                const int r = u.pm * 256 + ai * 128 + wr * 64 + m * 16 + fr;
                const bool valid = r < M;
                const float* xr = x_row_ptr(xp, xs, meta, valid ? r : 0);
                float* yd = y_row_ptr(out, r);
                float ss = 0.f;
#pragma unroll
                for (int bj = 0; bj < 2; ++bj) {
                    const int c = col0 + bj * 128;
                    const f32x4 v0 = acc[ai][bj][m][0] + *(const f32x4*)(xr + c), v1 = acc[ai][bj][m][1] + *(const f32x4*)(xr + c + 4);
                    ss += (v0[0] * v0[0] + v0[1] * v0[1]) + (v0[2] * v0[2] + v0[3] * v0[3]) + (v1[0] * v1[0] + v1[1] * v1[1]) + (v1[2] * v1[2] + v1[3] * v1[3]);
                    if (yd) { *(f32x4*)(yd + c) = v0; *(f32x4*)(yd + c + 4) = v1; }
                    if (valid) { u32x4 w; w.x = cvt_pk_bf16(v0[0], v0[1]); w.y = cvt_pk_bf16(v0[2], v0[3]); w.z = cvt_pk_bf16(v1[0], v1[1]); w.w = cvt_pk_bf16(v1[2], v1[3]);
                        *(u32x4*)(x1b + (size_t)r * D + c) = w; }
                }
                ss += __shfl_xor(ss, 16); ss += __shfl_xor(ss, 32);
                if (valid && fq == 0) ssq[(size_t)r * 32 + u.pn * 4 + wc] = ss;
            }
    }
};
struct EpiOut {
    float* out;
    __device__ __forceinline__ void operator()(const Acc& acc, const pg8::Unit& u, int wr, int wc, int fr, int fq) const {
        const int col0 = u.pn * 256 + wc * 32 + 8 * fq;
#pragma unroll
        for (int ai = 0; ai < 2; ++ai)
#pragma unroll
            for (int m = 0; m < 4; ++m) {
                const int r = u.pm * 256 + ai * 128 + wr * 64 + m * 16 + fr;
                float* yd = y_row_ptr(out, r);
                if (yd) {
#pragma unroll
                    for (int bj = 0; bj < 2; ++bj) {
                        const int c = col0 + bj * 128;
                        const f32x4 v0 = acc[ai][bj][m][0] + *(const f32x4*)(yd + c), v1 = acc[ai][bj][m][1] + *(const f32x4*)(yd + c + 4);
                        *(f32x4*)(yd + c) = v0; *(f32x4*)(yd + c + 4) = v1;
                    }
                }
            }
    }
};
struct EpiFFN {
    const float *ssq, *cw, *cb, *st_fc; bf16_t* hid; float* out;
    __device__ __forceinline__ void operator()(Acc& acc, const pg8::Unit& u, int wr, int wc, int fr, int fq) const {
        const int gbase = 252 * u.pm - 2 + 126 * wr;
        const int f0 = 128 * u.pn + 32 * wc + 8 * fq;
#pragma unroll
        for (int ai = 0; ai < 2; ++ai)
#pragma unroll
            for (int m = 0; m < 4; ++m) {
                int r = gbase + 64 * ai + 16 * m + fr; r = r < 0 ? 0 : (r >= M ? M - 1 : r);
                const float* sp = ssq + (size_t)r * 32 + 8 * fq;
                const f32x4 a = *(const f32x4*)sp, b = *(const f32x4*)(sp + 4);
                float s = ((a[0] + a[1]) + (a[2] + a[3])) + ((b[0] + b[1]) + (b[2] + b[3]));
                s += __shfl_xor(s, 16); s += __shfl_xor(s, 32);
                const float rs = __builtin_amdgcn_rsqf(s * (1.0f / D) + EPS);
#pragma unroll
                for (int bj = 0; bj < 2; ++bj)
#pragma unroll
                    for (int n = 0; n < 2; ++n) acc[ai][bj][m][n] *= rs;
                if (m & 1) __builtin_amdgcn_sched_barrier(0);
            }
        const f32x4 w0a = *(const f32x4*)(cw + f0), w0b = *(const f32x4*)(cw + f0 + 4);
        const f32x4 w1a = *(const f32x4*)(cw + DFF + f0), w1b = *(const f32x4*)(cw + DFF + f0 + 4);
        const f32x4 w2a = *(const f32x4*)(cw + 2 * DFF + f0), w2b = *(const f32x4*)(cw + 2 * DFF + f0 + 4);
        const f32x4 bba = *(const f32x4*)(cb + f0), bbb = *(const f32x4*)(cb + f0 + 4);
#pragma unroll
        for (int ai = 0; ai < 2; ++ai)
#pragma unroll
            for (int m = 0; m < 4; ++m) {
                const int j = 64 * ai + 16 * m + fr, r = gbase + j;
                const bool valid = (j >= 2) && (r < M);
                const f32x4 c0 = acc[ai][0][m][0], c1 = acc[ai][0][m][1];
                const int pai = (m == 0) ? (ai == 0 ? 0 : ai - 1) : ai, pm_ = (m == 0) ? (ai == 0 ? 0 : 3) : m - 1;
                const f32x4 q0 = acc[pai][0][pm_][0], q1 = acc[pai][0][pm_][1];
                f32x4 p1a, p1b, p2a, p2b;
#pragma unroll
                for (int e = 0; e < 4; ++e) {
                    p1a[e] = dppf<0x111>(dppf<0x121>(0.f, q0[e]), c0[e]); p1b[e] = dppf<0x111>(dppf<0x121>(0.f, q1[e]), c1[e]);
                    p2a[e] = dppf<0x112>(dppf<0x122>(0.f, q0[e]), c0[e]); p2b[e] = dppf<0x112>(dppf<0x122>(0.f, q1[e]), c1[e]);
                }
                int is_s, seq, t; row_decode(valid ? r : 0, is_s, seq, t);
                if (valid && t < 2) {
                    f32x4 s0a = (f32x4){0.f, 0.f, 0.f, 0.f}, s0b = s0a, s1a = s0a, s1b = s0a;
                    if (is_s) { const float* sp = st_fc + (size_t)seq * 2 * DFF + f0; s0a = *(const f32x4*)sp; s0b = *(const f32x4*)(sp + 4); s1a = *(const f32x4*)(sp + DFF); s1b = *(const f32x4*)(sp + DFF + 4); }
                    if (t == 0) { p1a = s1a; p1b = s1b; p2a = s0a; p2b = s0b; } else { p2a = s1a; p2b = s1b; }
                }
                const f32x4 ga = w0a * p2a + w1a * p1a + w2a * c0 + bba, gb = w0b * p2b + w1b * p1b + w2b * c1 + bbb;
                const f32x4 va = acc[ai][1][m][0], vb = acc[ai][1][m][1];
                if (valid) {
                    u32x4 w;
                    w.x = cvt_pk_bf16(gelu_tanh(ga[0]) * va[0], gelu_tanh(ga[1]) * va[1]); w.y = cvt_pk_bf16(gelu_tanh(ga[2]) * va[2], gelu_tanh(ga[3]) * va[3]);
                    w.z = cvt_pk_bf16(gelu_tanh(gb[0]) * vb[0], gelu_tanh(gb[1]) * vb[1]); w.w = cvt_pk_bf16(gelu_tanh(gb[2]) * vb[2], gelu_tanh(gb[3]) * vb[3]);
                    *(u32x4*)(hid + (size_t)r * DFF + f0) = w;
                    const int T = is_s ? TS : TP;
                    if (t >= T - 2) { float* so = out + (is_s ? O_SFC : O_PFC) + ((size_t)seq * 2 + (t - (T - 2))) * DFF + f0; *(f32x4*)so = c0; *(f32x4*)(so + 4) = c1; }
                }
                __builtin_amdgcn_sched_barrier(0);
            }
    }
};

__device__ __forceinline__ int invperm32(int q) { return 16 * ((q >> 2) & 1) + 4 * (q >> 3) + (q & 3); }
__device__ __forceinline__ void p0_transpose_item(const float* W, int K, int N, const float* kscale, bf16_t* WT, int mode, LAS float* scr, int item, int lane) {
    const int nblk = N / 32, kb = item / nblk, nb = item % nblk, k0 = 64 * kb, n0 = 32 * nb;
    float v[32];
    const float* src = W + (size_t)(k0 + (lane >> 5)) * N + n0 + (lane & 31);
#pragma unroll
    for (int i = 0; i < 32; ++i) v[i] = src[(size_t)(2 * i) * N];
#pragma unroll
    for (int i = 0; i < 32; ++i) scr[(2 * i + (lane >> 5)) * 33 + (lane & 31)] = v[i];
    asm volatile("s_waitcnt lgkmcnt(0)" ::: "memory");
    int rbase = n0;
    if (mode == 1) { const int bj = n0 >= DFF ? 1 : 0, f = n0 - bj * DFF; rbase = 256 * (f >> 7) + 128 * bj + (f & 96); }
    const int c = lane & 7;
    f32x4 ks0 = (f32x4){1.f, 1.f, 1.f, 1.f}, ks1 = ks0;
    if (kscale) { ks0 = *(const f32x4*)(kscale + k0 + 8 * c); ks1 = *(const f32x4*)(kscale + k0 + 8 * c + 4); }
#pragma unroll
    for (int j = 0; j < 4; ++j) { const int n = (lane >> 3) + 8 * j; const LAS float* sp = scr + (8 * c) * 33 + n;
        u32x4 o; o.x = cvt_pk_bf16(sp[0 * 33] * ks0[0], sp[1 * 33] * ks0[1]); o.y = cvt_pk_bf16(sp[2 * 33] * ks0[2], sp[3 * 33] * ks0[3]);
        o.z = cvt_pk_bf16(sp[4 * 33] * ks1[0], sp[5 * 33] * ks1[1]); o.w = cvt_pk_bf16(sp[6 * 33] * ks1[2], sp[7 * 33] * ks1[3]);
        *(u32x4*)(WT + (size_t)(rbase + (mode == 2 ? n : invperm32(n))) * K + k0 + 8 * c) = o; }
    asm volatile("s_waitcnt lgkmcnt(0)" ::: "memory");
}
__device__ __forceinline__ void phase0(const Params& p, LAS unsigned char* lds, int G) {
    const int tid = threadIdx.x, lane = tid & 63, wave = tid >> 6;
    unsigned char* ws = p.ws;
    LAS float* scr = (LAS float*)(lds + wave * 16384);
    const int gw = blockIdx.x * 8 + wave, NGW = G * 8;
    constexpr int I_IN = (D / 64) * (DIN / 32), I_O = (DMIX / 64) * (D / 32), I_UP = (D / 64) * (2 * DFF / 32), I_DN = (DFF / 64) * (D / 32), I_G = 2 * NH * 8;
    constexpr int NITEMS = I_IN + I_O + I_UP + I_DN + I_G;
    for (int it = gw; it < NITEMS; it += NGW) {
        int r = it;
        if (r < I_IN) { p0_transpose_item(p.w_in, D, DIN, p.g_mix, (bf16_t*)(ws + WS_WIN), 0, scr, r, lane); continue; } r -= I_IN;
        if (r < I_O) { p0_transpose_item(p.w_o, DMIX, D, nullptr, (bf16_t*)(ws + WS_WO), 0, scr, r, lane); continue; } r -= I_O;
        if (r < I_UP) { p0_transpose_item(p.w_up, D, 2 * DFF, p.g_ffn, (bf16_t*)(ws + WS_WUP), 1, scr, r, lane); continue; } r -= I_UP;
        if (r < I_DN) { p0_transpose_item(p.w_down, DFF, D, nullptr, (bf16_t*)(ws + WS_WDN), 0, scr, r, lane); continue; } r -= I_DN;
        { const int mat = r >> 3, sub = r & 7, gsel = mat / NH, n = mat % NH;
          p0_transpose_item((gsel ? p.w_gate_x : p.w_gate_a) + (size_t)n * 128 * 128, 128, 128, nullptr, (bf16_t*)(ws + WS_WG) + (size_t)mat * 128 * 128, 2, scr, sub, lane); }
    }
    { bf16_t* xb = (bf16_t*)(ws + WS_XB) + (size_t)16 * D; float* rstd1 = (float*)(ws + WS_RS1);
      for (int m = gw; m < M; m += NGW) {
          const f32x4* xr = (const f32x4*)x_row_ptr(p.x_prompt, p.x_sample, p.meta, m) + lane;
          f32x4 v[8]; float s = 0.f;
#pragma unroll
          for (int j = 0; j < 8; ++j) { v[j] = xr[64 * j]; s += (v[j][0] * v[j][0] + v[j][1] * v[j][1]) + (v[j][2] * v[j][2] + v[j][3] * v[j][3]); }
          s = wave_sum(s);
          if (lane == 0) rstd1[m] = __builtin_amdgcn_rsqf(s * (1.0f / D) + EPS);
          u32x2* o = (u32x2*)(xb + (size_t)m * D) + lane;
#pragma unroll
          for (int j = 0; j < 8; ++j) { u32x2 w; w.x = cvt_pk_bf16(v[j][0], v[j][1]); w.y = cvt_pk_bf16(v[j][2], v[j][3]); o[64 * j] = w; }
      } }
}

constexpr int XC_LD = 132, XB_LD = 136;
constexpr int L_XC = 0, L_XB = L_XC + 64 * XC_LD * 4, L_AA = L_XB + 64 * XB_LD * 2, L_UU = L_AA + 64 * XC_LD * 4, L_TOT = L_UU + 64 * XC_LD * 4, L_MIX_END = L_TOT + 4 * 128 * 2 * 4;
static_assert(L_MIX_END <= 131072, "mixer LDS");

__device__ __forceinline__ void branch_b(const Params& p, int G) {
    const bf16_t* z = (const bf16_t*)(p.ws + WS_Z); bf16_t* ym = (bf16_t*)(p.ws + WS_YM);
    const int total = M * 128;
    for (int idx = blockIdx.x * 512 + threadIdx.x; idx < total; idx += G * 512) {
        const int m = idx >> 7, g = idx & 127, ch = 8 * g;
        int is_s, seq, t; row_decode(m, is_s, seq, t);
        float u[3][8];
#pragma unroll
        for (int k = 0; k < 3; ++k) {
            const int tt = t - 2 + k;
            if (tt >= 0) {
                float a[8], b[8];
                unpack8(*(const u32x4*)(z + (size_t)(m - 2 + k) * DIN + 4096 + ch), a); unpack8(*(const u32x4*)(z + (size_t)(m - 2 + k) * DIN + 5120 + ch), b);
#pragma unroll
                for (int e = 0; e < 8; ++e) u[k][e] = a[e] * b[e];
            } else if (is_s) {
                const float* sp = p.st_sc + ((size_t)seq * 2 + (tt + 2)) * DB + ch; const f32x4 a = *(const f32x4*)sp, b = *(const f32x4*)(sp + 4);
#pragma unroll
                for (int e = 0; e < 4; ++e) { u[k][e] = a[e]; u[k][4 + e] = b[e]; }
            } else {
#pragma unroll
                for (int e = 0; e < 8; ++e) u[k][e] = 0.f;
            }
        }
        float gb[8]; unpack8(*(const u32x4*)(z + (size_t)m * DIN + 3072 + ch), gb);
        float y[8]; float ss = 0.f;
#pragma unroll
        for (int e = 0; e < 8; ++e) {
            const float uc = p.conv_b_w[ch + e] * u[0][e] + p.conv_b_w[DB + ch + e] * u[1][e] + p.conv_b_w[2 * DB + ch + e] * u[2][e];
            y[e] = gb[e] * uc; ss += y[e] * y[e];
        }
        ss = sum16(ss);
        const float rn = __builtin_amdgcn_rsqf(ss * (1.0f / 128.0f) + EPS);
#pragma unroll
        for (int e = 0; e < 8; ++e) y[e] = y[e] * rn * p.g_out_b[ch + e];
        *(u32x4*)(ym + (size_t)m * DMIX + DA + ch) = pack8(y);
        const int T = is_s ? TS : TP;
        if (t >= T - 2) { float* so = p.out + (is_s ? O_SSC : O_PSC) + ((size_t)seq * 2 + (t - (T - 2))) * DB + ch;
            *(f32x4*)so = (f32x4){u[2][0], u[2][1], u[2][2], u[2][3]}; *(f32x4*)(so + 4) = (f32x4){u[2][4], u[2][5], u[2][6], u[2][7]}; }
    }
}

template <int PASS>
__device__ __forceinline__ void lru_item(const Params& p, LAS unsigned char* lds, int is_s, int seq0, int chunk, int n) {
    const int tid = threadIdx.x, lane = tid & 63, wave = __builtin_amdgcn_readfirstlane(tid >> 6);
    const bf16_t* z = (const bf16_t*)(p.ws + WS_Z);
    LAS float* XC = (LAS float*)(lds + L_XC); LAS bf16_t* XBF = (LAS bf16_t*)(lds + L_XB); LAS float* AA = (LAS float*)(lds + L_AA); LAS float* UU = (LAS float*)(lds + L_UU); LAS float* TOT = (LAS float*)(lds + L_TOT);
    const int t0 = is_s ? 0 : chunk * CH;
    const int m0 = is_s ? MPR + seq0 * TS : seq0 * TP + t0;
    const int nrows = is_s ? 64 : (TP - t0 < CH ? TP - t0 : CH);
    {
        const int grp = tid & 15, ch = n * 128 + 8 * grp;
        float w[4][8], bias[8];
#pragma unroll
        for (int k = 0; k < 4; ++k) { const f32x4 a = *(const f32x4*)(p.conv_a_w + k * DA + ch), b = *(const f32x4*)(p.conv_a_w + k * DA + ch + 4);
#pragma unroll
            for (int e = 0; e < 4; ++e) { w[k][e] = a[e]; w[k][4 + e] = b[e]; } }
        { const f32x4 a = *(const f32x4*)(p.conv_a_b + ch), b = *(const f32x4*)(p.conv_a_b + ch + 4);
#pragma unroll
            for (int e = 0; e < 4; ++e) { bias[e] = a[e]; bias[4 + e] = b[e]; } }
#pragma unroll
        for (int it = 0; it < 2; ++it) {
            const int row = (tid >> 4) + 32 * it;
            const int rr = row < nrows ? row : nrows - 1;
            const int m = m0 + rr;
            const int t = is_s ? (rr & 7) : t0 + rr;
            const int sq = is_s ? seq0 + (rr >> 3) : seq0;
            float accv[8];
#pragma unroll
            for (int e = 0; e < 8; ++e) accv[e] = bias[e];
#pragma unroll
            for (int k = 0; k < 4; ++k) {
                const int tt = t - 3 + k;
                float xv[8];
                if (tt >= 0) unpack8(*(const u32x4*)(z + (size_t)(m - 3 + k) * DIN + ch), xv);
                else if (is_s) { const float* sp = p.st_rc + ((size_t)sq * 3 + (tt + 3)) * DA + ch; const f32x4 a = *(const f32x4*)sp, b = *(const f32x4*)(sp + 4);
#pragma unroll
                    for (int e = 0; e < 4; ++e) { xv[e] = a[e]; xv[4 + e] = b[e]; } }
                else {
#pragma unroll
                    for (int e = 0; e < 8; ++e) xv[e] = 0.f; }
#pragma unroll
                for (int e = 0; e < 8; ++e) accv[e] += w[k][e] * xv[e];
            }
            *(LAS f32x4*)(XC + row * XC_LD + 8 * grp) = (f32x4){accv[0], accv[1], accv[2], accv[3]};
            *(LAS f32x4*)(XC + row * XC_LD + 8 * grp + 4) = (f32x4){accv[4], accv[5], accv[6], accv[7]};
            *(LAS u32x4*)(XBF + row * XB_LD + 8 * grp) = pack8(accv);
        }
    }
    __syncthreads();
    {
        const int rb = wave & 3, chh = wave >> 2, fr = lane & 15, fq = lane >> 4;
        const bf16_t* wga = (const bf16_t*)(p.ws + WS_WG) + (size_t)n * 128 * 128;
        const bf16_t* wgx = wga + (size_t)NH * 128 * 128;
        f32x4 ca[4], cx[4];
#pragma unroll
        for (int nb = 0; nb < 4; ++nb) { ca[nb] = (f32x4){0.f, 0.f, 0.f, 0.f}; cx[nb] = (f32x4){0.f, 0.f, 0.f, 0.f}; }
#pragma unroll
        for (int ks = 0; ks < 4; ++ks) {
            const bf16x8 af = *(const LAS bf16x8*)(XBF + (16 * rb + fr) * XB_LD + 32 * ks + 8 * fq);
#pragma unroll
            for (int nb = 0; nb < 4; ++nb) {
                const size_t bo = (size_t)(64 * chh + 16 * nb + fr) * 128 + 32 * ks + 8 * fq;
                const bf16x8 ba = *(const bf16x8*)(wga + bo), bx = *(const bf16x8*)(wgx + bo);
                ca[nb] = __builtin_amdgcn_mfma_f32_16x16x32_bf16(af, ba, ca[nb], 0, 0, 0);
                cx[nb] = __builtin_amdgcn_mfma_f32_16x16x32_bf16(af, bx, cx[nb], 0, 0, 0);
            }
        }
#pragma unroll
        for (int nb = 0; nb < 4; ++nb) {
            const int j = 64 * chh + 16 * nb + fr, chn = n * 128 + j;
            const float bga = p.b_gate_a[chn], bgx = p.b_gate_x[chn];
            const float sp = log1pf(__expf(-p.lam[chn]));
#pragma unroll
            for (int rg = 0; rg < 4; ++rg) {
                const int row = 16 * rb + 4 * fq + rg;
                const float r = sigmoidf_(ca[nb][rg] + bga), ig = sigmoidf_(cx[nb][rg] + bgx);
                const float la = -8.0f * r * sp;
                const float a = __expf(la);
                const float x2 = 2.0f * la;
                const float em1 = x2 > -0.1f ? x2 * (1.0f + 0.5f * x2 * (1.0f + (1.0f / 3.0f) * x2 * (1.0f + 0.25f * x2 * (1.0f + 0.2f * x2)))) : (a * a - 1.0f);
                const float uu = sqrtf(-em1) * (ig * XC[row * XC_LD + j]);
                AA[row * XC_LD + j] = a; UU[row * XC_LD + j] = uu;
            }
        }
    }
    __syncthreads();
    {
        const int j = tid & 127, seg = tid >> 7, chn = n * 128 + j;
        if (is_s) {
            if (PASS == 2) {
#pragma unroll
                for (int q = 0; q < 2; ++q) {
                    const int sq = seq0 + 2 * seg + q;
                    float h = p.st_h[(size_t)sq * DA + chn];
#pragma unroll
                    for (int i = 0; i < 8; ++i) { const int row = 16 * seg + 8 * q + i; h = AA[row * XC_LD + j] * h + UU[row * XC_LD + j]; UU[row * XC_LD + j] = h; }
                    p.out[O_SH + (size_t)sq * DA + chn] = h;
                }
            }
        } else {
            float P = 1.f, S = 0.f;
#pragma unroll
            for (int i = 0; i < 16; ++i) { const int row = 16 * seg + i; const float a = AA[row * XC_LD + j], u = UU[row * XC_LD + j]; S = a * S + u; P = P * a; UU[row * XC_LD + j] = S; AA[row * XC_LD + j] = P; }
            TOT[(seg * 128 + j) * 2] = P; TOT[(seg * 128 + j) * 2 + 1] = S;
            __syncthreads();
            float* tot = (float*)(p.ws + WS_TOT);
            if (PASS == 1) {
                if (seg == 0) { float Pt = 1.f, St = 0.f;
#pragma unroll
                    for (int s2 = 0; s2 < 4; ++s2) { const float Ps = TOT[(s2 * 128 + j) * 2], Ss = TOT[(s2 * 128 + j) * 2 + 1]; St = Ps * St + Ss; Pt = Pt * Ps; }
                    float* o = tot + (((size_t)seq0 * NCH + chunk) * DA + chn) * 2; o[0] = Pt; o[1] = St; }
            } else {
                float h = 0.f;
                for (int c2 = 0; c2 < chunk; ++c2) { const float* o = tot + (((size_t)seq0 * NCH + c2) * DA + chn) * 2; h = o[0] * h + o[1]; }
                for (int s2 = 0; s2 < seg; ++s2) h = TOT[(s2 * 128 + j) * 2] * h + TOT[(s2 * 128 + j) * 2 + 1];
#pragma unroll
                for (int i = 0; i < 16; ++i) { const int row = 16 * seg + i; const float hf = UU[row * XC_LD + j] + AA[row * XC_LD + j] * h; UU[row * XC_LD + j] = hf;
                    if (t0 + row == TP - 1) p.out[O_PH + (size_t)seq0 * DA + chn] = hf; }
            }
        }
    }
    __syncthreads();
    if (PASS == 2) {
        bf16_t* ym = (bf16_t*)(p.ws + WS_YM);
        const int grp = tid & 15, ch = n * 128 + 8 * grp;
        float go[8];
        { const f32x4 a = *(const f32x4*)(p.g_out_a + ch), b = *(const f32x4*)(p.g_out_a + ch + 4);
#pragma unroll
            for (int e = 0; e < 4; ++e) { go[e] = a[e]; go[4 + e] = b[e]; } }
#pragma unroll
        for (int it = 0; it < 2; ++it) {
            const int row = (tid >> 4) + 32 * it;
            const int rr = row < nrows ? row : nrows - 1;
            const int m = m0 + rr;
            float gav[8]; unpack8(*(const u32x4*)(z + (size_t)m * DIN + DA + ch), gav);
            const f32x4 h0 = *(const LAS f32x4*)(UU + rr * XC_LD + 8 * grp), h1 = *(const LAS f32x4*)(UU + rr * XC_LD + 8 * grp + 4);
            float y[8]; float ss = 0.f;
#pragma unroll
            for (int e = 0; e < 8; ++e) { y[e] = gelu_tanh(gav[e]) * (e < 4 ? h0[e] : h1[e - 4]); ss += y[e] * y[e]; }
            ss = sum16(ss);
            const float rn = __builtin_amdgcn_rsqf(ss * (1.0f / 128.0f) + EPS);
#pragma unroll
            for (int e = 0; e < 8; ++e) y[e] = y[e] * rn * go[e];
            if (row < nrows) *(u32x4*)(ym + (size_t)m * DMIX + ch) = pack8(y);
        }
    }
    __syncthreads();
}
template <int PASS>
__device__ __forceinline__ void mixer_phase(const Params& p, LAS unsigned char* lds, int G) {
    constexpr int NPI = NB * NCH * NH;
    constexpr int NSI = (NS / 8) * NH;
    const int nitems = PASS == 1 ? NPI : NPI + NSI;
    for (int it = blockIdx.x; it < nitems; it += G) {
        if (it < NPI) { const int n = it % NH, q = it / NH, c = q % NCH, b = q / NCH; lru_item<PASS>(p, lds, 0, b, c, n); }
        else { const int i2 = it - NPI, n = i2 % NH, sb = i2 / NH; lru_item<PASS>(p, lds, 1, sb * 8, 0, n); }
    }
    if (PASS == 1) branch_b(p, G);
}

__device__ __forceinline__ void final_phase(const Params& p, int G) {
    const int lane = threadIdx.x & 63, gw = blockIdx.x * 8 + (threadIdx.x >> 6), NGW = G * 8;
    f32x4 gf[8];
#pragma unroll
    for (int j = 0; j < 8; ++j) gf[j] = ((const f32x4*)p.g_final)[lane + 64 * j];
    for (int r = gw; r < NB * SEQ + MSR; r += NGW) {
        f32x4* yr = (f32x4*)(p.out + (size_t)r * D) + lane;
        f32x4 v[8]; float s = 0.f;
#pragma unroll
        for (int j = 0; j < 8; ++j) { v[j] = yr[64 * j]; s += (v[j][0] * v[j][0] + v[j][1] * v[j][1]) + (v[j][2] * v[j][2] + v[j][3] * v[j][3]); }
        s = wave_sum(s);
        const float rs = __builtin_amdgcn_rsqf(s * (1.0f / D) + EPS);
#pragma unroll
        for (int j = 0; j < 8; ++j) yr[64 * j] = v[j] * rs * gf[j];
    }
}


#define XB_TMO      128
#define XB_XCNT(j)  (256  + 64 * (j))
#define XB_XSUB(j)  (1280 + 64 * (j))
#define XB_XGEN(j)  (2304 + 64 * (j))
#define XB_TOP      3328
#define XB_TOPGEN   3392
#define XCD_BAR_WORDS 3456
#define XB_SPIN_CAP (1u << 18)
__device__ __forceinline__ unsigned xb_ld(unsigned* p)              { return __hip_atomic_load(p, __ATOMIC_RELAXED, __HIP_MEMORY_SCOPE_AGENT); }
__device__ __forceinline__ unsigned xb_add(unsigned* p, unsigned v) { return __hip_atomic_fetch_add(p, v, __ATOMIC_RELAXED, __HIP_MEMORY_SCOPE_AGENT); }
__device__ __forceinline__ unsigned xb_xcc_id() { return (unsigned)__builtin_amdgcn_s_getreg((3 << 11) | 20) & 0xFu; }
#define XB_SPIN(cond, bar) do { unsigned _sp = 0; while (cond) { __builtin_amdgcn_s_sleep(1); \
    if ((++_sp & 255u) == 0u) { if (xb_ld(&(bar)[XB_TMO])) break; if (_sp > XB_SPIN_CAP) { atomicAdd(&(bar)[XB_TMO], 1u); break; } } } } while (0)
struct XcdBarrier { unsigned* bar; unsigned x; volatile LAS unsigned* st; };
__device__ __forceinline__ XcdBarrier xcd_barrier_post(unsigned* bar, volatile LAS unsigned* st) {
    XcdBarrier b; b.bar = bar; b.x = xb_xcc_id(); b.st = st;
    if (threadIdx.x == 0) (void)xb_add(&bar[XB_XCNT(b.x)], 1u);
    return b;
}
__device__ __forceinline__ void xcd_barrier_complete(unsigned* bar, unsigned x, unsigned& nloc, unsigned& nx) {
    const unsigned G = gridDim.x * gridDim.y * gridDim.z;
    unsigned sum, cnt, mine, sp = 0u;
    for (;;) {
        sum = 0u; cnt = 0u; mine = 0u;
#pragma unroll
        for (unsigned j = 0; j < 16; ++j) { const unsigned c = xb_ld(&bar[XB_XCNT(j)]); sum += c; cnt += (c > 0u) ? 1u : 0u; mine = (j == x) ? c : mine; }
        if (sum == G) break;
        __builtin_amdgcn_s_sleep(1);
        if ((++sp & 255u) == 0u) { if (xb_ld(&bar[XB_TMO])) break; if (sp > XB_SPIN_CAP) { atomicAdd(&bar[XB_TMO], 1u); break; } }
    }
    nloc = mine > 0u ? mine : 1u; nx = cnt > 0u ? cnt : 1u;
}
__device__ __forceinline__ void xcd_barrier(const XcdBarrier& b) {
    asm volatile("s_waitcnt vmcnt(0)" ::: "memory");
    __syncthreads();
    if (threadIdx.x == 0) {
        unsigned* bar = b.bar;
        __builtin_amdgcn_s_waitcnt(0);
        unsigned nloc = b.st[0], nx = b.st[1];
        if (nloc == 0u) { xcd_barrier_complete(bar, b.x, nloc, nx); b.st[0] = nloc; b.st[1] = nx; }
        const unsigned old = xb_add(&bar[XB_XSUB(b.x)], 1u);
        const unsigned gen = old / nloc;
        if (old + 1u == (gen + 1u) * nloc) {
            __builtin_amdgcn_fence(__ATOMIC_RELEASE, "agent");
            asm volatile("s_waitcnt vmcnt(0)" ::: "memory");
            const unsigned og = xb_add(&bar[XB_TOP], 1u);
            const unsigned tg = og / nx;
            if (og + 1u == (tg + 1u) * nx) xb_add(&bar[XB_TOPGEN], 1u);
            else XB_SPIN(xb_ld(&bar[XB_TOPGEN]) == tg, bar);
            __builtin_amdgcn_fence(__ATOMIC_ACQUIRE, "agent");
            xb_add(&bar[XB_XGEN(b.x)], 1u);
            asm volatile("s_waitcnt vmcnt(0)" ::: "memory");
        } else {
            XB_SPIN(xb_ld(&bar[XB_XGEN(b.x)]) == gen, bar);
            __builtin_amdgcn_fence(__ATOMIC_ACQUIRE, "agent");
            asm volatile("s_waitcnt vmcnt(0)" ::: "memory");
        }
    }
    __syncthreads();
}

constexpr int LDS_BYTES = 132096;
constexpr int N_PHASES = 8;
__global__ void __launch_bounds__(512, 2) hymba_fwd(Params p) {
    extern __shared__ __attribute__((aligned(16))) unsigned char lds_raw[];
    LAS unsigned char* lds = (LAS unsigned char*)lds_raw;
    const int G = gridDim.x;
    unsigned char* ws = p.ws;
    volatile LAS unsigned* misc = (volatile LAS unsigned*)(lds + 131072);
    if (threadIdx.x < 8) misc[threadIdx.x] = 0u;
    __syncthreads();
    XcdBarrier bar = xcd_barrier_post((unsigned*)ws, misc);
    const int lo = p.ph_lo, hi = p.ph_hi;
#ifndef PH_MASK
#define PH_MASK 0xff
#endif
#define IN(k) (((PH_MASK >> (k)) & 1) && lo <= (k) && (k) < hi)
#define SEAM(k) do { if (IN(k) && IN((k) + 1)) xcd_barrier(bar); } while (0)
#ifndef REP_MASK
#define REP_MASK 0x00
#endif
#define REPEAT(k) for (int rep_ = 0; rep_ < ((((REP_MASK) >> (k)) & 1) ? 2 : 1); ++rep_, (rep_ < ((((REP_MASK) >> (k)) & 1) ? 2 : 1) ? xcd_barrier(bar) : (void)0))
    if (IN(0)) REPEAT(0) phase0(p, lds, G);
    SEAM(0);
    if (IN(1)) REPEAT(1) {
        pg8::Gemm g{(const bf16_t*)(ws + WS_XB) + (size_t)16 * D, (const bf16_t*)(ws + WS_WIN), MP / 256, DIN / 256, D, (size_t)256 * D * 2, (size_t)128 * D * 2};
        pg8::StaticOrder S; S.init(g.nM, g.nN, G, (int)blockIdx.x);
        EpiZ E{(const float*)(ws + WS_RS1), (bf16_t*)(ws + WS_Z), p.out};
        pg8::gemm_phase<EpiZ, false, true, true>(lds, g, S, E);
    }
    SEAM(1);
    if (IN(2)) REPEAT(2) mixer_phase<1>(p, lds, G);
    SEAM(2);
    if (IN(3)) REPEAT(3) mixer_phase<2>(p, lds, G);
    SEAM(3);
    if (IN(4)) REPEAT(4) {
        pg8::Gemm g{(const bf16_t*)(ws + WS_YM), (const bf16_t*)(ws + WS_WO), MP / 256, D / 256, DMIX, (size_t)256 * DMIX * 2, (size_t)128 * DMIX * 2};
        pg8::StaticOrder S; S.init(g.nM, g.nN, G, (int)blockIdx.x);
        EpiX1 E{p.x_prompt, p.x_sample, p.meta, p.out, (bf16_t*)(ws + WS_XB) + (size_t)16 * D, (float*)(ws + WS_SSQ)};
        pg8::gemm_phase<EpiX1, false, true, true>(lds, g, S, E);
    }
    SEAM(4);
    if (IN(5)) REPEAT(5) {
        pg8::Gemm g{(const bf16_t*)(ws + WS_XB) + (size_t)14 * D, (const bf16_t*)(ws + WS_WUP), 37, 2 * DFF / 256, D, (size_t)252 * D * 2, (size_t)64 * D * 2};
        pg8::StaticOrder S; S.init(g.nM, g.nN, G, (int)blockIdx.x);
        EpiFFN E{(const float*)(ws + WS_SSQ), p.conv_f_w, p.conv_f_b, p.st_fc, (bf16_t*)(ws + WS_Z), p.out};
        pg8::gemm_phase<EpiFFN, true, true, true>(lds, g, S, E);
    }
    SEAM(5);
    if (IN(6)) {
        pg8::Gemm g{(const bf16_t*)(ws + WS_Z), (const bf16_t*)(ws + WS_WDN), MP / 256, D / 256, DFF, (size_t)256 * DFF * 2, (size_t)128 * DFF * 2};
        pg8::StaticOrder S; S.init(g.nM, g.nN, G, (int)blockIdx.x);
        EpiOut E{p.out};
        pg8::gemm_phase<EpiOut, false, true, true>(lds, g, S, E);
    }
    SEAM(6);
    if (IN(7)) final_phase(p, G);
#undef IN
#undef SEAM
}

extern "C" void kernel_launch(void* const* d_in, const int* in_sizes, int n_in, void* d_out, int out_size, void* d_ws, size_t ws_size, hipStream_t stream) {
    static int grid = 0;
    if (grid == 0) {
        if (n_in != 26 || (size_t)out_size != O_END || ws_size < WS_END) { fprintf(stderr, "kernel_launch: unexpected problem (n_in %d, out %d, ws %zu; need ws >= %zu)\n", n_in, out_size, ws_size, (size_t)WS_END); grid = -1; return; }
        int dev = 0, cus = 0, per_cu = 0;
        hipGetDevice(&dev); hipDeviceGetAttribute(&cus, hipDeviceAttributeMultiprocessorCount, dev);
        if (hipFuncSetAttribute((const void*)hymba_fwd, hipFuncAttributeMaxDynamicSharedMemorySize, LDS_BYTES) != hipSuccess) { fprintf(stderr, "kernel_launch: hipFuncSetAttribute failed\n"); grid = -1; return; }
        if (hipOccupancyMaxActiveBlocksPerMultiprocessor(&per_cu, (const void*)hymba_fwd, 512, LDS_BYTES) != hipSuccess || per_cu < 1) { fprintf(stderr, "kernel_launch: occupancy query says %d\n", per_cu); grid = -1; return; }
        grid = cus;
    }
    if (grid < 0) return;
    Params p{};
    const float** f = (const float**)&p;
    for (int i = 0; i < 26; ++i) f[i] = (const float*)d_in[i];
    p.out = (float*)d_out; p.ws = (unsigned char*)d_ws;
    if (hipMemsetAsync(d_ws, 0, XCD_BAR_WORDS * 4, stream) != hipSuccess) { fprintf(stderr, "kernel_launch: memset failed\n"); return; }
    if (MK_N_LAUNCHES == 1) {
        p.ph_lo = 0; p.ph_hi = N_PHASES;
        hipLaunchKernelGGL(hymba_fwd, dim3(grid), dim3(512), LDS_BYTES, stream, p);
    } else {
        for (int k = 0; k < N_PHASES; ++k) { p.ph_lo = k; p.ph_hi = k + 1; hipLaunchKernelGGL(hymba_fwd, dim3(grid), dim3(512), LDS_BYTES, stream, p); }
    }
}
```

```cpp
#include <hip/hip_runtime.h>
#include <cstdio>

#ifndef MK_N_LAUNCHES
#define MK_N_LAUNCHES 1
#endif

#define LAS __attribute__((address_space(3)))
typedef unsigned short bf16_t;
typedef short bf16x8 __attribute__((ext_vector_type(8)));
typedef float f32x4 __attribute__((ext_vector_type(4)));
typedef unsigned u32x4 __attribute__((ext_vector_type(4)));
typedef unsigned u32x2 __attribute__((ext_vector_type(2)));

constexpr int D = 2048, NMETA = 16, SEQ = 2048, TP = SEQ + NMETA, NB = 4, MPR = NB * TP;
constexpr int NS = 128, TS = 8, MSR = NS * TS, M = MPR + MSR;
constexpr int MP = 9472;
constexpr int DA = 1536, DB = 1024, DIN = 6144, DMIX = 2560, DFF = 6144, NH = 12;
constexpr float EPS = 1e-6f;
constexpr int NCH = 33;
constexpr size_t O_YP = 0, O_YS = O_YP + (size_t)NB * SEQ * D, O_PH = O_YS + (size_t)MSR * D, O_PRC = O_PH + NB * DA,
                 O_PSC = O_PRC + NB * 3 * DA, O_PFC = O_PSC + NB * 2 * DB, O_SH = O_PFC + NB * 2 * DFF, O_SRC = O_SH + NS * DA,
                 O_SSC = O_SRC + (size_t)NS * 3 * DA, O_SFC = O_SSC + (size_t)NS * 2 * DB, O_END = O_SFC + (size_t)NS * 2 * DFF;
constexpr size_t MiB = 1u << 20;
constexpr size_t WS_WIN = 1 * MiB;
constexpr size_t WS_WO = WS_WIN + (size_t)DIN * D * 2;
constexpr size_t WS_WUP = WS_WO + (size_t)D * DMIX * 2;
constexpr size_t WS_WDN = WS_WUP + (size_t)2 * DFF * D * 2;
constexpr size_t WS_WG = WS_WDN + (size_t)D * DFF * 2;
constexpr size_t WS_XB = WS_WG + (size_t)2 * NH * 128 * 128 * 2;
constexpr size_t XB_ROWS = 9600;
constexpr size_t WS_Z = WS_XB + XB_ROWS * D * 2;
constexpr size_t WS_YM = WS_Z + (size_t)MP * DIN * 2;
constexpr size_t WS_RS1 = WS_YM + (size_t)MP * DMIX * 2;
constexpr size_t WS_SSQ = WS_RS1 + (size_t)MP * 4;
constexpr size_t WS_TOT = WS_SSQ + (size_t)MP * 32 * 4;
constexpr size_t WS_END = WS_TOT + (size_t)NB * NCH * DA * 2 * 4;

struct Params {
    const float *x_prompt, *x_sample, *st_h, *st_rc, *st_sc, *st_fc, *meta, *g_mix, *w_in, *conv_a_w, *conv_a_b, *w_gate_a, *b_gate_a,
        *w_gate_x, *b_gate_x, *lam, *conv_b_w, *g_out_a, *g_out_b, *w_o, *g_ffn, *w_up, *conv_f_w, *conv_f_b, *w_down, *g_final;
    float* out; unsigned char* ws; int ph_lo, ph_hi;
};

__device__ __forceinline__ unsigned cvt_pk_bf16(float lo, float hi) { unsigned r; asm volatile("v_cvt_pk_bf16_f32 %0, %1, %2" : "=v"(r) : "v"(lo), "v"(hi)); return r; }
__device__ __forceinline__ float bf_lo(unsigned w) { return __builtin_bit_cast(float, w << 16); }
__device__ __forceinline__ float bf_hi(unsigned w) { return __builtin_bit_cast(float, w & 0xffff0000u); }
__device__ __forceinline__ void unpack8(const u32x4 w, float (&f)[8]) { f[0] = bf_lo(w.x); f[1] = bf_hi(w.x); f[2] = bf_lo(w.y); f[3] = bf_hi(w.y); f[4] = bf_lo(w.z); f[5] = bf_hi(w.z); f[6] = bf_lo(w.w); f[7] = bf_hi(w.w); }
__device__ __forceinline__ u32x4 pack8(const float (&f)[8]) { u32x4 w; w.x = cvt_pk_bf16(f[0], f[1]); w.y = cvt_pk_bf16(f[2], f[3]); w.z = cvt_pk_bf16(f[4], f[5]); w.w = cvt_pk_bf16(f[6], f[7]); return w; }
__device__ __forceinline__ float wave_sum(float v) {
#pragma unroll
    for (int o = 1; o < 64; o <<= 1) v += __shfl_xor(v, o);
    return v;
}
__device__ __forceinline__ float sum16(float v) {
    v += __shfl_xor(v, 1); v += __shfl_xor(v, 2); v += __shfl_xor(v, 4); v += __shfl_xor(v, 8); return v;
}
__device__ __forceinline__ float sigmoidf_(float x) { return __builtin_amdgcn_rcpf(1.0f + __expf(-x)); }
__device__ __forceinline__ float gelu_tanh(float x) {
    const float t = x * (1.0f + 0.044715f * x * x) * (-2.0f * 0.7978845608028654f * 1.4426950408889634f);
    return x * __builtin_amdgcn_rcpf(1.0f + __builtin_amdgcn_exp2f(t));
}
template <int CTRL> __device__ __forceinline__ float dppf(float old, float src) {
    return __builtin_bit_cast(float, __builtin_amdgcn_update_dpp(__builtin_bit_cast(int, old), __builtin_bit_cast(int, src), CTRL, 0xF, 0xF, false));
}
__device__ __forceinline__ void row_decode(int r, int& is_s, int& seq, int& t) {
    if (r < MPR) { seq = (r >= TP) + (r >= 2 * TP) + (r >= 3 * TP); t = r - seq * TP; is_s = 0; }
    else { const int q = r - MPR; seq = q >> 3; t = q & 7; is_s = 1; }
}
__device__ __forceinline__ const float* x_row_ptr(const float* xp, const float* xs, const float* meta, int r) {
    int is_s, seq, t; row_decode(r, is_s, seq, t);
    if (is_s) return xs + (size_t)(r - MPR) * D;
    return t < NMETA ? meta + (size_t)t * D : xp + ((size_t)seq * SEQ + (t - NMETA)) * D;
}
__device__ __forceinline__ float* y_row_ptr(float* out, int r) {
    if (r >= M) return nullptr;
    int is_s, seq, t; row_decode(r, is_s, seq, t);
    if (is_s) return out + O_YS + (size_t)(r - MPR) * D;
    return t < NMETA ? nullptr : out + O_YP + ((size_t)seq * SEQ + (t - NMETA)) * D;
}

namespace pg8 {
constexpr int BM = 256, BK = 64, HALF = 128, HTB = HALF * BK * 2, STAGE_BYTES = 8 * HTB, NXCD = 8, WGM = 8;
__host__ __device__ __forceinline__ int lds_byte(int r, int c) { const int st = (r >> 4) * 2 + (c >> 5), rr = r & 15, cc = c & 31, ob = rr * 64 + cc * 2; return st * 1024 + (ob ^ (((ob >> 9) & 1) << 5)); }
__host__ __device__ __forceinline__ void stage_rc(int b, int& R, int& C) { const int st = b / 1024, sb = b % 1024, swz = sb ^ (((sb >> 9) & 1) << 5); R = (st >> 1) * 16 + swz / 64; C = (st & 1) * 32 + (swz % 64) / 2; }
struct Unit { int pm, pn; };
struct Gemm { const bf16_t* A; const bf16_t* Bt; int nM, nN, K; size_t a_tstep, a_hstep; };
struct StaticOrder {
    int nM, nN, nwg, G, c;
    __device__ void init(int nM_, int nN_, int G_, int c_) { nM = nM_; nN = nN_; nwg = nM * nN; G = G_; c = c_; }
    __device__ bool next(int i, Unit& u) const {
        const long L = (long)i * G + c; if (L >= nwg) return false;
        int wgid = (int)L; { const int q = nwg / NXCD, r = nwg % NXCD, xcd = wgid % NXCD, off = wgid / NXCD; wgid = (xcd < r ? xcd * (q + 1) : r * (q + 1) + (xcd - r) * q) + off; }
        const int nig = WGM * nN, gid = wgid / nig, fm = gid * WGM, gsz = (nM - fm) < WGM ? (nM - fm) : WGM;
        u.pm = fm + ((wgid % nig) % gsz); u.pn = (wgid % nig) / gsz; return true;
    }
};

template <class Epi, bool FFNMAP, bool ALIGN_EPI, bool SP2>
__device__ __forceinline__ void gemm_phase(LAS unsigned char* lds, const Gemm g, const StaticOrder& S, const Epi& E) {
    int tid = threadIdx.x; asm volatile("" : "+v"(tid));
    const int wid = __builtin_amdgcn_readfirstlane(tid >> 6), lane = tid & 63, wr = wid >> 2, wc = wid & 3, fr = lane & 15, fq = lane >> 4;
    const int K = g.K, nt = K / BK;
    unsigned voffA[2], voffB[2];
#pragma unroll
    for (int i = 0; i < 2; ++i) { int R, C; stage_rc(tid * 16 + i * 8192, R, C); const int Ra = FFNMAP ? (126 * (R >> 6) + (R & 63)) : R;
        voffA[i] = (unsigned)(Ra * K + C) * 2u; voffB[i] = (unsigned)(R * K + C) * 2u; }
    const size_t kstep = (size_t)(BK * 2);
    const size_t hstepA = g.a_hstep, tstepA = g.a_tstep;
    const size_t hstepB = (size_t)HALF * K * 2, tstepB = 2 * hstepB;
    const unsigned ldsw = (unsigned)wid * 1024u;
    const int aoff = lds_byte(wr * 64 + fr, fq * 8), boff = lds_byte(wc * 32 + fr, fq * 8);
#define PG8_SA(b, h) (((b) * 2 + (h)) * HTB)
#define PG8_SB(b, h) ((4 + (b) * 2 + (h)) * HTB)
#define PG8_STAGE(bufoff, gbase, voff) do { _Pragma("unroll") for (int _i = 0; _i < 2; ++_i) \
        __builtin_amdgcn_global_load_lds((const unsigned*)((const char*)(gbase) + (voff)[_i]), (LAS unsigned*)(lds + (bufoff) + ldsw + _i * 8192), 16, 0, 0); } while (0)
#define PG8_LDA(dst, b, h) do { _Pragma("unroll") for (int m = 0; m < 4; ++m) _Pragma("unroll") for (int k = 0; k < 2; ++k) dst[m][k] = *(const LAS bf16x8*)(lds + PG8_SA(b, h) + aoff + m * 2048 + k * 1024); } while (0)
#define PG8_LDB(dst, b, h) do { _Pragma("unroll") for (int n = 0; n < 2; ++n) _Pragma("unroll") for (int k = 0; k < 2; ++k) dst[n][k] = *(const LAS bf16x8*)(lds + PG8_SB(b, h) + boff + n * 2048 + k * 1024); } while (0)
#define PG8_MMA(ai, bj, At, Bt) do { __builtin_amdgcn_s_setprio(1); _Pragma("unroll") for (int m = 0; m < 4; ++m) _Pragma("unroll") for (int n = 0; n < 2; ++n) _Pragma("unroll") for (int k = 0; k < 2; ++k) \
        acc[ai][bj][m][n] = __builtin_amdgcn_mfma_f32_16x16x32_bf16(Bt[n][k], At[m][k], acc[ai][bj][m][n], 0, 0, 0); __builtin_amdgcn_s_setprio(0); } while (0)
#define PG8_WAIT_V(n) asm volatile("s_waitcnt vmcnt(" #n ")" ::: "memory")
#define PG8_WAIT_L(n) asm volatile("s_waitcnt lgkmcnt(" #n ")" ::: "memory")
#define PG8_BAR __builtin_amdgcn_s_barrier()
#define PG8_SCHED __builtin_amdgcn_sched_barrier(0)
    Unit cur, nxt; int ui = 0;
    if (!S.next(0, cur)) return;
    f32x4 acc[2][2][4][2];
#pragma unroll
    for (int a = 0; a < 2; ++a)
#pragma unroll
        for (int b = 0; b < 2; ++b)
#pragma unroll
            for (int m = 0; m < 4; ++m)
#pragma unroll
                for (int n = 0; n < 2; ++n) acc[a][b][m][n] = (f32x4){0.f, 0.f, 0.f, 0.f};
    bf16x8 At[4][2], B0[2][2], B1[2][2];
    const char* cA = (const char*)g.A + (size_t)cur.pm * tstepA; const char* cB = (const char*)g.Bt + (size_t)cur.pn * tstepB;
    if constexpr (SP2) {
        PG8_STAGE(PG8_SB(0, 0), cB, voffB); PG8_STAGE(PG8_SB(0, 1), cB + hstepB, voffB); PG8_STAGE(PG8_SA(0, 0), cA, voffA); PG8_STAGE(PG8_SA(0, 1), cA + hstepA, voffA);
        if (wr == 1) PG8_BAR;
        PG8_WAIT_V(2); PG8_BAR;
        PG8_STAGE(PG8_SB(1, 0), cB + kstep, voffB); PG8_STAGE(PG8_SA(1, 0), cA + kstep, voffA); PG8_STAGE(PG8_SB(1, 1), cB + hstepB + kstep, voffB);
        PG8_WAIT_V(6); PG8_BAR;
    } else {
        PG8_STAGE(PG8_SB(0, 0), cB, voffB); PG8_STAGE(PG8_SA(0, 0), cA, voffA); PG8_STAGE(PG8_SB(0, 1), cB + hstepB, voffB); PG8_STAGE(PG8_SA(0, 1), cA + hstepA, voffA);
        if (wr == 1) PG8_BAR;
        PG8_WAIT_V(4); PG8_BAR;
        PG8_STAGE(PG8_SB(1, 0), cB + kstep, voffB); PG8_STAGE(PG8_SA(1, 0), cA + kstep, voffA); PG8_STAGE(PG8_SB(1, 1), cB + hstepB + kstep, voffB);
        PG8_WAIT_V(6); PG8_BAR;
    }
    for (;;) {
        const bool has_next = S.next(ui + 1, nxt);
        const char* nA = has_next ? (const char*)g.A + (size_t)nxt.pm * tstepA : cA; const char* nB = has_next ? (const char*)g.Bt + (size_t)nxt.pn * tstepB : cB;
        for (int t = 0; t < nt; t += 2) {
            const bool last = (t == nt - 2);
            const char* a1 = cA + (size_t)(t + 1) * kstep;
            const char* a2 = last ? nA : cA + (size_t)(t + 2) * kstep; const char* b2 = last ? nB : cB + (size_t)(t + 2) * kstep;
            const char* a3 = a2 + kstep; const char* b3 = b2 + kstep;
            if constexpr (SP2) {
            PG8_LDB(B0, 0, 0); PG8_LDB(B1, 0, 1); PG8_SCHED; PG8_LDA(At, 0, 0); PG8_STAGE(PG8_SA(1, 1), a1 + hstepA, voffA);
            PG8_WAIT_V(8); PG8_WAIT_L(0); PG8_BAR; PG8_MMA(0, 0, At, B0); PG8_MMA(0, 1, At, B1); PG8_BAR; PG8_SCHED;
            PG8_LDA(At, 0, 1); PG8_STAGE(PG8_SB(0, 0), b2, voffB); PG8_STAGE(PG8_SB(0, 1), b2 + hstepB, voffB); PG8_STAGE(PG8_SA(0, 0), a2, voffA);
            PG8_WAIT_V(8); PG8_WAIT_L(0); PG8_BAR; PG8_MMA(1, 0, At, B0); PG8_MMA(1, 1, At, B1); PG8_BAR; PG8_SCHED;
            PG8_LDB(B0, 1, 0); PG8_LDB(B1, 1, 1); PG8_SCHED; PG8_LDA(At, 1, 0); PG8_STAGE(PG8_SA(0, 1), a2 + hstepA, voffA);
            PG8_WAIT_V(8); PG8_WAIT_L(0); PG8_BAR; PG8_MMA(0, 0, At, B0); PG8_MMA(0, 1, At, B1); PG8_BAR; PG8_SCHED;
            PG8_LDA(At, 1, 1); PG8_STAGE(PG8_SB(1, 0), b3, voffB); PG8_STAGE(PG8_SB(1, 1), b3 + hstepB, voffB); PG8_STAGE(PG8_SA(1, 0), a3, voffA);
            PG8_WAIT_V(8); PG8_WAIT_L(0); PG8_BAR; PG8_MMA(1, 0, At, B0); PG8_MMA(1, 1, At, B1); PG8_BAR; PG8_SCHED;
            } else {
            PG8_LDB(B0, 0, 0); PG8_SCHED; PG8_LDA(At, 0, 0); PG8_STAGE(PG8_SA(1, 1), a1 + hstepA, voffA);
            PG8_WAIT_L(8); PG8_BAR; PG8_WAIT_L(0); PG8_MMA(0, 0, At, B0); PG8_BAR; PG8_SCHED;
            PG8_LDB(B1, 0, 1); PG8_STAGE(PG8_SB(0, 0), b2, voffB);
            PG8_BAR; PG8_WAIT_L(0); PG8_MMA(0, 1, At, B1); PG8_BAR;
            PG8_LDA(At, 0, 1); PG8_STAGE(PG8_SA(0, 0), a2, voffA);
            PG8_BAR; PG8_WAIT_L(0); PG8_MMA(1, 0, At, B0); PG8_BAR; PG8_SCHED;
            PG8_STAGE(PG8_SB(0, 1), b2 + hstepB, voffB);
            PG8_WAIT_V(6); PG8_BAR; PG8_MMA(1, 1, At, B1); PG8_BAR;
            PG8_LDB(B0, 1, 0); PG8_SCHED; PG8_LDA(At, 1, 0); PG8_STAGE(PG8_SA(0, 1), a2 + hstepA, voffA);
            PG8_WAIT_L(8); PG8_BAR; PG8_WAIT_L(0); PG8_MMA(0, 0, At, B0); PG8_BAR; PG8_SCHED;
            PG8_LDB(B1, 1, 1); PG8_STAGE(PG8_SB(1, 0), b3, voffB);
            PG8_BAR; PG8_WAIT_L(0); PG8_MMA(0, 1, At, B1); PG8_BAR;
            PG8_LDA(At, 1, 1); PG8_STAGE(PG8_SA(1, 0), a3, voffA);
            PG8_BAR; PG8_WAIT_L(0); PG8_MMA(1, 0, At, B0); PG8_BAR; PG8_SCHED;
            PG8_STAGE(PG8_SB(1, 1), b3 + hstepB, voffB);
            PG8_WAIT_V(6); PG8_BAR; PG8_MMA(1, 1, At, B1); PG8_BAR;
            }
        }
        if constexpr (ALIGN_EPI) { if (wr == 0) PG8_BAR; }
        E(acc, cur, wr, wc, fr, fq);
        if (!has_next) break;
#pragma unroll
        for (int a = 0; a < 2; ++a)
#pragma unroll
            for (int b = 0; b < 2; ++b)
#pragma unroll
                for (int m = 0; m < 4; ++m)
#pragma unroll
                    for (int n = 0; n < 2; ++n) acc[a][b][m][n] = (f32x4){0.f, 0.f, 0.f, 0.f};
        cur = nxt; cA = nA; cB = nB; ++ui;
        if constexpr (ALIGN_EPI) { if (wr == 1) PG8_BAR; }
    }
    PG8_WAIT_V(0);
    if constexpr (!ALIGN_EPI) { if (wr == 0) PG8_BAR; }
    PG8_BAR;
#undef PG8_SA
#undef PG8_SB
#undef PG8_STAGE
#undef PG8_LDA
#undef PG8_LDB
#undef PG8_MMA
#undef PG8_WAIT_V
#undef PG8_WAIT_L
#undef PG8_BAR
#undef PG8_SCHED
}
}

typedef f32x4 Acc[2][2][4][2];

struct EpiZ {
    const float* rstd1; bf16_t* z; float* out;
    __device__ __forceinline__ void operator()(const Acc& acc, const pg8::Unit& u, int wr, int wc, int fr, int fq) const {
        const int col0 = u.pn * 256 + wc * 32 + 8 * fq;
#pragma unroll
        for (int ai = 0; ai < 2; ++ai)
#pragma unroll
            for (int m = 0; m < 4; ++m) {
                const int r = u.pm * 256 + ai * 128 + wr * 64 + m * 16 + fr;
                if (r < M) {
                    const float rs = rstd1[r];
                    int is_s, seq, t; row_decode(r, is_s, seq, t);
                    float* so = nullptr;
                    if (u.pn < 6) { if (is_s) { if (t >= TS - 3) so = out + O_SRC + ((size_t)seq * 3 + (t - (TS - 3))) * DA; } else { if (t >= TP - 3) so = out + O_PRC + ((size_t)seq * 3 + (t - (TP - 3))) * DA; } }
#pragma unroll
                    for (int bj = 0; bj < 2; ++bj) {
                        const f32x4 v0 = acc[ai][bj][m][0] * rs, v1 = acc[ai][bj][m][1] * rs;
                        u32x4 w; w.x = cvt_pk_bf16(v0[0], v0[1]); w.y = cvt_pk_bf16(v0[2], v0[3]); w.z = cvt_pk_bf16(v1[0], v1[1]); w.w = cvt_pk_bf16(v1[2], v1[3]);
                        *(u32x4*)(z + (size_t)r * DIN + col0 + bj * 128) = w;
                        if (so) { *(f32x4*)(so + col0 + bj * 128) = v0; *(f32x4*)(so + col0 + bj * 128 + 4) = v1; }
                    }
                }
            }
    }
};
struct EpiX1 {
    const float *xp, *xs, *meta; float* out; bf16_t* x1b; float* ssq;
    __device__ __forceinline__ void operator()(const Acc& acc, const pg8::Unit& u, int wr, int wc, int fr, int fq) const {
        const int col0 = u.pn * 256 + wc * 32 + 8 * fq;
#pragma unroll
        for (int ai = 0; ai < 2; ++ai)
#pragma unroll
            for (int m = 0; m < 4; ++m) {
                const int r = u.pm * 256 + ai * 128 + wr * 64 + m * 16 + fr;
                const bool valid = r < M;
                const float* xr = x_row_ptr(xp, xs, meta, valid ? r : 0);
                float* yd = y_row_ptr(out, r);
                float ss = 0.f;
#pragma unroll
                for (int bj = 0; bj < 2; ++bj) {
                    const int c = col0 + bj * 128;
                    const f32x4 v0 = acc[ai][bj][m][0] + *(const f32x4*)(xr + c), v1 = acc[ai][bj][m][1] + *(const f32x4*)(xr + c + 4);
                    ss += (v0[0] * v0[0] + v0[1] * v0[1]) + (v0[2] * v0[2] + v0[3] * v0[3]) + (v1[0] * v1[0] + v1[1] * v1[1]) + (v1[2] * v1[2] + v1[3] * v1[3]);
                    if (yd) { *(f32x4*)(yd + c) = v0; *(f32x4*)(yd + c + 4) = v1; }
                    if (valid) { u32x4 w; w.x = cvt_pk_bf16(v0[0], v0[1]); w.y = cvt_pk_bf16(v0[2], v0[3]); w.z = cvt_pk_bf16(v1[0], v1[1]); w.w = cvt_pk_bf16(v1[2], v1[3]);
                        *(u32x4*)(x1b + (size_t)r * D + c) = w; }
                }
                ss += __shfl_xor(ss, 16); ss += __shfl_xor(ss, 32);
                if (valid && fq == 0) ssq[(size_t)r * 32 + u.pn * 4 + wc] = ss;
            }
    }
};
struct EpiOut {
    float* out;
    __device__ __forceinline__ void operator()(const Acc& acc, const pg8::Unit& u, int wr, int wc, int fr, int fq) const {
        const int col0 = u.pn * 256 + wc * 32 + 8 * fq;
#pragma unroll
        for (int ai = 0; ai < 2; ++ai)
#pragma unroll
            for (int m = 0; m < 4; ++m) {
                const int r = u.pm * 256 + ai * 128 + wr * 64 + m * 16 + fr;
                float* yd = y_row_ptr(out, r);
                if (yd) {
#pragma unroll
                    for (int bj = 0; bj < 2; ++bj) {
                        const int c = col0 + bj * 128;
                        const f32x4 v0 = acc[ai][bj][m][0] + *(const f32x4*)(yd + c), v1 = acc[ai][bj][m][1] + *(const f32x4*)(yd + c + 4);
                        *(f32x4*)(yd + c) = v0; *(f32x4*)(yd + c + 4) = v1;
                    }
                }
            }
    }
};
struct EpiFFN {
    const float *ssq, *cw, *cb, *st_fc; bf16_t* hid; float* out;
    __device__ __forceinline__ void operator()(Acc& acc, const pg8::Unit& u, int wr, int wc, int fr, int fq) const {
        const int gbase = 252 * u.pm - 2 + 126 * wr;
        const int f0 = 128 * u.pn + 32 * wc + 8 * fq;
#pragma unroll
        for (int ai = 0; ai < 2; ++ai)
#pragma unroll
            for (int m = 0; m < 4; ++m) {
                int r = gbase + 64 * ai + 16 * m + fr; r = r < 0 ? 0 : (r >= M ? M - 1 : r);
                const float* sp = ssq + (size_t)r * 32 + 8 * fq;
                const f32x4 a = *(const f32x4*)sp, b = *(const f32x4*)(sp + 4);
                float s = ((a[0] + a[1]) + (a[2] + a[3])) + ((b[0] + b[1]) + (b[2] + b[3]));
                s += __shfl_xor(s, 16); s += __shfl_xor(s, 32);
                const float rs = __builtin_amdgcn_rsqf(s * (1.0f / D) + EPS);
#pragma unroll
                for (int bj = 0; bj < 2; ++bj)
#pragma unroll
                    for (int n = 0; n < 2; ++n) acc[ai][bj][m][n] *= rs;
                if (m & 1) __builtin_amdgcn_sched_barrier(0);
            }
        const f32x4 w0a = *(const f32x4*)(cw + f0), w0b = *(const f32x4*)(cw + f0 + 4);
        const f32x4 w1a = *(const f32x4*)(cw + DFF + f0), w1b = *(const f32x4*)(cw + DFF + f0 + 4);
        const f32x4 w2a = *(const f32x4*)(cw + 2 * DFF + f0), w2b = *(const f32x4*)(cw + 2 * DFF + f0 + 4);
        const f32x4 bba = *(const f32x4*)(cb + f0), bbb = *(const f32x4*)(cb + f0 + 4);
#pragma unroll
        for (int ai = 0; ai < 2; ++ai)
#pragma unroll
            for (int m = 0; m < 4; ++m) {
                const int j = 64 * ai + 16 * m + fr, r = gbase + j;
                const bool valid = (j >= 2) && (r < M);
                const f32x4 c0 = acc[ai][0][m][0], c1 = acc[ai][0][m][1];
                const int pai = (m == 0) ? (ai == 0 ? 0 : ai - 1) : ai, pm_ = (m == 0) ? (ai == 0 ? 0 : 3) : m - 1;
                const f32x4 q0 = acc[pai][0][pm_][0], q1 = acc[pai][0][pm_][1];
                f32x4 p1a, p1b, p2a, p2b;
#pragma unroll
                for (int e = 0; e < 4; ++e) {
                    p1a[e] = dppf<0x111>(dppf<0x121>(0.f, q0[e]), c0[e]); p1b[e] = dppf<0x111>(dppf<0x121>(0.f, q1[e]), c1[e]);
                    p2a[e] = dppf<0x112>(dppf<0x122>(0.f, q0[e]), c0[e]); p2b[e] = dppf<0x112>(dppf<0x122>(0.f, q1[e]), c1[e]);
                }
                int is_s, seq, t; row_decode(valid ? r : 0, is_s, seq, t);
                if (valid && t < 2) {
                    f32x4 s0a = (f32x4){0.f, 0.f, 0.f, 0.f}, s0b = s0a, s1a = s0a, s1b = s0a;
                    if (is_s) { const float* sp = st_fc + (size_t)seq * 2 * DFF + f0; s0a = *(const f32x4*)sp; s0b = *(const f32x4*)(sp + 4); s1a = *(const f32x4*)(sp + DFF); s1b = *(const f32x4*)(sp + DFF + 4); }
                    if (t == 0) { p1a = s1a; p1b = s1b; p2a = s0a; p2b = s0b; } else { p2a = s1a; p2b = s1b; }
                }
                const f32x4 ga = w0a * p2a + w1a * p1a + w2a * c0 + bba, gb = w0b * p2b + w1b * p1b + w2b * c1 + bbb;
                const f32x4 va = acc[ai][1][m][0], vb = acc[ai][1][m][1];
                if (valid) {
                    u32x4 w;
                    w.x = cvt_pk_bf16(gelu_tanh(ga[0]) * va[0], gelu_tanh(ga[1]) * va[1]); w.y = cvt_pk_bf16(gelu_tanh(ga[2]) * va[2], gelu_tanh(ga[3]) * va[3]);
                    w.z = cvt_pk_bf16(gelu_tanh(gb[0]) * vb[0], gelu_tanh(gb[1]) * vb[1]); w.w = cvt_pk_bf16(gelu_tanh(gb[2]) * vb[2], gelu_tanh(gb[3]) * vb[3]);
                    *(u32x4*)(hid + (size_t)r * DFF + f0) = w;
                    const int T = is_s ? TS : TP;
                    if (t >= T - 2) { float* so = out + (is_s ? O_SFC : O_PFC) + ((size_t)seq * 2 + (t - (T - 2))) * DFF + f0; *(f32x4*)so = c0; *(f32x4*)(so + 4) = c1; }
                }
                __builtin_amdgcn_sched_barrier(0);
            }
    }
};

__device__ __forceinline__ int invperm32(int q) { return 16 * ((q >> 2) & 1) + 4 * (q >> 3) + (q & 3); }
__device__ __forceinline__ void p0_transpose_item(const float* W, int K, int N, const float* kscale, bf16_t* WT, int mode, LAS float* scr, int item, int lane) {
    const int nblk = N / 32, kb = item / nblk, nb = item % nblk, k0 = 64 * kb, n0 = 32 * nb;
    float v[32];
    const float* src = W + (size_t)(k0 + (lane >> 5)) * N + n0 + (lane & 31);
#pragma unroll
    for (int i = 0; i < 32; ++i) v[i] = src[(size_t)(2 * i) * N];
#pragma unroll
    for (int i = 0; i < 32; ++i) scr[(2 * i + (lane >> 5)) * 33 + (lane & 31)] = v[i];
    asm volatile("s_waitcnt lgkmcnt(0)" ::: "memory");
    int rbase = n0;
    if (mode == 1) { const int bj = n0 >= DFF ? 1 : 0, f = n0 - bj * DFF; rbase = 256 * (f >> 7) + 128 * bj + (f & 96); }
    const int c = lane & 7;
    f32x4 ks0 = (f32x4){1.f, 1.f, 1.f, 1.f}, ks1 = ks0;
    if (kscale) { ks0 = *(const f32x4*)(kscale + k0 + 8 * c); ks1 = *(const f32x4*)(kscale + k0 + 8 * c + 4); }
#pragma unroll
    for (int j = 0; j < 4; ++j) { const int n = (lane >> 3) + 8 * j; const LAS float* sp = scr + (8 * c) * 33 + n;
        u32x4 o; o.x = cvt_pk_bf16(sp[0 * 33] * ks0[0], sp[1 * 33] * ks0[1]); o.y = cvt_pk_bf16(sp[2 * 33] * ks0[2], sp[3 * 33] * ks0[3]);
        o.z = cvt_pk_bf16(sp[4 * 33] * ks1[0], sp[5 * 33] * ks1[1]); o.w = cvt_pk_bf16(sp[6 * 33] * ks1[2], sp[7 * 33] * ks1[3]);
        *(u32x4*)(WT + (size_t)(rbase + (mode == 2 ? n : invperm32(n))) * K + k0 + 8 * c) = o; }
    asm volatile("s_waitcnt lgkmcnt(0)" ::: "memory");
}
__device__ __forceinline__ void phase0(const Params& p, LAS unsigned char* lds, int G) {
    const int tid = threadIdx.x, lane = tid & 63, wave = tid >> 6;
    unsigned char* ws = p.ws;
    LAS float* scr = (LAS float*)(lds + wave * 16384);
    const int gw = blockIdx.x * 8 + wave, NGW = G * 8;
    constexpr int I_IN = (D / 64) * (DIN / 32), I_O = (DMIX / 64) * (D / 32), I_UP = (D / 64) * (2 * DFF / 32), I_DN = (DFF / 64) * (D / 32), I_G = 2 * NH * 8;
    constexpr int NITEMS = I_IN + I_O + I_UP + I_DN + I_G;
    for (int it = gw; it < NITEMS; it += NGW) {
        int r = it;
        if (r < I_IN) { p0_transpose_item(p.w_in, D, DIN, p.g_mix, (bf16_t*)(ws + WS_WIN), 0, scr, r, lane); continue; } r -= I_IN;
        if (r < I_O) { p0_transpose_item(p.w_o, DMIX, D, nullptr, (bf16_t*)(ws + WS_WO), 0, scr, r, lane); continue; } r -= I_O;
        if (r < I_UP) { p0_transpose_item(p.w_up, D, 2 * DFF, p.g_ffn, (bf16_t*)(ws + WS_WUP), 1, scr, r, lane); continue; } r -= I_UP;
        if (r < I_DN) { p0_transpose_item(p.w_down, DFF, D, nullptr, (bf16_t*)(ws + WS_WDN), 0, scr, r, lane); continue; } r -= I_DN;
        { const int mat = r >> 3, sub = r & 7, gsel = mat / NH, n = mat % NH;
          p0_transpose_item((gsel ? p.w_gate_x : p.w_gate_a) + (size_t)n * 128 * 128, 128, 128, nullptr, (bf16_t*)(ws + WS_WG) + (size_t)mat * 128 * 128, 0, scr, sub, lane); }
    }
    { bf16_t* xb = (bf16_t*)(ws + WS_XB) + (size_t)16 * D; float* rstd1 = (float*)(ws + WS_RS1);
      for (int m = gw; m < M; m += NGW) {
          const f32x4* xr = (const f32x4*)x_row_ptr(p.x_prompt, p.x_sample, p.meta, m) + lane;
          f32x4 v[8]; float s = 0.f;
#pragma unroll
          for (int j = 0; j < 8; ++j) { v[j] = xr[64 * j]; s += (v[j][0] * v[j][0] + v[j][1] * v[j][1]) + (v[j][2] * v[j][2] + v[j][3] * v[j][3]); }
          s = wave_sum(s);
          if (lane == 0) rstd1[m] = __builtin_amdgcn_rsqf(s * (1.0f / D) + EPS);
          u32x2* o = (u32x2*)(xb + (size_t)m * D) + lane;
#pragma unroll
          for (int j = 0; j < 8; ++j) { u32x2 w; w.x = cvt_pk_bf16(v[j][0], v[j][1]); w.y = cvt_pk_bf16(v[j][2], v[j][3]); o[64 * j] = w; }
      } }
}

__device__ __forceinline__ void branch_b(const Params& p, int G) {
    const bf16_t* z = (const bf16_t*)(p.ws + WS_Z); bf16_t* ym = (bf16_t*)(p.ws + WS_YM);
    const int total = M * 128;
    for (int idx = blockIdx.x * 512 + threadIdx.x; idx < total; idx += G * 512) {
        const int m = idx >> 7, g = idx & 127, ch = 8 * g;
        int is_s, seq, t; row_decode(m, is_s, seq, t);
        float u[3][8];
#pragma unroll
        for (int k = 0; k < 3; ++k) {
            const int tt = t - 2 + k;
            if (tt >= 0) {
                float a[8], b[8];
                unpack8(*(const u32x4*)(z + (size_t)(m - 2 + k) * DIN + 4096 + ch), a); unpack8(*(const u32x4*)(z + (size_t)(m - 2 + k) * DIN + 5120 + ch), b);
#pragma unroll
                for (int e = 0; e < 8; ++e) u[k][e] = a[e] * b[e];
            } else if (is_s) {
                const float* sp = p.st_sc + ((size_t)seq * 2 + (tt + 2)) * DB + ch; const f32x4 a = *(const f32x4*)sp, b = *(const f32x4*)(sp + 4);
#pragma unroll
                for (int e = 0; e < 4; ++e) { u[k][e] = a[e]; u[k][4 + e] = b[e]; }
            } else {
#pragma unroll
                for (int e = 0; e < 8; ++e) u[k][e] = 0.f;
            }
        }
        float gb[8]; unpack8(*(const u32x4*)(z + (size_t)m * DIN + 3072 + ch), gb);
        float y[8]; float ss = 0.f;
#pragma unroll
        for (int e = 0; e < 8; ++e) {
            const float uc = p.conv_b_w[ch + e] * u[0][e] + p.conv_b_w[DB + ch + e] * u[1][e] + p.conv_b_w[2 * DB + ch + e] * u[2][e];
            y[e] = gb[e] * uc; ss += y[e] * y[e];
        }
        ss = sum16(ss);
        const float rn = __builtin_amdgcn_rsqf(ss * (1.0f / 128.0f) + EPS);
#pragma unroll
        for (int e = 0; e < 8; ++e) y[e] = y[e] * rn * p.g_out_b[ch + e];
        *(u32x4*)(ym + (size_t)m * DMIX + DA + ch) = pack8(y);
        const int T = is_s ? TS : TP;
        if (t >= T - 2) { float* so = p.out + (is_s ? O_SSC : O_PSC) + ((size_t)seq * 2 + (t - (T - 2))) * DB + ch;
            *(f32x4*)so = (f32x4){u[2][0], u[2][1], u[2][2], u[2][3]}; *(f32x4*)(so + 4) = (f32x4){u[2][4], u[2][5], u[2][6], u[2][7]}; }
    }
}

constexpr int LW_STRIDE = 272, L_WA = 0, L_WX = 128 * LW_STRIDE, L_CT = 2 * 128 * LW_STRIDE, L_LRU_END = L_CT + 9 * 128 * 4;
static_assert(L_LRU_END <= 131072, "mixer LDS");
constexpr int LRU_WG_PER_HEAD = 19, LRU_NSEG = 33, LRU_PITEMS = NB * LRU_NSEG, LRU_SITEMS = MSR / 64;
static_assert(LRU_WG_PER_HEAD * 8 >= LRU_PITEMS + LRU_SITEMS, "waves per head");

template <int CTRL, int BANK> __device__ __forceinline__ float dppfb(float old, float src) {
    return __builtin_bit_cast(float, __builtin_amdgcn_update_dpp(__builtin_bit_cast(int, old), __builtin_bit_cast(int, src), CTRL, 0xF, BANK, false));
}
__device__ __forceinline__ float bcast15(float x, int lane) {
    return __builtin_bit_cast(float, __builtin_amdgcn_ds_bpermute(((lane & 48) | 15) << 2, __builtin_bit_cast(int, x)));
}
__device__ __forceinline__ void scan16(float& P, float& S) {
    float Sd, Pd;
    Sd = dppf<0x111>(0.f, S); Pd = dppf<0x111>(1.f, P); S = __builtin_fmaf(P, Sd, S); P *= Pd;
    Sd = dppf<0x112>(0.f, S); Pd = dppf<0x112>(1.f, P); S = __builtin_fmaf(P, Sd, S); P *= Pd;
    Sd = dppf<0x114>(0.f, S); Pd = dppf<0x114>(1.f, P); S = __builtin_fmaf(P, Sd, S); P *= Pd;
    Sd = dppf<0x118>(0.f, S); Pd = dppf<0x118>(1.f, P); S = __builtin_fmaf(P, Sd, S); P *= Pd;
}
__device__ __forceinline__ void scan8(float& P, float& S, int t) {
    float Sd, Pd;
    Sd = dppf<0x111>(0.f, S); Pd = dppf<0x111>(1.f, P); if (t < 1) { Sd = 0.f; Pd = 1.f; } S = __builtin_fmaf(P, Sd, S); P *= Pd;
    Sd = dppf<0x112>(0.f, S); Pd = dppf<0x112>(1.f, P); if (t < 2) { Sd = 0.f; Pd = 1.f; } S = __builtin_fmaf(P, Sd, S); P *= Pd;
    Sd = dppfb<0x114, 0xA>(0.f, S); Pd = dppfb<0x114, 0xA>(1.f, P); S = __builtin_fmaf(P, Sd, S); P *= Pd;
}

template <int PASS, bool IS_S>
__device__ __forceinline__ void lru_wave_item(const Params& p, LAS unsigned char* lds, int n, int b, int seg) {
    const int lane = threadIdx.x & 63, fr = lane & 15, fq = lane >> 4;
    const bf16_t* z = (const bf16_t*)(p.ws + WS_Z);
    bf16_t* ym = (bf16_t*)(p.ws + WS_YM);
    float* tot = (float*)(p.ws + WS_TOT);
    const LAS float* CT = (const LAS float*)(lds + L_CT) + 8 * fq;
    const int gch = n * 128 + 8 * fq;
    const int r0 = IS_S ? MPR + b * 64 : b * TP + seg * 64;
    const int nblk = IS_S ? 4 : (seg == LRU_NSEG - 1 ? 1 : 4);
    float hin[4][8], Pt[4][8];
    u32x4 prevx[4];
#pragma unroll
    for (int ks = 0; ks < 4; ++ks) {
#pragma unroll
        for (int e = 0; e < 8; ++e) { hin[ks][e] = 0.f; Pt[ks][e] = 1.f; }
        prevx[ks] = (u32x4){0u, 0u, 0u, 0u};
    }
    if constexpr (!IS_S) {
        if (seg > 0) {
#pragma unroll
            for (int ks = 0; ks < 4; ++ks) prevx[ks] = *(const u32x4*)(z + (size_t)(r0 - 16 + fr) * DIN + gch + 32 * ks);
            if constexpr (PASS == 2) {
#pragma unroll 1
                for (int round = 0; round < 2; ++round) {
                    const int s = 16 * round + fr;
                    if (16 * round >= seg) break;
                    const bool have = s < seg;
                    const float* tp = tot + ((size_t)(b * LRU_NSEG + (have ? s : 0)) * 2) * DA + gch;
#pragma unroll
                    for (int ks = 0; ks < 4; ++ks) {
                        const f32x4 P0 = *(const f32x4*)(tp + 32 * ks), P1 = *(const f32x4*)(tp + 32 * ks + 4), S0 = *(const f32x4*)(tp + DA + 32 * ks), S1 = *(const f32x4*)(tp + DA + 32 * ks + 4);
#pragma unroll
                        for (int e = 0; e < 8; ++e) {
                            float P = have ? (e < 4 ? P0[e & 3] : P1[e & 3]) : 1.f, S = have ? (e < 4 ? S0[e & 3] : S1[e & 3]) : 0.f;
                            scan16(P, S);
                            const float Pc = bcast15(P, lane), Sc = bcast15(S, lane);
                            hin[ks][e] = __builtin_fmaf(Pc, hin[ks][e], Sc);
                        }
                    }
                }
            }
        }
    }
#pragma unroll 1
    for (int blk = 0; blk < nblk; ++blk) {
        const int r = r0 + 16 * blk + fr;
        const int t8 = fr & 7, sq = (r - MPR) >> 3;
        u32x4 x4[4], g4[4];
#pragma unroll
        for (int ks = 0; ks < 4; ++ks) { x4[ks] = *(const u32x4*)(z + (size_t)r * DIN + gch + 32 * ks); if constexpr (PASS == 2) g4[ks] = *(const u32x4*)(z + (size_t)r * DIN + DA + gch + 32 * ks); }
        float xc[4][8];
        bf16x8 bfrag[4];
#pragma unroll
        for (int ks = 0; ks < 4; ++ks) {
            float xf[8]; unpack8(x4[ks], xf);
            const f32x4 w0a = *(const LAS f32x4*)(CT + 0 * 128 + 32 * ks), w0b = *(const LAS f32x4*)(CT + 0 * 128 + 32 * ks + 4);
            const f32x4 w1a = *(const LAS f32x4*)(CT + 1 * 128 + 32 * ks), w1b = *(const LAS f32x4*)(CT + 1 * 128 + 32 * ks + 4);
            const f32x4 w2a = *(const LAS f32x4*)(CT + 2 * 128 + 32 * ks), w2b = *(const LAS f32x4*)(CT + 2 * 128 + 32 * ks + 4);
            const f32x4 w3a = *(const LAS f32x4*)(CT + 3 * 128 + 32 * ks), w3b = *(const LAS f32x4*)(CT + 3 * 128 + 32 * ks + 4);
            const f32x4 cba = *(const LAS f32x4*)(CT + 4 * 128 + 32 * ks), cbb = *(const LAS f32x4*)(CT + 4 * 128 + 32 * ks + 4);
            if constexpr (IS_S) {
                const float* sp = p.st_rc + (size_t)sq * 3 * DA + gch + 32 * ks;
                const f32x4 b0a = *(const f32x4*)sp, b0b = *(const f32x4*)(sp + 4), b1a = *(const f32x4*)(sp + DA), b1b = *(const f32x4*)(sp + DA + 4), b2a = *(const f32x4*)(sp + 2 * DA), b2b = *(const f32x4*)(sp + 2 * DA + 4);
#pragma unroll
                for (int e = 0; e < 8; ++e) {
                    const float bb0 = e < 4 ? b0a[e & 3] : b0b[e & 3], bb1 = e < 4 ? b1a[e & 3] : b1b[e & 3], bb2 = e < 4 ? b2a[e & 3] : b2b[e & 3];
                    const float s1 = dppf<0x111>(0.f, xf[e]), s2 = dppf<0x112>(0.f, xf[e]), s3 = dppf<0x113>(0.f, xf[e]);
                    const float x1 = t8 >= 1 ? s1 : bb2;
                    const float x2 = t8 >= 2 ? s2 : (t8 == 1 ? bb2 : bb1);
                    const float x3 = t8 >= 3 ? s3 : (t8 == 2 ? bb2 : (t8 == 1 ? bb1 : bb0));
                    const float w0 = e < 4 ? w0a[e & 3] : w0b[e & 3], w1 = e < 4 ? w1a[e & 3] : w1b[e & 3], w2 = e < 4 ? w2a[e & 3] : w2b[e & 3], w3 = e < 4 ? w3a[e & 3] : w3b[e & 3];
                    xc[ks][e] = (e < 4 ? cba[e & 3] : cbb[e & 3]) + w3 * xf[e] + w2 * x1 + w1 * x2 + w0 * x3;
                }
            } else {
                float pf[8]; unpack8(prevx[ks], pf);
#pragma unroll
                for (int e = 0; e < 8; ++e) {
                    const float x1 = dppf<0x111>(dppf<0x121>(0.f, pf[e]), xf[e]);
                    const float x2 = dppf<0x112>(dppf<0x122>(0.f, pf[e]), xf[e]);
                    const float x3 = dppf<0x113>(dppf<0x123>(0.f, pf[e]), xf[e]);
                    const float w0 = e < 4 ? w0a[e & 3] : w0b[e & 3], w1 = e < 4 ? w1a[e & 3] : w1b[e & 3], w2 = e < 4 ? w2a[e & 3] : w2b[e & 3], w3 = e < 4 ? w3a[e & 3] : w3b[e & 3];
                    xc[ks][e] = (e < 4 ? cba[e & 3] : cbb[e & 3]) + w3 * xf[e] + w2 * x1 + w1 * x2 + w0 * x3;
                }
                prevx[ks] = x4[ks];
            }
            bfrag[ks] = __builtin_bit_cast(bf16x8, pack8(xc[ks]));
        }
        f32x4 aa[8], ax[8];
#pragma unroll
        for (int nb = 0; nb < 8; ++nb) { aa[nb] = (f32x4){0.f, 0.f, 0.f, 0.f}; ax[nb] = (f32x4){0.f, 0.f, 0.f, 0.f}; }
#pragma unroll
        for (int ks = 0; ks < 4; ++ks)
#pragma unroll
            for (int nb = 0; nb < 8; ++nb) {
                const bf16x8 wa = *(const LAS bf16x8*)(lds + L_WA + (16 * nb + fr) * LW_STRIDE + (32 * ks + 8 * fq) * 2);
                const bf16x8 wx = *(const LAS bf16x8*)(lds + L_WX + (16 * nb + fr) * LW_STRIDE + (32 * ks + 8 * fq) * 2);
                aa[nb] = __builtin_amdgcn_mfma_f32_16x16x32_bf16(wa, bfrag[ks], aa[nb], 0, 0, 0);
                ax[nb] = __builtin_amdgcn_mfma_f32_16x16x32_bf16(wx, bfrag[ks], ax[nb], 0, 0, 0);
            }
        float y[4][8]; float ss = 0.f;
#pragma unroll
        for (int ks = 0; ks < 4; ++ks) {
            const f32x4 bga0 = *(const LAS f32x4*)(CT + 5 * 128 + 32 * ks), bga1 = *(const LAS f32x4*)(CT + 5 * 128 + 32 * ks + 4);
            const f32x4 bgx0 = *(const LAS f32x4*)(CT + 6 * 128 + 32 * ks), bgx1 = *(const LAS f32x4*)(CT + 6 * 128 + 32 * ks + 4);
            const f32x4 sp0 = *(const LAS f32x4*)(CT + 7 * 128 + 32 * ks), sp1 = *(const LAS f32x4*)(CT + 7 * 128 + 32 * ks + 4);
            float gav[8];
            if constexpr (PASS == 2) unpack8(g4[ks], gav);
            f32x4 h0a, h0b;
            if constexpr (IS_S) { const float* hp = p.st_h + (size_t)sq * DA + gch + 32 * ks; h0a = *(const f32x4*)hp; h0b = *(const f32x4*)(hp + 4); }
            float hv[8];
#pragma unroll
            for (int e = 0; e < 8; ++e) {
                const int nb = 2 * ks + (e >> 2), rg = e & 3;
                const float rr = sigmoidf_(aa[nb][rg] + (e < 4 ? bga0[rg] : bga1[rg])), ii = sigmoidf_(ax[nb][rg] + (e < 4 ? bgx0[rg] : bgx1[rg]));
                const float la = -8.0f * rr * (e < 4 ? sp0[rg] : sp1[rg]);
                const float a = __expf(la);
                const float om = __builtin_fmaf(-a, a, 1.0f);
                float P = a, S = __builtin_amdgcn_sqrtf(om > 0.f ? om : 0.f) * (ii * xc[ks][e]);
                float h;
                if constexpr (IS_S) { scan8(P, S, t8); h = __builtin_fmaf(P, e < 4 ? h0a[rg] : h0b[rg], S); }
                else {
                    scan16(P, S);
                    h = __builtin_fmaf(P, hin[ks][e], S);
                    hin[ks][e] = bcast15(h, lane);
                    if constexpr (PASS == 1) Pt[ks][e] *= bcast15(P, lane);
                }
                hv[e] = h;
                if constexpr (PASS == 2) { y[ks][e] = gelu_tanh(gav[e]) * h; ss += y[ks][e] * y[ks][e]; }
            }
            if constexpr (PASS == 2) {
                if (IS_S ? (t8 == 7) : (seg == LRU_NSEG - 1 && fr == 15)) {
                    float* ho = p.out + (IS_S ? O_SH + (size_t)sq * DA : O_PH + (size_t)b * DA) + gch + 32 * ks;
                    *(f32x4*)ho = (f32x4){hv[0], hv[1], hv[2], hv[3]}; *(f32x4*)(ho + 4) = (f32x4){hv[4], hv[5], hv[6], hv[7]};
                }
            }
        }
        if constexpr (PASS == 2) {
            ss += __shfl_xor(ss, 16); ss += __shfl_xor(ss, 32);
            const float rn = __builtin_amdgcn_rsqf(ss * (1.0f / 128.0f) + EPS);
#pragma unroll
            for (int ks = 0; ks < 4; ++ks) {
                const f32x4 g0 = *(const LAS f32x4*)(CT + 8 * 128 + 32 * ks), g1 = *(const LAS f32x4*)(CT + 8 * 128 + 32 * ks + 4);
                float o[8];
#pragma unroll
                for (int e = 0; e < 8; ++e) o[e] = y[ks][e] * rn * (e < 4 ? g0[e & 3] : g1[e & 3]);
                *(u32x4*)(ym + (size_t)r * DMIX + gch + 32 * ks) = pack8(o);
            }
        }
    }
    if constexpr (PASS == 1 && !IS_S) {
        if (fr == 0) {
            float* tp = tot + ((size_t)(b * LRU_NSEG + seg) * 2) * DA + gch;
#pragma unroll
            for (int ks = 0; ks < 4; ++ks) {
                *(f32x4*)(tp + 32 * ks) = (f32x4){Pt[ks][0], Pt[ks][1], Pt[ks][2], Pt[ks][3]}; *(f32x4*)(tp + 32 * ks + 4) = (f32x4){Pt[ks][4], Pt[ks][5], Pt[ks][6], Pt[ks][7]};
                *(f32x4*)(tp + DA + 32 * ks) = (f32x4){hin[ks][0], hin[ks][1], hin[ks][2], hin[ks][3]}; *(f32x4*)(tp + DA + 32 * ks + 4) = (f32x4){hin[ks][4], hin[ks][5], hin[ks][6], hin[ks][7]};
            }
        }
    }
}
template <int PASS>
__device__ __forceinline__ void mixer_phase(const Params& p, LAS unsigned char* lds, int G) {
    const int tid = threadIdx.x, wave = __builtin_amdgcn_readfirstlane(tid >> 6);
    for (int v = blockIdx.x; v < NH * LRU_WG_PER_HEAD; v += G) {
        const int n = v / LRU_WG_PER_HEAD;
        __syncthreads();
        {
            const bf16_t* wg = (const bf16_t*)(p.ws + WS_WG);
            for (int i = tid; i < 2 * 128 * 16; i += 512) { const int g = i >> 11, row = (i >> 4) & 127, c16 = i & 15;
                *(LAS u32x4*)(lds + g * L_WX + row * LW_STRIDE + c16 * 16) = *(const u32x4*)(wg + (((size_t)g * NH + n) * 128 + row) * 128 + c16 * 8); }
            LAS float* CTw = (LAS float*)(lds + L_CT);
            for (int i = tid; i < 9 * 128; i += 512) { const int k = i >> 7, c = i & 127, ch = n * 128 + c;
                float vv;
                if (k < 4) vv = p.conv_a_w[k * DA + ch]; else if (k == 4) vv = p.conv_a_b[ch]; else if (k == 5) vv = p.b_gate_a[ch]; else if (k == 6) vv = p.b_gate_x[ch];
                else if (k == 7) vv = log1pf(__expf(-p.lam[ch])); else vv = p.g_out_a[ch];
                CTw[i] = vv; }
        }
        __syncthreads();
        const int wi = (v % LRU_WG_PER_HEAD) * 8 + wave;
        if (wi < LRU_PITEMS) lru_wave_item<PASS, false>(p, lds, n, wi / LRU_NSEG, wi % LRU_NSEG);
        else if (PASS == 2 && wi < LRU_PITEMS + LRU_SITEMS) lru_wave_item<PASS, true>(p, lds, n, wi - LRU_PITEMS, 0);
    }
    if (PASS == 1) branch_b(p, G);
}

__device__ __forceinline__ void final_phase(const Params& p, int G) {
    const int lane = threadIdx.x & 63, gw = blockIdx.x * 8 + (threadIdx.x >> 6), NGW = G * 8;
    f32x4 gf[8];
#pragma unroll
    for (int j = 0; j < 8; ++j) gf[j] = ((const f32x4*)p.g_final)[lane + 64 * j];
    for (int r = gw; r < NB * SEQ + MSR; r += NGW) {
        f32x4* yr = (f32x4*)(p.out + (size_t)r * D) + lane;
        f32x4 v[8]; float s = 0.f;
#pragma unroll
        for (int j = 0; j < 8; ++j) { v[j] = yr[64 * j]; s += (v[j][0] * v[j][0] + v[j][1] * v[j][1]) + (v[j][2] * v[j][2] + v[j][3] * v[j][3]); }
        s = wave_sum(s);
        const float rs = __builtin_amdgcn_rsqf(s * (1.0f / D) + EPS);
#pragma unroll
        for (int j = 0; j < 8; ++j) yr[64 * j] = v[j] * rs * gf[j];
    }
}


#define XB_TMO      128
#define XB_XCNT(j)  (256  + 64 * (j))
#define XB_XSUB(j)  (1280 + 64 * (j))
#define XB_XGEN(j)  (2304 + 64 * (j))
#define XB_TOP      3328
#define XB_TOPGEN   3392
#define XCD_BAR_WORDS 3456
#define XB_SPIN_CAP (1u << 18)
__device__ __forceinline__ unsigned xb_ld(unsigned* p)              { return __hip_atomic_load(p, __ATOMIC_RELAXED, __HIP_MEMORY_SCOPE_AGENT); }
__device__ __forceinline__ unsigned xb_add(unsigned* p, unsigned v) { return __hip_atomic_fetch_add(p, v, __ATOMIC_RELAXED, __HIP_MEMORY_SCOPE_AGENT); }
__device__ __forceinline__ unsigned xb_xcc_id() { return (unsigned)__builtin_amdgcn_s_getreg((3 << 11) | 20) & 0xFu; }
#define XB_SPIN(cond, bar) do { unsigned _sp = 0; while (cond) { __builtin_amdgcn_s_sleep(1); \
    if ((++_sp & 255u) == 0u) { if (xb_ld(&(bar)[XB_TMO])) break; if (_sp > XB_SPIN_CAP) { atomicAdd(&(bar)[XB_TMO], 1u); break; } } } } while (0)
struct XcdBarrier { unsigned* bar; unsigned x; volatile LAS unsigned* st; };
__device__ __forceinline__ XcdBarrier xcd_barrier_post(unsigned* bar, volatile LAS unsigned* st) {
    XcdBarrier b; b.bar = bar; b.x = xb_xcc_id(); b.st = st;
    if (threadIdx.x == 0) (void)xb_add(&bar[XB_XCNT(b.x)], 1u);
    return b;
}
__device__ __forceinline__ void xcd_barrier_complete(unsigned* bar, unsigned x, unsigned& nloc, unsigned& nx) {
    const unsigned G = gridDim.x * gridDim.y * gridDim.z;
    unsigned sum, cnt, mine, sp = 0u;
    for (;;) {
        sum = 0u; cnt = 0u; mine = 0u;
#pragma unroll
        for (unsigned j = 0; j < 16; ++j) { const unsigned c = xb_ld(&bar[XB_XCNT(j)]); sum += c; cnt += (c > 0u) ? 1u : 0u; mine = (j == x) ? c : mine; }
        if (sum == G) break;
        __builtin_amdgcn_s_sleep(1);
        if ((++sp & 255u) == 0u) { if (xb_ld(&bar[XB_TMO])) break; if (sp > XB_SPIN_CAP) { atomicAdd(&bar[XB_TMO], 1u); break; } }
    }
    nloc = mine > 0u ? mine : 1u; nx = cnt > 0u ? cnt : 1u;
}
__device__ __forceinline__ void xcd_barrier(const XcdBarrier& b) {
    asm volatile("s_waitcnt vmcnt(0)" ::: "memory");
    __syncthreads();
    if (threadIdx.x == 0) {
        unsigned* bar = b.bar;
        __builtin_amdgcn_s_waitcnt(0);
        unsigned nloc = b.st[0], nx = b.st[1];
        if (nloc == 0u) { xcd_barrier_complete(bar, b.x, nloc, nx); b.st[0] = nloc; b.st[1] = nx; }
        const unsigned old = xb_add(&bar[XB_XSUB(b.x)], 1u);
        const unsigned gen = old / nloc;
        if (old + 1u == (gen + 1u) * nloc) {
            __builtin_amdgcn_fence(__ATOMIC_RELEASE, "agent");
            asm volatile("s_waitcnt vmcnt(0)" ::: "memory");
            const unsigned og = xb_add(&bar[XB_TOP], 1u);
            const unsigned tg = og / nx;
            if (og + 1u == (tg + 1u) * nx) xb_add(&bar[XB_TOPGEN], 1u);
            else XB_SPIN(xb_ld(&bar[XB_TOPGEN]) == tg, bar);
            __builtin_amdgcn_fence(__ATOMIC_ACQUIRE, "agent");
            xb_add(&bar[XB_XGEN(b.x)], 1u);
            asm volatile("s_waitcnt vmcnt(0)" ::: "memory");
        } else {
            XB_SPIN(xb_ld(&bar[XB_XGEN(b.x)]) == gen, bar);
            __builtin_amdgcn_fence(__ATOMIC_ACQUIRE, "agent");
            asm volatile("s_waitcnt vmcnt(0)" ::: "memory");
        }
    }
    __syncthreads();
}

constexpr int LDS_BYTES = 132096;
constexpr int N_PHASES = 8;
__global__ void __launch_bounds__(512, 2) hymba_fwd(Params p) {
    extern __shared__ __attribute__((aligned(16))) unsigned char lds_raw[];
    LAS unsigned char* lds = (LAS unsigned char*)lds_raw;
    const int G = gridDim.x;
    unsigned char* ws = p.ws;
    volatile LAS unsigned* misc = (volatile LAS unsigned*)(lds + 131072);
    if (threadIdx.x < 8) misc[threadIdx.x] = 0u;
    __syncthreads();
    XcdBarrier bar = xcd_barrier_post((unsigned*)ws, misc);
    const int lo = p.ph_lo, hi = p.ph_hi;
#ifndef PH_MASK
#define PH_MASK 0xff
#endif
#define IN(k) (((PH_MASK >> (k)) & 1) && lo <= (k) && (k) < hi)
#define SEAM(k) do { if (IN(k) && IN((k) + 1)) xcd_barrier(bar); } while (0)
#ifndef REP_MASK
#define REP_MASK 0x00
#endif
#define REPEAT(k) for (int rep_ = 0; rep_ < ((((REP_MASK) >> (k)) & 1) ? 2 : 1); ++rep_, (rep_ < ((((REP_MASK) >> (k)) & 1) ? 2 : 1) ? xcd_barrier(bar) : (void)0))
    if (IN(0)) REPEAT(0) phase0(p, lds, G);
    SEAM(0);
    if (IN(1)) REPEAT(1) {
        pg8::Gemm g{(const bf16_t*)(ws + WS_XB) + (size_t)16 * D, (const bf16_t*)(ws + WS_WIN), MP / 256, DIN / 256, D, (size_t)256 * D * 2, (size_t)128 * D * 2};
        pg8::StaticOrder S; S.init(g.nM, g.nN, G, (int)blockIdx.x);
        EpiZ E{(const float*)(ws + WS_RS1), (bf16_t*)(ws + WS_Z), p.out};
        pg8::gemm_phase<EpiZ, false, true, true>(lds, g, S, E);
    }
    SEAM(1);
    if (IN(2)) REPEAT(2) mixer_phase<1>(p, lds, G);
    SEAM(2);
    if (IN(3)) REPEAT(3) mixer_phase<2>(p, lds, G);
    SEAM(3);
    if (IN(4)) REPEAT(4) {
        pg8::Gemm g{(const bf16_t*)(ws + WS_YM), (const bf16_t*)(ws + WS_WO), MP / 256, D / 256, DMIX, (size_t)256 * DMIX * 2, (size_t)128 * DMIX * 2};
        pg8::StaticOrder S; S.init(g.nM, g.nN, G, (int)blockIdx.x);
        EpiX1 E{p.x_prompt, p.x_sample, p.meta, p.out, (bf16_t*)(ws + WS_XB) + (size_t)16 * D, (float*)(ws + WS_SSQ)};
        pg8::gemm_phase<EpiX1, false, true, true>(lds, g, S, E);
    }
    SEAM(4);
    if (IN(5)) REPEAT(5) {
        pg8::Gemm g{(const bf16_t*)(ws + WS_XB) + (size_t)14 * D, (const bf16_t*)(ws + WS_WUP), 37, 2 * DFF / 256, D, (size_t)252 * D * 2, (size_t)64 * D * 2};
        pg8::StaticOrder S; S.init(g.nM, g.nN, G, (int)blockIdx.x);
        EpiFFN E{(const float*)(ws + WS_SSQ), p.conv_f_w, p.conv_f_b, p.st_fc, (bf16_t*)(ws + WS_Z), p.out};
        pg8::gemm_phase<EpiFFN, true, true, true>(lds, g, S, E);
    }
    SEAM(5);
    if (IN(6)) {
        pg8::Gemm g{(const bf16_t*)(ws + WS_Z), (const bf16_t*)(ws + WS_WDN), MP / 256, D / 256, DFF, (size_t)256 * DFF * 2, (size_t)128 * DFF * 2};
        pg8::StaticOrder S; S.init(g.nM, g.nN, G, (int)blockIdx.x);
        EpiOut E{p.out};
        pg8::gemm_phase<EpiOut, false, true, true>(lds, g, S, E);
    }
    SEAM(6);
    if (IN(7)) final_phase(p, G);
#undef IN
#undef SEAM
}

extern "C" void kernel_launch(void* const* d_in, const int* in_sizes, int n_in, void* d_out, int out_size, void* d_ws, size_t ws_size, hipStream_t stream) {
    static int grid = 0;
    if (grid == 0) {
        if (n_in != 26 || (size_t)out_size != O_END || ws_size < WS_END) { fprintf(stderr, "kernel_launch: unexpected problem (n_in %d, out %d, ws %zu; need ws >= %zu)\n", n_in, out_size, ws_size, (size_t)WS_END); grid = -1; return; }
        int dev = 0, cus = 0, per_cu = 0;
        hipGetDevice(&dev); hipDeviceGetAttribute(&cus, hipDeviceAttributeMultiprocessorCount, dev);
        if (hipFuncSetAttribute((const void*)hymba_fwd, hipFuncAttributeMaxDynamicSharedMemorySize, LDS_BYTES) != hipSuccess) { fprintf(stderr, "kernel_launch: hipFuncSetAttribute failed\n"); grid = -1; return; }
        if (hipOccupancyMaxActiveBlocksPerMultiprocessor(&per_cu, (const void*)hymba_fwd, 512, LDS_BYTES) != hipSuccess || per_cu < 1) { fprintf(stderr, "kernel_launch: occupancy query says %d\n", per_cu); grid = -1; return; }
        grid = cus;
    }
    if (grid < 0) return;
    Params p{};
    const float** f = (const float**)&p;
    for (int i = 0; i < 26; ++i) f[i] = (const float*)d_in[i];
    p.out = (float*)d_out; p.ws = (unsigned char*)d_ws;
    if (hipMemsetAsync(d_ws, 0, XCD_BAR_WORDS * 4, stream) != hipSuccess) { fprintf(stderr, "kernel_launch: memset failed\n"); return; }
    if (MK_N_LAUNCHES == 1) {
        p.ph_lo = 0; p.ph_hi = N_PHASES;
        hipLaunchKernelGGL(hymba_fwd, dim3(grid), dim3(512), LDS_BYTES, stream, p);
    } else {
        for (int k = 0; k < N_PHASES; ++k) { p.ph_lo = k; p.ph_hi = k + 1; hipLaunchKernelGGL(hymba_fwd, dim3(grid), dim3(512), LDS_BYTES, stream, p); }
    }
}
```

```cpp
#include <hip/hip_runtime.h>
#include <cstdio>

#ifndef MK_N_LAUNCHES
#define MK_N_LAUNCHES 1
#endif

#define LAS __attribute__((address_space(3)))
#define CAS __attribute__((address_space(4)))
typedef unsigned short bf16_t;
typedef short bf16x8 __attribute__((ext_vector_type(8)));
typedef float f32x4 __attribute__((ext_vector_type(4)));
typedef unsigned u32x4 __attribute__((ext_vector_type(4)));
typedef unsigned u32x2 __attribute__((ext_vector_type(2)));

constexpr int D = 2048, NMETA = 16, SEQ = 2048, TP = SEQ + NMETA, NB = 4, MPR = NB * TP;
constexpr int NS = 128, TS = 8, MSR = NS * TS, M = MPR + MSR;
constexpr int MP = 9472;
constexpr int DA = 1536, DB = 1024, DIN = 6144, DMIX = 2560, DFF = 6144, NH = 12;
constexpr float EPS = 1e-6f;
constexpr int NCH = 33;
constexpr size_t O_YP = 0, O_YS = O_YP + (size_t)NB * SEQ * D, O_PH = O_YS + (size_t)MSR * D, O_PRC = O_PH + NB * DA,
                 O_PSC = O_PRC + NB * 3 * DA, O_PFC = O_PSC + NB * 2 * DB, O_SH = O_PFC + NB * 2 * DFF, O_SRC = O_SH + NS * DA,
                 O_SSC = O_SRC + (size_t)NS * 3 * DA, O_SFC = O_SSC + (size_t)NS * 2 * DB, O_END = O_SFC + (size_t)NS * 2 * DFF;
constexpr size_t MiB = 1u << 20;
constexpr int CW_TK6 = 4096, CTL_WORDS = 4096 + 128 * 64;
constexpr int P6_SPLIT = 4;
constexpr int GRID = 256;
constexpr size_t WS_WIN = 1 * MiB;
constexpr size_t WS_WO = WS_WIN + (size_t)DIN * D * 2;
constexpr size_t WS_WUP = WS_WO + (size_t)D * DMIX * 2;
constexpr size_t WS_WDN = WS_WUP + (size_t)2 * DFF * D * 2;
constexpr size_t WS_WG = WS_WDN + (size_t)D * DFF * 2;
constexpr size_t WS_XB = WS_WG + (size_t)2 * NH * 128 * 128 * 2;
constexpr size_t XB_ROWS = 9600;
constexpr size_t WS_Z = WS_XB + XB_ROWS * D * 2;
constexpr size_t WS_YM = WS_Z + (size_t)MP * DIN * 2;
constexpr size_t WS_RS1 = WS_YM + (size_t)MP * DMIX * 2;
constexpr size_t WS_SSQ = WS_RS1 + (size_t)MP * 4;
constexpr size_t WS_TOT = WS_SSQ + (size_t)MP * 32 * 4;
constexpr size_t WS_END = WS_TOT + (size_t)NB * NCH * DA * 2 * 4;

struct Params;
typedef const CAS Params& PRef;
struct Params {
    const float *x_prompt, *x_sample, *st_h, *st_rc, *st_sc, *st_fc, *meta, *g_mix, *w_in, *conv_a_w, *conv_a_b, *w_gate_a, *b_gate_a,
        *w_gate_x, *b_gate_x, *lam, *conv_b_w, *g_out_a, *g_out_b, *w_o, *g_ffn, *w_up, *conv_f_w, *conv_f_b, *w_down, *g_final;
    float* out; unsigned char* ws; int ph_lo, ph_hi;
};

__device__ __forceinline__ unsigned cvt_pk_bf16(float lo, float hi) { unsigned r; asm volatile("v_cvt_pk_bf16_f32 %0, %1, %2" : "=v"(r) : "v"(lo), "v"(hi)); return r; }
__device__ __forceinline__ float bf_lo(unsigned w) { return __builtin_bit_cast(float, w << 16); }
__device__ __forceinline__ float bf_hi(unsigned w) { return __builtin_bit_cast(float, w & 0xffff0000u); }
__device__ __forceinline__ void unpack8(const u32x4 w, float (&f)[8]) { f[0] = bf_lo(w.x); f[1] = bf_hi(w.x); f[2] = bf_lo(w.y); f[3] = bf_hi(w.y); f[4] = bf_lo(w.z); f[5] = bf_hi(w.z); f[6] = bf_lo(w.w); f[7] = bf_hi(w.w); }
__device__ __forceinline__ u32x4 pack8(const float (&f)[8]) { u32x4 w; w.x = cvt_pk_bf16(f[0], f[1]); w.y = cvt_pk_bf16(f[2], f[3]); w.z = cvt_pk_bf16(f[4], f[5]); w.w = cvt_pk_bf16(f[6], f[7]); return w; }
__device__ __forceinline__ float wave_sum(float v) {
#pragma unroll
    for (int o = 1; o < 64; o <<= 1) v += __shfl_xor(v, o);
    return v;
}
__device__ __forceinline__ float sum16(float v) {
    v += __shfl_xor(v, 1); v += __shfl_xor(v, 2); v += __shfl_xor(v, 4); v += __shfl_xor(v, 8); return v;
}
__device__ __forceinline__ float sigmoidf_(float x) { return __builtin_amdgcn_rcpf(1.0f + __expf(-x)); }
__device__ __forceinline__ float gelu_tanh(float x) {
    const float t = x * (1.0f + 0.044715f * x * x) * (-2.0f * 0.7978845608028654f * 1.4426950408889634f);
    return x * __builtin_amdgcn_rcpf(1.0f + __builtin_amdgcn_exp2f(t));
}
__device__ __forceinline__ int opaque_tid() { int t = threadIdx.x; asm volatile("" : "+v"(t)); return t; }
template <int CTRL> __device__ __forceinline__ float dppf(float old, float src) {
    return __builtin_bit_cast(float, __builtin_amdgcn_update_dpp(__builtin_bit_cast(int, old), __builtin_bit_cast(int, src), CTRL, 0xF, 0xF, false));
}
__device__ __forceinline__ void row_decode(int r, int& is_s, int& seq, int& t) {
    if (r < MPR) { seq = (r >= TP) + (r >= 2 * TP) + (r >= 3 * TP); t = r - seq * TP; is_s = 0; }
    else { const int q = r - MPR; seq = q >> 3; t = q & 7; is_s = 1; }
}
__device__ __forceinline__ const float* x_row_ptr(const float* xp, const float* xs, const float* meta, int r) {
    int is_s, seq, t; row_decode(r, is_s, seq, t);
    if (is_s) return xs + (size_t)(r - MPR) * D;
    return t < NMETA ? meta + (size_t)t * D : xp + ((size_t)seq * SEQ + (t - NMETA)) * D;
}
__device__ __forceinline__ float* y_row_ptr(float* out, int r) {
    if (r >= M) return nullptr;
    int is_s, seq, t; row_decode(r, is_s, seq, t);
    if (is_s) return out + O_YS + (size_t)(r - MPR) * D;
    return t < NMETA ? nullptr : out + O_YP + ((size_t)seq * SEQ + (t - NMETA)) * D;
}

namespace pg8 {
constexpr int BM = 256, BK = 64, HALF = 128, HTB = HALF * BK * 2, STAGE_BYTES = 8 * HTB, NXCD = 8, WGM = 8;
__host__ __device__ __forceinline__ int lds_byte(int r, int c) { const int st = (r >> 4) * 2 + (c >> 5), rr = r & 15, cc = c & 31, ob = rr * 64 + cc * 2; return st * 1024 + (ob ^ (((ob >> 9) & 1) << 5)); }
__host__ __device__ __forceinline__ void stage_rc(int b, int& R, int& C) { const int st = b / 1024, sb = b % 1024, swz = sb ^ (((sb >> 9) & 1) << 5); R = (st >> 1) * 16 + swz / 64; C = (st & 1) * 32 + (swz % 64) / 2; }
struct Unit { int pm, pn, kb, nk, piece, lu; };
struct Gemm { const bf16_t* A; const bf16_t* Bt; int nM, nN, K; size_t a_tstep, a_hstep; };
struct StaticOrder {
    int nM, nN, nwg, G, c, nt, split, nfull, nleft, limit = 1 << 20, first = 0;
    __device__ __forceinline__ void init(int nM_, int nN_, int G_, int c_, int nt_, int split_) { nM = nM_; nN = nN_; nwg = nM * nN; G = G_; c = c_; nt = nt_; nfull = (nwg / G) * G; nleft = nwg - nfull;
        split = (split_ > 1 && nleft > 0 && nleft * split_ <= G && (nt / split_) * split_ == nt && ((nt / split_) & 1) == 0) ? split_ : 1; }
    __device__ __forceinline__ void map(int L, Unit& u) const {
        int wgid = L; { const int q = nwg / NXCD, r = nwg % NXCD, xcd = wgid % NXCD, off = wgid / NXCD; wgid = (xcd < r ? xcd * (q + 1) : r * (q + 1) + (xcd - r) * q) + off; }
        const int nig = WGM * nN, gid = wgid / nig, rem = wgid - gid * nig, fm = gid * WGM, glast = nM % WGM;
        if (nM - fm >= WGM || glast == 0) { u.pm = fm + (rem & (WGM - 1)); u.pn = rem / WGM; }
        else { u.pm = fm + rem % glast; u.pn = rem / glast; }
    }
    __device__ __forceinline__ bool next(int i, Unit& u) const {
        u.kb = 0; u.nk = nt; u.piece = -1; u.lu = 0;
        i += first; if (i >= limit) return false;
        const long L = (long)i * G + c;
        if (L < nfull || split == 1) { if (L >= nwg) return false; map((int)L, u); return true; }
        if (L >= nfull + G || c >= nleft * split) return false;
        u.lu = c % nleft; u.piece = c / nleft; u.nk = nt / split; u.kb = u.piece * u.nk; map(nfull + u.lu, u); return true;
    }
};

template <int P, int A, int Mi>
__device__ __forceinline__ void reduce_rowgroup(f32x4 (&acc)[2][2][4][2], const float* slab0, int tid) {
    const float* sp = slab0 + (size_t)((A * 4 + Mi) * 4) * 8192 + tid * 4;
#pragma unroll
    for (int b = 0; b < 2; ++b)
#pragma unroll
        for (int n = 0; n < 2; ++n) {
            f32x4 sum = (f32x4){0.f, 0.f, 0.f, 0.f};
#pragma unroll
            for (int src = 0; src < 4; ++src) { if (src == P) sum += acc[A][b][Mi][n]; else sum += *(const f32x4*)(sp + (size_t)src * 8192 + (b * 2 + n) * 2048); }
            acc[A][b][Mi][n] = sum;
        }
}
template <class Epi, bool FFNMAP, bool ALIGN_EPI, bool SP2>
__device__ __forceinline__ void gemm_phase(LAS unsigned char* lds, const Gemm g, const StaticOrder& S, const Epi& E, float* slabs, unsigned* tickets, bool dry = false) {
    int tid = threadIdx.x; asm volatile("" : "+v"(tid));
    const int wid = __builtin_amdgcn_readfirstlane(tid >> 6), lane = tid & 63, wr = wid >> 2, wc = wid & 3, fr = lane & 15, fq = lane >> 4;
    const int K = g.K;
    unsigned voffA[2], voffB[2];
#pragma unroll
    for (int i = 0; i < 2; ++i) { int R, C; stage_rc(tid * 16 + i * 8192, R, C); const int Ra = FFNMAP ? (126 * (R >> 6) + (R & 63)) : R;
        voffA[i] = (unsigned)(Ra * K + C) * 2u; voffB[i] = (unsigned)(R * K + C) * 2u; }
    const size_t kstep = (size_t)(BK * 2);
    const size_t hstepA = g.a_hstep, tstepA = g.a_tstep;
    const size_t hstepB = (size_t)HALF * K * 2, tstepB = 2 * hstepB;
    const unsigned ldsw = (unsigned)wid * 1024u;
    const int aoff = lds_byte(wr * 64 + fr, fq * 8), boff = lds_byte(wc * 32 + fr, fq * 8);
#define PG8_SA(b, h) (((b) * 2 + (h)) * HTB)
#define PG8_SB(b, h) ((4 + (b) * 2 + (h)) * HTB)
#define PG8_STAGE(bufoff, gbase, voff) do { _Pragma("unroll") for (int _i = 0; _i < 2; ++_i) \
        __builtin_amdgcn_global_load_lds((const unsigned*)((const char*)(gbase) + (voff)[_i]), (LAS unsigned*)(lds + (bufoff) + ldsw + _i * 8192), 16, 0, 0); } while (0)
#define PG8_LDA(dst, b, h) do { _Pragma("unroll") for (int m = 0; m < 4; ++m) _Pragma("unroll") for (int k = 0; k < 2; ++k) dst[m][k] = *(const LAS bf16x8*)(lds + PG8_SA(b, h) + aoff + m * 2048 + k * 1024); } while (0)
#define PG8_LDB(dst, b, h) do { _Pragma("unroll") for (int n = 0; n < 2; ++n) _Pragma("unroll") for (int k = 0; k < 2; ++k) dst[n][k] = *(const LAS bf16x8*)(lds + PG8_SB(b, h) + boff + n * 2048 + k * 1024); } while (0)
#define PG8_MMA(ai, bj, At, Bt) do { __builtin_amdgcn_s_setprio(1); _Pragma("unroll") for (int m = 0; m < 4; ++m) _Pragma("unroll") for (int n = 0; n < 2; ++n) _Pragma("unroll") for (int k = 0; k < 2; ++k) \
        acc[ai][bj][m][n] = __builtin_amdgcn_mfma_f32_16x16x32_bf16(Bt[n][k], At[m][k], acc[ai][bj][m][n], 0, 0, 0); __builtin_amdgcn_s_setprio(0); } while (0)
#define PG8_WAIT_V(n) asm volatile("s_waitcnt vmcnt(" #n ")" ::: "memory")
#define PG8_WAIT_L(n) asm volatile("s_waitcnt lgkmcnt(" #n ")" ::: "memory")
#define PG8_BAR __builtin_amdgcn_s_barrier()
#define PG8_SCHED __builtin_amdgcn_sched_barrier(0)
    Unit cur, nxt; int ui = 0;
    if (!S.next(0, cur)) return;
    f32x4 acc[2][2][4][2];
#pragma unroll
    for (int a = 0; a < 2; ++a)
#pragma unroll
        for (int b = 0; b < 2; ++b)
#pragma unroll
            for (int m = 0; m < 4; ++m)
#pragma unroll
                for (int n = 0; n < 2; ++n) acc[a][b][m][n] = (f32x4){0.f, 0.f, 0.f, 0.f};
    bf16x8 At[4][2], B0[2][2], B1[2][2];
    const char* cA = (const char*)g.A + (size_t)cur.pm * tstepA + (size_t)cur.kb * kstep; const char* cB = (const char*)g.Bt + (size_t)cur.pn * tstepB + (size_t)cur.kb * kstep;
    if constexpr (SP2) {
        PG8_STAGE(PG8_SB(0, 0), cB, voffB); PG8_STAGE(PG8_SB(0, 1), cB + hstepB, voffB); PG8_STAGE(PG8_SA(0, 0), cA, voffA); PG8_STAGE(PG8_SA(0, 1), cA + hstepA, voffA);
        if (wr == 1) PG8_BAR;
        PG8_WAIT_V(2); PG8_BAR;
        PG8_STAGE(PG8_SB(1, 0), cB + kstep, voffB); PG8_STAGE(PG8_SA(1, 0), cA + kstep, voffA); PG8_STAGE(PG8_SB(1, 1), cB + hstepB + kstep, voffB);
        PG8_WAIT_V(6); PG8_BAR;
    } else {
        PG8_STAGE(PG8_SB(0, 0), cB, voffB); PG8_STAGE(PG8_SA(0, 0), cA, voffA); PG8_STAGE(PG8_SB(0, 1), cB + hstepB, voffB); PG8_STAGE(PG8_SA(0, 1), cA + hstepA, voffA);
        if (wr == 1) PG8_BAR;
        PG8_WAIT_V(4); PG8_BAR;
        PG8_STAGE(PG8_SB(1, 0), cB + kstep, voffB); PG8_STAGE(PG8_SA(1, 0), cA + kstep, voffA); PG8_STAGE(PG8_SB(1, 1), cB + hstepB + kstep, voffB);
        PG8_WAIT_V(6); PG8_BAR;
    }
    for (;;) {
        const bool has_next = S.next(ui + 1, nxt);
        const char* nA = has_next ? (const char*)g.A + (size_t)nxt.pm * tstepA + (size_t)nxt.kb * kstep : cA; const char* nB = has_next ? (const char*)g.Bt + (size_t)nxt.pn * tstepB + (size_t)nxt.kb * kstep : cB;
        const int nt = cur.nk;
        for (int t = 0; t < nt; t += 2) {
            const bool last = (t == nt - 2);
            const char* a1 = cA + (size_t)(t + 1) * kstep;
            const char* a2 = last ? nA : cA + (size_t)(t + 2) * kstep; const char* b2 = last ? nB : cB + (size_t)(t + 2) * kstep;
            const char* a3 = a2 + kstep; const char* b3 = b2 + kstep;
            if constexpr (SP2) {
            PG8_LDB(B0, 0, 0); PG8_LDB(B1, 0, 1); PG8_SCHED; PG8_LDA(At, 0, 0); PG8_STAGE(PG8_SA(1, 1), a1 + hstepA, voffA);
            PG8_WAIT_V(8); PG8_WAIT_L(0); PG8_BAR; PG8_MMA(0, 0, At, B0); PG8_MMA(0, 1, At, B1); PG8_BAR; PG8_SCHED;
            PG8_LDA(At, 0, 1); PG8_STAGE(PG8_SB(0, 0), b2, voffB); PG8_STAGE(PG8_SB(0, 1), b2 + hstepB, voffB); PG8_STAGE(PG8_SA(0, 0), a2, voffA);
            PG8_WAIT_V(8); PG8_WAIT_L(0); PG8_BAR; PG8_MMA(1, 0, At, B0); PG8_MMA(1, 1, At, B1); PG8_BAR; PG8_SCHED;
            PG8_LDB(B0, 1, 0); PG8_LDB(B1, 1, 1); PG8_SCHED; PG8_LDA(At, 1, 0); PG8_STAGE(PG8_SA(0, 1), a2 + hstepA, voffA);
            PG8_WAIT_V(8); PG8_WAIT_L(0); PG8_BAR; PG8_MMA(0, 0, At, B0); PG8_MMA(0, 1, At, B1); PG8_BAR; PG8_SCHED;
            PG8_LDA(At, 1, 1); PG8_STAGE(PG8_SB(1, 0), b3, voffB); PG8_STAGE(PG8_SB(1, 1), b3 + hstepB, voffB); PG8_STAGE(PG8_SA(1, 0), a3, voffA);
            PG8_WAIT_V(8); PG8_WAIT_L(0); PG8_BAR; PG8_MMA(1, 0, At, B0); PG8_MMA(1, 1, At, B1); PG8_BAR; PG8_SCHED;
            } else {
            PG8_LDB(B0, 0, 0); PG8_SCHED; PG8_LDA(At, 0, 0); PG8_STAGE(PG8_SA(1, 1), a1 + hstepA, voffA);
            PG8_WAIT_L(8); PG8_BAR; PG8_WAIT_L(0); PG8_MMA(0, 0, At, B0); PG8_BAR; PG8_SCHED;
            PG8_LDB(B1, 0, 1); PG8_STAGE(PG8_SB(0, 0), b2, voffB);
            PG8_BAR; PG8_WAIT_L(0); PG8_MMA(0, 1, At, B1); PG8_BAR;
            PG8_LDA(At, 0, 1); PG8_STAGE(PG8_SA(0, 0), a2, voffA);
            PG8_BAR; PG8_WAIT_L(0); PG8_MMA(1, 0, At, B0); PG8_BAR; PG8_SCHED;
            PG8_STAGE(PG8_SB(0, 1), b2 + hstepB, voffB);
            PG8_WAIT_V(6); PG8_BAR; PG8_MMA(1, 1, At, B1); PG8_BAR;
            PG8_LDB(B0, 1, 0); PG8_SCHED; PG8_LDA(At, 1, 0); PG8_STAGE(PG8_SA(0, 1), a2 + hstepA, voffA);
            PG8_WAIT_L(8); PG8_BAR; PG8_WAIT_L(0); PG8_MMA(0, 0, At, B0); PG8_BAR; PG8_SCHED;
            PG8_LDB(B1, 1, 1); PG8_STAGE(PG8_SB(1, 0), b3, voffB);
            PG8_BAR; PG8_WAIT_L(0); PG8_MMA(0, 1, At, B1); PG8_BAR;
            PG8_LDA(At, 1, 1); PG8_STAGE(PG8_SA(1, 0), a3, voffA);
            PG8_BAR; PG8_WAIT_L(0); PG8_MMA(1, 0, At, B0); PG8_BAR; PG8_SCHED;
            PG8_STAGE(PG8_SB(1, 1), b3 + hstepB, voffB);
            PG8_WAIT_V(6); PG8_BAR; PG8_MMA(1, 1, At, B1); PG8_BAR;
            }
        }
        if constexpr (ALIGN_EPI) { if (wr == 0) PG8_BAR; }
        if (cur.piece < 0 && !dry) E(acc, cur, wr, wc, fr, fq);
        if (!has_next) break;
#pragma unroll
        for (int a = 0; a < 2; ++a)
#pragma unroll
            for (int b = 0; b < 2; ++b)
#pragma unroll
                for (int m = 0; m < 4; ++m)
#pragma unroll
                    for (int n = 0; n < 2; ++n) acc[a][b][m][n] = (f32x4){0.f, 0.f, 0.f, 0.f};
        cur = nxt; cA = nA; cB = nB; ++ui;
        if constexpr (ALIGN_EPI) { if (wr == 1) PG8_BAR; }
    }
    PG8_WAIT_V(0);
    if constexpr (!ALIGN_EPI) { if (wr == 0) PG8_BAR; }
    PG8_BAR;
    if constexpr (Epi::SPLIT) {
    if (cur.piece >= 0 && !dry) {
        float* slab0 = slabs + (size_t)cur.lu * (8 * 4 * 8192);
        {
            const __amdgpu_buffer_rsrc_t rs = __builtin_amdgcn_make_buffer_rsrc((void*)slab0, (short)0, 8 * 4 * 32768, 0x00020000);
#pragma unroll
            for (int a = 0; a < 2; ++a)
#pragma unroll
                for (int m = 0; m < 4; ++m) {
                    const int gq = a * 4 + m;
                    if ((gq >> 1) != cur.piece) {
#pragma unroll
                        for (int b = 0; b < 2; ++b)
#pragma unroll
                            for (int n = 0; n < 2; ++n) __builtin_amdgcn_raw_buffer_store_b128(__builtin_bit_cast(u32x4, acc[a][b][m][n]), rs, (gq * 4 + cur.piece) * 32768 + (b * 2 + n) * 8192 + tid * 16, 0, 16);
                    }
                }
        }
        asm volatile("s_waitcnt vmcnt(0)" ::: "memory");
        __syncthreads();
        if (tid == 0) {
            __hip_atomic_fetch_add(tickets + 64 * cur.lu, 1u, __ATOMIC_RELAXED, __HIP_MEMORY_SCOPE_AGENT);
            unsigned sp = 0;
            while (__hip_atomic_load(tickets + 64 * cur.lu, __ATOMIC_RELAXED, __HIP_MEMORY_SCOPE_AGENT) < 4u) { __builtin_amdgcn_s_sleep(2); if (++sp > (1u << 20)) break; }
            __builtin_amdgcn_fence(__ATOMIC_ACQUIRE, "agent"); asm volatile("s_waitcnt vmcnt(0)" ::: "memory");
        }
        __syncthreads();
        switch (cur.piece) {
            case 0: reduce_rowgroup<0, 0, 0>(acc, slab0, tid); reduce_rowgroup<0, 0, 1>(acc, slab0, tid); break;
            case 1: reduce_rowgroup<1, 0, 2>(acc, slab0, tid); reduce_rowgroup<1, 0, 3>(acc, slab0, tid); break;
            case 2: reduce_rowgroup<2, 1, 0>(acc, slab0, tid); reduce_rowgroup<2, 1, 1>(acc, slab0, tid); break;
            default: reduce_rowgroup<3, 1, 2>(acc, slab0, tid); reduce_rowgroup<3, 1, 3>(acc, slab0, tid); break;
        }
        E(acc, cur, wr, wc, fr, fq, 3u << (2 * cur.piece));
    }
    }
#undef PG8_SA
#undef PG8_SB
#undef PG8_STAGE
#undef PG8_LDA
#undef PG8_LDB
#undef PG8_MMA
#undef PG8_WAIT_V
#undef PG8_WAIT_L
#undef PG8_BAR
#undef PG8_SCHED
}
}

typedef f32x4 Acc[2][2][4][2];

struct EpiZ {
    static constexpr bool SPLIT = false;
    const float* rstd1; bf16_t* z; float* out;
    __device__ __forceinline__ void operator()(const Acc& acc, const pg8::Unit& u, int wr, int wc, int fr, int fq) const {
        asm volatile("" : "+v"(fr), "+v"(fq));
        const int col0 = u.pn * 256 + wc * 32 + 8 * fq;
#pragma unroll
        for (int ai = 0; ai < 2; ++ai)
#pragma unroll
            for (int m = 0; m < 4; ++m) {
                const int r = u.pm * 256 + ai * 128 + wr * 64 + m * 16 + fr;
                if (r < M) {
                    const float rs = rstd1[r];
                    int is_s, seq, t; row_decode(r, is_s, seq, t);
                    float* so = nullptr;
                    if (u.pn < 6) { if (is_s) { if (t >= TS - 3) so = out + O_SRC + ((size_t)seq * 3 + (t - (TS - 3))) * DA; } else { if (t >= TP - 3) so = out + O_PRC + ((size_t)seq * 3 + (t - (TP - 3))) * DA; } }
#pragma unroll
                    for (int bj = 0; bj < 2; ++bj) {
                        const f32x4 v0 = acc[ai][bj][m][0] * rs, v1 = acc[ai][bj][m][1] * rs;
                        u32x4 w; w.x = cvt_pk_bf16(v0[0], v0[1]); w.y = cvt_pk_bf16(v0[2], v0[3]); w.z = cvt_pk_bf16(v1[0], v1[1]); w.w = cvt_pk_bf16(v1[2], v1[3]);
                        *(u32x4*)(z + (size_t)r * DIN + col0 + bj * 128) = w;
                        if (so) { *(f32x4*)(so + col0 + bj * 128) = v0; *(f32x4*)(so + col0 + bj * 128 + 4) = v1; }
                    }
                }
            }
    }
};
struct EpiX1 {
    static constexpr bool SPLIT = true;
    const float *xp, *xs, *meta; float* out; bf16_t* x1b; float* ssq;
    __device__ __forceinline__ void operator()(const Acc& acc, const pg8::Unit& u, int wr, int wc, int fr, int fq, unsigned gmask = 0xffu) const {
        asm volatile("" : "+v"(fr), "+v"(fq));
        const int col0 = u.pn * 256 + wc * 32 + 8 * fq;
#pragma unroll
        for (int ai = 0; ai < 2; ++ai)
#pragma unroll
            for (int m = 0; m < 4; ++m) {
                if (!((gmask >> (ai * 4 + m)) & 1u)) continue;
                const int r = u.pm * 256 + ai * 128 + wr * 64 + m * 16 + fr;
                const bool valid = r < M;
                const float* xr = x_row_ptr(xp, xs, meta, valid ? r : 0);
                float* yd = y_row_ptr(out, r);
                float ss = 0.f;
#pragma unroll
                for (int bj = 0; bj < 2; ++bj) {
                    const int c = col0 + bj * 128;
                    const f32x4 v0 = acc[ai][bj][m][0] + *(const f32x4*)(xr + c), v1 = acc[ai][bj][m][1] + *(const f32x4*)(xr + c + 4);
                    ss += (v0[0] * v0[0] + v0[1] * v0[1]) + (v0[2] * v0[2] + v0[3] * v0[3]) + (v1[0] * v1[0] + v1[1] * v1[1]) + (v1[2] * v1[2] + v1[3] * v1[3]);
                    if (yd) { *(f32x4*)(yd + c) = v0; *(f32x4*)(yd + c + 4) = v1; }
                    if (valid) { u32x4 w; w.x = cvt_pk_bf16(v0[0], v0[1]); w.y = cvt_pk_bf16(v0[2], v0[3]); w.z = cvt_pk_bf16(v1[0], v1[1]); w.w = cvt_pk_bf16(v1[2], v1[3]);
                        *(u32x4*)(x1b + (size_t)r * D + c) = w; }
                }
                ss += __shfl_xor(ss, 16); ss += __shfl_xor(ss, 32);
                if (valid && fq == 0) ssq[(size_t)r * 32 + u.pn * 4 + wc] = ss;
            }
    }
};
struct EpiOut {
    static constexpr bool SPLIT = true;
    float* out;
    __device__ __forceinline__ void operator()(const Acc& acc, const pg8::Unit& u, int wr, int wc, int fr, int fq, unsigned gmask = 0xffu) const {
        asm volatile("" : "+v"(fr), "+v"(fq));
        const int col0 = u.pn * 256 + wc * 32 + 8 * fq;
#pragma unroll
        for (int ai = 0; ai < 2; ++ai)
#pragma unroll
            for (int m = 0; m < 4; ++m) {
                if (!((gmask >> (ai * 4 + m)) & 1u)) continue;
                const int r = u.pm * 256 + ai * 128 + wr * 64 + m * 16 + fr;
                float* yd = y_row_ptr(out, r);
                if (yd) {
#pragma unroll
                    for (int bj = 0; bj < 2; ++bj) {
                        const int c = col0 + bj * 128;
                        const f32x4 v0 = acc[ai][bj][m][0] + *(const f32x4*)(yd + c), v1 = acc[ai][bj][m][1] + *(const f32x4*)(yd + c + 4);
                        *(f32x4*)(yd + c) = v0; *(f32x4*)(yd + c + 4) = v1;
                    }
                }
            }
    }
};
struct EpiFFN {
    static constexpr bool SPLIT = false;
    const float *ssq, *cw, *cb, *st_fc; bf16_t* hid; float* out;
    __device__ __forceinline__ void operator()(Acc& acc, const pg8::Unit& u, int wr, int wc, int fr, int fq) const {
        asm volatile("" : "+v"(fr), "+v"(fq));
        const int gbase = 252 * u.pm - 2 + 126 * wr;
        const int f0 = 128 * u.pn + 32 * wc + 8 * fq;
#pragma unroll
        for (int ai = 0; ai < 2; ++ai)
#pragma unroll
            for (int m = 0; m < 4; ++m) {
                int r = gbase + 64 * ai + 16 * m + fr; r = r < 0 ? 0 : (r >= M ? M - 1 : r);
                const float* sp = ssq + (size_t)r * 32 + 8 * fq;
                const f32x4 a = *(const f32x4*)sp, b = *(const f32x4*)(sp + 4);
                float s = ((a[0] + a[1]) + (a[2] + a[3])) + ((b[0] + b[1]) + (b[2] + b[3]));
                s += __shfl_xor(s, 16); s += __shfl_xor(s, 32);
                const float rs = __builtin_amdgcn_rsqf(s * (1.0f / D) + EPS);
#pragma unroll
                for (int bj = 0; bj < 2; ++bj)
#pragma unroll
                    for (int n = 0; n < 2; ++n) acc[ai][bj][m][n] *= rs;
                if (m & 1) __builtin_amdgcn_sched_barrier(0);
            }
        const f32x4 w0a = *(const f32x4*)(cw + f0), w0b = *(const f32x4*)(cw + f0 + 4);
        const f32x4 w1a = *(const f32x4*)(cw + DFF + f0), w1b = *(const f32x4*)(cw + DFF + f0 + 4);
        const f32x4 w2a = *(const f32x4*)(cw + 2 * DFF + f0), w2b = *(const f32x4*)(cw + 2 * DFF + f0 + 4);
        const f32x4 bba = *(const f32x4*)(cb + f0), bbb = *(const f32x4*)(cb + f0 + 4);
#pragma unroll
        for (int ai = 0; ai < 2; ++ai)
#pragma unroll
            for (int m = 0; m < 4; ++m) {
                const int j = 64 * ai + 16 * m + fr, r = gbase + j;
                const bool valid = (j >= 2) && (r < M);
                const f32x4 c0 = acc[ai][0][m][0], c1 = acc[ai][0][m][1];
                const int pai = (m == 0) ? (ai == 0 ? 0 : ai - 1) : ai, pm_ = (m == 0) ? (ai == 0 ? 0 : 3) : m - 1;
                const f32x4 q0 = acc[pai][0][pm_][0], q1 = acc[pai][0][pm_][1];
                f32x4 p1a, p1b, p2a, p2b;
#pragma unroll
                for (int e = 0; e < 4; ++e) {
                    p1a[e] = dppf<0x111>(dppf<0x121>(0.f, q0[e]), c0[e]); p1b[e] = dppf<0x111>(dppf<0x121>(0.f, q1[e]), c1[e]);
                    p2a[e] = dppf<0x112>(dppf<0x122>(0.f, q0[e]), c0[e]); p2b[e] = dppf<0x112>(dppf<0x122>(0.f, q1[e]), c1[e]);
                }
                int is_s, seq, t; row_decode(valid ? r : 0, is_s, seq, t);
                if (valid && t < 2) {
                    f32x4 s0a = (f32x4){0.f, 0.f, 0.f, 0.f}, s0b = s0a, s1a = s0a, s1b = s0a;
                    if (is_s) { const float* sp = st_fc + (size_t)seq * 2 * DFF + f0; s0a = *(const f32x4*)sp; s0b = *(const f32x4*)(sp + 4); s1a = *(const f32x4*)(sp + DFF); s1b = *(const f32x4*)(sp + DFF + 4); }
                    if (t == 0) { p1a = s1a; p1b = s1b; p2a = s0a; p2b = s0b; } else { p2a = s1a; p2b = s1b; }
                }
                const f32x4 ga = w0a * p2a + w1a * p1a + w2a * c0 + bba, gb = w0b * p2b + w1b * p1b + w2b * c1 + bbb;
                const f32x4 va = acc[ai][1][m][0], vb = acc[ai][1][m][1];
                if (valid) {
                    u32x4 w;
                    w.x = cvt_pk_bf16(gelu_tanh(ga[0]) * va[0], gelu_tanh(ga[1]) * va[1]); w.y = cvt_pk_bf16(gelu_tanh(ga[2]) * va[2], gelu_tanh(ga[3]) * va[3]);
                    w.z = cvt_pk_bf16(gelu_tanh(gb[0]) * vb[0], gelu_tanh(gb[1]) * vb[1]); w.w = cvt_pk_bf16(gelu_tanh(gb[2]) * vb[2], gelu_tanh(gb[3]) * vb[3]);
                    *(u32x4*)(hid + (size_t)r * DFF + f0) = w;
                    const int T = is_s ? TS : TP;
                    if (t >= T - 2) { float* so = out + (is_s ? O_SFC : O_PFC) + ((size_t)seq * 2 + (t - (T - 2))) * DFF + f0; *(f32x4*)so = c0; *(f32x4*)(so + 4) = c1; }
                }
                __builtin_amdgcn_sched_barrier(0);
            }
    }
};

__device__ __forceinline__ int invperm32(int q) { return 16 * ((q >> 2) & 1) + 4 * (q >> 3) + (q & 3); }
__device__ __forceinline__ void p0_transpose_item(const float* W, int K, int N, const float* kscale, bf16_t* WT, int mode, LAS float* scr, int item, int lane) {
    const int nblk = N / 32, kb = item / nblk, nb = item % nblk, k0 = 64 * kb, n0 = 32 * nb;
    float v[32];
    const float* src = W + (size_t)(k0 + (lane >> 5)) * N + n0 + (lane & 31);
#pragma unroll
    for (int i = 0; i < 32; ++i) v[i] = src[(size_t)(2 * i) * N];
#pragma unroll
    for (int i = 0; i < 32; ++i) scr[(2 * i + (lane >> 5)) * 33 + (lane & 31)] = v[i];
    asm volatile("s_waitcnt lgkmcnt(0)" ::: "memory");
    int rbase = n0;
    if (mode == 1) { const int bj = n0 >= DFF ? 1 : 0, f = n0 - bj * DFF; rbase = 256 * (f >> 7) + 128 * bj + (f & 96); }
    const int c = lane & 7;
    f32x4 ks0 = (f32x4){1.f, 1.f, 1.f, 1.f}, ks1 = ks0;
    if (kscale) { ks0 = *(const f32x4*)(kscale + k0 + 8 * c); ks1 = *(const f32x4*)(kscale + k0 + 8 * c + 4); }
#pragma unroll
    for (int j = 0; j < 4; ++j) { const int n = (lane >> 3) + 8 * j; const LAS float* sp = scr + (8 * c) * 33 + n;
        u32x4 o; o.x = cvt_pk_bf16(sp[0 * 33] * ks0[0], sp[1 * 33] * ks0[1]); o.y = cvt_pk_bf16(sp[2 * 33] * ks0[2], sp[3 * 33] * ks0[3]);
        o.z = cvt_pk_bf16(sp[4 * 33] * ks1[0], sp[5 * 33] * ks1[1]); o.w = cvt_pk_bf16(sp[6 * 33] * ks1[2], sp[7 * 33] * ks1[3]);
        *(u32x4*)(WT + (size_t)(rbase + (mode == 2 ? n : invperm32(n))) * K + k0 + 8 * c) = o; }
    asm volatile("s_waitcnt lgkmcnt(0)" ::: "memory");
}
constexpr int I_IN = (D / 64) * (DIN / 32), I_O = (DMIX / 64) * (D / 32), I_UP = (D / 64) * (2 * DFF / 32), I_DN = (DFF / 64) * (D / 32), I_G = 2 * NH * 8;
constexpr int IT_O = I_IN, IT_UP = IT_O + I_O, IT_DN = IT_UP + I_UP, IT_G = IT_DN + I_DN, IT_END = IT_G + I_G;
__device__ __forceinline__ void convert_items(PRef p, LAS unsigned char* lds, int rank, int nwaves, int lo, int hi) {
    const int tid_ = opaque_tid(), lane = tid_ & 63, wave = tid_ >> 6;
    unsigned char* ws = p.ws;
    LAS float* scr = (LAS float*)(lds + wave * 16384);
    for (int it = lo + rank; it < hi; it += nwaves) {
        int r = it;
        if (r < I_IN) { p0_transpose_item(p.w_in, D, DIN, p.g_mix, (bf16_t*)(ws + WS_WIN), 0, scr, r, lane); continue; } r -= I_IN;
        if (r < I_O) { p0_transpose_item(p.w_o, DMIX, D, nullptr, (bf16_t*)(ws + WS_WO), 0, scr, r, lane); continue; } r -= I_O;
        if (r < I_UP) { p0_transpose_item(p.w_up, D, 2 * DFF, p.g_ffn, (bf16_t*)(ws + WS_WUP), 1, scr, r, lane); continue; } r -= I_UP;
        if (r < I_DN) { p0_transpose_item(p.w_down, DFF, D, nullptr, (bf16_t*)(ws + WS_WDN), 0, scr, r, lane); continue; } r -= I_DN;
        { const int mat = r >> 3, sub = r & 7, gsel = mat / NH, n = mat % NH;
          p0_transpose_item((gsel ? p.w_gate_x : p.w_gate_a) + (size_t)n * 128 * 128, 128, 128, nullptr, (bf16_t*)(ws + WS_WG) + (size_t)mat * 128 * 128, 0, scr, sub, lane); }
    }
}
constexpr int P1_TAIL_WG0 = (888 % 256), P4_TAIL_WG0 = (296 % 256), MIX_IDLE_WG0 = 228, IT_S1 = IT_O + 9000, IT_S2 = IT_S1 + 2400, IT_S3 = IT_S2 + 2400;
__device__ __forceinline__ void phase0(PRef p, LAS unsigned char* lds, int G) {
    const int tid = opaque_tid(), lane = tid & 63, wave = tid >> 6;
    unsigned char* ws = p.ws;
    const int gw = blockIdx.x * 8 + wave, NGW = G * 8;
    convert_items(p, lds, gw, NGW, 0, IT_O);
    convert_items(p, lds, gw, NGW, IT_G, IT_END);
    { bf16_t* xb = (bf16_t*)(ws + WS_XB) + (size_t)16 * D; float* rstd1 = (float*)(ws + WS_RS1);
      for (int m = gw; m < M; m += NGW) {
          const f32x4* xr = (const f32x4*)x_row_ptr(p.x_prompt, p.x_sample, p.meta, m) + lane;
          f32x4 v[8]; float s = 0.f;
#pragma unroll
          for (int j = 0; j < 8; ++j) { v[j] = xr[64 * j]; s += (v[j][0] * v[j][0] + v[j][1] * v[j][1]) + (v[j][2] * v[j][2] + v[j][3] * v[j][3]); }
          s = wave_sum(s);
          if (lane == 0) rstd1[m] = __builtin_amdgcn_rsqf(s * (1.0f / D) + EPS);
          u32x2* o = (u32x2*)(xb + (size_t)m * D) + lane;
#pragma unroll
          for (int j = 0; j < 8; ++j) { u32x2 w; w.x = cvt_pk_bf16(v[j][0], v[j][1]); w.y = cvt_pk_bf16(v[j][2], v[j][3]); o[64 * j] = w; }
      } }
}

__device__ __forceinline__ void branch_b(PRef p, int G) {
    const bf16_t* z = (const bf16_t*)(p.ws + WS_Z); bf16_t* ym = (bf16_t*)(p.ws + WS_YM);
    const int total = M * 128;
    for (int idx = blockIdx.x * 512 + opaque_tid(); idx < total; idx += G * 512) {
        const int m = idx >> 7, g = idx & 127, ch = 8 * g;
        int is_s, seq, t; row_decode(m, is_s, seq, t);
        float u[3][8];
#pragma unroll
        for (int k = 0; k < 3; ++k) {
            const int tt = t - 2 + k;
            if (tt >= 0) {
                float a[8], b[8];
                unpack8(*(const u32x4*)(z + (size_t)(m - 2 + k) * DIN + 4096 + ch), a); unpack8(*(const u32x4*)(z + (size_t)(m - 2 + k) * DIN + 5120 + ch), b);
#pragma unroll
                for (int e = 0; e < 8; ++e) u[k][e] = a[e] * b[e];
            } else if (is_s) {
                const float* sp = p.st_sc + ((size_t)seq * 2 + (tt + 2)) * DB + ch; const f32x4 a = *(const f32x4*)sp, b = *(const f32x4*)(sp + 4);
#pragma unroll
                for (int e = 0; e < 4; ++e) { u[k][e] = a[e]; u[k][4 + e] = b[e]; }
            } else {
#pragma unroll
                for (int e = 0; e < 8; ++e) u[k][e] = 0.f;
            }
        }
        float gb[8]; unpack8(*(const u32x4*)(z + (size_t)m * DIN + 3072 + ch), gb);
        float y[8]; float ss = 0.f;
#pragma unroll
        for (int e = 0; e < 8; ++e) {
            const float uc = p.conv_b_w[ch + e] * u[0][e] + p.conv_b_w[DB + ch + e] * u[1][e] + p.conv_b_w[2 * DB + ch + e] * u[2][e];
            y[e] = gb[e] * uc; ss += y[e] * y[e];
        }
        ss = sum16(ss);
        const float rn = __builtin_amdgcn_rsqf(ss * (1.0f / 128.0f) + EPS);
#pragma unroll
        for (int e = 0; e < 8; ++e) y[e] = y[e] * rn * p.g_out_b[ch + e];
        *(u32x4*)(ym + (size_t)m * DMIX + DA + ch) = pack8(y);
        const int T = is_s ? TS : TP;
        if (t >= T - 2) { float* so = p.out + (is_s ? O_SSC : O_PSC) + ((size_t)seq * 2 + (t - (T - 2))) * DB + ch;
            *(f32x4*)so = (f32x4){u[2][0], u[2][1], u[2][2], u[2][3]}; *(f32x4*)(so + 4) = (f32x4){u[2][4], u[2][5], u[2][6], u[2][7]}; }
    }
}

constexpr int LW_STRIDE = 272, L_WA = 0, L_WX = 128 * LW_STRIDE, L_CT = 2 * 128 * LW_STRIDE, L_LRU_END = L_CT + 9 * 128 * 4;
static_assert(L_LRU_END <= 131072, "mixer LDS");
constexpr int LRU_WG_PER_HEAD = 19, LRU_NSEG = 33, LRU_PITEMS = NB * LRU_NSEG, LRU_SITEMS = MSR / 64;
static_assert(LRU_WG_PER_HEAD * 8 >= LRU_PITEMS + LRU_SITEMS, "waves per head");

template <int CTRL, int BANK> __device__ __forceinline__ float dppfb(float old, float src) {
    return __builtin_bit_cast(float, __builtin_amdgcn_update_dpp(__builtin_bit_cast(int, old), __builtin_bit_cast(int, src), CTRL, 0xF, BANK, false));
}
__device__ __forceinline__ float bcast15(float x, int lane) {
    return __builtin_bit_cast(float, __builtin_amdgcn_ds_bpermute(((lane & 48) | 15) << 2, __builtin_bit_cast(int, x)));
}
__device__ __forceinline__ void scan16(float& P, float& S) {
    float Sd, Pd;
    Sd = dppf<0x111>(0.f, S); Pd = dppf<0x111>(1.f, P); S = __builtin_fmaf(P, Sd, S); P *= Pd;
    Sd = dppf<0x112>(0.f, S); Pd = dppf<0x112>(1.f, P); S = __builtin_fmaf(P, Sd, S); P *= Pd;
    Sd = dppf<0x114>(0.f, S); Pd = dppf<0x114>(1.f, P); S = __builtin_fmaf(P, Sd, S); P *= Pd;
    Sd = dppf<0x118>(0.f, S); Pd = dppf<0x118>(1.f, P); S = __builtin_fmaf(P, Sd, S); P *= Pd;
}
__device__ __forceinline__ void scan8(float& P, float& S, int t) {
    float Sd, Pd;
    Sd = dppf<0x111>(0.f, S); Pd = dppf<0x111>(1.f, P); if (t < 1) { Sd = 0.f; Pd = 1.f; } S = __builtin_fmaf(P, Sd, S); P *= Pd;
    Sd = dppf<0x112>(0.f, S); Pd = dppf<0x112>(1.f, P); if (t < 2) { Sd = 0.f; Pd = 1.f; } S = __builtin_fmaf(P, Sd, S); P *= Pd;
    Sd = dppfb<0x114, 0xA>(0.f, S); Pd = dppfb<0x114, 0xA>(1.f, P); S = __builtin_fmaf(P, Sd, S); P *= Pd;
}

template <int PASS, bool IS_S>
__device__ __forceinline__ void lru_wave_item(PRef p, LAS unsigned char* lds, int n, int b, int seg) {
    const int lane = opaque_tid() & 63, fr = lane & 15, fq = lane >> 4;
    const bf16_t* z = (const bf16_t*)(p.ws + WS_Z);
    bf16_t* ym = (bf16_t*)(p.ws + WS_YM);
    float* tot = (float*)(p.ws + WS_TOT);
    const LAS float* CT = (const LAS float*)(lds + L_CT) + 8 * fq;
    const int gch = n * 128 + 8 * fq;
    const int r0 = IS_S ? MPR + b * 64 : b * TP + seg * 64;
    const int nblk = IS_S ? 4 : (seg == LRU_NSEG - 1 ? 1 : 4);
    float hin[4][8], Pt[4][8];
    u32x4 prevx[4];
#pragma unroll
    for (int ks = 0; ks < 4; ++ks) {
#pragma unroll
        for (int e = 0; e < 8; ++e) { hin[ks][e] = 0.f; Pt[ks][e] = 1.f; }
        prevx[ks] = (u32x4){0u, 0u, 0u, 0u};
    }
    if constexpr (!IS_S) {
        if (seg > 0) {
#pragma unroll
            for (int ks = 0; ks < 4; ++ks) prevx[ks] = *(const u32x4*)(z + (size_t)(r0 - 16 + fr) * DIN + gch + 32 * ks);
            if constexpr (PASS == 2) {
#pragma unroll 1
                for (int round = 0; round < 2; ++round) {
                    const int s = 16 * round + fr;
                    if (16 * round >= seg) break;
                    const bool have = s < seg;
                    const float* tp = tot + ((size_t)(b * LRU_NSEG + (have ? s : 0)) * 2) * DA + gch;
#pragma unroll
                    for (int ks = 0; ks < 4; ++ks) {
                        const f32x4 P0 = *(const f32x4*)(tp + 32 * ks), P1 = *(const f32x4*)(tp + 32 * ks + 4), S0 = *(const f32x4*)(tp + DA + 32 * ks), S1 = *(const f32x4*)(tp + DA + 32 * ks + 4);
#pragma unroll
                        for (int e = 0; e < 8; ++e) {
                            float P = have ? (e < 4 ? P0[e & 3] : P1[e & 3]) : 1.f, S = have ? (e < 4 ? S0[e & 3] : S1[e & 3]) : 0.f;
                            scan16(P, S);
                            const float Pc = bcast15(P, lane), Sc = bcast15(S, lane);
                            hin[ks][e] = __builtin_fmaf(Pc, hin[ks][e], Sc);
                        }
                    }
                }
            }
        }
    }
#pragma unroll 1
    for (int blk = 0; blk < nblk; ++blk) {
        const int r = r0 + 16 * blk + fr;
        const int t8 = fr & 7, sq = (r - MPR) >> 3;
        u32x4 x4[4], g4[4];
#pragma unroll
        for (int ks = 0; ks < 4; ++ks) { x4[ks] = *(const u32x4*)(z + (size_t)r * DIN + gch + 32 * ks); if constexpr (PASS == 2) g4[ks] = *(const u32x4*)(z + (size_t)r * DIN + DA + gch + 32 * ks); }
        float xc[4][8];
        bf16x8 bfrag[4];
#pragma unroll
        for (int ks = 0; ks < 4; ++ks) {
            float xf[8]; unpack8(x4[ks], xf);
            const f32x4 w0a = *(const LAS f32x4*)(CT + 0 * 128 + 32 * ks), w0b = *(const LAS f32x4*)(CT + 0 * 128 + 32 * ks + 4);
            const f32x4 w1a = *(const LAS f32x4*)(CT + 1 * 128 + 32 * ks), w1b = *(const LAS f32x4*)(CT + 1 * 128 + 32 * ks + 4);
            const f32x4 w2a = *(const LAS f32x4*)(CT + 2 * 128 + 32 * ks), w2b = *(const LAS f32x4*)(CT + 2 * 128 + 32 * ks + 4);
            const f32x4 w3a = *(const LAS f32x4*)(CT + 3 * 128 + 32 * ks), w3b = *(const LAS f32x4*)(CT + 3 * 128 + 32 * ks + 4);
            const f32x4 cba = *(const LAS f32x4*)(CT + 4 * 128 + 32 * ks), cbb = *(const LAS f32x4*)(CT + 4 * 128 + 32 * ks + 4);
            if constexpr (IS_S) {
                const float* sp = p.st_rc + (size_t)sq * 3 * DA + gch + 32 * ks;
                const f32x4 b0a = *(const f32x4*)sp, b0b = *(const f32x4*)(sp + 4), b1a = *(const f32x4*)(sp + DA), b1b = *(const f32x4*)(sp + DA + 4), b2a = *(const f32x4*)(sp + 2 * DA), b2b = *(const f32x4*)(sp + 2 * DA + 4);
#pragma unroll
                for (int e = 0; e < 8; ++e) {
                    const float bb0 = e < 4 ? b0a[e & 3] : b0b[e & 3], bb1 = e < 4 ? b1a[e & 3] : b1b[e & 3], bb2 = e < 4 ? b2a[e & 3] : b2b[e & 3];
                    const float s1 = dppf<0x111>(0.f, xf[e]), s2 = dppf<0x112>(0.f, xf[e]), s3 = dppf<0x113>(0.f, xf[e]);
                    const float x1 = t8 >= 1 ? s1 : bb2;
                    const float x2 = t8 >= 2 ? s2 : (t8 == 1 ? bb2 : bb1);
                    const float x3 = t8 >= 3 ? s3 : (t8 == 2 ? bb2 : (t8 == 1 ? bb1 : bb0));
                    const float w0 = e < 4 ? w0a[e & 3] : w0b[e & 3], w1 = e < 4 ? w1a[e & 3] : w1b[e & 3], w2 = e < 4 ? w2a[e & 3] : w2b[e & 3], w3 = e < 4 ? w3a[e & 3] : w3b[e & 3];
                    xc[ks][e] = (e < 4 ? cba[e & 3] : cbb[e & 3]) + w3 * xf[e] + w2 * x1 + w1 * x2 + w0 * x3;
                }
            } else {
                float pf[8]; unpack8(prevx[ks], pf);
#pragma unroll
                for (int e = 0; e < 8; ++e) {
                    const float x1 = dppf<0x111>(dppf<0x121>(0.f, pf[e]), xf[e]);
                    const float x2 = dppf<0x112>(dppf<0x122>(0.f, pf[e]), xf[e]);
                    const float x3 = dppf<0x113>(dppf<0x123>(0.f, pf[e]), xf[e]);
                    const float w0 = e < 4 ? w0a[e & 3] : w0b[e & 3], w1 = e < 4 ? w1a[e & 3] : w1b[e & 3], w2 = e < 4 ? w2a[e & 3] : w2b[e & 3], w3 = e < 4 ? w3a[e & 3] : w3b[e & 3];
                    xc[ks][e] = (e < 4 ? cba[e & 3] : cbb[e & 3]) + w3 * xf[e] + w2 * x1 + w1 * x2 + w0 * x3;
                }
                prevx[ks] = x4[ks];
            }
            bfrag[ks] = __builtin_bit_cast(bf16x8, pack8(xc[ks]));
        }
        f32x4 aa[8], ax[8];
#pragma unroll
        for (int nb = 0; nb < 8; ++nb) { aa[nb] = (f32x4){0.f, 0.f, 0.f, 0.f}; ax[nb] = (f32x4){0.f, 0.f, 0.f, 0.f}; }
#pragma unroll
        for (int ks = 0; ks < 4; ++ks)
#pragma unroll
            for (int nb = 0; nb < 8; ++nb) {
                const bf16x8 wa = *(const LAS bf16x8*)(lds + L_WA + (16 * nb + fr) * LW_STRIDE + (32 * ks + 8 * fq) * 2);
                const bf16x8 wx = *(const LAS bf16x8*)(lds + L_WX + (16 * nb + fr) * LW_STRIDE + (32 * ks + 8 * fq) * 2);
                aa[nb] = __builtin_amdgcn_mfma_f32_16x16x32_bf16(wa, bfrag[ks], aa[nb], 0, 0, 0);
                ax[nb] = __builtin_amdgcn_mfma_f32_16x16x32_bf16(wx, bfrag[ks], ax[nb], 0, 0, 0);
            }
        float y[4][8]; float ss = 0.f;
#pragma unroll
        for (int ks = 0; ks < 4; ++ks) {
            const f32x4 bga0 = *(const LAS f32x4*)(CT + 5 * 128 + 32 * ks), bga1 = *(const LAS f32x4*)(CT + 5 * 128 + 32 * ks + 4);
            const f32x4 bgx0 = *(const LAS f32x4*)(CT + 6 * 128 + 32 * ks), bgx1 = *(const LAS f32x4*)(CT + 6 * 128 + 32 * ks + 4);
            const f32x4 sp0 = *(const LAS f32x4*)(CT + 7 * 128 + 32 * ks), sp1 = *(const LAS f32x4*)(CT + 7 * 128 + 32 * ks + 4);
            float gav[8];
            if constexpr (PASS == 2) unpack8(g4[ks], gav);
            f32x4 h0a, h0b;
            if constexpr (IS_S) { const float* hp = p.st_h + (size_t)sq * DA + gch + 32 * ks; h0a = *(const f32x4*)hp; h0b = *(const f32x4*)(hp + 4); }
            float hv[8];
#pragma unroll
            for (int e = 0; e < 8; ++e) {
                const int nb = 2 * ks + (e >> 2), rg = e & 3;
                const float rr = sigmoidf_(aa[nb][rg] + (e < 4 ? bga0[rg] : bga1[rg])), ii = sigmoidf_(ax[nb][rg] + (e < 4 ? bgx0[rg] : bgx1[rg]));
                const float la = -8.0f * rr * (e < 4 ? sp0[rg] : sp1[rg]);
                const float a = __expf(la);
                const float om = __builtin_fmaf(-a, a, 1.0f);
                float P = a, S = __builtin_amdgcn_sqrtf(om > 0.f ? om : 0.f) * (ii * xc[ks][e]);
                float h;
                if constexpr (IS_S) { scan8(P, S, t8); h = __builtin_fmaf(P, e < 4 ? h0a[rg] : h0b[rg], S); }
                else {
                    scan16(P, S);
                    h = __builtin_fmaf(P, hin[ks][e], S);
                    hin[ks][e] = bcast15(h, lane);
                    if constexpr (PASS == 1) Pt[ks][e] *= bcast15(P, lane);
                }
                hv[e] = h;
                if constexpr (PASS == 2) { y[ks][e] = gelu_tanh(gav[e]) * h; ss += y[ks][e] * y[ks][e]; }
            }
            if constexpr (PASS == 2) {
                if (IS_S ? (t8 == 7) : (seg == LRU_NSEG - 1 && fr == 15)) {
                    float* ho = p.out + (IS_S ? O_SH + (size_t)sq * DA : O_PH + (size_t)b * DA) + gch + 32 * ks;
                    *(f32x4*)ho = (f32x4){hv[0], hv[1], hv[2], hv[3]}; *(f32x4*)(ho + 4) = (f32x4){hv[4], hv[5], hv[6], hv[7]};
                }
            }
        }
        if constexpr (PASS == 2) {
            ss += __shfl_xor(ss, 16); ss += __shfl_xor(ss, 32);
            const float rn = __builtin_amdgcn_rsqf(ss * (1.0f / 128.0f) + EPS);
#pragma unroll
            for (int ks = 0; ks < 4; ++ks) {
                const f32x4 g0 = *(const LAS f32x4*)(CT + 8 * 128 + 32 * ks), g1 = *(const LAS f32x4*)(CT + 8 * 128 + 32 * ks + 4);
                float o[8];
#pragma unroll
                for (int e = 0; e < 8; ++e) o[e] = y[ks][e] * rn * (e < 4 ? g0[e & 3] : g1[e & 3]);
                *(u32x4*)(ym + (size_t)r * DMIX + gch + 32 * ks) = pack8(o);
            }
        }
    }
    if constexpr (PASS == 1 && !IS_S) {
        if (fr == 0) {
            float* tp = tot + ((size_t)(b * LRU_NSEG + seg) * 2) * DA + gch;
#pragma unroll
            for (int ks = 0; ks < 4; ++ks) {
                *(f32x4*)(tp + 32 * ks) = (f32x4){Pt[ks][0], Pt[ks][1], Pt[ks][2], Pt[ks][3]}; *(f32x4*)(tp + 32 * ks + 4) = (f32x4){Pt[ks][4], Pt[ks][5], Pt[ks][6], Pt[ks][7]};
                *(f32x4*)(tp + DA + 32 * ks) = (f32x4){hin[ks][0], hin[ks][1], hin[ks][2], hin[ks][3]}; *(f32x4*)(tp + DA + 32 * ks + 4) = (f32x4){hin[ks][4], hin[ks][5], hin[ks][6], hin[ks][7]};
            }
        }
    }
}
template <int PASS>
__device__ __forceinline__ void mixer_phase(PRef p, LAS unsigned char* lds, int G) {
    const int tid = opaque_tid(), wave = __builtin_amdgcn_readfirstlane(tid >> 6);
    for (int v = blockIdx.x; v < NH * LRU_WG_PER_HEAD; v += G) {
        const int n = v / LRU_WG_PER_HEAD;
        __syncthreads();
        {
            const bf16_t* wg = (const bf16_t*)(p.ws + WS_WG);
            for (int i = tid; i < 2 * 128 * 16; i += 512) { const int g = i >> 11, row = (i >> 4) & 127, c16 = i & 15;
                *(LAS u32x4*)(lds + g * L_WX + row * LW_STRIDE + c16 * 16) = *(const u32x4*)(wg + (((size_t)g * NH + n) * 128 + row) * 128 + c16 * 8); }
            LAS float* CTw = (LAS float*)(lds + L_CT);
            for (int i = tid; i < 9 * 128; i += 512) { const int k = i >> 7, c = i & 127, ch = n * 128 + c;
                float vv;
                if (k < 4) vv = p.conv_a_w[k * DA + ch]; else if (k == 4) vv = p.conv_a_b[ch]; else if (k == 5) vv = p.b_gate_a[ch]; else if (k == 6) vv = p.b_gate_x[ch];
                else if (k == 7) vv = log1pf(__expf(-p.lam[ch])); else vv = p.g_out_a[ch];
                CTw[i] = vv; }
        }
        __syncthreads();
        const int wi = (v % LRU_WG_PER_HEAD) * 8 + wave;
        if (wi < LRU_PITEMS) lru_wave_item<PASS, false>(p, lds, n, wi / LRU_NSEG, wi % LRU_NSEG);
        else if (PASS == 2 && wi < LRU_PITEMS + LRU_SITEMS) lru_wave_item<PASS, true>(p, lds, n, wi - LRU_PITEMS, 0);
    }
    if (G == 256 && (int)blockIdx.x >= MIX_IDLE_WG0) convert_items(p, lds, ((int)blockIdx.x - MIX_IDLE_WG0) * 8 + wave, (G - MIX_IDLE_WG0) * 8, PASS == 1 ? IT_S1 : IT_S2, PASS == 1 ? IT_S2 : IT_S3);
    if (PASS == 1) branch_b(p, G);
}

__device__ __forceinline__ void final_phase(PRef p, int G, float* probe_dst = nullptr) {
    const int tid_ = opaque_tid(), lane = tid_ & 63, gw = blockIdx.x * 8 + (tid_ >> 6), NGW = G * 8;
    f32x4 gf[8];
#pragma unroll
    for (int j = 0; j < 8; ++j) gf[j] = ((const f32x4*)p.g_final)[lane + 64 * j];
    for (int r = gw; r < NB * SEQ + MSR; r += NGW) {
        f32x4* yr = (f32x4*)(p.out + (size_t)r * D) + lane;
        f32x4 v[8]; float s = 0.f;
#pragma unroll
        for (int j = 0; j < 8; ++j) { v[j] = yr[64 * j]; s += (v[j][0] * v[j][0] + v[j][1] * v[j][1]) + (v[j][2] * v[j][2] + v[j][3] * v[j][3]); }
        s = wave_sum(s);
        const float rs = __builtin_amdgcn_rsqf(s * (1.0f / D) + EPS);
        f32x4* yo = probe_dst ? (f32x4*)(probe_dst + (size_t)r * D) + lane : yr;
#pragma unroll
        for (int j = 0; j < 8; ++j) yo[64 * j] = v[j] * rs * gf[j];
    }
}


#define XB_TMO      128
#define XB_XCNT(j)  (256  + 64 * (j))
#define XB_XSUB(j)  (1280 + 64 * (j))
#define XB_XGEN(j)  (2304 + 64 * (j))
#define XB_TOP      3328
#define XB_TOPGEN   3392
#define XCD_BAR_WORDS 3456
#define XB_SPIN_CAP (1u << 18)
__device__ __forceinline__ unsigned xb_ld(unsigned* p)              { return __hip_atomic_load(p, __ATOMIC_RELAXED, __HIP_MEMORY_SCOPE_AGENT); }
__device__ __forceinline__ unsigned xb_add(unsigned* p, unsigned v) { return __hip_atomic_fetch_add(p, v, __ATOMIC_RELAXED, __HIP_MEMORY_SCOPE_AGENT); }
__device__ __forceinline__ unsigned xb_xcc_id() { return (unsigned)__builtin_amdgcn_s_getreg((3 << 11) | 20) & 0xFu; }
#define XB_SPIN(cond, bar) do { unsigned _sp = 0; while (cond) { __builtin_amdgcn_s_sleep(1); \
    if ((++_sp & 255u) == 0u) { if (xb_ld(&(bar)[XB_TMO])) break; if (_sp > XB_SPIN_CAP) { atomicAdd(&(bar)[XB_TMO], 1u); break; } } } } while (0)
struct XcdBarrier { unsigned* bar; unsigned x; volatile LAS unsigned* st; };
__device__ __forceinline__ XcdBarrier xcd_barrier_post(unsigned* bar, volatile LAS unsigned* st) {
    XcdBarrier b; b.bar = bar; b.x = xb_xcc_id(); b.st = st;
    if (threadIdx.x == 0) (void)xb_add(&bar[XB_XCNT(b.x)], 1u);
    return b;
}
__device__ __forceinline__ void xcd_barrier_complete(unsigned* bar, unsigned x, unsigned& nloc, unsigned& nx) {
    const unsigned G = gridDim.x * gridDim.y * gridDim.z;
    unsigned sum, cnt, mine, sp = 0u;
    for (;;) {
        sum = 0u; cnt = 0u; mine = 0u;
#pragma unroll
        for (unsigned j = 0; j < 16; ++j) { const unsigned c = xb_ld(&bar[XB_XCNT(j)]); sum += c; cnt += (c > 0u) ? 1u : 0u; mine = (j == x) ? c : mine; }
        if (sum == G) break;
        __builtin_amdgcn_s_sleep(1);
        if ((++sp & 255u) == 0u) { if (xb_ld(&bar[XB_TMO])) break; if (sp > XB_SPIN_CAP) { atomicAdd(&bar[XB_TMO], 1u); break; } }
    }
    nloc = mine > 0u ? mine : 1u; nx = cnt > 0u ? cnt : 1u;
}
__device__ __forceinline__ void xcd_barrier(const XcdBarrier& b) {
    asm volatile("s_waitcnt vmcnt(0)" ::: "memory");
    __syncthreads();
    if (threadIdx.x == 0) {
        unsigned* bar = b.bar;
        __builtin_amdgcn_s_waitcnt(0);
        unsigned nloc = b.st[0], nx = b.st[1];
        if (nloc == 0u) { xcd_barrier_complete(bar, b.x, nloc, nx); b.st[0] = nloc; b.st[1] = nx; }
        const unsigned old = xb_add(&bar[XB_XSUB(b.x)], 1u);
        const unsigned gen = old / nloc;
        if (old + 1u == (gen + 1u) * nloc) {
            __builtin_amdgcn_fence(__ATOMIC_RELEASE, "agent");
            asm volatile("s_waitcnt vmcnt(0)" ::: "memory");
            const unsigned og = xb_add(&bar[XB_TOP], 1u);
            const unsigned tg = og / nx;
            if (og + 1u == (tg + 1u) * nx) xb_add(&bar[XB_TOPGEN], 1u);
            else XB_SPIN(xb_ld(&bar[XB_TOPGEN]) == tg, bar);
            __builtin_amdgcn_fence(__ATOMIC_ACQUIRE, "agent");
            xb_add(&bar[XB_XGEN(b.x)], 1u);
            asm volatile("s_waitcnt vmcnt(0)" ::: "memory");
        } else {
            XB_SPIN(xb_ld(&bar[XB_XGEN(b.x)]) == gen, bar);
            __builtin_amdgcn_fence(__ATOMIC_ACQUIRE, "agent");
            asm volatile("s_waitcnt vmcnt(0)" ::: "memory");
        }
    }
    __syncthreads();
}

constexpr int LDS_BYTES = 132096;
constexpr int N_PHASES = 8;
__global__ void __launch_bounds__(512, 2) hymba_fwd(Params p) {
    extern __shared__ __attribute__((aligned(16))) unsigned char lds_raw[];
    LAS unsigned char* lds = (LAS unsigned char*)lds_raw;
    constexpr int G = GRID;
    if ((int)gridDim.x != GRID) return;
    const CAS Params* kp = (const CAS Params*)__builtin_amdgcn_kernarg_segment_ptr();
#define P_HERE (*({ const CAS Params* q_ = kp; asm volatile("" : "+s"(q_)); q_; }))
    unsigned char* ws = p.ws;
    volatile LAS unsigned* misc = (volatile LAS unsigned*)(lds + 131072);
    if (threadIdx.x < 8) misc[threadIdx.x] = 0u;
    __syncthreads();
    XcdBarrier bar = xcd_barrier_post((unsigned*)ws, misc);
    const int lo = p.ph_lo, hi = p.ph_hi;
#ifndef PH_MASK
#define PH_MASK 0xff
#endif
#define IN(k) (((PH_MASK >> (k)) & 1) && lo <= (k) && (k) < hi)
#define SEAM(k) do { if (IN(k) && IN((k) + 1)) xcd_barrier(bar); } while (0)
#ifndef REP_MASK
#define REP_MASK 0x00
#endif
#define REPEAT(k) for (int rep_ = 0; rep_ < ((((REP_MASK) >> (k)) & 1) ? 2 : 1); ++rep_, (rep_ < ((((REP_MASK) >> (k)) & 1) ? 2 : 1) ? xcd_barrier(bar) : (void)0))
    if (IN(0)) REPEAT(0) phase0(P_HERE, lds, G);
    SEAM(0);
    if (IN(1)) REPEAT(1) {
        pg8::Gemm g{(const bf16_t*)(ws + WS_XB) + (size_t)16 * D, (const bf16_t*)(ws + WS_WIN), MP / 256, DIN / 256, D, (size_t)256 * D * 2, (size_t)128 * D * 2};
        pg8::StaticOrder S; S.init(g.nM, g.nN, G, (int)blockIdx.x, D / 64, 1);
        PRef q = P_HERE; EpiZ E{(const float*)(ws + WS_RS1), (bf16_t*)(ws + WS_Z), q.out};
        pg8::gemm_phase<EpiZ, false, true, true>(lds, g, S, E, nullptr, nullptr);
        if ((int)blockIdx.x >= P1_TAIL_WG0 && G == 256) convert_items(P_HERE, lds, ((int)blockIdx.x - P1_TAIL_WG0) * 8 + (opaque_tid() >> 6), (G - P1_TAIL_WG0) * 8, IT_O, IT_S1);
        else if (G != 256) convert_items(P_HERE, lds, (int)blockIdx.x * 8 + (opaque_tid() >> 6), G * 8, IT_O, IT_S3);
    }
    SEAM(1);
    if (IN(2)) REPEAT(2) mixer_phase<1>(P_HERE, lds, G);
    SEAM(2);
    if (IN(3)) REPEAT(3) mixer_phase<2>(P_HERE, lds, G);
    SEAM(3);
    if (IN(4)) REPEAT(4) {
        pg8::Gemm g{(const bf16_t*)(ws + WS_YM), (const bf16_t*)(ws + WS_WO), MP / 256, D / 256, DMIX, (size_t)256 * DMIX * 2, (size_t)128 * DMIX * 2};
        pg8::StaticOrder S; S.init(g.nM, g.nN, G, (int)blockIdx.x, DMIX / 64, 1);
        PRef q = P_HERE; EpiX1 E{q.x_prompt, q.x_sample, q.meta, q.out, (bf16_t*)(ws + WS_XB) + (size_t)16 * D, (float*)(ws + WS_SSQ)};
        pg8::gemm_phase<EpiX1, false, true, true>(lds, g, S, E, nullptr, nullptr);
        if ((int)blockIdx.x >= P4_TAIL_WG0 && G == 256) convert_items(P_HERE, lds, ((int)blockIdx.x - P4_TAIL_WG0) * 8 + (opaque_tid() >> 6), (G - P4_TAIL_WG0) * 8, IT_S3, IT_G);
        else if (G != 256) convert_items(P_HERE, lds, (int)blockIdx.x * 8 + (opaque_tid() >> 6), G * 8, IT_S3, IT_G);
    }
    SEAM(4);
    if (IN(5)) REPEAT(5) {
        pg8::Gemm g{(const bf16_t*)(ws + WS_XB) + (size_t)14 * D, (const bf16_t*)(ws + WS_WUP), 37, 2 * DFF / 256, D, (size_t)252 * D * 2, (size_t)64 * D * 2};
        pg8::StaticOrder S; S.init(g.nM, g.nN, G, (int)blockIdx.x, D / 64, 1);
        PRef q = P_HERE; EpiFFN E{(const float*)(ws + WS_SSQ), q.conv_f_w, q.conv_f_b, q.st_fc, (bf16_t*)(ws + WS_Z), q.out};
        pg8::gemm_phase<EpiFFN, true, true, true>(lds, g, S, E, nullptr, nullptr);
    }
    SEAM(5);
    if (IN(6)) {
        pg8::Gemm g{(const bf16_t*)(ws + WS_Z), (const bf16_t*)(ws + WS_WDN), MP / 256, D / 256, DFF, (size_t)256 * DFF * 2, (size_t)128 * DFF * 2};
        pg8::StaticOrder S; S.init(g.nM, g.nN, G, (int)blockIdx.x, DFF / 64, P6_SPLIT);
        PRef q = P_HERE; EpiOut E{q.out};
        if ((REP_MASK >> 6) & 1) { pg8::gemm_phase<EpiOut, false, true, true>(lds, g, S, E, (float*)(ws + WS_WIN), (unsigned*)ws + CW_TK6, true); xcd_barrier(bar); }
        if ((REP_MASK >> 9) & 1) { pg8::StaticOrder S3; S3.init(g.nM, g.nN, G, (int)blockIdx.x, DFF / 64, P6_SPLIT); S3.first = 1; EpiOut E3{(float*)(ws + WS_END)};
            pg8::gemm_phase<EpiOut, false, true, true>(lds, g, S3, E3, (float*)(ws + WS_WIN), (unsigned*)ws + CW_TK6 + 64 * 64); xcd_barrier(bar); }
        if ((REP_MASK >> 8) & 1) { pg8::StaticOrder S2; S2.init(g.nM, g.nN, G, (int)blockIdx.x, DFF / 64, 1); S2.limit = 1; EpiOut E2{(float*)(ws + WS_END)};
            pg8::gemm_phase<EpiOut, false, true, true>(lds, g, S2, E2, nullptr, nullptr); xcd_barrier(bar); }
        pg8::gemm_phase<EpiOut, false, true, true>(lds, g, S, E, (float*)(ws + WS_WIN), (unsigned*)ws + CW_TK6);
    }
    SEAM(6);
    if (IN(7)) { if ((REP_MASK >> 7) & 1) { final_phase(P_HERE, G, (float*)(ws + WS_Z)); xcd_barrier(bar); }
        final_phase(P_HERE, G); }
#undef IN
#undef SEAM
}

extern "C" void kernel_launch(void* const* d_in, const int* in_sizes, int n_in, void* d_out, int out_size, void* d_ws, size_t ws_size, hipStream_t stream) {
    static int grid = 0;
    if (grid == 0) {
        if (n_in != 26 || (size_t)out_size != O_END || ws_size < WS_END) { fprintf(stderr, "kernel_launch: unexpected problem (n_in %d, out %d, ws %zu; need ws >= %zu)\n", n_in, out_size, ws_size, (size_t)WS_END); grid = -1; return; }
        int dev = 0, cus = 0, per_cu = 0;
        hipGetDevice(&dev); hipDeviceGetAttribute(&cus, hipDeviceAttributeMultiprocessorCount, dev);
        if (hipFuncSetAttribute((const void*)hymba_fwd, hipFuncAttributeMaxDynamicSharedMemorySize, LDS_BYTES) != hipSuccess) { fprintf(stderr, "kernel_launch: hipFuncSetAttribute failed\n"); grid = -1; return; }
        if (hipOccupancyMaxActiveBlocksPerMultiprocessor(&per_cu, (const void*)hymba_fwd, 512, LDS_BYTES) != hipSuccess || per_cu < 1) { fprintf(stderr, "kernel_launch: occupancy query says %d\n", per_cu); grid = -1; return; }
        if (cus < GRID) { fprintf(stderr, "kernel_launch: built for a %d-CU device, found %d CUs\n", GRID, cus); grid = -1; return; }
        grid = GRID;
    }
    if (grid < 0) return;
    Params p{};
    const float** f = (const float**)&p;
    for (int i = 0; i < 26; ++i) f[i] = (const float*)d_in[i];
    p.out = (float*)d_out; p.ws = (unsigned char*)d_ws;
    if (hipMemsetAsync(d_ws, 0, CTL_WORDS * 4, stream) != hipSuccess) { fprintf(stderr, "kernel_launch: memset failed\n"); return; }
    if (MK_N_LAUNCHES == 1) {
        p.ph_lo = 0; p.ph_hi = N_PHASES;
        hipLaunchKernelGGL(hymba_fwd, dim3(grid), dim3(512), LDS_BYTES, stream, p);
    } else {
        for (int k = 0; k < N_PHASES; ++k) { p.ph_lo = k; p.ph_hi = k + 1; hipLaunchKernelGGL(hymba_fwd, dim3(grid), dim3(512), LDS_BYTES, stream, p); }
    }
}
```

```cpp
#include <hip/hip_runtime.h>
#include <cstdio>

#ifndef MK_N_LAUNCHES
#define MK_N_LAUNCHES 1
#endif

#define LAS __attribute__((address_space(3)))
#define CAS __attribute__((address_space(4)))
typedef unsigned short bf16_t;
typedef short bf16x8 __attribute__((ext_vector_type(8)));
typedef float f32x4 __attribute__((ext_vector_type(4)));
typedef unsigned u32x4 __attribute__((ext_vector_type(4)));
typedef unsigned u32x2 __attribute__((ext_vector_type(2)));

constexpr int D = 2048, NMETA = 16, SEQ = 2048, TP = SEQ + NMETA, NB = 4, MPR = NB * TP;
constexpr int NS = 128, TS = 8, MSR = NS * TS, M = MPR + MSR;
constexpr int MP = 9472;
constexpr int DA = 1536, DB = 1024, DIN = 6144, DMIX = 2560, DFF = 6144, NH = 12;
constexpr float EPS = 1e-6f;
constexpr int NCH = 33;
constexpr size_t O_YP = 0, O_YS = O_YP + (size_t)NB * SEQ * D, O_PH = O_YS + (size_t)MSR * D, O_PRC = O_PH + NB * DA,
                 O_PSC = O_PRC + NB * 3 * DA, O_PFC = O_PSC + NB * 2 * DB, O_SH = O_PFC + NB * 2 * DFF, O_SRC = O_SH + NS * DA,
                 O_SSC = O_SRC + (size_t)NS * 3 * DA, O_SFC = O_SSC + (size_t)NS * 2 * DB, O_END = O_SFC + (size_t)NS * 2 * DFF;
constexpr size_t MiB = 1u << 20;
constexpr int CW_TK6 = 4096, CTL_WORDS = 4096 + 128 * 64;
constexpr int P6_SPLIT = 4, P4_SPLIT = 4, CW_TK4 = CW_TK6 + 64 * 64;
constexpr int GRID = 256;
constexpr size_t WS_WIN = 1 * MiB;
constexpr size_t WS_WO = WS_WIN + (size_t)DIN * D * 2;
constexpr size_t WS_WUP = WS_WO + (size_t)D * DMIX * 2;
constexpr size_t WS_WDN = WS_WUP + (size_t)2 * DFF * D * 2;
constexpr size_t WS_WG = WS_WDN + (size_t)D * DFF * 2;
constexpr size_t WS_XB = WS_WG + (size_t)2 * NH * 128 * 128 * 2;
constexpr size_t XB_ROWS = 9600;
constexpr size_t WS_Z = WS_XB + XB_ROWS * D * 2;
constexpr size_t WS_YM = WS_Z + (size_t)MP * DIN * 2;
constexpr size_t WS_RS1 = WS_YM + (size_t)MP * DMIX * 2;
constexpr size_t WS_SSQ = WS_RS1 + (size_t)MP * 4;
constexpr size_t WS_TOT = WS_SSQ + (size_t)MP * 32 * 4;
constexpr size_t WS_END = WS_TOT + (size_t)NB * NCH * DA * 2 * 4;

struct Params;
typedef const CAS Params& PRef;
struct Params {
    const float *x_prompt, *x_sample, *st_h, *st_rc, *st_sc, *st_fc, *meta, *g_mix, *w_in, *conv_a_w, *conv_a_b, *w_gate_a, *b_gate_a,
        *w_gate_x, *b_gate_x, *lam, *conv_b_w, *g_out_a, *g_out_b, *w_o, *g_ffn, *w_up, *conv_f_w, *conv_f_b, *w_down, *g_final;
    float* out; unsigned char* ws; int ph_lo, ph_hi;
};

__device__ __forceinline__ unsigned cvt_pk_bf16(float lo, float hi) { unsigned r; asm volatile("v_cvt_pk_bf16_f32 %0, %1, %2" : "=v"(r) : "v"(lo), "v"(hi)); return r; }
__device__ __forceinline__ float bf_lo(unsigned w) { return __builtin_bit_cast(float, w << 16); }
__device__ __forceinline__ float bf_hi(unsigned w) { return __builtin_bit_cast(float, w & 0xffff0000u); }
__device__ __forceinline__ void unpack8(const u32x4 w, float (&f)[8]) { f[0] = bf_lo(w.x); f[1] = bf_hi(w.x); f[2] = bf_lo(w.y); f[3] = bf_hi(w.y); f[4] = bf_lo(w.z); f[5] = bf_hi(w.z); f[6] = bf_lo(w.w); f[7] = bf_hi(w.w); }
__device__ __forceinline__ u32x4 pack8(const float (&f)[8]) { u32x4 w; w.x = cvt_pk_bf16(f[0], f[1]); w.y = cvt_pk_bf16(f[2], f[3]); w.z = cvt_pk_bf16(f[4], f[5]); w.w = cvt_pk_bf16(f[6], f[7]); return w; }
__device__ __forceinline__ float wave_sum(float v) {
#pragma unroll
    for (int o = 1; o < 64; o <<= 1) v += __shfl_xor(v, o);
    return v;
}
__device__ __forceinline__ float sum16(float v) {
    v += __shfl_xor(v, 1); v += __shfl_xor(v, 2); v += __shfl_xor(v, 4); v += __shfl_xor(v, 8); return v;
}
__device__ __forceinline__ float sigmoidf_(float x) { return __builtin_amdgcn_rcpf(1.0f + __expf(-x)); }
__device__ __forceinline__ float gelu_tanh(float x) {
    const float t = x * (1.0f + 0.044715f * x * x) * (-2.0f * 0.7978845608028654f * 1.4426950408889634f);
    return x * __builtin_amdgcn_rcpf(1.0f + __builtin_amdgcn_exp2f(t));
}
__device__ __forceinline__ int opaque_tid() { int t = threadIdx.x; asm volatile("" : "+v"(t)); return t; }
template <int CTRL> __device__ __forceinline__ float dppf(float old, float src) {
    return __builtin_bit_cast(float, __builtin_amdgcn_update_dpp(__builtin_bit_cast(int, old), __builtin_bit_cast(int, src), CTRL, 0xF, 0xF, false));
}
__device__ __forceinline__ void row_decode(int r, int& is_s, int& seq, int& t) {
    if (r < MPR) { seq = (r >= TP) + (r >= 2 * TP) + (r >= 3 * TP); t = r - seq * TP; is_s = 0; }
    else { const int q = r - MPR; seq = q >> 3; t = q & 7; is_s = 1; }
}
__device__ __forceinline__ const float* x_row_ptr(const float* xp, const float* xs, const float* meta, int r) {
    int is_s, seq, t; row_decode(r, is_s, seq, t);
    if (is_s) return xs + (size_t)(r - MPR) * D;
    return t < NMETA ? meta + (size_t)t * D : xp + ((size_t)seq * SEQ + (t - NMETA)) * D;
}
__device__ __forceinline__ float* y_row_ptr(float* out, int r) {
    if (r >= M) return nullptr;
    int is_s, seq, t; row_decode(r, is_s, seq, t);
    if (is_s) return out + O_YS + (size_t)(r - MPR) * D;
    return t < NMETA ? nullptr : out + O_YP + ((size_t)seq * SEQ + (t - NMETA)) * D;
}

namespace pg8 {
constexpr int BM = 256, BK = 64, HALF = 128, HTB = HALF * BK * 2, STAGE_BYTES = 8 * HTB, NXCD = 8, WGM = 8;
__host__ __device__ __forceinline__ int lds_byte(int r, int c) { const int st = (r >> 4) * 2 + (c >> 5), rr = r & 15, cc = c & 31, ob = rr * 64 + cc * 2; return st * 1024 + (ob ^ (((ob >> 9) & 1) << 5)); }
__host__ __device__ __forceinline__ void stage_rc(int b, int& R, int& C) { const int st = b / 1024, sb = b % 1024, swz = sb ^ (((sb >> 9) & 1) << 5); R = (st >> 1) * 16 + swz / 64; C = (st & 1) * 32 + (swz % 64) / 2; }
struct Unit { int pm, pn, kb, nk, piece, lu; };
struct Gemm { const bf16_t* A; const bf16_t* Bt; int nM, nN, K; size_t a_tstep, a_hstep; };
struct StaticOrder {
    int nM, nN, nwg, G, c, nt, split, nfull, nleft, limit = 1 << 20, first = 0;
    __device__ __forceinline__ void init(int nM_, int nN_, int G_, int c_, int nt_, int split_) { nM = nM_; nN = nN_; nwg = nM * nN; G = G_; c = c_; nt = nt_; nfull = (nwg / G) * G; nleft = nwg - nfull;
        split = (split_ > 1 && nleft > 0 && nleft * split_ <= G && (nt / split_) * split_ == nt && ((nt / split_) & 1) == 0) ? split_ : 1; }
    __device__ __forceinline__ void map(int L, Unit& u) const {
        int wgid = L; { const int q = nwg / NXCD, r = nwg % NXCD, xcd = wgid % NXCD, off = wgid / NXCD; wgid = (xcd < r ? xcd * (q + 1) : r * (q + 1) + (xcd - r) * q) + off; }
        const int nig = WGM * nN, gid = wgid / nig, rem = wgid - gid * nig, fm = gid * WGM, glast = nM % WGM;
        if (nM - fm >= WGM || glast == 0) { u.pm = fm + (rem & (WGM - 1)); u.pn = rem / WGM; }
        else { u.pm = fm + rem % glast; u.pn = rem / glast; }
    }
    __device__ __forceinline__ bool next(int i, Unit& u) const {
        u.kb = 0; u.nk = nt; u.piece = -1; u.lu = 0;
        i += first; if (i >= limit) return false;
        const long L = (long)i * G + c;
        if (L < nfull || split == 1) { if (L >= nwg) return false; map((int)L, u); return true; }
        if (L >= nfull + G || c >= nleft * split) return false;
        u.lu = c % nleft; u.piece = c / nleft; u.nk = nt / split; u.kb = u.piece * u.nk; map(nfull + u.lu, u); return true;
    }
};

template <int P, int A, int Mi>
__device__ __forceinline__ void reduce_rowgroup(f32x4 (&acc)[2][2][4][2], const float* slab0, int tid) {
    const float* sp = slab0 + (size_t)((A * 4 + Mi) * 4) * 8192 + tid * 4;
#pragma unroll
    for (int b = 0; b < 2; ++b)
#pragma unroll
        for (int n = 0; n < 2; ++n) {
            f32x4 sum = (f32x4){0.f, 0.f, 0.f, 0.f};
#pragma unroll
            for (int src = 0; src < 4; ++src) { if (src == P) sum += acc[A][b][Mi][n]; else sum += *(const f32x4*)(sp + (size_t)src * 8192 + (b * 2 + n) * 2048); }
            acc[A][b][Mi][n] = sum;
        }
}
template <class Epi, bool FFNMAP, bool ALIGN_EPI, bool SP2>
__device__ __forceinline__ void gemm_phase(LAS unsigned char* lds, const Gemm g, const StaticOrder& S, const Epi& E, float* slabs, unsigned* tickets, bool dry = false) {
    int tid = threadIdx.x; asm volatile("" : "+v"(tid));
    const int wid = __builtin_amdgcn_readfirstlane(tid >> 6), lane = tid & 63, wr = wid >> 2, wc = wid & 3, fr = lane & 15, fq = lane >> 4;
    const int K = g.K;
    unsigned voffA[2], voffB[2];
#pragma unroll
    for (int i = 0; i < 2; ++i) { int R, C; stage_rc(tid * 16 + i * 8192, R, C); const int Ra = FFNMAP ? (126 * (R >> 6) + (R & 63)) : R;
        voffA[i] = (unsigned)(Ra * K + C) * 2u; voffB[i] = (unsigned)(R * K + C) * 2u; }
    const size_t kstep = (size_t)(BK * 2);
    const size_t hstepA = g.a_hstep, tstepA = g.a_tstep;
    const size_t hstepB = (size_t)HALF * K * 2, tstepB = 2 * hstepB;
    const unsigned ldsw = (unsigned)wid * 1024u;
    const int aoff = lds_byte(wr * 64 + fr, fq * 8), boff = lds_byte(wc * 32 + fr, fq * 8);
#define PG8_SA(b, h) (((b) * 2 + (h)) * HTB)
#define PG8_SB(b, h) ((4 + (b) * 2 + (h)) * HTB)
#define PG8_STAGE(bufoff, gbase, voff) do { _Pragma("unroll") for (int _i = 0; _i < 2; ++_i) \
        __builtin_amdgcn_global_load_lds((const unsigned*)((const char*)(gbase) + (voff)[_i]), (LAS unsigned*)(lds + (bufoff) + ldsw + _i * 8192), 16, 0, 0); } while (0)
#define PG8_LDA(dst, b, h) do { _Pragma("unroll") for (int m = 0; m < 4; ++m) _Pragma("unroll") for (int k = 0; k < 2; ++k) dst[m][k] = *(const LAS bf16x8*)(lds + PG8_SA(b, h) + aoff + m * 2048 + k * 1024); } while (0)
#define PG8_LDB(dst, b, h) do { _Pragma("unroll") for (int n = 0; n < 2; ++n) _Pragma("unroll") for (int k = 0; k < 2; ++k) dst[n][k] = *(const LAS bf16x8*)(lds + PG8_SB(b, h) + boff + n * 2048 + k * 1024); } while (0)
#define PG8_MMA(ai, bj, At, Bt) do { __builtin_amdgcn_s_setprio(1); _Pragma("unroll") for (int m = 0; m < 4; ++m) _Pragma("unroll") for (int n = 0; n < 2; ++n) _Pragma("unroll") for (int k = 0; k < 2; ++k) \
        acc[ai][bj][m][n] = __builtin_amdgcn_mfma_f32_16x16x32_bf16(Bt[n][k], At[m][k], acc[ai][bj][m][n], 0, 0, 0); __builtin_amdgcn_s_setprio(0); } while (0)
#define PG8_WAIT_V(n) asm volatile("s_waitcnt vmcnt(" #n ")" ::: "memory")
#define PG8_WAIT_L(n) asm volatile("s_waitcnt lgkmcnt(" #n ")" ::: "memory")
#define PG8_BAR __builtin_amdgcn_s_barrier()
#define PG8_SCHED __builtin_amdgcn_sched_barrier(0)
    Unit cur, nxt; int ui = 0;
    if (!S.next(0, cur)) return;
    f32x4 acc[2][2][4][2];
#pragma unroll
    for (int a = 0; a < 2; ++a)
#pragma unroll
        for (int b = 0; b < 2; ++b)
#pragma unroll
            for (int m = 0; m < 4; ++m)
#pragma unroll
                for (int n = 0; n < 2; ++n) acc[a][b][m][n] = (f32x4){0.f, 0.f, 0.f, 0.f};
    bf16x8 At[4][2], B0[2][2], B1[2][2];
    const char* cA = (const char*)g.A + (size_t)cur.pm * tstepA + (size_t)cur.kb * kstep; const char* cB = (const char*)g.Bt + (size_t)cur.pn * tstepB + (size_t)cur.kb * kstep;
    if constexpr (SP2) {
        PG8_STAGE(PG8_SB(0, 0), cB, voffB); PG8_STAGE(PG8_SB(0, 1), cB + hstepB, voffB); PG8_STAGE(PG8_SA(0, 0), cA, voffA); PG8_STAGE(PG8_SA(0, 1), cA + hstepA, voffA);
        if (wr == 1) PG8_BAR;
        PG8_WAIT_V(2); PG8_BAR;
        PG8_STAGE(PG8_SB(1, 0), cB + kstep, voffB); PG8_STAGE(PG8_SA(1, 0), cA + kstep, voffA); PG8_STAGE(PG8_SB(1, 1), cB + hstepB + kstep, voffB);
        PG8_WAIT_V(6); PG8_BAR;
    } else {
        PG8_STAGE(PG8_SB(0, 0), cB, voffB); PG8_STAGE(PG8_SA(0, 0), cA, voffA); PG8_STAGE(PG8_SB(0, 1), cB + hstepB, voffB); PG8_STAGE(PG8_SA(0, 1), cA + hstepA, voffA);
        if (wr == 1) PG8_BAR;
        PG8_WAIT_V(4); PG8_BAR;
        PG8_STAGE(PG8_SB(1, 0), cB + kstep, voffB); PG8_STAGE(PG8_SA(1, 0), cA + kstep, voffA); PG8_STAGE(PG8_SB(1, 1), cB + hstepB + kstep, voffB);
        PG8_WAIT_V(6); PG8_BAR;
    }
    for (;;) {
        const bool has_next = S.next(ui + 1, nxt);
        const char* nA = has_next ? (const char*)g.A + (size_t)nxt.pm * tstepA + (size_t)nxt.kb * kstep : cA; const char* nB = has_next ? (const char*)g.Bt + (size_t)nxt.pn * tstepB + (size_t)nxt.kb * kstep : cB;
        const int nt = cur.nk;
        for (int t = 0; t < nt; t += 2) {
            const bool last = (t == nt - 2);
            const char* a1 = cA + (size_t)(t + 1) * kstep;
            const char* a2 = last ? nA : cA + (size_t)(t + 2) * kstep; const char* b2 = last ? nB : cB + (size_t)(t + 2) * kstep;
            const char* a3 = a2 + kstep; const char* b3 = b2 + kstep;
            if constexpr (SP2) {
            PG8_LDB(B0, 0, 0); PG8_LDB(B1, 0, 1); PG8_SCHED; PG8_LDA(At, 0, 0); PG8_STAGE(PG8_SA(1, 1), a1 + hstepA, voffA);
            PG8_WAIT_V(8); PG8_WAIT_L(0); PG8_BAR; PG8_MMA(0, 0, At, B0); PG8_MMA(0, 1, At, B1); PG8_BAR; PG8_SCHED;
            PG8_LDA(At, 0, 1); PG8_STAGE(PG8_SB(0, 0), b2, voffB); PG8_STAGE(PG8_SB(0, 1), b2 + hstepB, voffB); PG8_STAGE(PG8_SA(0, 0), a2, voffA);
            PG8_WAIT_V(8); PG8_WAIT_L(0); PG8_BAR; PG8_MMA(1, 0, At, B0); PG8_MMA(1, 1, At, B1); PG8_BAR; PG8_SCHED;
            PG8_LDB(B0, 1, 0); PG8_LDB(B1, 1, 1); PG8_SCHED; PG8_LDA(At, 1, 0); PG8_STAGE(PG8_SA(0, 1), a2 + hstepA, voffA);
            PG8_WAIT_V(8); PG8_WAIT_L(0); PG8_BAR; PG8_MMA(0, 0, At, B0); PG8_MMA(0, 1, At, B1); PG8_BAR; PG8_SCHED;
            PG8_LDA(At, 1, 1); PG8_STAGE(PG8_SB(1, 0), b3, voffB); PG8_STAGE(PG8_SB(1, 1), b3 + hstepB, voffB); PG8_STAGE(PG8_SA(1, 0), a3, voffA);
            PG8_WAIT_V(8); PG8_WAIT_L(0); PG8_BAR; PG8_MMA(1, 0, At, B0); PG8_MMA(1, 1, At, B1); PG8_BAR; PG8_SCHED;
            } else {
            PG8_LDB(B0, 0, 0); PG8_SCHED; PG8_LDA(At, 0, 0); PG8_STAGE(PG8_SA(1, 1), a1 + hstepA, voffA);
            PG8_WAIT_L(8); PG8_BAR; PG8_WAIT_L(0); PG8_MMA(0, 0, At, B0); PG8_BAR; PG8_SCHED;
            PG8_LDB(B1, 0, 1); PG8_STAGE(PG8_SB(0, 0), b2, voffB);
            PG8_BAR; PG8_WAIT_L(0); PG8_MMA(0, 1, At, B1); PG8_BAR;
            PG8_LDA(At, 0, 1); PG8_STAGE(PG8_SA(0, 0), a2, voffA);
            PG8_BAR; PG8_WAIT_L(0); PG8_MMA(1, 0, At, B0); PG8_BAR; PG8_SCHED;
            PG8_STAGE(PG8_SB(0, 1), b2 + hstepB, voffB);
            PG8_WAIT_V(6); PG8_BAR; PG8_MMA(1, 1, At, B1); PG8_BAR;
            PG8_LDB(B0, 1, 0); PG8_SCHED; PG8_LDA(At, 1, 0); PG8_STAGE(PG8_SA(0, 1), a2 + hstepA, voffA);
            PG8_WAIT_L(8); PG8_BAR; PG8_WAIT_L(0); PG8_MMA(0, 0, At, B0); PG8_BAR; PG8_SCHED;
            PG8_LDB(B1, 1, 1); PG8_STAGE(PG8_SB(1, 0), b3, voffB);
            PG8_BAR; PG8_WAIT_L(0); PG8_MMA(0, 1, At, B1); PG8_BAR;
            PG8_LDA(At, 1, 1); PG8_STAGE(PG8_SA(1, 0), a3, voffA);
            PG8_BAR; PG8_WAIT_L(0); PG8_MMA(1, 0, At, B0); PG8_BAR; PG8_SCHED;
            PG8_STAGE(PG8_SB(1, 1), b3 + hstepB, voffB);
            PG8_WAIT_V(6); PG8_BAR; PG8_MMA(1, 1, At, B1); PG8_BAR;
            }
        }
        if constexpr (ALIGN_EPI) { if (wr == 0) PG8_BAR; }
        if (cur.piece < 0 && !dry) E(acc, cur, wr, wc, fr, fq);
        if (!has_next) break;
#pragma unroll
        for (int a = 0; a < 2; ++a)
#pragma unroll
            for (int b = 0; b < 2; ++b)
#pragma unroll
                for (int m = 0; m < 4; ++m)
#pragma unroll
                    for (int n = 0; n < 2; ++n) acc[a][b][m][n] = (f32x4){0.f, 0.f, 0.f, 0.f};
        cur = nxt; cA = nA; cB = nB; ++ui;
        if constexpr (ALIGN_EPI) { if (wr == 1) PG8_BAR; }
    }
    PG8_WAIT_V(0);
    if constexpr (!ALIGN_EPI) { if (wr == 0) PG8_BAR; }
    PG8_BAR;
    if constexpr (Epi::SPLIT) {
    if (cur.piece >= 0 && !dry) {
        float* slab0 = slabs + (size_t)cur.lu * (8 * 4 * 8192);
        {
            const __amdgpu_buffer_rsrc_t rs = __builtin_amdgcn_make_buffer_rsrc((void*)slab0, (short)0, 8 * 4 * 32768, 0x00020000);
#pragma unroll
            for (int a = 0; a < 2; ++a)
#pragma unroll
                for (int m = 0; m < 4; ++m) {
                    const int gq = a * 4 + m;
                    if ((gq >> 1) != cur.piece) {
#pragma unroll
                        for (int b = 0; b < 2; ++b)
#pragma unroll
                            for (int n = 0; n < 2; ++n) __builtin_amdgcn_raw_buffer_store_b128(__builtin_bit_cast(u32x4, acc[a][b][m][n]), rs, (gq * 4 + cur.piece) * 32768 + (b * 2 + n) * 8192 + tid * 16, 0, 16);
                    }
                }
        }
        asm volatile("s_waitcnt vmcnt(0)" ::: "memory");
        __syncthreads();
        if (tid == 0) {
            __hip_atomic_fetch_add(tickets + 64 * cur.lu, 1u, __ATOMIC_RELAXED, __HIP_MEMORY_SCOPE_AGENT);
            unsigned sp = 0;
            while (__hip_atomic_load(tickets + 64 * cur.lu, __ATOMIC_RELAXED, __HIP_MEMORY_SCOPE_AGENT) < 4u) { __builtin_amdgcn_s_sleep(2); if (++sp > (1u << 20)) break; }
            __builtin_amdgcn_fence(__ATOMIC_ACQUIRE, "agent"); asm volatile("s_waitcnt vmcnt(0)" ::: "memory");
        }
        __syncthreads();
        switch (cur.piece) {
            case 0: reduce_rowgroup<0, 0, 0>(acc, slab0, tid); reduce_rowgroup<0, 0, 1>(acc, slab0, tid); break;
            case 1: reduce_rowgroup<1, 0, 2>(acc, slab0, tid); reduce_rowgroup<1, 0, 3>(acc, slab0, tid); break;
            case 2: reduce_rowgroup<2, 1, 0>(acc, slab0, tid); reduce_rowgroup<2, 1, 1>(acc, slab0, tid); break;
            default: reduce_rowgroup<3, 1, 2>(acc, slab0, tid); reduce_rowgroup<3, 1, 3>(acc, slab0, tid); break;
        }
        E(acc, cur, wr, wc, fr, fq, 3u << (2 * cur.piece));
    }
    }
#undef PG8_SA
#undef PG8_SB
#undef PG8_STAGE
#undef PG8_LDA
#undef PG8_LDB
#undef PG8_MMA
#undef PG8_WAIT_V
#undef PG8_WAIT_L
#undef PG8_BAR
#undef PG8_SCHED
}
}

typedef f32x4 Acc[2][2][4][2];

struct EpiZ {
    static constexpr bool SPLIT = false;
    const float* rstd1; bf16_t* z; float* out;
    __device__ __forceinline__ void operator()(const Acc& acc, const pg8::Unit& u, int wr, int wc, int fr, int fq) const {
        asm volatile("" : "+v"(fr), "+v"(fq));
        const int col0 = u.pn * 256 + wc * 32 + 8 * fq;
#pragma unroll
        for (int ai = 0; ai < 2; ++ai)
#pragma unroll
            for (int m = 0; m < 4; ++m) {
                const int r = u.pm * 256 + ai * 128 + wr * 64 + m * 16 + fr;
                if (r < M) {
                    const float rs = rstd1[r];
                    int is_s, seq, t; row_decode(r, is_s, seq, t);
                    float* so = nullptr;
                    if (u.pn < 6) { if (is_s) { if (t >= TS - 3) so = out + O_SRC + ((size_t)seq * 3 + (t - (TS - 3))) * DA; } else { if (t >= TP - 3) so = out + O_PRC + ((size_t)seq * 3 + (t - (TP - 3))) * DA; } }
#pragma unroll
                    for (int bj = 0; bj < 2; ++bj) {
                        const f32x4 v0 = acc[ai][bj][m][0] * rs, v1 = acc[ai][bj][m][1] * rs;
                        u32x4 w; w.x = cvt_pk_bf16(v0[0], v0[1]); w.y = cvt_pk_bf16(v0[2], v0[3]); w.z = cvt_pk_bf16(v1[0], v1[1]); w.w = cvt_pk_bf16(v1[2], v1[3]);
                        *(u32x4*)(z + (size_t)r * DIN + col0 + bj * 128) = w;
                        if (so) { *(f32x4*)(so + col0 + bj * 128) = v0; *(f32x4*)(so + col0 + bj * 128 + 4) = v1; }
                    }
                }
            }
    }
};
struct EpiX1 {
    static constexpr bool SPLIT = true;
    const float *xp, *xs, *meta; float* out; bf16_t* x1b; float* ssq;
    __device__ __forceinline__ void operator()(const Acc& acc, const pg8::Unit& u, int wr, int wc, int fr, int fq, unsigned gmask = 0xffu) const {
        asm volatile("" : "+v"(fr), "+v"(fq));
        const int col0 = u.pn * 256 + wc * 32 + 8 * fq;
#pragma unroll
        for (int ai = 0; ai < 2; ++ai)
#pragma unroll
            for (int m = 0; m < 4; ++m) {
                if (!((gmask >> (ai * 4 + m)) & 1u)) continue;
                const int r = u.pm * 256 + ai * 128 + wr * 64 + m * 16 + fr;
                const bool valid = r < M;
                const float* xr = x_row_ptr(xp, xs, meta, valid ? r : 0);
                float* yd = y_row_ptr(out, r);
                float ss = 0.f;
#pragma unroll
                for (int bj = 0; bj < 2; ++bj) {
                    const int c = col0 + bj * 128;
                    const f32x4 v0 = acc[ai][bj][m][0] + *(const f32x4*)(xr + c), v1 = acc[ai][bj][m][1] + *(const f32x4*)(xr + c + 4);
                    ss += (v0[0] * v0[0] + v0[1] * v0[1]) + (v0[2] * v0[2] + v0[3] * v0[3]) + (v1[0] * v1[0] + v1[1] * v1[1]) + (v1[2] * v1[2] + v1[3] * v1[3]);
                    if (yd) { *(f32x4*)(yd + c) = v0; *(f32x4*)(yd + c + 4) = v1; }
                    if (valid) { u32x4 w; w.x = cvt_pk_bf16(v0[0], v0[1]); w.y = cvt_pk_bf16(v0[2], v0[3]); w.z = cvt_pk_bf16(v1[0], v1[1]); w.w = cvt_pk_bf16(v1[2], v1[3]);
                        *(u32x4*)(x1b + (size_t)r * D + c) = w; }
                }
                ss += __shfl_xor(ss, 16); ss += __shfl_xor(ss, 32);
                if (valid && fq == 0) ssq[(size_t)r * 32 + u.pn * 4 + wc] = ss;
            }
    }
};
struct EpiOut {
    static constexpr bool SPLIT = true;
    float* out;
    __device__ __forceinline__ void operator()(const Acc& acc, const pg8::Unit& u, int wr, int wc, int fr, int fq, unsigned gmask = 0xffu) const {
        asm volatile("" : "+v"(fr), "+v"(fq));
        const int col0 = u.pn * 256 + wc * 32 + 8 * fq;
#pragma unroll
        for (int ai = 0; ai < 2; ++ai)
#pragma unroll
            for (int m = 0; m < 4; ++m) {
                if (!((gmask >> (ai * 4 + m)) & 1u)) continue;
                const int r = u.pm * 256 + ai * 128 + wr * 64 + m * 16 + fr;
                float* yd = y_row_ptr(out, r);
                if (yd) {
#pragma unroll
                    for (int bj = 0; bj < 2; ++bj) {
                        const int c = col0 + bj * 128;
                        const f32x4 v0 = acc[ai][bj][m][0] + *(const f32x4*)(yd + c), v1 = acc[ai][bj][m][1] + *(const f32x4*)(yd + c + 4);
                        *(f32x4*)(yd + c) = v0; *(f32x4*)(yd + c + 4) = v1;
                    }
                }
            }
    }
};
struct EpiFFN {
    static constexpr bool SPLIT = false;
    const float *ssq, *cw, *cb, *st_fc; bf16_t* hid; float* out;
    __device__ __forceinline__ void operator()(Acc& acc, const pg8::Unit& u, int wr, int wc, int fr, int fq) const {
        asm volatile("" : "+v"(fr), "+v"(fq));
        const int gbase = 252 * u.pm - 2 + 126 * wr;
        const int f0 = 128 * u.pn + 32 * wc + 8 * fq;
#pragma unroll
        for (int ai = 0; ai < 2; ++ai)
#pragma unroll
            for (int m = 0; m < 4; ++m) {
                int r = gbase + 64 * ai + 16 * m + fr; r = r < 0 ? 0 : (r >= M ? M - 1 : r);
                const float* sp = ssq + (size_t)r * 32 + 8 * fq;
                const f32x4 a = *(const f32x4*)sp, b = *(const f32x4*)(sp + 4);
                float s = ((a[0] + a[1]) + (a[2] + a[3])) + ((b[0] + b[1]) + (b[2] + b[3]));
                s += __shfl_xor(s, 16); s += __shfl_xor(s, 32);
                const float rs = __builtin_amdgcn_rsqf(s * (1.0f / D) + EPS);
#pragma unroll
                for (int bj = 0; bj < 2; ++bj)
#pragma unroll
                    for (int n = 0; n < 2; ++n) acc[ai][bj][m][n] *= rs;
                if (m & 1) __builtin_amdgcn_sched_barrier(0);
            }
        const f32x4 w0a = *(const f32x4*)(cw + f0), w0b = *(const f32x4*)(cw + f0 + 4);
        const f32x4 w1a = *(const f32x4*)(cw + DFF + f0), w1b = *(const f32x4*)(cw + DFF + f0 + 4);
        const f32x4 w2a = *(const f32x4*)(cw + 2 * DFF + f0), w2b = *(const f32x4*)(cw + 2 * DFF + f0 + 4);
        const f32x4 bba = *(const f32x4*)(cb + f0), bbb = *(const f32x4*)(cb + f0 + 4);
#pragma unroll
        for (int ai = 0; ai < 2; ++ai)
#pragma unroll
            for (int m = 0; m < 4; ++m) {
                const int j = 64 * ai + 16 * m + fr, r = gbase + j;
                const bool valid = (j >= 2) && (r < M);
                const f32x4 c0 = acc[ai][0][m][0], c1 = acc[ai][0][m][1];
                const int pai = (m == 0) ? (ai == 0 ? 0 : ai - 1) : ai, pm_ = (m == 0) ? (ai == 0 ? 0 : 3) : m - 1;
                const f32x4 q0 = acc[pai][0][pm_][0], q1 = acc[pai][0][pm_][1];
                f32x4 p1a, p1b, p2a, p2b;
#pragma unroll
                for (int e = 0; e < 4; ++e) {
                    p1a[e] = dppf<0x111>(dppf<0x121>(0.f, q0[e]), c0[e]); p1b[e] = dppf<0x111>(dppf<0x121>(0.f, q1[e]), c1[e]);
                    p2a[e] = dppf<0x112>(dppf<0x122>(0.f, q0[e]), c0[e]); p2b[e] = dppf<0x112>(dppf<0x122>(0.f, q1[e]), c1[e]);
                }
                int is_s, seq, t; row_decode(valid ? r : 0, is_s, seq, t);
                if (valid && t < 2) {
                    f32x4 s0a = (f32x4){0.f, 0.f, 0.f, 0.f}, s0b = s0a, s1a = s0a, s1b = s0a;
                    if (is_s) { const float* sp = st_fc + (size_t)seq * 2 * DFF + f0; s0a = *(const f32x4*)sp; s0b = *(const f32x4*)(sp + 4); s1a = *(const f32x4*)(sp + DFF); s1b = *(const f32x4*)(sp + DFF + 4); }
                    if (t == 0) { p1a = s1a; p1b = s1b; p2a = s0a; p2b = s0b; } else { p2a = s1a; p2b = s1b; }
                }
                const f32x4 ga = w0a * p2a + w1a * p1a + w2a * c0 + bba, gb = w0b * p2b + w1b * p1b + w2b * c1 + bbb;
                const f32x4 va = acc[ai][1][m][0], vb = acc[ai][1][m][1];
                if (valid) {
                    u32x4 w;
                    w.x = cvt_pk_bf16(gelu_tanh(ga[0]) * va[0], gelu_tanh(ga[1]) * va[1]); w.y = cvt_pk_bf16(gelu_tanh(ga[2]) * va[2], gelu_tanh(ga[3]) * va[3]);
                    w.z = cvt_pk_bf16(gelu_tanh(gb[0]) * vb[0], gelu_tanh(gb[1]) * vb[1]); w.w = cvt_pk_bf16(gelu_tanh(gb[2]) * vb[2], gelu_tanh(gb[3]) * vb[3]);
                    *(u32x4*)(hid + (size_t)r * DFF + f0) = w;
                    const int T = is_s ? TS : TP;
                    if (t >= T - 2) { float* so = out + (is_s ? O_SFC : O_PFC) + ((size_t)seq * 2 + (t - (T - 2))) * DFF + f0; *(f32x4*)so = c0; *(f32x4*)(so + 4) = c1; }
                }
                __builtin_amdgcn_sched_barrier(0);
            }
    }
};

__device__ __forceinline__ int invperm32(int q) { return 16 * ((q >> 2) & 1) + 4 * (q >> 3) + (q & 3); }
__device__ __forceinline__ void p0_transpose_item(const float* W, int K, int N, const float* kscale, bf16_t* WT, int mode, LAS float* scr, int item, int lane) {
    const int nblk = N / 32, kb = item / nblk, nb = item % nblk, k0 = 64 * kb, n0 = 32 * nb;
    float v[32];
    const float* src = W + (size_t)(k0 + (lane >> 5)) * N + n0 + (lane & 31);
#pragma unroll
    for (int i = 0; i < 32; ++i) v[i] = src[(size_t)(2 * i) * N];
#pragma unroll
    for (int i = 0; i < 32; ++i) scr[(2 * i + (lane >> 5)) * 33 + (lane & 31)] = v[i];
    asm volatile("s_waitcnt lgkmcnt(0)" ::: "memory");
    int rbase = n0;
    if (mode == 1) { const int bj = n0 >= DFF ? 1 : 0, f = n0 - bj * DFF; rbase = 256 * (f >> 7) + 128 * bj + (f & 96); }
    const int c = lane & 7;
    f32x4 ks0 = (f32x4){1.f, 1.f, 1.f, 1.f}, ks1 = ks0;
    if (kscale) { ks0 = *(const f32x4*)(kscale + k0 + 8 * c); ks1 = *(const f32x4*)(kscale + k0 + 8 * c + 4); }
#pragma unroll
    for (int j = 0; j < 4; ++j) { const int n = (lane >> 3) + 8 * j; const LAS float* sp = scr + (8 * c) * 33 + n;
        u32x4 o; o.x = cvt_pk_bf16(sp[0 * 33] * ks0[0], sp[1 * 33] * ks0[1]); o.y = cvt_pk_bf16(sp[2 * 33] * ks0[2], sp[3 * 33] * ks0[3]);
        o.z = cvt_pk_bf16(sp[4 * 33] * ks1[0], sp[5 * 33] * ks1[1]); o.w = cvt_pk_bf16(sp[6 * 33] * ks1[2], sp[7 * 33] * ks1[3]);
        *(u32x4*)(WT + (size_t)(rbase + (mode == 2 ? n : invperm32(n))) * K + k0 + 8 * c) = o; }
    asm volatile("s_waitcnt lgkmcnt(0)" ::: "memory");
}
constexpr int I_IN = (D / 64) * (DIN / 32), I_O = (DMIX / 64) * (D / 32), I_UP = (D / 64) * (2 * DFF / 32), I_DN = (DFF / 64) * (D / 32), I_G = 2 * NH * 8;
constexpr int IT_O = I_IN, IT_UP = IT_O + I_O, IT_DN = IT_UP + I_UP, IT_G = IT_DN + I_DN, IT_END = IT_G + I_G;
__device__ __forceinline__ void convert_items(PRef p, LAS unsigned char* lds, int rank, int nwaves, int lo, int hi) {
    const int tid_ = opaque_tid(), lane = tid_ & 63, wave = tid_ >> 6;
    unsigned char* ws = p.ws;
    LAS float* scr = (LAS float*)(lds + wave * 16384);
    for (int it = lo + rank; it < hi; it += nwaves) {
        int r = it;
        if (r < I_IN) { p0_transpose_item(p.w_in, D, DIN, p.g_mix, (bf16_t*)(ws + WS_WIN), 0, scr, r, lane); continue; } r -= I_IN;
        if (r < I_O) { p0_transpose_item(p.w_o, DMIX, D, nullptr, (bf16_t*)(ws + WS_WO), 0, scr, r, lane); continue; } r -= I_O;
        if (r < I_UP) { p0_transpose_item(p.w_up, D, 2 * DFF, p.g_ffn, (bf16_t*)(ws + WS_WUP), 1, scr, r, lane); continue; } r -= I_UP;
        if (r < I_DN) { p0_transpose_item(p.w_down, DFF, D, nullptr, (bf16_t*)(ws + WS_WDN), 0, scr, r, lane); continue; } r -= I_DN;
        { const int mat = r >> 3, sub = r & 7, gsel = mat / NH, n = mat % NH;
          p0_transpose_item((gsel ? p.w_gate_x : p.w_gate_a) + (size_t)n * 128 * 128, 128, 128, nullptr, (bf16_t*)(ws + WS_WG) + (size_t)mat * 128 * 128, 0, scr, sub, lane); }
    }
}
constexpr int P1_TAIL_WG0 = (888 % 256), P4_TAIL_WG0 = (296 % 256) * P4_SPLIT, MIX_IDLE_WG0 = 228, IT_S1 = IT_O + 9000, IT_S2 = IT_S1 + 2400, IT_S3 = IT_S2 + 2400;
__device__ __forceinline__ void phase0(PRef p, LAS unsigned char* lds, int G) {
    const int tid = opaque_tid(), lane = tid & 63, wave = tid >> 6;
    unsigned char* ws = p.ws;
    const int gw = blockIdx.x * 8 + wave, NGW = G * 8;
    convert_items(p, lds, gw, NGW, 0, IT_O);
    convert_items(p, lds, gw, NGW, IT_G, IT_END);
    { bf16_t* xb = (bf16_t*)(ws + WS_XB) + (size_t)16 * D; float* rstd1 = (float*)(ws + WS_RS1);
      for (int m = gw; m < M; m += NGW) {
          const f32x4* xr = (const f32x4*)x_row_ptr(p.x_prompt, p.x_sample, p.meta, m) + lane;
          f32x4 v[8]; float s = 0.f;
#pragma unroll
          for (int j = 0; j < 8; ++j) { v[j] = xr[64 * j]; s += (v[j][0] * v[j][0] + v[j][1] * v[j][1]) + (v[j][2] * v[j][2] + v[j][3] * v[j][3]); }
          s = wave_sum(s);
          if (lane == 0) rstd1[m] = __builtin_amdgcn_rsqf(s * (1.0f / D) + EPS);
          u32x2* o = (u32x2*)(xb + (size_t)m * D) + lane;
#pragma unroll
          for (int j = 0; j < 8; ++j) { u32x2 w; w.x = cvt_pk_bf16(v[j][0], v[j][1]); w.y = cvt_pk_bf16(v[j][2], v[j][3]); o[64 * j] = w; }
      } }
}

__device__ __forceinline__ void branch_b(PRef p, int G) {
    const bf16_t* z = (const bf16_t*)(p.ws + WS_Z); bf16_t* ym = (bf16_t*)(p.ws + WS_YM);
    const int total = M * 128;
    for (int idx = blockIdx.x * 512 + opaque_tid(); idx < total; idx += G * 512) {
        const int m = idx >> 7, g = idx & 127, ch = 8 * g;
        int is_s, seq, t; row_decode(m, is_s, seq, t);
        float u[3][8];
#pragma unroll
        for (int k = 0; k < 3; ++k) {
            const int tt = t - 2 + k;
            if (tt >= 0) {
                float a[8], b[8];
                unpack8(*(const u32x4*)(z + (size_t)(m - 2 + k) * DIN + 4096 + ch), a); unpack8(*(const u32x4*)(z + (size_t)(m - 2 + k) * DIN + 5120 + ch), b);
#pragma unroll
                for (int e = 0; e < 8; ++e) u[k][e] = a[e] * b[e];
            } else if (is_s) {
                const float* sp = p.st_sc + ((size_t)seq * 2 + (tt + 2)) * DB + ch; const f32x4 a = *(const f32x4*)sp, b = *(const f32x4*)(sp + 4);
#pragma unroll
                for (int e = 0; e < 4; ++e) { u[k][e] = a[e]; u[k][4 + e] = b[e]; }
            } else {
#pragma unroll
                for (int e = 0; e < 8; ++e) u[k][e] = 0.f;
            }
        }
        float gb[8]; unpack8(*(const u32x4*)(z + (size_t)m * DIN + 3072 + ch), gb);
        float y[8]; float ss = 0.f;
#pragma unroll
        for (int e = 0; e < 8; ++e) {
            const float uc = p.conv_b_w[ch + e] * u[0][e] + p.conv_b_w[DB + ch + e] * u[1][e] + p.conv_b_w[2 * DB + ch + e] * u[2][e];
            y[e] = gb[e] * uc; ss += y[e] * y[e];
        }
        ss = sum16(ss);
        const float rn = __builtin_amdgcn_rsqf(ss * (1.0f / 128.0f) + EPS);
#pragma unroll
        for (int e = 0; e < 8; ++e) y[e] = y[e] * rn * p.g_out_b[ch + e];
        *(u32x4*)(ym + (size_t)m * DMIX + DA + ch) = pack8(y);
        const int T = is_s ? TS : TP;
        if (t >= T - 2) { float* so = p.out + (is_s ? O_SSC : O_PSC) + ((size_t)seq * 2 + (t - (T - 2))) * DB + ch;
            *(f32x4*)so = (f32x4){u[2][0], u[2][1], u[2][2], u[2][3]}; *(f32x4*)(so + 4) = (f32x4){u[2][4], u[2][5], u[2][6], u[2][7]}; }
    }
}

constexpr int LW_STRIDE = 272, L_WA = 0, L_WX = 128 * LW_STRIDE, L_CT = 2 * 128 * LW_STRIDE, L_LRU_END = L_CT + 9 * 128 * 4;
static_assert(L_LRU_END <= 131072, "mixer LDS");
constexpr int LRU_WG_PER_HEAD = 19, LRU_NSEG = 33, LRU_PITEMS = NB * LRU_NSEG, LRU_SITEMS = MSR / 64;
static_assert(LRU_WG_PER_HEAD * 8 >= LRU_PITEMS + LRU_SITEMS, "waves per head");

template <int CTRL, int BANK> __device__ __forceinline__ float dppfb(float old, float src) {
    return __builtin_bit_cast(float, __builtin_amdgcn_update_dpp(__builtin_bit_cast(int, old), __builtin_bit_cast(int, src), CTRL, 0xF, BANK, false));
}
__device__ __forceinline__ float bcast15(float x, int lane) {
    return __builtin_bit_cast(float, __builtin_amdgcn_ds_bpermute(((lane & 48) | 15) << 2, __builtin_bit_cast(int, x)));
}
__device__ __forceinline__ void scan16(float& P, float& S) {
    float Sd, Pd;
    Sd = dppf<0x111>(0.f, S); Pd = dppf<0x111>(1.f, P); S = __builtin_fmaf(P, Sd, S); P *= Pd;
    Sd = dppf<0x112>(0.f, S); Pd = dppf<0x112>(1.f, P); S = __builtin_fmaf(P, Sd, S); P *= Pd;
    Sd = dppf<0x114>(0.f, S); Pd = dppf<0x114>(1.f, P); S = __builtin_fmaf(P, Sd, S); P *= Pd;
    Sd = dppf<0x118>(0.f, S); Pd = dppf<0x118>(1.f, P); S = __builtin_fmaf(P, Sd, S); P *= Pd;
}
__device__ __forceinline__ void scan8(float& P, float& S, int t) {
    float Sd, Pd;
    Sd = dppf<0x111>(0.f, S); Pd = dppf<0x111>(1.f, P); if (t < 1) { Sd = 0.f; Pd = 1.f; } S = __builtin_fmaf(P, Sd, S); P *= Pd;
    Sd = dppf<0x112>(0.f, S); Pd = dppf<0x112>(1.f, P); if (t < 2) { Sd = 0.f; Pd = 1.f; } S = __builtin_fmaf(P, Sd, S); P *= Pd;
    Sd = dppfb<0x114, 0xA>(0.f, S); Pd = dppfb<0x114, 0xA>(1.f, P); S = __builtin_fmaf(P, Sd, S); P *= Pd;
}

template <int PASS, bool IS_S>
__device__ __forceinline__ void lru_wave_item(PRef p, LAS unsigned char* lds, int n, int b, int seg) {
    const int lane = opaque_tid() & 63, fr = lane & 15, fq = lane >> 4;
    const bf16_t* z = (const bf16_t*)(p.ws + WS_Z);
    bf16_t* ym = (bf16_t*)(p.ws + WS_YM);
    float* tot = (float*)(p.ws + WS_TOT);
    const LAS float* CT = (const LAS float*)(lds + L_CT) + 8 * fq;
    const int gch = n * 128 + 8 * fq;
    const int r0 = IS_S ? MPR + b * 64 : b * TP + seg * 64;
    const int nblk = IS_S ? 4 : (seg == LRU_NSEG - 1 ? 1 : 4);
    float hin[4][8], Pt[4][8];
    u32x4 prevx[4];
#pragma unroll
    for (int ks = 0; ks < 4; ++ks) {
#pragma unroll
        for (int e = 0; e < 8; ++e) { hin[ks][e] = 0.f; Pt[ks][e] = 1.f; }
        prevx[ks] = (u32x4){0u, 0u, 0u, 0u};
    }
    if constexpr (!IS_S) {
        if (seg > 0) {
#pragma unroll
            for (int ks = 0; ks < 4; ++ks) prevx[ks] = *(const u32x4*)(z + (size_t)(r0 - 16 + fr) * DIN + gch + 32 * ks);
            if constexpr (PASS == 2) {
#pragma unroll 1
                for (int round = 0; round < 2; ++round) {
                    const int s = 16 * round + fr;
                    if (16 * round >= seg) break;
                    const bool have = s < seg;
                    const float* tp = tot + ((size_t)(b * LRU_NSEG + (have ? s : 0)) * 2) * DA + gch;
#pragma unroll
                    for (int ks = 0; ks < 4; ++ks) {
                        const f32x4 P0 = *(const f32x4*)(tp + 32 * ks), P1 = *(const f32x4*)(tp + 32 * ks + 4), S0 = *(const f32x4*)(tp + DA + 32 * ks), S1 = *(const f32x4*)(tp + DA + 32 * ks + 4);
#pragma unroll
                        for (int e = 0; e < 8; ++e) {
                            float P = have ? (e < 4 ? P0[e & 3] : P1[e & 3]) : 1.f, S = have ? (e < 4 ? S0[e & 3] : S1[e & 3]) : 0.f;
                            scan16(P, S);
                            const float Pc = bcast15(P, lane), Sc = bcast15(S, lane);
                            hin[ks][e] = __builtin_fmaf(Pc, hin[ks][e], Sc);
                        }
                    }
                }
            }
        }
    }
#pragma unroll 1
    for (int blk = 0; blk < nblk; ++blk) {
        const int r = r0 + 16 * blk + fr;
        const int t8 = fr & 7, sq = (r - MPR) >> 3;
        u32x4 x4[4], g4[4];
#pragma unroll
        for (int ks = 0; ks < 4; ++ks) { x4[ks] = *(const u32x4*)(z + (size_t)r * DIN + gch + 32 * ks); if constexpr (PASS == 2) g4[ks] = *(const u32x4*)(z + (size_t)r * DIN + DA + gch + 32 * ks); }
        float xc[4][8];
        bf16x8 bfrag[4];
#pragma unroll
        for (int ks = 0; ks < 4; ++ks) {
            float xf[8]; unpack8(x4[ks], xf);
            const f32x4 w0a = *(const LAS f32x4*)(CT + 0 * 128 + 32 * ks), w0b = *(const LAS f32x4*)(CT + 0 * 128 + 32 * ks + 4);
            const f32x4 w1a = *(const LAS f32x4*)(CT + 1 * 128 + 32 * ks), w1b = *(const LAS f32x4*)(CT + 1 * 128 + 32 * ks + 4);
            const f32x4 w2a = *(const LAS f32x4*)(CT + 2 * 128 + 32 * ks), w2b = *(const LAS f32x4*)(CT + 2 * 128 + 32 * ks + 4);
            const f32x4 w3a = *(const LAS f32x4*)(CT + 3 * 128 + 32 * ks), w3b = *(const LAS f32x4*)(CT + 3 * 128 + 32 * ks + 4);
            const f32x4 cba = *(const LAS f32x4*)(CT + 4 * 128 + 32 * ks), cbb = *(const LAS f32x4*)(CT + 4 * 128 + 32 * ks + 4);
            if constexpr (IS_S) {
                const float* sp = p.st_rc + (size_t)sq * 3 * DA + gch + 32 * ks;
                const f32x4 b0a = *(const f32x4*)sp, b0b = *(const f32x4*)(sp + 4), b1a = *(const f32x4*)(sp + DA), b1b = *(const f32x4*)(sp + DA + 4), b2a = *(const f32x4*)(sp + 2 * DA), b2b = *(const f32x4*)(sp + 2 * DA + 4);
#pragma unroll
                for (int e = 0; e < 8; ++e) {
                    const float bb0 = e < 4 ? b0a[e & 3] : b0b[e & 3], bb1 = e < 4 ? b1a[e & 3] : b1b[e & 3], bb2 = e < 4 ? b2a[e & 3] : b2b[e & 3];
                    const float s1 = dppf<0x111>(0.f, xf[e]), s2 = dppf<0x112>(0.f, xf[e]), s3 = dppf<0x113>(0.f, xf[e]);
                    const float x1 = t8 >= 1 ? s1 : bb2;
                    const float x2 = t8 >= 2 ? s2 : (t8 == 1 ? bb2 : bb1);
                    const float x3 = t8 >= 3 ? s3 : (t8 == 2 ? bb2 : (t8 == 1 ? bb1 : bb0));
                    const float w0 = e < 4 ? w0a[e & 3] : w0b[e & 3], w1 = e < 4 ? w1a[e & 3] : w1b[e & 3], w2 = e < 4 ? w2a[e & 3] : w2b[e & 3], w3 = e < 4 ? w3a[e & 3] : w3b[e & 3];
                    xc[ks][e] = (e < 4 ? cba[e & 3] : cbb[e & 3]) + w3 * xf[e] + w2 * x1 + w1 * x2 + w0 * x3;
                }
            } else {
                float pf[8]; unpack8(prevx[ks], pf);
#pragma unroll
                for (int e = 0; e < 8; ++e) {
                    const float x1 = dppf<0x111>(dppf<0x121>(0.f, pf[e]), xf[e]);
                    const float x2 = dppf<0x112>(dppf<0x122>(0.f, pf[e]), xf[e]);
                    const float x3 = dppf<0x113>(dppf<0x123>(0.f, pf[e]), xf[e]);
                    const float w0 = e < 4 ? w0a[e & 3] : w0b[e & 3], w1 = e < 4 ? w1a[e & 3] : w1b[e & 3], w2 = e < 4 ? w2a[e & 3] : w2b[e & 3], w3 = e < 4 ? w3a[e & 3] : w3b[e & 3];
                    xc[ks][e] = (e < 4 ? cba[e & 3] : cbb[e & 3]) + w3 * xf[e] + w2 * x1 + w1 * x2 + w0 * x3;
                }
                prevx[ks] = x4[ks];
            }
            bfrag[ks] = __builtin_bit_cast(bf16x8, pack8(xc[ks]));
        }
        f32x4 aa[8], ax[8];
#pragma unroll
        for (int nb = 0; nb < 8; ++nb) { aa[nb] = (f32x4){0.f, 0.f, 0.f, 0.f}; ax[nb] = (f32x4){0.f, 0.f, 0.f, 0.f}; }
#pragma unroll
        for (int ks = 0; ks < 4; ++ks)
#pragma unroll
            for (int nb = 0; nb < 8; ++nb) {
                const bf16x8 wa = *(const LAS bf16x8*)(lds + L_WA + (16 * nb + fr) * LW_STRIDE + (32 * ks + 8 * fq) * 2);
                const bf16x8 wx = *(const LAS bf16x8*)(lds + L_WX + (16 * nb + fr) * LW_STRIDE + (32 * ks + 8 * fq) * 2);
                aa[nb] = __builtin_amdgcn_mfma_f32_16x16x32_bf16(wa, bfrag[ks], aa[nb], 0, 0, 0);
                ax[nb] = __builtin_amdgcn_mfma_f32_16x16x32_bf16(wx, bfrag[ks], ax[nb], 0, 0, 0);
            }
        float y[4][8]; float ss = 0.f;
#pragma unroll
        for (int ks = 0; ks < 4; ++ks) {
            const f32x4 bga0 = *(const LAS f32x4*)(CT + 5 * 128 + 32 * ks), bga1 = *(const LAS f32x4*)(CT + 5 * 128 + 32 * ks + 4);
            const f32x4 bgx0 = *(const LAS f32x4*)(CT + 6 * 128 + 32 * ks), bgx1 = *(const LAS f32x4*)(CT + 6 * 128 + 32 * ks + 4);
            const f32x4 sp0 = *(const LAS f32x4*)(CT + 7 * 128 + 32 * ks), sp1 = *(const LAS f32x4*)(CT + 7 * 128 + 32 * ks + 4);
            float gav[8];
            if constexpr (PASS == 2) unpack8(g4[ks], gav);
            f32x4 h0a, h0b;
            if constexpr (IS_S) { const float* hp = p.st_h + (size_t)sq * DA + gch + 32 * ks; h0a = *(const f32x4*)hp; h0b = *(const f32x4*)(hp + 4); }
            float hv[8];
#pragma unroll
            for (int e = 0; e < 8; ++e) {
                const int nb = 2 * ks + (e >> 2), rg = e & 3;
                const float rr = sigmoidf_(aa[nb][rg] + (e < 4 ? bga0[rg] : bga1[rg])), ii = sigmoidf_(ax[nb][rg] + (e < 4 ? bgx0[rg] : bgx1[rg]));
                const float la = -8.0f * rr * (e < 4 ? sp0[rg] : sp1[rg]);
                const float a = __expf(la);
                const float om = __builtin_fmaf(-a, a, 1.0f);
                float P = a, S = __builtin_amdgcn_sqrtf(om > 0.f ? om : 0.f) * (ii * xc[ks][e]);
                float h;
                if constexpr (IS_S) { scan8(P, S, t8); h = __builtin_fmaf(P, e < 4 ? h0a[rg] : h0b[rg], S); }
                else {
                    scan16(P, S);
                    h = __builtin_fmaf(P, hin[ks][e], S);
                    hin[ks][e] = bcast15(h, lane);
                    if constexpr (PASS == 1) Pt[ks][e] *= bcast15(P, lane);
                }
                hv[e] = h;
                if constexpr (PASS == 2) { y[ks][e] = gelu_tanh(gav[e]) * h; ss += y[ks][e] * y[ks][e]; }
            }
            if constexpr (PASS == 2) {
                if (IS_S ? (t8 == 7) : (seg == LRU_NSEG - 1 && fr == 15)) {
                    float* ho = p.out + (IS_S ? O_SH + (size_t)sq * DA : O_PH + (size_t)b * DA) + gch + 32 * ks;
                    *(f32x4*)ho = (f32x4){hv[0], hv[1], hv[2], hv[3]}; *(f32x4*)(ho + 4) = (f32x4){hv[4], hv[5], hv[6], hv[7]};
                }
            }
        }
        if constexpr (PASS == 2) {
            ss += __shfl_xor(ss, 16); ss += __shfl_xor(ss, 32);
            const float rn = __builtin_amdgcn_rsqf(ss * (1.0f / 128.0f) + EPS);
#pragma unroll
            for (int ks = 0; ks < 4; ++ks) {
                const f32x4 g0 = *(const LAS f32x4*)(CT + 8 * 128 + 32 * ks), g1 = *(const LAS f32x4*)(CT + 8 * 128 + 32 * ks + 4);
                float o[8];
#pragma unroll
                for (int e = 0; e < 8; ++e) o[e] = y[ks][e] * rn * (e < 4 ? g0[e & 3] : g1[e & 3]);
                *(u32x4*)(ym + (size_t)r * DMIX + gch + 32 * ks) = pack8(o);
            }
        }
    }
    if constexpr (PASS == 1 && !IS_S) {
        if (fr == 0) {
            float* tp = tot + ((size_t)(b * LRU_NSEG + seg) * 2) * DA + gch;
#pragma unroll
            for (int ks = 0; ks < 4; ++ks) {
                *(f32x4*)(tp + 32 * ks) = (f32x4){Pt[ks][0], Pt[ks][1], Pt[ks][2], Pt[ks][3]}; *(f32x4*)(tp + 32 * ks + 4) = (f32x4){Pt[ks][4], Pt[ks][5], Pt[ks][6], Pt[ks][7]};
                *(f32x4*)(tp + DA + 32 * ks) = (f32x4){hin[ks][0], hin[ks][1], hin[ks][2], hin[ks][3]}; *(f32x4*)(tp + DA + 32 * ks + 4) = (f32x4){hin[ks][4], hin[ks][5], hin[ks][6], hin[ks][7]};
            }
        }
    }
}
template <int PASS>
__device__ __forceinline__ void mixer_phase(PRef p, LAS unsigned char* lds, int G) {
    const int tid = opaque_tid(), wave = __builtin_amdgcn_readfirstlane(tid >> 6);
    for (int v = blockIdx.x; v < NH * LRU_WG_PER_HEAD; v += G) {
        const int n = v / LRU_WG_PER_HEAD;
        __syncthreads();
        {
            const bf16_t* wg = (const bf16_t*)(p.ws + WS_WG);
            for (int i = tid; i < 2 * 128 * 16; i += 512) { const int g = i >> 11, row = (i >> 4) & 127, c16 = i & 15;
                *(LAS u32x4*)(lds + g * L_WX + row * LW_STRIDE + c16 * 16) = *(const u32x4*)(wg + (((size_t)g * NH + n) * 128 + row) * 128 + c16 * 8); }
            LAS float* CTw = (LAS float*)(lds + L_CT);
            for (int i = tid; i < 9 * 128; i += 512) { const int k = i >> 7, c = i & 127, ch = n * 128 + c;
                float vv;
                if (k < 4) vv = p.conv_a_w[k * DA + ch]; else if (k == 4) vv = p.conv_a_b[ch]; else if (k == 5) vv = p.b_gate_a[ch]; else if (k == 6) vv = p.b_gate_x[ch];
                else if (k == 7) vv = log1pf(__expf(-p.lam[ch])); else vv = p.g_out_a[ch];
                CTw[i] = vv; }
        }
        __syncthreads();
        const int wi = (v % LRU_WG_PER_HEAD) * 8 + wave;
        if (wi < LRU_PITEMS) lru_wave_item<PASS, false>(p, lds, n, wi / LRU_NSEG, wi % LRU_NSEG);
        else if (PASS == 2 && wi < LRU_PITEMS + LRU_SITEMS) lru_wave_item<PASS, true>(p, lds, n, wi - LRU_PITEMS, 0);
    }
    if (G == 256 && (int)blockIdx.x >= MIX_IDLE_WG0) convert_items(p, lds, ((int)blockIdx.x - MIX_IDLE_WG0) * 8 + wave, (G - MIX_IDLE_WG0) * 8, PASS == 1 ? IT_S1 : IT_S2, PASS == 1 ? IT_S2 : IT_S3);
    if (PASS == 1) branch_b(p, G);
}

__device__ __forceinline__ void final_phase(PRef p, int G, float* probe_dst = nullptr) {
    const int tid_ = opaque_tid(), lane = tid_ & 63, gw = blockIdx.x * 8 + (tid_ >> 6), NGW = G * 8;
    f32x4 gf[8];
#pragma unroll
    for (int j = 0; j < 8; ++j) gf[j] = ((const f32x4*)p.g_final)[lane + 64 * j];
    for (int r = gw; r < NB * SEQ + MSR; r += NGW) {
        f32x4* yr = (f32x4*)(p.out + (size_t)r * D) + lane;
        f32x4 v[8]; float s = 0.f;
#pragma unroll
        for (int j = 0; j < 8; ++j) { v[j] = yr[64 * j]; s += (v[j][0] * v[j][0] + v[j][1] * v[j][1]) + (v[j][2] * v[j][2] + v[j][3] * v[j][3]); }
        s = wave_sum(s);
        const float rs = __builtin_amdgcn_rsqf(s * (1.0f / D) + EPS);
        f32x4* yo = probe_dst ? (f32x4*)(probe_dst + (size_t)r * D) + lane : yr;
#pragma unroll
        for (int j = 0; j < 8; ++j) yo[64 * j] = v[j] * rs * gf[j];
    }
}


#define XB_TMO      128
#define XB_XCNT(j)  (256  + 64 * (j))
#define XB_XSUB(j)  (1280 + 64 * (j))
#define XB_XGEN(j)  (2304 + 64 * (j))
#define XB_TOP      3328
#define XB_TOPGEN   3392
#define XCD_BAR_WORDS 3456
#define XB_SPIN_CAP (1u << 18)
__device__ __forceinline__ unsigned xb_ld(unsigned* p)              { return __hip_atomic_load(p, __ATOMIC_RELAXED, __HIP_MEMORY_SCOPE_AGENT); }
__device__ __forceinline__ unsigned xb_add(unsigned* p, unsigned v) { return __hip_atomic_fetch_add(p, v, __ATOMIC_RELAXED, __HIP_MEMORY_SCOPE_AGENT); }
__device__ __forceinline__ unsigned xb_xcc_id() { return (unsigned)__builtin_amdgcn_s_getreg((3 << 11) | 20) & 0xFu; }
#define XB_SPIN(cond, bar) do { unsigned _sp = 0; while (cond) { __builtin_amdgcn_s_sleep(1); \
    if ((++_sp & 255u) == 0u) { if (xb_ld(&(bar)[XB_TMO])) break; if (_sp > XB_SPIN_CAP) { atomicAdd(&(bar)[XB_TMO], 1u); break; } } } } while (0)
struct XcdBarrier { unsigned* bar; unsigned x; volatile LAS unsigned* st; };
__device__ __forceinline__ XcdBarrier xcd_barrier_post(unsigned* bar, volatile LAS unsigned* st) {
    XcdBarrier b; b.bar = bar; b.x = xb_xcc_id(); b.st = st;
    if (threadIdx.x == 0) (void)xb_add(&bar[XB_XCNT(b.x)], 1u);
    return b;
}
__device__ __forceinline__ void xcd_barrier_complete(unsigned* bar, unsigned x, unsigned& nloc, unsigned& nx) {
    const unsigned G = gridDim.x * gridDim.y * gridDim.z;
    unsigned sum, cnt, mine, sp = 0u;
    for (;;) {
        sum = 0u; cnt = 0u; mine = 0u;
#pragma unroll
        for (unsigned j = 0; j < 16; ++j) { const unsigned c = xb_ld(&bar[XB_XCNT(j)]); sum += c; cnt += (c > 0u) ? 1u : 0u; mine = (j == x) ? c : mine; }
        if (sum == G) break;
        __builtin_amdgcn_s_sleep(1);
        if ((++sp & 255u) == 0u) { if (xb_ld(&bar[XB_TMO])) break; if (sp > XB_SPIN_CAP) { atomicAdd(&bar[XB_TMO], 1u); break; } }
    }
    nloc = mine > 0u ? mine : 1u; nx = cnt > 0u ? cnt : 1u;
}
__device__ __forceinline__ void xcd_barrier(const XcdBarrier& b) {
    asm volatile("s_waitcnt vmcnt(0)" ::: "memory");
    __syncthreads();
    if (threadIdx.x == 0) {
        unsigned* bar = b.bar;
        __builtin_amdgcn_s_waitcnt(0);
        unsigned nloc = b.st[0], nx = b.st[1];
        if (nloc == 0u) { xcd_barrier_complete(bar, b.x, nloc, nx); b.st[0] = nloc; b.st[1] = nx; }
        const unsigned old = xb_add(&bar[XB_XSUB(b.x)], 1u);
        const unsigned gen = old / nloc;
        if (old + 1u == (gen + 1u) * nloc) {
            __builtin_amdgcn_fence(__ATOMIC_RELEASE, "agent");
            asm volatile("s_waitcnt vmcnt(0)" ::: "memory");
            const unsigned og = xb_add(&bar[XB_TOP], 1u);
            const unsigned tg = og / nx;
            if (og + 1u == (tg + 1u) * nx) xb_add(&bar[XB_TOPGEN], 1u);
            else XB_SPIN(xb_ld(&bar[XB_TOPGEN]) == tg, bar);
            __builtin_amdgcn_fence(__ATOMIC_ACQUIRE, "agent");
            xb_add(&bar[XB_XGEN(b.x)], 1u);
            asm volatile("s_waitcnt vmcnt(0)" ::: "memory");
        } else {
            XB_SPIN(xb_ld(&bar[XB_XGEN(b.x)]) == gen, bar);
            __builtin_amdgcn_fence(__ATOMIC_ACQUIRE, "agent");
            asm volatile("s_waitcnt vmcnt(0)" ::: "memory");
        }
    }
    __syncthreads();
}

constexpr int LDS_BYTES = 132096;
constexpr int N_PHASES = 8;
__global__ void __launch_bounds__(512, 2) hymba_fwd(Params p) {
    extern __shared__ __attribute__((aligned(16))) unsigned char lds_raw[];
    LAS unsigned char* lds = (LAS unsigned char*)lds_raw;
    constexpr int G = GRID;
    if ((int)gridDim.x != GRID) return;
    const CAS Params* kp = (const CAS Params*)__builtin_amdgcn_kernarg_segment_ptr();
#define P_HERE (*({ const CAS Params* q_ = kp; asm volatile("" : "+s"(q_)); q_; }))
    unsigned char* ws = p.ws;
    volatile LAS unsigned* misc = (volatile LAS unsigned*)(lds + 131072);
    if (threadIdx.x < 8) misc[threadIdx.x] = 0u;
    __syncthreads();
    XcdBarrier bar = xcd_barrier_post((unsigned*)ws, misc);
    const int lo = p.ph_lo, hi = p.ph_hi;
#ifndef PH_MASK
#define PH_MASK 0xff
#endif
#define IN(k) (((PH_MASK >> (k)) & 1) && lo <= (k) && (k) < hi)
#define SEAM(k) do { if (IN(k) && IN((k) + 1)) xcd_barrier(bar); } while (0)
#ifndef REP_MASK
#define REP_MASK 0x00
#endif
#define REPEAT(k) for (int rep_ = 0; rep_ < ((((REP_MASK) >> (k)) & 1) ? 2 : 1); ++rep_, (rep_ < ((((REP_MASK) >> (k)) & 1) ? 2 : 1) ? xcd_barrier(bar) : (void)0))
    if (IN(0)) REPEAT(0) phase0(P_HERE, lds, G);
    SEAM(0);
    if (IN(1)) REPEAT(1) {
        pg8::Gemm g{(const bf16_t*)(ws + WS_XB) + (size_t)16 * D, (const bf16_t*)(ws + WS_WIN), MP / 256, DIN / 256, D, (size_t)256 * D * 2, (size_t)128 * D * 2};
        pg8::StaticOrder S; S.init(g.nM, g.nN, G, (int)blockIdx.x, D / 64, 1);
        PRef q = P_HERE; EpiZ E{(const float*)(ws + WS_RS1), (bf16_t*)(ws + WS_Z), q.out};
        pg8::gemm_phase<EpiZ, false, true, true>(lds, g, S, E, nullptr, nullptr);
        if ((int)blockIdx.x >= P1_TAIL_WG0 && G == 256) convert_items(P_HERE, lds, ((int)blockIdx.x - P1_TAIL_WG0) * 8 + (opaque_tid() >> 6), (G - P1_TAIL_WG0) * 8, IT_O, IT_S1);
        else if (G != 256) convert_items(P_HERE, lds, (int)blockIdx.x * 8 + (opaque_tid() >> 6), G * 8, IT_O, IT_S3);
    }
    SEAM(1);
    if (IN(2)) REPEAT(2) mixer_phase<1>(P_HERE, lds, G);
    SEAM(2);
    if (IN(3)) REPEAT(3) mixer_phase<2>(P_HERE, lds, G);
    SEAM(3);
    if (IN(4)) REPEAT(4) {
        pg8::Gemm g{(const bf16_t*)(ws + WS_YM), (const bf16_t*)(ws + WS_WO), MP / 256, D / 256, DMIX, (size_t)256 * DMIX * 2, (size_t)128 * DMIX * 2};
        pg8::StaticOrder S; S.init(g.nM, g.nN, G, (int)blockIdx.x, DMIX / 64, P4_SPLIT);
        PRef q = P_HERE; EpiX1 E{q.x_prompt, q.x_sample, q.meta, q.out, (bf16_t*)(ws + WS_XB) + (size_t)16 * D, (float*)(ws + WS_SSQ)};
        pg8::gemm_phase<EpiX1, false, true, true>(lds, g, S, E, (float*)(ws + WS_Z), (unsigned*)ws + CW_TK4);
        if ((int)blockIdx.x >= P4_TAIL_WG0 && G == 256) convert_items(P_HERE, lds, ((int)blockIdx.x - P4_TAIL_WG0) * 8 + (opaque_tid() >> 6), (G - P4_TAIL_WG0) * 8, IT_S3, IT_G);
        else if (G != 256) convert_items(P_HERE, lds, (int)blockIdx.x * 8 + (opaque_tid() >> 6), G * 8, IT_S3, IT_G);
    }
    SEAM(4);
    if (IN(5)) REPEAT(5) {
        pg8::Gemm g{(const bf16_t*)(ws + WS_XB) + (size_t)14 * D, (const bf16_t*)(ws + WS_WUP), 37, 2 * DFF / 256, D, (size_t)252 * D * 2, (size_t)64 * D * 2};
        pg8::StaticOrder S; S.init(g.nM, g.nN, G, (int)blockIdx.x, D / 64, 1);
        PRef q = P_HERE; EpiFFN E{(const float*)(ws + WS_SSQ), q.conv_f_w, q.conv_f_b, q.st_fc, (bf16_t*)(ws + WS_Z), q.out};
        if ((REP_MASK >> 10) & 1) { pg8::gemm_phase<EpiFFN, true, true, true>(lds, g, S, E, nullptr, nullptr, true); xcd_barrier(bar); }
        pg8::gemm_phase<EpiFFN, true, true, true>(lds, g, S, E, nullptr, nullptr);
    }
    SEAM(5);
    if (IN(6)) {
        pg8::Gemm g{(const bf16_t*)(ws + WS_Z), (const bf16_t*)(ws + WS_WDN), MP / 256, D / 256, DFF, (size_t)256 * DFF * 2, (size_t)128 * DFF * 2};
        pg8::StaticOrder S; S.init(g.nM, g.nN, G, (int)blockIdx.x, DFF / 64, P6_SPLIT);
        PRef q = P_HERE; EpiOut E{q.out};
        if ((REP_MASK >> 6) & 1) { pg8::gemm_phase<EpiOut, false, true, true>(lds, g, S, E, (float*)(ws + WS_WIN), (unsigned*)ws + CW_TK6, true); xcd_barrier(bar); }
        if ((REP_MASK >> 9) & 1) { pg8::StaticOrder S3; S3.init(g.nM, g.nN, G, (int)blockIdx.x, DFF / 64, P6_SPLIT); S3.first = 1; EpiOut E3{(float*)(ws + WS_END)};
            pg8::gemm_phase<EpiOut, false, true, true>(lds, g, S3, E3, (float*)(ws + WS_WIN), (unsigned*)ws + CW_TK6 + 64 * 64); xcd_barrier(bar); }
        if ((REP_MASK >> 8) & 1) { pg8::StaticOrder S2; S2.init(g.nM, g.nN, G, (int)blockIdx.x, DFF / 64, 1); S2.limit = 1; EpiOut E2{(float*)(ws + WS_END)};
            pg8::gemm_phase<EpiOut, false, true, true>(lds, g, S2, E2, nullptr, nullptr); xcd_barrier(bar); }
        pg8::gemm_phase<EpiOut, false, true, true>(lds, g, S, E, (float*)(ws + WS_WIN), (unsigned*)ws + CW_TK6);
    }
    SEAM(6);
    if (IN(7)) { if ((REP_MASK >> 7) & 1) { final_phase(P_HERE, G, (float*)(ws + WS_Z)); xcd_barrier(bar); }
        final_phase(P_HERE, G); }
#undef IN
#undef SEAM
}

extern "C" void kernel_launch(void* const* d_in, const int* in_sizes, int n_in, void* d_out, int out_size, void* d_ws, size_t ws_size, hipStream_t stream) {
    static int grid = 0;
    if (grid == 0) {
        if (n_in != 26 || (size_t)out_size != O_END || ws_size < WS_END) { fprintf(stderr, "kernel_launch: unexpected problem (n_in %d, out %d, ws %zu; need ws >= %zu)\n", n_in, out_size, ws_size, (size_t)WS_END); grid = -1; return; }
        int dev = 0, cus = 0, per_cu = 0;
        hipGetDevice(&dev); hipDeviceGetAttribute(&cus, hipDeviceAttributeMultiprocessorCount, dev);
        if (hipFuncSetAttribute((const void*)hymba_fwd, hipFuncAttributeMaxDynamicSharedMemorySize, LDS_BYTES) != hipSuccess) { fprintf(stderr, "kernel_launch: hipFuncSetAttribute failed\n"); grid = -1; return; }
        if (hipOccupancyMaxActiveBlocksPerMultiprocessor(&per_cu, (const void*)hymba_fwd, 512, LDS_BYTES) != hipSuccess || per_cu < 1) { fprintf(stderr, "kernel_launch: occupancy query says %d\n", per_cu); grid = -1; return; }
        if (cus < GRID) { fprintf(stderr, "kernel_launch: built for a %d-CU device, found %d CUs\n", GRID, cus); grid = -1; return; }
        grid = GRID;
    }
    if (grid < 0) return;
    Params p{};
    const float** f = (const float**)&p;
    for (int i = 0; i < 26; ++i) f[i] = (const float*)d_in[i];
    p.out = (float*)d_out; p.ws = (unsigned char*)d_ws;
    if (hipMemsetAsync(d_ws, 0, CTL_WORDS * 4, stream) != hipSuccess) { fprintf(stderr, "kernel_launch: memset failed\n"); return; }
    if (MK_N_LAUNCHES == 1) {
        p.ph_lo = 0; p.ph_hi = N_PHASES;
        hipLaunchKernelGGL(hymba_fwd, dim3(grid), dim3(512), LDS_BYTES, stream, p);
    } else {
        for (int k = 0; k < N_PHASES; ++k) { p.ph_lo = k; p.ph_hi = k + 1; hipLaunchKernelGGL(hymba_fwd, dim3(grid), dim3(512), LDS_BYTES, stream, p); }
    }
}
```

```cpp
#include <hip/hip_runtime.h>
#include <cstdio>

#ifndef REP_MASK
#define REP_MASK 0x00
#endif
#ifndef MK_N_LAUNCHES
#define MK_N_LAUNCHES 1
#endif

#define LAS __attribute__((address_space(3)))
#define CAS __attribute__((address_space(4)))
typedef unsigned short bf16_t;
typedef short bf16x8 __attribute__((ext_vector_type(8)));
typedef float f32x4 __attribute__((ext_vector_type(4)));
typedef unsigned u32x4 __attribute__((ext_vector_type(4)));
typedef unsigned u32x2 __attribute__((ext_vector_type(2)));

constexpr int D = 2048, NMETA = 16, SEQ = 2048, TP = SEQ + NMETA, NB = 4, MPR = NB * TP;
constexpr int NS = 128, TS = 8, MSR = NS * TS, M = MPR + MSR;
constexpr int MP = 9472;
constexpr int DA = 1536, DB = 1024, DIN = 6144, DMIX = 2560, DFF = 6144, NH = 12;
constexpr float EPS = 1e-6f;
constexpr int NCH = 33;
constexpr size_t O_YP = 0, O_YS = O_YP + (size_t)NB * SEQ * D, O_PH = O_YS + (size_t)MSR * D, O_PRC = O_PH + NB * DA,
                 O_PSC = O_PRC + NB * 3 * DA, O_PFC = O_PSC + NB * 2 * DB, O_SH = O_PFC + NB * 2 * DFF, O_SRC = O_SH + NS * DA,
                 O_SSC = O_SRC + (size_t)NS * 3 * DA, O_SFC = O_SSC + (size_t)NS * 2 * DB, O_END = O_SFC + (size_t)NS * 2 * DFF;
constexpr size_t MiB = 1u << 20;
constexpr int CW_TK6 = 4096, CTL_WORDS = 4096 + 128 * 64;
constexpr int P6_SPLIT = 4, P4_SPLIT = 4, CW_TK4 = CW_TK6 + 64 * 64;
constexpr int GRID = 256;
constexpr size_t WS_WIN = 1 * MiB;
constexpr size_t WS_WO = WS_WIN + (size_t)DIN * D * 2;
constexpr size_t WS_WUP = WS_WO + (size_t)D * DMIX * 2;
constexpr size_t WS_WDN = WS_WUP + (size_t)2 * DFF * D * 2;
constexpr size_t WS_WG = WS_WDN + (size_t)D * DFF * 2;
constexpr size_t WS_XB = WS_WG + (size_t)2 * NH * 128 * 128 * 2;
constexpr size_t XB_ROWS = 9600;
constexpr size_t WS_Z = WS_XB + XB_ROWS * D * 2;
constexpr size_t WS_YM = WS_Z + (size_t)MP * DIN * 2;
constexpr size_t WS_RS1 = WS_YM + (size_t)MP * DMIX * 2;
constexpr size_t WS_SSQ = WS_RS1 + (size_t)MP * 4;
constexpr size_t WS_TOT = WS_SSQ + (size_t)MP * 32 * 4;
constexpr size_t WS_END = WS_TOT + (size_t)NB * NCH * DA * 2 * 4;

struct Params;
typedef const CAS Params& PRef;
struct Params {
    const float *x_prompt, *x_sample, *st_h, *st_rc, *st_sc, *st_fc, *meta, *g_mix, *w_in, *conv_a_w, *conv_a_b, *w_gate_a, *b_gate_a,
        *w_gate_x, *b_gate_x, *lam, *conv_b_w, *g_out_a, *g_out_b, *w_o, *g_ffn, *w_up, *conv_f_w, *conv_f_b, *w_down, *g_final;
    float* out; unsigned char* ws; int ph_lo, ph_hi;
};

__device__ __forceinline__ unsigned cvt_pk_bf16(float lo, float hi) { unsigned r; asm volatile("v_cvt_pk_bf16_f32 %0, %1, %2" : "=v"(r) : "v"(lo), "v"(hi)); return r; }
__device__ __forceinline__ float bf_lo(unsigned w) { return __builtin_bit_cast(float, w << 16); }
__device__ __forceinline__ float bf_hi(unsigned w) { return __builtin_bit_cast(float, w & 0xffff0000u); }
__device__ __forceinline__ void unpack8(const u32x4 w, float (&f)[8]) { f[0] = bf_lo(w.x); f[1] = bf_hi(w.x); f[2] = bf_lo(w.y); f[3] = bf_hi(w.y); f[4] = bf_lo(w.z); f[5] = bf_hi(w.z); f[6] = bf_lo(w.w); f[7] = bf_hi(w.w); }
__device__ __forceinline__ u32x4 pack8(const float (&f)[8]) { u32x4 w; w.x = cvt_pk_bf16(f[0], f[1]); w.y = cvt_pk_bf16(f[2], f[3]); w.z = cvt_pk_bf16(f[4], f[5]); w.w = cvt_pk_bf16(f[6], f[7]); return w; }
__device__ __forceinline__ float wave_sum(float v) {
#pragma unroll
    for (int o = 1; o < 64; o <<= 1) v += __shfl_xor(v, o);
    return v;
}
__device__ __forceinline__ float sum16(float v) {
    v += __shfl_xor(v, 1); v += __shfl_xor(v, 2); v += __shfl_xor(v, 4); v += __shfl_xor(v, 8); return v;
}
__device__ __forceinline__ float sigmoidf_(float x) { return __builtin_amdgcn_rcpf(1.0f + __expf(-x)); }
__device__ __forceinline__ float gelu_tanh(float x) {
    const float t = x * (1.0f + 0.044715f * x * x) * (-2.0f * 0.7978845608028654f * 1.4426950408889634f);
    return x * __builtin_amdgcn_rcpf(1.0f + __builtin_amdgcn_exp2f(t));
}
__device__ __forceinline__ int opaque_tid() { int t = threadIdx.x; asm volatile("" : "+v"(t)); return t; }
template <int CTRL> __device__ __forceinline__ float dppf(float old, float src) {
    return __builtin_bit_cast(float, __builtin_amdgcn_update_dpp(__builtin_bit_cast(int, old), __builtin_bit_cast(int, src), CTRL, 0xF, 0xF, false));
}
__device__ __forceinline__ void row_decode(int r, int& is_s, int& seq, int& t) {
    if (r < MPR) { seq = (r >= TP) + (r >= 2 * TP) + (r >= 3 * TP); t = r - seq * TP; is_s = 0; }
    else { const int q = r - MPR; seq = q >> 3; t = q & 7; is_s = 1; }
}
__device__ __forceinline__ const float* x_row_ptr(const float* xp, const float* xs, const float* meta, int r) {
    int is_s, seq, t; row_decode(r, is_s, seq, t);
    if (is_s) return xs + (size_t)(r - MPR) * D;
    return t < NMETA ? meta + (size_t)t * D : xp + ((size_t)seq * SEQ + (t - NMETA)) * D;
}
__device__ __forceinline__ float* y_row_ptr(float* out, int r) {
    if (r >= M) return nullptr;
    int is_s, seq, t; row_decode(r, is_s, seq, t);
    if (is_s) return out + O_YS + (size_t)(r - MPR) * D;
    return t < NMETA ? nullptr : out + O_YP + ((size_t)seq * SEQ + (t - NMETA)) * D;
}

namespace pg8 {
constexpr int BM = 256, BK = 64, HALF = 128, HTB = HALF * BK * 2, STAGE_BYTES = 8 * HTB, NXCD = 8, WGM = 8;
__host__ __device__ __forceinline__ int lds_byte(int r, int c) { const int st = (r >> 4) * 2 + (c >> 5), rr = r & 15, cc = c & 31, ob = rr * 64 + cc * 2; return st * 1024 + (ob ^ (((ob >> 9) & 1) << 5)); }
__host__ __device__ __forceinline__ void stage_rc(int b, int& R, int& C) { const int st = b / 1024, sb = b % 1024, swz = sb ^ (((sb >> 9) & 1) << 5); R = (st >> 1) * 16 + swz / 64; C = (st & 1) * 32 + (swz % 64) / 2; }
struct Unit { int pm, pn, kb, nk, piece, lu, idx; };
struct Gemm { const bf16_t* A; const bf16_t* Bt; int nM, nN, K; size_t a_tstep, a_hstep; };
struct StaticOrder {
    int nM, nN, nwg, G, c, nt, split, nfull, nleft, limit = 1 << 20, first = 0;
    __device__ __forceinline__ void init(int nM_, int nN_, int G_, int c_, int nt_, int split_) { nM = nM_; nN = nN_; nwg = nM * nN; G = G_; c = c_; nt = nt_; nfull = (nwg / G) * G; nleft = nwg - nfull;
        split = (split_ > 1 && nleft > 0 && nleft * split_ <= G && (nt / split_) * split_ == nt && ((nt / split_) & 1) == 0) ? split_ : 1; }
    __device__ __forceinline__ void map(int L, Unit& u) const {
        int wgid = L; { const int q = nwg / NXCD, r = nwg % NXCD, xcd = wgid % NXCD, off = wgid / NXCD; wgid = (xcd < r ? xcd * (q + 1) : r * (q + 1) + (xcd - r) * q) + off; }
        const int nig = WGM * nN, gid = wgid / nig, rem = wgid - gid * nig, fm = gid * WGM, glast = nM % WGM;
        if (nM - fm >= WGM || glast == 0) { u.pm = fm + (rem & (WGM - 1)); u.pn = rem / WGM; }
        else { u.pm = fm + rem % glast; u.pn = rem / glast; }
    }
    __device__ __forceinline__ bool next(int i, Unit& u) const {
        u.kb = 0; u.nk = nt; u.piece = -1; u.lu = 0; u.idx = i;
        i += first; if (i >= limit) return false;
        const long L = (long)i * G + c;
        if (L < nfull || split == 1) { if (L >= nwg) return false; map((int)L, u); return true; }
        if (L >= nfull + G || c >= nleft * split) return false;
        u.lu = c % nleft; u.piece = c / nleft; u.nk = nt / split; u.kb = u.piece * u.nk; map(nfull + u.lu, u); return true;
    }
};

template <int P, int A, int Mi>
__device__ __forceinline__ void reduce_rowgroup(f32x4 (&acc)[2][2][4][2], const float* slab0, int tid) {
    const float* sp = slab0 + (size_t)((A * 4 + Mi) * 4) * 8192 + tid * 4;
#pragma unroll
    for (int b = 0; b < 2; ++b)
#pragma unroll
        for (int n = 0; n < 2; ++n) {
            f32x4 sum = (f32x4){0.f, 0.f, 0.f, 0.f};
#pragma unroll
            for (int src = 0; src < 4; ++src) { if (src == P) sum += acc[A][b][Mi][n]; else sum += *(const f32x4*)(sp + (size_t)src * 8192 + (b * 2 + n) * 2048); }
            acc[A][b][Mi][n] = sum;
        }
}
template <class Epi, bool FFNMAP, bool ALIGN_EPI, bool SP2>
__device__ __forceinline__ void gemm_phase(LAS unsigned char* lds, const Gemm g, const StaticOrder& S, const Epi& E, float* slabs, unsigned* tickets, bool dry = false) {
    int tid = threadIdx.x; asm volatile("" : "+v"(tid));
    const int wid = __builtin_amdgcn_readfirstlane(tid >> 6), lane = tid & 63, wr = wid >> 2, wc = wid & 3, fr = lane & 15, fq = lane >> 4;
    const int K = g.K;
    unsigned voffA[2], voffB[2];
#pragma unroll
    for (int i = 0; i < 2; ++i) { int R, C; stage_rc(tid * 16 + i * 8192, R, C); const int Ra = FFNMAP ? (126 * (R >> 6) + (R & 63)) : R;
        voffA[i] = (unsigned)(Ra * K + C) * 2u; voffB[i] = (unsigned)(R * K + C) * 2u; }
    const size_t kstep = (size_t)(BK * 2);
    const size_t hstepA = g.a_hstep, tstepA = g.a_tstep;
    const size_t hstepB = (size_t)HALF * K * 2, tstepB = 2 * hstepB;
    const unsigned ldsw = (unsigned)wid * 1024u;
    const int aoff = lds_byte(wr * 64 + fr, fq * 8), boff = lds_byte(wc * 32 + fr, fq * 8);
#define PG8_SA(b, h) (((b) * 2 + (h)) * HTB)
#define PG8_SB(b, h) ((4 + (b) * 2 + (h)) * HTB)
#define PG8_STAGE(bufoff, gbase, voff) do { _Pragma("unroll") for (int _i = 0; _i < 2; ++_i) \
        __builtin_amdgcn_global_load_lds((const unsigned*)((const char*)(gbase) + (voff)[_i]), (LAS unsigned*)(lds + (bufoff) + ldsw + _i * 8192), 16, 0, 0); } while (0)
#define PG8_LDA(dst, b, h) do { _Pragma("unroll") for (int m = 0; m < 4; ++m) _Pragma("unroll") for (int k = 0; k < 2; ++k) dst[m][k] = *(const LAS bf16x8*)(lds + PG8_SA(b, h) + aoff + m * 2048 + k * 1024); } while (0)
#define PG8_LDB(dst, b, h) do { _Pragma("unroll") for (int n = 0; n < 2; ++n) _Pragma("unroll") for (int k = 0; k < 2; ++k) dst[n][k] = *(const LAS bf16x8*)(lds + PG8_SB(b, h) + boff + n * 2048 + k * 1024); } while (0)
#define PG8_MMA(ai, bj, At, Bt) do { __builtin_amdgcn_s_setprio(1); _Pragma("unroll") for (int m = 0; m < 4; ++m) _Pragma("unroll") for (int n = 0; n < 2; ++n) _Pragma("unroll") for (int k = 0; k < 2; ++k) \
        acc[ai][bj][m][n] = __builtin_amdgcn_mfma_f32_16x16x32_bf16(Bt[n][k], At[m][k], acc[ai][bj][m][n], 0, 0, 0); __builtin_amdgcn_s_setprio(0); } while (0)
#define PG8_WAIT_V(n) asm volatile("s_waitcnt vmcnt(" #n ")" ::: "memory")
#define PG8_WAIT_L(n) asm volatile("s_waitcnt lgkmcnt(" #n ")" ::: "memory")
#define PG8_BAR __builtin_amdgcn_s_barrier()
#define PG8_SCHED __builtin_amdgcn_sched_barrier(0)
    Unit cur, nxt; int ui = 0;
    if (!S.next(0, cur)) return;
    f32x4 acc[2][2][4][2];
#pragma unroll
    for (int a = 0; a < 2; ++a)
#pragma unroll
        for (int b = 0; b < 2; ++b)
#pragma unroll
            for (int m = 0; m < 4; ++m)
#pragma unroll
                for (int n = 0; n < 2; ++n) acc[a][b][m][n] = (f32x4){0.f, 0.f, 0.f, 0.f};
    bf16x8 At[4][2], B0[2][2], B1[2][2];
    const char* cA = (const char*)g.A + (size_t)cur.pm * tstepA + (size_t)cur.kb * kstep; const char* cB = (const char*)g.Bt + (size_t)cur.pn * tstepB + (size_t)cur.kb * kstep;
    if constexpr (SP2) {
        PG8_STAGE(PG8_SB(0, 0), cB, voffB); PG8_STAGE(PG8_SB(0, 1), cB + hstepB, voffB); PG8_STAGE(PG8_SA(0, 0), cA, voffA); PG8_STAGE(PG8_SA(0, 1), cA + hstepA, voffA);
        if (wr == 1) PG8_BAR;
        PG8_WAIT_V(2); PG8_BAR;
        PG8_STAGE(PG8_SB(1, 0), cB + kstep, voffB); PG8_STAGE(PG8_SA(1, 0), cA + kstep, voffA); PG8_STAGE(PG8_SB(1, 1), cB + hstepB + kstep, voffB);
        PG8_WAIT_V(6); PG8_BAR;
    } else {
        PG8_STAGE(PG8_SB(0, 0), cB, voffB); PG8_STAGE(PG8_SA(0, 0), cA, voffA); PG8_STAGE(PG8_SB(0, 1), cB + hstepB, voffB); PG8_STAGE(PG8_SA(0, 1), cA + hstepA, voffA);
        if (wr == 1) PG8_BAR;
        PG8_WAIT_V(4); PG8_BAR;
        PG8_STAGE(PG8_SB(1, 0), cB + kstep, voffB); PG8_STAGE(PG8_SA(1, 0), cA + kstep, voffA); PG8_STAGE(PG8_SB(1, 1), cB + hstepB + kstep, voffB);
        PG8_WAIT_V(6); PG8_BAR;
    }
    for (;;) {
        const bool has_next = S.next(ui + 1, nxt);
        const char* nA = has_next ? (const char*)g.A + (size_t)nxt.pm * tstepA + (size_t)nxt.kb * kstep : cA; const char* nB = has_next ? (const char*)g.Bt + (size_t)nxt.pn * tstepB + (size_t)nxt.kb * kstep : cB;
        const int nt = cur.nk;
        for (int t = 0; t < nt; t += 2) {
            const bool last = (t == nt - 2);
            const char* a1 = cA + (size_t)(t + 1) * kstep;
            const char* a2 = last ? nA : cA + (size_t)(t + 2) * kstep; const char* b2 = last ? nB : cB + (size_t)(t + 2) * kstep;
            const char* a3 = a2 + kstep; const char* b3 = b2 + kstep;
            if constexpr (SP2) {
            PG8_LDB(B0, 0, 0); PG8_LDB(B1, 0, 1); PG8_SCHED; PG8_LDA(At, 0, 0); PG8_STAGE(PG8_SA(1, 1), a1 + hstepA, voffA);
            PG8_WAIT_V(8); PG8_WAIT_L(0); PG8_BAR; PG8_MMA(0, 0, At, B0); PG8_MMA(0, 1, At, B1); PG8_BAR; PG8_SCHED;
            PG8_LDA(At, 0, 1); PG8_STAGE(PG8_SB(0, 0), b2, voffB); PG8_STAGE(PG8_SB(0, 1), b2 + hstepB, voffB); PG8_STAGE(PG8_SA(0, 0), a2, voffA);
            PG8_WAIT_V(8); PG8_WAIT_L(0); PG8_BAR; PG8_MMA(1, 0, At, B0); PG8_MMA(1, 1, At, B1); PG8_BAR; PG8_SCHED;
            PG8_LDB(B0, 1, 0); PG8_LDB(B1, 1, 1); PG8_SCHED; PG8_LDA(At, 1, 0); PG8_STAGE(PG8_SA(0, 1), a2 + hstepA, voffA);
            PG8_WAIT_V(8); PG8_WAIT_L(0); PG8_BAR; PG8_MMA(0, 0, At, B0); PG8_MMA(0, 1, At, B1); PG8_BAR; PG8_SCHED;
            PG8_LDA(At, 1, 1); PG8_STAGE(PG8_SB(1, 0), b3, voffB); PG8_STAGE(PG8_SB(1, 1), b3 + hstepB, voffB); PG8_STAGE(PG8_SA(1, 0), a3, voffA);
            PG8_WAIT_V(8); PG8_WAIT_L(0); PG8_BAR; PG8_MMA(1, 0, At, B0); PG8_MMA(1, 1, At, B1); PG8_BAR; PG8_SCHED;
            } else {
            PG8_LDB(B0, 0, 0); PG8_SCHED; PG8_LDA(At, 0, 0); PG8_STAGE(PG8_SA(1, 1), a1 + hstepA, voffA);
            PG8_WAIT_L(8); PG8_BAR; PG8_WAIT_L(0); PG8_MMA(0, 0, At, B0); PG8_BAR; PG8_SCHED;
            PG8_LDB(B1, 0, 1); PG8_STAGE(PG8_SB(0, 0), b2, voffB);
            PG8_BAR; PG8_WAIT_L(0); PG8_MMA(0, 1, At, B1); PG8_BAR;
            PG8_LDA(At, 0, 1); PG8_STAGE(PG8_SA(0, 0), a2, voffA);
            PG8_BAR; PG8_WAIT_L(0); PG8_MMA(1, 0, At, B0); PG8_BAR; PG8_SCHED;
            PG8_STAGE(PG8_SB(0, 1), b2 + hstepB, voffB);
            PG8_WAIT_V(6); PG8_BAR; PG8_MMA(1, 1, At, B1); PG8_BAR;
            PG8_LDB(B0, 1, 0); PG8_SCHED; PG8_LDA(At, 1, 0); PG8_STAGE(PG8_SA(0, 1), a2 + hstepA, voffA);
            PG8_WAIT_L(8); PG8_BAR; PG8_WAIT_L(0); PG8_MMA(0, 0, At, B0); PG8_BAR; PG8_SCHED;
            PG8_LDB(B1, 1, 1); PG8_STAGE(PG8_SB(1, 0), b3, voffB);
            PG8_BAR; PG8_WAIT_L(0); PG8_MMA(0, 1, At, B1); PG8_BAR;
            PG8_LDA(At, 1, 1); PG8_STAGE(PG8_SA(1, 0), a3, voffA);
            PG8_BAR; PG8_WAIT_L(0); PG8_MMA(1, 0, At, B0); PG8_BAR; PG8_SCHED;
            PG8_STAGE(PG8_SB(1, 1), b3 + hstepB, voffB);
            PG8_WAIT_V(6); PG8_BAR; PG8_MMA(1, 1, At, B1); PG8_BAR;
            }
        }
        if constexpr (ALIGN_EPI) { if (wr == 0) PG8_BAR; }
        if (cur.piece < 0 && !dry) E(acc, cur, wr, wc, fr, fq);
        if (!has_next) break;
#pragma unroll
        for (int a = 0; a < 2; ++a)
#pragma unroll
            for (int b = 0; b < 2; ++b)
#pragma unroll
                for (int m = 0; m < 4; ++m)
#pragma unroll
                    for (int n = 0; n < 2; ++n) acc[a][b][m][n] = (f32x4){0.f, 0.f, 0.f, 0.f};
        cur = nxt; cA = nA; cB = nB; ++ui;
        if constexpr (ALIGN_EPI) { if (wr == 1) PG8_BAR; }
    }
    PG8_WAIT_V(0);
    if constexpr (!ALIGN_EPI) { if (wr == 0) PG8_BAR; }
    PG8_BAR;
    if constexpr (Epi::SPLIT) {
    if (cur.piece >= 0 && !dry) {
        float* slab0 = slabs + (size_t)cur.lu * (8 * 4 * 8192);
        {
            const __amdgpu_buffer_rsrc_t rs = __builtin_amdgcn_make_buffer_rsrc((void*)slab0, (short)0, 8 * 4 * 32768, 0x00020000);
#pragma unroll
            for (int a = 0; a < 2; ++a)
#pragma unroll
                for (int m = 0; m < 4; ++m) {
                    const int gq = a * 4 + m;
                    if ((gq >> 1) != cur.piece) {
#pragma unroll
                        for (int b = 0; b < 2; ++b)
#pragma unroll
                            for (int n = 0; n < 2; ++n) __builtin_amdgcn_raw_buffer_store_b128(__builtin_bit_cast(u32x4, acc[a][b][m][n]), rs, (gq * 4 + cur.piece) * 32768 + (b * 2 + n) * 8192 + tid * 16, 0, 16);
                    }
                }
        }
        asm volatile("s_waitcnt vmcnt(0)" ::: "memory");
        __syncthreads();
        if (tid == 0) {
            __hip_atomic_fetch_add(tickets + 64 * cur.lu, 1u, __ATOMIC_RELAXED, __HIP_MEMORY_SCOPE_AGENT);
            unsigned sp = 0;
            while (__hip_atomic_load(tickets + 64 * cur.lu, __ATOMIC_RELAXED, __HIP_MEMORY_SCOPE_AGENT) < 4u) { __builtin_amdgcn_s_sleep(2); if (++sp > (1u << 20)) break; }
            __builtin_amdgcn_fence(__ATOMIC_ACQUIRE, "agent"); asm volatile("s_waitcnt vmcnt(0)" ::: "memory");
        }
        __syncthreads();
        switch (cur.piece) {
            case 0: reduce_rowgroup<0, 0, 0>(acc, slab0, tid); reduce_rowgroup<0, 0, 1>(acc, slab0, tid); break;
            case 1: reduce_rowgroup<1, 0, 2>(acc, slab0, tid); reduce_rowgroup<1, 0, 3>(acc, slab0, tid); break;
            case 2: reduce_rowgroup<2, 1, 0>(acc, slab0, tid); reduce_rowgroup<2, 1, 1>(acc, slab0, tid); break;
            default: reduce_rowgroup<3, 1, 2>(acc, slab0, tid); reduce_rowgroup<3, 1, 3>(acc, slab0, tid); break;
        }
        E(acc, cur, wr, wc, fr, fq, 3u << (2 * cur.piece));
    }
    }
#undef PG8_SA
#undef PG8_SB
#undef PG8_STAGE
#undef PG8_LDA
#undef PG8_LDB
#undef PG8_MMA
#undef PG8_WAIT_V
#undef PG8_WAIT_L
#undef PG8_BAR
#undef PG8_SCHED
}
}

typedef f32x4 Acc[2][2][4][2];

struct EpiZ {
    static constexpr bool SPLIT = false;
    const float* rstd1; bf16_t* z; float* out;
    __device__ __forceinline__ void operator()(const Acc& acc, const pg8::Unit& u, int wr, int wc, int fr, int fq) const {
        asm volatile("" : "+v"(fr), "+v"(fq));
        const int col0 = u.pn * 256 + wc * 32 + 8 * fq;
#pragma unroll
        for (int ai = 0; ai < 2; ++ai)
#pragma unroll
            for (int m = 0; m < 4; ++m) {
                const int r = u.pm * 256 + ai * 128 + wr * 64 + m * 16 + fr;
                if (r < M) {
                    const float rs = rstd1[r];
                    int is_s, seq, t; row_decode(r, is_s, seq, t);
                    float* so = nullptr;
                    if (u.pn < 6) { if (is_s) { if (t >= TS - 3) so = out + O_SRC + ((size_t)seq * 3 + (t - (TS - 3))) * DA; } else { if (t >= TP - 3) so = out + O_PRC + ((size_t)seq * 3 + (t - (TP - 3))) * DA; } }
#pragma unroll
                    for (int bj = 0; bj < 2; ++bj) {
                        const f32x4 v0 = acc[ai][bj][m][0] * rs, v1 = acc[ai][bj][m][1] * rs;
                        u32x4 w; w.x = cvt_pk_bf16(v0[0], v0[1]); w.y = cvt_pk_bf16(v0[2], v0[3]); w.z = cvt_pk_bf16(v1[0], v1[1]); w.w = cvt_pk_bf16(v1[2], v1[3]);
                        *(u32x4*)(z + (size_t)r * DIN + col0 + bj * 128) = w;
                        if (so) { *(f32x4*)(so + col0 + bj * 128) = v0; *(f32x4*)(so + col0 + bj * 128 + 4) = v1; }
                    }
                }
            }
    }
};
struct EpiX1 {
    static constexpr bool SPLIT = true;
    const float *xp, *xs, *meta; float* out; bf16_t* x1b; float* ssq;
    __device__ __forceinline__ void operator()(const Acc& acc, const pg8::Unit& u, int wr, int wc, int fr, int fq, unsigned gmask = 0xffu) const {
        asm volatile("" : "+v"(fr), "+v"(fq));
        const int col0 = u.pn * 256 + wc * 32 + 8 * fq;
#pragma unroll
        for (int ai = 0; ai < 2; ++ai) {
            if (!((gmask >> (ai * 4)) & 0xfu)) continue;
            f32x4 xv[4][2][2];
#pragma unroll
            for (int m = 0; m < 4; ++m) {
                const int r = u.pm * 256 + ai * 128 + wr * 64 + m * 16 + fr;
                const float* xr = x_row_ptr(xp, xs, meta, r < M ? r : 0) + col0;
#pragma unroll
                for (int bj = 0; bj < 2; ++bj) { xv[m][bj][0] = *(const f32x4*)(xr + bj * 128); xv[m][bj][1] = *(const f32x4*)(xr + bj * 128 + 4); }
            }
#pragma unroll
            for (int m = 0; m < 4; ++m) {
                if (!((gmask >> (ai * 4 + m)) & 1u)) continue;
                const int r = u.pm * 256 + ai * 128 + wr * 64 + m * 16 + fr;
                const bool valid = r < M;
                float* yd = y_row_ptr(out, r);
                float ss = 0.f;
#pragma unroll
                for (int bj = 0; bj < 2; ++bj) {
                    const int c = col0 + bj * 128;
                    const f32x4 v0 = acc[ai][bj][m][0] + xv[m][bj][0], v1 = acc[ai][bj][m][1] + xv[m][bj][1];
                    ss += (v0[0] * v0[0] + v0[1] * v0[1]) + (v0[2] * v0[2] + v0[3] * v0[3]) + (v1[0] * v1[0] + v1[1] * v1[1]) + (v1[2] * v1[2] + v1[3] * v1[3]);
                    if (yd) { *(f32x4*)(yd + c) = v0; *(f32x4*)(yd + c + 4) = v1; }
                    if (valid) { u32x4 w; w.x = cvt_pk_bf16(v0[0], v0[1]); w.y = cvt_pk_bf16(v0[2], v0[3]); w.z = cvt_pk_bf16(v1[0], v1[1]); w.w = cvt_pk_bf16(v1[2], v1[3]);
                        *(u32x4*)(x1b + (size_t)r * D + c) = w; }
                }
                ss += __shfl_xor(ss, 16); ss += __shfl_xor(ss, 32);
                if (valid && fq == 0) ssq[(size_t)r * 32 + u.pn * 4 + wc] = ss;
            }
        }
    }
};
struct EpiOut {
    static constexpr bool SPLIT = true;
    float* out;
    __device__ __forceinline__ void operator()(const Acc& acc, const pg8::Unit& u, int wr, int wc, int fr, int fq, unsigned gmask = 0xffu) const {
        asm volatile("" : "+v"(fr), "+v"(fq));
        const int col0 = u.pn * 256 + wc * 32 + 8 * fq;
#pragma unroll
        for (int ai = 0; ai < 2; ++ai) {
            if (!((gmask >> (ai * 4)) & 0xfu)) continue;
            f32x4 xv[4][2][2];
#pragma unroll
            for (int m = 0; m < 4; ++m) {
                const int r = u.pm * 256 + ai * 128 + wr * 64 + m * 16 + fr;
                const float* yd = y_row_ptr(out, r); const float* ys = (yd ? yd : out) + col0;
#pragma unroll
                for (int bj = 0; bj < 2; ++bj) { xv[m][bj][0] = *(const f32x4*)(ys + bj * 128); xv[m][bj][1] = *(const f32x4*)(ys + bj * 128 + 4); }
            }
#pragma unroll
            for (int m = 0; m < 4; ++m) {
                if (!((gmask >> (ai * 4 + m)) & 1u)) continue;
                const int r = u.pm * 256 + ai * 128 + wr * 64 + m * 16 + fr;
                float* yd = y_row_ptr(out, r);
                if (yd) {
#pragma unroll
                    for (int bj = 0; bj < 2; ++bj) {
                        const int c = col0 + bj * 128;
                        *(f32x4*)(yd + c) = acc[ai][bj][m][0] + xv[m][bj][0]; *(f32x4*)(yd + c + 4) = acc[ai][bj][m][1] + xv[m][bj][1];
                    }
                }
            }
        }
    }
};
struct EpiFFN {
    static constexpr bool SPLIT = false;
    const float *cw, *cb, *st_fc; bf16_t* hid; float* out; const LAS float* rstab;
    __device__ __forceinline__ void operator()(Acc& acc, const pg8::Unit& u, int wr, int wc, int fr, int fq) const {
        asm volatile("" : "+v"(fr), "+v"(fq));
        const int gbase = 252 * u.pm - 2 + 126 * wr;
        const int f0 = 128 * u.pn + 32 * wc + 8 * fq;
        const f32x4 w0a = *(const f32x4*)(cw + f0), w0b = *(const f32x4*)(cw + f0 + 4);
        const f32x4 w1a = *(const f32x4*)(cw + DFF + f0), w1b = *(const f32x4*)(cw + DFF + f0 + 4);
        const f32x4 w2a = *(const f32x4*)(cw + 2 * DFF + f0), w2b = *(const f32x4*)(cw + 2 * DFF + f0 + 4);
        const f32x4 bba = *(const f32x4*)(cb + f0), bbb = *(const f32x4*)(cb + f0 + 4);
        const LAS float* rt = rstab + u.idx * 256 + wr * 128 + fr;
#pragma unroll
        for (int ai = 0; ai < 2; ++ai)
#pragma unroll
            for (int m = 0; m < 4; ++m) {
                const float rs = rt[64 * ai + 16 * m];
#pragma unroll
                for (int bj = 0; bj < 2; ++bj)
#pragma unroll
                    for (int n = 0; n < 2; ++n) acc[ai][bj][m][n] *= rs;
            }
        const bool has_samples = 252 * u.pm + 252 > MPR;
#pragma unroll
        for (int ai = 0; ai < 2; ++ai)
#pragma unroll
            for (int m = 0; m < 4; ++m) {
                const int j = 64 * ai + 16 * m + fr, r = gbase + j;
                const bool valid = (j >= 2) && (r < M);
                const f32x4 c0 = acc[ai][0][m][0], c1 = acc[ai][0][m][1];
                const int pai = (m == 0) ? (ai == 0 ? 0 : ai - 1) : ai, pm_ = (m == 0) ? (ai == 0 ? 0 : 3) : m - 1;
                const f32x4 q0 = acc[pai][0][pm_][0], q1 = acc[pai][0][pm_][1];
                f32x4 p1a, p1b, p2a, p2b;
#pragma unroll
                for (int e = 0; e < 4; ++e) {
                    p1a[e] = dppf<0x111>(dppf<0x121>(0.f, q0[e]), c0[e]); p1b[e] = dppf<0x111>(dppf<0x121>(0.f, q1[e]), c1[e]);
                    p2a[e] = dppf<0x112>(dppf<0x122>(0.f, q0[e]), c0[e]); p2b[e] = dppf<0x112>(dppf<0x122>(0.f, q1[e]), c1[e]);
                }
                int is_s, seq, t; row_decode(valid ? r : 0, is_s, seq, t);
                if (!has_samples) {
                    const f32x4 zz = (f32x4){0.f, 0.f, 0.f, 0.f};
                    if (t == 0) { p1a = zz; p1b = zz; }
                    if (t < 2) { p2a = zz; p2b = zz; }
                } else if (valid && t < 2) {
                    f32x4 s0a = (f32x4){0.f, 0.f, 0.f, 0.f}, s0b = s0a, s1a = s0a, s1b = s0a;
                    if (is_s) { const float* sp = st_fc + (size_t)seq * 2 * DFF + f0; s0a = *(const f32x4*)sp; s0b = *(const f32x4*)(sp + 4); s1a = *(const f32x4*)(sp + DFF); s1b = *(const f32x4*)(sp + DFF + 4); }
                    if (t == 0) { p1a = s1a; p1b = s1b; p2a = s0a; p2b = s0b; } else { p2a = s1a; p2b = s1b; }
                }
                const f32x4 ga = w0a * p2a + w1a * p1a + w2a * c0 + bba, gb = w0b * p2b + w1b * p1b + w2b * c1 + bbb;
                const f32x4 va = acc[ai][1][m][0], vb = acc[ai][1][m][1];
                if (valid) {
                    u32x4 w;
                    w.x = cvt_pk_bf16(gelu_tanh(ga[0]) * va[0], gelu_tanh(ga[1]) * va[1]); w.y = cvt_pk_bf16(gelu_tanh(ga[2]) * va[2], gelu_tanh(ga[3]) * va[3]);
                    w.z = cvt_pk_bf16(gelu_tanh(gb[0]) * vb[0], gelu_tanh(gb[1]) * vb[1]); w.w = cvt_pk_bf16(gelu_tanh(gb[2]) * vb[2], gelu_tanh(gb[3]) * vb[3]);
                    *(u32x4*)(hid + (size_t)r * DFF + f0) = w;
                    const int T = is_s ? TS : TP;
                    if (t >= T - 2) { float* so = out + (is_s ? O_SFC : O_PFC) + ((size_t)seq * 2 + (t - (T - 2))) * DFF + f0; *(f32x4*)so = c0; *(f32x4*)(so + 4) = c1; }
                }
                if (m & 1) __builtin_amdgcn_sched_barrier(0);
            }
    }
};
__device__ __forceinline__ void ffn_rstd_table(const float* ssq, LAS float* tab, const pg8::StaticOrder& S) {
    const int tid = opaque_tid(), q = tid >> 1, half = tid & 1;
    pg8::Unit u;
    for (int i = 0; S.next(i, u); ++i) {
        int r = 252 * u.pm - 2 + 126 * (q >> 7) + (q & 127); r = r < 0 ? 0 : (r >= M ? M - 1 : r);
        const float* sp = ssq + (size_t)r * 32 + 16 * half;
        const f32x4 a = *(const f32x4*)sp, b = *(const f32x4*)(sp + 4), c = *(const f32x4*)(sp + 8), d = *(const f32x4*)(sp + 12);
        float sm = (((a[0] + a[1]) + (a[2] + a[3])) + ((b[0] + b[1]) + (b[2] + b[3]))) + (((c[0] + c[1]) + (c[2] + c[3])) + ((d[0] + d[1]) + (d[2] + d[3])));
        sm += __shfl_xor(sm, 1);
        if (half == 0) tab[i * 256 + q] = __builtin_amdgcn_rsqf(sm * (1.0f / D) + EPS);
    }
}

struct EpiProbe {
    static constexpr bool SPLIT = false;
    bf16_t* hid;
    __device__ __forceinline__ void operator()(const Acc& acc, const pg8::Unit& u, int wr, int wc, int fr, int fq) const {
        asm volatile("" : "+v"(fr), "+v"(fq));
        const int gbase = 252 * u.pm - 2 + 126 * wr, f0 = 128 * u.pn + 32 * wc + 8 * fq;
#pragma unroll
        for (int ai = 0; ai < 2; ++ai)
#pragma unroll
            for (int m = 0; m < 4; ++m) {
                const int j = 64 * ai + 16 * m + fr, r = gbase + j;
                if (j >= 2 && r < M) { const f32x4 a = acc[ai][0][m][0] + acc[ai][1][m][0], b = acc[ai][0][m][1] + acc[ai][1][m][1];
                    u32x4 w; w.x = cvt_pk_bf16(a[0], a[1]); w.y = cvt_pk_bf16(a[2], a[3]); w.z = cvt_pk_bf16(b[0], b[1]); w.w = cvt_pk_bf16(b[2], b[3]);
                    *(u32x4*)(hid + (size_t)r * DFF + f0) = w; }
            }
    }
};

__device__ __forceinline__ int invperm32(int q) { return 16 * ((q >> 2) & 1) + 4 * (q >> 3) + (q & 3); }
__device__ __forceinline__ void p0_transpose_item(const float* W, int K, int N, const float* kscale, bf16_t* WT, int mode, LAS float* scr, int item, int lane) {
    const int nblk = N / 32, kb = item / nblk, nb = item % nblk, k0 = 64 * kb, n0 = 32 * nb;
    float v[32];
    const float* src = W + (size_t)(k0 + (lane >> 5)) * N + n0 + (lane & 31);
#pragma unroll
    for (int i = 0; i < 32; ++i) v[i] = src[(size_t)(2 * i) * N];
#pragma unroll
    for (int i = 0; i < 32; ++i) scr[(2 * i + (lane >> 5)) * 33 + (lane & 31)] = v[i];
    asm volatile("s_waitcnt lgkmcnt(0)" ::: "memory");
    int rbase = n0;
    if (mode == 1) { const int bj = n0 >= DFF ? 1 : 0, f = n0 - bj * DFF; rbase = 256 * (f >> 7) + 128 * bj + (f & 96); }
    const int c = lane & 7;
    f32x4 ks0 = (f32x4){1.f, 1.f, 1.f, 1.f}, ks1 = ks0;
    if (kscale) { ks0 = *(const f32x4*)(kscale + k0 + 8 * c); ks1 = *(const f32x4*)(kscale + k0 + 8 * c + 4); }
#pragma unroll
    for (int j = 0; j < 4; ++j) { const int n = (lane >> 3) + 8 * j; const LAS float* sp = scr + (8 * c) * 33 + n;
        u32x4 o; o.x = cvt_pk_bf16(sp[0 * 33] * ks0[0], sp[1 * 33] * ks0[1]); o.y = cvt_pk_bf16(sp[2 * 33] * ks0[2], sp[3 * 33] * ks0[3]);
        o.z = cvt_pk_bf16(sp[4 * 33] * ks1[0], sp[5 * 33] * ks1[1]); o.w = cvt_pk_bf16(sp[6 * 33] * ks1[2], sp[7 * 33] * ks1[3]);
        *(u32x4*)(WT + (size_t)(rbase + (mode == 2 ? n : invperm32(n))) * K + k0 + 8 * c) = o; }
    asm volatile("s_waitcnt lgkmcnt(0)" ::: "memory");
}
constexpr int I_IN = (D / 64) * (DIN / 32), I_O = (DMIX / 64) * (D / 32), I_UP = (D / 64) * (2 * DFF / 32), I_DN = (DFF / 64) * (D / 32), I_G = 2 * NH * 8;
constexpr int IT_O = I_IN, IT_UP = IT_O + I_O, IT_DN = IT_UP + I_UP, IT_G = IT_DN + I_DN, IT_END = IT_G + I_G;
__device__ __forceinline__ void convert_items(PRef p, LAS unsigned char* lds, int rank, int nwaves, int lo, int hi) {
    const int tid_ = opaque_tid(), lane = tid_ & 63, wave = tid_ >> 6;
    unsigned char* ws = p.ws;
    LAS float* scr = (LAS float*)(lds + wave * 16384);
    for (int it = lo + rank; it < hi; it += nwaves) {
        int r = it;
        if (r < I_IN) { p0_transpose_item(p.w_in, D, DIN, p.g_mix, (bf16_t*)(ws + WS_WIN), 0, scr, r, lane); continue; } r -= I_IN;
        if (r < I_O) { p0_transpose_item(p.w_o, DMIX, D, nullptr, (bf16_t*)(ws + WS_WO), 0, scr, r, lane); continue; } r -= I_O;
        if (r < I_UP) { p0_transpose_item(p.w_up, D, 2 * DFF, p.g_ffn, (bf16_t*)(ws + WS_WUP), 1, scr, r, lane); continue; } r -= I_UP;
        if (r < I_DN) { p0_transpose_item(p.w_down, DFF, D, nullptr, (bf16_t*)(ws + WS_WDN), 0, scr, r, lane); continue; } r -= I_DN;
        { const int mat = r >> 3, sub = r & 7, gsel = mat / NH, n = mat % NH;
          p0_transpose_item((gsel ? p.w_gate_x : p.w_gate_a) + (size_t)n * 128 * 128, 128, 128, nullptr, (bf16_t*)(ws + WS_WG) + (size_t)mat * 128 * 128, 0, scr, sub, lane); }
    }
}
constexpr int P1_TAIL_WG0 = (888 % 256), P4_TAIL_WG0 = (296 % 256) * P4_SPLIT, MIX_IDLE_WG0 = 228, IT_S1 = IT_O + 9000, IT_S2 = IT_S1 + 2400, IT_S3 = IT_S2 + 2400;
__device__ __forceinline__ void phase0(PRef p, LAS unsigned char* lds, int G) {
    const int tid = opaque_tid(), lane = tid & 63, wave = tid >> 6;
    unsigned char* ws = p.ws;
    const int gw = blockIdx.x * 8 + wave, NGW = G * 8;
    convert_items(p, lds, gw, NGW, 0, IT_O);
    convert_items(p, lds, gw, NGW, IT_G, IT_END);
    { bf16_t* xb = (bf16_t*)(ws + WS_XB) + (size_t)16 * D; float* rstd1 = (float*)(ws + WS_RS1);
      for (int m = gw; m < M; m += NGW) {
          const f32x4* xr = (const f32x4*)x_row_ptr(p.x_prompt, p.x_sample, p.meta, m) + lane;
          f32x4 v[8]; float s = 0.f;
#pragma unroll
          for (int j = 0; j < 8; ++j) { v[j] = xr[64 * j]; s += (v[j][0] * v[j][0] + v[j][1] * v[j][1]) + (v[j][2] * v[j][2] + v[j][3] * v[j][3]); }
          s = wave_sum(s);
          if (lane == 0) rstd1[m] = __builtin_amdgcn_rsqf(s * (1.0f / D) + EPS);
          u32x2* o = (u32x2*)(xb + (size_t)m * D) + lane;
#pragma unroll
          for (int j = 0; j < 8; ++j) { u32x2 w; w.x = cvt_pk_bf16(v[j][0], v[j][1]); w.y = cvt_pk_bf16(v[j][2], v[j][3]); o[64 * j] = w; }
      } }
}

__device__ __forceinline__ void branch_b(PRef p, int G) {
    const bf16_t* z = (const bf16_t*)(p.ws + WS_Z); bf16_t* ym = (bf16_t*)(p.ws + WS_YM);
    const int total = (M / 4) * 128;
    for (int idx = blockIdx.x * 512 + opaque_tid(); idx < total; idx += G * 512) {
        const int m0 = (idx >> 7) * 4, g = idx & 127, ch = 8 * g;
        int is_s, seq, t0; row_decode(m0, is_s, seq, t0);
        u32x4 rc[6], rv[6], rg[4];
#pragma unroll
        for (int k = 0; k < 6; ++k) {
            const int mm = (t0 - 2 + k >= 0) ? m0 - 2 + k : m0;
            rc[k] = *(const u32x4*)(z + (size_t)mm * DIN + 4096 + ch); rv[k] = *(const u32x4*)(z + (size_t)mm * DIN + 5120 + ch);
        }
#pragma unroll
        for (int k = 0; k < 4; ++k) rg[k] = *(const u32x4*)(z + (size_t)(m0 + k) * DIN + 3072 + ch);
        const f32x4 w0a = *(const f32x4*)(p.conv_b_w + ch), w0b = *(const f32x4*)(p.conv_b_w + ch + 4), w1a = *(const f32x4*)(p.conv_b_w + DB + ch), w1b = *(const f32x4*)(p.conv_b_w + DB + ch + 4),
                    w2a = *(const f32x4*)(p.conv_b_w + 2 * DB + ch), w2b = *(const f32x4*)(p.conv_b_w + 2 * DB + ch + 4), goa = *(const f32x4*)(p.g_out_b + ch), gob = *(const f32x4*)(p.g_out_b + ch + 4);
        float u[6][8];
#pragma unroll
        for (int k = 0; k < 6; ++k) {
            float a[8], b[8]; unpack8(rc[k], a); unpack8(rv[k], b);
#pragma unroll
            for (int e = 0; e < 8; ++e) u[k][e] = a[e] * b[e];
        }
        if (t0 == 0) {
#pragma unroll
            for (int k = 0; k < 2; ++k) {
                f32x4 a = (f32x4){0.f, 0.f, 0.f, 0.f}, b = a;
                if (is_s) { const float* sp = p.st_sc + ((size_t)seq * 2 + k) * DB + ch; a = *(const f32x4*)sp; b = *(const f32x4*)(sp + 4); }
#pragma unroll
                for (int e = 0; e < 4; ++e) { u[k][e] = a[e]; u[k][4 + e] = b[e]; }
            }
        }
        const int T = is_s ? TS : TP;
#pragma unroll
        for (int k = 0; k < 4; ++k) {
            float gb[8]; unpack8(rg[k], gb);
            float y[8]; float ss = 0.f;
#pragma unroll
            for (int e = 0; e < 8; ++e) {
                const float uc = (e < 4 ? w0a[e & 3] : w0b[e & 3]) * u[k][e] + (e < 4 ? w1a[e & 3] : w1b[e & 3]) * u[k + 1][e] + (e < 4 ? w2a[e & 3] : w2b[e & 3]) * u[k + 2][e];
                y[e] = gb[e] * uc; ss += y[e] * y[e];
            }
            ss = sum16(ss);
            const float rn = __builtin_amdgcn_rsqf(ss * (1.0f / 128.0f) + EPS);
#pragma unroll
            for (int e = 0; e < 8; ++e) y[e] = y[e] * rn * (e < 4 ? goa[e & 3] : gob[e & 3]);
            *(u32x4*)(ym + (size_t)(m0 + k) * DMIX + DA + ch) = pack8(y);
            const int t = t0 + k;
            if (t >= T - 2) { float* so = p.out + (is_s ? O_SSC : O_PSC) + ((size_t)seq * 2 + (t - (T - 2))) * DB + ch;
                *(f32x4*)so = (f32x4){u[k + 2][0], u[k + 2][1], u[k + 2][2], u[k + 2][3]}; *(f32x4*)(so + 4) = (f32x4){u[k + 2][4], u[k + 2][5], u[k + 2][6], u[k + 2][7]}; }
        }
    }
}

constexpr int LW_STRIDE = 272, L_WA = 0, L_WX = 128 * LW_STRIDE, L_CT = 2 * 128 * LW_STRIDE, L_LRU_END = L_CT + 9 * 128 * 4;
static_assert(L_LRU_END <= 131072, "mixer LDS");
constexpr int LRU_WG_PER_HEAD = 19, LRU_NSEG = 33, LRU_PITEMS = NB * LRU_NSEG, LRU_SITEMS = MSR / 64;
static_assert(LRU_WG_PER_HEAD * 8 >= LRU_PITEMS + LRU_SITEMS, "waves per head");

template <int CTRL, int BANK> __device__ __forceinline__ float dppfb(float old, float src) {
    return __builtin_bit_cast(float, __builtin_amdgcn_update_dpp(__builtin_bit_cast(int, old), __builtin_bit_cast(int, src), CTRL, 0xF, BANK, false));
}
__device__ __forceinline__ float bcast15(float x, int lane) {
    return __builtin_bit_cast(float, __builtin_amdgcn_ds_bpermute(((lane & 48) | 15) << 2, __builtin_bit_cast(int, x)));
}
__device__ __forceinline__ void scan16(float& P, float& S) {
    float Sd, Pd;
    Sd = dppf<0x111>(0.f, S); Pd = dppf<0x111>(1.f, P); S = __builtin_fmaf(P, Sd, S); P *= Pd;
    Sd = dppf<0x112>(0.f, S); Pd = dppf<0x112>(1.f, P); S = __builtin_fmaf(P, Sd, S); P *= Pd;
    Sd = dppf<0x114>(0.f, S); Pd = dppf<0x114>(1.f, P); S = __builtin_fmaf(P, Sd, S); P *= Pd;
    Sd = dppf<0x118>(0.f, S); Pd = dppf<0x118>(1.f, P); S = __builtin_fmaf(P, Sd, S); P *= Pd;
}
__device__ __forceinline__ void scan8(float& P, float& S, int t) {
    float Sd, Pd;
    Sd = dppf<0x111>(0.f, S); Pd = dppf<0x111>(1.f, P); if (t < 1) { Sd = 0.f; Pd = 1.f; } S = __builtin_fmaf(P, Sd, S); P *= Pd;
    Sd = dppf<0x112>(0.f, S); Pd = dppf<0x112>(1.f, P); if (t < 2) { Sd = 0.f; Pd = 1.f; } S = __builtin_fmaf(P, Sd, S); P *= Pd;
    Sd = dppfb<0x114, 0xA>(0.f, S); Pd = dppfb<0x114, 0xA>(1.f, P); S = __builtin_fmaf(P, Sd, S); P *= Pd;
}

template <int PASS, bool IS_S>
__device__ __forceinline__ void lru_wave_item(PRef p, LAS unsigned char* lds, int n, int b, int seg) {
    const int lane = opaque_tid() & 63, fr = lane & 15, fq = lane >> 4;
    const bf16_t* z = (const bf16_t*)(p.ws + WS_Z);
    bf16_t* ym = (bf16_t*)(p.ws + WS_YM);
    float* tot = (float*)(p.ws + WS_TOT);
    const LAS float* CT = (const LAS float*)(lds + L_CT) + 8 * fq;
    const int gch = n * 128 + 8 * fq;
    const int r0 = IS_S ? MPR + b * 64 : b * TP + seg * 64;
    const int nblk = IS_S ? 4 : (seg == LRU_NSEG - 1 ? 1 : 4);
    float hin[4][8], Pt[4][8];
    u32x4 prevx[4];
#pragma unroll
    for (int ks = 0; ks < 4; ++ks) {
#pragma unroll
        for (int e = 0; e < 8; ++e) { hin[ks][e] = 0.f; Pt[ks][e] = 1.f; }
        prevx[ks] = (u32x4){0u, 0u, 0u, 0u};
    }
    if constexpr (!IS_S) {
        if (seg > 0) {
#pragma unroll
            for (int ks = 0; ks < 4; ++ks) prevx[ks] = *(const u32x4*)(z + (size_t)(r0 - 16 + fr) * DIN + gch + 32 * ks);
            if constexpr (PASS == 2) {
#pragma unroll 1
                for (int round = 0; round < 2; ++round) {
                    const int s = 16 * round + fr;
                    if (16 * round >= seg) break;
                    const bool have = s < seg;
                    const float* tp = tot + ((size_t)(b * LRU_NSEG + (have ? s : 0)) * 2) * DA + gch;
#pragma unroll
                    for (int ks = 0; ks < 4; ++ks) {
                        const f32x4 P0 = *(const f32x4*)(tp + 32 * ks), P1 = *(const f32x4*)(tp + 32 * ks + 4), S0 = *(const f32x4*)(tp + DA + 32 * ks), S1 = *(const f32x4*)(tp + DA + 32 * ks + 4);
#pragma unroll
                        for (int e = 0; e < 8; ++e) {
                            float P = have ? (e < 4 ? P0[e & 3] : P1[e & 3]) : 1.f, S = have ? (e < 4 ? S0[e & 3] : S1[e & 3]) : 0.f;
                            scan16(P, S);
                            const float Pc = bcast15(P, lane), Sc = bcast15(S, lane);
                            hin[ks][e] = __builtin_fmaf(Pc, hin[ks][e], Sc);
                        }
                    }
                }
            }
        }
    }
    u32x4 xnext[4];
#pragma unroll
    for (int ks = 0; ks < 4; ++ks) xnext[ks] = *(const u32x4*)(z + (size_t)(r0 + fr) * DIN + gch + 32 * ks);
#pragma unroll 1
    for (int blk = 0; blk < nblk; ++blk) {
        const int r = r0 + 16 * blk + fr;
        const int t8 = fr & 7, sq = (r - MPR) >> 3;
        u32x4 x4[4], g4[4];
#pragma unroll
        for (int ks = 0; ks < 4; ++ks) { x4[ks] = xnext[ks]; if constexpr (PASS == 2) g4[ks] = *(const u32x4*)(z + (size_t)r * DIN + DA + gch + 32 * ks); }
        { const int rn_ = (blk + 1 < nblk) ? r + 16 : r;
#pragma unroll
          for (int ks = 0; ks < 4; ++ks) xnext[ks] = *(const u32x4*)(z + (size_t)rn_ * DIN + gch + 32 * ks); }
        float xc[4][8];
        bf16x8 bfrag[4];
#pragma unroll
        for (int ks = 0; ks < 4; ++ks) {
            float xf[8]; unpack8(x4[ks], xf);
            const f32x4 w0a = *(const LAS f32x4*)(CT + 0 * 128 + 32 * ks), w0b = *(const LAS f32x4*)(CT + 0 * 128 + 32 * ks + 4);
            const f32x4 w1a = *(const LAS f32x4*)(CT + 1 * 128 + 32 * ks), w1b = *(const LAS f32x4*)(CT + 1 * 128 + 32 * ks + 4);
            const f32x4 w2a = *(const LAS f32x4*)(CT + 2 * 128 + 32 * ks), w2b = *(const LAS f32x4*)(CT + 2 * 128 + 32 * ks + 4);
            const f32x4 w3a = *(const LAS f32x4*)(CT + 3 * 128 + 32 * ks), w3b = *(const LAS f32x4*)(CT + 3 * 128 + 32 * ks + 4);
            const f32x4 cba = *(const LAS f32x4*)(CT + 4 * 128 + 32 * ks), cbb = *(const LAS f32x4*)(CT + 4 * 128 + 32 * ks + 4);
            if constexpr (IS_S) {
                const float* sp = p.st_rc + (size_t)sq * 3 * DA + gch + 32 * ks;
                const f32x4 b0a = *(const f32x4*)sp, b0b = *(const f32x4*)(sp + 4), b1a = *(const f32x4*)(sp + DA), b1b = *(const f32x4*)(sp + DA + 4), b2a = *(const f32x4*)(sp + 2 * DA), b2b = *(const f32x4*)(sp + 2 * DA + 4);
#pragma unroll
                for (int e = 0; e < 8; ++e) {
                    const float bb0 = e < 4 ? b0a[e & 3] : b0b[e & 3], bb1 = e < 4 ? b1a[e & 3] : b1b[e & 3], bb2 = e < 4 ? b2a[e & 3] : b2b[e & 3];
                    const float s1 = dppf<0x111>(0.f, xf[e]), s2 = dppf<0x112>(0.f, xf[e]), s3 = dppf<0x113>(0.f, xf[e]);
                    const float x1 = t8 >= 1 ? s1 : bb2;
                    const float x2 = t8 >= 2 ? s2 : (t8 == 1 ? bb2 : bb1);
                    const float x3 = t8 >= 3 ? s3 : (t8 == 2 ? bb2 : (t8 == 1 ? bb1 : bb0));
                    const float w0 = e < 4 ? w0a[e & 3] : w0b[e & 3], w1 = e < 4 ? w1a[e & 3] : w1b[e & 3], w2 = e < 4 ? w2a[e & 3] : w2b[e & 3], w3 = e < 4 ? w3a[e & 3] : w3b[e & 3];
                    xc[ks][e] = (e < 4 ? cba[e & 3] : cbb[e & 3]) + w3 * xf[e] + w2 * x1 + w1 * x2 + w0 * x3;
                }
            } else {
                float pf[8]; unpack8(prevx[ks], pf);
#pragma unroll
                for (int e = 0; e < 8; ++e) {
                    const float x1 = dppf<0x111>(dppf<0x121>(0.f, pf[e]), xf[e]);
                    const float x2 = dppf<0x112>(dppf<0x122>(0.f, pf[e]), xf[e]);
                    const float x3 = dppf<0x113>(dppf<0x123>(0.f, pf[e]), xf[e]);
                    const float w0 = e < 4 ? w0a[e & 3] : w0b[e & 3], w1 = e < 4 ? w1a[e & 3] : w1b[e & 3], w2 = e < 4 ? w2a[e & 3] : w2b[e & 3], w3 = e < 4 ? w3a[e & 3] : w3b[e & 3];
                    xc[ks][e] = (e < 4 ? cba[e & 3] : cbb[e & 3]) + w3 * xf[e] + w2 * x1 + w1 * x2 + w0 * x3;
                }
                prevx[ks] = x4[ks];
            }
            bfrag[ks] = __builtin_bit_cast(bf16x8, pack8(xc[ks]));
        }
        f32x4 aa[8], ax[8];
#pragma unroll
        for (int nb = 0; nb < 8; ++nb) { aa[nb] = (f32x4){0.f, 0.f, 0.f, 0.f}; ax[nb] = (f32x4){0.f, 0.f, 0.f, 0.f}; }
#pragma unroll
        for (int ks = 0; ks < 4; ++ks)
#pragma unroll
            for (int nb = 0; nb < 8; ++nb) {
                const bf16x8 wa = *(const LAS bf16x8*)(lds + L_WA + (16 * nb + fr) * LW_STRIDE + (32 * ks + 8 * fq) * 2);
                const bf16x8 wx = *(const LAS bf16x8*)(lds + L_WX + (16 * nb + fr) * LW_STRIDE + (32 * ks + 8 * fq) * 2);
                aa[nb] = __builtin_amdgcn_mfma_f32_16x16x32_bf16(wa, bfrag[ks], aa[nb], 0, 0, 0);
                ax[nb] = __builtin_amdgcn_mfma_f32_16x16x32_bf16(wx, bfrag[ks], ax[nb], 0, 0, 0);
            }
        float y[4][8]; float ss = 0.f;
#pragma unroll
        for (int ks = 0; ks < 4; ++ks) {
            const f32x4 bga0 = *(const LAS f32x4*)(CT + 5 * 128 + 32 * ks), bga1 = *(const LAS f32x4*)(CT + 5 * 128 + 32 * ks + 4);
            const f32x4 bgx0 = *(const LAS f32x4*)(CT + 6 * 128 + 32 * ks), bgx1 = *(const LAS f32x4*)(CT + 6 * 128 + 32 * ks + 4);
            const f32x4 sp0 = *(const LAS f32x4*)(CT + 7 * 128 + 32 * ks), sp1 = *(const LAS f32x4*)(CT + 7 * 128 + 32 * ks + 4);
            float gav[8];
            if constexpr (PASS == 2) unpack8(g4[ks], gav);
            f32x4 h0a, h0b;
            if constexpr (IS_S) { const float* hp = p.st_h + (size_t)sq * DA + gch + 32 * ks; h0a = *(const f32x4*)hp; h0b = *(const f32x4*)(hp + 4); }
            float hv[8];
#pragma unroll
            for (int e = 0; e < 8; ++e) {
                const int nb = 2 * ks + (e >> 2), rg = e & 3;
                const float rr = sigmoidf_(aa[nb][rg] + (e < 4 ? bga0[rg] : bga1[rg])), ii = sigmoidf_(ax[nb][rg] + (e < 4 ? bgx0[rg] : bgx1[rg]));
                const float la = -8.0f * rr * (e < 4 ? sp0[rg] : sp1[rg]);
                const float a = __expf(la);
                const float om = __builtin_fmaf(-a, a, 1.0f);
                float P = a, S = __builtin_amdgcn_sqrtf(om > 0.f ? om : 0.f) * (ii * xc[ks][e]);
                float h;
                if constexpr (IS_S) { scan8(P, S, t8); h = __builtin_fmaf(P, e < 4 ? h0a[rg] : h0b[rg], S); }
                else {
                    scan16(P, S);
                    h = __builtin_fmaf(P, hin[ks][e], S);
                    hin[ks][e] = bcast15(h, lane);
                    if constexpr (PASS == 1) Pt[ks][e] *= bcast15(P, lane);
                }
                hv[e] = h;
                if constexpr (PASS == 2) { y[ks][e] = gelu_tanh(gav[e]) * h; ss += y[ks][e] * y[ks][e]; }
            }
            if constexpr (PASS == 2) {
                if (IS_S ? (t8 == 7) : (seg == LRU_NSEG - 1 && fr == 15)) {
                    float* ho = p.out + (IS_S ? O_SH + (size_t)sq * DA : O_PH + (size_t)b * DA) + gch + 32 * ks;
                    *(f32x4*)ho = (f32x4){hv[0], hv[1], hv[2], hv[3]}; *(f32x4*)(ho + 4) = (f32x4){hv[4], hv[5], hv[6], hv[7]};
                }
            }
        }
        if constexpr (PASS == 2) {
            ss += __shfl_xor(ss, 16); ss += __shfl_xor(ss, 32);
            const float rn = __builtin_amdgcn_rsqf(ss * (1.0f / 128.0f) + EPS);
#pragma unroll
            for (int ks = 0; ks < 4; ++ks) {
                const f32x4 g0 = *(const LAS f32x4*)(CT + 8 * 128 + 32 * ks), g1 = *(const LAS f32x4*)(CT + 8 * 128 + 32 * ks + 4);
                float o[8];
#pragma unroll
                for (int e = 0; e < 8; ++e) o[e] = y[ks][e] * rn * (e < 4 ? g0[e & 3] : g1[e & 3]);
                *(u32x4*)(ym + (size_t)r * DMIX + gch + 32 * ks) = pack8(o);
            }
        }
    }
    if constexpr (PASS == 1 && !IS_S) {
        if (fr == 0) {
            float* tp = tot + ((size_t)(b * LRU_NSEG + seg) * 2) * DA + gch;
#pragma unroll
            for (int ks = 0; ks < 4; ++ks) {
                *(f32x4*)(tp + 32 * ks) = (f32x4){Pt[ks][0], Pt[ks][1], Pt[ks][2], Pt[ks][3]}; *(f32x4*)(tp + 32 * ks + 4) = (f32x4){Pt[ks][4], Pt[ks][5], Pt[ks][6], Pt[ks][7]};
                *(f32x4*)(tp + DA + 32 * ks) = (f32x4){hin[ks][0], hin[ks][1], hin[ks][2], hin[ks][3]}; *(f32x4*)(tp + DA + 32 * ks + 4) = (f32x4){hin[ks][4], hin[ks][5], hin[ks][6], hin[ks][7]};
            }
        }
    }
}
template <int PASS>
__device__ __forceinline__ void mixer_phase(PRef p, LAS unsigned char* lds, int G) {
    const int tid = opaque_tid(), wave = __builtin_amdgcn_readfirstlane(tid >> 6);
    for (int v = blockIdx.x; v < NH * LRU_WG_PER_HEAD; v += G) {
        const int n = v / LRU_WG_PER_HEAD;
        __syncthreads();
        {
            const bf16_t* wg = (const bf16_t*)(p.ws + WS_WG);
            for (int i = tid; i < 2 * 128 * 16; i += 512) { const int g = i >> 11, row = (i >> 4) & 127, c16 = i & 15;
                *(LAS u32x4*)(lds + g * L_WX + row * LW_STRIDE + c16 * 16) = *(const u32x4*)(wg + (((size_t)g * NH + n) * 128 + row) * 128 + c16 * 8); }
            LAS float* CTw = (LAS float*)(lds + L_CT);
            for (int i = tid; i < 9 * 128; i += 512) { const int k = i >> 7, c = i & 127, ch = n * 128 + c;
                float vv;
                if (k < 4) vv = p.conv_a_w[k * DA + ch]; else if (k == 4) vv = p.conv_a_b[ch]; else if (k == 5) vv = p.b_gate_a[ch]; else if (k == 6) vv = p.b_gate_x[ch];
                else if (k == 7) vv = log1pf(__expf(-p.lam[ch])); else vv = p.g_out_a[ch];
                CTw[i] = vv; }
        }
        __syncthreads();
        const int wi = (v % LRU_WG_PER_HEAD) * 8 + wave;
        if (wi < LRU_PITEMS) lru_wave_item<PASS, false>(p, lds, n, wi / LRU_NSEG, wi % LRU_NSEG);
        else if (PASS == 2 && wi < LRU_PITEMS + LRU_SITEMS) lru_wave_item<PASS, true>(p, lds, n, wi - LRU_PITEMS, 0);
    }
    if (G == 256 && (int)blockIdx.x >= MIX_IDLE_WG0) convert_items(p, lds, ((int)blockIdx.x - MIX_IDLE_WG0) * 8 + wave, (G - MIX_IDLE_WG0) * 8, PASS == 1 ? IT_S1 : IT_S2, PASS == 1 ? IT_S2 : IT_S3);
    if (PASS == 1) { branch_b(p, G); if ((REP_MASK >> 11) & 1) branch_b(p, G); }
}

__device__ __forceinline__ void final_phase(PRef p, int G, float* probe_dst = nullptr) {
    const int tid_ = opaque_tid(), lane = tid_ & 63, gw = blockIdx.x * 8 + (tid_ >> 6), NGW = G * 8;
    f32x4 gf[8];
#pragma unroll
    for (int j = 0; j < 8; ++j) gf[j] = ((const f32x4*)p.g_final)[lane + 64 * j];
    for (int r = gw; r < NB * SEQ + MSR; r += NGW) {
        f32x4* yr = (f32x4*)(p.out + (size_t)r * D) + lane;
        f32x4 v[8]; float s = 0.f;
#pragma unroll
        for (int j = 0; j < 8; ++j) { v[j] = yr[64 * j]; s += (v[j][0] * v[j][0] + v[j][1] * v[j][1]) + (v[j][2] * v[j][2] + v[j][3] * v[j][3]); }
        s = wave_sum(s);
        const float rs = __builtin_amdgcn_rsqf(s * (1.0f / D) + EPS);
        f32x4* yo = probe_dst ? (f32x4*)(probe_dst + (size_t)r * D) + lane : yr;
#pragma unroll
        for (int j = 0; j < 8; ++j) yo[64 * j] = v[j] * rs * gf[j];
    }
}


#define XB_TMO      128
#define XB_XCNT(j)  (256  + 64 * (j))
#define XB_XSUB(j)  (1280 + 64 * (j))
#define XB_XGEN(j)  (2304 + 64 * (j))
#define XB_TOP      3328
#define XB_TOPGEN   3392
#define XCD_BAR_WORDS 3456
#define XB_SPIN_CAP (1u << 18)
__device__ __forceinline__ unsigned xb_ld(unsigned* p)              { return __hip_atomic_load(p, __ATOMIC_RELAXED, __HIP_MEMORY_SCOPE_AGENT); }
__device__ __forceinline__ unsigned xb_add(unsigned* p, unsigned v) { return __hip_atomic_fetch_add(p, v, __ATOMIC_RELAXED, __HIP_MEMORY_SCOPE_AGENT); }
__device__ __forceinline__ unsigned xb_xcc_id() { return (unsigned)__builtin_amdgcn_s_getreg((3 << 11) | 20) & 0xFu; }
#define XB_SPIN(cond, bar) do { unsigned _sp = 0; while (cond) { __builtin_amdgcn_s_sleep(1); \
    if ((++_sp & 255u) == 0u) { if (xb_ld(&(bar)[XB_TMO])) break; if (_sp > XB_SPIN_CAP) { atomicAdd(&(bar)[XB_TMO], 1u); break; } } } } while (0)
struct XcdBarrier { unsigned* bar; unsigned x; volatile LAS unsigned* st; };
__device__ __forceinline__ XcdBarrier xcd_barrier_post(unsigned* bar, volatile LAS unsigned* st) {
    XcdBarrier b; b.bar = bar; b.x = xb_xcc_id(); b.st = st;
    if (threadIdx.x == 0) (void)xb_add(&bar[XB_XCNT(b.x)], 1u);
    return b;
}
__device__ __forceinline__ void xcd_barrier_complete(unsigned* bar, unsigned x, unsigned& nloc, unsigned& nx) {
    const unsigned G = gridDim.x * gridDim.y * gridDim.z;
    unsigned sum, cnt, mine, sp = 0u;
    for (;;) {
        sum = 0u; cnt = 0u; mine = 0u;
#pragma unroll
        for (unsigned j = 0; j < 16; ++j) { const unsigned c = xb_ld(&bar[XB_XCNT(j)]); sum += c; cnt += (c > 0u) ? 1u : 0u; mine = (j == x) ? c : mine; }
        if (sum == G) break;
        __builtin_amdgcn_s_sleep(1);
        if ((++sp & 255u) == 0u) { if (xb_ld(&bar[XB_TMO])) break; if (sp > XB_SPIN_CAP) { atomicAdd(&bar[XB_TMO], 1u); break; } }
    }
    nloc = mine > 0u ? mine : 1u; nx = cnt > 0u ? cnt : 1u;
}
__device__ __forceinline__ void xcd_barrier(const XcdBarrier& b) {
    asm volatile("s_waitcnt vmcnt(0)" ::: "memory");
    __syncthreads();
    if (threadIdx.x == 0) {
        unsigned* bar = b.bar;
        __builtin_amdgcn_s_waitcnt(0);
        unsigned nloc = b.st[0], nx = b.st[1];
        if (nloc == 0u) { xcd_barrier_complete(bar, b.x, nloc, nx); b.st[0] = nloc; b.st[1] = nx; }
        const unsigned old = xb_add(&bar[XB_XSUB(b.x)], 1u);
        const unsigned gen = old / nloc;
        if (old + 1u == (gen + 1u) * nloc) {
            __builtin_amdgcn_fence(__ATOMIC_RELEASE, "agent");
            asm volatile("s_waitcnt vmcnt(0)" ::: "memory");
            const unsigned og = xb_add(&bar[XB_TOP], 1u);
            const unsigned tg = og / nx;
            if (og + 1u == (tg + 1u) * nx) xb_add(&bar[XB_TOPGEN], 1u);
            else XB_SPIN(xb_ld(&bar[XB_TOPGEN]) == tg, bar);
            __builtin_amdgcn_fence(__ATOMIC_ACQUIRE, "agent");
            xb_add(&bar[XB_XGEN(b.x)], 1u);
            asm volatile("s_waitcnt vmcnt(0)" ::: "memory");
        } else {
            XB_SPIN(xb_ld(&bar[XB_XGEN(b.x)]) == gen, bar);
            __builtin_amdgcn_fence(__ATOMIC_ACQUIRE, "agent");
            asm volatile("s_waitcnt vmcnt(0)" ::: "memory");
        }
    }
    __syncthreads();
}

constexpr int LDS_BYTES = 131072 + 1024 + 8 * 1024;
constexpr int N_PHASES = 8;
__global__ void __launch_bounds__(512, 2) hymba_fwd(Params p) {
    extern __shared__ __attribute__((aligned(16))) unsigned char lds_raw[];
    LAS unsigned char* lds = (LAS unsigned char*)lds_raw;
    constexpr int G = GRID;
    if ((int)gridDim.x != GRID) return;
    const CAS Params* kp = (const CAS Params*)__builtin_amdgcn_kernarg_segment_ptr();
#define P_HERE (*({ const CAS Params* q_ = kp; asm volatile("" : "+s"(q_)); q_; }))
    unsigned char* ws = p.ws;
    volatile LAS unsigned* misc = (volatile LAS unsigned*)(lds + 131072);
    if (threadIdx.x < 8) misc[threadIdx.x] = 0u;
    __syncthreads();
    XcdBarrier bar = xcd_barrier_post((unsigned*)ws, misc);
    const int lo = p.ph_lo, hi = p.ph_hi;
#ifndef PH_MASK
#define PH_MASK 0xff
#endif
#define IN(k) (((PH_MASK >> (k)) & 1) && lo <= (k) && (k) < hi)
#define SEAM(k) do { if (IN(k) && IN((k) + 1)) xcd_barrier(bar); } while (0)
#define REPEAT(k) for (int rep_ = 0; rep_ < ((((REP_MASK) >> (k)) & 1) ? 2 : 1); ++rep_, (rep_ < ((((REP_MASK) >> (k)) & 1) ? 2 : 1) ? xcd_barrier(bar) : (void)0))
    if (IN(0)) REPEAT(0) phase0(P_HERE, lds, G);
    SEAM(0);
    if (IN(1)) REPEAT(1) {
        pg8::Gemm g{(const bf16_t*)(ws + WS_XB) + (size_t)16 * D, (const bf16_t*)(ws + WS_WIN), MP / 256, DIN / 256, D, (size_t)256 * D * 2, (size_t)128 * D * 2};
        pg8::StaticOrder S; S.init(g.nM, g.nN, G, (int)blockIdx.x, D / 64, 1);
        PRef q = P_HERE; EpiZ E{(const float*)(ws + WS_RS1), (bf16_t*)(ws + WS_Z), q.out};
        pg8::gemm_phase<EpiZ, false, true, true>(lds, g, S, E, nullptr, nullptr);
        if ((int)blockIdx.x >= P1_TAIL_WG0 && G == 256) convert_items(P_HERE, lds, ((int)blockIdx.x - P1_TAIL_WG0) * 8 + (opaque_tid() >> 6), (G - P1_TAIL_WG0) * 8, IT_O, IT_S1);
        else if (G != 256) convert_items(P_HERE, lds, (int)blockIdx.x * 8 + (opaque_tid() >> 6), G * 8, IT_O, IT_S3);
    }
    SEAM(1);
    if (IN(2)) REPEAT(2) mixer_phase<1>(P_HERE, lds, G);
    SEAM(2);
    if (IN(3)) REPEAT(3) mixer_phase<2>(P_HERE, lds, G);
    SEAM(3);
    if (IN(4)) REPEAT(4) {
        pg8::Gemm g{(const bf16_t*)(ws + WS_YM), (const bf16_t*)(ws + WS_WO), MP / 256, D / 256, DMIX, (size_t)256 * DMIX * 2, (size_t)128 * DMIX * 2};
        pg8::StaticOrder S; S.init(g.nM, g.nN, G, (int)blockIdx.x, DMIX / 64, P4_SPLIT);
        PRef q = P_HERE; EpiX1 E{q.x_prompt, q.x_sample, q.meta, q.out, (bf16_t*)(ws + WS_XB) + (size_t)16 * D, (float*)(ws + WS_SSQ)};
        pg8::gemm_phase<EpiX1, false, true, true>(lds, g, S, E, (float*)(ws + WS_Z), (unsigned*)ws + CW_TK4);
        if ((int)blockIdx.x >= P4_TAIL_WG0 && G == 256) convert_items(P_HERE, lds, ((int)blockIdx.x - P4_TAIL_WG0) * 8 + (opaque_tid() >> 6), (G - P4_TAIL_WG0) * 8, IT_S3, IT_G);
        else if (G != 256) convert_items(P_HERE, lds, (int)blockIdx.x * 8 + (opaque_tid() >> 6), G * 8, IT_S3, IT_G);
    }
    SEAM(4);
    if (IN(5)) REPEAT(5) {
        pg8::Gemm g{(const bf16_t*)(ws + WS_XB) + (size_t)14 * D, (const bf16_t*)(ws + WS_WUP), 37, 2 * DFF / 256, D, (size_t)252 * D * 2, (size_t)64 * D * 2};
        pg8::StaticOrder S; S.init(g.nM, g.nN, G, (int)blockIdx.x, D / 64, 1);
        LAS float* rstab = (LAS float*)(lds + 131072 + 1024);
        ffn_rstd_table((const float*)(ws + WS_SSQ), rstab, S); __syncthreads();
        PRef q = P_HERE; EpiFFN E{q.conv_f_w, q.conv_f_b, q.st_fc, (bf16_t*)(ws + WS_Z), q.out, rstab};
        if ((REP_MASK >> 10) & 1) { EpiProbe Ep{(bf16_t*)(ws + WS_Z)}; pg8::gemm_phase<EpiProbe, true, true, true>(lds, g, S, Ep, nullptr, nullptr); xcd_barrier(bar); }
        pg8::gemm_phase<EpiFFN, true, true, true>(lds, g, S, E, nullptr, nullptr);
    }
    SEAM(5);
    if (IN(6)) {
        pg8::Gemm g{(const bf16_t*)(ws + WS_Z), (const bf16_t*)(ws + WS_WDN), MP / 256, D / 256, DFF, (size_t)256 * DFF * 2, (size_t)128 * DFF * 2};
        pg8::StaticOrder S; S.init(g.nM, g.nN, G, (int)blockIdx.x, DFF / 64, P6_SPLIT);
        PRef q = P_HERE; EpiOut E{q.out};
        if ((REP_MASK >> 6) & 1) { pg8::gemm_phase<EpiOut, false, true, true>(lds, g, S, E, (float*)(ws + WS_WIN), (unsigned*)ws + CW_TK6, true); xcd_barrier(bar); }
        if ((REP_MASK >> 9) & 1) { pg8::StaticOrder S3; S3.init(g.nM, g.nN, G, (int)blockIdx.x, DFF / 64, P6_SPLIT); S3.first = 1; EpiOut E3{(float*)(ws + WS_END)};
            pg8::gemm_phase<EpiOut, false, true, true>(lds, g, S3, E3, (float*)(ws + WS_WIN), (unsigned*)ws + CW_TK6 + 64 * 64); xcd_barrier(bar); }
        if ((REP_MASK >> 8) & 1) { pg8::StaticOrder S2; S2.init(g.nM, g.nN, G, (int)blockIdx.x, DFF / 64, 1); S2.limit = 1; EpiOut E2{(float*)(ws + WS_END)};
            pg8::gemm_phase<EpiOut, false, true, true>(lds, g, S2, E2, nullptr, nullptr); xcd_barrier(bar); }
        pg8::gemm_phase<EpiOut, false, true, true>(lds, g, S, E, (float*)(ws + WS_WIN), (unsigned*)ws + CW_TK6);
    }
    SEAM(6);
    if (IN(7)) { if ((REP_MASK >> 7) & 1) { final_phase(P_HERE, G, (float*)(ws + WS_Z)); xcd_barrier(bar); }
        final_phase(P_HERE, G); }
#undef IN
#undef SEAM
}

extern "C" void kernel_launch(void* const* d_in, const int* in_sizes, int n_in, void* d_out, int out_size, void* d_ws, size_t ws_size, hipStream_t stream) {
    static int grid = 0;
    if (grid == 0) {
        if (n_in != 26 || (size_t)out_size != O_END || ws_size < WS_END) { fprintf(stderr, "kernel_launch: unexpected problem (n_in %d, out %d, ws %zu; need ws >= %zu)\n", n_in, out_size, ws_size, (size_t)WS_END); grid = -1; return; }
        int dev = 0, cus = 0, per_cu = 0;
        hipGetDevice(&dev); hipDeviceGetAttribute(&cus, hipDeviceAttributeMultiprocessorCount, dev);
        if (hipFuncSetAttribute((const void*)hymba_fwd, hipFuncAttributeMaxDynamicSharedMemorySize, LDS_BYTES) != hipSuccess) { fprintf(stderr, "kernel_launch: hipFuncSetAttribute failed\n"); grid = -1; return; }
        if (hipOccupancyMaxActiveBlocksPerMultiprocessor(&per_cu, (const void*)hymba_fwd, 512, LDS_BYTES) != hipSuccess || per_cu < 1) { fprintf(stderr, "kernel_launch: occupancy query says %d\n", per_cu); grid = -1; return; }
        if (cus < GRID) { fprintf(stderr, "kernel_launch: built for a %d-CU device, found %d CUs\n", GRID, cus); grid = -1; return; }
        grid = GRID;
    }
    if (grid < 0) return;
    Params p{};
    const float** f = (const float**)&p;
    for (int i = 0; i < 26; ++i) f[i] = (const float*)d_in[i];
    p.out = (float*)d_out; p.ws = (unsigned char*)d_ws;
    if (hipMemsetAsync(d_ws, 0, CTL_WORDS * 4, stream) != hipSuccess) { fprintf(stderr, "kernel_launch: memset failed\n"); return; }
    if (MK_N_LAUNCHES == 1) {
        p.ph_lo = 0; p.ph_hi = N_PHASES;
        hipLaunchKernelGGL(hymba_fwd, dim3(grid), dim3(512), LDS_BYTES, stream, p);
    } else {
        for (int k = 0; k < N_PHASES; ++k) { p.ph_lo = k; p.ph_hi = k + 1; hipLaunchKernelGGL(hymba_fwd, dim3(grid), dim3(512), LDS_BYTES, stream, p); }
    }
}
```

```cpp
#include <hip/hip_runtime.h>
#include <cstdio>

#ifndef REP_MASK
#define REP_MASK 0x00
#endif
#ifndef MK_N_LAUNCHES
#define MK_N_LAUNCHES 1
#endif

#define LAS __attribute__((address_space(3)))
#define CAS __attribute__((address_space(4)))
typedef unsigned short bf16_t;
typedef short bf16x8 __attribute__((ext_vector_type(8)));
typedef float f32x4 __attribute__((ext_vector_type(4)));
typedef unsigned u32x4 __attribute__((ext_vector_type(4)));
typedef unsigned u32x2 __attribute__((ext_vector_type(2)));

constexpr int D = 2048, NMETA = 16, SEQ = 2048, TP = SEQ + NMETA, NB = 4, MPR = NB * TP;
constexpr int NS = 128, TS = 8, MSR = NS * TS, M = MPR + MSR;
constexpr int MP = 9472;
constexpr int DA = 1536, DB = 1024, DIN = 6144, DMIX = 2560, DFF = 6144, NH = 12;
constexpr float EPS = 1e-6f;
constexpr int NCH = 33;
constexpr size_t O_YP = 0, O_YS = O_YP + (size_t)NB * SEQ * D, O_PH = O_YS + (size_t)MSR * D, O_PRC = O_PH + NB * DA,
                 O_PSC = O_PRC + NB * 3 * DA, O_PFC = O_PSC + NB * 2 * DB, O_SH = O_PFC + NB * 2 * DFF, O_SRC = O_SH + NS * DA,
                 O_SSC = O_SRC + (size_t)NS * 3 * DA, O_SFC = O_SSC + (size_t)NS * 2 * DB, O_END = O_SFC + (size_t)NS * 2 * DFF;
constexpr size_t MiB = 1u << 20;
constexpr int CW_TK6 = 4096, CTL_WORDS = 4096 + 128 * 64;
constexpr int P6_SPLIT = 4, P4_SPLIT = 4, CW_TK4 = CW_TK6 + 64 * 64;
constexpr int GRID = 256;
constexpr size_t WS_WIN = 1 * MiB;
constexpr size_t WS_WO = WS_WIN + (size_t)DIN * D * 2;
constexpr size_t WS_WUP = WS_WO + (size_t)D * DMIX * 2;
constexpr size_t WS_WDN = WS_WUP + (size_t)2 * DFF * D * 2;
constexpr size_t WS_WG = WS_WDN + (size_t)D * DFF * 2;
constexpr size_t WS_XB = WS_WG + (size_t)2 * NH * 128 * 128 * 2;
constexpr size_t XB_ROWS = 9600;
constexpr size_t WS_Z = WS_XB + XB_ROWS * D * 2;
constexpr size_t WS_YM = WS_Z + (size_t)MP * DIN * 2;
constexpr size_t WS_RS1 = WS_YM + (size_t)MP * DMIX * 2;
constexpr size_t WS_SSQ = WS_RS1 + (size_t)MP * 4;
constexpr size_t WS_TOT = WS_SSQ + (size_t)MP * 32 * 4;
constexpr size_t WS_END = WS_TOT + (size_t)NB * NCH * DA * 2 * 4;

struct Params;
typedef const CAS Params& PRef;
struct Params {
    const float *x_prompt, *x_sample, *st_h, *st_rc, *st_sc, *st_fc, *meta, *g_mix, *w_in, *conv_a_w, *conv_a_b, *w_gate_a, *b_gate_a,
        *w_gate_x, *b_gate_x, *lam, *conv_b_w, *g_out_a, *g_out_b, *w_o, *g_ffn, *w_up, *conv_f_w, *conv_f_b, *w_down, *g_final;
    float* out; unsigned char* ws; int ph_lo, ph_hi;
};

__device__ __forceinline__ unsigned cvt_pk_bf16(float lo, float hi) { unsigned r; asm volatile("v_cvt_pk_bf16_f32 %0, %1, %2" : "=v"(r) : "v"(lo), "v"(hi)); return r; }
__device__ __forceinline__ float bf_lo(unsigned w) { return __builtin_bit_cast(float, w << 16); }
__device__ __forceinline__ float bf_hi(unsigned w) { return __builtin_bit_cast(float, w & 0xffff0000u); }
__device__ __forceinline__ void unpack8(const u32x4 w, float (&f)[8]) { f[0] = bf_lo(w.x); f[1] = bf_hi(w.x); f[2] = bf_lo(w.y); f[3] = bf_hi(w.y); f[4] = bf_lo(w.z); f[5] = bf_hi(w.z); f[6] = bf_lo(w.w); f[7] = bf_hi(w.w); }
__device__ __forceinline__ u32x4 pack8(const float (&f)[8]) { u32x4 w; w.x = cvt_pk_bf16(f[0], f[1]); w.y = cvt_pk_bf16(f[2], f[3]); w.z = cvt_pk_bf16(f[4], f[5]); w.w = cvt_pk_bf16(f[6], f[7]); return w; }
__device__ __forceinline__ float wave_sum(float v) {
#pragma unroll
    for (int o = 1; o < 64; o <<= 1) v += __shfl_xor(v, o);
    return v;
}
__device__ __forceinline__ float sum16(float v) {
    v += __shfl_xor(v, 1); v += __shfl_xor(v, 2); v += __shfl_xor(v, 4); v += __shfl_xor(v, 8); return v;
}
__device__ __forceinline__ float sigmoidf_(float x) { return __builtin_amdgcn_rcpf(1.0f + __expf(-x)); }
__device__ __forceinline__ float gelu_tanh(float x) {
    const float t = x * (1.0f + 0.044715f * x * x) * (-2.0f * 0.7978845608028654f * 1.4426950408889634f);
    return x * __builtin_amdgcn_rcpf(1.0f + __builtin_amdgcn_exp2f(t));
}
__device__ __forceinline__ int opaque_tid() { int t = threadIdx.x; asm volatile("" : "+v"(t)); return t; }
template <int CTRL> __device__ __forceinline__ float dppf(float old, float src) {
    return __builtin_bit_cast(float, __builtin_amdgcn_update_dpp(__builtin_bit_cast(int, old), __builtin_bit_cast(int, src), CTRL, 0xF, 0xF, false));
}
__device__ __forceinline__ void row_decode(int r, int& is_s, int& seq, int& t) {
    if (r < MPR) { seq = (r >= TP) + (r >= 2 * TP) + (r >= 3 * TP); t = r - seq * TP; is_s = 0; }
    else { const int q = r - MPR; seq = q >> 3; t = q & 7; is_s = 1; }
}
__device__ __forceinline__ const float* x_row_ptr(const float* xp, const float* xs, const float* meta, int r) {
    int is_s, seq, t; row_decode(r, is_s, seq, t);
    if (is_s) return xs + (size_t)(r - MPR) * D;
    return t < NMETA ? meta + (size_t)t * D : xp + ((size_t)seq * SEQ + (t - NMETA)) * D;
}
__device__ __forceinline__ float* y_row_ptr(float* out, int r) {
    if (r >= M) return nullptr;
    int is_s, seq, t; row_decode(r, is_s, seq, t);
    if (is_s) return out + O_YS + (size_t)(r - MPR) * D;
    return t < NMETA ? nullptr : out + O_YP + ((size_t)seq * SEQ + (t - NMETA)) * D;
}

namespace pg8 {
constexpr int BM = 256, BK = 64, HALF = 128, HTB = HALF * BK * 2, STAGE_BYTES = 8 * HTB, NXCD = 8, WGM = 2;
__host__ __device__ __forceinline__ int lds_byte(int r, int c) { const int st = (r >> 4) * 2 + (c >> 5), rr = r & 15, cc = c & 31, ob = rr * 64 + cc * 2; return st * 1024 + (ob ^ (((ob >> 9) & 1) << 5)); }
__host__ __device__ __forceinline__ void stage_rc(int b, int& R, int& C) { const int st = b / 1024, sb = b % 1024, swz = sb ^ (((sb >> 9) & 1) << 5); R = (st >> 1) * 16 + swz / 64; C = (st & 1) * 32 + (swz % 64) / 2; }
struct Unit { int pm, pn, kb, nk, piece, lu, idx; };
struct Gemm { const bf16_t* A; const bf16_t* Bt; int nM, nN, K; size_t a_tstep, a_hstep; };
struct StaticOrder {
    int nM, nN, nwg, G, c, nt, split, nfull, nleft, limit = 1 << 20, first = 0;
    __device__ __forceinline__ void init(int nM_, int nN_, int G_, int c_, int nt_, int split_) { nM = nM_; nN = nN_; nwg = nM * nN; G = G_; c = c_; nt = nt_; nfull = (nwg / G) * G; nleft = nwg - nfull;
        split = (split_ > 1 && nleft > 0 && nleft * split_ <= G && (nt / split_) * split_ == nt && ((nt / split_) & 1) == 0) ? split_ : 1; }
    __device__ __forceinline__ void map(int L, Unit& u) const {
        int wgid = L; { const int q = nwg / NXCD, r = nwg % NXCD, xcd = wgid % NXCD, off = wgid / NXCD; wgid = (xcd < r ? xcd * (q + 1) : r * (q + 1) + (xcd - r) * q) + off; }
        const int nig = WGM * nN, gid = wgid / nig, rem = wgid - gid * nig, fm = gid * WGM, glast = nM % WGM;
        if (nM - fm >= WGM || glast == 0) { u.pm = fm + (rem & (WGM - 1)); u.pn = rem / WGM; }
        else { u.pm = fm + rem % glast; u.pn = rem / glast; }
    }
    __device__ __forceinline__ bool next(int i, Unit& u) const {
        u.kb = 0; u.nk = nt; u.piece = -1; u.lu = 0; u.idx = i;
        i += first; if (i >= limit) return false;
        const long L = (long)i * G + c;
        if (L < nfull || split == 1) { if (L >= nwg) return false; map((int)L, u); return true; }
        if (L >= nfull + G || c >= nleft * split) return false;
        u.lu = c % nleft; u.piece = c / nleft; u.nk = nt / split; u.kb = u.piece * u.nk; map(nfull + u.lu, u); return true;
    }
};

template <int P, int A, int Mi>
__device__ __forceinline__ void reduce_rowgroup(f32x4 (&acc)[2][2][4][2], const float* slab0, int tid) {
    const float* sp = slab0 + (size_t)((A * 4 + Mi) * 4) * 8192 + tid * 4;
#pragma unroll
    for (int b = 0; b < 2; ++b)
#pragma unroll
        for (int n = 0; n < 2; ++n) {
            f32x4 sum = (f32x4){0.f, 0.f, 0.f, 0.f};
#pragma unroll
            for (int src = 0; src < 4; ++src) { if (src == P) sum += acc[A][b][Mi][n]; else sum += *(const f32x4*)(sp + (size_t)src * 8192 + (b * 2 + n) * 2048); }
            acc[A][b][Mi][n] = sum;
        }
}
template <class Epi, bool FFNMAP, bool ALIGN_EPI, bool SP2>
__device__ __forceinline__ void gemm_phase(LAS unsigned char* lds, const Gemm g, const StaticOrder& S, const Epi& E, float* slabs, unsigned* tickets, bool dry = false) {
    int tid = threadIdx.x; asm volatile("" : "+v"(tid));
    const int wid = __builtin_amdgcn_readfirstlane(tid >> 6), lane = tid & 63, wr = wid >> 2, wc = wid & 3, fr = lane & 15, fq = lane >> 4;
    const int K = g.K;
    unsigned voffA[2], voffB[2];
#pragma unroll
    for (int i = 0; i < 2; ++i) { int R, C; stage_rc(tid * 16 + i * 8192, R, C); const int Ra = FFNMAP ? (126 * (R >> 6) + (R & 63)) : R;
        voffA[i] = (unsigned)(Ra * K + C) * 2u; voffB[i] = (unsigned)(R * K + C) * 2u; }
    const size_t kstep = (size_t)(BK * 2);
    const size_t hstepA = g.a_hstep, tstepA = g.a_tstep;
    const size_t hstepB = (size_t)HALF * K * 2, tstepB = 2 * hstepB;
    const unsigned ldsw = (unsigned)wid * 1024u;
    const int aoff = lds_byte(wr * 64 + fr, fq * 8), boff = lds_byte(wc * 32 + fr, fq * 8);
#define PG8_SA(b, h) (((b) * 2 + (h)) * HTB)
#define PG8_SB(b, h) ((4 + (b) * 2 + (h)) * HTB)
#define PG8_STAGE(bufoff, gbase, voff) do { _Pragma("unroll") for (int _i = 0; _i < 2; ++_i) \
        __builtin_amdgcn_global_load_lds((const unsigned*)((const char*)(gbase) + (voff)[_i]), (LAS unsigned*)(lds + (bufoff) + ldsw + _i * 8192), 16, 0, 0); } while (0)
#define PG8_LDA(dst, b, h) do { _Pragma("unroll") for (int m = 0; m < 4; ++m) _Pragma("unroll") for (int k = 0; k < 2; ++k) dst[m][k] = *(const LAS bf16x8*)(lds + PG8_SA(b, h) + aoff + m * 2048 + k * 1024); } while (0)
#define PG8_LDB(dst, b, h) do { _Pragma("unroll") for (int n = 0; n < 2; ++n) _Pragma("unroll") for (int k = 0; k < 2; ++k) dst[n][k] = *(const LAS bf16x8*)(lds + PG8_SB(b, h) + boff + n * 2048 + k * 1024); } while (0)
#define PG8_MMA(ai, bj, At, Bt) do { __builtin_amdgcn_s_setprio(1); _Pragma("unroll") for (int m = 0; m < 4; ++m) _Pragma("unroll") for (int n = 0; n < 2; ++n) _Pragma("unroll") for (int k = 0; k < 2; ++k) \
        acc[ai][bj][m][n] = __builtin_amdgcn_mfma_f32_16x16x32_bf16(Bt[n][k], At[m][k], acc[ai][bj][m][n], 0, 0, 0); __builtin_amdgcn_s_setprio(0); } while (0)
#define PG8_WAIT_V(n) asm volatile("s_waitcnt vmcnt(" #n ")" ::: "memory")
#define PG8_WAIT_L(n) asm volatile("s_waitcnt lgkmcnt(" #n ")" ::: "memory")
#define PG8_BAR __builtin_amdgcn_s_barrier()
#define PG8_SCHED __builtin_amdgcn_sched_barrier(0)
    Unit cur, nxt; int ui = 0;
    if (!S.next(0, cur)) return;
    f32x4 acc[2][2][4][2];
#pragma unroll
    for (int a = 0; a < 2; ++a)
#pragma unroll
        for (int b = 0; b < 2; ++b)
#pragma unroll
            for (int m = 0; m < 4; ++m)
#pragma unroll
                for (int n = 0; n < 2; ++n) acc[a][b][m][n] = (f32x4){0.f, 0.f, 0.f, 0.f};
    bf16x8 At[4][2], B0[2][2], B1[2][2];
    const char* cA = (const char*)g.A + (size_t)cur.pm * tstepA + (size_t)cur.kb * kstep; const char* cB = (const char*)g.Bt + (size_t)cur.pn * tstepB + (size_t)cur.kb * kstep;
    if constexpr (SP2) {
        PG8_STAGE(PG8_SB(0, 0), cB, voffB); PG8_STAGE(PG8_SB(0, 1), cB + hstepB, voffB); PG8_STAGE(PG8_SA(0, 0), cA, voffA); PG8_STAGE(PG8_SA(0, 1), cA + hstepA, voffA);
        if (wr == 1) PG8_BAR;
        PG8_WAIT_V(2); PG8_BAR;
        PG8_STAGE(PG8_SB(1, 0), cB + kstep, voffB); PG8_STAGE(PG8_SA(1, 0), cA + kstep, voffA); PG8_STAGE(PG8_SB(1, 1), cB + hstepB + kstep, voffB);
        PG8_WAIT_V(6); PG8_BAR;
    } else {
        PG8_STAGE(PG8_SB(0, 0), cB, voffB); PG8_STAGE(PG8_SA(0, 0), cA, voffA); PG8_STAGE(PG8_SB(0, 1), cB + hstepB, voffB); PG8_STAGE(PG8_SA(0, 1), cA + hstepA, voffA);
        if (wr == 1) PG8_BAR;
        PG8_WAIT_V(4); PG8_BAR;
        PG8_STAGE(PG8_SB(1, 0), cB + kstep, voffB); PG8_STAGE(PG8_SA(1, 0), cA + kstep, voffA); PG8_STAGE(PG8_SB(1, 1), cB + hstepB + kstep, voffB);
        PG8_WAIT_V(6); PG8_BAR;
    }
    for (;;) {
        const bool has_next = S.next(ui + 1, nxt);
        const char* nA = has_next ? (const char*)g.A + (size_t)nxt.pm * tstepA + (size_t)nxt.kb * kstep : cA; const char* nB = has_next ? (const char*)g.Bt + (size_t)nxt.pn * tstepB + (size_t)nxt.kb * kstep : cB;
        const int nt = cur.nk;
        for (int t = 0; t < nt; t += 2) {
            const bool last = (t == nt - 2);
            const char* a1 = cA + (size_t)(t + 1) * kstep;
            const char* a2 = last ? nA : cA + (size_t)(t + 2) * kstep; const char* b2 = last ? nB : cB + (size_t)(t + 2) * kstep;
            const char* a3 = a2 + kstep; const char* b3 = b2 + kstep;
            if constexpr (SP2) {
            PG8_LDB(B0, 0, 0); PG8_LDB(B1, 0, 1); PG8_SCHED; PG8_LDA(At, 0, 0); PG8_STAGE(PG8_SA(1, 1), a1 + hstepA, voffA);
            PG8_WAIT_V(8); PG8_WAIT_L(0); PG8_BAR; PG8_MMA(0, 0, At, B0); PG8_MMA(0, 1, At, B1); PG8_BAR; PG8_SCHED;
            PG8_LDA(At, 0, 1); PG8_STAGE(PG8_SB(0, 0), b2, voffB); PG8_STAGE(PG8_SB(0, 1), b2 + hstepB, voffB); PG8_STAGE(PG8_SA(0, 0), a2, voffA);
            PG8_WAIT_V(8); PG8_WAIT_L(0); PG8_BAR; PG8_MMA(1, 0, At, B0); PG8_MMA(1, 1, At, B1); PG8_BAR; PG8_SCHED;
            PG8_LDB(B0, 1, 0); PG8_LDB(B1, 1, 1); PG8_SCHED; PG8_LDA(At, 1, 0); PG8_STAGE(PG8_SA(0, 1), a2 + hstepA, voffA);
            PG8_WAIT_V(8); PG8_WAIT_L(0); PG8_BAR; PG8_MMA(0, 0, At, B0); PG8_MMA(0, 1, At, B1); PG8_BAR; PG8_SCHED;
            PG8_LDA(At, 1, 1); PG8_STAGE(PG8_SB(1, 0), b3, voffB); PG8_STAGE(PG8_SB(1, 1), b3 + hstepB, voffB); PG8_STAGE(PG8_SA(1, 0), a3, voffA);
            PG8_WAIT_V(8); PG8_WAIT_L(0); PG8_BAR; PG8_MMA(1, 0, At, B0); PG8_MMA(1, 1, At, B1); PG8_BAR; PG8_SCHED;
            } else {
            PG8_LDB(B0, 0, 0); PG8_SCHED; PG8_LDA(At, 0, 0); PG8_STAGE(PG8_SA(1, 1), a1 + hstepA, voffA);
            PG8_WAIT_L(8); PG8_BAR; PG8_WAIT_L(0); PG8_MMA(0, 0, At, B0); PG8_BAR; PG8_SCHED;
            PG8_LDB(B1, 0, 1); PG8_STAGE(PG8_SB(0, 0), b2, voffB);
            PG8_BAR; PG8_WAIT_L(0); PG8_MMA(0, 1, At, B1); PG8_BAR;
            PG8_LDA(At, 0, 1); PG8_STAGE(PG8_SA(0, 0), a2, voffA);
            PG8_BAR; PG8_WAIT_L(0); PG8_MMA(1, 0, At, B0); PG8_BAR; PG8_SCHED;
            PG8_STAGE(PG8_SB(0, 1), b2 + hstepB, voffB);
            PG8_WAIT_V(6); PG8_BAR; PG8_MMA(1, 1, At, B1); PG8_BAR;
            PG8_LDB(B0, 1, 0); PG8_SCHED; PG8_LDA(At, 1, 0); PG8_STAGE(PG8_SA(0, 1), a2 + hstepA, voffA);
            PG8_WAIT_L(8); PG8_BAR; PG8_WAIT_L(0); PG8_MMA(0, 0, At, B0); PG8_BAR; PG8_SCHED;
            PG8_LDB(B1, 1, 1); PG8_STAGE(PG8_SB(1, 0), b3, voffB);
            PG8_BAR; PG8_WAIT_L(0); PG8_MMA(0, 1, At, B1); PG8_BAR;
            PG8_LDA(At, 1, 1); PG8_STAGE(PG8_SA(1, 0), a3, voffA);
            PG8_BAR; PG8_WAIT_L(0); PG8_MMA(1, 0, At, B0); PG8_BAR; PG8_SCHED;
            PG8_STAGE(PG8_SB(1, 1), b3 + hstepB, voffB);
            PG8_WAIT_V(6); PG8_BAR; PG8_MMA(1, 1, At, B1); PG8_BAR;
            }
        }
        if constexpr (ALIGN_EPI) { if (wr == 0) PG8_BAR; }
        if (cur.piece < 0 && !dry) E(acc, cur, wr, wc, fr, fq);
        if (!has_next) break;
#pragma unroll
        for (int a = 0; a < 2; ++a)
#pragma unroll
            for (int b = 0; b < 2; ++b)
#pragma unroll
                for (int m = 0; m < 4; ++m)
#pragma unroll
                    for (int n = 0; n < 2; ++n) acc[a][b][m][n] = (f32x4){0.f, 0.f, 0.f, 0.f};
        cur = nxt; cA = nA; cB = nB; ++ui;
        if constexpr (ALIGN_EPI) { if (wr == 1) PG8_BAR; }
    }
    PG8_WAIT_V(0);
    if constexpr (!ALIGN_EPI) { if (wr == 0) PG8_BAR; }
    PG8_BAR;
    if constexpr (Epi::SPLIT) {
    if (cur.piece >= 0 && !dry) {
        float* slab0 = slabs + (size_t)cur.lu * (8 * 4 * 8192);
        {
            const __amdgpu_buffer_rsrc_t rs = __builtin_amdgcn_make_buffer_rsrc((void*)slab0, (short)0, 8 * 4 * 32768, 0x00020000);
#pragma unroll
            for (int a = 0; a < 2; ++a)
#pragma unroll
                for (int m = 0; m < 4; ++m) {
                    const int gq = a * 4 + m;
                    if ((gq >> 1) != cur.piece) {
#pragma unroll
                        for (int b = 0; b < 2; ++b)
#pragma unroll
                            for (int n = 0; n < 2; ++n) __builtin_amdgcn_raw_buffer_store_b128(__builtin_bit_cast(u32x4, acc[a][b][m][n]), rs, (gq * 4 + cur.piece) * 32768 + (b * 2 + n) * 8192 + tid * 16, 0, 16);
                    }
                }
        }
        asm volatile("s_waitcnt vmcnt(0)" ::: "memory");
        __syncthreads();
        if (tid == 0) {
            __hip_atomic_fetch_add(tickets + 64 * cur.lu, 1u, __ATOMIC_RELAXED, __HIP_MEMORY_SCOPE_AGENT);
            unsigned sp = 0;
            while (__hip_atomic_load(tickets + 64 * cur.lu, __ATOMIC_RELAXED, __HIP_MEMORY_SCOPE_AGENT) < 4u) { __builtin_amdgcn_s_sleep(2); if (++sp > (1u << 20)) break; }
            __builtin_amdgcn_fence(__ATOMIC_ACQUIRE, "agent"); asm volatile("s_waitcnt vmcnt(0)" ::: "memory");
        }
        __syncthreads();
        switch (cur.piece) {
            case 0: reduce_rowgroup<0, 0, 0>(acc, slab0, tid); reduce_rowgroup<0, 0, 1>(acc, slab0, tid); break;
            case 1: reduce_rowgroup<1, 0, 2>(acc, slab0, tid); reduce_rowgroup<1, 0, 3>(acc, slab0, tid); break;
            case 2: reduce_rowgroup<2, 1, 0>(acc, slab0, tid); reduce_rowgroup<2, 1, 1>(acc, slab0, tid); break;
            default: reduce_rowgroup<3, 1, 2>(acc, slab0, tid); reduce_rowgroup<3, 1, 3>(acc, slab0, tid); break;
        }
        E(acc, cur, wr, wc, fr, fq, 3u << (2 * cur.piece));
    }
    }
#undef PG8_SA
#undef PG8_SB
#undef PG8_STAGE
#undef PG8_LDA
#undef PG8_LDB
#undef PG8_MMA
#undef PG8_WAIT_V
#undef PG8_WAIT_L
#undef PG8_BAR
#undef PG8_SCHED
}
}

typedef f32x4 Acc[2][2][4][2];

struct EpiZ {
    static constexpr bool SPLIT = false;
    const float* rstd1; bf16_t* z; float* out;
    __device__ __forceinline__ void operator()(const Acc& acc, const pg8::Unit& u, int wr, int wc, int fr, int fq) const {
        asm volatile("" : "+v"(fr), "+v"(fq));
        const int col0 = u.pn * 256 + wc * 32 + 8 * fq;
#pragma unroll
        for (int ai = 0; ai < 2; ++ai)
#pragma unroll
            for (int m = 0; m < 4; ++m) {
                const int r = u.pm * 256 + ai * 128 + wr * 64 + m * 16 + fr;
                if (r < M) {
                    const float rs = rstd1[r];
                    int is_s, seq, t; row_decode(r, is_s, seq, t);
                    float* so = nullptr;
                    if (u.pn < 6) { if (is_s) { if (t >= TS - 3) so = out + O_SRC + ((size_t)seq * 3 + (t - (TS - 3))) * DA; } else { if (t >= TP - 3) so = out + O_PRC + ((size_t)seq * 3 + (t - (TP - 3))) * DA; } }
#pragma unroll
                    for (int bj = 0; bj < 2; ++bj) {
                        const f32x4 v0 = acc[ai][bj][m][0] * rs, v1 = acc[ai][bj][m][1] * rs;
                        u32x4 w; w.x = cvt_pk_bf16(v0[0], v0[1]); w.y = cvt_pk_bf16(v0[2], v0[3]); w.z = cvt_pk_bf16(v1[0], v1[1]); w.w = cvt_pk_bf16(v1[2], v1[3]);
                        *(u32x4*)(z + (size_t)r * DIN + col0 + bj * 128) = w;
                        if (so) { *(f32x4*)(so + col0 + bj * 128) = v0; *(f32x4*)(so + col0 + bj * 128 + 4) = v1; }
                    }
                }
            }
    }
};
struct EpiX1 {
    static constexpr bool SPLIT = true;
    const float *xp, *xs, *meta; float* out; bf16_t* x1b; float* ssq;
    __device__ __forceinline__ void operator()(const Acc& acc, const pg8::Unit& u, int wr, int wc, int fr, int fq, unsigned gmask = 0xffu) const {
        asm volatile("" : "+v"(fr), "+v"(fq));
        const int col0 = u.pn * 256 + wc * 32 + 8 * fq;
#pragma unroll
        for (int ai = 0; ai < 2; ++ai) {
            if (!((gmask >> (ai * 4)) & 0xfu)) continue;
            f32x4 xv[4][2][2];
#pragma unroll
            for (int m = 0; m < 4; ++m) {
                const int r = u.pm * 256 + ai * 128 + wr * 64 + m * 16 + fr;
                const float* xr = x_row_ptr(xp, xs, meta, r < M ? r : 0) + col0;
#pragma unroll
                for (int bj = 0; bj < 2; ++bj) { xv[m][bj][0] = *(const f32x4*)(xr + bj * 128); xv[m][bj][1] = *(const f32x4*)(xr + bj * 128 + 4); }
            }
#pragma unroll
            for (int m = 0; m < 4; ++m) {
                if (!((gmask >> (ai * 4 + m)) & 1u)) continue;
                const int r = u.pm * 256 + ai * 128 + wr * 64 + m * 16 + fr;
                const bool valid = r < M;
                float* yd = y_row_ptr(out, r);
                float ss = 0.f;
#pragma unroll
                for (int bj = 0; bj < 2; ++bj) {
                    const int c = col0 + bj * 128;
                    const f32x4 v0 = acc[ai][bj][m][0] + xv[m][bj][0], v1 = acc[ai][bj][m][1] + xv[m][bj][1];
                    ss += (v0[0] * v0[0] + v0[1] * v0[1]) + (v0[2] * v0[2] + v0[3] * v0[3]) + (v1[0] * v1[0] + v1[1] * v1[1]) + (v1[2] * v1[2] + v1[3] * v1[3]);
                    if (yd) { *(f32x4*)(yd + c) = v0; *(f32x4*)(yd + c + 4) = v1; }
                    if (valid) { u32x4 w; w.x = cvt_pk_bf16(v0[0], v0[1]); w.y = cvt_pk_bf16(v0[2], v0[3]); w.z = cvt_pk_bf16(v1[0], v1[1]); w.w = cvt_pk_bf16(v1[2], v1[3]);
                        *(u32x4*)(x1b + (size_t)r * D + c) = w; }
                }
                ss += __shfl_xor(ss, 16); ss += __shfl_xor(ss, 32);
                if (valid && fq == 0) ssq[(size_t)r * 32 + u.pn * 4 + wc] = ss;
            }
        }
    }
};
struct EpiOut {
    static constexpr bool SPLIT = true;
    float* out;
    __device__ __forceinline__ void operator()(const Acc& acc, const pg8::Unit& u, int wr, int wc, int fr, int fq, unsigned gmask = 0xffu) const {
        asm volatile("" : "+v"(fr), "+v"(fq));
        const int col0 = u.pn * 256 + wc * 32 + 8 * fq;
#pragma unroll
        for (int ai = 0; ai < 2; ++ai) {
            if (!((gmask >> (ai * 4)) & 0xfu)) continue;
            f32x4 xv[4][2][2];
#pragma unroll
            for (int m = 0; m < 4; ++m) {
                const int r = u.pm * 256 + ai * 128 + wr * 64 + m * 16 + fr;
                const float* yd = y_row_ptr(out, r); const float* ys = (yd ? yd : out) + col0;
#pragma unroll
                for (int bj = 0; bj < 2; ++bj) { xv[m][bj][0] = *(const f32x4*)(ys + bj * 128); xv[m][bj][1] = *(const f32x4*)(ys + bj * 128 + 4); }
            }
#pragma unroll
            for (int m = 0; m < 4; ++m) {
                if (!((gmask >> (ai * 4 + m)) & 1u)) continue;
                const int r = u.pm * 256 + ai * 128 + wr * 64 + m * 16 + fr;
                float* yd = y_row_ptr(out, r);
                if (yd) {
#pragma unroll
                    for (int bj = 0; bj < 2; ++bj) {
                        const int c = col0 + bj * 128;
                        *(f32x4*)(yd + c) = acc[ai][bj][m][0] + xv[m][bj][0]; *(f32x4*)(yd + c + 4) = acc[ai][bj][m][1] + xv[m][bj][1];
                    }
                }
            }
        }
    }
};
struct EpiFFN {
    static constexpr bool SPLIT = false;
    const float *cw, *cb, *st_fc; bf16_t* hid; float* out; const LAS float* rstab;
    __device__ __forceinline__ void operator()(Acc& acc, const pg8::Unit& u, int wr, int wc, int fr, int fq) const {
        asm volatile("" : "+v"(fr), "+v"(fq));
        const int gbase = 252 * u.pm - 2 + 126 * wr;
        const int f0 = 128 * u.pn + 32 * wc + 8 * fq;
        const f32x4 w0a = *(const f32x4*)(cw + f0), w0b = *(const f32x4*)(cw + f0 + 4);
        const f32x4 w1a = *(const f32x4*)(cw + DFF + f0), w1b = *(const f32x4*)(cw + DFF + f0 + 4);
        const f32x4 w2a = *(const f32x4*)(cw + 2 * DFF + f0), w2b = *(const f32x4*)(cw + 2 * DFF + f0 + 4);
        const f32x4 bba = *(const f32x4*)(cb + f0), bbb = *(const f32x4*)(cb + f0 + 4);
        const LAS float* rt = rstab + u.idx * 256 + wr * 128 + fr;
#pragma unroll
        for (int ai = 0; ai < 2; ++ai)
#pragma unroll
            for (int m = 0; m < 4; ++m) {
                const float rs = rt[64 * ai + 16 * m];
#pragma unroll
                for (int bj = 0; bj < 2; ++bj)
#pragma unroll
                    for (int n = 0; n < 2; ++n) acc[ai][bj][m][n] *= rs;
            }
        const bool has_samples = 252 * u.pm + 252 > MPR;
#pragma unroll
        for (int ai = 0; ai < 2; ++ai)
#pragma unroll
            for (int m = 0; m < 4; ++m) {
                const int j = 64 * ai + 16 * m + fr, r = gbase + j;
                const bool valid = (j >= 2) && (r < M);
                const f32x4 c0 = acc[ai][0][m][0], c1 = acc[ai][0][m][1];
                const int pai = (m == 0) ? (ai == 0 ? 0 : ai - 1) : ai, pm_ = (m == 0) ? (ai == 0 ? 0 : 3) : m - 1;
                const f32x4 q0 = acc[pai][0][pm_][0], q1 = acc[pai][0][pm_][1];
                f32x4 p1a, p1b, p2a, p2b;
#pragma unroll
                for (int e = 0; e < 4; ++e) {
                    p1a[e] = dppf<0x111>(dppf<0x121>(0.f, q0[e]), c0[e]); p1b[e] = dppf<0x111>(dppf<0x121>(0.f, q1[e]), c1[e]);
                    p2a[e] = dppf<0x112>(dppf<0x122>(0.f, q0[e]), c0[e]); p2b[e] = dppf<0x112>(dppf<0x122>(0.f, q1[e]), c1[e]);
                }
                int is_s, seq, t; row_decode(valid ? r : 0, is_s, seq, t);
                if (!has_samples) {
                    const f32x4 zz = (f32x4){0.f, 0.f, 0.f, 0.f};
                    if (t == 0) { p1a = zz; p1b = zz; }
                    if (t < 2) { p2a = zz; p2b = zz; }
                } else if (valid && t < 2) {
                    f32x4 s0a = (f32x4){0.f, 0.f, 0.f, 0.f}, s0b = s0a, s1a = s0a, s1b = s0a;
                    if (is_s) { const float* sp = st_fc + (size_t)seq * 2 * DFF + f0; s0a = *(const f32x4*)sp; s0b = *(const f32x4*)(sp + 4); s1a = *(const f32x4*)(sp + DFF); s1b = *(const f32x4*)(sp + DFF + 4); }
                    if (t == 0) { p1a = s1a; p1b = s1b; p2a = s0a; p2b = s0b; } else { p2a = s1a; p2b = s1b; }
                }
                const f32x4 ga = w0a * p2a + w1a * p1a + w2a * c0 + bba, gb = w0b * p2b + w1b * p1b + w2b * c1 + bbb;
                const f32x4 va = acc[ai][1][m][0], vb = acc[ai][1][m][1];
                if (valid) {
                    u32x4 w;
                    w.x = cvt_pk_bf16(gelu_tanh(ga[0]) * va[0], gelu_tanh(ga[1]) * va[1]); w.y = cvt_pk_bf16(gelu_tanh(ga[2]) * va[2], gelu_tanh(ga[3]) * va[3]);
                    w.z = cvt_pk_bf16(gelu_tanh(gb[0]) * vb[0], gelu_tanh(gb[1]) * vb[1]); w.w = cvt_pk_bf16(gelu_tanh(gb[2]) * vb[2], gelu_tanh(gb[3]) * vb[3]);
                    *(u32x4*)(hid + (size_t)r * DFF + f0) = w;
                    const int T = is_s ? TS : TP;
                    if (t >= T - 2) { float* so = out + (is_s ? O_SFC : O_PFC) + ((size_t)seq * 2 + (t - (T - 2))) * DFF + f0; *(f32x4*)so = c0; *(f32x4*)(so + 4) = c1; }
                }
                if (m & 1) __builtin_amdgcn_sched_barrier(0);
            }
    }
};
__device__ __forceinline__ void ffn_rstd_table(const float* ssq, LAS float* tab, const pg8::StaticOrder& S) {
    const int tid = opaque_tid(), q = tid >> 1, half = tid & 1;
    pg8::Unit u;
    for (int i = 0; S.next(i, u); ++i) {
        int r = 252 * u.pm - 2 + 126 * (q >> 7) + (q & 127); r = r < 0 ? 0 : (r >= M ? M - 1 : r);
        const float* sp = ssq + (size_t)r * 32 + 16 * half;
        const f32x4 a = *(const f32x4*)sp, b = *(const f32x4*)(sp + 4), c = *(const f32x4*)(sp + 8), d = *(const f32x4*)(sp + 12);
        float sm = (((a[0] + a[1]) + (a[2] + a[3])) + ((b[0] + b[1]) + (b[2] + b[3]))) + (((c[0] + c[1]) + (c[2] + c[3])) + ((d[0] + d[1]) + (d[2] + d[3])));
        sm += __shfl_xor(sm, 1);
        if (half == 0) tab[i * 256 + q] = __builtin_amdgcn_rsqf(sm * (1.0f / D) + EPS);
    }
}

struct EpiProbe {
    static constexpr bool SPLIT = false;
    bf16_t* hid;
    __device__ __forceinline__ void operator()(const Acc& acc, const pg8::Unit& u, int wr, int wc, int fr, int fq) const {
        asm volatile("" : "+v"(fr), "+v"(fq));
        const int gbase = 252 * u.pm - 2 + 126 * wr, f0 = 128 * u.pn + 32 * wc + 8 * fq;
#pragma unroll
        for (int ai = 0; ai < 2; ++ai)
#pragma unroll
            for (int m = 0; m < 4; ++m) {
                const int j = 64 * ai + 16 * m + fr, r = gbase + j;
                if (j >= 2 && r < M) { const f32x4 a = acc[ai][0][m][0] + acc[ai][1][m][0], b = acc[ai][0][m][1] + acc[ai][1][m][1];
                    u32x4 w; w.x = cvt_pk_bf16(a[0], a[1]); w.y = cvt_pk_bf16(a[2], a[3]); w.z = cvt_pk_bf16(b[0], b[1]); w.w = cvt_pk_bf16(b[2], b[3]);
                    *(u32x4*)(hid + (size_t)r * DFF + f0) = w; }
            }
    }
};

__device__ __forceinline__ int invperm32(int q) { return 16 * ((q >> 2) & 1) + 4 * (q >> 3) + (q & 3); }
__device__ __forceinline__ void p0_transpose_item(const float* W, int K, int N, const float* kscale, bf16_t* WT, int mode, LAS float* scr, int item, int lane) {
    const int nblk = N / 32, kb = item / nblk, nb = item % nblk, k0 = 64 * kb, n0 = 32 * nb;
    float v[32];
    const float* src = W + (size_t)(k0 + (lane >> 5)) * N + n0 + (lane & 31);
#pragma unroll
    for (int i = 0; i < 32; ++i) v[i] = src[(size_t)(2 * i) * N];
#pragma unroll
    for (int i = 0; i < 32; ++i) scr[(2 * i + (lane >> 5)) * 33 + (lane & 31)] = v[i];
    asm volatile("s_waitcnt lgkmcnt(0)" ::: "memory");
    int rbase = n0;
    if (mode == 1) { const int bj = n0 >= DFF ? 1 : 0, f = n0 - bj * DFF; rbase = 256 * (f >> 7) + 128 * bj + (f & 96); }
    const int c = lane & 7;
    f32x4 ks0 = (f32x4){1.f, 1.f, 1.f, 1.f}, ks1 = ks0;
    if (kscale) { ks0 = *(const f32x4*)(kscale + k0 + 8 * c); ks1 = *(const f32x4*)(kscale + k0 + 8 * c + 4); }
#pragma unroll
    for (int j = 0; j < 4; ++j) { const int n = (lane >> 3) + 8 * j; const LAS float* sp = scr + (8 * c) * 33 + n;
        u32x4 o; o.x = cvt_pk_bf16(sp[0 * 33] * ks0[0], sp[1 * 33] * ks0[1]); o.y = cvt_pk_bf16(sp[2 * 33] * ks0[2], sp[3 * 33] * ks0[3]);
        o.z = cvt_pk_bf16(sp[4 * 33] * ks1[0], sp[5 * 33] * ks1[1]); o.w = cvt_pk_bf16(sp[6 * 33] * ks1[2], sp[7 * 33] * ks1[3]);
        *(u32x4*)(WT + (size_t)(rbase + (mode == 2 ? n : invperm32(n))) * K + k0 + 8 * c) = o; }
    asm volatile("s_waitcnt lgkmcnt(0)" ::: "memory");
}
constexpr int I_IN = (D / 64) * (DIN / 32), I_O = (DMIX / 64) * (D / 32), I_UP = (D / 64) * (2 * DFF / 32), I_DN = (DFF / 64) * (D / 32), I_G = 2 * NH * 8;
constexpr int IT_O = I_IN, IT_UP = IT_O + I_O, IT_DN = IT_UP + I_UP, IT_G = IT_DN + I_DN, IT_END = IT_G + I_G;
__device__ __forceinline__ void convert_items(PRef p, LAS unsigned char* lds, int rank, int nwaves, int lo, int hi) {
    const int tid_ = opaque_tid(), lane = tid_ & 63, wave = tid_ >> 6;
    unsigned char* ws = p.ws;
    LAS float* scr = (LAS float*)(lds + wave * 16384);
    for (int it = lo + rank; it < hi; it += nwaves) {
        int r = it;
        if (r < I_IN) { p0_transpose_item(p.w_in, D, DIN, p.g_mix, (bf16_t*)(ws + WS_WIN), 0, scr, r, lane); continue; } r -= I_IN;
        if (r < I_O) { p0_transpose_item(p.w_o, DMIX, D, nullptr, (bf16_t*)(ws + WS_WO), 0, scr, r, lane); continue; } r -= I_O;
        if (r < I_UP) { p0_transpose_item(p.w_up, D, 2 * DFF, p.g_ffn, (bf16_t*)(ws + WS_WUP), 1, scr, r, lane); continue; } r -= I_UP;
        if (r < I_DN) { p0_transpose_item(p.w_down, DFF, D, nullptr, (bf16_t*)(ws + WS_WDN), 0, scr, r, lane); continue; } r -= I_DN;
        { const int mat = r >> 3, sub = r & 7, gsel = mat / NH, n = mat % NH;
          p0_transpose_item((gsel ? p.w_gate_x : p.w_gate_a) + (size_t)n * 128 * 128, 128, 128, nullptr, (bf16_t*)(ws + WS_WG) + (size_t)mat * 128 * 128, 0, scr, sub, lane); }
    }
}
constexpr int P1_TAIL_WG0 = (888 % 256), P4_TAIL_WG0 = (296 % 256) * P4_SPLIT, MIX_IDLE_WG0 = 228, IT_S1 = IT_O + 9000, IT_S2 = IT_S1 + 2400, IT_S3 = IT_S2 + 2400;
__device__ __forceinline__ void phase0(PRef p, LAS unsigned char* lds, int G) {
    const int tid = opaque_tid(), lane = tid & 63, wave = tid >> 6;
    unsigned char* ws = p.ws;
    const int gw = blockIdx.x * 8 + wave, NGW = G * 8;
    convert_items(p, lds, gw, NGW, 0, IT_O);
    convert_items(p, lds, gw, NGW, IT_G, IT_END);
    { bf16_t* xb = (bf16_t*)(ws + WS_XB) + (size_t)16 * D; float* rstd1 = (float*)(ws + WS_RS1);
      for (int m = gw; m < M; m += NGW) {
          const f32x4* xr = (const f32x4*)x_row_ptr(p.x_prompt, p.x_sample, p.meta, m) + lane;
          f32x4 v[8]; float s = 0.f;
#pragma unroll
          for (int j = 0; j < 8; ++j) { v[j] = xr[64 * j]; s += (v[j][0] * v[j][0] + v[j][1] * v[j][1]) + (v[j][2] * v[j][2] + v[j][3] * v[j][3]); }
          s = wave_sum(s);
          if (lane == 0) rstd1[m] = __builtin_amdgcn_rsqf(s * (1.0f / D) + EPS);
          u32x2* o = (u32x2*)(xb + (size_t)m * D) + lane;
#pragma unroll
          for (int j = 0; j < 8; ++j) { u32x2 w; w.x = cvt_pk_bf16(v[j][0], v[j][1]); w.y = cvt_pk_bf16(v[j][2], v[j][3]); o[64 * j] = w; }
      } }
}

__device__ __forceinline__ void branch_b(PRef p, int G) {
    const bf16_t* z = (const bf16_t*)(p.ws + WS_Z); bf16_t* ym = (bf16_t*)(p.ws + WS_YM);
    const int total = (M / 4) * 128;
    for (int idx = blockIdx.x * 512 + opaque_tid(); idx < total; idx += G * 512) {
        const int m0 = (idx >> 7) * 4, g = idx & 127, ch = 8 * g;
        int is_s, seq, t0; row_decode(m0, is_s, seq, t0);
        u32x4 rc[6], rv[6], rg[4];
#pragma unroll
        for (int k = 0; k < 6; ++k) {
            const int mm = (t0 - 2 + k >= 0) ? m0 - 2 + k : m0;
            rc[k] = *(const u32x4*)(z + (size_t)mm * DIN + 4096 + ch); rv[k] = *(const u32x4*)(z + (size_t)mm * DIN + 5120 + ch);
        }
#pragma unroll
        for (int k = 0; k < 4; ++k) rg[k] = *(const u32x4*)(z + (size_t)(m0 + k) * DIN + 3072 + ch);
        const f32x4 w0a = *(const f32x4*)(p.conv_b_w + ch), w0b = *(const f32x4*)(p.conv_b_w + ch + 4), w1a = *(const f32x4*)(p.conv_b_w + DB + ch), w1b = *(const f32x4*)(p.conv_b_w + DB + ch + 4),
                    w2a = *(const f32x4*)(p.conv_b_w + 2 * DB + ch), w2b = *(const f32x4*)(p.conv_b_w + 2 * DB + ch + 4), goa = *(const f32x4*)(p.g_out_b + ch), gob = *(const f32x4*)(p.g_out_b + ch + 4);
        float u[6][8];
#pragma unroll
        for (int k = 0; k < 6; ++k) {
            float a[8], b[8]; unpack8(rc[k], a); unpack8(rv[k], b);
#pragma unroll
            for (int e = 0; e < 8; ++e) u[k][e] = a[e] * b[e];
        }
        if (t0 == 0) {
#pragma unroll
            for (int k = 0; k < 2; ++k) {
                f32x4 a = (f32x4){0.f, 0.f, 0.f, 0.f}, b = a;
                if (is_s) { const float* sp = p.st_sc + ((size_t)seq * 2 + k) * DB + ch; a = *(const f32x4*)sp; b = *(const f32x4*)(sp + 4); }
#pragma unroll
                for (int e = 0; e < 4; ++e) { u[k][e] = a[e]; u[k][4 + e] = b[e]; }
            }
        }
        const int T = is_s ? TS : TP;
#pragma unroll
        for (int k = 0; k < 4; ++k) {
            float gb[8]; unpack8(rg[k], gb);
            float y[8]; float ss = 0.f;
#pragma unroll
            for (int e = 0; e < 8; ++e) {
                const float uc = (e < 4 ? w0a[e & 3] : w0b[e & 3]) * u[k][e] + (e < 4 ? w1a[e & 3] : w1b[e & 3]) * u[k + 1][e] + (e < 4 ? w2a[e & 3] : w2b[e & 3]) * u[k + 2][e];
                y[e] = gb[e] * uc; ss += y[e] * y[e];
            }
            ss = sum16(ss);
            const float rn = __builtin_amdgcn_rsqf(ss * (1.0f / 128.0f) + EPS);
#pragma unroll
            for (int e = 0; e < 8; ++e) y[e] = y[e] * rn * (e < 4 ? goa[e & 3] : gob[e & 3]);
            *(u32x4*)(ym + (size_t)(m0 + k) * DMIX + DA + ch) = pack8(y);
            const int t = t0 + k;
            if (t >= T - 2) { float* so = p.out + (is_s ? O_SSC : O_PSC) + ((size_t)seq * 2 + (t - (T - 2))) * DB + ch;
                *(f32x4*)so = (f32x4){u[k + 2][0], u[k + 2][1], u[k + 2][2], u[k + 2][3]}; *(f32x4*)(so + 4) = (f32x4){u[k + 2][4], u[k + 2][5], u[k + 2][6], u[k + 2][7]}; }
        }
    }
}

constexpr int LW_STRIDE = 272, L_WA = 0, L_WX = 128 * LW_STRIDE, L_CT = 2 * 128 * LW_STRIDE, L_LRU_END = L_CT + 9 * 128 * 4;
static_assert(L_LRU_END <= 131072, "mixer LDS");
constexpr int LRU_WG_PER_HEAD = 19, LRU_NSEG = 33, LRU_PITEMS = NB * LRU_NSEG, LRU_SITEMS = MSR / 64;
static_assert(LRU_WG_PER_HEAD * 8 >= LRU_PITEMS + LRU_SITEMS, "waves per head");

template <int CTRL, int BANK> __device__ __forceinline__ float dppfb(float old, float src) {
    return __builtin_bit_cast(float, __builtin_amdgcn_update_dpp(__builtin_bit_cast(int, old), __builtin_bit_cast(int, src), CTRL, 0xF, BANK, false));
}
__device__ __forceinline__ float bcast15(float x, int lane) {
    return __builtin_bit_cast(float, __builtin_amdgcn_ds_bpermute(((lane & 48) | 15) << 2, __builtin_bit_cast(int, x)));
}
__device__ __forceinline__ void scan16(float& P, float& S) {
    float Sd, Pd;
    Sd = dppf<0x111>(0.f, S); Pd = dppf<0x111>(1.f, P); S = __builtin_fmaf(P, Sd, S); P *= Pd;
    Sd = dppf<0x112>(0.f, S); Pd = dppf<0x112>(1.f, P); S = __builtin_fmaf(P, Sd, S); P *= Pd;
    Sd = dppf<0x114>(0.f, S); Pd = dppf<0x114>(1.f, P); S = __builtin_fmaf(P, Sd, S); P *= Pd;
    Sd = dppf<0x118>(0.f, S); Pd = dppf<0x118>(1.f, P); S = __builtin_fmaf(P, Sd, S); P *= Pd;
}
__device__ __forceinline__ void scan8(float& P, float& S, int t) {
    float Sd, Pd;
    Sd = dppf<0x111>(0.f, S); Pd = dppf<0x111>(1.f, P); if (t < 1) { Sd = 0.f; Pd = 1.f; } S = __builtin_fmaf(P, Sd, S); P *= Pd;
    Sd = dppf<0x112>(0.f, S); Pd = dppf<0x112>(1.f, P); if (t < 2) { Sd = 0.f; Pd = 1.f; } S = __builtin_fmaf(P, Sd, S); P *= Pd;
    Sd = dppfb<0x114, 0xA>(0.f, S); Pd = dppfb<0x114, 0xA>(1.f, P); S = __builtin_fmaf(P, Sd, S); P *= Pd;
}

template <int PASS, bool IS_S>
__device__ __forceinline__ void lru_wave_item(PRef p, LAS unsigned char* lds, int n, int b, int seg) {
    const int lane = opaque_tid() & 63, fr = lane & 15, fq = lane >> 4;
    const bf16_t* z = (const bf16_t*)(p.ws + WS_Z);
    bf16_t* ym = (bf16_t*)(p.ws + WS_YM);
    float* tot = (float*)(p.ws + WS_TOT);
    const LAS float* CT = (const LAS float*)(lds + L_CT) + 8 * fq;
    const int gch = n * 128 + 8 * fq;
    const int r0 = IS_S ? MPR + b * 64 : b * TP + seg * 64;
    const int nblk = IS_S ? 4 : (seg == LRU_NSEG - 1 ? 1 : 4);
    float hin[4][8], Pt[4][8];
    u32x4 prevx[4];
#pragma unroll
    for (int ks = 0; ks < 4; ++ks) {
#pragma unroll
        for (int e = 0; e < 8; ++e) { hin[ks][e] = 0.f; Pt[ks][e] = 1.f; }
        prevx[ks] = (u32x4){0u, 0u, 0u, 0u};
    }
    if constexpr (!IS_S) {
        if (seg > 0) {
#pragma unroll
            for (int ks = 0; ks < 4; ++ks) prevx[ks] = *(const u32x4*)(z + (size_t)(r0 - 16 + fr) * DIN + gch + 32 * ks);
            if constexpr (PASS == 2) {
#pragma unroll 1
                for (int round = 0; round < 2; ++round) {
                    const int s = 16 * round + fr;
                    if (16 * round >= seg) break;
                    const bool have = s < seg;
                    const float* tp = tot + ((size_t)(b * LRU_NSEG + (have ? s : 0)) * 2) * DA + gch;
#pragma unroll
                    for (int ks = 0; ks < 4; ++ks) {
                        const f32x4 P0 = *(const f32x4*)(tp + 32 * ks), P1 = *(const f32x4*)(tp + 32 * ks + 4), S0 = *(const f32x4*)(tp + DA + 32 * ks), S1 = *(const f32x4*)(tp + DA + 32 * ks + 4);
#pragma unroll
                        for (int e = 0; e < 8; ++e) {
                            float P = have ? (e < 4 ? P0[e & 3] : P1[e & 3]) : 1.f, S = have ? (e < 4 ? S0[e & 3] : S1[e & 3]) : 0.f;
                            scan16(P, S);
                            const float Pc = bcast15(P, lane), Sc = bcast15(S, lane);
                            hin[ks][e] = __builtin_fmaf(Pc, hin[ks][e], Sc);
                        }
                    }
                }
            }
        }
    }
    u32x4 xnext[4];
#pragma unroll
    for (int ks = 0; ks < 4; ++ks) xnext[ks] = *(const u32x4*)(z + (size_t)(r0 + fr) * DIN + gch + 32 * ks);
#pragma unroll 1
    for (int blk = 0; blk < nblk; ++blk) {
        const int r = r0 + 16 * blk + fr;
        const int t8 = fr & 7, sq = (r - MPR) >> 3;
        u32x4 x4[4], g4[4];
#pragma unroll
        for (int ks = 0; ks < 4; ++ks) { x4[ks] = xnext[ks]; if constexpr (PASS == 2) g4[ks] = *(const u32x4*)(z + (size_t)r * DIN + DA + gch + 32 * ks); }
        { const int rn_ = (blk + 1 < nblk) ? r + 16 : r;
#pragma unroll
          for (int ks = 0; ks < 4; ++ks) xnext[ks] = *(const u32x4*)(z + (size_t)rn_ * DIN + gch + 32 * ks); }
        float xc[4][8];
        bf16x8 bfrag[4];
#pragma unroll
        for (int ks = 0; ks < 4; ++ks) {
            float xf[8]; unpack8(x4[ks], xf);
            const f32x4 w0a = *(const LAS f32x4*)(CT + 0 * 128 + 32 * ks), w0b = *(const LAS f32x4*)(CT + 0 * 128 + 32 * ks + 4);
            const f32x4 w1a = *(const LAS f32x4*)(CT + 1 * 128 + 32 * ks), w1b = *(const LAS f32x4*)(CT + 1 * 128 + 32 * ks + 4);
            const f32x4 w2a = *(const LAS f32x4*)(CT + 2 * 128 + 32 * ks), w2b = *(const LAS f32x4*)(CT + 2 * 128 + 32 * ks + 4);
            const f32x4 w3a = *(const LAS f32x4*)(CT + 3 * 128 + 32 * ks), w3b = *(const LAS f32x4*)(CT + 3 * 128 + 32 * ks + 4);
            const f32x4 cba = *(const LAS f32x4*)(CT + 4 * 128 + 32 * ks), cbb = *(const LAS f32x4*)(CT + 4 * 128 + 32 * ks + 4);
            if constexpr (IS_S) {
                const float* sp = p.st_rc + (size_t)sq * 3 * DA + gch + 32 * ks;
                const f32x4 b0a = *(const f32x4*)sp, b0b = *(const f32x4*)(sp + 4), b1a = *(const f32x4*)(sp + DA), b1b = *(const f32x4*)(sp + DA + 4), b2a = *(const f32x4*)(sp + 2 * DA), b2b = *(const f32x4*)(sp + 2 * DA + 4);
#pragma unroll
                for (int e = 0; e < 8; ++e) {
                    const float bb0 = e < 4 ? b0a[e & 3] : b0b[e & 3], bb1 = e < 4 ? b1a[e & 3] : b1b[e & 3], bb2 = e < 4 ? b2a[e & 3] : b2b[e & 3];
                    const float s1 = dppf<0x111>(0.f, xf[e]), s2 = dppf<0x112>(0.f, xf[e]), s3 = dppf<0x113>(0.f, xf[e]);
                    const float x1 = t8 >= 1 ? s1 : bb2;
                    const float x2 = t8 >= 2 ? s2 : (t8 == 1 ? bb2 : bb1);
                    const float x3 = t8 >= 3 ? s3 : (t8 == 2 ? bb2 : (t8 == 1 ? bb1 : bb0));
                    const float w0 = e < 4 ? w0a[e & 3] : w0b[e & 3], w1 = e < 4 ? w1a[e & 3] : w1b[e & 3], w2 = e < 4 ? w2a[e & 3] : w2b[e & 3], w3 = e < 4 ? w3a[e & 3] : w3b[e & 3];
                    xc[ks][e] = (e < 4 ? cba[e & 3] : cbb[e & 3]) + w3 * xf[e] + w2 * x1 + w1 * x2 + w0 * x3;
                }
            } else {
                float pf[8]; unpack8(prevx[ks], pf);
#pragma unroll
                for (int e = 0; e < 8; ++e) {
                    const float x1 = dppf<0x111>(dppf<0x121>(0.f, pf[e]), xf[e]);
                    const float x2 = dppf<0x112>(dppf<0x122>(0.f, pf[e]), xf[e]);
                    const float x3 = dppf<0x113>(dppf<0x123>(0.f, pf[e]), xf[e]);
                    const float w0 = e < 4 ? w0a[e & 3] : w0b[e & 3], w1 = e < 4 ? w1a[e & 3] : w1b[e & 3], w2 = e < 4 ? w2a[e & 3] : w2b[e & 3], w3 = e < 4 ? w3a[e & 3] : w3b[e & 3];
                    xc[ks][e] = (e < 4 ? cba[e & 3] : cbb[e & 3]) + w3 * xf[e] + w2 * x1 + w1 * x2 + w0 * x3;
                }
                prevx[ks] = x4[ks];
            }
            bfrag[ks] = __builtin_bit_cast(bf16x8, pack8(xc[ks]));
        }
        f32x4 aa[8], ax[8];
#pragma unroll
        for (int nb = 0; nb < 8; ++nb) { aa[nb] = (f32x4){0.f, 0.f, 0.f, 0.f}; ax[nb] = (f32x4){0.f, 0.f, 0.f, 0.f}; }
#pragma unroll
        for (int ks = 0; ks < 4; ++ks)
#pragma unroll
            for (int nb = 0; nb < 8; ++nb) {
                const bf16x8 wa = *(const LAS bf16x8*)(lds + L_WA + (16 * nb + fr) * LW_STRIDE + (32 * ks + 8 * fq) * 2);
                const bf16x8 wx = *(const LAS bf16x8*)(lds + L_WX + (16 * nb + fr) * LW_STRIDE + (32 * ks + 8 * fq) * 2);
                aa[nb] = __builtin_amdgcn_mfma_f32_16x16x32_bf16(wa, bfrag[ks], aa[nb], 0, 0, 0);
                ax[nb] = __builtin_amdgcn_mfma_f32_16x16x32_bf16(wx, bfrag[ks], ax[nb], 0, 0, 0);
            }
        float y[4][8]; float ss = 0.f;
#pragma unroll
        for (int ks = 0; ks < 4; ++ks) {
            const f32x4 bga0 = *(const LAS f32x4*)(CT + 5 * 128 + 32 * ks), bga1 = *(const LAS f32x4*)(CT + 5 * 128 + 32 * ks + 4);
            const f32x4 bgx0 = *(const LAS f32x4*)(CT + 6 * 128 + 32 * ks), bgx1 = *(const LAS f32x4*)(CT + 6 * 128 + 32 * ks + 4);
            const f32x4 sp0 = *(const LAS f32x4*)(CT + 7 * 128 + 32 * ks), sp1 = *(const LAS f32x4*)(CT + 7 * 128 + 32 * ks + 4);
            float gav[8];
            if constexpr (PASS == 2) unpack8(g4[ks], gav);
            f32x4 h0a, h0b;
            if constexpr (IS_S) { const float* hp = p.st_h + (size_t)sq * DA + gch + 32 * ks; h0a = *(const f32x4*)hp; h0b = *(const f32x4*)(hp + 4); }
            float hv[8];
#pragma unroll
            for (int e = 0; e < 8; ++e) {
                const int nb = 2 * ks + (e >> 2), rg = e & 3;
                const float rr = sigmoidf_(aa[nb][rg] + (e < 4 ? bga0[rg] : bga1[rg])), ii = sigmoidf_(ax[nb][rg] + (e < 4 ? bgx0[rg] : bgx1[rg]));
                const float la = -8.0f * rr * (e < 4 ? sp0[rg] : sp1[rg]);
                const float a = __expf(la);
                const float om = __builtin_fmaf(-a, a, 1.0f);
                float P = a, S = __builtin_amdgcn_sqrtf(om > 0.f ? om : 0.f) * (ii * xc[ks][e]);
                float h;
                if constexpr (IS_S) { scan8(P, S, t8); h = __builtin_fmaf(P, e < 4 ? h0a[rg] : h0b[rg], S); }
                else {
                    scan16(P, S);
                    h = __builtin_fmaf(P, hin[ks][e], S);
                    hin[ks][e] = bcast15(h, lane);
                    if constexpr (PASS == 1) Pt[ks][e] *= bcast15(P, lane);
                }
                hv[e] = h;
                if constexpr (PASS == 2) { y[ks][e] = gelu_tanh(gav[e]) * h; ss += y[ks][e] * y[ks][e]; }
            }
            if constexpr (PASS == 2) {
                if (IS_S ? (t8 == 7) : (seg == LRU_NSEG - 1 && fr == 15)) {
                    float* ho = p.out + (IS_S ? O_SH + (size_t)sq * DA : O_PH + (size_t)b * DA) + gch + 32 * ks;
                    *(f32x4*)ho = (f32x4){hv[0], hv[1], hv[2], hv[3]}; *(f32x4*)(ho + 4) = (f32x4){hv[4], hv[5], hv[6], hv[7]};
                }
            }
        }
        if constexpr (PASS == 2) {
            ss += __shfl_xor(ss, 16); ss += __shfl_xor(ss, 32);
            const float rn = __builtin_amdgcn_rsqf(ss * (1.0f / 128.0f) + EPS);
#pragma unroll
            for (int ks = 0; ks < 4; ++ks) {
                const f32x4 g0 = *(const LAS f32x4*)(CT + 8 * 128 + 32 * ks), g1 = *(const LAS f32x4*)(CT + 8 * 128 + 32 * ks + 4);
                float o[8];
#pragma unroll
                for (int e = 0; e < 8; ++e) o[e] = y[ks][e] * rn * (e < 4 ? g0[e & 3] : g1[e & 3]);
                *(u32x4*)(ym + (size_t)r * DMIX + gch + 32 * ks) = pack8(o);
            }
        }
    }
    if constexpr (PASS == 1 && !IS_S) {
        if (fr == 0) {
            float* tp = tot + ((size_t)(b * LRU_NSEG + seg) * 2) * DA + gch;
#pragma unroll
            for (int ks = 0; ks < 4; ++ks) {
                *(f32x4*)(tp + 32 * ks) = (f32x4){Pt[ks][0], Pt[ks][1], Pt[ks][2], Pt[ks][3]}; *(f32x4*)(tp + 32 * ks + 4) = (f32x4){Pt[ks][4], Pt[ks][5], Pt[ks][6], Pt[ks][7]};
                *(f32x4*)(tp + DA + 32 * ks) = (f32x4){hin[ks][0], hin[ks][1], hin[ks][2], hin[ks][3]}; *(f32x4*)(tp + DA + 32 * ks + 4) = (f32x4){hin[ks][4], hin[ks][5], hin[ks][6], hin[ks][7]};
            }
        }
    }
}
template <int PASS>
__device__ __forceinline__ void mixer_phase(PRef p, LAS unsigned char* lds, int G) {
    const int tid = opaque_tid(), wave = __builtin_amdgcn_readfirstlane(tid >> 6);
    for (int v = blockIdx.x; v < NH * LRU_WG_PER_HEAD; v += G) {
        const int n = v / LRU_WG_PER_HEAD;
        __syncthreads();
        {
            const bf16_t* wg = (const bf16_t*)(p.ws + WS_WG);
            for (int i = tid; i < 2 * 128 * 16; i += 512) { const int g = i >> 11, row = (i >> 4) & 127, c16 = i & 15;
                *(LAS u32x4*)(lds + g * L_WX + row * LW_STRIDE + c16 * 16) = *(const u32x4*)(wg + (((size_t)g * NH + n) * 128 + row) * 128 + c16 * 8); }
            LAS float* CTw = (LAS float*)(lds + L_CT);
            for (int i = tid; i < 9 * 128; i += 512) { const int k = i >> 7, c = i & 127, ch = n * 128 + c;
                float vv;
                if (k < 4) vv = p.conv_a_w[k * DA + ch]; else if (k == 4) vv = p.conv_a_b[ch]; else if (k == 5) vv = p.b_gate_a[ch]; else if (k == 6) vv = p.b_gate_x[ch];
                else if (k == 7) vv = log1pf(__expf(-p.lam[ch])); else vv = p.g_out_a[ch];
                CTw[i] = vv; }
        }
        __syncthreads();
        const int wi = (v % LRU_WG_PER_HEAD) * 8 + wave;
        if (wi < LRU_PITEMS) lru_wave_item<PASS, false>(p, lds, n, wi / LRU_NSEG, wi % LRU_NSEG);
        else if (PASS == 2 && wi < LRU_PITEMS + LRU_SITEMS) lru_wave_item<PASS, true>(p, lds, n, wi - LRU_PITEMS, 0);
    }
    if (G == 256 && (int)blockIdx.x >= MIX_IDLE_WG0) convert_items(p, lds, ((int)blockIdx.x - MIX_IDLE_WG0) * 8 + wave, (G - MIX_IDLE_WG0) * 8, PASS == 1 ? IT_S1 : IT_S2, PASS == 1 ? IT_S2 : IT_S3);
    if (PASS == 1) { branch_b(p, G); if ((REP_MASK >> 11) & 1) branch_b(p, G); }
}

__device__ __forceinline__ void final_phase(PRef p, int G, float* probe_dst = nullptr) {
    const int tid_ = opaque_tid(), lane = tid_ & 63, gw = blockIdx.x * 8 + (tid_ >> 6), NGW = G * 8;
    f32x4 gf[8];
#pragma unroll
    for (int j = 0; j < 8; ++j) gf[j] = ((const f32x4*)p.g_final)[lane + 64 * j];
    for (int r = gw; r < NB * SEQ + MSR; r += NGW) {
        f32x4* yr = (f32x4*)(p.out + (size_t)r * D) + lane;
        f32x4 v[8]; float s = 0.f;
#pragma unroll
        for (int j = 0; j < 8; ++j) { v[j] = yr[64 * j]; s += (v[j][0] * v[j][0] + v[j][1] * v[j][1]) + (v[j][2] * v[j][2] + v[j][3] * v[j][3]); }
        s = wave_sum(s);
        const float rs = __builtin_amdgcn_rsqf(s * (1.0f / D) + EPS);
        f32x4* yo = probe_dst ? (f32x4*)(probe_dst + (size_t)r * D) + lane : yr;
#pragma unroll
        for (int j = 0; j < 8; ++j) yo[64 * j] = v[j] * rs * gf[j];
    }
}


#define XB_TMO      128
#define XB_XCNT(j)  (256  + 64 * (j))
#define XB_XSUB(j)  (1280 + 64 * (j))
#define XB_XGEN(j)  (2304 + 64 * (j))
#define XB_TOP      3328
#define XB_TOPGEN   3392
#define XCD_BAR_WORDS 3456
#define XB_SPIN_CAP (1u << 18)
__device__ __forceinline__ unsigned xb_ld(unsigned* p)              { return __hip_atomic_load(p, __ATOMIC_RELAXED, __HIP_MEMORY_SCOPE_AGENT); }
__device__ __forceinline__ unsigned xb_add(unsigned* p, unsigned v) { return __hip_atomic_fetch_add(p, v, __ATOMIC_RELAXED, __HIP_MEMORY_SCOPE_AGENT); }
__device__ __forceinline__ unsigned xb_xcc_id() { return (unsigned)__builtin_amdgcn_s_getreg((3 << 11) | 20) & 0xFu; }
#define XB_SPIN(cond, bar) do { unsigned _sp = 0; while (cond) { __builtin_amdgcn_s_sleep(1); \
    if ((++_sp & 255u) == 0u) { if (xb_ld(&(bar)[XB_TMO])) break; if (_sp > XB_SPIN_CAP) { atomicAdd(&(bar)[XB_TMO], 1u); break; } } } } while (0)
struct XcdBarrier { unsigned* bar; unsigned x; volatile LAS unsigned* st; };
__device__ __forceinline__ XcdBarrier xcd_barrier_post(unsigned* bar, volatile LAS unsigned* st) {
    XcdBarrier b; b.bar = bar; b.x = xb_xcc_id(); b.st = st;
    if (threadIdx.x == 0) (void)xb_add(&bar[XB_XCNT(b.x)], 1u);
    return b;
}
__device__ __forceinline__ void xcd_barrier_complete(unsigned* bar, unsigned x, unsigned& nloc, unsigned& nx) {
    const unsigned G = gridDim.x * gridDim.y * gridDim.z;
    unsigned sum, cnt, mine, sp = 0u;
    for (;;) {
        sum = 0u; cnt = 0u; mine = 0u;
#pragma unroll
        for (unsigned j = 0; j < 16; ++j) { const unsigned c = xb_ld(&bar[XB_XCNT(j)]); sum += c; cnt += (c > 0u) ? 1u : 0u; mine = (j == x) ? c : mine; }
        if (sum == G) break;
        __builtin_amdgcn_s_sleep(1);
        if ((++sp & 255u) == 0u) { if (xb_ld(&bar[XB_TMO])) break; if (sp > XB_SPIN_CAP) { atomicAdd(&bar[XB_TMO], 1u); break; } }
    }
    nloc = mine > 0u ? mine : 1u; nx = cnt > 0u ? cnt : 1u;
}
__device__ __forceinline__ void xcd_barrier(const XcdBarrier& b) {
    asm volatile("s_waitcnt vmcnt(0)" ::: "memory");
    __syncthreads();
    if (threadIdx.x == 0) {
        unsigned* bar = b.bar;
        __builtin_amdgcn_s_waitcnt(0);
        unsigned nloc = b.st[0], nx = b.st[1];
        if (nloc == 0u) { xcd_barrier_complete(bar, b.x, nloc, nx); b.st[0] = nloc; b.st[1] = nx; }
        const unsigned old = xb_add(&bar[XB_XSUB(b.x)], 1u);
        const unsigned gen = old / nloc;
        if (old + 1u == (gen + 1u) * nloc) {
            __builtin_amdgcn_fence(__ATOMIC_RELEASE, "agent");
            asm volatile("s_waitcnt vmcnt(0)" ::: "memory");
            const unsigned og = xb_add(&bar[XB_TOP], 1u);
            const unsigned tg = og / nx;
            if (og + 1u == (tg + 1u) * nx) xb_add(&bar[XB_TOPGEN], 1u);
            else XB_SPIN(xb_ld(&bar[XB_TOPGEN]) == tg, bar);
            __builtin_amdgcn_fence(__ATOMIC_ACQUIRE, "agent");
            xb_add(&bar[XB_XGEN(b.x)], 1u);
            asm volatile("s_waitcnt vmcnt(0)" ::: "memory");
        } else {
            XB_SPIN(xb_ld(&bar[XB_XGEN(b.x)]) == gen, bar);
            __builtin_amdgcn_fence(__ATOMIC_ACQUIRE, "agent");
            asm volatile("s_waitcnt vmcnt(0)" ::: "memory");
        }
    }
    __syncthreads();
}

constexpr int LDS_BYTES = 131072 + 1024 + 8 * 1024;
constexpr int N_PHASES = 8;
__global__ void __launch_bounds__(512, 2) hymba_fwd(Params p) {
    extern __shared__ __attribute__((aligned(16))) unsigned char lds_raw[];
    LAS unsigned char* lds = (LAS unsigned char*)lds_raw;
    constexpr int G = GRID;
    if ((int)gridDim.x != GRID) return;
    const CAS Params* kp = (const CAS Params*)__builtin_amdgcn_kernarg_segment_ptr();
#define P_HERE (*({ const CAS Params* q_ = kp; asm volatile("" : "+s"(q_)); q_; }))
    unsigned char* ws = p.ws;
    volatile LAS unsigned* misc = (volatile LAS unsigned*)(lds + 131072);
    if (threadIdx.x < 8) misc[threadIdx.x] = 0u;
    __syncthreads();
    XcdBarrier bar = xcd_barrier_post((unsigned*)ws, misc);
    const int lo = p.ph_lo, hi = p.ph_hi;
#ifndef PH_MASK
#define PH_MASK 0xff
#endif
#define IN(k) (((PH_MASK >> (k)) & 1) && lo <= (k) && (k) < hi)
#define SEAM(k) do { if (IN(k) && IN((k) + 1)) xcd_barrier(bar); } while (0)
#define REPEAT(k) for (int rep_ = 0; rep_ < ((((REP_MASK) >> (k)) & 1) ? 2 : 1); ++rep_, (rep_ < ((((REP_MASK) >> (k)) & 1) ? 2 : 1) ? xcd_barrier(bar) : (void)0))
    if (IN(0)) REPEAT(0) phase0(P_HERE, lds, G);
    SEAM(0);
    if (IN(1)) REPEAT(1) {
        pg8::Gemm g{(const bf16_t*)(ws + WS_XB) + (size_t)16 * D, (const bf16_t*)(ws + WS_WIN), MP / 256, DIN / 256, D, (size_t)256 * D * 2, (size_t)128 * D * 2};
        pg8::StaticOrder S; S.init(g.nM, g.nN, G, (int)blockIdx.x, D / 64, 1);
        PRef q = P_HERE; EpiZ E{(const float*)(ws + WS_RS1), (bf16_t*)(ws + WS_Z), q.out};
        pg8::gemm_phase<EpiZ, false, true, true>(lds, g, S, E, nullptr, nullptr);
        if ((int)blockIdx.x >= P1_TAIL_WG0 && G == 256) convert_items(P_HERE, lds, ((int)blockIdx.x - P1_TAIL_WG0) * 8 + (opaque_tid() >> 6), (G - P1_TAIL_WG0) * 8, IT_O, IT_S1);
        else if (G != 256) convert_items(P_HERE, lds, (int)blockIdx.x * 8 + (opaque_tid() >> 6), G * 8, IT_O, IT_S3);
    }
    SEAM(1);
    if (IN(2)) REPEAT(2) mixer_phase<1>(P_HERE, lds, G);
    SEAM(2);
    if (IN(3)) REPEAT(3) mixer_phase<2>(P_HERE, lds, G);
    SEAM(3);
    if (IN(4)) REPEAT(4) {
        pg8::Gemm g{(const bf16_t*)(ws + WS_YM), (const bf16_t*)(ws + WS_WO), MP / 256, D / 256, DMIX, (size_t)256 * DMIX * 2, (size_t)128 * DMIX * 2};
        pg8::StaticOrder S; S.init(g.nM, g.nN, G, (int)blockIdx.x, DMIX / 64, P4_SPLIT);
        PRef q = P_HERE; EpiX1 E{q.x_prompt, q.x_sample, q.meta, q.out, (bf16_t*)(ws + WS_XB) + (size_t)16 * D, (float*)(ws + WS_SSQ)};
        pg8::gemm_phase<EpiX1, false, true, true>(lds, g, S, E, (float*)(ws + WS_Z), (unsigned*)ws + CW_TK4);
        if ((int)blockIdx.x >= P4_TAIL_WG0 && G == 256) convert_items(P_HERE, lds, ((int)blockIdx.x - P4_TAIL_WG0) * 8 + (opaque_tid() >> 6), (G - P4_TAIL_WG0) * 8, IT_S3, IT_G);
        else if (G != 256) convert_items(P_HERE, lds, (int)blockIdx.x * 8 + (opaque_tid() >> 6), G * 8, IT_S3, IT_G);
    }
    SEAM(4);
    if (IN(5)) REPEAT(5) {
        pg8::Gemm g{(const bf16_t*)(ws + WS_XB) + (size_t)14 * D, (const bf16_t*)(ws + WS_WUP), 37, 2 * DFF / 256, D, (size_t)252 * D * 2, (size_t)64 * D * 2};
        pg8::StaticOrder S; S.init(g.nM, g.nN, G, (int)blockIdx.x, D / 64, 1);
        LAS float* rstab = (LAS float*)(lds + 131072 + 1024);
        ffn_rstd_table((const float*)(ws + WS_SSQ), rstab, S); __syncthreads();
        PRef q = P_HERE; EpiFFN E{q.conv_f_w, q.conv_f_b, q.st_fc, (bf16_t*)(ws + WS_Z), q.out, rstab};
        if ((REP_MASK >> 10) & 1) { EpiProbe Ep{(bf16_t*)(ws + WS_Z)}; pg8::gemm_phase<EpiProbe, true, true, true>(lds, g, S, Ep, nullptr, nullptr); xcd_barrier(bar); }
        pg8::gemm_phase<EpiFFN, true, true, true>(lds, g, S, E, nullptr, nullptr);
    }
    SEAM(5);
    if (IN(6)) {
        pg8::Gemm g{(const bf16_t*)(ws + WS_Z), (const bf16_t*)(ws + WS_WDN), MP / 256, D / 256, DFF, (size_t)256 * DFF * 2, (size_t)128 * DFF * 2};
        pg8::StaticOrder S; S.init(g.nM, g.nN, G, (int)blockIdx.x, DFF / 64, P6_SPLIT);
        PRef q = P_HERE; EpiOut E{q.out};
        if ((REP_MASK >> 6) & 1) { pg8::gemm_phase<EpiOut, false, true, true>(lds, g, S, E, (float*)(ws + WS_WIN), (unsigned*)ws + CW_TK6, true); xcd_barrier(bar); }
        if ((REP_MASK >> 9) & 1) { pg8::StaticOrder S3; S3.init(g.nM, g.nN, G, (int)blockIdx.x, DFF / 64, P6_SPLIT); S3.first = 1; EpiOut E3{(float*)(ws + WS_END)};
            pg8::gemm_phase<EpiOut, false, true, true>(lds, g, S3, E3, (float*)(ws + WS_WIN), (unsigned*)ws + CW_TK6 + 64 * 64); xcd_barrier(bar); }
        if ((REP_MASK >> 8) & 1) { pg8::StaticOrder S2; S2.init(g.nM, g.nN, G, (int)blockIdx.x, DFF / 64, 1); S2.limit = 1; EpiOut E2{(float*)(ws + WS_END)};
            pg8::gemm_phase<EpiOut, false, true, true>(lds, g, S2, E2, nullptr, nullptr); xcd_barrier(bar); }
        pg8::gemm_phase<EpiOut, false, true, true>(lds, g, S, E, (float*)(ws + WS_WIN), (unsigned*)ws + CW_TK6);
    }
    SEAM(6);
    if (IN(7)) { if ((REP_MASK >> 7) & 1) { final_phase(P_HERE, G, (float*)(ws + WS_Z)); xcd_barrier(bar); }
        final_phase(P_HERE, G); }
#undef IN
#undef SEAM
}

extern "C" void kernel_launch(void* const* d_in, const int* in_sizes, int n_in, void* d_out, int out_size, void* d_ws, size_t ws_size, hipStream_t stream) {
    static int grid = 0;
    if (grid == 0) {
        if (n_in != 26 || (size_t)out_size != O_END || ws_size < WS_END) { fprintf(stderr, "kernel_launch: unexpected problem (n_in %d, out %d, ws %zu; need ws >= %zu)\n", n_in, out_size, ws_size, (size_t)WS_END); grid = -1; return; }
        int dev = 0, cus = 0, per_cu = 0;
        hipGetDevice(&dev); hipDeviceGetAttribute(&cus, hipDeviceAttributeMultiprocessorCount, dev);
        if (hipFuncSetAttribute((const void*)hymba_fwd, hipFuncAttributeMaxDynamicSharedMemorySize, LDS_BYTES) != hipSuccess) { fprintf(stderr, "kernel_launch: hipFuncSetAttribute failed\n"); grid = -1; return; }
        if (hipOccupancyMaxActiveBlocksPerMultiprocessor(&per_cu, (const void*)hymba_fwd, 512, LDS_BYTES) != hipSuccess || per_cu < 1) { fprintf(stderr, "kernel_launch: occupancy query says %d\n", per_cu); grid = -1; return; }
        if (cus < GRID) { fprintf(stderr, "kernel_launch: built for a %d-CU device, found %d CUs\n", GRID, cus); grid = -1; return; }
        grid = GRID;
    }
    if (grid < 0) return;
    Params p{};
    const float** f = (const float**)&p;
    for (int i = 0; i < 26; ++i) f[i] = (const float*)d_in[i];
    p.out = (float*)d_out; p.ws = (unsigned char*)d_ws;
    if (hipMemsetAsync(d_ws, 0, CTL_WORDS * 4, stream) != hipSuccess) { fprintf(stderr, "kernel_launch: memset failed\n"); return; }
    if (MK_N_LAUNCHES == 1) {
        p.ph_lo = 0; p.ph_hi = N_PHASES;
        hipLaunchKernelGGL(hymba_fwd, dim3(grid), dim3(512), LDS_BYTES, stream, p);
    } else {
        for (int k = 0; k < N_PHASES; ++k) { p.ph_lo = k; p.ph_hi = k + 1; hipLaunchKernelGGL(hymba_fwd, dim3(grid), dim3(512), LDS_BYTES, stream, p); }
    }
}
```

```cpp
#include <hip/hip_runtime.h>
#include <cstdio>

#ifndef REP_MASK
#define REP_MASK 0x00
#endif
#ifndef MK_N_LAUNCHES
#define MK_N_LAUNCHES 1
#endif

#define LAS __attribute__((address_space(3)))
#define CAS __attribute__((address_space(4)))
typedef unsigned short bf16_t;
typedef short bf16x8 __attribute__((ext_vector_type(8)));
typedef float f32x4 __attribute__((ext_vector_type(4)));
typedef unsigned u32x4 __attribute__((ext_vector_type(4)));
typedef unsigned u32x2 __attribute__((ext_vector_type(2)));

constexpr int D = 2048, NMETA = 16, SEQ = 2048, TP = SEQ + NMETA, NB = 4, MPR = NB * TP;
constexpr int NS = 128, TS = 8, MSR = NS * TS, M = MPR + MSR;
constexpr int MP = 9472;
constexpr int DA = 1536, DB = 1024, DIN = 6144, DMIX = 2560, DFF = 6144, NH = 12;
constexpr float EPS = 1e-6f;
constexpr int NCH = 33;
constexpr size_t O_YP = 0, O_YS = O_YP + (size_t)NB * SEQ * D, O_PH = O_YS + (size_t)MSR * D, O_PRC = O_PH + NB * DA,
                 O_PSC = O_PRC + NB * 3 * DA, O_PFC = O_PSC + NB * 2 * DB, O_SH = O_PFC + NB * 2 * DFF, O_SRC = O_SH + NS * DA,
                 O_SSC = O_SRC + (size_t)NS * 3 * DA, O_SFC = O_SSC + (size_t)NS * 2 * DB, O_END = O_SFC + (size_t)NS * 2 * DFF;
constexpr size_t MiB = 1u << 20;
constexpr int CW_TK6 = 4096, CTL_WORDS = 4096 + 128 * 64;
constexpr int P6_SPLIT = 4, P4_SPLIT = 4, CW_TK4 = CW_TK6 + 64 * 64;
constexpr int GRID = 256;
constexpr size_t WS_WIN = 1 * MiB;
constexpr size_t WS_WO = WS_WIN + (size_t)DIN * D * 2;
constexpr size_t WS_WUP = WS_WO + (size_t)D * DMIX * 2;
constexpr size_t WS_WDN = WS_WUP + (size_t)2 * DFF * D * 2;
constexpr size_t WS_WG = WS_WDN + (size_t)D * DFF * 2;
constexpr size_t WS_XB = WS_WG + (size_t)2 * NH * 128 * 128 * 2;
constexpr size_t XB_ROWS = 9600;
constexpr size_t WS_Z = WS_XB + XB_ROWS * D * 2;
constexpr size_t WS_YM = WS_Z + (size_t)MP * DIN * 2;
constexpr size_t WS_RS1 = WS_YM + (size_t)MP * DMIX * 2;
constexpr size_t WS_SSQ = WS_RS1 + (size_t)MP * 4;
constexpr size_t WS_TOT = WS_SSQ + (size_t)MP * 32 * 4;
constexpr size_t WS_END = WS_TOT + (size_t)NB * NCH * DA * 2 * 4;

struct Params;
typedef const CAS Params& PRef;
struct Params {
    const float *x_prompt, *x_sample, *st_h, *st_rc, *st_sc, *st_fc, *meta, *g_mix, *w_in, *conv_a_w, *conv_a_b, *w_gate_a, *b_gate_a,
        *w_gate_x, *b_gate_x, *lam, *conv_b_w, *g_out_a, *g_out_b, *w_o, *g_ffn, *w_up, *conv_f_w, *conv_f_b, *w_down, *g_final;
    float* out; unsigned char* ws; int ph_lo, ph_hi;
};

__device__ __forceinline__ unsigned cvt_pk_bf16(float lo, float hi) { unsigned r; asm volatile("v_cvt_pk_bf16_f32 %0, %1, %2" : "=v"(r) : "v"(lo), "v"(hi)); return r; }
__device__ __forceinline__ float bf_lo(unsigned w) { return __builtin_bit_cast(float, w << 16); }
__device__ __forceinline__ float bf_hi(unsigned w) { return __builtin_bit_cast(float, w & 0xffff0000u); }
__device__ __forceinline__ void unpack8(const u32x4 w, float (&f)[8]) { f[0] = bf_lo(w.x); f[1] = bf_hi(w.x); f[2] = bf_lo(w.y); f[3] = bf_hi(w.y); f[4] = bf_lo(w.z); f[5] = bf_hi(w.z); f[6] = bf_lo(w.w); f[7] = bf_hi(w.w); }
__device__ __forceinline__ u32x4 pack8(const float (&f)[8]) { u32x4 w; w.x = cvt_pk_bf16(f[0], f[1]); w.y = cvt_pk_bf16(f[2], f[3]); w.z = cvt_pk_bf16(f[4], f[5]); w.w = cvt_pk_bf16(f[6], f[7]); return w; }
__device__ __forceinline__ float wave_sum(float v) {
#pragma unroll
    for (int o = 1; o < 64; o <<= 1) v += __shfl_xor(v, o);
    return v;
}
__device__ __forceinline__ float sum16(float v) {
    v += __shfl_xor(v, 1); v += __shfl_xor(v, 2); v += __shfl_xor(v, 4); v += __shfl_xor(v, 8); return v;
}
__device__ __forceinline__ float sigmoidf_(float x) { return __builtin_amdgcn_rcpf(1.0f + __expf(-x)); }
__device__ __forceinline__ float gelu_tanh(float x) {
    const float t = x * (1.0f + 0.044715f * x * x) * (-2.0f * 0.7978845608028654f * 1.4426950408889634f);
    return x * __builtin_amdgcn_rcpf(1.0f + __builtin_amdgcn_exp2f(t));
}
__device__ __forceinline__ int opaque_tid() { int t = threadIdx.x; asm volatile("" : "+v"(t)); return t; }
template <int CTRL> __device__ __forceinline__ float dppf(float old, float src) {
    return __builtin_bit_cast(float, __builtin_amdgcn_update_dpp(__builtin_bit_cast(int, old), __builtin_bit_cast(int, src), CTRL, 0xF, 0xF, false));
}
__device__ __forceinline__ void row_decode(int r, int& is_s, int& seq, int& t) {
    if (r < MPR) { seq = (r >= TP) + (r >= 2 * TP) + (r >= 3 * TP); t = r - seq * TP; is_s = 0; }
    else { const int q = r - MPR; seq = q >> 3; t = q & 7; is_s = 1; }
}
__device__ __forceinline__ const float* x_row_ptr(const float* xp, const float* xs, const float* meta, int r) {
    int is_s, seq, t; row_decode(r, is_s, seq, t);
    if (is_s) return xs + (size_t)(r - MPR) * D;
    return t < NMETA ? meta + (size_t)t * D : xp + ((size_t)seq * SEQ + (t - NMETA)) * D;
}
__device__ __forceinline__ float* y_row_ptr(float* out, int r) {
    if (r >= M) return nullptr;
    int is_s, seq, t; row_decode(r, is_s, seq, t);
    if (is_s) return out + O_YS + (size_t)(r - MPR) * D;
    return t < NMETA ? nullptr : out + O_YP + ((size_t)seq * SEQ + (t - NMETA)) * D;
}

namespace pg8 {
constexpr int BM = 256, BK = 64, HALF = 128, HTB = HALF * BK * 2, STAGE_BYTES = 8 * HTB, NXCD = 8, WGM = 2;
__host__ __device__ __forceinline__ int lds_byte(int r, int c) { const int st = (r >> 4) * 2 + (c >> 5), rr = r & 15, cc = c & 31, ob = rr * 64 + cc * 2; return st * 1024 + (ob ^ (((ob >> 9) & 1) << 5)); }
__host__ __device__ __forceinline__ void stage_rc(int b, int& R, int& C) { const int st = b / 1024, sb = b % 1024, swz = sb ^ (((sb >> 9) & 1) << 5); R = (st >> 1) * 16 + swz / 64; C = (st & 1) * 32 + (swz % 64) / 2; }
struct Unit { int pm, pn, kb, nk, piece, lu, idx; };
struct Gemm { const bf16_t* A; const bf16_t* Bt; int nM, nN, K; size_t a_tstep, a_hstep; };
struct StaticOrder {
    int nM, nN, nwg, G, c, nt, split, nfull, nleft, limit = 1 << 20, first = 0;
    __device__ __forceinline__ void init(int nM_, int nN_, int G_, int c_, int nt_, int split_) { nM = nM_; nN = nN_; nwg = nM * nN; G = G_; c = c_; nt = nt_; nfull = (nwg / G) * G; nleft = nwg - nfull;
        split = (split_ > 1 && nleft > 0 && nleft * split_ <= G && (nt / split_) * split_ == nt && ((nt / split_) & 1) == 0) ? split_ : 1; }
    __device__ __forceinline__ void map(int L, Unit& u) const {
        int wgid = L; { const int q = nwg / NXCD, r = nwg % NXCD, xcd = wgid % NXCD, off = wgid / NXCD; wgid = (xcd < r ? xcd * (q + 1) : r * (q + 1) + (xcd - r) * q) + off; }
        const int nig = WGM * nN, gid = wgid / nig, rem = wgid - gid * nig, fm = gid * WGM, glast = nM % WGM;
        if (nM - fm >= WGM || glast == 0) { u.pm = fm + (rem & (WGM - 1)); u.pn = rem / WGM; }
        else { u.pm = fm + rem % glast; u.pn = rem / glast; }
    }
    __device__ __forceinline__ bool next(int i, Unit& u) const {
        u.kb = 0; u.nk = nt; u.piece = -1; u.lu = 0; u.idx = i;
        i += first; if (i >= limit) return false;
        const long L = (long)i * G + c;
        if (L < nfull || split == 1) { if (L >= nwg) return false; map((int)L, u); return true; }
        if (L >= nfull + G || c >= nleft * split) return false;
        u.lu = c % nleft; u.piece = c / nleft; u.nk = nt / split; u.kb = u.piece * u.nk; map(nfull + u.lu, u); return true;
    }
};

template <int P, int A, int Mi>
__device__ __forceinline__ void reduce_rowgroup(f32x4 (&acc)[2][2][4][2], const float* slab0, int tid) {
    const float* sp = slab0 + (size_t)((A * 4 + Mi) * 4) * 8192 + tid * 4;
#pragma unroll
    for (int b = 0; b < 2; ++b)
#pragma unroll
        for (int n = 0; n < 2; ++n) {
            f32x4 sum = (f32x4){0.f, 0.f, 0.f, 0.f};
#pragma unroll
            for (int src = 0; src < 4; ++src) { if (src == P) sum += acc[A][b][Mi][n]; else sum += *(const f32x4*)(sp + (size_t)src * 8192 + (b * 2 + n) * 2048); }
            acc[A][b][Mi][n] = sum;
        }
}
template <class Epi, bool FFNMAP, bool ALIGN_EPI, bool SP2>
__device__ __forceinline__ void gemm_phase(LAS unsigned char* lds, const Gemm g, const StaticOrder& S, const Epi& E, float* slabs, unsigned* tickets, bool dry = false) {
    int tid = threadIdx.x; asm volatile("" : "+v"(tid));
    const int wid = __builtin_amdgcn_readfirstlane(tid >> 6), lane = tid & 63, wr = wid >> 2, wc = wid & 3, fr = lane & 15, fq = lane >> 4;
    const int K = g.K;
    unsigned voffA[2], voffB[2];
#pragma unroll
    for (int i = 0; i < 2; ++i) { int R, C; stage_rc(tid * 16 + i * 8192, R, C); const int Ra = FFNMAP ? (126 * (R >> 6) + (R & 63)) : R;
        voffA[i] = (unsigned)(Ra * K + C) * 2u; voffB[i] = (unsigned)(R * K + C) * 2u; }
    const size_t kstep = (size_t)(BK * 2);
    const size_t hstepA = g.a_hstep, tstepA = g.a_tstep;
    const size_t hstepB = (size_t)HALF * K * 2, tstepB = 2 * hstepB;
    const unsigned ldsw = (unsigned)wid * 1024u;
    const int aoff = lds_byte(wr * 64 + fr, fq * 8), boff = lds_byte(wc * 32 + fr, fq * 8);
#define PG8_SA(b, h) (((b) * 2 + (h)) * HTB)
#define PG8_SB(b, h) ((4 + (b) * 2 + (h)) * HTB)
#define PG8_STAGE(bufoff, gbase, voff) do { _Pragma("unroll") for (int _i = 0; _i < 2; ++_i) \
        __builtin_amdgcn_global_load_lds((const unsigned*)((const char*)(gbase) + (voff)[_i]), (LAS unsigned*)(lds + (bufoff) + ldsw + _i * 8192), 16, 0, 0); } while (0)
#define PG8_LDA(dst, b, h) do { _Pragma("unroll") for (int m = 0; m < 4; ++m) _Pragma("unroll") for (int k = 0; k < 2; ++k) dst[m][k] = *(const LAS bf16x8*)(lds + PG8_SA(b, h) + aoff + m * 2048 + k * 1024); } while (0)
#define PG8_LDB(dst, b, h) do { _Pragma("unroll") for (int n = 0; n < 2; ++n) _Pragma("unroll") for (int k = 0; k < 2; ++k) dst[n][k] = *(const LAS bf16x8*)(lds + PG8_SB(b, h) + boff + n * 2048 + k * 1024); } while (0)
#define PG8_MMA(ai, bj, At, Bt) do { __builtin_amdgcn_s_setprio(1); _Pragma("unroll") for (int m = 0; m < 4; ++m) _Pragma("unroll") for (int n = 0; n < 2; ++n) _Pragma("unroll") for (int k = 0; k < 2; ++k) \
        acc[ai][bj][m][n] = __builtin_amdgcn_mfma_f32_16x16x32_bf16(Bt[n][k], At[m][k], acc[ai][bj][m][n], 0, 0, 0); __builtin_amdgcn_s_setprio(0); } while (0)
#define PG8_WAIT_V(n) asm volatile("s_waitcnt vmcnt(" #n ")" ::: "memory")
#define PG8_WAIT_L(n) asm volatile("s_waitcnt lgkmcnt(" #n ")" ::: "memory")
#define PG8_BAR __builtin_amdgcn_s_barrier()
#define PG8_SCHED __builtin_amdgcn_sched_barrier(0)
    Unit cur, nxt; int ui = 0;
    if (!S.next(0, cur)) return;
    f32x4 acc[2][2][4][2];
#pragma unroll
    for (int a = 0; a < 2; ++a)
#pragma unroll
        for (int b = 0; b < 2; ++b)
#pragma unroll
            for (int m = 0; m < 4; ++m)
#pragma unroll
                for (int n = 0; n < 2; ++n) acc[a][b][m][n] = (f32x4){0.f, 0.f, 0.f, 0.f};
    bf16x8 At[4][2], B0[2][2], B1[2][2];
    const char* cA = (const char*)g.A + (size_t)cur.pm * tstepA + (size_t)cur.kb * kstep; const char* cB = (const char*)g.Bt + (size_t)cur.pn * tstepB + (size_t)cur.kb * kstep;
    if constexpr (SP2) {
        PG8_STAGE(PG8_SB(0, 0), cB, voffB); PG8_STAGE(PG8_SB(0, 1), cB + hstepB, voffB); PG8_STAGE(PG8_SA(0, 0), cA, voffA); PG8_STAGE(PG8_SA(0, 1), cA + hstepA, voffA);
        if (wr == 1) PG8_BAR;
        PG8_WAIT_V(2); PG8_BAR;
        PG8_STAGE(PG8_SB(1, 0), cB + kstep, voffB); PG8_STAGE(PG8_SA(1, 0), cA + kstep, voffA); PG8_STAGE(PG8_SB(1, 1), cB + hstepB + kstep, voffB);
        PG8_WAIT_V(6); PG8_BAR;
    } else {
        PG8_STAGE(PG8_SB(0, 0), cB, voffB); PG8_STAGE(PG8_SA(0, 0), cA, voffA); PG8_STAGE(PG8_SB(0, 1), cB + hstepB, voffB); PG8_STAGE(PG8_SA(0, 1), cA + hstepA, voffA);
        if (wr == 1) PG8_BAR;
        PG8_WAIT_V(4); PG8_BAR;
        PG8_STAGE(PG8_SB(1, 0), cB + kstep, voffB); PG8_STAGE(PG8_SA(1, 0), cA + kstep, voffA); PG8_STAGE(PG8_SB(1, 1), cB + hstepB + kstep, voffB);
        PG8_WAIT_V(6); PG8_BAR;
    }
    for (;;) {
        const bool has_next = S.next(ui + 1, nxt);
        const char* nA = has_next ? (const char*)g.A + (size_t)nxt.pm * tstepA + (size_t)nxt.kb * kstep : cA; const char* nB = has_next ? (const char*)g.Bt + (size_t)nxt.pn * tstepB + (size_t)nxt.kb * kstep : cB;
        const int nt = cur.nk;
        for (int t = 0; t < nt; t += 2) {
            const bool last = (t == nt - 2);
            const char* a1 = cA + (size_t)(t + 1) * kstep;
            const char* a2 = last ? nA : cA + (size_t)(t + 2) * kstep; const char* b2 = last ? nB : cB + (size_t)(t + 2) * kstep;
            const char* a3 = a2 + kstep; const char* b3 = b2 + kstep;
            if constexpr (SP2) {
            PG8_LDB(B0, 0, 0); PG8_LDB(B1, 0, 1); PG8_SCHED; PG8_LDA(At, 0, 0); PG8_STAGE(PG8_SA(1, 1), a1 + hstepA, voffA);
            PG8_WAIT_V(8); PG8_WAIT_L(0); PG8_BAR; PG8_MMA(0, 0, At, B0); PG8_MMA(0, 1, At, B1); PG8_BAR; PG8_SCHED;
            PG8_LDA(At, 0, 1); PG8_STAGE(PG8_SB(0, 0), b2, voffB); PG8_STAGE(PG8_SB(0, 1), b2 + hstepB, voffB); PG8_STAGE(PG8_SA(0, 0), a2, voffA);
            PG8_WAIT_V(8); PG8_WAIT_L(0); PG8_BAR; PG8_MMA(1, 0, At, B0); PG8_MMA(1, 1, At, B1); PG8_BAR; PG8_SCHED;
            PG8_LDB(B0, 1, 0); PG8_LDB(B1, 1, 1); PG8_SCHED; PG8_LDA(At, 1, 0); PG8_STAGE(PG8_SA(0, 1), a2 + hstepA, voffA);
            PG8_WAIT_V(8); PG8_WAIT_L(0); PG8_BAR; PG8_MMA(0, 0, At, B0); PG8_MMA(0, 1, At, B1); PG8_BAR; PG8_SCHED;
            PG8_LDA(At, 1, 1); PG8_STAGE(PG8_SB(1, 0), b3, voffB); PG8_STAGE(PG8_SB(1, 1), b3 + hstepB, voffB); PG8_STAGE(PG8_SA(1, 0), a3, voffA);
            PG8_WAIT_V(8); PG8_WAIT_L(0); PG8_BAR; PG8_MMA(1, 0, At, B0); PG8_MMA(1, 1, At, B1); PG8_BAR; PG8_SCHED;
            } else {
            PG8_LDB(B0, 0, 0); PG8_SCHED; PG8_LDA(At, 0, 0); PG8_STAGE(PG8_SA(1, 1), a1 + hstepA, voffA);
            PG8_WAIT_L(8); PG8_BAR; PG8_WAIT_L(0); PG8_MMA(0, 0, At, B0); PG8_BAR; PG8_SCHED;
            PG8_LDB(B1, 0, 1); PG8_STAGE(PG8_SB(0, 0), b2, voffB);
            PG8_BAR; PG8_WAIT_L(0); PG8_MMA(0, 1, At, B1); PG8_BAR;
            PG8_LDA(At, 0, 1); PG8_STAGE(PG8_SA(0, 0), a2, voffA);
            PG8_BAR; PG8_WAIT_L(0); PG8_MMA(1, 0, At, B0); PG8_BAR; PG8_SCHED;
            PG8_STAGE(PG8_SB(0, 1), b2 + hstepB, voffB);
            PG8_WAIT_V(6); PG8_BAR; PG8_MMA(1, 1, At, B1); PG8_BAR;
            PG8_LDB(B0, 1, 0); PG8_SCHED; PG8_LDA(At, 1, 0); PG8_STAGE(PG8_SA(0, 1), a2 + hstepA, voffA);
            PG8_WAIT_L(8); PG8_BAR; PG8_WAIT_L(0); PG8_MMA(0, 0, At, B0); PG8_BAR; PG8_SCHED;
            PG8_LDB(B1, 1, 1); PG8_STAGE(PG8_SB(1, 0), b3, voffB);
            PG8_BAR; PG8_WAIT_L(0); PG8_MMA(0, 1, At, B1); PG8_BAR;
            PG8_LDA(At, 1, 1); PG8_STAGE(PG8_SA(1, 0), a3, voffA);
            PG8_BAR; PG8_WAIT_L(0); PG8_MMA(1, 0, At, B0); PG8_BAR; PG8_SCHED;
            PG8_STAGE(PG8_SB(1, 1), b3 + hstepB, voffB);
            PG8_WAIT_V(6); PG8_BAR; PG8_MMA(1, 1, At, B1); PG8_BAR;
            }
        }
        if constexpr (ALIGN_EPI) { if (wr == 0) PG8_BAR; }
        if (cur.piece < 0 && !dry) E(acc, cur, wr, wc, fr, fq);
        if (!has_next) break;
#pragma unroll
        for (int a = 0; a < 2; ++a)
#pragma unroll
            for (int b = 0; b < 2; ++b)
#pragma unroll
                for (int m = 0; m < 4; ++m)
#pragma unroll
                    for (int n = 0; n < 2; ++n) acc[a][b][m][n] = (f32x4){0.f, 0.f, 0.f, 0.f};
        cur = nxt; cA = nA; cB = nB; ++ui;
        if constexpr (ALIGN_EPI) { if (wr == 1) PG8_BAR; }
    }
    PG8_WAIT_V(0);
    if constexpr (!ALIGN_EPI) { if (wr == 0) PG8_BAR; }
    PG8_BAR;
    if constexpr (Epi::SPLIT) {
    if (cur.piece >= 0 && !dry) {
        float* slab0 = slabs + (size_t)cur.lu * (8 * 4 * 8192);
        {
            const __amdgpu_buffer_rsrc_t rs = __builtin_amdgcn_make_buffer_rsrc((void*)slab0, (short)0, 8 * 4 * 32768, 0x00020000);
#pragma unroll
            for (int a = 0; a < 2; ++a)
#pragma unroll
                for (int m = 0; m < 4; ++m) {
                    const int gq = a * 4 + m;
                    if ((gq >> 1) != cur.piece) {
#pragma unroll
                        for (int b = 0; b < 2; ++b)
#pragma unroll
                            for (int n = 0; n < 2; ++n) __builtin_amdgcn_raw_buffer_store_b128(__builtin_bit_cast(u32x4, acc[a][b][m][n]), rs, (gq * 4 + cur.piece) * 32768 + (b * 2 + n) * 8192 + tid * 16, 0, 16);
                    }
                }
        }
        asm volatile("s_waitcnt vmcnt(0)" ::: "memory");
        __syncthreads();
        if (tid == 0) {
            __hip_atomic_fetch_add(tickets + 64 * cur.lu, 1u, __ATOMIC_RELAXED, __HIP_MEMORY_SCOPE_AGENT);
            unsigned sp = 0;
            while (__hip_atomic_load(tickets + 64 * cur.lu, __ATOMIC_RELAXED, __HIP_MEMORY_SCOPE_AGENT) < 4u) { __builtin_amdgcn_s_sleep(2); if (++sp > (1u << 20)) break; }
            __builtin_amdgcn_fence(__ATOMIC_ACQUIRE, "agent"); asm volatile("s_waitcnt vmcnt(0)" ::: "memory");
        }
        __syncthreads();
        switch (cur.piece) {
            case 0: reduce_rowgroup<0, 0, 0>(acc, slab0, tid); reduce_rowgroup<0, 0, 1>(acc, slab0, tid); break;
            case 1: reduce_rowgroup<1, 0, 2>(acc, slab0, tid); reduce_rowgroup<1, 0, 3>(acc, slab0, tid); break;
            case 2: reduce_rowgroup<2, 1, 0>(acc, slab0, tid); reduce_rowgroup<2, 1, 1>(acc, slab0, tid); break;
            default: reduce_rowgroup<3, 1, 2>(acc, slab0, tid); reduce_rowgroup<3, 1, 3>(acc, slab0, tid); break;
        }
        E(acc, cur, wr, wc, fr, fq, 3u << (2 * cur.piece));
    }
    }
#undef PG8_SA
#undef PG8_SB
#undef PG8_STAGE
#undef PG8_LDA
#undef PG8_LDB
#undef PG8_MMA
#undef PG8_WAIT_V
#undef PG8_WAIT_L
#undef PG8_BAR
#undef PG8_SCHED
}
}

typedef f32x4 Acc[2][2][4][2];

struct EpiZ {
    static constexpr bool SPLIT = false;
    const float* rstd1; bf16_t* z; float* out;
    __device__ __forceinline__ void operator()(const Acc& acc, const pg8::Unit& u, int wr, int wc, int fr, int fq) const {
        asm volatile("" : "+v"(fr), "+v"(fq));
        const int col0 = u.pn * 256 + wc * 32 + 8 * fq;
#pragma unroll
        for (int ai = 0; ai < 2; ++ai)
#pragma unroll
            for (int m = 0; m < 4; ++m) {
                const int r = u.pm * 256 + ai * 128 + wr * 64 + m * 16 + fr;
                if (r < M) {
                    const float rs = rstd1[r];
                    int is_s, seq, t; row_decode(r, is_s, seq, t);
                    float* so = nullptr;
                    if (u.pn < 6) { if (is_s) { if (t >= TS - 3) so = out + O_SRC + ((size_t)seq * 3 + (t - (TS - 3))) * DA; } else { if (t >= TP - 3) so = out + O_PRC + ((size_t)seq * 3 + (t - (TP - 3))) * DA; } }
#pragma unroll
                    for (int bj = 0; bj < 2; ++bj) {
                        const f32x4 v0 = acc[ai][bj][m][0] * rs, v1 = acc[ai][bj][m][1] * rs;
                        u32x4 w; w.x = cvt_pk_bf16(v0[0], v0[1]); w.y = cvt_pk_bf16(v0[2], v0[3]); w.z = cvt_pk_bf16(v1[0], v1[1]); w.w = cvt_pk_bf16(v1[2], v1[3]);
                        *(u32x4*)(z + (size_t)r * DIN + col0 + bj * 128) = w;
                        if (so) { *(f32x4*)(so + col0 + bj * 128) = v0; *(f32x4*)(so + col0 + bj * 128 + 4) = v1; }
                    }
                }
            }
    }
};
struct EpiX1 {
    static constexpr bool SPLIT = true;
    const float *xp, *xs, *meta; float* out; bf16_t* x1b; float* ssq;
    __device__ __forceinline__ void operator()(const Acc& acc, const pg8::Unit& u, int wr, int wc, int fr, int fq, unsigned gmask = 0xffu) const {
        asm volatile("" : "+v"(fr), "+v"(fq));
        const int col0 = u.pn * 256 + wc * 32 + 8 * fq;
#pragma unroll
        for (int ai = 0; ai < 2; ++ai) {
            if (!((gmask >> (ai * 4)) & 0xfu)) continue;
            f32x4 xv[4][2][2];
#pragma unroll
            for (int m = 0; m < 4; ++m) {
                const int r = u.pm * 256 + ai * 128 + wr * 64 + m * 16 + fr;
                const float* xr = x_row_ptr(xp, xs, meta, r < M ? r : 0) + col0;
#pragma unroll
                for (int bj = 0; bj < 2; ++bj) { xv[m][bj][0] = *(const f32x4*)(xr + bj * 128); xv[m][bj][1] = *(const f32x4*)(xr + bj * 128 + 4); }
            }
#pragma unroll
            for (int m = 0; m < 4; ++m) {
                if (!((gmask >> (ai * 4 + m)) & 1u)) continue;
                const int r = u.pm * 256 + ai * 128 + wr * 64 + m * 16 + fr;
                const bool valid = r < M;
                float* yd = y_row_ptr(out, r);
                float ss = 0.f;
#pragma unroll
                for (int bj = 0; bj < 2; ++bj) {
                    const int c = col0 + bj * 128;
                    const f32x4 v0 = acc[ai][bj][m][0] + xv[m][bj][0], v1 = acc[ai][bj][m][1] + xv[m][bj][1];
                    ss += (v0[0] * v0[0] + v0[1] * v0[1]) + (v0[2] * v0[2] + v0[3] * v0[3]) + (v1[0] * v1[0] + v1[1] * v1[1]) + (v1[2] * v1[2] + v1[3] * v1[3]);
                    if (yd) { *(f32x4*)(yd + c) = v0; *(f32x4*)(yd + c + 4) = v1; }
                    if (valid) { u32x4 w; w.x = cvt_pk_bf16(v0[0], v0[1]); w.y = cvt_pk_bf16(v0[2], v0[3]); w.z = cvt_pk_bf16(v1[0], v1[1]); w.w = cvt_pk_bf16(v1[2], v1[3]);
                        *(u32x4*)(x1b + (size_t)r * D + c) = w; }
                }
                ss += __shfl_xor(ss, 16); ss += __shfl_xor(ss, 32);
                if (valid && fq == 0) ssq[(size_t)r * 32 + u.pn * 4 + wc] = ss;
            }
        }
    }
};
struct EpiOut {
    static constexpr bool SPLIT = true;
    float* out;
    __device__ __forceinline__ void operator()(const Acc& acc, const pg8::Unit& u, int wr, int wc, int fr, int fq, unsigned gmask = 0xffu) const {
        asm volatile("" : "+v"(fr), "+v"(fq));
        const int col0 = u.pn * 256 + wc * 32 + 8 * fq;
#pragma unroll
        for (int ai = 0; ai < 2; ++ai) {
            if (!((gmask >> (ai * 4)) & 0xfu)) continue;
            f32x4 xv[4][2][2];
#pragma unroll
            for (int m = 0; m < 4; ++m) {
                const int r = u.pm * 256 + ai * 128 + wr * 64 + m * 16 + fr;
                const float* yd = y_row_ptr(out, r); const float* ys = (yd ? yd : out) + col0;
#pragma unroll
                for (int bj = 0; bj < 2; ++bj) { xv[m][bj][0] = *(const f32x4*)(ys + bj * 128); xv[m][bj][1] = *(const f32x4*)(ys + bj * 128 + 4); }
            }
#pragma unroll
            for (int m = 0; m < 4; ++m) {
                if (!((gmask >> (ai * 4 + m)) & 1u)) continue;
                const int r = u.pm * 256 + ai * 128 + wr * 64 + m * 16 + fr;
                float* yd = y_row_ptr(out, r);
                if (yd) {
#pragma unroll
                    for (int bj = 0; bj < 2; ++bj) {
                        const int c = col0 + bj * 128;
                        *(f32x4*)(yd + c) = acc[ai][bj][m][0] + xv[m][bj][0]; *(f32x4*)(yd + c + 4) = acc[ai][bj][m][1] + xv[m][bj][1];
                    }
                }
            }
        }
    }
};
struct EpiFFN {
    static constexpr bool SPLIT = false;
    const float *cw, *cb, *st_fc; bf16_t* hid; float* out; const LAS float* rstab;
    __device__ __forceinline__ void operator()(Acc& acc, const pg8::Unit& u, int wr, int wc, int fr, int fq) const {
        asm volatile("" : "+v"(fr), "+v"(fq));
        const int gbase = 252 * u.pm - 2 + 126 * wr;
        const int f0 = 128 * u.pn + 32 * wc + 8 * fq;
        const f32x4 w0a = *(const f32x4*)(cw + f0), w0b = *(const f32x4*)(cw + f0 + 4);
        const f32x4 w1a = *(const f32x4*)(cw + DFF + f0), w1b = *(const f32x4*)(cw + DFF + f0 + 4);
        const f32x4 w2a = *(const f32x4*)(cw + 2 * DFF + f0), w2b = *(const f32x4*)(cw + 2 * DFF + f0 + 4);
        const f32x4 bba = *(const f32x4*)(cb + f0), bbb = *(const f32x4*)(cb + f0 + 4);
        const LAS float* rt = rstab + u.idx * 256 + wr * 128 + fr;
#pragma unroll
        for (int ai = 0; ai < 2; ++ai)
#pragma unroll
            for (int m = 0; m < 4; ++m) {
                const float rs = rt[64 * ai + 16 * m];
#pragma unroll
                for (int bj = 0; bj < 2; ++bj)
#pragma unroll
                    for (int n = 0; n < 2; ++n) acc[ai][bj][m][n] *= rs;
            }
        const bool has_samples = 252 * u.pm + 252 > MPR;
#pragma unroll
        for (int ai = 0; ai < 2; ++ai)
#pragma unroll
            for (int m = 0; m < 4; ++m) {
                const int j = 64 * ai + 16 * m + fr, r = gbase + j;
                const bool valid = (j >= 2) && (r < M);
                const f32x4 c0 = acc[ai][0][m][0], c1 = acc[ai][0][m][1];
                const int pai = (m == 0) ? (ai == 0 ? 0 : ai - 1) : ai, pm_ = (m == 0) ? (ai == 0 ? 0 : 3) : m - 1;
                const f32x4 q0 = acc[pai][0][pm_][0], q1 = acc[pai][0][pm_][1];
                f32x4 p1a, p1b, p2a, p2b;
#pragma unroll
                for (int e = 0; e < 4; ++e) {
                    p1a[e] = dppf<0x111>(dppf<0x121>(0.f, q0[e]), c0[e]); p1b[e] = dppf<0x111>(dppf<0x121>(0.f, q1[e]), c1[e]);
                    p2a[e] = dppf<0x112>(dppf<0x122>(0.f, q0[e]), c0[e]); p2b[e] = dppf<0x112>(dppf<0x122>(0.f, q1[e]), c1[e]);
                }
                int is_s, seq, t; row_decode(valid ? r : 0, is_s, seq, t);
                if (!has_samples) {
                    const f32x4 zz = (f32x4){0.f, 0.f, 0.f, 0.f};
                    if (t == 0) { p1a = zz; p1b = zz; }
                    if (t < 2) { p2a = zz; p2b = zz; }
                } else if (valid && t < 2) {
                    f32x4 s0a = (f32x4){0.f, 0.f, 0.f, 0.f}, s0b = s0a, s1a = s0a, s1b = s0a;
                    if (is_s) { const float* sp = st_fc + (size_t)seq * 2 * DFF + f0; s0a = *(const f32x4*)sp; s0b = *(const f32x4*)(sp + 4); s1a = *(const f32x4*)(sp + DFF); s1b = *(const f32x4*)(sp + DFF + 4); }
                    if (t == 0) { p1a = s1a; p1b = s1b; p2a = s0a; p2b = s0b; } else { p2a = s1a; p2b = s1b; }
                }
                const f32x4 ga = w0a * p2a + w1a * p1a + w2a * c0 + bba, gb = w0b * p2b + w1b * p1b + w2b * c1 + bbb;
                const f32x4 va = acc[ai][1][m][0], vb = acc[ai][1][m][1];
                if (valid) {
                    u32x4 w;
                    w.x = cvt_pk_bf16(gelu_tanh(ga[0]) * va[0], gelu_tanh(ga[1]) * va[1]); w.y = cvt_pk_bf16(gelu_tanh(ga[2]) * va[2], gelu_tanh(ga[3]) * va[3]);
                    w.z = cvt_pk_bf16(gelu_tanh(gb[0]) * vb[0], gelu_tanh(gb[1]) * vb[1]); w.w = cvt_pk_bf16(gelu_tanh(gb[2]) * vb[2], gelu_tanh(gb[3]) * vb[3]);
                    *(u32x4*)(hid + (size_t)r * DFF + f0) = w;
                    const int T = is_s ? TS : TP;
                    if (t >= T - 2) { float* so = out + (is_s ? O_SFC : O_PFC) + ((size_t)seq * 2 + (t - (T - 2))) * DFF + f0; *(f32x4*)so = c0; *(f32x4*)(so + 4) = c1; }
                }
                if (m & 1) __builtin_amdgcn_sched_barrier(0);
            }
    }
};
__device__ __forceinline__ void ffn_rstd_table(const float* ssq, LAS float* tab, const pg8::StaticOrder& S) {
    const int tid = opaque_tid(), q = tid >> 1, half = tid & 1;
    pg8::Unit u;
    for (int i = 0; S.next(i, u); ++i) {
        int r = 252 * u.pm - 2 + 126 * (q >> 7) + (q & 127); r = r < 0 ? 0 : (r >= M ? M - 1 : r);
        const float* sp = ssq + (size_t)r * 32 + 16 * half;
        const f32x4 a = *(const f32x4*)sp, b = *(const f32x4*)(sp + 4), c = *(const f32x4*)(sp + 8), d = *(const f32x4*)(sp + 12);
        float sm = (((a[0] + a[1]) + (a[2] + a[3])) + ((b[0] + b[1]) + (b[2] + b[3]))) + (((c[0] + c[1]) + (c[2] + c[3])) + ((d[0] + d[1]) + (d[2] + d[3])));
        sm += __shfl_xor(sm, 1);
        if (half == 0) tab[i * 256 + q] = __builtin_amdgcn_rsqf(sm * (1.0f / D) + EPS);
    }
}

struct EpiProbe {
    static constexpr bool SPLIT = false;
    bf16_t* hid;
    __device__ __forceinline__ void operator()(const Acc& acc, const pg8::Unit& u, int wr, int wc, int fr, int fq) const {
        asm volatile("" : "+v"(fr), "+v"(fq));
        const int gbase = 252 * u.pm - 2 + 126 * wr, f0 = 128 * u.pn + 32 * wc + 8 * fq;
#pragma unroll
        for (int ai = 0; ai < 2; ++ai)
#pragma unroll
            for (int m = 0; m < 4; ++m) {
                const int j = 64 * ai + 16 * m + fr, r = gbase + j;
                if (j >= 2 && r < M) { const f32x4 a = acc[ai][0][m][0] + acc[ai][1][m][0], b = acc[ai][0][m][1] + acc[ai][1][m][1];
                    u32x4 w; w.x = cvt_pk_bf16(a[0], a[1]); w.y = cvt_pk_bf16(a[2], a[3]); w.z = cvt_pk_bf16(b[0], b[1]); w.w = cvt_pk_bf16(b[2], b[3]);
                    *(u32x4*)(hid + (size_t)r * DFF + f0) = w; }
            }
    }
};

__device__ __forceinline__ int invperm32(int q) { return 16 * ((q >> 2) & 1) + 4 * (q >> 3) + (q & 3); }
__device__ __forceinline__ void p0_transpose_item(const float* W, int K, int N, const float* kscale, bf16_t* WT, int mode, LAS float* scr, int item, int lane) {
    const int nblk = N / 32, kb = item / nblk, nb = item % nblk, k0 = 64 * kb, n0 = 32 * nb;
    float v[32];
    const float* src = W + (size_t)(k0 + (lane >> 5)) * N + n0 + (lane & 31);
#pragma unroll
    for (int i = 0; i < 32; ++i) v[i] = src[(size_t)(2 * i) * N];
#pragma unroll
    for (int i = 0; i < 32; ++i) scr[(2 * i + (lane >> 5)) * 33 + (lane & 31)] = v[i];
    asm volatile("s_waitcnt lgkmcnt(0)" ::: "memory");
    int rbase = n0;
    if (mode == 1) { const int bj = n0 >= DFF ? 1 : 0, f = n0 - bj * DFF; rbase = 256 * (f >> 7) + 128 * bj + (f & 96); }
    const int c = lane & 7;
    f32x4 ks0 = (f32x4){1.f, 1.f, 1.f, 1.f}, ks1 = ks0;
    if (kscale) { ks0 = *(const f32x4*)(kscale + k0 + 8 * c); ks1 = *(const f32x4*)(kscale + k0 + 8 * c + 4); }
#pragma unroll
    for (int j = 0; j < 4; ++j) { const int n = (lane >> 3) + 8 * j; const LAS float* sp = scr + (8 * c) * 33 + n;
        u32x4 o; o.x = cvt_pk_bf16(sp[0 * 33] * ks0[0], sp[1 * 33] * ks0[1]); o.y = cvt_pk_bf16(sp[2 * 33] * ks0[2], sp[3 * 33] * ks0[3]);
        o.z = cvt_pk_bf16(sp[4 * 33] * ks1[0], sp[5 * 33] * ks1[1]); o.w = cvt_pk_bf16(sp[6 * 33] * ks1[2], sp[7 * 33] * ks1[3]);
        *(u32x4*)(WT + (size_t)(rbase + (mode == 2 ? n : invperm32(n))) * K + k0 + 8 * c) = o; }
    asm volatile("s_waitcnt lgkmcnt(0)" ::: "memory");
}
constexpr int I_IN = (D / 64) * (DIN / 32), I_O = (DMIX / 64) * (D / 32), I_UP = (D / 64) * (2 * DFF / 32), I_DN = (DFF / 64) * (D / 32), I_G = 2 * NH * 8;
constexpr int IT_O = I_IN, IT_UP = IT_O + I_O, IT_DN = IT_UP + I_UP, IT_G = IT_DN + I_DN, IT_END = IT_G + I_G;
__device__ __forceinline__ void convert_items(PRef p, LAS unsigned char* lds, int rank, int nwaves, int lo, int hi) {
    const int tid_ = opaque_tid(), lane = tid_ & 63, wave = tid_ >> 6;
    unsigned char* ws = p.ws;
    LAS float* scr = (LAS float*)(lds + wave * 16384);
    for (int it = lo + rank; it < hi; it += nwaves) {
        int r = it;
        if (r < I_IN) { p0_transpose_item(p.w_in, D, DIN, p.g_mix, (bf16_t*)(ws + WS_WIN), 0, scr, r, lane); continue; } r -= I_IN;
        if (r < I_O) { p0_transpose_item(p.w_o, DMIX, D, nullptr, (bf16_t*)(ws + WS_WO), 0, scr, r, lane); continue; } r -= I_O;
        if (r < I_UP) { p0_transpose_item(p.w_up, D, 2 * DFF, p.g_ffn, (bf16_t*)(ws + WS_WUP), 1, scr, r, lane); continue; } r -= I_UP;
        if (r < I_DN) { p0_transpose_item(p.w_down, DFF, D, nullptr, (bf16_t*)(ws + WS_WDN), 0, scr, r, lane); continue; } r -= I_DN;
        { const int mat = r >> 3, sub = r & 7, gsel = mat / NH, n = mat % NH;
          p0_transpose_item((gsel ? p.w_gate_x : p.w_gate_a) + (size_t)n * 128 * 128, 128, 128, nullptr, (bf16_t*)(ws + WS_WG) + (size_t)mat * 128 * 128, 0, scr, sub, lane); }
    }
}
constexpr int P1_TAIL_WG0 = (888 % 256), P4_TAIL_WG0 = (296 % 256) * P4_SPLIT, MIX_IDLE_WG0 = 228, IT_S1 = IT_O + 10600, IT_S2 = IT_S1 + 1600, IT_S3 = IT_S2 + 1600;
__device__ __forceinline__ void phase0(PRef p, LAS unsigned char* lds, int G) {
    const int tid = opaque_tid(), lane = tid & 63, wave = tid >> 6;
    unsigned char* ws = p.ws;
    const int gw = blockIdx.x * 8 + wave, NGW = G * 8;
    convert_items(p, lds, gw, NGW, 0, IT_O);
    convert_items(p, lds, gw, NGW, IT_G, IT_END);
    { bf16_t* xb = (bf16_t*)(ws + WS_XB) + (size_t)16 * D; float* rstd1 = (float*)(ws + WS_RS1);
      for (int m = gw; m < M; m += NGW) {
          const f32x4* xr = (const f32x4*)x_row_ptr(p.x_prompt, p.x_sample, p.meta, m) + lane;
          f32x4 v[8]; float s = 0.f;
#pragma unroll
          for (int j = 0; j < 8; ++j) { v[j] = xr[64 * j]; s += (v[j][0] * v[j][0] + v[j][1] * v[j][1]) + (v[j][2] * v[j][2] + v[j][3] * v[j][3]); }
          s = wave_sum(s);
          if (lane == 0) rstd1[m] = __builtin_amdgcn_rsqf(s * (1.0f / D) + EPS);
          u32x2* o = (u32x2*)(xb + (size_t)m * D) + lane;
#pragma unroll
          for (int j = 0; j < 8; ++j) { u32x2 w; w.x = cvt_pk_bf16(v[j][0], v[j][1]); w.y = cvt_pk_bf16(v[j][2], v[j][3]); o[64 * j] = w; }
      } }
}

__device__ __forceinline__ void branch_b(PRef p, int G) {
    const bf16_t* z = (const bf16_t*)(p.ws + WS_Z); bf16_t* ym = (bf16_t*)(p.ws + WS_YM);
    const int total = (M / 4) * 128;
    for (int idx = blockIdx.x * 512 + opaque_tid(); idx < total; idx += G * 512) {
        const int m0 = (idx >> 7) * 4, g = idx & 127, ch = 8 * g;
        int is_s, seq, t0; row_decode(m0, is_s, seq, t0);
        u32x4 rc[6], rv[6], rg[4];
#pragma unroll
        for (int k = 0; k < 6; ++k) {
            const int mm = (t0 - 2 + k >= 0) ? m0 - 2 + k : m0;
            rc[k] = *(const u32x4*)(z + (size_t)mm * DIN + 4096 + ch); rv[k] = *(const u32x4*)(z + (size_t)mm * DIN + 5120 + ch);
        }
#pragma unroll
        for (int k = 0; k < 4; ++k) rg[k] = *(const u32x4*)(z + (size_t)(m0 + k) * DIN + 3072 + ch);
        const f32x4 w0a = *(const f32x4*)(p.conv_b_w + ch), w0b = *(const f32x4*)(p.conv_b_w + ch + 4), w1a = *(const f32x4*)(p.conv_b_w + DB + ch), w1b = *(const f32x4*)(p.conv_b_w + DB + ch + 4),
                    w2a = *(const f32x4*)(p.conv_b_w + 2 * DB + ch), w2b = *(const f32x4*)(p.conv_b_w + 2 * DB + ch + 4), goa = *(const f32x4*)(p.g_out_b + ch), gob = *(const f32x4*)(p.g_out_b + ch + 4);
        float u[6][8];
#pragma unroll
        for (int k = 0; k < 6; ++k) {
            float a[8], b[8]; unpack8(rc[k], a); unpack8(rv[k], b);
#pragma unroll
            for (int e = 0; e < 8; ++e) u[k][e] = a[e] * b[e];
        }
        if (t0 == 0) {
#pragma unroll
            for (int k = 0; k < 2; ++k) {
                f32x4 a = (f32x4){0.f, 0.f, 0.f, 0.f}, b = a;
                if (is_s) { const float* sp = p.st_sc + ((size_t)seq * 2 + k) * DB + ch; a = *(const f32x4*)sp; b = *(const f32x4*)(sp + 4); }
#pragma unroll
                for (int e = 0; e < 4; ++e) { u[k][e] = a[e]; u[k][4 + e] = b[e]; }
            }
        }
        const int T = is_s ? TS : TP;
#pragma unroll
        for (int k = 0; k < 4; ++k) {
            float gb[8]; unpack8(rg[k], gb);
            float y[8]; float ss = 0.f;
#pragma unroll
            for (int e = 0; e < 8; ++e) {
                const float uc = (e < 4 ? w0a[e & 3] : w0b[e & 3]) * u[k][e] + (e < 4 ? w1a[e & 3] : w1b[e & 3]) * u[k + 1][e] + (e < 4 ? w2a[e & 3] : w2b[e & 3]) * u[k + 2][e];
                y[e] = gb[e] * uc; ss += y[e] * y[e];
            }
            ss = sum16(ss);
            const float rn = __builtin_amdgcn_rsqf(ss * (1.0f / 128.0f) + EPS);
#pragma unroll
            for (int e = 0; e < 8; ++e) y[e] = y[e] * rn * (e < 4 ? goa[e & 3] : gob[e & 3]);
            *(u32x4*)(ym + (size_t)(m0 + k) * DMIX + DA + ch) = pack8(y);
            const int t = t0 + k;
            if (t >= T - 2) { float* so = p.out + (is_s ? O_SSC : O_PSC) + ((size_t)seq * 2 + (t - (T - 2))) * DB + ch;
                *(f32x4*)so = (f32x4){u[k + 2][0], u[k + 2][1], u[k + 2][2], u[k + 2][3]}; *(f32x4*)(so + 4) = (f32x4){u[k + 2][4], u[k + 2][5], u[k + 2][6], u[k + 2][7]}; }
        }
    }
}

constexpr int LW_STRIDE = 272, L_WA = 0, L_WX = 128 * LW_STRIDE, L_CT = 2 * 128 * LW_STRIDE, L_LRU_END = L_CT + 9 * 128 * 4;
static_assert(L_LRU_END <= 131072, "mixer LDS");
constexpr int LRU_WG_PER_HEAD = 19, LRU_NSEG = 33, LRU_PITEMS = NB * LRU_NSEG, LRU_SITEMS = MSR / 64;
static_assert(LRU_WG_PER_HEAD * 8 >= LRU_PITEMS + LRU_SITEMS, "waves per head");

template <int CTRL, int BANK> __device__ __forceinline__ float dppfb(float old, float src) {
    return __builtin_bit_cast(float, __builtin_amdgcn_update_dpp(__builtin_bit_cast(int, old), __builtin_bit_cast(int, src), CTRL, 0xF, BANK, false));
}
__device__ __forceinline__ float bcast15(float x, int lane) {
    return __builtin_bit_cast(float, __builtin_amdgcn_ds_bpermute(((lane & 48) | 15) << 2, __builtin_bit_cast(int, x)));
}
__device__ __forceinline__ void scan16(float& P, float& S) {
    float Sd, Pd;
    Sd = dppf<0x111>(0.f, S); Pd = dppf<0x111>(1.f, P); S = __builtin_fmaf(P, Sd, S); P *= Pd;
    Sd = dppf<0x112>(0.f, S); Pd = dppf<0x112>(1.f, P); S = __builtin_fmaf(P, Sd, S); P *= Pd;
    Sd = dppf<0x114>(0.f, S); Pd = dppf<0x114>(1.f, P); S = __builtin_fmaf(P, Sd, S); P *= Pd;
    Sd = dppf<0x118>(0.f, S); Pd = dppf<0x118>(1.f, P); S = __builtin_fmaf(P, Sd, S); P *= Pd;
}
__device__ __forceinline__ void scan16x2(float& P1, float& S1, float& P2, float& S2) {
    asm volatile(
        "s_nop 1\n\t"
        "v_fmac_f32_dpp %1, %1, %0 row_shr:1 row_mask:0xf bank_mask:0xf bound_ctrl:1\n\t"
        "v_fmac_f32_dpp %3, %3, %2 row_shr:1 row_mask:0xf bank_mask:0xf bound_ctrl:1\n\t"
        "v_mul_f32_dpp %0, %0, %0 row_shr:1 row_mask:0xf bank_mask:0xf\n\t"
        "v_mul_f32_dpp %2, %2, %2 row_shr:1 row_mask:0xf bank_mask:0xf\n\t"
        "v_fmac_f32_dpp %1, %1, %0 row_shr:2 row_mask:0xf bank_mask:0xf bound_ctrl:1\n\t"
        "v_fmac_f32_dpp %3, %3, %2 row_shr:2 row_mask:0xf bank_mask:0xf bound_ctrl:1\n\t"
        "v_mul_f32_dpp %0, %0, %0 row_shr:2 row_mask:0xf bank_mask:0xf\n\t"
        "v_mul_f32_dpp %2, %2, %2 row_shr:2 row_mask:0xf bank_mask:0xf\n\t"
        "v_fmac_f32_dpp %1, %1, %0 row_shr:4 row_mask:0xf bank_mask:0xf bound_ctrl:1\n\t"
        "v_fmac_f32_dpp %3, %3, %2 row_shr:4 row_mask:0xf bank_mask:0xf bound_ctrl:1\n\t"
        "v_mul_f32_dpp %0, %0, %0 row_shr:4 row_mask:0xf bank_mask:0xf\n\t"
        "v_mul_f32_dpp %2, %2, %2 row_shr:4 row_mask:0xf bank_mask:0xf\n\t"
        "v_fmac_f32_dpp %1, %1, %0 row_shr:8 row_mask:0xf bank_mask:0xf bound_ctrl:1\n\t"
        "v_fmac_f32_dpp %3, %3, %2 row_shr:8 row_mask:0xf bank_mask:0xf bound_ctrl:1\n\t"
        "v_mul_f32_dpp %0, %0, %0 row_shr:8 row_mask:0xf bank_mask:0xf\n\t"
        "v_mul_f32_dpp %2, %2, %2 row_shr:8 row_mask:0xf bank_mask:0xf\n\t"
        "s_nop 0"
        : "+v"(P1), "+v"(S1), "+v"(P2), "+v"(S2));
}
__device__ __forceinline__ void scan8(float& P, float& S, int t) {
    float Sd, Pd;
    Sd = dppf<0x111>(0.f, S); Pd = dppf<0x111>(1.f, P); if (t < 1) { Sd = 0.f; Pd = 1.f; } S = __builtin_fmaf(P, Sd, S); P *= Pd;
    Sd = dppf<0x112>(0.f, S); Pd = dppf<0x112>(1.f, P); if (t < 2) { Sd = 0.f; Pd = 1.f; } S = __builtin_fmaf(P, Sd, S); P *= Pd;
    Sd = dppfb<0x114, 0xA>(0.f, S); Pd = dppfb<0x114, 0xA>(1.f, P); S = __builtin_fmaf(P, Sd, S); P *= Pd;
}

template <int PASS, bool IS_S>
__device__ __forceinline__ void lru_wave_item(PRef p, LAS unsigned char* lds, int n, int b, int seg) {
    const int lane = opaque_tid() & 63, fr = lane & 15, fq = lane >> 4;
    const bf16_t* z = (const bf16_t*)(p.ws + WS_Z);
    bf16_t* ym = (bf16_t*)(p.ws + WS_YM);
    float* tot = (float*)(p.ws + WS_TOT);
    const LAS float* CT = (const LAS float*)(lds + L_CT) + 8 * fq;
    const int gch = n * 128 + 8 * fq;
    const int r0 = IS_S ? MPR + b * 64 : b * TP + seg * 64;
    const int nblk = IS_S ? 4 : (seg == LRU_NSEG - 1 ? 1 : 4);
    float hin[4][8], Pt[4][8];
    u32x4 prevx[4];
#pragma unroll
    for (int ks = 0; ks < 4; ++ks) {
#pragma unroll
        for (int e = 0; e < 8; ++e) { hin[ks][e] = 0.f; Pt[ks][e] = 1.f; }
        prevx[ks] = (u32x4){0u, 0u, 0u, 0u};
    }
    if constexpr (!IS_S) {
        if (seg > 0) {
#pragma unroll
            for (int ks = 0; ks < 4; ++ks) prevx[ks] = *(const u32x4*)(z + (size_t)(r0 - 16 + fr) * DIN + gch + 32 * ks);
            if constexpr (PASS == 2) {
#pragma unroll 1
                for (int round = 0; round < 2; ++round) {
                    const int s = 16 * round + fr;
                    if (16 * round >= seg) break;
                    const bool have = s < seg;
                    const float* tp = tot + ((size_t)(b * LRU_NSEG + (have ? s : 0)) * 2) * DA + gch;
#pragma unroll
                    for (int ks = 0; ks < 4; ++ks) {
                        const f32x4 P0 = *(const f32x4*)(tp + 32 * ks), P1 = *(const f32x4*)(tp + 32 * ks + 4), S0 = *(const f32x4*)(tp + DA + 32 * ks), S1 = *(const f32x4*)(tp + DA + 32 * ks + 4);
#pragma unroll
                        for (int e = 0; e < 8; e += 2) {
                            float Pa = have ? (e < 4 ? P0[e & 3] : P1[e & 3]) : 1.f, Sa = have ? (e < 4 ? S0[e & 3] : S1[e & 3]) : 0.f;
                            float Pb = have ? (e < 4 ? P0[(e + 1) & 3] : P1[(e + 1) & 3]) : 1.f, Sb = have ? (e < 4 ? S0[(e + 1) & 3] : S1[(e + 1) & 3]) : 0.f;
                            scan16x2(Pa, Sa, Pb, Sb);
                            hin[ks][e] = __builtin_fmaf(bcast15(Pa, lane), hin[ks][e], bcast15(Sa, lane));
                            hin[ks][e + 1] = __builtin_fmaf(bcast15(Pb, lane), hin[ks][e + 1], bcast15(Sb, lane));
                        }
                    }
                }
            }
        }
    }
    u32x4 xnext[4];
#pragma unroll
    for (int ks = 0; ks < 4; ++ks) xnext[ks] = *(const u32x4*)(z + (size_t)(r0 + fr) * DIN + gch + 32 * ks);
#pragma unroll 1
    for (int blk = 0; blk < nblk; ++blk) {
        const int r = r0 + 16 * blk + fr;
        const int t8 = fr & 7, sq = (r - MPR) >> 3;
        u32x4 x4[4], g4[4];
#pragma unroll
        for (int ks = 0; ks < 4; ++ks) { x4[ks] = xnext[ks]; if constexpr (PASS == 2) g4[ks] = *(const u32x4*)(z + (size_t)r * DIN + DA + gch + 32 * ks); }
        { const int rn_ = (blk + 1 < nblk) ? r + 16 : r;
#pragma unroll
          for (int ks = 0; ks < 4; ++ks) xnext[ks] = *(const u32x4*)(z + (size_t)rn_ * DIN + gch + 32 * ks); }
        float xc[4][8];
        bf16x8 bfrag[4];
#pragma unroll
        for (int ks = 0; ks < 4; ++ks) {
            float xf[8]; unpack8(x4[ks], xf);
            const f32x4 w0a = *(const LAS f32x4*)(CT + 0 * 128 + 32 * ks), w0b = *(const LAS f32x4*)(CT + 0 * 128 + 32 * ks + 4);
            const f32x4 w1a = *(const LAS f32x4*)(CT + 1 * 128 + 32 * ks), w1b = *(const LAS f32x4*)(CT + 1 * 128 + 32 * ks + 4);
            const f32x4 w2a = *(const LAS f32x4*)(CT + 2 * 128 + 32 * ks), w2b = *(const LAS f32x4*)(CT + 2 * 128 + 32 * ks + 4);
            const f32x4 w3a = *(const LAS f32x4*)(CT + 3 * 128 + 32 * ks), w3b = *(const LAS f32x4*)(CT + 3 * 128 + 32 * ks + 4);
            const f32x4 cba = *(const LAS f32x4*)(CT + 4 * 128 + 32 * ks), cbb = *(const LAS f32x4*)(CT + 4 * 128 + 32 * ks + 4);
            if constexpr (IS_S) {
                const float* sp = p.st_rc + (size_t)sq * 3 * DA + gch + 32 * ks;
                const f32x4 b0a = *(const f32x4*)sp, b0b = *(const f32x4*)(sp + 4), b1a = *(const f32x4*)(sp + DA), b1b = *(const f32x4*)(sp + DA + 4), b2a = *(const f32x4*)(sp + 2 * DA), b2b = *(const f32x4*)(sp + 2 * DA + 4);
#pragma unroll
                for (int e = 0; e < 8; ++e) {
                    const float bb0 = e < 4 ? b0a[e & 3] : b0b[e & 3], bb1 = e < 4 ? b1a[e & 3] : b1b[e & 3], bb2 = e < 4 ? b2a[e & 3] : b2b[e & 3];
                    const float s1 = dppf<0x111>(0.f, xf[e]), s2 = dppf<0x112>(0.f, xf[e]), s3 = dppf<0x113>(0.f, xf[e]);
                    const float x1 = t8 >= 1 ? s1 : bb2;
                    const float x2 = t8 >= 2 ? s2 : (t8 == 1 ? bb2 : bb1);
                    const float x3 = t8 >= 3 ? s3 : (t8 == 2 ? bb2 : (t8 == 1 ? bb1 : bb0));
                    const float w0 = e < 4 ? w0a[e & 3] : w0b[e & 3], w1 = e < 4 ? w1a[e & 3] : w1b[e & 3], w2 = e < 4 ? w2a[e & 3] : w2b[e & 3], w3 = e < 4 ? w3a[e & 3] : w3b[e & 3];
                    xc[ks][e] = (e < 4 ? cba[e & 3] : cbb[e & 3]) + w3 * xf[e] + w2 * x1 + w1 * x2 + w0 * x3;
                }
            } else {
                float pf[8]; unpack8(prevx[ks], pf);
#pragma unroll
                for (int e = 0; e < 8; ++e) {
                    const float x1 = dppf<0x111>(dppf<0x121>(0.f, pf[e]), xf[e]);
                    const float x2 = dppf<0x112>(dppf<0x122>(0.f, pf[e]), xf[e]);
                    const float x3 = dppf<0x113>(dppf<0x123>(0.f, pf[e]), xf[e]);
                    const float w0 = e < 4 ? w0a[e & 3] : w0b[e & 3], w1 = e < 4 ? w1a[e & 3] : w1b[e & 3], w2 = e < 4 ? w2a[e & 3] : w2b[e & 3], w3 = e < 4 ? w3a[e & 3] : w3b[e & 3];
                    xc[ks][e] = (e < 4 ? cba[e & 3] : cbb[e & 3]) + w3 * xf[e] + w2 * x1 + w1 * x2 + w0 * x3;
                }
                prevx[ks] = x4[ks];
            }
            bfrag[ks] = __builtin_bit_cast(bf16x8, pack8(xc[ks]));
        }
        f32x4 aa[8], ax[8];
#pragma unroll
        for (int nb = 0; nb < 8; ++nb) { aa[nb] = (f32x4){0.f, 0.f, 0.f, 0.f}; ax[nb] = (f32x4){0.f, 0.f, 0.f, 0.f}; }
#pragma unroll
        for (int ks = 0; ks < 4; ++ks)
#pragma unroll
            for (int nb = 0; nb < 8; ++nb) {
                const bf16x8 wa = *(const LAS bf16x8*)(lds + L_WA + (16 * nb + fr) * LW_STRIDE + (32 * ks + 8 * fq) * 2);
                const bf16x8 wx = *(const LAS bf16x8*)(lds + L_WX + (16 * nb + fr) * LW_STRIDE + (32 * ks + 8 * fq) * 2);
                aa[nb] = __builtin_amdgcn_mfma_f32_16x16x32_bf16(wa, bfrag[ks], aa[nb], 0, 0, 0);
                ax[nb] = __builtin_amdgcn_mfma_f32_16x16x32_bf16(wx, bfrag[ks], ax[nb], 0, 0, 0);
            }
        float y[4][8]; float ss = 0.f;
#pragma unroll
        for (int ks = 0; ks < 4; ++ks) {
            const f32x4 bga0 = *(const LAS f32x4*)(CT + 5 * 128 + 32 * ks), bga1 = *(const LAS f32x4*)(CT + 5 * 128 + 32 * ks + 4);
            const f32x4 bgx0 = *(const LAS f32x4*)(CT + 6 * 128 + 32 * ks), bgx1 = *(const LAS f32x4*)(CT + 6 * 128 + 32 * ks + 4);
            const f32x4 sp0 = *(const LAS f32x4*)(CT + 7 * 128 + 32 * ks), sp1 = *(const LAS f32x4*)(CT + 7 * 128 + 32 * ks + 4);
            float gav[8];
            if constexpr (PASS == 2) unpack8(g4[ks], gav);
            f32x4 h0a, h0b;
            if constexpr (IS_S) { const float* hp = p.st_h + (size_t)sq * DA + gch + 32 * ks; h0a = *(const f32x4*)hp; h0b = *(const f32x4*)(hp + 4); }
            float hv[8], Pv[8], Sv[8];
#pragma unroll
            for (int e = 0; e < 8; ++e) {
                const int nb = 2 * ks + (e >> 2), rg = e & 3;
                const float rr = __builtin_amdgcn_rcpf(1.0f + __builtin_amdgcn_exp2f(__builtin_fmaf(aa[nb][rg], -1.4426950408889634f, e < 4 ? bga0[rg] : bga1[rg])));
                const float ii = __builtin_amdgcn_rcpf(1.0f + __builtin_amdgcn_exp2f(__builtin_fmaf(ax[nb][rg], -1.4426950408889634f, e < 4 ? bgx0[rg] : bgx1[rg])));
                const float a = __builtin_amdgcn_exp2f(rr * (e < 4 ? sp0[rg] : sp1[rg]));
                const float om = __builtin_fmaf(-a, a, 1.0f);
                Pv[e] = a; Sv[e] = __builtin_amdgcn_sqrtf(om > 0.f ? om : 0.f) * (ii * xc[ks][e]);
            }
            if constexpr (IS_S) {
#pragma unroll
                for (int e = 0; e < 8; ++e) { scan8(Pv[e], Sv[e], t8); hv[e] = __builtin_fmaf(Pv[e], e < 4 ? h0a[e & 3] : h0b[e & 3], Sv[e]); }
            } else {
#pragma unroll
                for (int e = 0; e < 8; e += 2) scan16x2(Pv[e], Sv[e], Pv[e + 1], Sv[e + 1]);
#pragma unroll
                for (int e = 0; e < 8; ++e) {
                    hv[e] = __builtin_fmaf(Pv[e], hin[ks][e], Sv[e]);
                    hin[ks][e] = bcast15(hv[e], lane);
                    if constexpr (PASS == 1) Pt[ks][e] *= bcast15(Pv[e], lane);
                }
            }
            if constexpr (PASS == 2) {
#pragma unroll
                for (int e = 0; e < 8; ++e) { y[ks][e] = gelu_tanh(gav[e]) * hv[e]; ss += y[ks][e] * y[ks][e]; }
            }
            if constexpr (PASS == 2) {
                if (IS_S ? (t8 == 7) : (seg == LRU_NSEG - 1 && fr == 15)) {
                    float* ho = p.out + (IS_S ? O_SH + (size_t)sq * DA : O_PH + (size_t)b * DA) + gch + 32 * ks;
                    *(f32x4*)ho = (f32x4){hv[0], hv[1], hv[2], hv[3]}; *(f32x4*)(ho + 4) = (f32x4){hv[4], hv[5], hv[6], hv[7]};
                }
            }
        }
        if constexpr (PASS == 2) {
            ss += __shfl_xor(ss, 16); ss += __shfl_xor(ss, 32);
            const float rn = __builtin_amdgcn_rsqf(ss * (1.0f / 128.0f) + EPS);
#pragma unroll
            for (int ks = 0; ks < 4; ++ks) {
                const f32x4 g0 = *(const LAS f32x4*)(CT + 8 * 128 + 32 * ks), g1 = *(const LAS f32x4*)(CT + 8 * 128 + 32 * ks + 4);
                float o[8];
#pragma unroll
                for (int e = 0; e < 8; ++e) o[e] = y[ks][e] * rn * (e < 4 ? g0[e & 3] : g1[e & 3]);
                *(u32x4*)(ym + (size_t)r * DMIX + gch + 32 * ks) = pack8(o);
            }
        }
    }
    if constexpr (PASS == 1 && !IS_S) {
        if (fr == 0) {
            float* tp = tot + ((size_t)(b * LRU_NSEG + seg) * 2) * DA + gch;
#pragma unroll
            for (int ks = 0; ks < 4; ++ks) {
                *(f32x4*)(tp + 32 * ks) = (f32x4){Pt[ks][0], Pt[ks][1], Pt[ks][2], Pt[ks][3]}; *(f32x4*)(tp + 32 * ks + 4) = (f32x4){Pt[ks][4], Pt[ks][5], Pt[ks][6], Pt[ks][7]};
                *(f32x4*)(tp + DA + 32 * ks) = (f32x4){hin[ks][0], hin[ks][1], hin[ks][2], hin[ks][3]}; *(f32x4*)(tp + DA + 32 * ks + 4) = (f32x4){hin[ks][4], hin[ks][5], hin[ks][6], hin[ks][7]};
            }
        }
    }
}
template <int PASS>
__device__ __forceinline__ void mixer_phase(PRef p, LAS unsigned char* lds, int G) {
    const int tid = opaque_tid(), wave = __builtin_amdgcn_readfirstlane(tid >> 6);
    for (int v = blockIdx.x; v < NH * LRU_WG_PER_HEAD; v += G) {
        const int n = v / LRU_WG_PER_HEAD;
        __syncthreads();
        if (!(PASS == 2 && G == GRID && p.ph_lo <= 2))
        {
            const bf16_t* wg = (const bf16_t*)(p.ws + WS_WG);
            for (int i = tid; i < 2 * 128 * 16; i += 512) { const int g = i >> 11, row = (i >> 4) & 127, c16 = i & 15;
                *(LAS u32x4*)(lds + g * L_WX + row * LW_STRIDE + c16 * 16) = *(const u32x4*)(wg + (((size_t)g * NH + n) * 128 + row) * 128 + c16 * 8); }
            LAS float* CTw = (LAS float*)(lds + L_CT);
            for (int i = tid; i < 9 * 128; i += 512) { const int k = i >> 7, c = i & 127, ch = n * 128 + c;
                float vv;
                if (k < 4) vv = p.conv_a_w[k * DA + ch]; else if (k == 4) vv = p.conv_a_b[ch]; else if (k == 5) vv = -1.4426950408889634f * p.b_gate_a[ch]; else if (k == 6) vv = -1.4426950408889634f * p.b_gate_x[ch];
                else if (k == 7) vv = -8.0f * 1.4426950408889634f * log1pf(__expf(-p.lam[ch])); else vv = p.g_out_a[ch];
                CTw[i] = vv; }
        }
        __syncthreads();
        const int wi = (v % LRU_WG_PER_HEAD) * 8 + wave;
        if (wi < LRU_PITEMS) lru_wave_item<PASS, false>(p, lds, n, wi / LRU_NSEG, wi % LRU_NSEG);
        else if (PASS == 2 && wi < LRU_PITEMS + LRU_SITEMS) lru_wave_item<PASS, true>(p, lds, n, wi - LRU_PITEMS, 0);
    }
    if (G == 256 && (int)blockIdx.x >= MIX_IDLE_WG0) convert_items(p, lds, ((int)blockIdx.x - MIX_IDLE_WG0) * 8 + wave, (G - MIX_IDLE_WG0) * 8, PASS == 1 ? IT_S1 : IT_S2, PASS == 1 ? IT_S2 : IT_S3);
    if (PASS == 1) { branch_b(p, G); if ((REP_MASK >> 11) & 1) branch_b(p, G); }
}

__device__ __forceinline__ void final_phase(PRef p, int G, float* probe_dst = nullptr) {
    const int tid_ = opaque_tid(), lane = tid_ & 63, gw = blockIdx.x * 8 + (tid_ >> 6), NGW = G * 8;
    f32x4 gf[8];
#pragma unroll
    for (int j = 0; j < 8; ++j) gf[j] = ((const f32x4*)p.g_final)[lane + 64 * j];
    for (int r = gw; r < NB * SEQ + MSR; r += NGW) {
        f32x4* yr = (f32x4*)(p.out + (size_t)r * D) + lane;
        f32x4 v[8]; float s = 0.f;
#pragma unroll
        for (int j = 0; j < 8; ++j) { v[j] = yr[64 * j]; s += (v[j][0] * v[j][0] + v[j][1] * v[j][1]) + (v[j][2] * v[j][2] + v[j][3] * v[j][3]); }
        s = wave_sum(s);
        const float rs = __builtin_amdgcn_rsqf(s * (1.0f / D) + EPS);
        f32x4* yo = probe_dst ? (f32x4*)(probe_dst + (size_t)r * D) + lane : yr;
#pragma unroll
        for (int j = 0; j < 8; ++j) yo[64 * j] = v[j] * rs * gf[j];
    }
}


#define XB_TMO      128
#define XB_XCNT(j)  (256  + 64 * (j))
#define XB_XSUB(j)  (1280 + 64 * (j))
#define XB_XGEN(j)  (2304 + 64 * (j))
#define XB_TOP      3328
#define XB_TOPGEN   3392
#define XCD_BAR_WORDS 3456
#define XB_SPIN_CAP (1u << 18)
__device__ __forceinline__ unsigned xb_ld(unsigned* p)              { return __hip_atomic_load(p, __ATOMIC_RELAXED, __HIP_MEMORY_SCOPE_AGENT); }
__device__ __forceinline__ unsigned xb_add(unsigned* p, unsigned v) { return __hip_atomic_fetch_add(p, v, __ATOMIC_RELAXED, __HIP_MEMORY_SCOPE_AGENT); }
__device__ __forceinline__ unsigned xb_xcc_id() { return (unsigned)__builtin_amdgcn_s_getreg((3 << 11) | 20) & 0xFu; }
#define XB_SPIN(cond, bar) do { unsigned _sp = 0; while (cond) { __builtin_amdgcn_s_sleep(1); \
    if ((++_sp & 255u) == 0u) { if (xb_ld(&(bar)[XB_TMO])) break; if (_sp > XB_SPIN_CAP) { atomicAdd(&(bar)[XB_TMO], 1u); break; } } } } while (0)
struct XcdBarrier { unsigned* bar; unsigned x; volatile LAS unsigned* st; };
__device__ __forceinline__ XcdBarrier xcd_barrier_post(unsigned* bar, volatile LAS unsigned* st) {
    XcdBarrier b; b.bar = bar; b.x = xb_xcc_id(); b.st = st;
    if (threadIdx.x == 0) (void)xb_add(&bar[XB_XCNT(b.x)], 1u);
    return b;
}
__device__ __forceinline__ void xcd_barrier_complete(unsigned* bar, unsigned x, unsigned& nloc, unsigned& nx) {
    const unsigned G = gridDim.x * gridDim.y * gridDim.z;
    unsigned sum, cnt, mine, sp = 0u;
    for (;;) {
        sum = 0u; cnt = 0u; mine = 0u;
#pragma unroll
        for (unsigned j = 0; j < 16; ++j) { const unsigned c = xb_ld(&bar[XB_XCNT(j)]); sum += c; cnt += (c > 0u) ? 1u : 0u; mine = (j == x) ? c : mine; }
        if (sum == G) break;
        __builtin_amdgcn_s_sleep(1);
        if ((++sp & 255u) == 0u) { if (xb_ld(&bar[XB_TMO])) break; if (sp > XB_SPIN_CAP) { atomicAdd(&bar[XB_TMO], 1u); break; } }
    }
    nloc = mine > 0u ? mine : 1u; nx = cnt > 0u ? cnt : 1u;
}
__device__ __forceinline__ void xcd_barrier(const XcdBarrier& b) {
    asm volatile("s_waitcnt vmcnt(0)" ::: "memory");
    __syncthreads();
    if (threadIdx.x == 0) {
        unsigned* bar = b.bar;
        __builtin_amdgcn_s_waitcnt(0);
        unsigned nloc = b.st[0], nx = b.st[1];
        if (nloc == 0u) { xcd_barrier_complete(bar, b.x, nloc, nx); b.st[0] = nloc; b.st[1] = nx; }
        const unsigned old = xb_add(&bar[XB_XSUB(b.x)], 1u);
        const unsigned gen = old / nloc;
        if (old + 1u == (gen + 1u) * nloc) {
            __builtin_amdgcn_fence(__ATOMIC_RELEASE, "agent");
            asm volatile("s_waitcnt vmcnt(0)" ::: "memory");
            const unsigned og = xb_add(&bar[XB_TOP], 1u);
            const unsigned tg = og / nx;
            if (og + 1u == (tg + 1u) * nx) xb_add(&bar[XB_TOPGEN], 1u);
            else XB_SPIN(xb_ld(&bar[XB_TOPGEN]) == tg, bar);
            __builtin_amdgcn_fence(__ATOMIC_ACQUIRE, "agent");
            xb_add(&bar[XB_XGEN(b.x)], 1u);
            asm volatile("s_waitcnt vmcnt(0)" ::: "memory");
        } else {
            XB_SPIN(xb_ld(&bar[XB_XGEN(b.x)]) == gen, bar);
            __builtin_amdgcn_fence(__ATOMIC_ACQUIRE, "agent");
            asm volatile("s_waitcnt vmcnt(0)" ::: "memory");
        }
    }
    __syncthreads();
}

constexpr int LDS_BYTES = 131072 + 1024 + 8 * 1024;
constexpr int N_PHASES = 8;
__global__ void __launch_bounds__(512, 2) hymba_fwd(Params p) {
    extern __shared__ __attribute__((aligned(16))) unsigned char lds_raw[];
    LAS unsigned char* lds = (LAS unsigned char*)lds_raw;
    constexpr int G = GRID;
    if ((int)gridDim.x != GRID) return;
    const CAS Params* kp = (const CAS Params*)__builtin_amdgcn_kernarg_segment_ptr();
#define P_HERE (*({ const CAS Params* q_ = kp; asm volatile("" : "+s"(q_)); q_; }))
    unsigned char* ws = p.ws;
    volatile LAS unsigned* misc = (volatile LAS unsigned*)(lds + 131072);
    if (threadIdx.x < 8) misc[threadIdx.x] = 0u;
    __syncthreads();
    XcdBarrier bar = xcd_barrier_post((unsigned*)ws, misc);
    const int lo = p.ph_lo, hi = p.ph_hi;
#ifndef PH_MASK
#define PH_MASK 0xff
#endif
#define IN(k) (((PH_MASK >> (k)) & 1) && lo <= (k) && (k) < hi)
#define SEAM(k) do { if (IN(k) && IN((k) + 1)) xcd_barrier(bar); } while (0)
#define REPEAT(k) for (int rep_ = 0; rep_ < ((((REP_MASK) >> (k)) & 1) ? 2 : 1); ++rep_, (rep_ < ((((REP_MASK) >> (k)) & 1) ? 2 : 1) ? xcd_barrier(bar) : (void)0))
    if (IN(0)) REPEAT(0) phase0(P_HERE, lds, G);
    SEAM(0);
    if (IN(1)) REPEAT(1) {
        pg8::Gemm g{(const bf16_t*)(ws + WS_XB) + (size_t)16 * D, (const bf16_t*)(ws + WS_WIN), MP / 256, DIN / 256, D, (size_t)256 * D * 2, (size_t)128 * D * 2};
        pg8::StaticOrder S; S.init(g.nM, g.nN, G, (int)blockIdx.x, D / 64, 1);
        PRef q = P_HERE; EpiZ E{(const float*)(ws + WS_RS1), (bf16_t*)(ws + WS_Z), q.out};
        pg8::gemm_phase<EpiZ, false, true, true>(lds, g, S, E, nullptr, nullptr);
        if ((int)blockIdx.x >= P1_TAIL_WG0 && G == 256) convert_items(P_HERE, lds, ((int)blockIdx.x - P1_TAIL_WG0) * 8 + (opaque_tid() >> 6), (G - P1_TAIL_WG0) * 8, IT_O, IT_S1);
        else if (G != 256) convert_items(P_HERE, lds, (int)blockIdx.x * 8 + (opaque_tid() >> 6), G * 8, IT_O, IT_S3);
    }
    SEAM(1);
    if (IN(2)) REPEAT(2) mixer_phase<1>(P_HERE, lds, G);
    SEAM(2);
    if (IN(3)) REPEAT(3) mixer_phase<2>(P_HERE, lds, G);
    SEAM(3);
    if (IN(4)) REPEAT(4) {
        pg8::Gemm g{(const bf16_t*)(ws + WS_YM), (const bf16_t*)(ws + WS_WO), MP / 256, D / 256, DMIX, (size_t)256 * DMIX * 2, (size_t)128 * DMIX * 2};
        pg8::StaticOrder S; S.init(g.nM, g.nN, G, (int)blockIdx.x, DMIX / 64, P4_SPLIT);
        PRef q = P_HERE; EpiX1 E{q.x_prompt, q.x_sample, q.meta, q.out, (bf16_t*)(ws + WS_XB) + (size_t)16 * D, (float*)(ws + WS_SSQ)};
        pg8::gemm_phase<EpiX1, false, true, true>(lds, g, S, E, (float*)(ws + WS_Z), (unsigned*)ws + CW_TK4);
        if ((int)blockIdx.x >= P4_TAIL_WG0 && G == 256) convert_items(P_HERE, lds, ((int)blockIdx.x - P4_TAIL_WG0) * 8 + (opaque_tid() >> 6), (G - P4_TAIL_WG0) * 8, IT_S3, IT_G);
        else if (G != 256) convert_items(P_HERE, lds, (int)blockIdx.x * 8 + (opaque_tid() >> 6), G * 8, IT_S3, IT_G);
    }
    SEAM(4);
    if (IN(5)) REPEAT(5) {
        pg8::Gemm g{(const bf16_t*)(ws + WS_XB) + (size_t)14 * D, (const bf16_t*)(ws + WS_WUP), 37, 2 * DFF / 256, D, (size_t)252 * D * 2, (size_t)64 * D * 2};
        pg8::StaticOrder S; S.init(g.nM, g.nN, G, (int)blockIdx.x, D / 64, 1);
        LAS float* rstab = (LAS float*)(lds + 131072 + 1024);
        ffn_rstd_table((const float*)(ws + WS_SSQ), rstab, S); __syncthreads();
        PRef q = P_HERE; EpiFFN E{q.conv_f_w, q.conv_f_b, q.st_fc, (bf16_t*)(ws + WS_Z), q.out, rstab};
        if ((REP_MASK >> 10) & 1) { EpiProbe Ep{(bf16_t*)(ws + WS_Z)}; pg8::gemm_phase<EpiProbe, true, true, true>(lds, g, S, Ep, nullptr, nullptr); xcd_barrier(bar); }
        pg8::gemm_phase<EpiFFN, true, true, true>(lds, g, S, E, nullptr, nullptr);
    }
    SEAM(5);
    if (IN(6)) {
        pg8::Gemm g{(const bf16_t*)(ws + WS_Z), (const bf16_t*)(ws + WS_WDN), MP / 256, D / 256, DFF, (size_t)256 * DFF * 2, (size_t)128 * DFF * 2};
        pg8::StaticOrder S; S.init(g.nM, g.nN, G, (int)blockIdx.x, DFF / 64, P6_SPLIT);
        PRef q = P_HERE; EpiOut E{q.out};
        if ((REP_MASK >> 6) & 1) { pg8::gemm_phase<EpiOut, false, true, true>(lds, g, S, E, (float*)(ws + WS_WIN), (unsigned*)ws + CW_TK6, true); xcd_barrier(bar); }
        if ((REP_MASK >> 9) & 1) { pg8::StaticOrder S3; S3.init(g.nM, g.nN, G, (int)blockIdx.x, DFF / 64, P6_SPLIT); S3.first = 1; EpiOut E3{(float*)(ws + WS_END)};
            pg8::gemm_phase<EpiOut, false, true, true>(lds, g, S3, E3, (float*)(ws + WS_WIN), (unsigned*)ws + CW_TK6 + 64 * 64); xcd_barrier(bar); }
        if ((REP_MASK >> 8) & 1) { pg8::StaticOrder S2; S2.init(g.nM, g.nN, G, (int)blockIdx.x, DFF / 64, 1); S2.limit = 1; EpiOut E2{(float*)(ws + WS_END)};
            pg8::gemm_phase<EpiOut, false, true, true>(lds, g, S2, E2, nullptr, nullptr); xcd_barrier(bar); }
        pg8::gemm_phase<EpiOut, false, true, true>(lds, g, S, E, (float*)(ws + WS_WIN), (unsigned*)ws + CW_TK6);
    }
    SEAM(6);
    if (IN(7)) { if ((REP_MASK >> 7) & 1) { final_phase(P_HERE, G, (float*)(ws + WS_Z)); xcd_barrier(bar); }
        final_phase(P_HERE, G); }
#undef IN
#undef SEAM
}

extern "C" void kernel_launch(void* const* d_in, const int* in_sizes, int n_in, void* d_out, int out_size, void* d_ws, size_t ws_size, hipStream_t stream) {
    static int grid = 0;
    if (grid == 0) {
        if (n_in != 26 || (size_t)out_size != O_END || ws_size < WS_END) { fprintf(stderr, "kernel_launch: unexpected problem (n_in %d, out %d, ws %zu; need ws >= %zu)\n", n_in, out_size, ws_size, (size_t)WS_END); grid = -1; return; }
        int dev = 0, cus = 0, per_cu = 0;
        hipGetDevice(&dev); hipDeviceGetAttribute(&cus, hipDeviceAttributeMultiprocessorCount, dev);
        if (hipFuncSetAttribute((const void*)hymba_fwd, hipFuncAttributeMaxDynamicSharedMemorySize, LDS_BYTES) != hipSuccess) { fprintf(stderr, "kernel_launch: hipFuncSetAttribute failed\n"); grid = -1; return; }
        if (hipOccupancyMaxActiveBlocksPerMultiprocessor(&per_cu, (const void*)hymba_fwd, 512, LDS_BYTES) != hipSuccess || per_cu < 1) { fprintf(stderr, "kernel_launch: occupancy query says %d\n", per_cu); grid = -1; return; }
        if (cus < GRID) { fprintf(stderr, "kernel_launch: built for a %d-CU device, found %d CUs\n", GRID, cus); grid = -1; return; }
        grid = GRID;
    }
    if (grid < 0) return;
    Params p{};
    const float** f = (const float**)&p;
    for (int i = 0; i < 26; ++i) f[i] = (const float*)d_in[i];
    p.out = (float*)d_out; p.ws = (unsigned char*)d_ws;
    if (hipMemsetAsync(d_ws, 0, CTL_WORDS * 4, stream) != hipSuccess) { fprintf(stderr, "kernel_launch: memset failed\n"); return; }
    if (MK_N_LAUNCHES == 1) {
        p.ph_lo = 0; p.ph_hi = N_PHASES;
        hipLaunchKernelGGL(hymba_fwd, dim3(grid), dim3(512), LDS_BYTES, stream, p);
    } else {
        for (int k = 0; k < N_PHASES; ++k) { p.ph_lo = k; p.ph_hi = k + 1; hipLaunchKernelGGL(hymba_fwd, dim3(grid), dim3(512), LDS_BYTES, stream, p); }
    }
}
```

```cpp
#include <hip/hip_runtime.h>
#include <cstdio>

#ifndef REP_MASK
#define REP_MASK 0x00
#endif
#ifndef MK_N_LAUNCHES
#define MK_N_LAUNCHES 1
#endif

#define LAS __attribute__((address_space(3)))
#define CAS __attribute__((address_space(4)))
typedef unsigned short bf16_t;
typedef short bf16x8 __attribute__((ext_vector_type(8)));
typedef float f32x4 __attribute__((ext_vector_type(4)));
typedef unsigned u32x4 __attribute__((ext_vector_type(4)));
typedef unsigned u32x2 __attribute__((ext_vector_type(2)));

constexpr int D = 2048, NMETA = 16, SEQ = 2048, TP = SEQ + NMETA, NB = 4, MPR = NB * TP;
constexpr int NS = 128, TS = 8, MSR = NS * TS, M = MPR + MSR;
constexpr int MP = 9472;
constexpr int DA = 1536, DB = 1024, DIN = 6144, DMIX = 2560, DFF = 6144, NH = 12;
constexpr float EPS = 1e-6f;
constexpr int NCH = 33;
constexpr size_t O_YP = 0, O_YS = O_YP + (size_t)NB * SEQ * D, O_PH = O_YS + (size_t)MSR * D, O_PRC = O_PH + NB * DA,
                 O_PSC = O_PRC + NB * 3 * DA, O_PFC = O_PSC + NB * 2 * DB, O_SH = O_PFC + NB * 2 * DFF, O_SRC = O_SH + NS * DA,
                 O_SSC = O_SRC + (size_t)NS * 3 * DA, O_SFC = O_SSC + (size_t)NS * 2 * DB, O_END = O_SFC + (size_t)NS * 2 * DFF;
constexpr size_t MiB = 1u << 20;
constexpr int CW_TK6 = 4096, CTL_WORDS = 4096 + 256 * 64;
constexpr int P6_SPLIT = 4, P4_SPLIT = 4, CW_TK4 = CW_TK6 + 64 * 64;
constexpr int GRID = 256;
constexpr size_t WS_WIN = 1 * MiB;
constexpr size_t WS_WO = WS_WIN + (size_t)DIN * D * 2;
constexpr size_t WS_WUP = WS_WO + (size_t)D * DMIX * 2;
constexpr size_t WS_WDN = WS_WUP + (size_t)2 * DFF * D * 2;
constexpr size_t WS_WG = WS_WDN + (size_t)D * DFF * 2;
constexpr size_t WS_XB = WS_WG + (size_t)2 * NH * 128 * 128 * 2;
constexpr size_t XB_ROWS = 9600;
constexpr size_t WS_Z = WS_XB + XB_ROWS * D * 2;
constexpr size_t WS_YM = WS_Z + (size_t)MP * DIN * 2;
constexpr size_t WS_RS1 = WS_YM + (size_t)MP * DMIX * 2;
constexpr size_t WS_SSQ = WS_RS1 + (size_t)MP * 4;
constexpr size_t WS_TOT = WS_SSQ + (size_t)MP * 32 * 4;
constexpr size_t WS_END = WS_TOT + (size_t)NB * NCH * DA * 2 * 4;

struct Params;
typedef const CAS Params& PRef;
struct Params {
    const float *x_prompt, *x_sample, *st_h, *st_rc, *st_sc, *st_fc, *meta, *g_mix, *w_in, *conv_a_w, *conv_a_b, *w_gate_a, *b_gate_a,
        *w_gate_x, *b_gate_x, *lam, *conv_b_w, *g_out_a, *g_out_b, *w_o, *g_ffn, *w_up, *conv_f_w, *conv_f_b, *w_down, *g_final;
    float* out; unsigned char* ws; int ph_lo, ph_hi;
};

__device__ __forceinline__ unsigned cvt_pk_bf16(float lo, float hi) { unsigned r; asm volatile("v_cvt_pk_bf16_f32 %0, %1, %2" : "=v"(r) : "v"(lo), "v"(hi)); return r; }
__device__ __forceinline__ float bf_lo(unsigned w) { return __builtin_bit_cast(float, w << 16); }
__device__ __forceinline__ float bf_hi(unsigned w) { return __builtin_bit_cast(float, w & 0xffff0000u); }
__device__ __forceinline__ void unpack8(const u32x4 w, float (&f)[8]) { f[0] = bf_lo(w.x); f[1] = bf_hi(w.x); f[2] = bf_lo(w.y); f[3] = bf_hi(w.y); f[4] = bf_lo(w.z); f[5] = bf_hi(w.z); f[6] = bf_lo(w.w); f[7] = bf_hi(w.w); }
__device__ __forceinline__ u32x4 pack8(const float (&f)[8]) { u32x4 w; w.x = cvt_pk_bf16(f[0], f[1]); w.y = cvt_pk_bf16(f[2], f[3]); w.z = cvt_pk_bf16(f[4], f[5]); w.w = cvt_pk_bf16(f[6], f[7]); return w; }
__device__ __forceinline__ float wave_sum(float v) {
#pragma unroll
    for (int o = 1; o < 64; o <<= 1) v += __shfl_xor(v, o);
    return v;
}
__device__ __forceinline__ float sum16(float v) {
    v += __shfl_xor(v, 1); v += __shfl_xor(v, 2); v += __shfl_xor(v, 4); v += __shfl_xor(v, 8); return v;
}
__device__ __forceinline__ float sigmoidf_(float x) { return __builtin_amdgcn_rcpf(1.0f + __expf(-x)); }
__device__ __forceinline__ float gelu_tanh(float x) {
    const float t = x * (1.0f + 0.044715f * x * x) * (-2.0f * 0.7978845608028654f * 1.4426950408889634f);
    return x * __builtin_amdgcn_rcpf(1.0f + __builtin_amdgcn_exp2f(t));
}
__device__ __forceinline__ int opaque_tid() { int t = threadIdx.x; asm volatile("" : "+v"(t)); return t; }
template <int CTRL> __device__ __forceinline__ float dppf(float old, float src) {
    return __builtin_bit_cast(float, __builtin_amdgcn_update_dpp(__builtin_bit_cast(int, old), __builtin_bit_cast(int, src), CTRL, 0xF, 0xF, false));
}
__device__ __forceinline__ void row_decode(int r, int& is_s, int& seq, int& t) {
    if (r < MPR) { seq = (r >= TP) + (r >= 2 * TP) + (r >= 3 * TP); t = r - seq * TP; is_s = 0; }
    else { const int q = r - MPR; seq = q >> 3; t = q & 7; is_s = 1; }
}
__device__ __forceinline__ const float* x_row_ptr(const float* xp, const float* xs, const float* meta, int r) {
    int is_s, seq, t; row_decode(r, is_s, seq, t);
    if (is_s) return xs + (size_t)(r - MPR) * D;
    return t < NMETA ? meta + (size_t)t * D : xp + ((size_t)seq * SEQ + (t - NMETA)) * D;
}
__device__ __forceinline__ float* y_row_ptr(float* out, int r) {
    if (r >= M) return nullptr;
    int is_s, seq, t; row_decode(r, is_s, seq, t);
    if (is_s) return out + O_YS + (size_t)(r - MPR) * D;
    return t < NMETA ? nullptr : out + O_YP + ((size_t)seq * SEQ + (t - NMETA)) * D;
}

namespace pg8 {
constexpr int BM = 256, BK = 64, HALF = 128, HTB = HALF * BK * 2, STAGE_BYTES = 8 * HTB, NXCD = 8, WGM = 2;
__host__ __device__ __forceinline__ int lds_byte(int r, int c) { const int st = (r >> 4) * 2 + (c >> 5), rr = r & 15, cc = c & 31, ob = rr * 64 + cc * 2; return st * 1024 + (ob ^ (((ob >> 9) & 1) << 5)); }
__host__ __device__ __forceinline__ void stage_rc(int b, int& R, int& C) { const int st = b / 1024, sb = b % 1024, swz = sb ^ (((sb >> 9) & 1) << 5); R = (st >> 1) * 16 + swz / 64; C = (st & 1) * 32 + (swz % 64) / 2; }
struct Unit { int pm, pn, kb, nk, piece, lu, idx; };
struct Gemm { const bf16_t* A; const bf16_t* Bt; int nM, nN, K; size_t a_tstep, a_hstep; };
struct StaticOrder {
    int nM, nN, nwg, G, c, nt, split, nfull, nleft, limit = 1 << 20, first = 0;
    __device__ __forceinline__ void init(int nM_, int nN_, int G_, int c_, int nt_, int split_) { nM = nM_; nN = nN_; nwg = nM * nN; G = G_; c = c_; nt = nt_; nfull = (nwg / G) * G; nleft = nwg - nfull;
        split = (split_ > 1 && nleft > 0 && nleft * split_ <= G && (nt / split_) * split_ == nt && ((nt / split_) & 1) == 0) ? split_ : 1; }
    __device__ __forceinline__ void map(int L, Unit& u) const {
        int wgid = L; { const int q = nwg / NXCD, r = nwg % NXCD, xcd = wgid % NXCD, off = wgid / NXCD; wgid = (xcd < r ? xcd * (q + 1) : r * (q + 1) + (xcd - r) * q) + off; }
        const int nig = WGM * nN, gid = wgid / nig, rem = wgid - gid * nig, fm = gid * WGM, glast = nM % WGM;
        if (nM - fm >= WGM || glast == 0) { u.pm = fm + (rem & (WGM - 1)); u.pn = rem / WGM; }
        else { u.pm = fm + rem % glast; u.pn = rem / glast; }
    }
    __device__ __forceinline__ bool next(int i, Unit& u) const {
        u.kb = 0; u.nk = nt; u.piece = -1; u.lu = 0; u.idx = i;
        i += first; if (i >= limit) return false;
        const long L = (long)i * G + c;
        if (L < nfull || split == 1) { if (L >= nwg) return false; map((int)L, u); return true; }
        if (L >= nfull + G || c >= nleft * split) return false;
        u.lu = c % nleft; u.piece = c / nleft; u.nk = nt / split; u.kb = u.piece * u.nk; map(nfull + u.lu, u); return true;
    }
};

template <int P, int A, int Mi>
__device__ __forceinline__ void reduce_rowgroup(f32x4 (&acc)[2][2][4][2], const float* slab0, int tid) {
    const float* sp = slab0 + (size_t)((A * 4 + Mi) * 4) * 8192 + tid * 4;
#pragma unroll
    for (int b = 0; b < 2; ++b)
#pragma unroll
        for (int n = 0; n < 2; ++n) {
            f32x4 sum = (f32x4){0.f, 0.f, 0.f, 0.f};
#pragma unroll
            for (int src = 0; src < 4; ++src) { if (src == P) sum += acc[A][b][Mi][n]; else sum += *(const f32x4*)(sp + (size_t)src * 8192 + (b * 2 + n) * 2048); }
            acc[A][b][Mi][n] = sum;
        }
}
template <class Epi, bool FFNMAP, bool ALIGN_EPI, bool SP2>
__device__ __forceinline__ void gemm_phase(LAS unsigned char* lds, const Gemm g, const StaticOrder& S, const Epi& E, float* slabs, unsigned* tickets, bool dry = false) {
    int tid = threadIdx.x; asm volatile("" : "+v"(tid));
    const int wid = __builtin_amdgcn_readfirstlane(tid >> 6), lane = tid & 63, wr = wid >> 2, wc = wid & 3, fr = lane & 15, fq = lane >> 4;
    const int K = g.K;
    unsigned voffA[2], voffB[2];
#pragma unroll
    for (int i = 0; i < 2; ++i) { int R, C; stage_rc(tid * 16 + i * 8192, R, C); const int Ra = FFNMAP ? (126 * (R >> 6) + (R & 63)) : R;
        voffA[i] = (unsigned)(Ra * K + C) * 2u; voffB[i] = (unsigned)(R * K + C) * 2u; }
    const size_t kstep = (size_t)(BK * 2);
    const size_t hstepA = g.a_hstep, tstepA = g.a_tstep;
    const size_t hstepB = (size_t)HALF * K * 2, tstepB = 2 * hstepB;
    const unsigned ldsw = (unsigned)wid * 1024u;
    const int aoff = lds_byte(wr * 64 + fr, fq * 8), boff = lds_byte(wc * 32 + fr, fq * 8);
#define PG8_SA(b, h) (((b) * 2 + (h)) * HTB)
#define PG8_SB(b, h) ((4 + (b) * 2 + (h)) * HTB)
#define PG8_STAGE(bufoff, gbase, voff) do { _Pragma("unroll") for (int _i = 0; _i < 2; ++_i) \
        __builtin_amdgcn_global_load_lds((const unsigned*)((const char*)(gbase) + (voff)[_i]), (LAS unsigned*)(lds + (bufoff) + ldsw + _i * 8192), 16, 0, 0); } while (0)
#define PG8_LDA(dst, b, h) do { _Pragma("unroll") for (int m = 0; m < 4; ++m) _Pragma("unroll") for (int k = 0; k < 2; ++k) dst[m][k] = *(const LAS bf16x8*)(lds + PG8_SA(b, h) + aoff + m * 2048 + k * 1024); } while (0)
#define PG8_LDB(dst, b, h) do { _Pragma("unroll") for (int n = 0; n < 2; ++n) _Pragma("unroll") for (int k = 0; k < 2; ++k) dst[n][k] = *(const LAS bf16x8*)(lds + PG8_SB(b, h) + boff + n * 2048 + k * 1024); } while (0)
#define PG8_MMA(ai, bj, At, Bt) do { __builtin_amdgcn_s_setprio(1); _Pragma("unroll") for (int m = 0; m < 4; ++m) _Pragma("unroll") for (int n = 0; n < 2; ++n) _Pragma("unroll") for (int k = 0; k < 2; ++k) \
        acc[ai][bj][m][n] = __builtin_amdgcn_mfma_f32_16x16x32_bf16(Bt[n][k], At[m][k], acc[ai][bj][m][n], 0, 0, 0); __builtin_amdgcn_s_setprio(0); } while (0)
#define PG8_WAIT_V(n) asm volatile("s_waitcnt vmcnt(" #n ")" ::: "memory")
#define PG8_WAIT_L(n) asm volatile("s_waitcnt lgkmcnt(" #n ")" ::: "memory")
#define PG8_BAR __builtin_amdgcn_s_barrier()
#define PG8_SCHED __builtin_amdgcn_sched_barrier(0)
    Unit cur, nxt; int ui = 0;
    if (!S.next(0, cur)) return;
    f32x4 acc[2][2][4][2];
#pragma unroll
    for (int a = 0; a < 2; ++a)
#pragma unroll
        for (int b = 0; b < 2; ++b)
#pragma unroll
            for (int m = 0; m < 4; ++m)
#pragma unroll
                for (int n = 0; n < 2; ++n) acc[a][b][m][n] = (f32x4){0.f, 0.f, 0.f, 0.f};
    bf16x8 At[4][2], B0[2][2], B1[2][2];
    const char* cA = (const char*)g.A + (size_t)cur.pm * tstepA + (size_t)cur.kb * kstep; const char* cB = (const char*)g.Bt + (size_t)cur.pn * tstepB + (size_t)cur.kb * kstep;
    if constexpr (SP2) {
        PG8_STAGE(PG8_SB(0, 0), cB, voffB); PG8_STAGE(PG8_SB(0, 1), cB + hstepB, voffB); PG8_STAGE(PG8_SA(0, 0), cA, voffA); PG8_STAGE(PG8_SA(0, 1), cA + hstepA, voffA);
        if (wr == 1) PG8_BAR;
        PG8_WAIT_V(2); PG8_BAR;
        PG8_STAGE(PG8_SB(1, 0), cB + kstep, voffB); PG8_STAGE(PG8_SA(1, 0), cA + kstep, voffA); PG8_STAGE(PG8_SB(1, 1), cB + hstepB + kstep, voffB);
        PG8_WAIT_V(6); PG8_BAR;
    } else {
        PG8_STAGE(PG8_SB(0, 0), cB, voffB); PG8_STAGE(PG8_SA(0, 0), cA, voffA); PG8_STAGE(PG8_SB(0, 1), cB + hstepB, voffB); PG8_STAGE(PG8_SA(0, 1), cA + hstepA, voffA);
        if (wr == 1) PG8_BAR;
        PG8_WAIT_V(4); PG8_BAR;
        PG8_STAGE(PG8_SB(1, 0), cB + kstep, voffB); PG8_STAGE(PG8_SA(1, 0), cA + kstep, voffA); PG8_STAGE(PG8_SB(1, 1), cB + hstepB + kstep, voffB);
        PG8_WAIT_V(6); PG8_BAR;
    }
    for (;;) {
        const bool has_next = S.next(ui + 1, nxt);
        const char* nA = has_next ? (const char*)g.A + (size_t)nxt.pm * tstepA + (size_t)nxt.kb * kstep : cA; const char* nB = has_next ? (const char*)g.Bt + (size_t)nxt.pn * tstepB + (size_t)nxt.kb * kstep : cB;
        const int nt = cur.nk;
        for (int t = 0; t < nt; t += 2) {
            const bool last = (t == nt - 2);
            const char* a1 = cA + (size_t)(t + 1) * kstep;
            const char* a2 = last ? nA : cA + (size_t)(t + 2) * kstep; const char* b2 = last ? nB : cB + (size_t)(t + 2) * kstep;
            const char* a3 = a2 + kstep; const char* b3 = b2 + kstep;
            if constexpr (SP2) {
            PG8_LDB(B0, 0, 0); PG8_LDB(B1, 0, 1); PG8_SCHED; PG8_LDA(At, 0, 0); PG8_STAGE(PG8_SA(1, 1), a1 + hstepA, voffA);
            PG8_WAIT_V(8); PG8_WAIT_L(0); PG8_BAR; PG8_MMA(0, 0, At, B0); PG8_MMA(0, 1, At, B1); PG8_BAR; PG8_SCHED;
            PG8_LDA(At, 0, 1); PG8_STAGE(PG8_SB(0, 0), b2, voffB); PG8_STAGE(PG8_SB(0, 1), b2 + hstepB, voffB); PG8_STAGE(PG8_SA(0, 0), a2, voffA);
            PG8_WAIT_V(8); PG8_WAIT_L(0); PG8_BAR; PG8_MMA(1, 0, At, B0); PG8_MMA(1, 1, At, B1); PG8_BAR; PG8_SCHED;
            PG8_LDB(B0, 1, 0); PG8_LDB(B1, 1, 1); PG8_SCHED; PG8_LDA(At, 1, 0); PG8_STAGE(PG8_SA(0, 1), a2 + hstepA, voffA);
            PG8_WAIT_V(8); PG8_WAIT_L(0); PG8_BAR; PG8_MMA(0, 0, At, B0); PG8_MMA(0, 1, At, B1); PG8_BAR; PG8_SCHED;
            PG8_LDA(At, 1, 1); PG8_STAGE(PG8_SB(1, 0), b3, voffB); PG8_STAGE(PG8_SB(1, 1), b3 + hstepB, voffB); PG8_STAGE(PG8_SA(1, 0), a3, voffA);
            PG8_WAIT_V(8); PG8_WAIT_L(0); PG8_BAR; PG8_MMA(1, 0, At, B0); PG8_MMA(1, 1, At, B1); PG8_BAR; PG8_SCHED;
            } else {
            PG8_LDB(B0, 0, 0); PG8_SCHED; PG8_LDA(At, 0, 0); PG8_STAGE(PG8_SA(1, 1), a1 + hstepA, voffA);
            PG8_WAIT_L(8); PG8_BAR; PG8_WAIT_L(0); PG8_MMA(0, 0, At, B0); PG8_BAR; PG8_SCHED;
            PG8_LDB(B1, 0, 1); PG8_STAGE(PG8_SB(0, 0), b2, voffB);
            PG8_BAR; PG8_WAIT_L(0); PG8_MMA(0, 1, At, B1); PG8_BAR;
            PG8_LDA(At, 0, 1); PG8_STAGE(PG8_SA(0, 0), a2, voffA);
            PG8_BAR; PG8_WAIT_L(0); PG8_MMA(1, 0, At, B0); PG8_BAR; PG8_SCHED;
            PG8_STAGE(PG8_SB(0, 1), b2 + hstepB, voffB);
            PG8_WAIT_V(6); PG8_BAR; PG8_MMA(1, 1, At, B1); PG8_BAR;
            PG8_LDB(B0, 1, 0); PG8_SCHED; PG8_LDA(At, 1, 0); PG8_STAGE(PG8_SA(0, 1), a2 + hstepA, voffA);
            PG8_WAIT_L(8); PG8_BAR; PG8_WAIT_L(0); PG8_MMA(0, 0, At, B0); PG8_BAR; PG8_SCHED;
            PG8_LDB(B1, 1, 1); PG8_STAGE(PG8_SB(1, 0), b3, voffB);
            PG8_BAR; PG8_WAIT_L(0); PG8_MMA(0, 1, At, B1); PG8_BAR;
            PG8_LDA(At, 1, 1); PG8_STAGE(PG8_SA(1, 0), a3, voffA);
            PG8_BAR; PG8_WAIT_L(0); PG8_MMA(1, 0, At, B0); PG8_BAR; PG8_SCHED;
            PG8_STAGE(PG8_SB(1, 1), b3 + hstepB, voffB);
            PG8_WAIT_V(6); PG8_BAR; PG8_MMA(1, 1, At, B1); PG8_BAR;
            }
        }
        if constexpr (ALIGN_EPI) { if (wr == 0) PG8_BAR; }
        if (cur.piece < 0 && !dry) E(acc, cur, wr, wc, fr, fq);
        if (!has_next) break;
#pragma unroll
        for (int a = 0; a < 2; ++a)
#pragma unroll
            for (int b = 0; b < 2; ++b)
#pragma unroll
                for (int m = 0; m < 4; ++m)
#pragma unroll
                    for (int n = 0; n < 2; ++n) acc[a][b][m][n] = (f32x4){0.f, 0.f, 0.f, 0.f};
        cur = nxt; cA = nA; cB = nB; ++ui;
        if constexpr (ALIGN_EPI) { if (wr == 1) PG8_BAR; }
    }
    PG8_WAIT_V(0);
    if constexpr (!ALIGN_EPI) { if (wr == 0) PG8_BAR; }
    PG8_BAR;
    if constexpr (Epi::SPLIT) {
    if (cur.piece >= 0 && !dry) {
        float* slab0 = slabs + (size_t)cur.lu * (8 * 4 * 8192);
        {
            const __amdgpu_buffer_rsrc_t rs = __builtin_amdgcn_make_buffer_rsrc((void*)slab0, (short)0, 8 * 4 * 32768, 0x00020000);
#pragma unroll
            for (int a = 0; a < 2; ++a)
#pragma unroll
                for (int m = 0; m < 4; ++m) {
                    const int gq = a * 4 + m;
                    if ((gq >> 1) != cur.piece) {
#pragma unroll
                        for (int b = 0; b < 2; ++b)
#pragma unroll
                            for (int n = 0; n < 2; ++n) __builtin_amdgcn_raw_buffer_store_b128(__builtin_bit_cast(u32x4, acc[a][b][m][n]), rs, (gq * 4 + cur.piece) * 32768 + (b * 2 + n) * 8192 + tid * 16, 0, 16);
                    }
                }
        }
        asm volatile("s_waitcnt vmcnt(0)" ::: "memory");
        __syncthreads();
        if (tid == 0) {
            __hip_atomic_fetch_add(tickets + 64 * cur.lu, 1u, __ATOMIC_RELAXED, __HIP_MEMORY_SCOPE_AGENT);
            unsigned sp = 0;
            while (__hip_atomic_load(tickets + 64 * cur.lu, __ATOMIC_RELAXED, __HIP_MEMORY_SCOPE_AGENT) < 4u) { __builtin_amdgcn_s_sleep(2); if (++sp > (1u << 20)) break; }
            __builtin_amdgcn_fence(__ATOMIC_ACQUIRE, "agent"); asm volatile("s_waitcnt vmcnt(0)" ::: "memory");
        }
        __syncthreads();
        switch (cur.piece) {
            case 0: reduce_rowgroup<0, 0, 0>(acc, slab0, tid); reduce_rowgroup<0, 0, 1>(acc, slab0, tid); break;
            case 1: reduce_rowgroup<1, 0, 2>(acc, slab0, tid); reduce_rowgroup<1, 0, 3>(acc, slab0, tid); break;
            case 2: reduce_rowgroup<2, 1, 0>(acc, slab0, tid); reduce_rowgroup<2, 1, 1>(acc, slab0, tid); break;
            default: reduce_rowgroup<3, 1, 2>(acc, slab0, tid); reduce_rowgroup<3, 1, 3>(acc, slab0, tid); break;
        }
        E(acc, cur, wr, wc, fr, fq, 3u << (2 * cur.piece));
    }
    }
#undef PG8_SA
#undef PG8_SB
#undef PG8_STAGE
#undef PG8_LDA
#undef PG8_LDB
#undef PG8_MMA
#undef PG8_WAIT_V
#undef PG8_WAIT_L
#undef PG8_BAR
#undef PG8_SCHED
}
}

typedef f32x4 Acc[2][2][4][2];

struct EpiZ {
    static constexpr bool SPLIT = false;
    const float* rstd1; bf16_t* z; float* out;
    __device__ __forceinline__ void operator()(const Acc& acc, const pg8::Unit& u, int wr, int wc, int fr, int fq) const {
        asm volatile("" : "+v"(fr), "+v"(fq));
        const int col0 = u.pn * 256 + wc * 32 + 8 * fq;
#pragma unroll
        for (int ai = 0; ai < 2; ++ai)
#pragma unroll
            for (int m = 0; m < 4; ++m) {
                const int r = u.pm * 256 + ai * 128 + wr * 64 + m * 16 + fr;
                if (r < M) {
                    const float rs = rstd1[r];
                    int is_s, seq, t; row_decode(r, is_s, seq, t);
                    float* so = nullptr;
                    if (u.pn < 6) { if (is_s) { if (t >= TS - 3) so = out + O_SRC + ((size_t)seq * 3 + (t - (TS - 3))) * DA; } else { if (t >= TP - 3) so = out + O_PRC + ((size_t)seq * 3 + (t - (TP - 3))) * DA; } }
#pragma unroll
                    for (int bj = 0; bj < 2; ++bj) {
                        const f32x4 v0 = acc[ai][bj][m][0] * rs, v1 = acc[ai][bj][m][1] * rs;
                        u32x4 w; w.x = cvt_pk_bf16(v0[0], v0[1]); w.y = cvt_pk_bf16(v0[2], v0[3]); w.z = cvt_pk_bf16(v1[0], v1[1]); w.w = cvt_pk_bf16(v1[2], v1[3]);
                        *(u32x4*)(z + (size_t)r * DIN + col0 + bj * 128) = w;
                        if (so) { *(f32x4*)(so + col0 + bj * 128) = v0; *(f32x4*)(so + col0 + bj * 128 + 4) = v1; }
                    }
                }
            }
    }
};
struct EpiX1 {
    static constexpr bool SPLIT = true;
    const float *xp, *xs, *meta; bf16_t* x1b; float* ssq;
    __device__ __forceinline__ void operator()(const Acc& acc, const pg8::Unit& u, int wr, int wc, int fr, int fq, unsigned gmask = 0xffu) const {
        asm volatile("" : "+v"(fr), "+v"(fq));
        const int col0 = u.pn * 256 + wc * 32 + 8 * fq;
#pragma unroll
        for (int ai = 0; ai < 2; ++ai) {
            if (!((gmask >> (ai * 4)) & 0xfu)) continue;
            f32x4 xv[4][2][2];
#pragma unroll
            for (int m = 0; m < 4; ++m) {
                const int r = u.pm * 256 + ai * 128 + wr * 64 + m * 16 + fr;
                const float* xr = x_row_ptr(xp, xs, meta, r < M ? r : 0) + col0;
#pragma unroll
                for (int bj = 0; bj < 2; ++bj) { xv[m][bj][0] = *(const f32x4*)(xr + bj * 128); xv[m][bj][1] = *(const f32x4*)(xr + bj * 128 + 4); }
            }
#pragma unroll
            for (int m = 0; m < 4; ++m) {
                if (!((gmask >> (ai * 4 + m)) & 1u)) continue;
                const int r = u.pm * 256 + ai * 128 + wr * 64 + m * 16 + fr;
                const bool valid = r < M;
                float ss = 0.f;
#pragma unroll
                for (int bj = 0; bj < 2; ++bj) {
                    const int c = col0 + bj * 128;
                    const f32x4 v0 = acc[ai][bj][m][0] + xv[m][bj][0], v1 = acc[ai][bj][m][1] + xv[m][bj][1];
                    ss += (v0[0] * v0[0] + v0[1] * v0[1]) + (v0[2] * v0[2] + v0[3] * v0[3]) + (v1[0] * v1[0] + v1[1] * v1[1]) + (v1[2] * v1[2] + v1[3] * v1[3]);
                    if (valid) { u32x4 w; w.x = cvt_pk_bf16(v0[0], v0[1]); w.y = cvt_pk_bf16(v0[2], v0[3]); w.z = cvt_pk_bf16(v1[0], v1[1]); w.w = cvt_pk_bf16(v1[2], v1[3]);
                        *(u32x4*)(x1b + (size_t)r * D + c) = w; }
                }
                ss += __shfl_xor(ss, 16); ss += __shfl_xor(ss, 32);
                if (valid && fq == 0) ssq[(size_t)r * 32 + u.pn * 4 + wc] = ss;
            }
        }
    }
};
struct EpiOut {
    static constexpr bool SPLIT = true;
    const bf16_t* x1b; bf16_t* x2b;
    __device__ __forceinline__ void operator()(const Acc& acc, const pg8::Unit& u, int wr, int wc, int fr, int fq, unsigned gmask = 0xffu) const {
        asm volatile("" : "+v"(fr), "+v"(fq));
        const int col0 = u.pn * 256 + wc * 32 + 8 * fq;
#pragma unroll
        for (int ai = 0; ai < 2; ++ai) {
            if (!((gmask >> (ai * 4)) & 0xfu)) continue;
            u32x4 xv[4][2];
#pragma unroll
            for (int m = 0; m < 4; ++m) {
                const int r = u.pm * 256 + ai * 128 + wr * 64 + m * 16 + fr;
                const bf16_t* xr = x1b + (size_t)(r < M ? r : 0) * D + col0;
#pragma unroll
                for (int bj = 0; bj < 2; ++bj) xv[m][bj] = *(const u32x4*)(xr + bj * 128);
            }
#pragma unroll
            for (int m = 0; m < 4; ++m) {
                if (!((gmask >> (ai * 4 + m)) & 1u)) continue;
                const int r = u.pm * 256 + ai * 128 + wr * 64 + m * 16 + fr;
                if (r < M) {
#pragma unroll
                    for (int bj = 0; bj < 2; ++bj) {
                        float xf[8]; unpack8(xv[m][bj], xf);
                        const f32x4 a0 = acc[ai][bj][m][0], a1 = acc[ai][bj][m][1];
                        u32x4 w; w.x = cvt_pk_bf16(a0[0] + xf[0], a0[1] + xf[1]); w.y = cvt_pk_bf16(a0[2] + xf[2], a0[3] + xf[3]); w.z = cvt_pk_bf16(a1[0] + xf[4], a1[1] + xf[5]); w.w = cvt_pk_bf16(a1[2] + xf[6], a1[3] + xf[7]);
                        *(u32x4*)(x2b + (size_t)r * D + col0 + bj * 128) = w;
                    }
                }
            }
        }
    }
};
struct EpiFFN {
    static constexpr bool SPLIT = false;
    const float *cw, *cb, *st_fc; bf16_t* hid; float* out; const LAS float* rstab;
    __device__ __forceinline__ void operator()(Acc& acc, const pg8::Unit& u, int wr, int wc, int fr, int fq) const {
        asm volatile("" : "+v"(fr), "+v"(fq));
        const int gbase = 252 * u.pm - 2 + 126 * wr;
        const int f0 = 128 * u.pn + 32 * wc + 8 * fq;
        const f32x4 w0a = *(const f32x4*)(cw + f0), w0b = *(const f32x4*)(cw + f0 + 4);
        const f32x4 w1a = *(const f32x4*)(cw + DFF + f0), w1b = *(const f32x4*)(cw + DFF + f0 + 4);
        const f32x4 w2a = *(const f32x4*)(cw + 2 * DFF + f0), w2b = *(const f32x4*)(cw + 2 * DFF + f0 + 4);
        const f32x4 bba = *(const f32x4*)(cb + f0), bbb = *(const f32x4*)(cb + f0 + 4);
        const LAS float* rt = rstab + u.idx * 256 + wr * 128 + fr;
#pragma unroll
        for (int ai = 0; ai < 2; ++ai)
#pragma unroll
            for (int m = 0; m < 4; ++m) {
                const float rs = rt[64 * ai + 16 * m];
#pragma unroll
                for (int bj = 0; bj < 2; ++bj)
#pragma unroll
                    for (int n = 0; n < 2; ++n) acc[ai][bj][m][n] *= rs;
            }
        const bool has_samples = 252 * u.pm + 252 > MPR;
#pragma unroll
        for (int ai = 0; ai < 2; ++ai)
#pragma unroll
            for (int m = 0; m < 4; ++m) {
                const int j = 64 * ai + 16 * m + fr, r = gbase + j;
                const bool valid = (j >= 2) && (r < M);
                const f32x4 c0 = acc[ai][0][m][0], c1 = acc[ai][0][m][1];
                const int pai = (m == 0) ? (ai == 0 ? 0 : ai - 1) : ai, pm_ = (m == 0) ? (ai == 0 ? 0 : 3) : m - 1;
                const f32x4 q0 = acc[pai][0][pm_][0], q1 = acc[pai][0][pm_][1];
                f32x4 p1a, p1b, p2a, p2b;
#pragma unroll
                for (int e = 0; e < 4; ++e) {
                    p1a[e] = dppf<0x111>(dppf<0x121>(0.f, q0[e]), c0[e]); p1b[e] = dppf<0x111>(dppf<0x121>(0.f, q1[e]), c1[e]);
                    p2a[e] = dppf<0x112>(dppf<0x122>(0.f, q0[e]), c0[e]); p2b[e] = dppf<0x112>(dppf<0x122>(0.f, q1[e]), c1[e]);
                }
                int is_s, seq, t; row_decode(valid ? r : 0, is_s, seq, t);
                if (!has_samples) {
                    const f32x4 zz = (f32x4){0.f, 0.f, 0.f, 0.f};
                    if (t == 0) { p1a = zz; p1b = zz; }
                    if (t < 2) { p2a = zz; p2b = zz; }
                } else if (valid && t < 2) {
                    f32x4 s0a = (f32x4){0.f, 0.f, 0.f, 0.f}, s0b = s0a, s1a = s0a, s1b = s0a;
                    if (is_s) { const float* sp = st_fc + (size_t)seq * 2 * DFF + f0; s0a = *(const f32x4*)sp; s0b = *(const f32x4*)(sp + 4); s1a = *(const f32x4*)(sp + DFF); s1b = *(const f32x4*)(sp + DFF + 4); }
                    if (t == 0) { p1a = s1a; p1b = s1b; p2a = s0a; p2b = s0b; } else { p2a = s1a; p2b = s1b; }
                }
                const f32x4 ga = w0a * p2a + w1a * p1a + w2a * c0 + bba, gb = w0b * p2b + w1b * p1b + w2b * c1 + bbb;
                const f32x4 va = acc[ai][1][m][0], vb = acc[ai][1][m][1];
                if (valid) {
                    u32x4 w;
                    w.x = cvt_pk_bf16(gelu_tanh(ga[0]) * va[0], gelu_tanh(ga[1]) * va[1]); w.y = cvt_pk_bf16(gelu_tanh(ga[2]) * va[2], gelu_tanh(ga[3]) * va[3]);
                    w.z = cvt_pk_bf16(gelu_tanh(gb[0]) * vb[0], gelu_tanh(gb[1]) * vb[1]); w.w = cvt_pk_bf16(gelu_tanh(gb[2]) * vb[2], gelu_tanh(gb[3]) * vb[3]);
                    *(u32x4*)(hid + (size_t)r * DFF + f0) = w;
                    const int T = is_s ? TS : TP;
                    if (t >= T - 2) { float* so = out + (is_s ? O_SFC : O_PFC) + ((size_t)seq * 2 + (t - (T - 2))) * DFF + f0; *(f32x4*)so = c0; *(f32x4*)(so + 4) = c1; }
                }
                if (m & 1) __builtin_amdgcn_sched_barrier(0);
            }
    }
};
__device__ __forceinline__ void ffn_rstd_table(const float* ssq, LAS float* tab, const pg8::StaticOrder& S) {
    const int tid = opaque_tid(), q = tid >> 1, half = tid & 1;
    pg8::Unit u;
    for (int i = 0; S.next(i, u); ++i) {
        int r = 252 * u.pm - 2 + 126 * (q >> 7) + (q & 127); r = r < 0 ? 0 : (r >= M ? M - 1 : r);
        const float* sp = ssq + (size_t)r * 32 + 16 * half;
        const f32x4 a = *(const f32x4*)sp, b = *(const f32x4*)(sp + 4), c = *(const f32x4*)(sp + 8), d = *(const f32x4*)(sp + 12);
        float sm = (((a[0] + a[1]) + (a[2] + a[3])) + ((b[0] + b[1]) + (b[2] + b[3]))) + (((c[0] + c[1]) + (c[2] + c[3])) + ((d[0] + d[1]) + (d[2] + d[3])));
        sm += __shfl_xor(sm, 1);
        if (half == 0) tab[i * 256 + q] = __builtin_amdgcn_rsqf(sm * (1.0f / D) + EPS);
    }
}

struct EpiProbe {
    static constexpr bool SPLIT = false;
    bf16_t* hid;
    __device__ __forceinline__ void operator()(const Acc& acc, const pg8::Unit& u, int wr, int wc, int fr, int fq) const {
        asm volatile("" : "+v"(fr), "+v"(fq));
        const int gbase = 252 * u.pm - 2 + 126 * wr, f0 = 128 * u.pn + 32 * wc + 8 * fq;
#pragma unroll
        for (int ai = 0; ai < 2; ++ai)
#pragma unroll
            for (int m = 0; m < 4; ++m) {
                const int j = 64 * ai + 16 * m + fr, r = gbase + j;
                if (j >= 2 && r < M) { const f32x4 a = acc[ai][0][m][0] + acc[ai][1][m][0], b = acc[ai][0][m][1] + acc[ai][1][m][1];
                    u32x4 w; w.x = cvt_pk_bf16(a[0], a[1]); w.y = cvt_pk_bf16(a[2], a[3]); w.z = cvt_pk_bf16(b[0], b[1]); w.w = cvt_pk_bf16(b[2], b[3]);
                    *(u32x4*)(hid + (size_t)r * DFF + f0) = w; }
            }
    }
};

__device__ __forceinline__ int invperm32(int q) { return 16 * ((q >> 2) & 1) + 4 * (q >> 3) + (q & 3); }
__device__ __forceinline__ void p0_transpose_item(const float* W, int K, int N, const float* kscale, bf16_t* WT, int mode, LAS float* scr, int item, int lane) {
    const int nblk = N / 32, kb = item / nblk, nb = item % nblk, k0 = 64 * kb, n0 = 32 * nb;
    float v[32];
    const float* src = W + (size_t)(k0 + (lane >> 5)) * N + n0 + (lane & 31);
#pragma unroll
    for (int i = 0; i < 32; ++i) v[i] = src[(size_t)(2 * i) * N];
#pragma unroll
    for (int i = 0; i < 32; ++i) scr[(2 * i + (lane >> 5)) * 33 + (lane & 31)] = v[i];
    asm volatile("s_waitcnt lgkmcnt(0)" ::: "memory");
    int rbase = n0;
    if (mode == 1) { const int bj = n0 >= DFF ? 1 : 0, f = n0 - bj * DFF; rbase = 256 * (f >> 7) + 128 * bj + (f & 96); }
    const int c = lane & 7;
    f32x4 ks0 = (f32x4){1.f, 1.f, 1.f, 1.f}, ks1 = ks0;
    if (kscale) { ks0 = *(const f32x4*)(kscale + k0 + 8 * c); ks1 = *(const f32x4*)(kscale + k0 + 8 * c + 4); }
#pragma unroll
    for (int j = 0; j < 4; ++j) { const int n = (lane >> 3) + 8 * j; const LAS float* sp = scr + (8 * c) * 33 + n;
        u32x4 o; o.x = cvt_pk_bf16(sp[0 * 33] * ks0[0], sp[1 * 33] * ks0[1]); o.y = cvt_pk_bf16(sp[2 * 33] * ks0[2], sp[3 * 33] * ks0[3]);
        o.z = cvt_pk_bf16(sp[4 * 33] * ks1[0], sp[5 * 33] * ks1[1]); o.w = cvt_pk_bf16(sp[6 * 33] * ks1[2], sp[7 * 33] * ks1[3]);
        *(u32x4*)(WT + (size_t)(rbase + (mode == 2 ? n : invperm32(n))) * K + k0 + 8 * c) = o; }
    asm volatile("s_waitcnt lgkmcnt(0)" ::: "memory");
}
constexpr int I_IN = (D / 64) * (DIN / 32), I_O = (DMIX / 64) * (D / 32), I_UP = (D / 64) * (2 * DFF / 32), I_DN = (DFF / 64) * (D / 32), I_G = 2 * NH * 8;
constexpr int IT_O = I_IN, IT_UP = IT_O + I_O, IT_DN = IT_UP + I_UP, IT_G = IT_DN + I_DN, IT_END = IT_G + I_G;
__device__ __forceinline__ void convert_items(PRef p, LAS unsigned char* lds, int rank, int nwaves, int lo, int hi) {
    const int tid_ = opaque_tid(), lane = tid_ & 63, wave = tid_ >> 6;
    unsigned char* ws = p.ws;
    LAS float* scr = (LAS float*)(lds + wave * 16384);
    for (int it = lo + rank; it < hi; it += nwaves) {
        int r = it;
        if (r < I_IN) { p0_transpose_item(p.w_in, D, DIN, p.g_mix, (bf16_t*)(ws + WS_WIN), 0, scr, r, lane); continue; } r -= I_IN;
        if (r < I_O) { p0_transpose_item(p.w_o, DMIX, D, nullptr, (bf16_t*)(ws + WS_WO), 0, scr, r, lane); continue; } r -= I_O;
        if (r < I_UP) { p0_transpose_item(p.w_up, D, 2 * DFF, p.g_ffn, (bf16_t*)(ws + WS_WUP), 1, scr, r, lane); continue; } r -= I_UP;
        if (r < I_DN) { p0_transpose_item(p.w_down, DFF, D, nullptr, (bf16_t*)(ws + WS_WDN), 0, scr, r, lane); continue; } r -= I_DN;
        { const int mat = r >> 3, sub = r & 7, gsel = mat / NH, n = mat % NH;
          p0_transpose_item((gsel ? p.w_gate_x : p.w_gate_a) + (size_t)n * 128 * 128, 128, 128, nullptr, (bf16_t*)(ws + WS_WG) + (size_t)mat * 128 * 128, 0, scr, sub, lane); }
    }
}
constexpr int P1_TAIL_WG0 = (888 % 256), P4_TAIL_WG0 = (296 % 256) * P4_SPLIT, MIX_IDLE_WG0 = 228, IT_S1 = IT_O + 10600, IT_S2 = IT_S1 + 1600, IT_S3 = IT_S2 + 1600;
__device__ __forceinline__ void phase0(PRef p, LAS unsigned char* lds, int G) {
    const int tid = opaque_tid(), lane = tid & 63, wave = tid >> 6;
    unsigned char* ws = p.ws;
    const int gw = blockIdx.x * 8 + wave, NGW = G * 8;
    convert_items(p, lds, gw, NGW, 0, IT_O);
    convert_items(p, lds, gw, NGW, IT_G, IT_END);
    { bf16_t* xb = (bf16_t*)(ws + WS_XB) + (size_t)16 * D; float* rstd1 = (float*)(ws + WS_RS1);
      for (int m = gw; m < M; m += NGW) {
          const f32x4* xr = (const f32x4*)x_row_ptr(p.x_prompt, p.x_sample, p.meta, m) + lane;
          f32x4 v[8]; float s = 0.f;
#pragma unroll
          for (int j = 0; j < 8; ++j) { v[j] = xr[64 * j]; s += (v[j][0] * v[j][0] + v[j][1] * v[j][1]) + (v[j][2] * v[j][2] + v[j][3] * v[j][3]); }
          s = wave_sum(s);
          if (lane == 0) rstd1[m] = __builtin_amdgcn_rsqf(s * (1.0f / D) + EPS);
          u32x2* o = (u32x2*)(xb + (size_t)m * D) + lane;
#pragma unroll
          for (int j = 0; j < 8; ++j) { u32x2 w; w.x = cvt_pk_bf16(v[j][0], v[j][1]); w.y = cvt_pk_bf16(v[j][2], v[j][3]); o[64 * j] = w; }
      } }
}

__device__ __forceinline__ void branch_b(PRef p, int G) {
    const bf16_t* z = (const bf16_t*)(p.ws + WS_Z); bf16_t* ym = (bf16_t*)(p.ws + WS_YM);
    const int total = (M / 4) * 128;
    for (int idx = blockIdx.x * 512 + opaque_tid(); idx < total; idx += G * 512) {
        const int m0 = (idx >> 7) * 4, g = idx & 127, ch = 8 * g;
        int is_s, seq, t0; row_decode(m0, is_s, seq, t0);
        u32x4 rc[6], rv[6], rg[4];
#pragma unroll
        for (int k = 0; k < 6; ++k) {
            const int mm = (t0 - 2 + k >= 0) ? m0 - 2 + k : m0;
            rc[k] = *(const u32x4*)(z + (size_t)mm * DIN + 4096 + ch); rv[k] = *(const u32x4*)(z + (size_t)mm * DIN + 5120 + ch);
        }
#pragma unroll
        for (int k = 0; k < 4; ++k) rg[k] = *(const u32x4*)(z + (size_t)(m0 + k) * DIN + 3072 + ch);
        const f32x4 w0a = *(const f32x4*)(p.conv_b_w + ch), w0b = *(const f32x4*)(p.conv_b_w + ch + 4), w1a = *(const f32x4*)(p.conv_b_w + DB + ch), w1b = *(const f32x4*)(p.conv_b_w + DB + ch + 4),
                    w2a = *(const f32x4*)(p.conv_b_w + 2 * DB + ch), w2b = *(const f32x4*)(p.conv_b_w + 2 * DB + ch + 4), goa = *(const f32x4*)(p.g_out_b + ch), gob = *(const f32x4*)(p.g_out_b + ch + 4);
        float u[6][8];
#pragma unroll
        for (int k = 0; k < 6; ++k) {
            float a[8], b[8]; unpack8(rc[k], a); unpack8(rv[k], b);
#pragma unroll
            for (int e = 0; e < 8; ++e) u[k][e] = a[e] * b[e];
        }
        if (t0 == 0) {
#pragma unroll
            for (int k = 0; k < 2; ++k) {
                f32x4 a = (f32x4){0.f, 0.f, 0.f, 0.f}, b = a;
                if (is_s) { const float* sp = p.st_sc + ((size_t)seq * 2 + k) * DB + ch; a = *(const f32x4*)sp; b = *(const f32x4*)(sp + 4); }
#pragma unroll
                for (int e = 0; e < 4; ++e) { u[k][e] = a[e]; u[k][4 + e] = b[e]; }
            }
        }
        const int T = is_s ? TS : TP;
#pragma unroll
        for (int k = 0; k < 4; ++k) {
            float gb[8]; unpack8(rg[k], gb);
            float y[8]; float ss = 0.f;
#pragma unroll
            for (int e = 0; e < 8; ++e) {
                const float uc = (e < 4 ? w0a[e & 3] : w0b[e & 3]) * u[k][e] + (e < 4 ? w1a[e & 3] : w1b[e & 3]) * u[k + 1][e] + (e < 4 ? w2a[e & 3] : w2b[e & 3]) * u[k + 2][e];
                y[e] = gb[e] * uc; ss += y[e] * y[e];
            }
            ss = sum16(ss);
            const float rn = __builtin_amdgcn_rsqf(ss * (1.0f / 128.0f) + EPS);
#pragma unroll
            for (int e = 0; e < 8; ++e) y[e] = y[e] * rn * (e < 4 ? goa[e & 3] : gob[e & 3]);
            *(u32x4*)(ym + (size_t)(m0 + k) * DMIX + DA + ch) = pack8(y);
            const int t = t0 + k;
            if (t >= T - 2) { float* so = p.out + (is_s ? O_SSC : O_PSC) + ((size_t)seq * 2 + (t - (T - 2))) * DB + ch;
                *(f32x4*)so = (f32x4){u[k + 2][0], u[k + 2][1], u[k + 2][2], u[k + 2][3]}; *(f32x4*)(so + 4) = (f32x4){u[k + 2][4], u[k + 2][5], u[k + 2][6], u[k + 2][7]}; }
        }
    }
}

constexpr int LW_STRIDE = 272, L_WA = 0, L_WX = 128 * LW_STRIDE, L_CT = 2 * 128 * LW_STRIDE, L_LRU_END = L_CT + 9 * 128 * 4;
static_assert(L_LRU_END <= 131072, "mixer LDS");
constexpr int LRU_WG_PER_HEAD = 19, LRU_NSEG = 33, LRU_PITEMS = NB * LRU_NSEG, LRU_SITEMS = MSR / 64;
static_assert(LRU_WG_PER_HEAD * 8 >= LRU_PITEMS + LRU_SITEMS, "waves per head");

template <int CTRL, int BANK> __device__ __forceinline__ float dppfb(float old, float src) {
    return __builtin_bit_cast(float, __builtin_amdgcn_update_dpp(__builtin_bit_cast(int, old), __builtin_bit_cast(int, src), CTRL, 0xF, BANK, false));
}
__device__ __forceinline__ float bcast15(float x, int lane) {
    return __builtin_bit_cast(float, __builtin_amdgcn_ds_bpermute(((lane & 48) | 15) << 2, __builtin_bit_cast(int, x)));
}
__device__ __forceinline__ void scan16(float& P, float& S) {
    float Sd, Pd;
    Sd = dppf<0x111>(0.f, S); Pd = dppf<0x111>(1.f, P); S = __builtin_fmaf(P, Sd, S); P *= Pd;
    Sd = dppf<0x112>(0.f, S); Pd = dppf<0x112>(1.f, P); S = __builtin_fmaf(P, Sd, S); P *= Pd;
    Sd = dppf<0x114>(0.f, S); Pd = dppf<0x114>(1.f, P); S = __builtin_fmaf(P, Sd, S); P *= Pd;
    Sd = dppf<0x118>(0.f, S); Pd = dppf<0x118>(1.f, P); S = __builtin_fmaf(P, Sd, S); P *= Pd;
}
__device__ __forceinline__ void scan16x2(float& P1, float& S1, float& P2, float& S2) {
    asm volatile(
        "s_nop 1\n\t"
        "v_fmac_f32_dpp %1, %1, %0 row_shr:1 row_mask:0xf bank_mask:0xf bound_ctrl:1\n\t"
        "v_fmac_f32_dpp %3, %3, %2 row_shr:1 row_mask:0xf bank_mask:0xf bound_ctrl:1\n\t"
        "v_mul_f32_dpp %0, %0, %0 row_shr:1 row_mask:0xf bank_mask:0xf\n\t"
        "v_mul_f32_dpp %2, %2, %2 row_shr:1 row_mask:0xf bank_mask:0xf\n\t"
        "v_fmac_f32_dpp %1, %1, %0 row_shr:2 row_mask:0xf bank_mask:0xf bound_ctrl:1\n\t"
        "v_fmac_f32_dpp %3, %3, %2 row_shr:2 row_mask:0xf bank_mask:0xf bound_ctrl:1\n\t"
        "v_mul_f32_dpp %0, %0, %0 row_shr:2 row_mask:0xf bank_mask:0xf\n\t"
        "v_mul_f32_dpp %2, %2, %2 row_shr:2 row_mask:0xf bank_mask:0xf\n\t"
        "v_fmac_f32_dpp %1, %1, %0 row_shr:4 row_mask:0xf bank_mask:0xf bound_ctrl:1\n\t"
        "v_fmac_f32_dpp %3, %3, %2 row_shr:4 row_mask:0xf bank_mask:0xf bound_ctrl:1\n\t"
        "v_mul_f32_dpp %0, %0, %0 row_shr:4 row_mask:0xf bank_mask:0xf\n\t"
        "v_mul_f32_dpp %2, %2, %2 row_shr:4 row_mask:0xf bank_mask:0xf\n\t"
        "v_fmac_f32_dpp %1, %1, %0 row_shr:8 row_mask:0xf bank_mask:0xf bound_ctrl:1\n\t"
        "v_fmac_f32_dpp %3, %3, %2 row_shr:8 row_mask:0xf bank_mask:0xf bound_ctrl:1\n\t"
        "v_mul_f32_dpp %0, %0, %0 row_shr:8 row_mask:0xf bank_mask:0xf\n\t"
        "v_mul_f32_dpp %2, %2, %2 row_shr:8 row_mask:0xf bank_mask:0xf\n\t"
        "s_nop 0"
        : "+v"(P1), "+v"(S1), "+v"(P2), "+v"(S2));
}
__device__ __forceinline__ void scan8(float& P, float& S, int t) {
    float Sd, Pd;
    Sd = dppf<0x111>(0.f, S); Pd = dppf<0x111>(1.f, P); if (t < 1) { Sd = 0.f; Pd = 1.f; } S = __builtin_fmaf(P, Sd, S); P *= Pd;
    Sd = dppf<0x112>(0.f, S); Pd = dppf<0x112>(1.f, P); if (t < 2) { Sd = 0.f; Pd = 1.f; } S = __builtin_fmaf(P, Sd, S); P *= Pd;
    Sd = dppfb<0x114, 0xA>(0.f, S); Pd = dppfb<0x114, 0xA>(1.f, P); S = __builtin_fmaf(P, Sd, S); P *= Pd;
}

template <int PASS, bool IS_S>
__device__ __forceinline__ void lru_wave_item(PRef p, LAS unsigned char* lds, int n, int b, int seg) {
    const int lane = opaque_tid() & 63, fr = lane & 15, fq = lane >> 4;
    const bf16_t* z = (const bf16_t*)(p.ws + WS_Z);
    bf16_t* ym = (bf16_t*)(p.ws + WS_YM);
    float* tot = (float*)(p.ws + WS_TOT);
    const LAS float* CT = (const LAS float*)(lds + L_CT) + 8 * fq;
    const int gch = n * 128 + 8 * fq;
    const int r0 = IS_S ? MPR + b * 64 : b * TP + seg * 64;
    const int nblk = IS_S ? 4 : (seg == LRU_NSEG - 1 ? 1 : 4);
    float hin[4][8], Pt[4][8];
    u32x4 prevx[4];
#pragma unroll
    for (int ks = 0; ks < 4; ++ks) {
#pragma unroll
        for (int e = 0; e < 8; ++e) { hin[ks][e] = 0.f; Pt[ks][e] = 1.f; }
        prevx[ks] = (u32x4){0u, 0u, 0u, 0u};
    }
    if constexpr (!IS_S) {
        if (seg > 0) {
#pragma unroll
            for (int ks = 0; ks < 4; ++ks) prevx[ks] = *(const u32x4*)(z + (size_t)(r0 - 16 + fr) * DIN + gch + 32 * ks);
            if constexpr (PASS == 2) {
#pragma unroll 1
                for (int round = 0; round < 2; ++round) {
                    const int s = 16 * round + fr;
                    if (16 * round >= seg) break;
                    const bool have = s < seg;
                    const float* tp = tot + ((size_t)(b * LRU_NSEG + (have ? s : 0)) * 2) * DA + gch;
#pragma unroll
                    for (int ks = 0; ks < 4; ++ks) {
                        const f32x4 P0 = *(const f32x4*)(tp + 32 * ks), P1 = *(const f32x4*)(tp + 32 * ks + 4), S0 = *(const f32x4*)(tp + DA + 32 * ks), S1 = *(const f32x4*)(tp + DA + 32 * ks + 4);
#pragma unroll
                        for (int e = 0; e < 8; e += 2) {
                            float Pa = have ? (e < 4 ? P0[e & 3] : P1[e & 3]) : 1.f, Sa = have ? (e < 4 ? S0[e & 3] : S1[e & 3]) : 0.f;
                            float Pb = have ? (e < 4 ? P0[(e + 1) & 3] : P1[(e + 1) & 3]) : 1.f, Sb = have ? (e < 4 ? S0[(e + 1) & 3] : S1[(e + 1) & 3]) : 0.f;
                            scan16x2(Pa, Sa, Pb, Sb);
                            hin[ks][e] = __builtin_fmaf(bcast15(Pa, lane), hin[ks][e], bcast15(Sa, lane));
                            hin[ks][e + 1] = __builtin_fmaf(bcast15(Pb, lane), hin[ks][e + 1], bcast15(Sb, lane));
                        }
                    }
                }
            }
        }
    }
    u32x4 xnext[4];
#pragma unroll
    for (int ks = 0; ks < 4; ++ks) xnext[ks] = *(const u32x4*)(z + (size_t)(r0 + fr) * DIN + gch + 32 * ks);
#pragma unroll 1
    for (int blk = 0; blk < nblk; ++blk) {
        const int r = r0 + 16 * blk + fr;
        const int t8 = fr & 7, sq = (r - MPR) >> 3;
        u32x4 x4[4], g4[4];
#pragma unroll
        for (int ks = 0; ks < 4; ++ks) { x4[ks] = xnext[ks]; if constexpr (PASS == 2) g4[ks] = *(const u32x4*)(z + (size_t)r * DIN + DA + gch + 32 * ks); }
        { const int rn_ = (blk + 1 < nblk) ? r + 16 : r;
#pragma unroll
          for (int ks = 0; ks < 4; ++ks) xnext[ks] = *(const u32x4*)(z + (size_t)rn_ * DIN + gch + 32 * ks); }
        float xc[4][8];
        bf16x8 bfrag[4];
#pragma unroll
        for (int ks = 0; ks < 4; ++ks) {
            float xf[8]; unpack8(x4[ks], xf);
            const f32x4 w0a = *(const LAS f32x4*)(CT + 0 * 128 + 32 * ks), w0b = *(const LAS f32x4*)(CT + 0 * 128 + 32 * ks + 4);
            const f32x4 w1a = *(const LAS f32x4*)(CT + 1 * 128 + 32 * ks), w1b = *(const LAS f32x4*)(CT + 1 * 128 + 32 * ks + 4);
            const f32x4 w2a = *(const LAS f32x4*)(CT + 2 * 128 + 32 * ks), w2b = *(const LAS f32x4*)(CT + 2 * 128 + 32 * ks + 4);
            const f32x4 w3a = *(const LAS f32x4*)(CT + 3 * 128 + 32 * ks), w3b = *(const LAS f32x4*)(CT + 3 * 128 + 32 * ks + 4);
            const f32x4 cba = *(const LAS f32x4*)(CT + 4 * 128 + 32 * ks), cbb = *(const LAS f32x4*)(CT + 4 * 128 + 32 * ks + 4);
            if constexpr (IS_S) {
                const float* sp = p.st_rc + (size_t)sq * 3 * DA + gch + 32 * ks;
                const f32x4 b0a = *(const f32x4*)sp, b0b = *(const f32x4*)(sp + 4), b1a = *(const f32x4*)(sp + DA), b1b = *(const f32x4*)(sp + DA + 4), b2a = *(const f32x4*)(sp + 2 * DA), b2b = *(const f32x4*)(sp + 2 * DA + 4);
#pragma unroll
                for (int e = 0; e < 8; ++e) {
                    const float bb0 = e < 4 ? b0a[e & 3] : b0b[e & 3], bb1 = e < 4 ? b1a[e & 3] : b1b[e & 3], bb2 = e < 4 ? b2a[e & 3] : b2b[e & 3];
                    const float s1 = dppf<0x111>(0.f, xf[e]), s2 = dppf<0x112>(0.f, xf[e]), s3 = dppf<0x113>(0.f, xf[e]);
                    const float x1 = t8 >= 1 ? s1 : bb2;
                    const float x2 = t8 >= 2 ? s2 : (t8 == 1 ? bb2 : bb1);
                    const float x3 = t8 >= 3 ? s3 : (t8 == 2 ? bb2 : (t8 == 1 ? bb1 : bb0));
                    const float w0 = e < 4 ? w0a[e & 3] : w0b[e & 3], w1 = e < 4 ? w1a[e & 3] : w1b[e & 3], w2 = e < 4 ? w2a[e & 3] : w2b[e & 3], w3 = e < 4 ? w3a[e & 3] : w3b[e & 3];
                    xc[ks][e] = (e < 4 ? cba[e & 3] : cbb[e & 3]) + w3 * xf[e] + w2 * x1 + w1 * x2 + w0 * x3;
                }
            } else {
                float pf[8]; unpack8(prevx[ks], pf);
#pragma unroll
                for (int e = 0; e < 8; ++e) {
                    const float x1 = dppf<0x111>(dppf<0x121>(0.f, pf[e]), xf[e]);
                    const float x2 = dppf<0x112>(dppf<0x122>(0.f, pf[e]), xf[e]);
                    const float x3 = dppf<0x113>(dppf<0x123>(0.f, pf[e]), xf[e]);
                    const float w0 = e < 4 ? w0a[e & 3] : w0b[e & 3], w1 = e < 4 ? w1a[e & 3] : w1b[e & 3], w2 = e < 4 ? w2a[e & 3] : w2b[e & 3], w3 = e < 4 ? w3a[e & 3] : w3b[e & 3];
                    xc[ks][e] = (e < 4 ? cba[e & 3] : cbb[e & 3]) + w3 * xf[e] + w2 * x1 + w1 * x2 + w0 * x3;
                }
                prevx[ks] = x4[ks];
            }
            bfrag[ks] = __builtin_bit_cast(bf16x8, pack8(xc[ks]));
        }
        f32x4 aa[8], ax[8];
#pragma unroll
        for (int nb = 0; nb < 8; ++nb) { aa[nb] = (f32x4){0.f, 0.f, 0.f, 0.f}; ax[nb] = (f32x4){0.f, 0.f, 0.f, 0.f}; }
#pragma unroll
        for (int ks = 0; ks < 4; ++ks)
#pragma unroll
            for (int nb = 0; nb < 8; ++nb) {
                const bf16x8 wa = *(const LAS bf16x8*)(lds + L_WA + (16 * nb + fr) * LW_STRIDE + (32 * ks + 8 * fq) * 2);
                const bf16x8 wx = *(const LAS bf16x8*)(lds + L_WX + (16 * nb + fr) * LW_STRIDE + (32 * ks + 8 * fq) * 2);
                aa[nb] = __builtin_amdgcn_mfma_f32_16x16x32_bf16(wa, bfrag[ks], aa[nb], 0, 0, 0);
                ax[nb] = __builtin_amdgcn_mfma_f32_16x16x32_bf16(wx, bfrag[ks], ax[nb], 0, 0, 0);
            }
        float y[4][8]; float ss = 0.f;
#pragma unroll
        for (int ks = 0; ks < 4; ++ks) {
            const f32x4 bga0 = *(const LAS f32x4*)(CT + 5 * 128 + 32 * ks), bga1 = *(const LAS f32x4*)(CT + 5 * 128 + 32 * ks + 4);
            const f32x4 bgx0 = *(const LAS f32x4*)(CT + 6 * 128 + 32 * ks), bgx1 = *(const LAS f32x4*)(CT + 6 * 128 + 32 * ks + 4);
            const f32x4 sp0 = *(const LAS f32x4*)(CT + 7 * 128 + 32 * ks), sp1 = *(const LAS f32x4*)(CT + 7 * 128 + 32 * ks + 4);
            float gav[8];
            if constexpr (PASS == 2) unpack8(g4[ks], gav);
            f32x4 h0a, h0b;
            if constexpr (IS_S) { const float* hp = p.st_h + (size_t)sq * DA + gch + 32 * ks; h0a = *(const f32x4*)hp; h0b = *(const f32x4*)(hp + 4); }
            float hv[8], Pv[8], Sv[8];
#pragma unroll
            for (int e = 0; e < 8; ++e) {
                const int nb = 2 * ks + (e >> 2), rg = e & 3;
                const float rr = __builtin_amdgcn_rcpf(1.0f + __builtin_amdgcn_exp2f(__builtin_fmaf(aa[nb][rg], -1.4426950408889634f, e < 4 ? bga0[rg] : bga1[rg])));
                const float ii = __builtin_amdgcn_rcpf(1.0f + __builtin_amdgcn_exp2f(__builtin_fmaf(ax[nb][rg], -1.4426950408889634f, e < 4 ? bgx0[rg] : bgx1[rg])));
                const float a = __builtin_amdgcn_exp2f(rr * (e < 4 ? sp0[rg] : sp1[rg]));
                const float om = __builtin_fmaf(-a, a, 1.0f);
                Pv[e] = a; Sv[e] = __builtin_amdgcn_sqrtf(om > 0.f ? om : 0.f) * (ii * xc[ks][e]);
            }
            if constexpr (IS_S) {
#pragma unroll
                for (int e = 0; e < 8; ++e) { scan8(Pv[e], Sv[e], t8); hv[e] = __builtin_fmaf(Pv[e], e < 4 ? h0a[e & 3] : h0b[e & 3], Sv[e]); }
            } else {
#pragma unroll
                for (int e = 0; e < 8; e += 2) scan16x2(Pv[e], Sv[e], Pv[e + 1], Sv[e + 1]);
#pragma unroll
                for (int e = 0; e < 8; ++e) {
                    hv[e] = __builtin_fmaf(Pv[e], hin[ks][e], Sv[e]);
                    hin[ks][e] = bcast15(hv[e], lane);
                    if constexpr (PASS == 1) Pt[ks][e] *= bcast15(Pv[e], lane);
                }
            }
            if constexpr (PASS == 2) {
#pragma unroll
                for (int e = 0; e < 8; ++e) { y[ks][e] = gelu_tanh(gav[e]) * hv[e]; ss += y[ks][e] * y[ks][e]; }
            }
            if constexpr (PASS == 2) {
                if (IS_S ? (t8 == 7) : (seg == LRU_NSEG - 1 && fr == 15)) {
                    float* ho = p.out + (IS_S ? O_SH + (size_t)sq * DA : O_PH + (size_t)b * DA) + gch + 32 * ks;
                    *(f32x4*)ho = (f32x4){hv[0], hv[1], hv[2], hv[3]}; *(f32x4*)(ho + 4) = (f32x4){hv[4], hv[5], hv[6], hv[7]};
                }
            }
        }
        if constexpr (PASS == 2) {
            ss += __shfl_xor(ss, 16); ss += __shfl_xor(ss, 32);
            const float rn = __builtin_amdgcn_rsqf(ss * (1.0f / 128.0f) + EPS);
#pragma unroll
            for (int ks = 0; ks < 4; ++ks) {
                const f32x4 g0 = *(const LAS f32x4*)(CT + 8 * 128 + 32 * ks), g1 = *(const LAS f32x4*)(CT + 8 * 128 + 32 * ks + 4);
                float o[8];
#pragma unroll
                for (int e = 0; e < 8; ++e) o[e] = y[ks][e] * rn * (e < 4 ? g0[e & 3] : g1[e & 3]);
                *(u32x4*)(ym + (size_t)r * DMIX + gch + 32 * ks) = pack8(o);
            }
        }
    }
    if constexpr (PASS == 1 && !IS_S) {
        if (fr == 0) {
            float* tp = tot + ((size_t)(b * LRU_NSEG + seg) * 2) * DA + gch;
#pragma unroll
            for (int ks = 0; ks < 4; ++ks) {
                *(f32x4*)(tp + 32 * ks) = (f32x4){Pt[ks][0], Pt[ks][1], Pt[ks][2], Pt[ks][3]}; *(f32x4*)(tp + 32 * ks + 4) = (f32x4){Pt[ks][4], Pt[ks][5], Pt[ks][6], Pt[ks][7]};
                *(f32x4*)(tp + DA + 32 * ks) = (f32x4){hin[ks][0], hin[ks][1], hin[ks][2], hin[ks][3]}; *(f32x4*)(tp + DA + 32 * ks + 4) = (f32x4){hin[ks][4], hin[ks][5], hin[ks][6], hin[ks][7]};
            }
        }
    }
}
template <int PASS>
__device__ __forceinline__ void mixer_phase(PRef p, LAS unsigned char* lds, int G) {
    const int tid = opaque_tid(), wave = __builtin_amdgcn_readfirstlane(tid >> 6);
    for (int v = blockIdx.x; v < NH * LRU_WG_PER_HEAD; v += G) {
        const int n = v / LRU_WG_PER_HEAD;
        __syncthreads();
        if (!(PASS == 2 && G == GRID && p.ph_lo <= 2))
        {
            const bf16_t* wg = (const bf16_t*)(p.ws + WS_WG);
            for (int i = tid; i < 2 * 128 * 16; i += 512) { const int g = i >> 11, row = (i >> 4) & 127, c16 = i & 15;
                *(LAS u32x4*)(lds + g * L_WX + row * LW_STRIDE + c16 * 16) = *(const u32x4*)(wg + (((size_t)g * NH + n) * 128 + row) * 128 + c16 * 8); }
            LAS float* CTw = (LAS float*)(lds + L_CT);
            for (int i = tid; i < 9 * 128; i += 512) { const int k = i >> 7, c = i & 127, ch = n * 128 + c;
                float vv;
                if (k < 4) vv = p.conv_a_w[k * DA + ch]; else if (k == 4) vv = p.conv_a_b[ch]; else if (k == 5) vv = -1.4426950408889634f * p.b_gate_a[ch]; else if (k == 6) vv = -1.4426950408889634f * p.b_gate_x[ch];
                else if (k == 7) vv = -8.0f * 1.4426950408889634f * log1pf(__expf(-p.lam[ch])); else vv = p.g_out_a[ch];
                CTw[i] = vv; }
        }
        __syncthreads();
        const int wi = (v % LRU_WG_PER_HEAD) * 8 + wave;
        if (wi < LRU_PITEMS) lru_wave_item<PASS, false>(p, lds, n, wi / LRU_NSEG, wi % LRU_NSEG);
        else if (PASS == 2 && wi < LRU_PITEMS + LRU_SITEMS) lru_wave_item<PASS, true>(p, lds, n, wi - LRU_PITEMS, 0);
    }
    if (G == 256 && (int)blockIdx.x >= MIX_IDLE_WG0) convert_items(p, lds, ((int)blockIdx.x - MIX_IDLE_WG0) * 8 + wave, (G - MIX_IDLE_WG0) * 8, PASS == 1 ? IT_S1 : IT_S2, PASS == 1 ? IT_S2 : IT_S3);
    if (PASS == 1) { branch_b(p, G); if ((REP_MASK >> 11) & 1) branch_b(p, G); }
}

__device__ __forceinline__ void final_phase(PRef p, int G) {
    const int tid_ = opaque_tid(), lane = tid_ & 63, gw = blockIdx.x * 8 + (tid_ >> 6), NGW = G * 8;
    const bf16_t* x2b = (const bf16_t*)(p.ws + WS_YM);
    f32x4 gf[8];
#pragma unroll
    for (int j = 0; j < 8; ++j) gf[j] = ((const f32x4*)p.g_final)[lane + 64 * j];
    for (int o = gw; o < NB * SEQ + MSR; o += NGW) {
        const int r = o < NB * SEQ ? (o / SEQ) * TP + NMETA + (o % SEQ) : MPR + (o - NB * SEQ);
        const u32x2* xr = (const u32x2*)(x2b + (size_t)r * D) + lane;
        f32x4 v[8]; float s = 0.f;
#pragma unroll
        for (int j = 0; j < 8; ++j) { const u32x2 w = xr[64 * j]; v[j] = (f32x4){bf_lo(w.x), bf_hi(w.x), bf_lo(w.y), bf_hi(w.y)};
            s += (v[j][0] * v[j][0] + v[j][1] * v[j][1]) + (v[j][2] * v[j][2] + v[j][3] * v[j][3]); }
        s = wave_sum(s);
        const float rs = __builtin_amdgcn_rsqf(s * (1.0f / D) + EPS);
        f32x4* yo = (f32x4*)(p.out + (size_t)o * D) + lane;
#pragma unroll
        for (int j = 0; j < 8; ++j) yo[64 * j] = v[j] * rs * gf[j];
    }
}

#define XB_TMO      128
#define XB_XCNT(j)  (256  + 64 * (j))
#define XB_XSUB(j)  (1280 + 64 * (j))
#define XB_XGEN(j)  (2304 + 64 * (j))
#define XB_TOP      3328
#define XB_TOPGEN   3392
#define XCD_BAR_WORDS 3456
#define XB_SPIN_CAP (1u << 18)
__device__ __forceinline__ unsigned xb_ld(unsigned* p)              { return __hip_atomic_load(p, __ATOMIC_RELAXED, __HIP_MEMORY_SCOPE_AGENT); }
__device__ __forceinline__ unsigned xb_add(unsigned* p, unsigned v) { return __hip_atomic_fetch_add(p, v, __ATOMIC_RELAXED, __HIP_MEMORY_SCOPE_AGENT); }
__device__ __forceinline__ unsigned xb_xcc_id() { return (unsigned)__builtin_amdgcn_s_getreg((3 << 11) | 20) & 0xFu; }
#define XB_SPIN(cond, bar) do { unsigned _sp = 0; while (cond) { __builtin_amdgcn_s_sleep(1); \
    if ((++_sp & 255u) == 0u) { if (xb_ld(&(bar)[XB_TMO])) break; if (_sp > XB_SPIN_CAP) { atomicAdd(&(bar)[XB_TMO], 1u); break; } } } } while (0)
struct XcdBarrier { unsigned* bar; unsigned x; volatile LAS unsigned* st; };
__device__ __forceinline__ XcdBarrier xcd_barrier_post(unsigned* bar, volatile LAS unsigned* st) {
    XcdBarrier b; b.bar = bar; b.x = xb_xcc_id(); b.st = st;
    if (threadIdx.x == 0) (void)xb_add(&bar[XB_XCNT(b.x)], 1u);
    return b;
}
__device__ __forceinline__ void xcd_barrier_complete(unsigned* bar, unsigned x, unsigned& nloc, unsigned& nx) {
    const unsigned G = gridDim.x * gridDim.y * gridDim.z;
    unsigned sum, cnt, mine, sp = 0u;
    for (;;) {
        sum = 0u; cnt = 0u; mine = 0u;
#pragma unroll
        for (unsigned j = 0; j < 16; ++j) { const unsigned c = xb_ld(&bar[XB_XCNT(j)]); sum += c; cnt += (c > 0u) ? 1u : 0u; mine = (j == x) ? c : mine; }
        if (sum == G) break;
        __builtin_amdgcn_s_sleep(1);
        if ((++sp & 255u) == 0u) { if (xb_ld(&bar[XB_TMO])) break; if (sp > XB_SPIN_CAP) { atomicAdd(&bar[XB_TMO], 1u); break; } }
    }
    nloc = mine > 0u ? mine : 1u; nx = cnt > 0u ? cnt : 1u;
}
__device__ __forceinline__ void xcd_barrier(const XcdBarrier& b) {
    asm volatile("s_waitcnt vmcnt(0)" ::: "memory");
    __syncthreads();
    if (threadIdx.x == 0) {
        unsigned* bar = b.bar;
        __builtin_amdgcn_s_waitcnt(0);
        unsigned nloc = b.st[0], nx = b.st[1];
        if (nloc == 0u) { xcd_barrier_complete(bar, b.x, nloc, nx); b.st[0] = nloc; b.st[1] = nx; }
        const unsigned old = xb_add(&bar[XB_XSUB(b.x)], 1u);
        const unsigned gen = old / nloc;
        if (old + 1u == (gen + 1u) * nloc) {
            __builtin_amdgcn_fence(__ATOMIC_RELEASE, "agent");
            asm volatile("s_waitcnt vmcnt(0)" ::: "memory");
            const unsigned og = xb_add(&bar[XB_TOP], 1u);
            const unsigned tg = og / nx;
            if (og + 1u == (tg + 1u) * nx) xb_add(&bar[XB_TOPGEN], 1u);
            else XB_SPIN(xb_ld(&bar[XB_TOPGEN]) == tg, bar);
            __builtin_amdgcn_fence(__ATOMIC_ACQUIRE, "agent");
            xb_add(&bar[XB_XGEN(b.x)], 1u);
            asm volatile("s_waitcnt vmcnt(0)" ::: "memory");
        } else {
            XB_SPIN(xb_ld(&bar[XB_XGEN(b.x)]) == gen, bar);
            __builtin_amdgcn_fence(__ATOMIC_ACQUIRE, "agent");
            asm volatile("s_waitcnt vmcnt(0)" ::: "memory");
        }
    }
    __syncthreads();
}

constexpr int LDS_BYTES = 131072 + 1024 + 8 * 1024;
constexpr int N_PHASES = 8;
__global__ void __launch_bounds__(512, 2) hymba_fwd(Params p) {
    extern __shared__ __attribute__((aligned(16))) unsigned char lds_raw[];
    LAS unsigned char* lds = (LAS unsigned char*)lds_raw;
    constexpr int G = GRID;
    if ((int)gridDim.x != GRID) return;
    const CAS Params* kp = (const CAS Params*)__builtin_amdgcn_kernarg_segment_ptr();
#define P_HERE (*({ const CAS Params* q_ = kp; asm volatile("" : "+s"(q_)); q_; }))
    unsigned char* ws = p.ws;
    volatile LAS unsigned* misc = (volatile LAS unsigned*)(lds + 131072);
    if (threadIdx.x < 8) misc[threadIdx.x] = 0u;
    __syncthreads();
    XcdBarrier bar = xcd_barrier_post((unsigned*)ws, misc);
    const int lo = p.ph_lo, hi = p.ph_hi;
#ifndef PH_MASK
#define PH_MASK 0xff
#endif
#define IN(k) (((PH_MASK >> (k)) & 1) && lo <= (k) && (k) < hi)
#define SEAM(k) do { if (IN(k) && IN((k) + 1)) xcd_barrier(bar); } while (0)
#define REPEAT(k) for (int rep_ = 0; rep_ < ((((REP_MASK) >> (k)) & 1) ? 2 : 1); ++rep_, (rep_ < ((((REP_MASK) >> (k)) & 1) ? 2 : 1) ? xcd_barrier(bar) : (void)0))
    if (IN(0)) REPEAT(0) phase0(P_HERE, lds, G);
    SEAM(0);
    if (IN(1)) REPEAT(1) {
        pg8::Gemm g{(const bf16_t*)(ws + WS_XB) + (size_t)16 * D, (const bf16_t*)(ws + WS_WIN), MP / 256, DIN / 256, D, (size_t)256 * D * 2, (size_t)128 * D * 2};
        pg8::StaticOrder S; S.init(g.nM, g.nN, G, (int)blockIdx.x, D / 64, 1);
        PRef q = P_HERE; EpiZ E{(const float*)(ws + WS_RS1), (bf16_t*)(ws + WS_Z), q.out};
        pg8::gemm_phase<EpiZ, false, true, true>(lds, g, S, E, nullptr, nullptr);
        if ((int)blockIdx.x >= P1_TAIL_WG0 && G == 256) convert_items(P_HERE, lds, ((int)blockIdx.x - P1_TAIL_WG0) * 8 + (opaque_tid() >> 6), (G - P1_TAIL_WG0) * 8, IT_O, IT_S1);
        else if (G != 256) convert_items(P_HERE, lds, (int)blockIdx.x * 8 + (opaque_tid() >> 6), G * 8, IT_O, IT_S3);
    }
    SEAM(1);
    if (IN(2)) REPEAT(2) mixer_phase<1>(P_HERE, lds, G);
    SEAM(2);
    if (IN(3)) REPEAT(3) mixer_phase<2>(P_HERE, lds, G);
    SEAM(3);
    if (IN(4)) REPEAT(4) {
        pg8::Gemm g{(const bf16_t*)(ws + WS_YM), (const bf16_t*)(ws + WS_WO), MP / 256, D / 256, DMIX, (size_t)256 * DMIX * 2, (size_t)128 * DMIX * 2};
        pg8::StaticOrder S; S.init(g.nM, g.nN, G, (int)blockIdx.x, DMIX / 64, P4_SPLIT);
        PRef q = P_HERE; EpiX1 E{q.x_prompt, q.x_sample, q.meta, (bf16_t*)(ws + WS_XB) + (size_t)16 * D, (float*)(ws + WS_SSQ)};
        pg8::gemm_phase<EpiX1, false, true, true>(lds, g, S, E, (float*)(ws + WS_Z), (unsigned*)ws + CW_TK4 + rep_ * 128 * 64);
        if ((int)blockIdx.x >= P4_TAIL_WG0 && G == 256) convert_items(P_HERE, lds, ((int)blockIdx.x - P4_TAIL_WG0) * 8 + (opaque_tid() >> 6), (G - P4_TAIL_WG0) * 8, IT_S3, IT_G);
        else if (G != 256) convert_items(P_HERE, lds, (int)blockIdx.x * 8 + (opaque_tid() >> 6), G * 8, IT_S3, IT_G);
    }
    SEAM(4);
    if (IN(5)) REPEAT(5) {
        pg8::Gemm g{(const bf16_t*)(ws + WS_XB) + (size_t)14 * D, (const bf16_t*)(ws + WS_WUP), 37, 2 * DFF / 256, D, (size_t)252 * D * 2, (size_t)64 * D * 2};
        pg8::StaticOrder S; S.init(g.nM, g.nN, G, (int)blockIdx.x, D / 64, 1);
        LAS float* rstab = (LAS float*)(lds + 131072 + 1024);
        ffn_rstd_table((const float*)(ws + WS_SSQ), rstab, S); __syncthreads();
        PRef q = P_HERE; EpiFFN E{q.conv_f_w, q.conv_f_b, q.st_fc, (bf16_t*)(ws + WS_Z), q.out, rstab};
        if ((REP_MASK >> 10) & 1) { EpiProbe Ep{(bf16_t*)(ws + WS_Z)}; pg8::gemm_phase<EpiProbe, true, true, true>(lds, g, S, Ep, nullptr, nullptr); xcd_barrier(bar); }
        pg8::gemm_phase<EpiFFN, true, true, true>(lds, g, S, E, nullptr, nullptr);
    }
    SEAM(5);
    if (IN(6)) {
        pg8::Gemm g{(const bf16_t*)(ws + WS_Z), (const bf16_t*)(ws + WS_WDN), MP / 256, D / 256, DFF, (size_t)256 * DFF * 2, (size_t)128 * DFF * 2};
        pg8::StaticOrder S; S.init(g.nM, g.nN, G, (int)blockIdx.x, DFF / 64, P6_SPLIT);
        EpiOut E{(const bf16_t*)(ws + WS_XB) + (size_t)16 * D, (bf16_t*)(ws + WS_YM)};
        pg8::gemm_phase<EpiOut, false, true, true>(lds, g, S, E, (float*)(ws + WS_WIN), (unsigned*)ws + CW_TK6);
    }
    SEAM(6);
    if (IN(7)) REPEAT(7) final_phase(P_HERE, G);
#undef IN
#undef SEAM
}

extern "C" void kernel_launch(void* const* d_in, const int* in_sizes, int n_in, void* d_out, int out_size, void* d_ws, size_t ws_size, hipStream_t stream) {
    static int grid = 0;
    if (grid == 0) {
        if (n_in != 26 || (size_t)out_size != O_END || ws_size < WS_END) { fprintf(stderr, "kernel_launch: unexpected problem (n_in %d, out %d, ws %zu; need ws >= %zu)\n", n_in, out_size, ws_size, (size_t)WS_END); grid = -1; return; }
        int dev = 0, cus = 0, per_cu = 0;
        hipGetDevice(&dev); hipDeviceGetAttribute(&cus, hipDeviceAttributeMultiprocessorCount, dev);
        if (hipFuncSetAttribute((const void*)hymba_fwd, hipFuncAttributeMaxDynamicSharedMemorySize, LDS_BYTES) != hipSuccess) { fprintf(stderr, "kernel_launch: hipFuncSetAttribute failed\n"); grid = -1; return; }
        if (hipOccupancyMaxActiveBlocksPerMultiprocessor(&per_cu, (const void*)hymba_fwd, 512, LDS_BYTES) != hipSuccess || per_cu < 1) { fprintf(stderr, "kernel_launch: occupancy query says %d\n", per_cu); grid = -1; return; }
        if (cus < GRID) { fprintf(stderr, "kernel_launch: built for a %d-CU device, found %d CUs\n", GRID, cus); grid = -1; return; }
        grid = GRID;
    }
    if (grid < 0) return;
    Params p{};
    const float** f = (const float**)&p;
    for (int i = 0; i < 26; ++i) f[i] = (const float*)d_in[i];
    p.out = (float*)d_out; p.ws = (unsigned char*)d_ws;
    if (hipMemsetAsync(d_ws, 0, CTL_WORDS * 4, stream) != hipSuccess) { fprintf(stderr, "kernel_launch: memset failed\n"); return; }
    if (MK_N_LAUNCHES == 1) {
        p.ph_lo = 0; p.ph_hi = N_PHASES;
        hipLaunchKernelGGL(hymba_fwd, dim3(grid), dim3(512), LDS_BYTES, stream, p);
    } else {
        for (int k = 0; k < N_PHASES; ++k) { p.ph_lo = k; p.ph_hi = k + 1; hipLaunchKernelGGL(hymba_fwd, dim3(grid), dim3(512), LDS_BYTES, stream, p); }
    }
}
```

```cpp
#include <hip/hip_runtime.h>
#include <cstdio>

#ifndef REP_MASK
#define REP_MASK 0x00
#endif
#ifndef MK_N_LAUNCHES
#define MK_N_LAUNCHES 1
#endif

#define LAS __attribute__((address_space(3)))
#define CAS __attribute__((address_space(4)))
typedef unsigned short bf16_t;
typedef short bf16x8 __attribute__((ext_vector_type(8)));
typedef float f32x4 __attribute__((ext_vector_type(4)));
typedef unsigned u32x4 __attribute__((ext_vector_type(4)));
typedef unsigned u32x2 __attribute__((ext_vector_type(2)));

constexpr int D = 2048, NMETA = 16, SEQ = 2048, TP = SEQ + NMETA, NB = 4, MPR = NB * TP;
constexpr int NS = 128, TS = 8, MSR = NS * TS, M = MPR + MSR;
constexpr int MP = 9472;
constexpr int DA = 1536, DB = 1024, DIN = 6144, DMIX = 2560, DFF = 6144, NH = 12;
constexpr float EPS = 1e-6f;
constexpr int NCH = 33;
constexpr size_t O_YP = 0, O_YS = O_YP + (size_t)NB * SEQ * D, O_PH = O_YS + (size_t)MSR * D, O_PRC = O_PH + NB * DA,
                 O_PSC = O_PRC + NB * 3 * DA, O_PFC = O_PSC + NB * 2 * DB, O_SH = O_PFC + NB * 2 * DFF, O_SRC = O_SH + NS * DA,
                 O_SSC = O_SRC + (size_t)NS * 3 * DA, O_SFC = O_SSC + (size_t)NS * 2 * DB, O_END = O_SFC + (size_t)NS * 2 * DFF;
constexpr size_t MiB = 1u << 20;
constexpr int CW_TK6 = 4096, CTL_WORDS = 4096 + 256 * 64;
constexpr int P6_SPLIT = 4, P4_SPLIT = 4, CW_TK4 = CW_TK6 + 64 * 64;
constexpr int GRID = 256;
constexpr size_t WS_WIN = 1 * MiB;
constexpr size_t WS_WO = WS_WIN + (size_t)DIN * D * 2;
constexpr size_t WS_WUP = WS_WO + (size_t)D * DMIX * 2;
constexpr size_t WS_WDN = WS_WUP + (size_t)2 * DFF * D * 2;
constexpr size_t WS_WG = WS_WDN + (size_t)D * DFF * 2;
constexpr size_t WS_XB = WS_WG + (size_t)2 * NH * 128 * 128 * 2;
constexpr size_t XB_ROWS = 9600;
constexpr size_t WS_Z = WS_XB + XB_ROWS * D * 2;
constexpr size_t WS_YM = WS_Z + (size_t)MP * DIN * 2;
constexpr size_t WS_RS1 = WS_YM + (size_t)MP * DMIX * 2;
constexpr size_t WS_SSQ = WS_RS1 + (size_t)MP * 4;
constexpr size_t WS_TOT = WS_SSQ + (size_t)MP * 32 * 4;
constexpr size_t WS_END = WS_TOT + (size_t)NB * NCH * DA * 2 * 4;

struct Params;
typedef const CAS Params& PRef;
struct Params {
    const float *x_prompt, *x_sample, *st_h, *st_rc, *st_sc, *st_fc, *meta, *g_mix, *w_in, *conv_a_w, *conv_a_b, *w_gate_a, *b_gate_a,
        *w_gate_x, *b_gate_x, *lam, *conv_b_w, *g_out_a, *g_out_b, *w_o, *g_ffn, *w_up, *conv_f_w, *conv_f_b, *w_down, *g_final;
    float* out; unsigned char* ws; int ph_lo, ph_hi;
};

__device__ __forceinline__ unsigned cvt_pk_bf16(float lo, float hi) { unsigned r; asm volatile("v_cvt_pk_bf16_f32 %0, %1, %2" : "=v"(r) : "v"(lo), "v"(hi)); return r; }
__device__ __forceinline__ float bf_lo(unsigned w) { return __builtin_bit_cast(float, w << 16); }
__device__ __forceinline__ float bf_hi(unsigned w) { return __builtin_bit_cast(float, w & 0xffff0000u); }
__device__ __forceinline__ void unpack8(const u32x4 w, float (&f)[8]) { f[0] = bf_lo(w.x); f[1] = bf_hi(w.x); f[2] = bf_lo(w.y); f[3] = bf_hi(w.y); f[4] = bf_lo(w.z); f[5] = bf_hi(w.z); f[6] = bf_lo(w.w); f[7] = bf_hi(w.w); }
__device__ __forceinline__ u32x4 pack8(const float (&f)[8]) { u32x4 w; w.x = cvt_pk_bf16(f[0], f[1]); w.y = cvt_pk_bf16(f[2], f[3]); w.z = cvt_pk_bf16(f[4], f[5]); w.w = cvt_pk_bf16(f[6], f[7]); return w; }
__device__ __forceinline__ float wave_sum(float v) {
#pragma unroll
    for (int o = 1; o < 64; o <<= 1) v += __shfl_xor(v, o);
    return v;
}
__device__ __forceinline__ float sum16(float v) {
    v += __shfl_xor(v, 1); v += __shfl_xor(v, 2); v += __shfl_xor(v, 4); v += __shfl_xor(v, 8); return v;
}
__device__ __forceinline__ float sigmoidf_(float x) { return __builtin_amdgcn_rcpf(1.0f + __expf(-x)); }
__device__ __forceinline__ float gelu_tanh(float x) {
    const float t = x * (1.0f + 0.044715f * x * x) * (-2.0f * 0.7978845608028654f * 1.4426950408889634f);
    return x * __builtin_amdgcn_rcpf(1.0f + __builtin_amdgcn_exp2f(t));
}
__device__ __forceinline__ int opaque_tid() { int t = threadIdx.x; asm volatile("" : "+v"(t)); return t; }
template <int CTRL> __device__ __forceinline__ float dppf(float old, float src) {
    return __builtin_bit_cast(float, __builtin_amdgcn_update_dpp(__builtin_bit_cast(int, old), __builtin_bit_cast(int, src), CTRL, 0xF, 0xF, false));
}
__device__ __forceinline__ void row_decode(int r, int& is_s, int& seq, int& t) {
    if (r < MPR) { seq = (r >= TP) + (r >= 2 * TP) + (r >= 3 * TP); t = r - seq * TP; is_s = 0; }
    else { const int q = r - MPR; seq = q >> 3; t = q & 7; is_s = 1; }
}
__device__ __forceinline__ const float* x_row_ptr(const float* xp, const float* xs, const float* meta, int r) {
    int is_s, seq, t; row_decode(r, is_s, seq, t);
    if (is_s) return xs + (size_t)(r - MPR) * D;
    return t < NMETA ? meta + (size_t)t * D : xp + ((size_t)seq * SEQ + (t - NMETA)) * D;
}
__device__ __forceinline__ float* y_row_ptr(float* out, int r) {
    if (r >= M) return nullptr;
    int is_s, seq, t; row_decode(r, is_s, seq, t);
    if (is_s) return out + O_YS + (size_t)(r - MPR) * D;
    return t < NMETA ? nullptr : out + O_YP + ((size_t)seq * SEQ + (t - NMETA)) * D;
}

namespace pg8 {
constexpr int BM = 256, BK = 64, HALF = 128, HTB = HALF * BK * 2, STAGE_BYTES = 8 * HTB, NXCD = 8, WGM = 2;
__host__ __device__ __forceinline__ int lds_byte(int r, int c) { const int st = (r >> 4) * 2 + (c >> 5), rr = r & 15, cc = c & 31, ob = rr * 64 + cc * 2; return st * 1024 + (ob ^ (((ob >> 9) & 1) << 5)); }
__host__ __device__ __forceinline__ void stage_rc(int b, int& R, int& C) { const int st = b / 1024, sb = b % 1024, swz = sb ^ (((sb >> 9) & 1) << 5); R = (st >> 1) * 16 + swz / 64; C = (st & 1) * 32 + (swz % 64) / 2; }
struct Unit { int pm, pn, kb, nk, piece, lu, idx; };
struct Gemm { const bf16_t* A; const bf16_t* Bt; int nM, nN, K; size_t a_tstep, a_hstep; };
struct StaticOrder {
    int nM, nN, nwg, G, c, nt, split, nfull, nleft, limit = 1 << 20, first = 0;
    __device__ __forceinline__ void init(int nM_, int nN_, int G_, int c_, int nt_, int split_) { nM = nM_; nN = nN_; nwg = nM * nN; G = G_; c = c_; nt = nt_; nfull = (nwg / G) * G; nleft = nwg - nfull;
        split = (split_ > 1 && nleft > 0 && nleft * split_ <= G && (nt / split_) * split_ == nt && ((nt / split_) & 1) == 0) ? split_ : 1; }
    __device__ __forceinline__ void map(int L, Unit& u) const {
        int wgid = L; { const int q = nwg / NXCD, r = nwg % NXCD, xcd = wgid % NXCD, off = wgid / NXCD; wgid = (xcd < r ? xcd * (q + 1) : r * (q + 1) + (xcd - r) * q) + off; }
        const int nig = WGM * nN, gid = wgid / nig, rem = wgid - gid * nig, fm = gid * WGM, glast = nM % WGM;
        if (nM - fm >= WGM || glast == 0) { u.pm = fm + (rem & (WGM - 1)); u.pn = rem / WGM; }
        else { u.pm = fm + rem % glast; u.pn = rem / glast; }
    }
    __device__ __forceinline__ bool next(int i, Unit& u) const {
        u.kb = 0; u.nk = nt; u.piece = -1; u.lu = 0; u.idx = i;
        i += first; if (i >= limit) return false;
        const long L = (long)i * G + c;
        if (L < nfull || split == 1) { if (L >= nwg) return false; map((int)L, u); return true; }
        if (L >= nfull + G || c >= nleft * split) return false;
        u.lu = c % nleft; u.piece = c / nleft; u.nk = nt / split; u.kb = u.piece * u.nk; map(nfull + u.lu, u); return true;
    }
};

template <int P, int A, int Mi>
__device__ __forceinline__ void reduce_rowgroup(f32x4 (&acc)[2][2][4][2], const float* slab0, int tid) {
    const float* sp = slab0 + (size_t)((A * 4 + Mi) * 4) * 8192 + tid * 4;
#pragma unroll
    for (int b = 0; b < 2; ++b)
#pragma unroll
        for (int n = 0; n < 2; ++n) {
            f32x4 sum = (f32x4){0.f, 0.f, 0.f, 0.f};
#pragma unroll
            for (int src = 0; src < 4; ++src) { if (src == P) sum += acc[A][b][Mi][n]; else sum += *(const f32x4*)(sp + (size_t)src * 8192 + (b * 2 + n) * 2048); }
            acc[A][b][Mi][n] = sum;
        }
}
template <class Epi, bool FFNMAP, bool ALIGN_EPI, bool SP2>
__device__ __forceinline__ void gemm_phase(LAS unsigned char* lds, const Gemm g, const StaticOrder& S, const Epi& E, float* slabs, unsigned* tickets, bool dry = false) {
    int tid = threadIdx.x; asm volatile("" : "+v"(tid));
    const int wid = __builtin_amdgcn_readfirstlane(tid >> 6), lane = tid & 63, wr = wid >> 2, wc = wid & 3, fr = lane & 15, fq = lane >> 4;
    const int K = g.K;
    unsigned voffA[2], voffB[2];
#pragma unroll
    for (int i = 0; i < 2; ++i) { int R, C; stage_rc(tid * 16 + i * 8192, R, C); const int Ra = FFNMAP ? (126 * (R >> 6) + (R & 63)) : R;
        voffA[i] = (unsigned)(Ra * K + C) * 2u; voffB[i] = (unsigned)(R * K + C) * 2u; }
    const size_t kstep = (size_t)(BK * 2);
    const size_t hstepA = g.a_hstep, tstepA = g.a_tstep;
    const size_t hstepB = (size_t)HALF * K * 2, tstepB = 2 * hstepB;
    const unsigned ldsw = (unsigned)wid * 1024u;
    const int aoff = lds_byte(wr * 64 + fr, fq * 8), boff = lds_byte(wc * 32 + fr, fq * 8);
#define PG8_SA(b, h) (((b) * 2 + (h)) * HTB)
#define PG8_SB(b, h) ((4 + (b) * 2 + (h)) * HTB)
#define PG8_STAGE(bufoff, gbase, voff) do { _Pragma("unroll") for (int _i = 0; _i < 2; ++_i) \
        __builtin_amdgcn_global_load_lds((const unsigned*)((const char*)(gbase) + (voff)[_i]), (LAS unsigned*)(lds + (bufoff) + ldsw + _i * 8192), 16, 0, 0); } while (0)
#define PG8_LDA(dst, b, h) do { _Pragma("unroll") for (int m = 0; m < 4; ++m) _Pragma("unroll") for (int k = 0; k < 2; ++k) dst[m][k] = *(const LAS bf16x8*)(lds + PG8_SA(b, h) + aoff + m * 2048 + k * 1024); } while (0)
#define PG8_LDB(dst, b, h) do { _Pragma("unroll") for (int n = 0; n < 2; ++n) _Pragma("unroll") for (int k = 0; k < 2; ++k) dst[n][k] = *(const LAS bf16x8*)(lds + PG8_SB(b, h) + boff + n * 2048 + k * 1024); } while (0)
#define PG8_MMA(ai, bj, At, Bt) do { __builtin_amdgcn_s_setprio(1); _Pragma("unroll") for (int m = 0; m < 4; ++m) _Pragma("unroll") for (int n = 0; n < 2; ++n) _Pragma("unroll") for (int k = 0; k < 2; ++k) \
        acc[ai][bj][m][n] = __builtin_amdgcn_mfma_f32_16x16x32_bf16(Bt[n][k], At[m][k], acc[ai][bj][m][n], 0, 0, 0); __builtin_amdgcn_s_setprio(0); } while (0)
#define PG8_WAIT_V(n) asm volatile("s_waitcnt vmcnt(" #n ")" ::: "memory")
#define PG8_WAIT_L(n) asm volatile("s_waitcnt lgkmcnt(" #n ")" ::: "memory")
#define PG8_BAR __builtin_amdgcn_s_barrier()
#define PG8_SCHED __builtin_amdgcn_sched_barrier(0)
    Unit cur, nxt; int ui = 0;
    if (!S.next(0, cur)) return;
    f32x4 acc[2][2][4][2];
#pragma unroll
    for (int a = 0; a < 2; ++a)
#pragma unroll
        for (int b = 0; b < 2; ++b)
#pragma unroll
            for (int m = 0; m < 4; ++m)
#pragma unroll
                for (int n = 0; n < 2; ++n) acc[a][b][m][n] = (f32x4){0.f, 0.f, 0.f, 0.f};
    bf16x8 At[4][2], B0[2][2], B1[2][2];
    const char* cA = (const char*)g.A + (size_t)cur.pm * tstepA + (size_t)cur.kb * kstep; const char* cB = (const char*)g.Bt + (size_t)cur.pn * tstepB + (size_t)cur.kb * kstep;
    if constexpr (SP2) {
        PG8_STAGE(PG8_SB(0, 0), cB, voffB); PG8_STAGE(PG8_SB(0, 1), cB + hstepB, voffB); PG8_STAGE(PG8_SA(0, 0), cA, voffA); PG8_STAGE(PG8_SA(0, 1), cA + hstepA, voffA);
        if (wr == 1) PG8_BAR;
        PG8_WAIT_V(2); PG8_BAR;
        PG8_STAGE(PG8_SB(1, 0), cB + kstep, voffB); PG8_STAGE(PG8_SA(1, 0), cA + kstep, voffA); PG8_STAGE(PG8_SB(1, 1), cB + hstepB + kstep, voffB);
        PG8_WAIT_V(6); PG8_BAR;
    } else {
        PG8_STAGE(PG8_SB(0, 0), cB, voffB); PG8_STAGE(PG8_SA(0, 0), cA, voffA); PG8_STAGE(PG8_SB(0, 1), cB + hstepB, voffB); PG8_STAGE(PG8_SA(0, 1), cA + hstepA, voffA);
        if (wr == 1) PG8_BAR;
        PG8_WAIT_V(4); PG8_BAR;
        PG8_STAGE(PG8_SB(1, 0), cB + kstep, voffB); PG8_STAGE(PG8_SA(1, 0), cA + kstep, voffA); PG8_STAGE(PG8_SB(1, 1), cB + hstepB + kstep, voffB);
        PG8_WAIT_V(6); PG8_BAR;
    }
    for (;;) {
        const bool has_next = S.next(ui + 1, nxt);
        const char* nA = has_next ? (const char*)g.A + (size_t)nxt.pm * tstepA + (size_t)nxt.kb * kstep : cA; const char* nB = has_next ? (const char*)g.Bt + (size_t)nxt.pn * tstepB + (size_t)nxt.kb * kstep : cB;
        const int nt = cur.nk;
        for (int t = 0; t < nt; t += 2) {
            const bool last = (t == nt - 2);
            const char* a1 = cA + (size_t)(t + 1) * kstep;
            const char* a2 = last ? nA : cA + (size_t)(t + 2) * kstep; const char* b2 = last ? nB : cB + (size_t)(t + 2) * kstep;
            const char* a3 = a2 + kstep; const char* b3 = b2 + kstep;
            if constexpr (SP2) {
            PG8_LDB(B0, 0, 0); PG8_LDB(B1, 0, 1); PG8_SCHED; PG8_LDA(At, 0, 0); PG8_STAGE(PG8_SA(1, 1), a1 + hstepA, voffA);
            PG8_WAIT_V(8); PG8_WAIT_L(0); PG8_BAR; PG8_MMA(0, 0, At, B0); PG8_MMA(0, 1, At, B1); PG8_BAR; PG8_SCHED;
            PG8_LDA(At, 0, 1); PG8_STAGE(PG8_SB(0, 0), b2, voffB); PG8_STAGE(PG8_SB(0, 1), b2 + hstepB, voffB); PG8_STAGE(PG8_SA(0, 0), a2, voffA);
            PG8_WAIT_V(8); PG8_WAIT_L(0); PG8_BAR; PG8_MMA(1, 0, At, B0); PG8_MMA(1, 1, At, B1); PG8_BAR; PG8_SCHED;
            PG8_LDB(B0, 1, 0); PG8_LDB(B1, 1, 1); PG8_SCHED; PG8_LDA(At, 1, 0); PG8_STAGE(PG8_SA(0, 1), a2 + hstepA, voffA);
            PG8_WAIT_V(8); PG8_WAIT_L(0); PG8_BAR; PG8_MMA(0, 0, At, B0); PG8_MMA(0, 1, At, B1); PG8_BAR; PG8_SCHED;
            PG8_LDA(At, 1, 1); PG8_STAGE(PG8_SB(1, 0), b3, voffB); PG8_STAGE(PG8_SB(1, 1), b3 + hstepB, voffB); PG8_STAGE(PG8_SA(1, 0), a3, voffA);
            PG8_WAIT_V(8); PG8_WAIT_L(0); PG8_BAR; PG8_MMA(1, 0, At, B0); PG8_MMA(1, 1, At, B1); PG8_BAR; PG8_SCHED;
            } else {
            PG8_LDB(B0, 0, 0); PG8_SCHED; PG8_LDA(At, 0, 0); PG8_STAGE(PG8_SA(1, 1), a1 + hstepA, voffA);
            PG8_WAIT_L(8); PG8_BAR; PG8_WAIT_L(0); PG8_MMA(0, 0, At, B0); PG8_BAR; PG8_SCHED;
            PG8_LDB(B1, 0, 1); PG8_STAGE(PG8_SB(0, 0), b2, voffB);
            PG8_BAR; PG8_WAIT_L(0); PG8_MMA(0, 1, At, B1); PG8_BAR;
            PG8_LDA(At, 0, 1); PG8_STAGE(PG8_SA(0, 0), a2, voffA);
            PG8_BAR; PG8_WAIT_L(0); PG8_MMA(1, 0, At, B0); PG8_BAR; PG8_SCHED;
            PG8_STAGE(PG8_SB(0, 1), b2 + hstepB, voffB);
            PG8_WAIT_V(6); PG8_BAR; PG8_MMA(1, 1, At, B1); PG8_BAR;
            PG8_LDB(B0, 1, 0); PG8_SCHED; PG8_LDA(At, 1, 0); PG8_STAGE(PG8_SA(0, 1), a2 + hstepA, voffA);
            PG8_WAIT_L(8); PG8_BAR; PG8_WAIT_L(0); PG8_MMA(0, 0, At, B0); PG8_BAR; PG8_SCHED;
            PG8_LDB(B1, 1, 1); PG8_STAGE(PG8_SB(1, 0), b3, voffB);
            PG8_BAR; PG8_WAIT_L(0); PG8_MMA(0, 1, At, B1); PG8_BAR;
            PG8_LDA(At, 1, 1); PG8_STAGE(PG8_SA(1, 0), a3, voffA);
            PG8_BAR; PG8_WAIT_L(0); PG8_MMA(1, 0, At, B0); PG8_BAR; PG8_SCHED;
            PG8_STAGE(PG8_SB(1, 1), b3 + hstepB, voffB);
            PG8_WAIT_V(6); PG8_BAR; PG8_MMA(1, 1, At, B1); PG8_BAR;
            }
        }
        if constexpr (ALIGN_EPI) { if (wr == 0) PG8_BAR; }
        if (cur.piece < 0 && !dry) E(acc, cur, wr, wc, fr, fq);
        if (!has_next) break;
#pragma unroll
        for (int a = 0; a < 2; ++a)
#pragma unroll
            for (int b = 0; b < 2; ++b)
#pragma unroll
                for (int m = 0; m < 4; ++m)
#pragma unroll
                    for (int n = 0; n < 2; ++n) acc[a][b][m][n] = (f32x4){0.f, 0.f, 0.f, 0.f};
        cur = nxt; cA = nA; cB = nB; ++ui;
        if constexpr (ALIGN_EPI) { if (wr == 1) PG8_BAR; }
    }
    PG8_WAIT_V(0);
    if constexpr (!ALIGN_EPI) { if (wr == 0) PG8_BAR; }
    PG8_BAR;
    if constexpr (Epi::SPLIT) {
    if (cur.piece >= 0 && !dry) {
        float* slab0 = slabs + (size_t)cur.lu * (8 * 4 * 8192);
        {
            const __amdgpu_buffer_rsrc_t rs = __builtin_amdgcn_make_buffer_rsrc((void*)slab0, (short)0, 8 * 4 * 32768, 0x00020000);
#pragma unroll
            for (int a = 0; a < 2; ++a)
#pragma unroll
                for (int m = 0; m < 4; ++m) {
                    const int gq = a * 4 + m;
                    if ((gq >> 1) != cur.piece) {
#pragma unroll
                        for (int b = 0; b < 2; ++b)
#pragma unroll
                            for (int n = 0; n < 2; ++n) __builtin_amdgcn_raw_buffer_store_b128(__builtin_bit_cast(u32x4, acc[a][b][m][n]), rs, (gq * 4 + cur.piece) * 32768 + (b * 2 + n) * 8192 + tid * 16, 0, 16);
                    }
                }
        }
        asm volatile("s_waitcnt vmcnt(0)" ::: "memory");
        __syncthreads();
        if (tid == 0) {
            __hip_atomic_fetch_add(tickets + 64 * cur.lu, 1u, __ATOMIC_RELAXED, __HIP_MEMORY_SCOPE_AGENT);
            unsigned sp = 0;
            while (__hip_atomic_load(tickets + 64 * cur.lu, __ATOMIC_RELAXED, __HIP_MEMORY_SCOPE_AGENT) < 4u) { __builtin_amdgcn_s_sleep(2); if (++sp > (1u << 20)) break; }
            __builtin_amdgcn_fence(__ATOMIC_ACQUIRE, "agent"); asm volatile("s_waitcnt vmcnt(0)" ::: "memory");
        }
        __syncthreads();
        switch (cur.piece) {
            case 0: reduce_rowgroup<0, 0, 0>(acc, slab0, tid); reduce_rowgroup<0, 0, 1>(acc, slab0, tid); break;
            case 1: reduce_rowgroup<1, 0, 2>(acc, slab0, tid); reduce_rowgroup<1, 0, 3>(acc, slab0, tid); break;
            case 2: reduce_rowgroup<2, 1, 0>(acc, slab0, tid); reduce_rowgroup<2, 1, 1>(acc, slab0, tid); break;
            default: reduce_rowgroup<3, 1, 2>(acc, slab0, tid); reduce_rowgroup<3, 1, 3>(acc, slab0, tid); break;
        }
        E(acc, cur, wr, wc, fr, fq, 3u << (2 * cur.piece));
    }
    }
#undef PG8_SA
#undef PG8_SB
#undef PG8_STAGE
#undef PG8_LDA
#undef PG8_LDB
#undef PG8_MMA
#undef PG8_WAIT_V
#undef PG8_WAIT_L
#undef PG8_BAR
#undef PG8_SCHED
}
}

typedef f32x4 Acc[2][2][4][2];

struct EpiZ {
    static constexpr bool SPLIT = false;
    const LAS float* rstab; bf16_t* z; float* out;
    __device__ __forceinline__ void operator()(const Acc& acc, const pg8::Unit& u, int wr, int wc, int fr, int fq) const {
        asm volatile("" : "+v"(fr), "+v"(fq));
        const int col0 = u.pn * 256 + wc * 32 + 8 * fq;
#pragma unroll
        for (int ai = 0; ai < 2; ++ai)
#pragma unroll
            for (int m = 0; m < 4; ++m) {
                const int r = u.pm * 256 + ai * 128 + wr * 64 + m * 16 + fr;
                if (r < M) {
                    const float rs = rstab[u.idx * 256 + ai * 128 + wr * 64 + m * 16 + fr];
                    int is_s, seq, t; row_decode(r, is_s, seq, t);
                    float* so = nullptr;
                    if (u.pn < 6) { if (is_s) { if (t >= TS - 3) so = out + O_SRC + ((size_t)seq * 3 + (t - (TS - 3))) * DA; } else { if (t >= TP - 3) so = out + O_PRC + ((size_t)seq * 3 + (t - (TP - 3))) * DA; } }
#pragma unroll
                    for (int bj = 0; bj < 2; ++bj) {
                        const f32x4 v0 = acc[ai][bj][m][0] * rs, v1 = acc[ai][bj][m][1] * rs;
                        u32x4 w; w.x = cvt_pk_bf16(v0[0], v0[1]); w.y = cvt_pk_bf16(v0[2], v0[3]); w.z = cvt_pk_bf16(v1[0], v1[1]); w.w = cvt_pk_bf16(v1[2], v1[3]);
                        *(u32x4*)(z + (size_t)r * DIN + col0 + bj * 128) = w;
                        if (so) { *(f32x4*)(so + col0 + bj * 128) = v0; *(f32x4*)(so + col0 + bj * 128 + 4) = v1; }
                    }
                }
            }
    }
};
__device__ __forceinline__ void rstd1_table(const float* rstd1, LAS float* tab, const pg8::StaticOrder& S) {
    const int tid = opaque_tid(), q = tid & 255;
    pg8::Unit u;
    for (int i = tid >> 8; S.next(i, u); i += 2) { const int r = u.pm * 256 + q; tab[i * 256 + q] = r < M ? rstd1[r] : 0.f; }
}
struct EpiX1 {
    static constexpr bool SPLIT = true;
    bf16_t* xb; float* ssq;
    __device__ __forceinline__ void operator()(const Acc& acc, const pg8::Unit& u, int wr, int wc, int fr, int fq, unsigned gmask = 0xffu) const {
        asm volatile("" : "+v"(fr), "+v"(fq));
        const int col0 = u.pn * 256 + wc * 32 + 8 * fq;
#pragma unroll
        for (int ai = 0; ai < 2; ++ai) {
            if (!((gmask >> (ai * 4)) & 0xfu)) continue;
            u32x4 xv[4][2];
#pragma unroll
            for (int m = 0; m < 4; ++m) {
                const int r = u.pm * 256 + ai * 128 + wr * 64 + m * 16 + fr;
                const bf16_t* xr = xb + (size_t)(r < M ? r : 0) * D + col0;
#pragma unroll
                for (int bj = 0; bj < 2; ++bj) xv[m][bj] = *(const u32x4*)(xr + bj * 128);
            }
#pragma unroll
            for (int m = 0; m < 4; ++m) {
                if (!((gmask >> (ai * 4 + m)) & 1u)) continue;
                const int r = u.pm * 256 + ai * 128 + wr * 64 + m * 16 + fr;
                const bool valid = r < M;
                float ss = 0.f;
#pragma unroll
                for (int bj = 0; bj < 2; ++bj) {
                    float xf[8]; unpack8(xv[m][bj], xf);
                    const f32x4 a0 = acc[ai][bj][m][0], a1 = acc[ai][bj][m][1];
                    const f32x4 v0 = (f32x4){a0[0] + xf[0], a0[1] + xf[1], a0[2] + xf[2], a0[3] + xf[3]}, v1 = (f32x4){a1[0] + xf[4], a1[1] + xf[5], a1[2] + xf[6], a1[3] + xf[7]};
                    ss += (v0[0] * v0[0] + v0[1] * v0[1]) + (v0[2] * v0[2] + v0[3] * v0[3]) + (v1[0] * v1[0] + v1[1] * v1[1]) + (v1[2] * v1[2] + v1[3] * v1[3]);
                    if (valid) { u32x4 w; w.x = cvt_pk_bf16(v0[0], v0[1]); w.y = cvt_pk_bf16(v0[2], v0[3]); w.z = cvt_pk_bf16(v1[0], v1[1]); w.w = cvt_pk_bf16(v1[2], v1[3]);
                        *(u32x4*)(xb + (size_t)r * D + col0 + bj * 128) = w; }
                }
                ss += __shfl_xor(ss, 16); ss += __shfl_xor(ss, 32);
                if (valid && fq == 0) ssq[(size_t)r * 32 + u.pn * 4 + wc] = ss;
            }
        }
    }
};
struct EpiOut {
    static constexpr bool SPLIT = true;
    const bf16_t* x1b; bf16_t* x2b;
    __device__ __forceinline__ void operator()(const Acc& acc, const pg8::Unit& u, int wr, int wc, int fr, int fq, unsigned gmask = 0xffu) const {
        asm volatile("" : "+v"(fr), "+v"(fq));
        const int col0 = u.pn * 256 + wc * 32 + 8 * fq;
#pragma unroll
        for (int ai = 0; ai < 2; ++ai) {
            if (!((gmask >> (ai * 4)) & 0xfu)) continue;
            u32x4 xv[4][2];
#pragma unroll
            for (int m = 0; m < 4; ++m) {
                const int r = u.pm * 256 + ai * 128 + wr * 64 + m * 16 + fr;
                const bf16_t* xr = x1b + (size_t)(r < M ? r : 0) * D + col0;
#pragma unroll
                for (int bj = 0; bj < 2; ++bj) xv[m][bj] = *(const u32x4*)(xr + bj * 128);
            }
#pragma unroll
            for (int m = 0; m < 4; ++m) {
                if (!((gmask >> (ai * 4 + m)) & 1u)) continue;
                const int r = u.pm * 256 + ai * 128 + wr * 64 + m * 16 + fr;
                if (r < M) {
#pragma unroll
                    for (int bj = 0; bj < 2; ++bj) {
                        float xf[8]; unpack8(xv[m][bj], xf);
                        const f32x4 a0 = acc[ai][bj][m][0], a1 = acc[ai][bj][m][1];
                        u32x4 w; w.x = cvt_pk_bf16(a0[0] + xf[0], a0[1] + xf[1]); w.y = cvt_pk_bf16(a0[2] + xf[2], a0[3] + xf[3]); w.z = cvt_pk_bf16(a1[0] + xf[4], a1[1] + xf[5]); w.w = cvt_pk_bf16(a1[2] + xf[6], a1[3] + xf[7]);
                        *(u32x4*)(x2b + (size_t)r * D + col0 + bj * 128) = w;
                    }
                }
            }
        }
    }
};
struct EpiFFN {
    static constexpr bool SPLIT = false;
    const float* st_fc; bf16_t* hid; float* out; const LAS float* rstab; const LAS float* wtab;
    __device__ __forceinline__ void operator()(Acc& acc, const pg8::Unit& u, int wr, int wc, int fr, int fq) const {
        asm volatile("" : "+v"(fr), "+v"(fq));
        const int gbase = 252 * u.pm - 2 + 126 * wr;
        const int f0 = 128 * u.pn + 32 * wc + 8 * fq;
        const LAS float* wt = wtab + u.idx * 512 + 32 * wc + 8 * fq;
        const f32x4 w0a = *(const LAS f32x4*)(wt), w0b = *(const LAS f32x4*)(wt + 4);
        const f32x4 w1a = *(const LAS f32x4*)(wt + 128), w1b = *(const LAS f32x4*)(wt + 128 + 4);
        const f32x4 w2a = *(const LAS f32x4*)(wt + 256), w2b = *(const LAS f32x4*)(wt + 256 + 4);
        const f32x4 bba = *(const LAS f32x4*)(wt + 384), bbb = *(const LAS f32x4*)(wt + 384 + 4);
        const LAS float* rt = rstab + u.idx * 256 + wr * 128 + fr;
#pragma unroll
        for (int ai = 0; ai < 2; ++ai)
#pragma unroll
            for (int m = 0; m < 4; ++m) {
                const float rs = rt[64 * ai + 16 * m];
#pragma unroll
                for (int bj = 0; bj < 2; ++bj)
#pragma unroll
                    for (int n = 0; n < 2; ++n) acc[ai][bj][m][n] *= rs;
            }
        const bool has_samples = 252 * u.pm + 252 > MPR;
#pragma unroll
        for (int ai = 0; ai < 2; ++ai)
#pragma unroll
            for (int m = 0; m < 4; ++m) {
                const int j = 64 * ai + 16 * m + fr, r = gbase + j;
                const bool valid = (j >= 2) && (r < M);
                const f32x4 c0 = acc[ai][0][m][0], c1 = acc[ai][0][m][1];
                const int pai = (m == 0) ? (ai == 0 ? 0 : ai - 1) : ai, pm_ = (m == 0) ? (ai == 0 ? 0 : 3) : m - 1;
                const f32x4 q0 = acc[pai][0][pm_][0], q1 = acc[pai][0][pm_][1];
                f32x4 p1a, p1b, p2a, p2b;
#pragma unroll
                for (int e = 0; e < 4; ++e) {
                    p1a[e] = dppf<0x111>(dppf<0x121>(0.f, q0[e]), c0[e]); p1b[e] = dppf<0x111>(dppf<0x121>(0.f, q1[e]), c1[e]);
                    p2a[e] = dppf<0x112>(dppf<0x122>(0.f, q0[e]), c0[e]); p2b[e] = dppf<0x112>(dppf<0x122>(0.f, q1[e]), c1[e]);
                }
                int is_s, seq, t; row_decode(valid ? r : 0, is_s, seq, t);
                if (!has_samples) {
                    const f32x4 zz = (f32x4){0.f, 0.f, 0.f, 0.f};
                    if (t == 0) { p1a = zz; p1b = zz; }
                    if (t < 2) { p2a = zz; p2b = zz; }
                } else if (valid && t < 2) {
                    f32x4 s0a = (f32x4){0.f, 0.f, 0.f, 0.f}, s0b = s0a, s1a = s0a, s1b = s0a;
                    if (is_s) { const float* sp = st_fc + (size_t)seq * 2 * DFF + f0; s0a = *(const f32x4*)sp; s0b = *(const f32x4*)(sp + 4); s1a = *(const f32x4*)(sp + DFF); s1b = *(const f32x4*)(sp + DFF + 4); }
                    if (t == 0) { p1a = s1a; p1b = s1b; p2a = s0a; p2b = s0b; } else { p2a = s1a; p2b = s1b; }
                }
                const f32x4 ga = w0a * p2a + w1a * p1a + w2a * c0 + bba, gb = w0b * p2b + w1b * p1b + w2b * c1 + bbb;
                const f32x4 va = acc[ai][1][m][0], vb = acc[ai][1][m][1];
                if (valid) {
                    u32x4 w;
                    w.x = cvt_pk_bf16(gelu_tanh(ga[0]) * va[0], gelu_tanh(ga[1]) * va[1]); w.y = cvt_pk_bf16(gelu_tanh(ga[2]) * va[2], gelu_tanh(ga[3]) * va[3]);
                    w.z = cvt_pk_bf16(gelu_tanh(gb[0]) * vb[0], gelu_tanh(gb[1]) * vb[1]); w.w = cvt_pk_bf16(gelu_tanh(gb[2]) * vb[2], gelu_tanh(gb[3]) * vb[3]);
                    *(u32x4*)(hid + (size_t)r * DFF + f0) = w;
                    const int T = is_s ? TS : TP;
                    if (t >= T - 2) { float* so = out + (is_s ? O_SFC : O_PFC) + ((size_t)seq * 2 + (t - (T - 2))) * DFF + f0; *(f32x4*)so = c0; *(f32x4*)(so + 4) = c1; }
                }
                if (m & 1) __builtin_amdgcn_sched_barrier(0);
            }
    }
};
__device__ __forceinline__ void ffn_rstd_table(const float* ssq, const float* cw, const float* cb, LAS float* tab, LAS float* wtab, const pg8::StaticOrder& S) {
    const int tid = opaque_tid(), q = tid >> 1, half = tid & 1;
    pg8::Unit u;
    for (int i = 0; S.next(i, u); ++i) {
        { const int k = tid >> 7, c = tid & 127, f = 128 * u.pn + c; wtab[i * 512 + tid] = k < 3 ? cw[k * DFF + f] : cb[f]; }
        int r = 252 * u.pm - 2 + 126 * (q >> 7) + (q & 127); r = r < 0 ? 0 : (r >= M ? M - 1 : r);
        const float* sp = ssq + (size_t)r * 32 + 16 * half;
        const f32x4 a = *(const f32x4*)sp, b = *(const f32x4*)(sp + 4), c = *(const f32x4*)(sp + 8), d = *(const f32x4*)(sp + 12);
        float sm = (((a[0] + a[1]) + (a[2] + a[3])) + ((b[0] + b[1]) + (b[2] + b[3]))) + (((c[0] + c[1]) + (c[2] + c[3])) + ((d[0] + d[1]) + (d[2] + d[3])));
        sm += __shfl_xor(sm, 1);
        if (half == 0) tab[i * 256 + q] = __builtin_amdgcn_rsqf(sm * (1.0f / D) + EPS);
    }
}

struct EpiProbe {
    static constexpr bool SPLIT = false;
    bf16_t* hid;
    __device__ __forceinline__ void operator()(const Acc& acc, const pg8::Unit& u, int wr, int wc, int fr, int fq) const {
        asm volatile("" : "+v"(fr), "+v"(fq));
        const int gbase = 252 * u.pm - 2 + 126 * wr, f0 = 128 * u.pn + 32 * wc + 8 * fq;
#pragma unroll
        for (int ai = 0; ai < 2; ++ai)
#pragma unroll
            for (int m = 0; m < 4; ++m) {
                const int j = 64 * ai + 16 * m + fr, r = gbase + j;
                if (j >= 2 && r < M) { const f32x4 a = acc[ai][0][m][0] + acc[ai][1][m][0], b = acc[ai][0][m][1] + acc[ai][1][m][1];
                    u32x4 w; w.x = cvt_pk_bf16(a[0], a[1]); w.y = cvt_pk_bf16(a[2], a[3]); w.z = cvt_pk_bf16(b[0], b[1]); w.w = cvt_pk_bf16(b[2], b[3]);
                    *(u32x4*)(hid + (size_t)r * DFF + f0) = w; }
            }
    }
};

__device__ __forceinline__ int invperm32(int q) { return 16 * ((q >> 2) & 1) + 4 * (q >> 3) + (q & 3); }
__device__ __forceinline__ void p0_transpose_item(const float* W, int K, int N, const float* kscale, bf16_t* WT, int mode, LAS float* scr, int item, int lane) {
    const int nblk = N / 32, kb = item / nblk, nb = item % nblk, k0 = 64 * kb, n0 = 32 * nb;
    float v[32];
    const float* src = W + (size_t)(k0 + (lane >> 5)) * N + n0 + (lane & 31);
#pragma unroll
    for (int i = 0; i < 32; ++i) v[i] = src[(size_t)(2 * i) * N];
#pragma unroll
    for (int i = 0; i < 32; ++i) scr[(2 * i + (lane >> 5)) * 33 + (lane & 31)] = v[i];
    asm volatile("s_waitcnt lgkmcnt(0)" ::: "memory");
    int rbase = n0;
    if (mode == 1) { const int bj = n0 >= DFF ? 1 : 0, f = n0 - bj * DFF; rbase = 256 * (f >> 7) + 128 * bj + (f & 96); }
    const int c = lane & 7;
    f32x4 ks0 = (f32x4){1.f, 1.f, 1.f, 1.f}, ks1 = ks0;
    if (kscale) { ks0 = *(const f32x4*)(kscale + k0 + 8 * c); ks1 = *(const f32x4*)(kscale + k0 + 8 * c + 4); }
#pragma unroll
    for (int j = 0; j < 4; ++j) { const int n = (lane >> 3) + 8 * j; const LAS float* sp = scr + (8 * c) * 33 + n;
        u32x4 o; o.x = cvt_pk_bf16(sp[0 * 33] * ks0[0], sp[1 * 33] * ks0[1]); o.y = cvt_pk_bf16(sp[2 * 33] * ks0[2], sp[3 * 33] * ks0[3]);
        o.z = cvt_pk_bf16(sp[4 * 33] * ks1[0], sp[5 * 33] * ks1[1]); o.w = cvt_pk_bf16(sp[6 * 33] * ks1[2], sp[7 * 33] * ks1[3]);
        *(u32x4*)(WT + (size_t)(rbase + (mode == 2 ? n : invperm32(n))) * K + k0 + 8 * c) = o; }
    asm volatile("s_waitcnt lgkmcnt(0)" ::: "memory");
}
constexpr int I_IN = (D / 64) * (DIN / 32), I_O = (DMIX / 64) * (D / 32), I_UP = (D / 64) * (2 * DFF / 32), I_DN = (DFF / 64) * (D / 32), I_G = 2 * NH * 8;
constexpr int IT_O = I_IN, IT_UP = IT_O + I_O, IT_DN = IT_UP + I_UP, IT_G = IT_DN + I_DN, IT_END = IT_G + I_G;
__device__ __forceinline__ void convert_items(PRef p, LAS unsigned char* lds, int rank, int nwaves, int lo, int hi) {
    const int tid_ = opaque_tid(), lane = tid_ & 63, wave = tid_ >> 6;
    unsigned char* ws = p.ws;
    LAS float* scr = (LAS float*)(lds + wave * 16384);
    for (int it = lo + rank; it < hi; it += nwaves) {
        int r = it;
        if (r < I_IN) { p0_transpose_item(p.w_in, D, DIN, p.g_mix, (bf16_t*)(ws + WS_WIN), 0, scr, r, lane); continue; } r -= I_IN;
        if (r < I_O) { p0_transpose_item(p.w_o, DMIX, D, nullptr, (bf16_t*)(ws + WS_WO), 0, scr, r, lane); continue; } r -= I_O;
        if (r < I_UP) { p0_transpose_item(p.w_up, D, 2 * DFF, p.g_ffn, (bf16_t*)(ws + WS_WUP), 1, scr, r, lane); continue; } r -= I_UP;
        if (r < I_DN) { p0_transpose_item(p.w_down, DFF, D, nullptr, (bf16_t*)(ws + WS_WDN), 0, scr, r, lane); continue; } r -= I_DN;
        { const int mat = r >> 3, sub = r & 7, gsel = mat / NH, n = mat % NH;
          p0_transpose_item((gsel ? p.w_gate_x : p.w_gate_a) + (size_t)n * 128 * 128, 128, 128, nullptr, (bf16_t*)(ws + WS_WG) + (size_t)mat * 128 * 128, 0, scr, sub, lane); }
    }
}
constexpr int P1_TAIL_WG0 = (888 % 256), P4_TAIL_WG0 = (296 % 256) * P4_SPLIT, MIX_IDLE_WG0 = 228, IT_S1 = IT_O + 10600, IT_S2 = IT_S1 + 1600, IT_S3 = IT_S2 + 1600;
__device__ __forceinline__ void phase0(PRef p, LAS unsigned char* lds, int G) {
    const int tid = opaque_tid(), lane = tid & 63, wave = tid >> 6;
    unsigned char* ws = p.ws;
    const int gw = blockIdx.x * 8 + wave, NGW = G * 8;
    convert_items(p, lds, gw, NGW, 0, IT_O);
    convert_items(p, lds, gw, NGW, IT_G, IT_END);
    { bf16_t* xb = (bf16_t*)(ws + WS_XB) + (size_t)16 * D; float* rstd1 = (float*)(ws + WS_RS1);
      for (int m = gw; m < M; m += NGW) {
          const f32x4* xr = (const f32x4*)x_row_ptr(p.x_prompt, p.x_sample, p.meta, m) + lane;
          f32x4 v[8]; float s = 0.f;
#pragma unroll
          for (int j = 0; j < 8; ++j) { v[j] = xr[64 * j]; s += (v[j][0] * v[j][0] + v[j][1] * v[j][1]) + (v[j][2] * v[j][2] + v[j][3] * v[j][3]); }
          s = wave_sum(s);
          if (lane == 0) rstd1[m] = __builtin_amdgcn_rsqf(s * (1.0f / D) + EPS);
          u32x2* o = (u32x2*)(xb + (size_t)m * D) + lane;
#pragma unroll
          for (int j = 0; j < 8; ++j) { u32x2 w; w.x = cvt_pk_bf16(v[j][0], v[j][1]); w.y = cvt_pk_bf16(v[j][2], v[j][3]); o[64 * j] = w; }
      } }
}

__device__ __forceinline__ void branch_b(PRef p, int G) {
    const bf16_t* z = (const bf16_t*)(p.ws + WS_Z); bf16_t* ym = (bf16_t*)(p.ws + WS_YM);
    const int total = (M / 4) * 128;
    for (int idx = blockIdx.x * 512 + opaque_tid(); idx < total; idx += G * 512) {
        const int m0 = (idx >> 7) * 4, g = idx & 127, ch = 8 * g;
        int is_s, seq, t0; row_decode(m0, is_s, seq, t0);
        u32x4 rc[6], rv[6], rg[4];
#pragma unroll
        for (int k = 0; k < 6; ++k) {
            const int mm = (t0 - 2 + k >= 0) ? m0 - 2 + k : m0;
            rc[k] = *(const u32x4*)(z + (size_t)mm * DIN + 4096 + ch); rv[k] = *(const u32x4*)(z + (size_t)mm * DIN + 5120 + ch);
        }
#pragma unroll
        for (int k = 0; k < 4; ++k) rg[k] = *(const u32x4*)(z + (size_t)(m0 + k) * DIN + 3072 + ch);
        const f32x4 w0a = *(const f32x4*)(p.conv_b_w + ch), w0b = *(const f32x4*)(p.conv_b_w + ch + 4), w1a = *(const f32x4*)(p.conv_b_w + DB + ch), w1b = *(const f32x4*)(p.conv_b_w + DB + ch + 4),
                    w2a = *(const f32x4*)(p.conv_b_w + 2 * DB + ch), w2b = *(const f32x4*)(p.conv_b_w + 2 * DB + ch + 4), goa = *(const f32x4*)(p.g_out_b + ch), gob = *(const f32x4*)(p.g_out_b + ch + 4);
        float u[6][8];
#pragma unroll
        for (int k = 0; k < 6; ++k) {
            float a[8], b[8]; unpack8(rc[k], a); unpack8(rv[k], b);
#pragma unroll
            for (int e = 0; e < 8; ++e) u[k][e] = a[e] * b[e];
        }
        if (t0 == 0) {
#pragma unroll
            for (int k = 0; k < 2; ++k) {
                f32x4 a = (f32x4){0.f, 0.f, 0.f, 0.f}, b = a;
                if (is_s) { const float* sp = p.st_sc + ((size_t)seq * 2 + k) * DB + ch; a = *(const f32x4*)sp; b = *(const f32x4*)(sp + 4); }
#pragma unroll
                for (int e = 0; e < 4; ++e) { u[k][e] = a[e]; u[k][4 + e] = b[e]; }
            }
        }
        const int T = is_s ? TS : TP;
#pragma unroll
        for (int k = 0; k < 4; ++k) {
            float gb[8]; unpack8(rg[k], gb);
            float y[8]; float ss = 0.f;
#pragma unroll
            for (int e = 0; e < 8; ++e) {
                const float uc = (e < 4 ? w0a[e & 3] : w0b[e & 3]) * u[k][e] + (e < 4 ? w1a[e & 3] : w1b[e & 3]) * u[k + 1][e] + (e < 4 ? w2a[e & 3] : w2b[e & 3]) * u[k + 2][e];
                y[e] = gb[e] * uc; ss += y[e] * y[e];
            }
            ss = sum16(ss);
            const float rn = __builtin_amdgcn_rsqf(ss * (1.0f / 128.0f) + EPS);
#pragma unroll
            for (int e = 0; e < 8; ++e) y[e] = y[e] * rn * (e < 4 ? goa[e & 3] : gob[e & 3]);
            *(u32x4*)(ym + (size_t)(m0 + k) * DMIX + DA + ch) = pack8(y);
            const int t = t0 + k;
            if (t >= T - 2) { float* so = p.out + (is_s ? O_SSC : O_PSC) + ((size_t)seq * 2 + (t - (T - 2))) * DB + ch;
                *(f32x4*)so = (f32x4){u[k + 2][0], u[k + 2][1], u[k + 2][2], u[k + 2][3]}; *(f32x4*)(so + 4) = (f32x4){u[k + 2][4], u[k + 2][5], u[k + 2][6], u[k + 2][7]}; }
        }
    }
}

constexpr int LW_STRIDE = 272, L_WA = 0, L_WX = 128 * LW_STRIDE, L_CT = 2 * 128 * LW_STRIDE, L_LRU_END = L_CT + 9 * 128 * 4;
static_assert(L_LRU_END <= 131072, "mixer LDS");
constexpr int LRU_WG_PER_HEAD = 19, LRU_NSEG = 33, LRU_PITEMS = NB * LRU_NSEG, LRU_SITEMS = MSR / 64;
static_assert(LRU_WG_PER_HEAD * 8 >= LRU_PITEMS + LRU_SITEMS, "waves per head");

template <int CTRL, int BANK> __device__ __forceinline__ float dppfb(float old, float src) {
    return __builtin_bit_cast(float, __builtin_amdgcn_update_dpp(__builtin_bit_cast(int, old), __builtin_bit_cast(int, src), CTRL, 0xF, BANK, false));
}
__device__ __forceinline__ float bcast15(float x, int lane) {
    return __builtin_bit_cast(float, __builtin_amdgcn_ds_bpermute(((lane & 48) | 15) << 2, __builtin_bit_cast(int, x)));
}
__device__ __forceinline__ void scan16(float& P, float& S) {
    float Sd, Pd;
    Sd = dppf<0x111>(0.f, S); Pd = dppf<0x111>(1.f, P); S = __builtin_fmaf(P, Sd, S); P *= Pd;
    Sd = dppf<0x112>(0.f, S); Pd = dppf<0x112>(1.f, P); S = __builtin_fmaf(P, Sd, S); P *= Pd;
    Sd = dppf<0x114>(0.f, S); Pd = dppf<0x114>(1.f, P); S = __builtin_fmaf(P, Sd, S); P *= Pd;
    Sd = dppf<0x118>(0.f, S); Pd = dppf<0x118>(1.f, P); S = __builtin_fmaf(P, Sd, S); P *= Pd;
}
__device__ __forceinline__ void scan16x2(float& P1, float& S1, float& P2, float& S2) {
    asm volatile(
        "s_nop 1\n\t"
        "v_fmac_f32_dpp %1, %1, %0 row_shr:1 row_mask:0xf bank_mask:0xf bound_ctrl:1\n\t"
        "v_fmac_f32_dpp %3, %3, %2 row_shr:1 row_mask:0xf bank_mask:0xf bound_ctrl:1\n\t"
        "v_mul_f32_dpp %0, %0, %0 row_shr:1 row_mask:0xf bank_mask:0xf\n\t"
        "v_mul_f32_dpp %2, %2, %2 row_shr:1 row_mask:0xf bank_mask:0xf\n\t"
        "v_fmac_f32_dpp %1, %1, %0 row_shr:2 row_mask:0xf bank_mask:0xf bound_ctrl:1\n\t"
        "v_fmac_f32_dpp %3, %3, %2 row_shr:2 row_mask:0xf bank_mask:0xf bound_ctrl:1\n\t"
        "v_mul_f32_dpp %0, %0, %0 row_shr:2 row_mask:0xf bank_mask:0xf\n\t"
        "v_mul_f32_dpp %2, %2, %2 row_shr:2 row_mask:0xf bank_mask:0xf\n\t"
        "v_fmac_f32_dpp %1, %1, %0 row_shr:4 row_mask:0xf bank_mask:0xf bound_ctrl:1\n\t"
        "v_fmac_f32_dpp %3, %3, %2 row_shr:4 row_mask:0xf bank_mask:0xf bound_ctrl:1\n\t"
        "v_mul_f32_dpp %0, %0, %0 row_shr:4 row_mask:0xf bank_mask:0xf\n\t"
        "v_mul_f32_dpp %2, %2, %2 row_shr:4 row_mask:0xf bank_mask:0xf\n\t"
        "v_fmac_f32_dpp %1, %1, %0 row_shr:8 row_mask:0xf bank_mask:0xf bound_ctrl:1\n\t"
        "v_fmac_f32_dpp %3, %3, %2 row_shr:8 row_mask:0xf bank_mask:0xf bound_ctrl:1\n\t"
        "v_mul_f32_dpp %0, %0, %0 row_shr:8 row_mask:0xf bank_mask:0xf\n\t"
        "v_mul_f32_dpp %2, %2, %2 row_shr:8 row_mask:0xf bank_mask:0xf\n\t"
        "s_nop 0"
        : "+v"(P1), "+v"(S1), "+v"(P2), "+v"(S2));
}
__device__ __forceinline__ void scan8(float& P, float& S, int t) {
    float Sd, Pd;
    Sd = dppf<0x111>(0.f, S); Pd = dppf<0x111>(1.f, P); if (t < 1) { Sd = 0.f; Pd = 1.f; } S = __builtin_fmaf(P, Sd, S); P *= Pd;
    Sd = dppf<0x112>(0.f, S); Pd = dppf<0x112>(1.f, P); if (t < 2) { Sd = 0.f; Pd = 1.f; } S = __builtin_fmaf(P, Sd, S); P *= Pd;
    Sd = dppfb<0x114, 0xA>(0.f, S); Pd = dppfb<0x114, 0xA>(1.f, P); S = __builtin_fmaf(P, Sd, S); P *= Pd;
}

template <int PASS, bool IS_S>
__device__ __forceinline__ void lru_wave_item(PRef p, LAS unsigned char* lds, int n, int b, int seg) {
    const int lane = opaque_tid() & 63, fr = lane & 15, fq = lane >> 4;
    const bf16_t* z = (const bf16_t*)(p.ws + WS_Z);
    bf16_t* ym = (bf16_t*)(p.ws + WS_YM);
    float* tot = (float*)(p.ws + WS_TOT);
    const LAS float* CT = (const LAS float*)(lds + L_CT) + 8 * fq;
    const int gch = n * 128 + 8 * fq;
    const int r0 = IS_S ? MPR + b * 64 : b * TP + seg * 64;
    const int nblk = IS_S ? 4 : (seg == LRU_NSEG - 1 ? 1 : 4);
    float hin[4][8], Pt[4][8];
    u32x4 prevx[4];
#pragma unroll
    for (int ks = 0; ks < 4; ++ks) {
#pragma unroll
        for (int e = 0; e < 8; ++e) { hin[ks][e] = 0.f; Pt[ks][e] = 1.f; }
        prevx[ks] = (u32x4){0u, 0u, 0u, 0u};
    }
    if constexpr (!IS_S) {
        if (seg > 0) {
#pragma unroll
            for (int ks = 0; ks < 4; ++ks) prevx[ks] = *(const u32x4*)(z + (size_t)(r0 - 16 + fr) * DIN + gch + 32 * ks);
            if constexpr (PASS == 2) {
#pragma unroll 1
                for (int round = 0; round < 2; ++round) {
                    const int s = 16 * round + fr;
                    if (16 * round >= seg) break;
                    const bool have = s < seg;
                    const float* tp = tot + ((size_t)(b * LRU_NSEG + (have ? s : 0)) * 2) * DA + gch;
#pragma unroll
                    for (int ks = 0; ks < 4; ++ks) {
                        const f32x4 P0 = *(const f32x4*)(tp + 32 * ks), P1 = *(const f32x4*)(tp + 32 * ks + 4), S0 = *(const f32x4*)(tp + DA + 32 * ks), S1 = *(const f32x4*)(tp + DA + 32 * ks + 4);
#pragma unroll
                        for (int e = 0; e < 8; e += 2) {
                            float Pa = have ? (e < 4 ? P0[e & 3] : P1[e & 3]) : 1.f, Sa = have ? (e < 4 ? S0[e & 3] : S1[e & 3]) : 0.f;
                            float Pb = have ? (e < 4 ? P0[(e + 1) & 3] : P1[(e + 1) & 3]) : 1.f, Sb = have ? (e < 4 ? S0[(e + 1) & 3] : S1[(e + 1) & 3]) : 0.f;
                            scan16x2(Pa, Sa, Pb, Sb);
                            hin[ks][e] = __builtin_fmaf(bcast15(Pa, lane), hin[ks][e], bcast15(Sa, lane));
                            hin[ks][e + 1] = __builtin_fmaf(bcast15(Pb, lane), hin[ks][e + 1], bcast15(Sb, lane));
                        }
                    }
                }
            }
        }
    }
    u32x4 xnext[4];
#pragma unroll
    for (int ks = 0; ks < 4; ++ks) xnext[ks] = *(const u32x4*)(z + (size_t)(r0 + fr) * DIN + gch + 32 * ks);
#pragma unroll 1
    for (int blk = 0; blk < nblk; ++blk) {
        const int r = r0 + 16 * blk + fr;
        const int t8 = fr & 7, sq = (r - MPR) >> 3;
        u32x4 x4[4], g4[4];
#pragma unroll
        for (int ks = 0; ks < 4; ++ks) { x4[ks] = xnext[ks]; if constexpr (PASS == 2) g4[ks] = *(const u32x4*)(z + (size_t)r * DIN + DA + gch + 32 * ks); }
        { const int rn_ = (blk + 1 < nblk) ? r + 16 : r;
#pragma unroll
          for (int ks = 0; ks < 4; ++ks) xnext[ks] = *(const u32x4*)(z + (size_t)rn_ * DIN + gch + 32 * ks); }
        float xc[4][8];
        bf16x8 bfrag[4];
#pragma unroll
        for (int ks = 0; ks < 4; ++ks) {
            float xf[8]; unpack8(x4[ks], xf);
            const f32x4 w0a = *(const LAS f32x4*)(CT + 0 * 128 + 32 * ks), w0b = *(const LAS f32x4*)(CT + 0 * 128 + 32 * ks + 4);
            const f32x4 w1a = *(const LAS f32x4*)(CT + 1 * 128 + 32 * ks), w1b = *(const LAS f32x4*)(CT + 1 * 128 + 32 * ks + 4);
            const f32x4 w2a = *(const LAS f32x4*)(CT + 2 * 128 + 32 * ks), w2b = *(const LAS f32x4*)(CT + 2 * 128 + 32 * ks + 4);
            const f32x4 w3a = *(const LAS f32x4*)(CT + 3 * 128 + 32 * ks), w3b = *(const LAS f32x4*)(CT + 3 * 128 + 32 * ks + 4);
            const f32x4 cba = *(const LAS f32x4*)(CT + 4 * 128 + 32 * ks), cbb = *(const LAS f32x4*)(CT + 4 * 128 + 32 * ks + 4);
            if constexpr (IS_S) {
                const float* sp = p.st_rc + (size_t)sq * 3 * DA + gch + 32 * ks;
                const f32x4 b0a = *(const f32x4*)sp, b0b = *(const f32x4*)(sp + 4), b1a = *(const f32x4*)(sp + DA), b1b = *(const f32x4*)(sp + DA + 4), b2a = *(const f32x4*)(sp + 2 * DA), b2b = *(const f32x4*)(sp + 2 * DA + 4);
#pragma unroll
                for (int e = 0; e < 8; ++e) {
                    const float bb0 = e < 4 ? b0a[e & 3] : b0b[e & 3], bb1 = e < 4 ? b1a[e & 3] : b1b[e & 3], bb2 = e < 4 ? b2a[e & 3] : b2b[e & 3];
                    const float s1 = dppf<0x111>(0.f, xf[e]), s2 = dppf<0x112>(0.f, xf[e]), s3 = dppf<0x113>(0.f, xf[e]);
                    const float x1 = t8 >= 1 ? s1 : bb2;
                    const float x2 = t8 >= 2 ? s2 : (t8 == 1 ? bb2 : bb1);
                    const float x3 = t8 >= 3 ? s3 : (t8 == 2 ? bb2 : (t8 == 1 ? bb1 : bb0));
                    const float w0 = e < 4 ? w0a[e & 3] : w0b[e & 3], w1 = e < 4 ? w1a[e & 3] : w1b[e & 3], w2 = e < 4 ? w2a[e & 3] : w2b[e & 3], w3 = e < 4 ? w3a[e & 3] : w3b[e & 3];
                    xc[ks][e] = (e < 4 ? cba[e & 3] : cbb[e & 3]) + w3 * xf[e] + w2 * x1 + w1 * x2 + w0 * x3;
                }
            } else {
                float pf[8]; unpack8(prevx[ks], pf);
#pragma unroll
                for (int e = 0; e < 8; ++e) {
                    const float x1 = dppf<0x111>(dppf<0x121>(0.f, pf[e]), xf[e]);
                    const float x2 = dppf<0x112>(dppf<0x122>(0.f, pf[e]), xf[e]);
                    const float x3 = dppf<0x113>(dppf<0x123>(0.f, pf[e]), xf[e]);
                    const float w0 = e < 4 ? w0a[e & 3] : w0b[e & 3], w1 = e < 4 ? w1a[e & 3] : w1b[e & 3], w2 = e < 4 ? w2a[e & 3] : w2b[e & 3], w3 = e < 4 ? w3a[e & 3] : w3b[e & 3];
                    xc[ks][e] = (e < 4 ? cba[e & 3] : cbb[e & 3]) + w3 * xf[e] + w2 * x1 + w1 * x2 + w0 * x3;
                }
                prevx[ks] = x4[ks];
            }
            bfrag[ks] = __builtin_bit_cast(bf16x8, pack8(xc[ks]));
        }
        f32x4 aa[8], ax[8];
#pragma unroll
        for (int nb = 0; nb < 8; ++nb) { aa[nb] = (f32x4){0.f, 0.f, 0.f, 0.f}; ax[nb] = (f32x4){0.f, 0.f, 0.f, 0.f}; }
#pragma unroll
        for (int ks = 0; ks < 4; ++ks)
#pragma unroll
            for (int nb = 0; nb < 8; ++nb) {
                const bf16x8 wa = *(const LAS bf16x8*)(lds + L_WA + (16 * nb + fr) * LW_STRIDE + (32 * ks + 8 * fq) * 2);
                const bf16x8 wx = *(const LAS bf16x8*)(lds + L_WX + (16 * nb + fr) * LW_STRIDE + (32 * ks + 8 * fq) * 2);
                aa[nb] = __builtin_amdgcn_mfma_f32_16x16x32_bf16(wa, bfrag[ks], aa[nb], 0, 0, 0);
                ax[nb] = __builtin_amdgcn_mfma_f32_16x16x32_bf16(wx, bfrag[ks], ax[nb], 0, 0, 0);
            }
        float y[4][8]; float ss = 0.f;
#pragma unroll
        for (int ks = 0; ks < 4; ++ks) {
            const f32x4 bga0 = *(const LAS f32x4*)(CT + 5 * 128 + 32 * ks), bga1 = *(const LAS f32x4*)(CT + 5 * 128 + 32 * ks + 4);
            const f32x4 bgx0 = *(const LAS f32x4*)(CT + 6 * 128 + 32 * ks), bgx1 = *(const LAS f32x4*)(CT + 6 * 128 + 32 * ks + 4);
            const f32x4 sp0 = *(const LAS f32x4*)(CT + 7 * 128 + 32 * ks), sp1 = *(const LAS f32x4*)(CT + 7 * 128 + 32 * ks + 4);
            float gav[8];
            if constexpr (PASS == 2) unpack8(g4[ks], gav);
            f32x4 h0a, h0b;
            if constexpr (IS_S) { const float* hp = p.st_h + (size_t)sq * DA + gch + 32 * ks; h0a = *(const f32x4*)hp; h0b = *(const f32x4*)(hp + 4); }
            float hv[8], Pv[8], Sv[8];
#pragma unroll
            for (int e = 0; e < 8; ++e) {
                const int nb = 2 * ks + (e >> 2), rg = e & 3;
                const float rr = __builtin_amdgcn_rcpf(1.0f + __builtin_amdgcn_exp2f(__builtin_fmaf(aa[nb][rg], -1.4426950408889634f, e < 4 ? bga0[rg] : bga1[rg])));
                const float ii = __builtin_amdgcn_rcpf(1.0f + __builtin_amdgcn_exp2f(__builtin_fmaf(ax[nb][rg], -1.4426950408889634f, e < 4 ? bgx0[rg] : bgx1[rg])));
                const float a = __builtin_amdgcn_exp2f(rr * (e < 4 ? sp0[rg] : sp1[rg]));
                const float om = __builtin_fmaf(-a, a, 1.0f);
                Pv[e] = a; Sv[e] = __builtin_amdgcn_sqrtf(om > 0.f ? om : 0.f) * (ii * xc[ks][e]);
            }
            if constexpr (IS_S) {
#pragma unroll
                for (int e = 0; e < 8; ++e) { scan8(Pv[e], Sv[e], t8); hv[e] = __builtin_fmaf(Pv[e], e < 4 ? h0a[e & 3] : h0b[e & 3], Sv[e]); }
            } else {
#pragma unroll
                for (int e = 0; e < 8; e += 2) scan16x2(Pv[e], Sv[e], Pv[e + 1], Sv[e + 1]);
#pragma unroll
                for (int e = 0; e < 8; ++e) {
                    hv[e] = __builtin_fmaf(Pv[e], hin[ks][e], Sv[e]);
                    hin[ks][e] = bcast15(hv[e], lane);
                    if constexpr (PASS == 1) Pt[ks][e] *= bcast15(Pv[e], lane);
                }
            }
            if constexpr (PASS == 2) {
#pragma unroll
                for (int e = 0; e < 8; ++e) { y[ks][e] = gelu_tanh(gav[e]) * hv[e]; ss += y[ks][e] * y[ks][e]; }
            }
            if constexpr (PASS == 2) {
                if (IS_S ? (t8 == 7) : (seg == LRU_NSEG - 1 && fr == 15)) {
                    float* ho = p.out + (IS_S ? O_SH + (size_t)sq * DA : O_PH + (size_t)b * DA) + gch + 32 * ks;
                    *(f32x4*)ho = (f32x4){hv[0], hv[1], hv[2], hv[3]}; *(f32x4*)(ho + 4) = (f32x4){hv[4], hv[5], hv[6], hv[7]};
                }
            }
        }
        if constexpr (PASS == 2) {
            ss += __shfl_xor(ss, 16); ss += __shfl_xor(ss, 32);
            const float rn = __builtin_amdgcn_rsqf(ss * (1.0f / 128.0f) + EPS);
#pragma unroll
            for (int ks = 0; ks < 4; ++ks) {
                const f32x4 g0 = *(const LAS f32x4*)(CT + 8 * 128 + 32 * ks), g1 = *(const LAS f32x4*)(CT + 8 * 128 + 32 * ks + 4);
                float o[8];
#pragma unroll
                for (int e = 0; e < 8; ++e) o[e] = y[ks][e] * rn * (e < 4 ? g0[e & 3] : g1[e & 3]);
                *(u32x4*)(ym + (size_t)r * DMIX + gch + 32 * ks) = pack8(o);
            }
        }
    }
    if constexpr (PASS == 1 && !IS_S) {
        if (fr == 0) {
            float* tp = tot + ((size_t)(b * LRU_NSEG + seg) * 2) * DA + gch;
#pragma unroll
            for (int ks = 0; ks < 4; ++ks) {
                *(f32x4*)(tp + 32 * ks) = (f32x4){Pt[ks][0], Pt[ks][1], Pt[ks][2], Pt[ks][3]}; *(f32x4*)(tp + 32 * ks + 4) = (f32x4){Pt[ks][4], Pt[ks][5], Pt[ks][6], Pt[ks][7]};
                *(f32x4*)(tp + DA + 32 * ks) = (f32x4){hin[ks][0], hin[ks][1], hin[ks][2], hin[ks][3]}; *(f32x4*)(tp + DA + 32 * ks + 4) = (f32x4){hin[ks][4], hin[ks][5], hin[ks][6], hin[ks][7]};
            }
        }
    }
}
template <int PASS>
__device__ __forceinline__ void mixer_phase(PRef p, LAS unsigned char* lds, int G) {
    const int tid = opaque_tid(), wave = __builtin_amdgcn_readfirstlane(tid >> 6);
    for (int v = blockIdx.x; v < NH * LRU_WG_PER_HEAD; v += G) {
        const int n = v / LRU_WG_PER_HEAD;
        __syncthreads();
        if (!(PASS == 2 && G == GRID && p.ph_lo <= 2))
        {
            const bf16_t* wg = (const bf16_t*)(p.ws + WS_WG);
            for (int i = tid; i < 2 * 128 * 16; i += 512) { const int g = i >> 11, row = (i >> 4) & 127, c16 = i & 15;
                *(LAS u32x4*)(lds + g * L_WX + row * LW_STRIDE + c16 * 16) = *(const u32x4*)(wg + (((size_t)g * NH + n) * 128 + row) * 128 + c16 * 8); }
            LAS float* CTw = (LAS float*)(lds + L_CT);
            for (int i = tid; i < 9 * 128; i += 512) { const int k = i >> 7, c = i & 127, ch = n * 128 + c;
                float vv;
                if (k < 4) vv = p.conv_a_w[k * DA + ch]; else if (k == 4) vv = p.conv_a_b[ch]; else if (k == 5) vv = -1.4426950408889634f * p.b_gate_a[ch]; else if (k == 6) vv = -1.4426950408889634f * p.b_gate_x[ch];
                else if (k == 7) vv = -8.0f * 1.4426950408889634f * log1pf(__expf(-p.lam[ch])); else vv = p.g_out_a[ch];
                CTw[i] = vv; }
        }
        __syncthreads();
        const int wi = (v % LRU_WG_PER_HEAD) * 8 + wave;
        if (wi < LRU_PITEMS) lru_wave_item<PASS, false>(p, lds, n, wi / LRU_NSEG, wi % LRU_NSEG);
        else if (PASS == 2 && wi < LRU_PITEMS + LRU_SITEMS) lru_wave_item<PASS, true>(p, lds, n, wi - LRU_PITEMS, 0);
    }
    if (G == 256 && (int)blockIdx.x >= MIX_IDLE_WG0) convert_items(p, lds, ((int)blockIdx.x - MIX_IDLE_WG0) * 8 + wave, (G - MIX_IDLE_WG0) * 8, PASS == 1 ? IT_S1 : IT_S2, PASS == 1 ? IT_S2 : IT_S3);
    if (PASS == 1) { branch_b(p, G); if ((REP_MASK >> 11) & 1) branch_b(p, G); }
}

__device__ __forceinline__ void final_phase(PRef p, int G) {
    const int tid_ = opaque_tid(), lane = tid_ & 63, gw = blockIdx.x * 8 + (tid_ >> 6), NGW = G * 8;
    const bf16_t* x2b = (const bf16_t*)(p.ws + WS_YM);
    f32x4 gf[8];
#pragma unroll
    for (int j = 0; j < 8; ++j) gf[j] = ((const f32x4*)p.g_final)[lane + 64 * j];
    for (int o = gw; o < NB * SEQ + MSR; o += NGW) {
        const int r = o < NB * SEQ ? (o / SEQ) * TP + NMETA + (o % SEQ) : MPR + (o - NB * SEQ);
        const u32x2* xr = (const u32x2*)(x2b + (size_t)r * D) + lane;
        f32x4 v[8]; float s = 0.f;
#pragma unroll
        for (int j = 0; j < 8; ++j) { const u32x2 w = xr[64 * j]; v[j] = (f32x4){bf_lo(w.x), bf_hi(w.x), bf_lo(w.y), bf_hi(w.y)};
            s += (v[j][0] * v[j][0] + v[j][1] * v[j][1]) + (v[j][2] * v[j][2] + v[j][3] * v[j][3]); }
        s = wave_sum(s);
        const float rs = __builtin_amdgcn_rsqf(s * (1.0f / D) + EPS);
        f32x4* yo = (f32x4*)(p.out + (size_t)o * D) + lane;
#pragma unroll
        for (int j = 0; j < 8; ++j) yo[64 * j] = v[j] * rs * gf[j];
    }
}

#define XB_TMO      128
#define XB_XCNT(j)  (256  + 64 * (j))
#define XB_XSUB(j)  (1280 + 64 * (j))
#define XB_XGEN(j)  (2304 + 64 * (j))
#define XB_TOP      3328
#define XB_TOPGEN   3392
#define XCD_BAR_WORDS 3456
#define XB_SPIN_CAP (1u << 18)
__device__ __forceinline__ unsigned xb_ld(unsigned* p)              { return __hip_atomic_load(p, __ATOMIC_RELAXED, __HIP_MEMORY_SCOPE_AGENT); }
__device__ __forceinline__ unsigned xb_add(unsigned* p, unsigned v) { return __hip_atomic_fetch_add(p, v, __ATOMIC_RELAXED, __HIP_MEMORY_SCOPE_AGENT); }
__device__ __forceinline__ unsigned xb_xcc_id() { return (unsigned)__builtin_amdgcn_s_getreg((3 << 11) | 20) & 0xFu; }
#define XB_SPIN(cond, bar) do { unsigned _sp = 0; while (cond) { __builtin_amdgcn_s_sleep(1); \
    if ((++_sp & 255u) == 0u) { if (xb_ld(&(bar)[XB_TMO])) break; if (_sp > XB_SPIN_CAP) { atomicAdd(&(bar)[XB_TMO], 1u); break; } } } } while (0)
struct XcdBarrier { unsigned* bar; unsigned x; volatile LAS unsigned* st; };
__device__ __forceinline__ XcdBarrier xcd_barrier_post(unsigned* bar, volatile LAS unsigned* st) {
    XcdBarrier b; b.bar = bar; b.x = xb_xcc_id(); b.st = st;
    if (threadIdx.x == 0) (void)xb_add(&bar[XB_XCNT(b.x)], 1u);
    return b;
}
__device__ __forceinline__ void xcd_barrier_complete(unsigned* bar, unsigned x, unsigned& nloc, unsigned& nx) {
    const unsigned G = gridDim.x * gridDim.y * gridDim.z;
    unsigned sum, cnt, mine, sp = 0u;
    for (;;) {
        sum = 0u; cnt = 0u; mine = 0u;
#pragma unroll
        for (unsigned j = 0; j < 16; ++j) { const unsigned c = xb_ld(&bar[XB_XCNT(j)]); sum += c; cnt += (c > 0u) ? 1u : 0u; mine = (j == x) ? c : mine; }
        if (sum == G) break;
        __builtin_amdgcn_s_sleep(1);
        if ((++sp & 255u) == 0u) { if (xb_ld(&bar[XB_TMO])) break; if (sp > XB_SPIN_CAP) { atomicAdd(&bar[XB_TMO], 1u); break; } }
    }
    nloc = mine > 0u ? mine : 1u; nx = cnt > 0u ? cnt : 1u;
}
__device__ __forceinline__ void xcd_barrier(const XcdBarrier& b) {
    asm volatile("s_waitcnt vmcnt(0)" ::: "memory");
    __syncthreads();
    if (threadIdx.x == 0) {
        unsigned* bar = b.bar;
        __builtin_amdgcn_s_waitcnt(0);
        unsigned nloc = b.st[0], nx = b.st[1];
        if (nloc == 0u) { xcd_barrier_complete(bar, b.x, nloc, nx); b.st[0] = nloc; b.st[1] = nx; }
        const unsigned old = xb_add(&bar[XB_XSUB(b.x)], 1u);
        const unsigned gen = old / nloc;
        if (old + 1u == (gen + 1u) * nloc) {
            __builtin_amdgcn_fence(__ATOMIC_RELEASE, "agent");
            asm volatile("s_waitcnt vmcnt(0)" ::: "memory");
            const unsigned og = xb_add(&bar[XB_TOP], 1u);
            const unsigned tg = og / nx;
            if (og + 1u == (tg + 1u) * nx) xb_add(&bar[XB_TOPGEN], 1u);
            else XB_SPIN(xb_ld(&bar[XB_TOPGEN]) == tg, bar);
            __builtin_amdgcn_fence(__ATOMIC_ACQUIRE, "agent");
            xb_add(&bar[XB_XGEN(b.x)], 1u);
            asm volatile("s_waitcnt vmcnt(0)" ::: "memory");
        } else {
            XB_SPIN(xb_ld(&bar[XB_XGEN(b.x)]) == gen, bar);
            __builtin_amdgcn_fence(__ATOMIC_ACQUIRE, "agent");
            asm volatile("s_waitcnt vmcnt(0)" ::: "memory");
        }
    }
    __syncthreads();
}

constexpr int LDS_BYTES = 131072 + 1024 + 8 * 1024 + 8 * 2048;
constexpr int N_PHASES = 8;
__global__ void __launch_bounds__(512, 2) hymba_fwd(Params p) {
    extern __shared__ __attribute__((aligned(16))) unsigned char lds_raw[];
    LAS unsigned char* lds = (LAS unsigned char*)lds_raw;
    constexpr int G = GRID;
    if ((int)gridDim.x != GRID) return;
    const CAS Params* kp = (const CAS Params*)__builtin_amdgcn_kernarg_segment_ptr();
#define P_HERE (*({ const CAS Params* q_ = kp; asm volatile("" : "+s"(q_)); q_; }))
    unsigned char* ws = p.ws;
    volatile LAS unsigned* misc = (volatile LAS unsigned*)(lds + 131072);
    if (threadIdx.x < 8) misc[threadIdx.x] = 0u;
    __syncthreads();
    XcdBarrier bar = xcd_barrier_post((unsigned*)ws, misc);
    const int lo = p.ph_lo, hi = p.ph_hi;
#ifndef PH_MASK
#define PH_MASK 0xff
#endif
#define IN(k) (((PH_MASK >> (k)) & 1) && lo <= (k) && (k) < hi)
#define SEAM(k) do { if (IN(k) && IN((k) + 1)) xcd_barrier(bar); } while (0)
#define REPEAT(k) for (int rep_ = 0; rep_ < ((((REP_MASK) >> (k)) & 1) ? 2 : 1); ++rep_, (rep_ < ((((REP_MASK) >> (k)) & 1) ? 2 : 1) ? xcd_barrier(bar) : (void)0))
    if (IN(0)) REPEAT(0) phase0(P_HERE, lds, G);
    SEAM(0);
    if (IN(1)) REPEAT(1) {
        pg8::Gemm g{(const bf16_t*)(ws + WS_XB) + (size_t)16 * D, (const bf16_t*)(ws + WS_WIN), MP / 256, DIN / 256, D, (size_t)256 * D * 2, (size_t)128 * D * 2};
        pg8::StaticOrder S; S.init(g.nM, g.nN, G, (int)blockIdx.x, D / 64, 1);
        LAS float* rstab1 = (LAS float*)(lds + 131072 + 1024);
        rstd1_table((const float*)(ws + WS_RS1), rstab1, S); __syncthreads();
        PRef q = P_HERE; EpiZ E{rstab1, (bf16_t*)(ws + WS_Z), q.out};
        pg8::gemm_phase<EpiZ, false, true, true>(lds, g, S, E, nullptr, nullptr);
        if ((int)blockIdx.x >= P1_TAIL_WG0 && G == 256) convert_items(P_HERE, lds, ((int)blockIdx.x - P1_TAIL_WG0) * 8 + (opaque_tid() >> 6), (G - P1_TAIL_WG0) * 8, IT_O, IT_S1);
        else if (G != 256) convert_items(P_HERE, lds, (int)blockIdx.x * 8 + (opaque_tid() >> 6), G * 8, IT_O, IT_S3);
    }
    SEAM(1);
    if (IN(2)) REPEAT(2) mixer_phase<1>(P_HERE, lds, G);
    SEAM(2);
    if (IN(3)) REPEAT(3) mixer_phase<2>(P_HERE, lds, G);
    SEAM(3);
    if (IN(4)) REPEAT(4) {
        pg8::Gemm g{(const bf16_t*)(ws + WS_YM), (const bf16_t*)(ws + WS_WO), MP / 256, D / 256, DMIX, (size_t)256 * DMIX * 2, (size_t)128 * DMIX * 2};
        pg8::StaticOrder S; S.init(g.nM, g.nN, G, (int)blockIdx.x, DMIX / 64, P4_SPLIT);
        EpiX1 E{(bf16_t*)(ws + WS_XB) + (size_t)16 * D, (float*)(ws + WS_SSQ)};
        pg8::gemm_phase<EpiX1, false, true, true>(lds, g, S, E, (float*)(ws + WS_Z), (unsigned*)ws + CW_TK4 + rep_ * 128 * 64);
        if ((int)blockIdx.x >= P4_TAIL_WG0 && G == 256) convert_items(P_HERE, lds, ((int)blockIdx.x - P4_TAIL_WG0) * 8 + (opaque_tid() >> 6), (G - P4_TAIL_WG0) * 8, IT_S3, IT_G);
        else if (G != 256) convert_items(P_HERE, lds, (int)blockIdx.x * 8 + (opaque_tid() >> 6), G * 8, IT_S3, IT_G);
    }
    SEAM(4);
    if (IN(5)) REPEAT(5) {
        pg8::Gemm g{(const bf16_t*)(ws + WS_XB) + (size_t)14 * D, (const bf16_t*)(ws + WS_WUP), 37, 2 * DFF / 256, D, (size_t)252 * D * 2, (size_t)64 * D * 2};
        pg8::StaticOrder S; S.init(g.nM, g.nN, G, (int)blockIdx.x, D / 64, 1);
        LAS float* rstab = (LAS float*)(lds + 131072 + 1024); LAS float* wtab = rstab + 8 * 256;
        PRef q = P_HERE; ffn_rstd_table((const float*)(ws + WS_SSQ), q.conv_f_w, q.conv_f_b, rstab, wtab, S); __syncthreads();
        EpiFFN E{q.st_fc, (bf16_t*)(ws + WS_Z), q.out, rstab, wtab};
        if ((REP_MASK >> 10) & 1) { EpiProbe Ep{(bf16_t*)(ws + WS_Z)}; pg8::gemm_phase<EpiProbe, true, true, true>(lds, g, S, Ep, nullptr, nullptr); xcd_barrier(bar); }
        pg8::gemm_phase<EpiFFN, true, true, true>(lds, g, S, E, nullptr, nullptr);
    }
    SEAM(5);
    if (IN(6)) {
        pg8::Gemm g{(const bf16_t*)(ws + WS_Z), (const bf16_t*)(ws + WS_WDN), MP / 256, D / 256, DFF, (size_t)256 * DFF * 2, (size_t)128 * DFF * 2};
        pg8::StaticOrder S; S.init(g.nM, g.nN, G, (int)blockIdx.x, DFF / 64, P6_SPLIT);
        EpiOut E{(const bf16_t*)(ws + WS_XB) + (size_t)16 * D, (bf16_t*)(ws + WS_YM)};
        pg8::gemm_phase<EpiOut, false, true, true>(lds, g, S, E, (float*)(ws + WS_WIN), (unsigned*)ws + CW_TK6);
    }
    SEAM(6);
    if (IN(7)) REPEAT(7) final_phase(P_HERE, G);
#undef IN
#undef SEAM
}

extern "C" void kernel_launch(void* const* d_in, const int* in_sizes, int n_in, void* d_out, int out_size, void* d_ws, size_t ws_size, hipStream_t stream) {
    static int grid = 0;
    if (grid == 0) {
        if (n_in != 26 || (size_t)out_size != O_END || ws_size < WS_END) { fprintf(stderr, "kernel_launch: unexpected problem (n_in %d, out %d, ws %zu; need ws >= %zu)\n", n_in, out_size, ws_size, (size_t)WS_END); grid = -1; return; }
        int dev = 0, cus = 0, per_cu = 0;
        hipGetDevice(&dev); hipDeviceGetAttribute(&cus, hipDeviceAttributeMultiprocessorCount, dev);
        if (hipFuncSetAttribute((const void*)hymba_fwd, hipFuncAttributeMaxDynamicSharedMemorySize, LDS_BYTES) != hipSuccess) { fprintf(stderr, "kernel_launch: hipFuncSetAttribute failed\n"); grid = -1; return; }
        if (hipOccupancyMaxActiveBlocksPerMultiprocessor(&per_cu, (const void*)hymba_fwd, 512, LDS_BYTES) != hipSuccess || per_cu < 1) { fprintf(stderr, "kernel_launch: occupancy query says %d\n", per_cu); grid = -1; return; }
        if (cus < GRID) { fprintf(stderr, "kernel_launch: built for a %d-CU device, found %d CUs\n", GRID, cus); grid = -1; return; }
        grid = GRID;
    }
    if (grid < 0) return;
    Params p{};
    const float** f = (const float**)&p;
    for (int i = 0; i < 26; ++i) f[i] = (const float*)d_in[i];
    p.out = (float*)d_out; p.ws = (unsigned char*)d_ws;
    if (hipMemsetAsync(d_ws, 0, CTL_WORDS * 4, stream) != hipSuccess) { fprintf(stderr, "kernel_launch: memset failed\n"); return; }
    if (MK_N_LAUNCHES == 1) {
        p.ph_lo = 0; p.ph_hi = N_PHASES;
        hipLaunchKernelGGL(hymba_fwd, dim3(grid), dim3(512), LDS_BYTES, stream, p);
    } else {
        for (int k = 0; k < N_PHASES; ++k) { p.ph_lo = k; p.ph_hi = k + 1; hipLaunchKernelGGL(hymba_fwd, dim3(grid), dim3(512), LDS_BYTES, stream, p); }
    }
}
```

```cpp
#include <hip/hip_runtime.h>
#include <cstdio>

#ifndef REP_MASK
#define REP_MASK 0x00
#endif
#ifndef MK_N_LAUNCHES
#define MK_N_LAUNCHES 1
#endif

#define LAS __attribute__((address_space(3)))
#define CAS __attribute__((address_space(4)))
typedef unsigned short bf16_t;
typedef short bf16x8 __attribute__((ext_vector_type(8)));
typedef float f32x4 __attribute__((ext_vector_type(4)));
typedef unsigned u32x4 __attribute__((ext_vector_type(4)));
typedef unsigned u32x2 __attribute__((ext_vector_type(2)));

constexpr int D = 2048, NMETA = 16, SEQ = 2048, TP = SEQ + NMETA, NB = 4, MPR = NB * TP;
constexpr int NS = 128, TS = 8, MSR = NS * TS, M = MPR + MSR;
constexpr int MP = 9472;
constexpr int DA = 1536, DB = 1024, DIN = 6144, DMIX = 2560, DFF = 6144, NH = 12;
constexpr float EPS = 1e-6f;
constexpr int NCH = 33;
constexpr size_t O_YP = 0, O_YS = O_YP + (size_t)NB * SEQ * D, O_PH = O_YS + (size_t)MSR * D, O_PRC = O_PH + NB * DA,
                 O_PSC = O_PRC + NB * 3 * DA, O_PFC = O_PSC + NB * 2 * DB, O_SH = O_PFC + NB * 2 * DFF, O_SRC = O_SH + NS * DA,
                 O_SSC = O_SRC + (size_t)NS * 3 * DA, O_SFC = O_SSC + (size_t)NS * 2 * DB, O_END = O_SFC + (size_t)NS * 2 * DFF;
constexpr size_t MiB = 1u << 20;
constexpr int CW_TK6 = 4096, CTL_WORDS = 4096 + 256 * 64;
constexpr int P6_SPLIT = 4, P4_SPLIT = 4, CW_TK4 = CW_TK6 + 64 * 64;
constexpr int GRID = 256;
constexpr size_t WS_WIN = 1 * MiB;
constexpr size_t WS_WO = WS_WIN + (size_t)DIN * D * 2;
constexpr size_t WS_WUP = WS_WO + (size_t)D * DMIX * 2;
constexpr size_t WS_WDN = WS_WUP + (size_t)2 * DFF * D * 2;
constexpr size_t WS_WG = WS_WDN + (size_t)D * DFF * 2;
constexpr size_t WS_XB = WS_WG + (size_t)2 * NH * 128 * 128 * 2;
constexpr size_t XB_ROWS = 9600;
constexpr size_t WS_Z = WS_XB + XB_ROWS * D * 2;
constexpr size_t WS_YM = WS_Z + (size_t)MP * DIN * 2;
constexpr size_t WS_RS1 = WS_YM + (size_t)MP * DMIX * 2;
constexpr size_t WS_SSQ = WS_RS1 + (size_t)MP * 4;
constexpr size_t WS_TOT = WS_SSQ + (size_t)MP * 32 * 4;
constexpr size_t WS_END = WS_TOT + (size_t)NB * NCH * DA * 2 * 4;

struct Params;
typedef const CAS Params& PRef;
struct Params {
    const float *x_prompt, *x_sample, *st_h, *st_rc, *st_sc, *st_fc, *meta, *g_mix, *w_in, *conv_a_w, *conv_a_b, *w_gate_a, *b_gate_a,
        *w_gate_x, *b_gate_x, *lam, *conv_b_w, *g_out_a, *g_out_b, *w_o, *g_ffn, *w_up, *conv_f_w, *conv_f_b, *w_down, *g_final;
    float* out; unsigned char* ws; int ph_lo, ph_hi;
};

__device__ __forceinline__ unsigned cvt_pk_bf16(float lo, float hi) { unsigned r; asm volatile("v_cvt_pk_bf16_f32 %0, %1, %2" : "=v"(r) : "v"(lo), "v"(hi)); return r; }
__device__ __forceinline__ float bf_lo(unsigned w) { return __builtin_bit_cast(float, w << 16); }
__device__ __forceinline__ float bf_hi(unsigned w) { return __builtin_bit_cast(float, w & 0xffff0000u); }
__device__ __forceinline__ void unpack8(const u32x4 w, float (&f)[8]) { f[0] = bf_lo(w.x); f[1] = bf_hi(w.x); f[2] = bf_lo(w.y); f[3] = bf_hi(w.y); f[4] = bf_lo(w.z); f[5] = bf_hi(w.z); f[6] = bf_lo(w.w); f[7] = bf_hi(w.w); }
__device__ __forceinline__ u32x4 pack8(const float (&f)[8]) { u32x4 w; w.x = cvt_pk_bf16(f[0], f[1]); w.y = cvt_pk_bf16(f[2], f[3]); w.z = cvt_pk_bf16(f[4], f[5]); w.w = cvt_pk_bf16(f[6], f[7]); return w; }
__device__ __forceinline__ float wave_sum(float v) {
#pragma unroll
    for (int o = 1; o < 64; o <<= 1) v += __shfl_xor(v, o);
    return v;
}
__device__ __forceinline__ float sum16(float v) {
    v += __shfl_xor(v, 1); v += __shfl_xor(v, 2); v += __shfl_xor(v, 4); v += __shfl_xor(v, 8); return v;
}
__device__ __forceinline__ float sigmoidf_(float x) { return __builtin_amdgcn_rcpf(1.0f + __expf(-x)); }
__device__ __forceinline__ float gelu_tanh(float x) {
    const float t = x * (1.0f + 0.044715f * x * x) * (-2.0f * 0.7978845608028654f * 1.4426950408889634f);
    return x * __builtin_amdgcn_rcpf(1.0f + __builtin_amdgcn_exp2f(t));
}
__device__ __forceinline__ int opaque_tid() { int t = threadIdx.x; asm volatile("" : "+v"(t)); return t; }
template <int CTRL> __device__ __forceinline__ float dppf(float old, float src) {
    return __builtin_bit_cast(float, __builtin_amdgcn_update_dpp(__builtin_bit_cast(int, old), __builtin_bit_cast(int, src), CTRL, 0xF, 0xF, false));
}
__device__ __forceinline__ void row_decode(int r, int& is_s, int& seq, int& t) {
    if (r < MPR) { seq = (r >= TP) + (r >= 2 * TP) + (r >= 3 * TP); t = r - seq * TP; is_s = 0; }
    else { const int q = r - MPR; seq = q >> 3; t = q & 7; is_s = 1; }
}
__device__ __forceinline__ const float* x_row_ptr(const float* xp, const float* xs, const float* meta, int r) {
    int is_s, seq, t; row_decode(r, is_s, seq, t);
    if (is_s) return xs + (size_t)(r - MPR) * D;
    return t < NMETA ? meta + (size_t)t * D : xp + ((size_t)seq * SEQ + (t - NMETA)) * D;
}
__device__ __forceinline__ float* y_row_ptr(float* out, int r) {
    if (r >= M) return nullptr;
    int is_s, seq, t; row_decode(r, is_s, seq, t);
    if (is_s) return out + O_YS + (size_t)(r - MPR) * D;
    return t < NMETA ? nullptr : out + O_YP + ((size_t)seq * SEQ + (t - NMETA)) * D;
}

namespace pg8 {
constexpr int BM = 256, BK = 64, HALF = 128, HTB = HALF * BK * 2, STAGE_BYTES = 8 * HTB, NXCD = 8, WGM = 2;
__host__ __device__ __forceinline__ int lds_byte(int r, int c) { const int st = (r >> 4) * 2 + (c >> 5), rr = r & 15, cc = c & 31, ob = rr * 64 + cc * 2; return st * 1024 + (ob ^ (((ob >> 9) & 1) << 5)); }
__host__ __device__ __forceinline__ void stage_rc(int b, int& R, int& C) { const int st = b / 1024, sb = b % 1024, swz = sb ^ (((sb >> 9) & 1) << 5); R = (st >> 1) * 16 + swz / 64; C = (st & 1) * 32 + (swz % 64) / 2; }
struct Unit { int pm, pn, kb, nk, piece, lu, idx; };
struct Gemm { const bf16_t* A; const bf16_t* Bt; int nM, nN, K; size_t a_tstep, a_hstep; };
struct StaticOrder {
    int nM, nN, nwg, G, c, nt, split, nfull, nleft, limit = 1 << 20, first = 0;
    __device__ __forceinline__ void init(int nM_, int nN_, int G_, int c_, int nt_, int split_) { nM = nM_; nN = nN_; nwg = nM * nN; G = G_; c = c_; nt = nt_; nfull = (nwg / G) * G; nleft = nwg - nfull;
        split = (split_ > 1 && nleft > 0 && nleft * split_ <= G && (nt / split_) * split_ == nt && ((nt / split_) & 1) == 0) ? split_ : 1; }
    __device__ __forceinline__ void map(int L, Unit& u) const {
        int wgid = L; { const int q = nwg / NXCD, r = nwg % NXCD, xcd = wgid % NXCD, off = wgid / NXCD; wgid = (xcd < r ? xcd * (q + 1) : r * (q + 1) + (xcd - r) * q) + off; }
        const int nig = WGM * nN, gid = wgid / nig, rem = wgid - gid * nig, fm = gid * WGM, glast = nM % WGM;
        if (nM - fm >= WGM || glast == 0) { u.pm = fm + (rem & (WGM - 1)); u.pn = rem / WGM; }
        else { u.pm = fm + rem % glast; u.pn = rem / glast; }
    }
    __device__ __forceinline__ bool next(int i, Unit& u) const {
        u.kb = 0; u.nk = nt; u.piece = -1; u.lu = 0; u.idx = i;
        i += first; if (i >= limit) return false;
        const long L = (long)i * G + c;
        if (L < nfull || split == 1) { if (L >= nwg) return false; map((int)L, u); return true; }
        if (L >= nfull + G || c >= nleft * split) return false;
        u.lu = c % nleft; u.piece = c / nleft; u.nk = nt / split; u.kb = u.piece * u.nk; map(nfull + u.lu, u); return true;
    }
};

template <int P, int A, int Mi>
__device__ __forceinline__ void reduce_rowgroup(f32x4 (&acc)[2][2][4][2], const float* slab0, int tid) {
    const float* sp = slab0 + (size_t)((A * 4 + Mi) * 4) * 8192 + tid * 4;
#pragma unroll
    for (int b = 0; b < 2; ++b)
#pragma unroll
        for (int n = 0; n < 2; ++n) {
            f32x4 sum = (f32x4){0.f, 0.f, 0.f, 0.f};
#pragma unroll
            for (int src = 0; src < 4; ++src) { if (src == P) sum += acc[A][b][Mi][n]; else sum += *(const f32x4*)(sp + (size_t)src * 8192 + (b * 2 + n) * 2048); }
            acc[A][b][Mi][n] = sum;
        }
}
template <class Epi, bool FFNMAP, bool ALIGN_EPI, bool SP2>
__device__ __forceinline__ void gemm_phase(LAS unsigned char* lds, const Gemm g, const StaticOrder& S, const Epi& E, float* slabs, unsigned* tickets, bool dry = false) {
    int tid = threadIdx.x; asm volatile("" : "+v"(tid));
    const int wid = __builtin_amdgcn_readfirstlane(tid >> 6), lane = tid & 63, wr = wid >> 2, wc = wid & 3, fr = lane & 15, fq = lane >> 4;
    const int K = g.K;
    unsigned voffA[2], voffB[2];
#pragma unroll
    for (int i = 0; i < 2; ++i) { int R, C; stage_rc(tid * 16 + i * 8192, R, C); const int Ra = FFNMAP ? (126 * (R >> 6) + 4 * (R & 15) + ((R >> 4) & 3)) : R;
        voffA[i] = (unsigned)(Ra * K + C) * 2u; voffB[i] = (unsigned)(R * K + C) * 2u; }
    const size_t kstep = (size_t)(BK * 2);
    const size_t hstepA = g.a_hstep, tstepA = g.a_tstep;
    const size_t hstepB = (size_t)HALF * K * 2, tstepB = 2 * hstepB;
    const unsigned ldsw = (unsigned)wid * 1024u;
    const int aoff = lds_byte(wr * 64 + fr, fq * 8), boff = lds_byte(wc * 32 + fr, fq * 8);
#define PG8_SA(b, h) (((b) * 2 + (h)) * HTB)
#define PG8_SB(b, h) ((4 + (b) * 2 + (h)) * HTB)
#define PG8_STAGE(bufoff, gbase, voff) do { _Pragma("unroll") for (int _i = 0; _i < 2; ++_i) \
        __builtin_amdgcn_global_load_lds((const unsigned*)((const char*)(gbase) + (voff)[_i]), (LAS unsigned*)(lds + (bufoff) + ldsw + _i * 8192), 16, 0, 0); } while (0)
#define PG8_LDA(dst, b, h) do { _Pragma("unroll") for (int m = 0; m < 4; ++m) _Pragma("unroll") for (int k = 0; k < 2; ++k) dst[m][k] = *(const LAS bf16x8*)(lds + PG8_SA(b, h) + aoff + m * 2048 + k * 1024); } while (0)
#define PG8_LDB(dst, b, h) do { _Pragma("unroll") for (int n = 0; n < 2; ++n) _Pragma("unroll") for (int k = 0; k < 2; ++k) dst[n][k] = *(const LAS bf16x8*)(lds + PG8_SB(b, h) + boff + n * 2048 + k * 1024); } while (0)
#define PG8_MMA(ai, bj, At, Bt) do { __builtin_amdgcn_s_setprio(1); _Pragma("unroll") for (int m = 0; m < 4; ++m) _Pragma("unroll") for (int n = 0; n < 2; ++n) _Pragma("unroll") for (int k = 0; k < 2; ++k) \
        acc[ai][bj][m][n] = __builtin_amdgcn_mfma_f32_16x16x32_bf16(Bt[n][k], At[m][k], acc[ai][bj][m][n], 0, 0, 0); __builtin_amdgcn_s_setprio(0); } while (0)
#define PG8_WAIT_V(n) asm volatile("s_waitcnt vmcnt(" #n ")" ::: "memory")
#define PG8_WAIT_L(n) asm volatile("s_waitcnt lgkmcnt(" #n ")" ::: "memory")
#define PG8_BAR __builtin_amdgcn_s_barrier()
#define PG8_SCHED __builtin_amdgcn_sched_barrier(0)
    Unit cur, nxt; int ui = 0;
    if (!S.next(0, cur)) return;
    f32x4 acc[2][2][4][2];
#pragma unroll
    for (int a = 0; a < 2; ++a)
#pragma unroll
        for (int b = 0; b < 2; ++b)
#pragma unroll
            for (int m = 0; m < 4; ++m)
#pragma unroll
                for (int n = 0; n < 2; ++n) acc[a][b][m][n] = (f32x4){0.f, 0.f, 0.f, 0.f};
    bf16x8 At[4][2], B0[2][2], B1[2][2];
    const char* cA = (const char*)g.A + (size_t)cur.pm * tstepA + (size_t)cur.kb * kstep; const char* cB = (const char*)g.Bt + (size_t)cur.pn * tstepB + (size_t)cur.kb * kstep;
    if constexpr (SP2) {
        PG8_STAGE(PG8_SB(0, 0), cB, voffB); PG8_STAGE(PG8_SB(0, 1), cB + hstepB, voffB); PG8_STAGE(PG8_SA(0, 0), cA, voffA); PG8_STAGE(PG8_SA(0, 1), cA + hstepA, voffA);
        if (wr == 1) PG8_BAR;
        PG8_WAIT_V(2); PG8_BAR;
        PG8_STAGE(PG8_SB(1, 0), cB + kstep, voffB); PG8_STAGE(PG8_SA(1, 0), cA + kstep, voffA); PG8_STAGE(PG8_SB(1, 1), cB + hstepB + kstep, voffB);
        PG8_WAIT_V(6); PG8_BAR;
    } else {
        PG8_STAGE(PG8_SB(0, 0), cB, voffB); PG8_STAGE(PG8_SA(0, 0), cA, voffA); PG8_STAGE(PG8_SB(0, 1), cB + hstepB, voffB); PG8_STAGE(PG8_SA(0, 1), cA + hstepA, voffA);
        if (wr == 1) PG8_BAR;
        PG8_WAIT_V(4); PG8_BAR;
        PG8_STAGE(PG8_SB(1, 0), cB + kstep, voffB); PG8_STAGE(PG8_SA(1, 0), cA + kstep, voffA); PG8_STAGE(PG8_SB(1, 1), cB + hstepB + kstep, voffB);
        PG8_WAIT_V(6); PG8_BAR;
    }
    for (;;) {
        const bool has_next = S.next(ui + 1, nxt);
        const char* nA = has_next ? (const char*)g.A + (size_t)nxt.pm * tstepA + (size_t)nxt.kb * kstep : cA; const char* nB = has_next ? (const char*)g.Bt + (size_t)nxt.pn * tstepB + (size_t)nxt.kb * kstep : cB;
        const int nt = cur.nk;
        for (int t = 0; t < nt; t += 2) {
            const bool last = (t == nt - 2);
            const char* a1 = cA + (size_t)(t + 1) * kstep;
            const char* a2 = last ? nA : cA + (size_t)(t + 2) * kstep; const char* b2 = last ? nB : cB + (size_t)(t + 2) * kstep;
            const char* a3 = a2 + kstep; const char* b3 = b2 + kstep;
            if constexpr (SP2) {
            PG8_LDB(B0, 0, 0); PG8_LDB(B1, 0, 1); PG8_SCHED; PG8_LDA(At, 0, 0); PG8_STAGE(PG8_SA(1, 1), a1 + hstepA, voffA);
            PG8_WAIT_V(8); PG8_WAIT_L(0); PG8_BAR; PG8_MMA(0, 0, At, B0); PG8_MMA(0, 1, At, B1); PG8_BAR; PG8_SCHED;
            PG8_LDA(At, 0, 1); PG8_STAGE(PG8_SB(0, 0), b2, voffB); PG8_STAGE(PG8_SB(0, 1), b2 + hstepB, voffB); PG8_STAGE(PG8_SA(0, 0), a2, voffA);
            PG8_WAIT_V(8); PG8_WAIT_L(0); PG8_BAR; PG8_MMA(1, 0, At, B0); PG8_MMA(1, 1, At, B1); PG8_BAR; PG8_SCHED;
            PG8_LDB(B0, 1, 0); PG8_LDB(B1, 1, 1); PG8_SCHED; PG8_LDA(At, 1, 0); PG8_STAGE(PG8_SA(0, 1), a2 + hstepA, voffA);
            PG8_WAIT_V(8); PG8_WAIT_L(0); PG8_BAR; PG8_MMA(0, 0, At, B0); PG8_MMA(0, 1, At, B1); PG8_BAR; PG8_SCHED;
            PG8_LDA(At, 1, 1); PG8_STAGE(PG8_SB(1, 0), b3, voffB); PG8_STAGE(PG8_SB(1, 1), b3 + hstepB, voffB); PG8_STAGE(PG8_SA(1, 0), a3, voffA);
            PG8_WAIT_V(8); PG8_WAIT_L(0); PG8_BAR; PG8_MMA(1, 0, At, B0); PG8_MMA(1, 1, At, B1); PG8_BAR; PG8_SCHED;
            } else {
            PG8_LDB(B0, 0, 0); PG8_SCHED; PG8_LDA(At, 0, 0); PG8_STAGE(PG8_SA(1, 1), a1 + hstepA, voffA);
            PG8_WAIT_L(8); PG8_BAR; PG8_WAIT_L(0); PG8_MMA(0, 0, At, B0); PG8_BAR; PG8_SCHED;
            PG8_LDB(B1, 0, 1); PG8_STAGE(PG8_SB(0, 0), b2, voffB);
            PG8_BAR; PG8_WAIT_L(0); PG8_MMA(0, 1, At, B1); PG8_BAR;
            PG8_LDA(At, 0, 1); PG8_STAGE(PG8_SA(0, 0), a2, voffA);
            PG8_BAR; PG8_WAIT_L(0); PG8_MMA(1, 0, At, B0); PG8_BAR; PG8_SCHED;
            PG8_STAGE(PG8_SB(0, 1), b2 + hstepB, voffB);
            PG8_WAIT_V(6); PG8_BAR; PG8_MMA(1, 1, At, B1); PG8_BAR;
            PG8_LDB(B0, 1, 0); PG8_SCHED; PG8_LDA(At, 1, 0); PG8_STAGE(PG8_SA(0, 1), a2 + hstepA, voffA);
            PG8_WAIT_L(8); PG8_BAR; PG8_WAIT_L(0); PG8_MMA(0, 0, At, B0); PG8_BAR; PG8_SCHED;
            PG8_LDB(B1, 1, 1); PG8_STAGE(PG8_SB(1, 0), b3, voffB);
            PG8_BAR; PG8_WAIT_L(0); PG8_MMA(0, 1, At, B1); PG8_BAR;
            PG8_LDA(At, 1, 1); PG8_STAGE(PG8_SA(1, 0), a3, voffA);
            PG8_BAR; PG8_WAIT_L(0); PG8_MMA(1, 0, At, B0); PG8_BAR; PG8_SCHED;
            PG8_STAGE(PG8_SB(1, 1), b3 + hstepB, voffB);
            PG8_WAIT_V(6); PG8_BAR; PG8_MMA(1, 1, At, B1); PG8_BAR;
            }
        }
        if constexpr (ALIGN_EPI) { if (wr == 0) PG8_BAR; }
        if (cur.piece < 0 && !dry) E(acc, cur, wr, wc, fr, fq);
        if (!has_next) break;
#pragma unroll
        for (int a = 0; a < 2; ++a)
#pragma unroll
            for (int b = 0; b < 2; ++b)
#pragma unroll
                for (int m = 0; m < 4; ++m)
#pragma unroll
                    for (int n = 0; n < 2; ++n) acc[a][b][m][n] = (f32x4){0.f, 0.f, 0.f, 0.f};
        cur = nxt; cA = nA; cB = nB; ++ui;
        if constexpr (ALIGN_EPI) { if (wr == 1) PG8_BAR; }
    }
    PG8_WAIT_V(0);
    if constexpr (!ALIGN_EPI) { if (wr == 0) PG8_BAR; }
    PG8_BAR;
    if constexpr (Epi::SPLIT) {
    if (cur.piece >= 0 && !dry) {
        float* slab0 = slabs + (size_t)cur.lu * (8 * 4 * 8192);
        {
            const __amdgpu_buffer_rsrc_t rs = __builtin_amdgcn_make_buffer_rsrc((void*)slab0, (short)0, 8 * 4 * 32768, 0x00020000);
#pragma unroll
            for (int a = 0; a < 2; ++a)
#pragma unroll
                for (int m = 0; m < 4; ++m) {
                    const int gq = a * 4 + m;
                    if ((gq >> 1) != cur.piece) {
#pragma unroll
                        for (int b = 0; b < 2; ++b)
#pragma unroll
                            for (int n = 0; n < 2; ++n) __builtin_amdgcn_raw_buffer_store_b128(__builtin_bit_cast(u32x4, acc[a][b][m][n]), rs, (gq * 4 + cur.piece) * 32768 + (b * 2 + n) * 8192 + tid * 16, 0, 16);
                    }
                }
        }
        asm volatile("s_waitcnt vmcnt(0)" ::: "memory");
        __syncthreads();
        if (tid == 0) {
            __hip_atomic_fetch_add(tickets + 64 * cur.lu, 1u, __ATOMIC_RELAXED, __HIP_MEMORY_SCOPE_AGENT);
            unsigned sp = 0;
            while (__hip_atomic_load(tickets + 64 * cur.lu, __ATOMIC_RELAXED, __HIP_MEMORY_SCOPE_AGENT) < 4u) { __builtin_amdgcn_s_sleep(2); if (++sp > (1u << 20)) break; }
            __builtin_amdgcn_fence(__ATOMIC_ACQUIRE, "agent"); asm volatile("s_waitcnt vmcnt(0)" ::: "memory");
        }
        __syncthreads();
        switch (cur.piece) {
            case 0: reduce_rowgroup<0, 0, 0>(acc, slab0, tid); reduce_rowgroup<0, 0, 1>(acc, slab0, tid); break;
            case 1: reduce_rowgroup<1, 0, 2>(acc, slab0, tid); reduce_rowgroup<1, 0, 3>(acc, slab0, tid); break;
            case 2: reduce_rowgroup<2, 1, 0>(acc, slab0, tid); reduce_rowgroup<2, 1, 1>(acc, slab0, tid); break;
            default: reduce_rowgroup<3, 1, 2>(acc, slab0, tid); reduce_rowgroup<3, 1, 3>(acc, slab0, tid); break;
        }
        E(acc, cur, wr, wc, fr, fq, 3u << (2 * cur.piece));
    }
    }
#undef PG8_SA
#undef PG8_SB
#undef PG8_STAGE
#undef PG8_LDA
#undef PG8_LDB
#undef PG8_MMA
#undef PG8_WAIT_V
#undef PG8_WAIT_L
#undef PG8_BAR
#undef PG8_SCHED
}
}

typedef f32x4 Acc[2][2][4][2];

struct EpiZ {
    static constexpr bool SPLIT = false;
    const LAS float* rstab; bf16_t* z; float* out;
    __device__ __forceinline__ void operator()(const Acc& acc, const pg8::Unit& u, int wr, int wc, int fr, int fq) const {
        asm volatile("" : "+v"(fr), "+v"(fq));
        const int col0 = u.pn * 256 + wc * 32 + 8 * fq;
#pragma unroll
        for (int ai = 0; ai < 2; ++ai)
#pragma unroll
            for (int m = 0; m < 4; ++m) {
                const int r = u.pm * 256 + ai * 128 + wr * 64 + m * 16 + fr;
                if (r < M) {
                    const float rs = rstab[u.idx * 256 + ai * 128 + wr * 64 + m * 16 + fr];
                    int is_s, seq, t; row_decode(r, is_s, seq, t);
                    float* so = nullptr;
                    if (u.pn < 6) { if (is_s) { if (t >= TS - 3) so = out + O_SRC + ((size_t)seq * 3 + (t - (TS - 3))) * DA; } else { if (t >= TP - 3) so = out + O_PRC + ((size_t)seq * 3 + (t - (TP - 3))) * DA; } }
#pragma unroll
                    for (int bj = 0; bj < 2; ++bj) {
                        const f32x4 v0 = acc[ai][bj][m][0] * rs, v1 = acc[ai][bj][m][1] * rs;
                        u32x4 w; w.x = cvt_pk_bf16(v0[0], v0[1]); w.y = cvt_pk_bf16(v0[2], v0[3]); w.z = cvt_pk_bf16(v1[0], v1[1]); w.w = cvt_pk_bf16(v1[2], v1[3]);
                        *(u32x4*)(z + (size_t)r * DIN + col0 + bj * 128) = w;
                        if (so) { *(f32x4*)(so + col0 + bj * 128) = v0; *(f32x4*)(so + col0 + bj * 128 + 4) = v1; }
                    }
                }
            }
    }
};
__device__ __forceinline__ void rstd1_table(const float* rstd1, LAS float* tab, const pg8::StaticOrder& S) {
    const int tid = opaque_tid(), q = tid & 255;
    pg8::Unit u;
    for (int i = tid >> 8; S.next(i, u); i += 2) { const int r = u.pm * 256 + q; tab[i * 256 + q] = r < M ? rstd1[r] : 0.f; }
}
struct EpiX1 {
    static constexpr bool SPLIT = true;
    bf16_t* xb; float* ssq;
    __device__ __forceinline__ void operator()(const Acc& acc, const pg8::Unit& u, int wr, int wc, int fr, int fq, unsigned gmask = 0xffu) const {
        asm volatile("" : "+v"(fr), "+v"(fq));
        const int col0 = u.pn * 256 + wc * 32 + 8 * fq;
#pragma unroll
        for (int ai = 0; ai < 2; ++ai) {
            if (!((gmask >> (ai * 4)) & 0xfu)) continue;
            u32x4 xv[4][2];
#pragma unroll
            for (int m = 0; m < 4; ++m) {
                const int r = u.pm * 256 + ai * 128 + wr * 64 + m * 16 + fr;
                const bf16_t* xr = xb + (size_t)(r < M ? r : 0) * D + col0;
#pragma unroll
                for (int bj = 0; bj < 2; ++bj) xv[m][bj] = *(const u32x4*)(xr + bj * 128);
            }
#pragma unroll
            for (int m = 0; m < 4; ++m) {
                if (!((gmask >> (ai * 4 + m)) & 1u)) continue;
                const int r = u.pm * 256 + ai * 128 + wr * 64 + m * 16 + fr;
                const bool valid = r < M;
                float ss = 0.f;
#pragma unroll
                for (int bj = 0; bj < 2; ++bj) {
                    float xf[8]; unpack8(xv[m][bj], xf);
                    const f32x4 a0 = acc[ai][bj][m][0], a1 = acc[ai][bj][m][1];
                    const f32x4 v0 = (f32x4){a0[0] + xf[0], a0[1] + xf[1], a0[2] + xf[2], a0[3] + xf[3]}, v1 = (f32x4){a1[0] + xf[4], a1[1] + xf[5], a1[2] + xf[6], a1[3] + xf[7]};
                    ss += (v0[0] * v0[0] + v0[1] * v0[1]) + (v0[2] * v0[2] + v0[3] * v0[3]) + (v1[0] * v1[0] + v1[1] * v1[1]) + (v1[2] * v1[2] + v1[3] * v1[3]);
                    if (valid) { u32x4 w; w.x = cvt_pk_bf16(v0[0], v0[1]); w.y = cvt_pk_bf16(v0[2], v0[3]); w.z = cvt_pk_bf16(v1[0], v1[1]); w.w = cvt_pk_bf16(v1[2], v1[3]);
                        *(u32x4*)(xb + (size_t)r * D + col0 + bj * 128) = w; }
                }
                ss += __shfl_xor(ss, 16); ss += __shfl_xor(ss, 32);
                if (valid && fq == 0) ssq[(size_t)r * 32 + u.pn * 4 + wc] = ss;
            }
        }
    }
};
struct EpiOut {
    static constexpr bool SPLIT = true;
    const bf16_t* x1b; bf16_t* x2b;
    __device__ __forceinline__ void operator()(const Acc& acc, const pg8::Unit& u, int wr, int wc, int fr, int fq, unsigned gmask = 0xffu) const {
        asm volatile("" : "+v"(fr), "+v"(fq));
        const int col0 = u.pn * 256 + wc * 32 + 8 * fq;
#pragma unroll
        for (int ai = 0; ai < 2; ++ai) {
            if (!((gmask >> (ai * 4)) & 0xfu)) continue;
            u32x4 xv[4][2];
#pragma unroll
            for (int m = 0; m < 4; ++m) {
                const int r = u.pm * 256 + ai * 128 + wr * 64 + m * 16 + fr;
                const bf16_t* xr = x1b + (size_t)(r < M ? r : 0) * D + col0;
#pragma unroll
                for (int bj = 0; bj < 2; ++bj) xv[m][bj] = *(const u32x4*)(xr + bj * 128);
            }
#pragma unroll
            for (int m = 0; m < 4; ++m) {
                if (!((gmask >> (ai * 4 + m)) & 1u)) continue;
                const int r = u.pm * 256 + ai * 128 + wr * 64 + m * 16 + fr;
                if (r < M) {
#pragma unroll
                    for (int bj = 0; bj < 2; ++bj) {
                        float xf[8]; unpack8(xv[m][bj], xf);
                        const f32x4 a0 = acc[ai][bj][m][0], a1 = acc[ai][bj][m][1];
                        u32x4 w; w.x = cvt_pk_bf16(a0[0] + xf[0], a0[1] + xf[1]); w.y = cvt_pk_bf16(a0[2] + xf[2], a0[3] + xf[3]); w.z = cvt_pk_bf16(a1[0] + xf[4], a1[1] + xf[5]); w.w = cvt_pk_bf16(a1[2] + xf[6], a1[3] + xf[7]);
                        *(u32x4*)(x2b + (size_t)r * D + col0 + bj * 128) = w;
                    }
                }
            }
        }
    }
};
struct EpiFFN {
    static constexpr bool SPLIT = false;
    const float* st_fc; bf16_t* hid; float* out; const LAS float* rstab; const LAS float* wtab;
    template <bool PLAIN>
    __device__ __forceinline__ void body(Acc& acc, const pg8::Unit& u, int wr, int wc, int fr, int fq, int gbase, int f0,
                                         const f32x4 (&wv)[4][2]) const {
#pragma unroll
        for (int ai = 0; ai < 2; ++ai) {
            f32x4 s3[2], s2[2];
#pragma unroll
            for (int n = 0; n < 2; ++n)
#pragma unroll
                for (int e = 0; e < 4; ++e) {
                    const float o3 = ai == 0 ? 0.f : dppf<0x121>(0.f, acc[0][0][3][n][e]), o2 = ai == 0 ? 0.f : dppf<0x121>(0.f, acc[0][0][2][n][e]);
                    s3[n][e] = dppf<0x111>(o3, acc[ai][0][3][n][e]); s2[n][e] = dppf<0x111>(o2, acc[ai][0][2][n][e]);
                }
#pragma unroll
            for (int m = 0; m < 4; ++m) {
                const int j = 64 * ai + 4 * fr + m, r = gbase + j;
                const f32x4 c0 = acc[ai][0][m][0], c1 = acc[ai][0][m][1];
                f32x4 p1a = m == 0 ? s3[0] : acc[ai][0][m == 0 ? 0 : m - 1][0], p1b = m == 0 ? s3[1] : acc[ai][0][m == 0 ? 0 : m - 1][1];
                f32x4 p2a = m == 0 ? s2[0] : (m == 1 ? s3[0] : acc[ai][0][m < 2 ? 0 : m - 2][0]), p2b = m == 0 ? s2[1] : (m == 1 ? s3[1] : acc[ai][0][m < 2 ? 0 : m - 2][1]);
                bool valid = j >= 2;
                int is_s = 0, seq = 0, t = 2;
                if constexpr (!PLAIN) {
                    valid = valid && (r < M);
                    row_decode(valid ? r : 0, is_s, seq, t);
                    if (valid && t < 2) {
                        f32x4 s0a = (f32x4){0.f, 0.f, 0.f, 0.f}, s0b = s0a, s1a = s0a, s1b = s0a;
                        if (is_s) { const float* sp = st_fc + (size_t)seq * 2 * DFF + f0; s0a = *(const f32x4*)sp; s0b = *(const f32x4*)(sp + 4); s1a = *(const f32x4*)(sp + DFF); s1b = *(const f32x4*)(sp + DFF + 4); }
                        if (t == 0) { p1a = s1a; p1b = s1b; p2a = s0a; p2b = s0b; } else { p2a = s1a; p2b = s1b; }
                    }
                }
                const f32x4 ga = wv[0][0] * p2a + wv[1][0] * p1a + wv[2][0] * c0 + wv[3][0], gb = wv[0][1] * p2b + wv[1][1] * p1b + wv[2][1] * c1 + wv[3][1];
                const f32x4 va = acc[ai][1][m][0], vb = acc[ai][1][m][1];
                if (valid) {
                    u32x4 w;
                    w.x = cvt_pk_bf16(gelu_tanh(ga[0]) * va[0], gelu_tanh(ga[1]) * va[1]); w.y = cvt_pk_bf16(gelu_tanh(ga[2]) * va[2], gelu_tanh(ga[3]) * va[3]);
                    w.z = cvt_pk_bf16(gelu_tanh(gb[0]) * vb[0], gelu_tanh(gb[1]) * vb[1]); w.w = cvt_pk_bf16(gelu_tanh(gb[2]) * vb[2], gelu_tanh(gb[3]) * vb[3]);
                    *(u32x4*)(hid + (size_t)r * DFF + f0) = w;
                    if constexpr (!PLAIN) {
                        const int T = is_s ? TS : TP;
                        if (t >= T - 2) { float* so = out + (is_s ? O_SFC : O_PFC) + ((size_t)seq * 2 + (t - (T - 2))) * DFF + f0; *(f32x4*)so = c0; *(f32x4*)(so + 4) = c1; }
                    }
                }
            }
            __builtin_amdgcn_sched_barrier(0);
        }
    }
    __device__ __forceinline__ void operator()(Acc& acc, const pg8::Unit& u, int wr, int wc, int fr, int fq) const {
        asm volatile("" : "+v"(fr), "+v"(fq));
        const int gbase = 252 * u.pm - 2 + 126 * wr;
        const int f0 = 128 * u.pn + 32 * wc + 8 * fq;
        const LAS float* wt = wtab + u.idx * 512 + 32 * wc + 8 * fq;
        f32x4 wv[4][2];
#pragma unroll
        for (int k = 0; k < 4; ++k) { wv[k][0] = *(const LAS f32x4*)(wt + 128 * k); wv[k][1] = *(const LAS f32x4*)(wt + 128 * k + 4); }
        const LAS float* rt = rstab + u.idx * 256 + wr * 128 + 4 * fr;
#pragma unroll
        for (int ai = 0; ai < 2; ++ai) {
            const f32x4 rs4 = *(const LAS f32x4*)(rt + 64 * ai);
#pragma unroll
            for (int m = 0; m < 4; ++m)
#pragma unroll
                for (int bj = 0; bj < 2; ++bj)
#pragma unroll
                    for (int n = 0; n < 2; ++n) acc[ai][bj][m][n] *= rs4[m];
        }
        const int lo = gbase, hi = gbase + 127;
        bool plain = hi < MPR && lo >= 0;
#pragma unroll
        for (int b2 = 0; b2 < NB; ++b2) { const int s0 = b2 * TP; if (lo <= s0 + 1 && hi >= s0) plain = false; if (lo <= s0 + TP - 1 && hi >= s0 + TP - 2) plain = false; }
        if (plain) body<true>(acc, u, wr, wc, fr, fq, gbase, f0, wv); else body<false>(acc, u, wr, wc, fr, fq, gbase, f0, wv);
    }
};
__device__ __forceinline__ void ffn_rstd_table(const float* ssq, const float* cw, const float* cb, LAS float* tab, LAS float* wtab, const pg8::StaticOrder& S) {
    const int tid = opaque_tid(), q = tid >> 1, half = tid & 1;
    pg8::Unit u;
    for (int i = 0; S.next(i, u); ++i) {
        { const int k = tid >> 7, c = tid & 127, f = 128 * u.pn + c; wtab[i * 512 + tid] = k < 3 ? cw[k * DFF + f] : cb[f]; }
        int r = 252 * u.pm - 2 + 126 * (q >> 7) + (q & 127); r = r < 0 ? 0 : (r >= M ? M - 1 : r);
        const float* sp = ssq + (size_t)r * 32 + 16 * half;
        const f32x4 a = *(const f32x4*)sp, b = *(const f32x4*)(sp + 4), c = *(const f32x4*)(sp + 8), d = *(const f32x4*)(sp + 12);
        float sm = (((a[0] + a[1]) + (a[2] + a[3])) + ((b[0] + b[1]) + (b[2] + b[3]))) + (((c[0] + c[1]) + (c[2] + c[3])) + ((d[0] + d[1]) + (d[2] + d[3])));
        sm += __shfl_xor(sm, 1);
        if (half == 0) tab[i * 256 + q] = __builtin_amdgcn_rsqf(sm * (1.0f / D) + EPS);
    }
}

__device__ __forceinline__ int invperm32(int q) { return 16 * ((q >> 2) & 1) + 4 * (q >> 3) + (q & 3); }
__device__ __forceinline__ void p0_transpose_item(const float* W, int K, int N, const float* kscale, bf16_t* WT, int mode, LAS float* scr, int item, int lane) {
    const int nblk = N / 32, kb = item / nblk, nb = item % nblk, k0 = 64 * kb, n0 = 32 * nb;
    float v[32];
    const float* src = W + (size_t)(k0 + (lane >> 5)) * N + n0 + (lane & 31);
#pragma unroll
    for (int i = 0; i < 32; ++i) v[i] = src[(size_t)(2 * i) * N];
#pragma unroll
    for (int i = 0; i < 32; ++i) scr[(2 * i + (lane >> 5)) * 33 + (lane & 31)] = v[i];
    asm volatile("s_waitcnt lgkmcnt(0)" ::: "memory");
    int rbase = n0;
    if (mode == 1) { const int bj = n0 >= DFF ? 1 : 0, f = n0 - bj * DFF; rbase = 256 * (f >> 7) + 128 * bj + (f & 96); }
    const int c = lane & 7;
    f32x4 ks0 = (f32x4){1.f, 1.f, 1.f, 1.f}, ks1 = ks0;
    if (kscale) { ks0 = *(const f32x4*)(kscale + k0 + 8 * c); ks1 = *(const f32x4*)(kscale + k0 + 8 * c + 4); }
#pragma unroll
    for (int j = 0; j < 4; ++j) { const int n = (lane >> 3) + 8 * j; const LAS float* sp = scr + (8 * c) * 33 + n;
        u32x4 o; o.x = cvt_pk_bf16(sp[0 * 33] * ks0[0], sp[1 * 33] * ks0[1]); o.y = cvt_pk_bf16(sp[2 * 33] * ks0[2], sp[3 * 33] * ks0[3]);
        o.z = cvt_pk_bf16(sp[4 * 33] * ks1[0], sp[5 * 33] * ks1[1]); o.w = cvt_pk_bf16(sp[6 * 33] * ks1[2], sp[7 * 33] * ks1[3]);
        *(u32x4*)(WT + (size_t)(rbase + (mode == 2 ? n : invperm32(n))) * K + k0 + 8 * c) = o; }
    asm volatile("s_waitcnt lgkmcnt(0)" ::: "memory");
}
constexpr int I_IN = (D / 64) * (DIN / 32), I_O = (DMIX / 64) * (D / 32), I_UP = (D / 64) * (2 * DFF / 32), I_DN = (DFF / 64) * (D / 32), I_G = 2 * NH * 8;
constexpr int IT_O = I_IN, IT_UP = IT_O + I_O, IT_DN = IT_UP + I_UP, IT_G = IT_DN + I_DN, IT_END = IT_G + I_G;
__device__ __forceinline__ void convert_items(PRef p, LAS unsigned char* lds, int rank, int nwaves, int lo, int hi) {
    const int tid_ = opaque_tid(), lane = tid_ & 63, wave = tid_ >> 6;
    unsigned char* ws = p.ws;
    LAS float* scr = (LAS float*)(lds + wave * 16384);
    for (int it = lo + rank; it < hi; it += nwaves) {
        int r = it;
        if (r < I_IN) { p0_transpose_item(p.w_in, D, DIN, p.g_mix, (bf16_t*)(ws + WS_WIN), 0, scr, r, lane); continue; } r -= I_IN;
        if (r < I_O) { p0_transpose_item(p.w_o, DMIX, D, nullptr, (bf16_t*)(ws + WS_WO), 0, scr, r, lane); continue; } r -= I_O;
        if (r < I_UP) { p0_transpose_item(p.w_up, D, 2 * DFF, p.g_ffn, (bf16_t*)(ws + WS_WUP), 1, scr, r, lane); continue; } r -= I_UP;
        if (r < I_DN) { p0_transpose_item(p.w_down, DFF, D, nullptr, (bf16_t*)(ws + WS_WDN), 0, scr, r, lane); continue; } r -= I_DN;
        { const int mat = r >> 3, sub = r & 7, gsel = mat / NH, n = mat % NH;
          p0_transpose_item((gsel ? p.w_gate_x : p.w_gate_a) + (size_t)n * 128 * 128, 128, 128, nullptr, (bf16_t*)(ws + WS_WG) + (size_t)mat * 128 * 128, 0, scr, sub, lane); }
    }
}
constexpr int P1_TAIL_WG0 = (888 % 256), P4_TAIL_WG0 = (296 % 256) * P4_SPLIT, MIX_IDLE_WG0 = 228, IT_S1 = IT_O + 10600, IT_S2 = IT_S1 + 1600, IT_S3 = IT_S2 + 1600;
__device__ __forceinline__ void phase0(PRef p, LAS unsigned char* lds, int G) {
    const int tid = opaque_tid(), lane = tid & 63, wave = tid >> 6;
    unsigned char* ws = p.ws;
    const int gw = blockIdx.x * 8 + wave, NGW = G * 8;
    convert_items(p, lds, gw, NGW, 0, IT_O);
    convert_items(p, lds, gw, NGW, IT_G, IT_END);
    { bf16_t* xb = (bf16_t*)(ws + WS_XB) + (size_t)16 * D; float* rstd1 = (float*)(ws + WS_RS1);
      for (int m = gw; m < M; m += NGW) {
          const f32x4* xr = (const f32x4*)x_row_ptr(p.x_prompt, p.x_sample, p.meta, m) + lane;
          f32x4 v[8]; float s = 0.f;
#pragma unroll
          for (int j = 0; j < 8; ++j) { v[j] = xr[64 * j]; s += (v[j][0] * v[j][0] + v[j][1] * v[j][1]) + (v[j][2] * v[j][2] + v[j][3] * v[j][3]); }
          s = wave_sum(s);
          if (lane == 0) rstd1[m] = __builtin_amdgcn_rsqf(s * (1.0f / D) + EPS);
          u32x2* o = (u32x2*)(xb + (size_t)m * D) + lane;
#pragma unroll
          for (int j = 0; j < 8; ++j) { u32x2 w; w.x = cvt_pk_bf16(v[j][0], v[j][1]); w.y = cvt_pk_bf16(v[j][2], v[j][3]); o[64 * j] = w; }
      } }
}

__device__ __forceinline__ void branch_b(PRef p, int G) {
    const bf16_t* z = (const bf16_t*)(p.ws + WS_Z); bf16_t* ym = (bf16_t*)(p.ws + WS_YM);
    const int total = (M / 4) * 128;
    for (int idx = blockIdx.x * 512 + opaque_tid(); idx < total; idx += G * 512) {
        const int m0 = (idx >> 7) * 4, g = idx & 127, ch = 8 * g;
        int is_s, seq, t0; row_decode(m0, is_s, seq, t0);
        u32x4 rc[6], rv[6], rg[4];
#pragma unroll
        for (int k = 0; k < 6; ++k) {
            const int mm = (t0 - 2 + k >= 0) ? m0 - 2 + k : m0;
            rc[k] = *(const u32x4*)(z + (size_t)mm * DIN + 4096 + ch); rv[k] = *(const u32x4*)(z + (size_t)mm * DIN + 5120 + ch);
        }
#pragma unroll
        for (int k = 0; k < 4; ++k) rg[k] = *(const u32x4*)(z + (size_t)(m0 + k) * DIN + 3072 + ch);
        const f32x4 w0a = *(const f32x4*)(p.conv_b_w + ch), w0b = *(const f32x4*)(p.conv_b_w + ch + 4), w1a = *(const f32x4*)(p.conv_b_w + DB + ch), w1b = *(const f32x4*)(p.conv_b_w + DB + ch + 4),
                    w2a = *(const f32x4*)(p.conv_b_w + 2 * DB + ch), w2b = *(const f32x4*)(p.conv_b_w + 2 * DB + ch + 4), goa = *(const f32x4*)(p.g_out_b + ch), gob = *(const f32x4*)(p.g_out_b + ch + 4);
        float u[6][8];
#pragma unroll
        for (int k = 0; k < 6; ++k) {
            float a[8], b[8]; unpack8(rc[k], a); unpack8(rv[k], b);
#pragma unroll
            for (int e = 0; e < 8; ++e) u[k][e] = a[e] * b[e];
        }
        if (t0 == 0) {
#pragma unroll
            for (int k = 0; k < 2; ++k) {
                f32x4 a = (f32x4){0.f, 0.f, 0.f, 0.f}, b = a;
                if (is_s) { const float* sp = p.st_sc + ((size_t)seq * 2 + k) * DB + ch; a = *(const f32x4*)sp; b = *(const f32x4*)(sp + 4); }
#pragma unroll
                for (int e = 0; e < 4; ++e) { u[k][e] = a[e]; u[k][4 + e] = b[e]; }
            }
        }
        const int T = is_s ? TS : TP;
#pragma unroll
        for (int k = 0; k < 4; ++k) {
            float gb[8]; unpack8(rg[k], gb);
            float y[8]; float ss = 0.f;
#pragma unroll
            for (int e = 0; e < 8; ++e) {
                const float uc = (e < 4 ? w0a[e & 3] : w0b[e & 3]) * u[k][e] + (e < 4 ? w1a[e & 3] : w1b[e & 3]) * u[k + 1][e] + (e < 4 ? w2a[e & 3] : w2b[e & 3]) * u[k + 2][e];
                y[e] = gb[e] * uc; ss += y[e] * y[e];
            }
            ss = sum16(ss);
            const float rn = __builtin_amdgcn_rsqf(ss * (1.0f / 128.0f) + EPS);
#pragma unroll
            for (int e = 0; e < 8; ++e) y[e] = y[e] * rn * (e < 4 ? goa[e & 3] : gob[e & 3]);
            *(u32x4*)(ym + (size_t)(m0 + k) * DMIX + DA + ch) = pack8(y);
            const int t = t0 + k;
            if (t >= T - 2) { float* so = p.out + (is_s ? O_SSC : O_PSC) + ((size_t)seq * 2 + (t - (T - 2))) * DB + ch;
                *(f32x4*)so = (f32x4){u[k + 2][0], u[k + 2][1], u[k + 2][2], u[k + 2][3]}; *(f32x4*)(so + 4) = (f32x4){u[k + 2][4], u[k + 2][5], u[k + 2][6], u[k + 2][7]}; }
        }
    }
}

constexpr int LW_STRIDE = 272, L_WA = 0, L_WX = 128 * LW_STRIDE, L_CT = 2 * 128 * LW_STRIDE, L_LRU_END = L_CT + 9 * 128 * 4;
static_assert(L_LRU_END <= 131072, "mixer LDS");
constexpr int LRU_WG_PER_HEAD = 19, LRU_NSEG = 33, LRU_PITEMS = NB * LRU_NSEG, LRU_SITEMS = MSR / 64;
static_assert(LRU_WG_PER_HEAD * 8 >= LRU_PITEMS + LRU_SITEMS, "waves per head");

template <int CTRL, int BANK> __device__ __forceinline__ float dppfb(float old, float src) {
    return __builtin_bit_cast(float, __builtin_amdgcn_update_dpp(__builtin_bit_cast(int, old), __builtin_bit_cast(int, src), CTRL, 0xF, BANK, false));
}
__device__ __forceinline__ float bcast15(float x, int lane) {
    return __builtin_bit_cast(float, __builtin_amdgcn_ds_bpermute(((lane & 48) | 15) << 2, __builtin_bit_cast(int, x)));
}
__device__ __forceinline__ void scan16(float& P, float& S) {
    float Sd, Pd;
    Sd = dppf<0x111>(0.f, S); Pd = dppf<0x111>(1.f, P); S = __builtin_fmaf(P, Sd, S); P *= Pd;
    Sd = dppf<0x112>(0.f, S); Pd = dppf<0x112>(1.f, P); S = __builtin_fmaf(P, Sd, S); P *= Pd;
    Sd = dppf<0x114>(0.f, S); Pd = dppf<0x114>(1.f, P); S = __builtin_fmaf(P, Sd, S); P *= Pd;
    Sd = dppf<0x118>(0.f, S); Pd = dppf<0x118>(1.f, P); S = __builtin_fmaf(P, Sd, S); P *= Pd;
}
__device__ __forceinline__ void scan16x2(float& P1, float& S1, float& P2, float& S2) {
    asm volatile(
        "s_nop 1\n\t"
        "v_fmac_f32_dpp %1, %1, %0 row_shr:1 row_mask:0xf bank_mask:0xf bound_ctrl:1\n\t"
        "v_fmac_f32_dpp %3, %3, %2 row_shr:1 row_mask:0xf bank_mask:0xf bound_ctrl:1\n\t"
        "v_mul_f32_dpp %0, %0, %0 row_shr:1 row_mask:0xf bank_mask:0xf\n\t"
        "v_mul_f32_dpp %2, %2, %2 row_shr:1 row_mask:0xf bank_mask:0xf\n\t"
        "v_fmac_f32_dpp %1, %1, %0 row_shr:2 row_mask:0xf bank_mask:0xf bound_ctrl:1\n\t"
        "v_fmac_f32_dpp %3, %3, %2 row_shr:2 row_mask:0xf bank_mask:0xf bound_ctrl:1\n\t"
        "v_mul_f32_dpp %0, %0, %0 row_shr:2 row_mask:0xf bank_mask:0xf\n\t"
        "v_mul_f32_dpp %2, %2, %2 row_shr:2 row_mask:0xf bank_mask:0xf\n\t"
        "v_fmac_f32_dpp %1, %1, %0 row_shr:4 row_mask:0xf bank_mask:0xf bound_ctrl:1\n\t"
        "v_fmac_f32_dpp %3, %3, %2 row_shr:4 row_mask:0xf bank_mask:0xf bound_ctrl:1\n\t"
        "v_mul_f32_dpp %0, %0, %0 row_shr:4 row_mask:0xf bank_mask:0xf\n\t"
        "v_mul_f32_dpp %2, %2, %2 row_shr:4 row_mask:0xf bank_mask:0xf\n\t"
        "v_fmac_f32_dpp %1, %1, %0 row_shr:8 row_mask:0xf bank_mask:0xf bound_ctrl:1\n\t"
        "v_fmac_f32_dpp %3, %3, %2 row_shr:8 row_mask:0xf bank_mask:0xf bound_ctrl:1\n\t"
        "v_mul_f32_dpp %0, %0, %0 row_shr:8 row_mask:0xf bank_mask:0xf\n\t"
        "v_mul_f32_dpp %2, %2, %2 row_shr:8 row_mask:0xf bank_mask:0xf\n\t"
        "s_nop 0"
        : "+v"(P1), "+v"(S1), "+v"(P2), "+v"(S2));
}
__device__ __forceinline__ void scan8(float& P, float& S, int t) {
    float Sd, Pd;
    Sd = dppf<0x111>(0.f, S); Pd = dppf<0x111>(1.f, P); if (t < 1) { Sd = 0.f; Pd = 1.f; } S = __builtin_fmaf(P, Sd, S); P *= Pd;
    Sd = dppf<0x112>(0.f, S); Pd = dppf<0x112>(1.f, P); if (t < 2) { Sd = 0.f; Pd = 1.f; } S = __builtin_fmaf(P, Sd, S); P *= Pd;
    Sd = dppfb<0x114, 0xA>(0.f, S); Pd = dppfb<0x114, 0xA>(1.f, P); S = __builtin_fmaf(P, Sd, S); P *= Pd;
}

template <int PASS, bool IS_S>
__device__ __forceinline__ void lru_wave_item(PRef p, LAS unsigned char* lds, int n, int b, int seg) {
    const int lane = opaque_tid() & 63, fr = lane & 15, fq = lane >> 4;
    const bf16_t* z = (const bf16_t*)(p.ws + WS_Z);
    bf16_t* ym = (bf16_t*)(p.ws + WS_YM);
    float* tot = (float*)(p.ws + WS_TOT);
    const LAS float* CT = (const LAS float*)(lds + L_CT) + 8 * fq;
    const int gch = n * 128 + 8 * fq;
    const int r0 = IS_S ? MPR + b * 64 : b * TP + seg * 64;
    const int nblk = IS_S ? 4 : (seg == LRU_NSEG - 1 ? 1 : 4);
    float hin[4][8], Pt[4][8];
    u32x4 prevx[4];
#pragma unroll
    for (int ks = 0; ks < 4; ++ks) {
#pragma unroll
        for (int e = 0; e < 8; ++e) { hin[ks][e] = 0.f; Pt[ks][e] = 1.f; }
        prevx[ks] = (u32x4){0u, 0u, 0u, 0u};
    }
    if constexpr (!IS_S) {
        if (seg > 0) {
#pragma unroll
            for (int ks = 0; ks < 4; ++ks) prevx[ks] = *(const u32x4*)(z + (size_t)(r0 - 16 + fr) * DIN + gch + 32 * ks);
            if constexpr (PASS == 2) {
#pragma unroll 1
                for (int round = 0; round < 2; ++round) {
                    const int s = 16 * round + fr;
                    if (16 * round >= seg) break;
                    const bool have = s < seg;
                    const float* tp = tot + ((size_t)(b * LRU_NSEG + (have ? s : 0)) * 2) * DA + gch;
#pragma unroll
                    for (int ks = 0; ks < 4; ++ks) {
                        const f32x4 P0 = *(const f32x4*)(tp + 32 * ks), P1 = *(const f32x4*)(tp + 32 * ks + 4), S0 = *(const f32x4*)(tp + DA + 32 * ks), S1 = *(const f32x4*)(tp + DA + 32 * ks + 4);
#pragma unroll
                        for (int e = 0; e < 8; e += 2) {
                            float Pa = have ? (e < 4 ? P0[e & 3] : P1[e & 3]) : 1.f, Sa = have ? (e < 4 ? S0[e & 3] : S1[e & 3]) : 0.f;
                            float Pb = have ? (e < 4 ? P0[(e + 1) & 3] : P1[(e + 1) & 3]) : 1.f, Sb = have ? (e < 4 ? S0[(e + 1) & 3] : S1[(e + 1) & 3]) : 0.f;
                            scan16x2(Pa, Sa, Pb, Sb);
                            hin[ks][e] = __builtin_fmaf(bcast15(Pa, lane), hin[ks][e], bcast15(Sa, lane));
                            hin[ks][e + 1] = __builtin_fmaf(bcast15(Pb, lane), hin[ks][e + 1], bcast15(Sb, lane));
                        }
                    }
                }
            }
        }
    }
    u32x4 xnext[4];
#pragma unroll
    for (int ks = 0; ks < 4; ++ks) xnext[ks] = *(const u32x4*)(z + (size_t)(r0 + fr) * DIN + gch + 32 * ks);
#pragma unroll 1
    for (int blk = 0; blk < nblk; ++blk) {
        const int r = r0 + 16 * blk + fr;
        const int t8 = fr & 7, sq = (r - MPR) >> 3;
        u32x4 x4[4], g4[4];
#pragma unroll
        for (int ks = 0; ks < 4; ++ks) { x4[ks] = xnext[ks]; if constexpr (PASS == 2) g4[ks] = *(const u32x4*)(z + (size_t)r * DIN + DA + gch + 32 * ks); }
        { const int rn_ = (blk + 1 < nblk) ? r + 16 : r;
#pragma unroll
          for (int ks = 0; ks < 4; ++ks) xnext[ks] = *(const u32x4*)(z + (size_t)rn_ * DIN + gch + 32 * ks); }
        float xc[4][8];
        bf16x8 bfrag[4];
#pragma unroll
        for (int ks = 0; ks < 4; ++ks) {
            float xf[8]; unpack8(x4[ks], xf);
            const f32x4 w0a = *(const LAS f32x4*)(CT + 0 * 128 + 32 * ks), w0b = *(const LAS f32x4*)(CT + 0 * 128 + 32 * ks + 4);
            const f32x4 w1a = *(const LAS f32x4*)(CT + 1 * 128 + 32 * ks), w1b = *(const LAS f32x4*)(CT + 1 * 128 + 32 * ks + 4);
            const f32x4 w2a = *(const LAS f32x4*)(CT + 2 * 128 + 32 * ks), w2b = *(const LAS f32x4*)(CT + 2 * 128 + 32 * ks + 4);
            const f32x4 w3a = *(const LAS f32x4*)(CT + 3 * 128 + 32 * ks), w3b = *(const LAS f32x4*)(CT + 3 * 128 + 32 * ks + 4);
            const f32x4 cba = *(const LAS f32x4*)(CT + 4 * 128 + 32 * ks), cbb = *(const LAS f32x4*)(CT + 4 * 128 + 32 * ks + 4);
            if constexpr (IS_S) {
                const float* sp = p.st_rc + (size_t)sq * 3 * DA + gch + 32 * ks;
                const f32x4 b0a = *(const f32x4*)sp, b0b = *(const f32x4*)(sp + 4), b1a = *(const f32x4*)(sp + DA), b1b = *(const f32x4*)(sp + DA + 4), b2a = *(const f32x4*)(sp + 2 * DA), b2b = *(const f32x4*)(sp + 2 * DA + 4);
#pragma unroll
                for (int e = 0; e < 8; ++e) {
                    const float bb0 = e < 4 ? b0a[e & 3] : b0b[e & 3], bb1 = e < 4 ? b1a[e & 3] : b1b[e & 3], bb2 = e < 4 ? b2a[e & 3] : b2b[e & 3];
                    const float s1 = dppf<0x111>(0.f, xf[e]), s2 = dppf<0x112>(0.f, xf[e]), s3 = dppf<0x113>(0.f, xf[e]);
                    const float x1 = t8 >= 1 ? s1 : bb2;
                    const float x2 = t8 >= 2 ? s2 : (t8 == 1 ? bb2 : bb1);
                    const float x3 = t8 >= 3 ? s3 : (t8 == 2 ? bb2 : (t8 == 1 ? bb1 : bb0));
                    const float w0 = e < 4 ? w0a[e & 3] : w0b[e & 3], w1 = e < 4 ? w1a[e & 3] : w1b[e & 3], w2 = e < 4 ? w2a[e & 3] : w2b[e & 3], w3 = e < 4 ? w3a[e & 3] : w3b[e & 3];
                    xc[ks][e] = (e < 4 ? cba[e & 3] : cbb[e & 3]) + w3 * xf[e] + w2 * x1 + w1 * x2 + w0 * x3;
                }
            } else {
                float pf[8]; unpack8(prevx[ks], pf);
#pragma unroll
                for (int e = 0; e < 8; ++e) {
                    const float x1 = dppf<0x111>(dppf<0x121>(0.f, pf[e]), xf[e]);
                    const float x2 = dppf<0x112>(dppf<0x122>(0.f, pf[e]), xf[e]);
                    const float x3 = dppf<0x113>(dppf<0x123>(0.f, pf[e]), xf[e]);
                    const float w0 = e < 4 ? w0a[e & 3] : w0b[e & 3], w1 = e < 4 ? w1a[e & 3] : w1b[e & 3], w2 = e < 4 ? w2a[e & 3] : w2b[e & 3], w3 = e < 4 ? w3a[e & 3] : w3b[e & 3];
                    xc[ks][e] = (e < 4 ? cba[e & 3] : cbb[e & 3]) + w3 * xf[e] + w2 * x1 + w1 * x2 + w0 * x3;
                }
                prevx[ks] = x4[ks];
            }
            bfrag[ks] = __builtin_bit_cast(bf16x8, pack8(xc[ks]));
        }
        f32x4 aa[8], ax[8];
#pragma unroll
        for (int nb = 0; nb < 8; ++nb) { aa[nb] = (f32x4){0.f, 0.f, 0.f, 0.f}; ax[nb] = (f32x4){0.f, 0.f, 0.f, 0.f}; }
#pragma unroll
        for (int ks = 0; ks < 4; ++ks)
#pragma unroll
            for (int nb = 0; nb < 8; ++nb) {
                const bf16x8 wa = *(const LAS bf16x8*)(lds + L_WA + (16 * nb + fr) * LW_STRIDE + (32 * ks + 8 * fq) * 2);
                const bf16x8 wx = *(const LAS bf16x8*)(lds + L_WX + (16 * nb + fr) * LW_STRIDE + (32 * ks + 8 * fq) * 2);
                aa[nb] = __builtin_amdgcn_mfma_f32_16x16x32_bf16(wa, bfrag[ks], aa[nb], 0, 0, 0);
                ax[nb] = __builtin_amdgcn_mfma_f32_16x16x32_bf16(wx, bfrag[ks], ax[nb], 0, 0, 0);
            }
        float y[4][8]; float ss = 0.f;
#pragma unroll
        for (int ks = 0; ks < 4; ++ks) {
            const f32x4 bga0 = *(const LAS f32x4*)(CT + 5 * 128 + 32 * ks), bga1 = *(const LAS f32x4*)(CT + 5 * 128 + 32 * ks + 4);
            const f32x4 bgx0 = *(const LAS f32x4*)(CT + 6 * 128 + 32 * ks), bgx1 = *(const LAS f32x4*)(CT + 6 * 128 + 32 * ks + 4);
            const f32x4 sp0 = *(const LAS f32x4*)(CT + 7 * 128 + 32 * ks), sp1 = *(const LAS f32x4*)(CT + 7 * 128 + 32 * ks + 4);
            float gav[8];
            if constexpr (PASS == 2) unpack8(g4[ks], gav);
            f32x4 h0a, h0b;
            if constexpr (IS_S) { const float* hp = p.st_h + (size_t)sq * DA + gch + 32 * ks; h0a = *(const f32x4*)hp; h0b = *(const f32x4*)(hp + 4); }
            float hv[8], Pv[8], Sv[8];
#pragma unroll
            for (int e = 0; e < 8; ++e) {
                const int nb = 2 * ks + (e >> 2), rg = e & 3;
                const float rr = __builtin_amdgcn_rcpf(1.0f + __builtin_amdgcn_exp2f(__builtin_fmaf(aa[nb][rg], -1.4426950408889634f, e < 4 ? bga0[rg] : bga1[rg])));
                const float ii = __builtin_amdgcn_rcpf(1.0f + __builtin_amdgcn_exp2f(__builtin_fmaf(ax[nb][rg], -1.4426950408889634f, e < 4 ? bgx0[rg] : bgx1[rg])));
                const float a = __builtin_amdgcn_exp2f(rr * (e < 4 ? sp0[rg] : sp1[rg]));
                const float om = __builtin_fmaf(-a, a, 1.0f);
                Pv[e] = a; Sv[e] = __builtin_amdgcn_sqrtf(om > 0.f ? om : 0.f) * (ii * xc[ks][e]);
            }
            if constexpr (IS_S) {
#pragma unroll
                for (int e = 0; e < 8; ++e) { scan8(Pv[e], Sv[e], t8); hv[e] = __builtin_fmaf(Pv[e], e < 4 ? h0a[e & 3] : h0b[e & 3], Sv[e]); }
            } else {
#pragma unroll
                for (int e = 0; e < 8; e += 2) scan16x2(Pv[e], Sv[e], Pv[e + 1], Sv[e + 1]);
#pragma unroll
                for (int e = 0; e < 8; ++e) {
                    hv[e] = __builtin_fmaf(Pv[e], hin[ks][e], Sv[e]);
                    hin[ks][e] = bcast15(hv[e], lane);
                    if constexpr (PASS == 1) Pt[ks][e] *= bcast15(Pv[e], lane);
                }
            }
            if constexpr (PASS == 2) {
#pragma unroll
                for (int e = 0; e < 8; ++e) { y[ks][e] = gelu_tanh(gav[e]) * hv[e]; ss += y[ks][e] * y[ks][e]; }
            }
            if constexpr (PASS == 2) {
                if (IS_S ? (t8 == 7) : (seg == LRU_NSEG - 1 && fr == 15)) {
                    float* ho = p.out + (IS_S ? O_SH + (size_t)sq * DA : O_PH + (size_t)b * DA) + gch + 32 * ks;
                    *(f32x4*)ho = (f32x4){hv[0], hv[1], hv[2], hv[3]}; *(f32x4*)(ho + 4) = (f32x4){hv[4], hv[5], hv[6], hv[7]};
                }
            }
        }
        if constexpr (PASS == 2) {
            ss += __shfl_xor(ss, 16); ss += __shfl_xor(ss, 32);
            const float rn = __builtin_amdgcn_rsqf(ss * (1.0f / 128.0f) + EPS);
#pragma unroll
            for (int ks = 0; ks < 4; ++ks) {
                const f32x4 g0 = *(const LAS f32x4*)(CT + 8 * 128 + 32 * ks), g1 = *(const LAS f32x4*)(CT + 8 * 128 + 32 * ks + 4);
                float o[8];
#pragma unroll
                for (int e = 0; e < 8; ++e) o[e] = y[ks][e] * rn * (e < 4 ? g0[e & 3] : g1[e & 3]);
                *(u32x4*)(ym + (size_t)r * DMIX + gch + 32 * ks) = pack8(o);
            }
        }
    }
    if constexpr (PASS == 1 && !IS_S) {
        if (fr == 0) {
            float* tp = tot + ((size_t)(b * LRU_NSEG + seg) * 2) * DA + gch;
#pragma unroll
            for (int ks = 0; ks < 4; ++ks) {
                *(f32x4*)(tp + 32 * ks) = (f32x4){Pt[ks][0], Pt[ks][1], Pt[ks][2], Pt[ks][3]}; *(f32x4*)(tp + 32 * ks + 4) = (f32x4){Pt[ks][4], Pt[ks][5], Pt[ks][6], Pt[ks][7]};
                *(f32x4*)(tp + DA + 32 * ks) = (f32x4){hin[ks][0], hin[ks][1], hin[ks][2], hin[ks][3]}; *(f32x4*)(tp + DA + 32 * ks + 4) = (f32x4){hin[ks][4], hin[ks][5], hin[ks][6], hin[ks][7]};
            }
        }
    }
}
template <int PASS>
__device__ __forceinline__ void mixer_phase(PRef p, LAS unsigned char* lds, int G) {
    const int tid = opaque_tid(), wave = __builtin_amdgcn_readfirstlane(tid >> 6);
    for (int v = blockIdx.x; v < NH * LRU_WG_PER_HEAD; v += G) {
        const int n = v / LRU_WG_PER_HEAD;
        __syncthreads();
        if (!(PASS == 2 && G == GRID && p.ph_lo <= 2))
        {
            const bf16_t* wg = (const bf16_t*)(p.ws + WS_WG);
            for (int i = tid; i < 2 * 128 * 16; i += 512) { const int g = i >> 11, row = (i >> 4) & 127, c16 = i & 15;
                *(LAS u32x4*)(lds + g * L_WX + row * LW_STRIDE + c16 * 16) = *(const u32x4*)(wg + (((size_t)g * NH + n) * 128 + row) * 128 + c16 * 8); }
            LAS float* CTw = (LAS float*)(lds + L_CT);
            for (int i = tid; i < 9 * 128; i += 512) { const int k = i >> 7, c = i & 127, ch = n * 128 + c;
                float vv;
                if (k < 4) vv = p.conv_a_w[k * DA + ch]; else if (k == 4) vv = p.conv_a_b[ch]; else if (k == 5) vv = -1.4426950408889634f * p.b_gate_a[ch]; else if (k == 6) vv = -1.4426950408889634f * p.b_gate_x[ch];
                else if (k == 7) vv = -8.0f * 1.4426950408889634f * log1pf(__expf(-p.lam[ch])); else vv = p.g_out_a[ch];
                CTw[i] = vv; }
        }
        __syncthreads();
        const int wi = (v % LRU_WG_PER_HEAD) * 8 + wave;
        if (wi < LRU_PITEMS) lru_wave_item<PASS, false>(p, lds, n, wi / LRU_NSEG, wi % LRU_NSEG);
        else if (PASS == 2 && wi < LRU_PITEMS + LRU_SITEMS) lru_wave_item<PASS, true>(p, lds, n, wi - LRU_PITEMS, 0);
    }
    if (G == 256 && (int)blockIdx.x >= MIX_IDLE_WG0) convert_items(p, lds, ((int)blockIdx.x - MIX_IDLE_WG0) * 8 + wave, (G - MIX_IDLE_WG0) * 8, PASS == 1 ? IT_S1 : IT_S2, PASS == 1 ? IT_S2 : IT_S3);
    if (PASS == 1) { branch_b(p, G); if ((REP_MASK >> 11) & 1) branch_b(p, G); }
}

__device__ __forceinline__ void final_phase(PRef p, int G) {
    const int tid_ = opaque_tid(), lane = tid_ & 63, gw = blockIdx.x * 8 + (tid_ >> 6), NGW = G * 8;
    const bf16_t* x2b = (const bf16_t*)(p.ws + WS_YM);
    f32x4 gf[8];
#pragma unroll
    for (int j = 0; j < 8; ++j) gf[j] = ((const f32x4*)p.g_final)[lane + 64 * j];
    for (int o = gw; o < NB * SEQ + MSR; o += NGW) {
        const int r = o < NB * SEQ ? (o / SEQ) * TP + NMETA + (o % SEQ) : MPR + (o - NB * SEQ);
        const u32x2* xr = (const u32x2*)(x2b + (size_t)r * D) + lane;
        f32x4 v[8]; float s = 0.f;
#pragma unroll
        for (int j = 0; j < 8; ++j) { const u32x2 w = xr[64 * j]; v[j] = (f32x4){bf_lo(w.x), bf_hi(w.x), bf_lo(w.y), bf_hi(w.y)};
            s += (v[j][0] * v[j][0] + v[j][1] * v[j][1]) + (v[j][2] * v[j][2] + v[j][3] * v[j][3]); }
        s = wave_sum(s);
        const float rs = __builtin_amdgcn_rsqf(s * (1.0f / D) + EPS);
        f32x4* yo = (f32x4*)(p.out + (size_t)o * D) + lane;
#pragma unroll
        for (int j = 0; j < 8; ++j) yo[64 * j] = v[j] * rs * gf[j];
    }
}

#define XB_TMO      128
#define XB_XCNT(j)  (256  + 64 * (j))
#define XB_XSUB(j)  (1280 + 64 * (j))
#define XB_XGEN(j)  (2304 + 64 * (j))
#define XB_TOP      3328
#define XB_TOPGEN   3392
#define XCD_BAR_WORDS 3456
#define XB_SPIN_CAP (1u << 18)
__device__ __forceinline__ unsigned xb_ld(unsigned* p)              { return __hip_atomic_load(p, __ATOMIC_RELAXED, __HIP_MEMORY_SCOPE_AGENT); }
__device__ __forceinline__ unsigned xb_add(unsigned* p, unsigned v) { return __hip_atomic_fetch_add(p, v, __ATOMIC_RELAXED, __HIP_MEMORY_SCOPE_AGENT); }
__device__ __forceinline__ unsigned xb_xcc_id() { return (unsigned)__builtin_amdgcn_s_getreg((3 << 11) | 20) & 0xFu; }
#define XB_SPIN(cond, bar) do { unsigned _sp = 0; while (cond) { __builtin_amdgcn_s_sleep(1); \
    if ((++_sp & 255u) == 0u) { if (xb_ld(&(bar)[XB_TMO])) break; if (_sp > XB_SPIN_CAP) { atomicAdd(&(bar)[XB_TMO], 1u); break; } } } } while (0)
struct XcdBarrier { unsigned* bar; unsigned x; volatile LAS unsigned* st; };
__device__ __forceinline__ XcdBarrier xcd_barrier_post(unsigned* bar, volatile LAS unsigned* st) {
    XcdBarrier b; b.bar = bar; b.x = xb_xcc_id(); b.st = st;
    if (threadIdx.x == 0) (void)xb_add(&bar[XB_XCNT(b.x)], 1u);
    return b;
}
__device__ __forceinline__ void xcd_barrier_complete(unsigned* bar, unsigned x, unsigned& nloc, unsigned& nx) {
    const unsigned G = gridDim.x * gridDim.y * gridDim.z;
    unsigned sum, cnt, mine, sp = 0u;
    for (;;) {
        sum = 0u; cnt = 0u; mine = 0u;
#pragma unroll
        for (unsigned j = 0; j < 16; ++j) { const unsigned c = xb_ld(&bar[XB_XCNT(j)]); sum += c; cnt += (c > 0u) ? 1u : 0u; mine = (j == x) ? c : mine; }
        if (sum == G) break;
        __builtin_amdgcn_s_sleep(1);
        if ((++sp & 255u) == 0u) { if (xb_ld(&bar[XB_TMO])) break; if (sp > XB_SPIN_CAP) { atomicAdd(&bar[XB_TMO], 1u); break; } }
    }
    nloc = mine > 0u ? mine : 1u; nx = cnt > 0u ? cnt : 1u;
}
__device__ __forceinline__ void xcd_barrier(const XcdBarrier& b) {
    asm volatile("s_waitcnt vmcnt(0)" ::: "memory");
    __syncthreads();
    if (threadIdx.x == 0) {
        unsigned* bar = b.bar;
        __builtin_amdgcn_s_waitcnt(0);
        unsigned nloc = b.st[0], nx = b.st[1];
        if (nloc == 0u) { xcd_barrier_complete(bar, b.x, nloc, nx); b.st[0] = nloc; b.st[1] = nx; }
        const unsigned old = xb_add(&bar[XB_XSUB(b.x)], 1u);
        const unsigned gen = old / nloc;
        if (old + 1u == (gen + 1u) * nloc) {
            __builtin_amdgcn_fence(__ATOMIC_RELEASE, "agent");
            asm volatile("s_waitcnt vmcnt(0)" ::: "memory");
            const unsigned og = xb_add(&bar[XB_TOP], 1u);
            const unsigned tg = og / nx;
            if (og + 1u == (tg + 1u) * nx) xb_add(&bar[XB_TOPGEN], 1u);
            else XB_SPIN(xb_ld(&bar[XB_TOPGEN]) == tg, bar);
            __builtin_amdgcn_fence(__ATOMIC_ACQUIRE, "agent");
            xb_add(&bar[XB_XGEN(b.x)], 1u);
            asm volatile("s_waitcnt vmcnt(0)" ::: "memory");
        } else {
            XB_SPIN(xb_ld(&bar[XB_XGEN(b.x)]) == gen, bar);
            __builtin_amdgcn_fence(__ATOMIC_ACQUIRE, "agent");
            asm volatile("s_waitcnt vmcnt(0)" ::: "memory");
        }
    }
    __syncthreads();
}

constexpr int LDS_BYTES = 131072 + 1024 + 8 * 1024 + 8 * 2048;
constexpr int N_PHASES = 8;
__global__ void __launch_bounds__(512, 2) hymba_fwd(Params p) {
    extern __shared__ __attribute__((aligned(16))) unsigned char lds_raw[];
    LAS unsigned char* lds = (LAS unsigned char*)lds_raw;
    constexpr int G = GRID;
    if ((int)gridDim.x != GRID) return;
    const CAS Params* kp = (const CAS Params*)__builtin_amdgcn_kernarg_segment_ptr();
#define P_HERE (*({ const CAS Params* q_ = kp; asm volatile("" : "+s"(q_)); q_; }))
    unsigned char* ws = p.ws;
    volatile LAS unsigned* misc = (volatile LAS unsigned*)(lds + 131072);
    if (threadIdx.x < 8) misc[threadIdx.x] = 0u;
    __syncthreads();
    XcdBarrier bar = xcd_barrier_post((unsigned*)ws, misc);
    const int lo = p.ph_lo, hi = p.ph_hi;
#ifndef PH_MASK
#define PH_MASK 0xff
#endif
#define IN(k) (((PH_MASK >> (k)) & 1) && lo <= (k) && (k) < hi)
#define SEAM(k) do { if (IN(k) && IN((k) + 1)) xcd_barrier(bar); } while (0)
#define REPEAT(k) for (int rep_ = 0; rep_ < ((((REP_MASK) >> (k)) & 1) ? 2 : 1); ++rep_, (rep_ < ((((REP_MASK) >> (k)) & 1) ? 2 : 1) ? xcd_barrier(bar) : (void)0))
    if ((REP_MASK >> 12) & 1) { xcd_barrier(bar); xcd_barrier(bar); xcd_barrier(bar); xcd_barrier(bar); }
    if (IN(0)) REPEAT(0) phase0(P_HERE, lds, G);
    SEAM(0);
    if (IN(1)) REPEAT(1) {
        pg8::Gemm g{(const bf16_t*)(ws + WS_XB) + (size_t)16 * D, (const bf16_t*)(ws + WS_WIN), MP / 256, DIN / 256, D, (size_t)256 * D * 2, (size_t)128 * D * 2};
        pg8::StaticOrder S; S.init(g.nM, g.nN, G, (int)blockIdx.x, D / 64, 1);
        LAS float* rstab1 = (LAS float*)(lds + 131072 + 1024);
        rstd1_table((const float*)(ws + WS_RS1), rstab1, S); __syncthreads();
        PRef q = P_HERE; EpiZ E{rstab1, (bf16_t*)(ws + WS_Z), q.out};
        pg8::gemm_phase<EpiZ, false, true, true>(lds, g, S, E, nullptr, nullptr);
        if ((int)blockIdx.x >= P1_TAIL_WG0 && G == 256) convert_items(P_HERE, lds, ((int)blockIdx.x - P1_TAIL_WG0) * 8 + (opaque_tid() >> 6), (G - P1_TAIL_WG0) * 8, IT_O, IT_S1);
        else if (G != 256) convert_items(P_HERE, lds, (int)blockIdx.x * 8 + (opaque_tid() >> 6), G * 8, IT_O, IT_S3);
    }
    SEAM(1);
    if (IN(2)) REPEAT(2) mixer_phase<1>(P_HERE, lds, G);
    SEAM(2);
    if (IN(3)) REPEAT(3) mixer_phase<2>(P_HERE, lds, G);
    SEAM(3);
    if (IN(4)) REPEAT(4) {
        pg8::Gemm g{(const bf16_t*)(ws + WS_YM), (const bf16_t*)(ws + WS_WO), MP / 256, D / 256, DMIX, (size_t)256 * DMIX * 2, (size_t)128 * DMIX * 2};
        pg8::StaticOrder S; S.init(g.nM, g.nN, G, (int)blockIdx.x, DMIX / 64, P4_SPLIT);
        EpiX1 E{(bf16_t*)(ws + WS_XB) + (size_t)16 * D, (float*)(ws + WS_SSQ)};
        pg8::gemm_phase<EpiX1, false, true, true>(lds, g, S, E, (float*)(ws + WS_Z), (unsigned*)ws + CW_TK4 + rep_ * 128 * 64);
        if ((int)blockIdx.x >= P4_TAIL_WG0 && G == 256) convert_items(P_HERE, lds, ((int)blockIdx.x - P4_TAIL_WG0) * 8 + (opaque_tid() >> 6), (G - P4_TAIL_WG0) * 8, IT_S3, IT_G);
        else if (G != 256) convert_items(P_HERE, lds, (int)blockIdx.x * 8 + (opaque_tid() >> 6), G * 8, IT_S3, IT_G);
    }
    SEAM(4);
    if (IN(5)) REPEAT(5) {
        pg8::Gemm g{(const bf16_t*)(ws + WS_XB) + (size_t)14 * D, (const bf16_t*)(ws + WS_WUP), 37, 2 * DFF / 256, D, (size_t)252 * D * 2, (size_t)64 * D * 2};
        pg8::StaticOrder S; S.init(g.nM, g.nN, G, (int)blockIdx.x, D / 64, 1);
        LAS float* rstab = (LAS float*)(lds + 131072 + 1024); LAS float* wtab = rstab + 8 * 256;
        PRef q = P_HERE; ffn_rstd_table((const float*)(ws + WS_SSQ), q.conv_f_w, q.conv_f_b, rstab, wtab, S); __syncthreads();
        EpiFFN E{q.st_fc, (bf16_t*)(ws + WS_Z), q.out, rstab, wtab};
        pg8::gemm_phase<EpiFFN, true, true, true>(lds, g, S, E, nullptr, nullptr);
    }
    SEAM(5);
    if (IN(6)) {
        pg8::Gemm g{(const bf16_t*)(ws + WS_Z), (const bf16_t*)(ws + WS_WDN), MP / 256, D / 256, DFF, (size_t)256 * DFF * 2, (size_t)128 * DFF * 2};
        pg8::StaticOrder S; S.init(g.nM, g.nN, G, (int)blockIdx.x, DFF / 64, P6_SPLIT);
        EpiOut E{(const bf16_t*)(ws + WS_XB) + (size_t)16 * D, (bf16_t*)(ws + WS_YM)};
        pg8::gemm_phase<EpiOut, false, true, true>(lds, g, S, E, (float*)(ws + WS_WIN), (unsigned*)ws + CW_TK6);
    }
    SEAM(6);
    if (IN(7)) REPEAT(7) final_phase(P_HERE, G);
#undef IN
#undef SEAM
}

extern "C" void kernel_launch(void* const* d_in, const int* in_sizes, int n_in, void* d_out, int out_size, void* d_ws, size_t ws_size, hipStream_t stream) {
    static int grid = 0;
    if (grid == 0) {
        if (n_in != 26 || (size_t)out_size != O_END || ws_size < WS_END) { fprintf(stderr, "kernel_launch: unexpected problem (n_in %d, out %d, ws %zu; need ws >= %zu)\n", n_in, out_size, ws_size, (size_t)WS_END); grid = -1; return; }
        int dev = 0, cus = 0, per_cu = 0;
        hipGetDevice(&dev); hipDeviceGetAttribute(&cus, hipDeviceAttributeMultiprocessorCount, dev);
        if (hipFuncSetAttribute((const void*)hymba_fwd, hipFuncAttributeMaxDynamicSharedMemorySize, LDS_BYTES) != hipSuccess) { fprintf(stderr, "kernel_launch: hipFuncSetAttribute failed\n"); grid = -1; return; }
        if (hipOccupancyMaxActiveBlocksPerMultiprocessor(&per_cu, (const void*)hymba_fwd, 512, LDS_BYTES) != hipSuccess || per_cu < 1) { fprintf(stderr, "kernel_launch: occupancy query says %d\n", per_cu); grid = -1; return; }
        if (cus < GRID) { fprintf(stderr, "kernel_launch: built for a %d-CU device, found %d CUs\n", GRID, cus); grid = -1; return; }
        grid = GRID;
    }
    if (grid < 0) return;
    Params p{};
    const float** f = (const float**)&p;
    for (int i = 0; i < 26; ++i) f[i] = (const float*)d_in[i];
    p.out = (float*)d_out; p.ws = (unsigned char*)d_ws;
    if (hipMemsetAsync(d_ws, 0, CTL_WORDS * 4, stream) != hipSuccess) { fprintf(stderr, "kernel_launch: memset failed\n"); return; }
    if (MK_N_LAUNCHES == 1) {
        p.ph_lo = 0; p.ph_hi = N_PHASES;
        hipLaunchKernelGGL(hymba_fwd, dim3(grid), dim3(512), LDS_BYTES, stream, p);
    } else {
        for (int k = 0; k < N_PHASES; ++k) { p.ph_lo = k; p.ph_hi = k + 1; hipLaunchKernelGGL(hymba_fwd, dim3(grid), dim3(512), LDS_BYTES, stream, p); }
    }
}
```

```cpp
#include <hip/hip_runtime.h>
#include <cstdio>

#ifndef REP_MASK
#define REP_MASK 0x00
#endif
#ifndef MK_N_LAUNCHES
#define MK_N_LAUNCHES 1
#endif

#define LAS __attribute__((address_space(3)))
#define CAS __attribute__((address_space(4)))
typedef unsigned short bf16_t;
typedef short bf16x8 __attribute__((ext_vector_type(8)));
typedef float f32x4 __attribute__((ext_vector_type(4)));
typedef unsigned u32x4 __attribute__((ext_vector_type(4)));
typedef unsigned u32x2 __attribute__((ext_vector_type(2)));

constexpr int D = 2048, NMETA = 16, SEQ = 2048, TP = SEQ + NMETA, NB = 4, MPR = NB * TP;
constexpr int NS = 128, TS = 8, MSR = NS * TS, M = MPR + MSR;
constexpr int MP = 9472;
constexpr int DA = 1536, DB = 1024, DIN = 6144, DMIX = 2560, DFF = 6144, NH = 12;
constexpr float EPS = 1e-6f;
constexpr int NCH = 33;
constexpr size_t O_YP = 0, O_YS = O_YP + (size_t)NB * SEQ * D, O_PH = O_YS + (size_t)MSR * D, O_PRC = O_PH + NB * DA,
                 O_PSC = O_PRC + NB * 3 * DA, O_PFC = O_PSC + NB * 2 * DB, O_SH = O_PFC + NB * 2 * DFF, O_SRC = O_SH + NS * DA,
                 O_SSC = O_SRC + (size_t)NS * 3 * DA, O_SFC = O_SSC + (size_t)NS * 2 * DB, O_END = O_SFC + (size_t)NS * 2 * DFF;
constexpr size_t MiB = 1u << 20;
constexpr int CW_TK6 = 4096, CTL_WORDS = 4096 + 256 * 64;
constexpr int P6_SPLIT = 4, P4_SPLIT = 4, CW_TK4 = CW_TK6 + 64 * 64;
constexpr int GRID = 256;
constexpr size_t WS_WIN = 1 * MiB;
constexpr size_t WS_WO = WS_WIN + (size_t)DIN * D * 2;
constexpr size_t WS_WUP = WS_WO + (size_t)D * DMIX * 2;
constexpr size_t WS_WDN = WS_WUP + (size_t)2 * DFF * D * 2;
constexpr size_t WS_WG = WS_WDN + (size_t)D * DFF * 2;
constexpr size_t WS_XB = WS_WG + (size_t)2 * NH * 128 * 128 * 2;
constexpr size_t XB_ROWS = 9600;
constexpr size_t WS_Z = WS_XB + XB_ROWS * D * 2;
constexpr size_t WS_YM = WS_Z + (size_t)MP * DIN * 2;
constexpr size_t WS_RS1 = WS_YM + (size_t)MP * DMIX * 2;
constexpr size_t WS_SSQ = WS_RS1 + (size_t)MP * 4;
constexpr size_t WS_TOT = WS_SSQ + (size_t)MP * 32 * 4;
constexpr size_t WS_END = WS_TOT + (size_t)NB * NCH * DA * 2 * 4;

struct Params;
typedef const CAS Params& PRef;
struct Params {
    const float *x_prompt, *x_sample, *st_h, *st_rc, *st_sc, *st_fc, *meta, *g_mix, *w_in, *conv_a_w, *conv_a_b, *w_gate_a, *b_gate_a,
        *w_gate_x, *b_gate_x, *lam, *conv_b_w, *g_out_a, *g_out_b, *w_o, *g_ffn, *w_up, *conv_f_w, *conv_f_b, *w_down, *g_final;
    float* out; unsigned char* ws; int ph_lo, ph_hi;
};

__device__ __forceinline__ unsigned cvt_pk_bf16(float lo, float hi) { unsigned r; asm volatile("v_cvt_pk_bf16_f32 %0, %1, %2" : "=v"(r) : "v"(lo), "v"(hi)); return r; }
__device__ __forceinline__ float bf_lo(unsigned w) { return __builtin_bit_cast(float, w << 16); }
__device__ __forceinline__ float bf_hi(unsigned w) { return __builtin_bit_cast(float, w & 0xffff0000u); }
__device__ __forceinline__ void unpack8(const u32x4 w, float (&f)[8]) { f[0] = bf_lo(w.x); f[1] = bf_hi(w.x); f[2] = bf_lo(w.y); f[3] = bf_hi(w.y); f[4] = bf_lo(w.z); f[5] = bf_hi(w.z); f[6] = bf_lo(w.w); f[7] = bf_hi(w.w); }
__device__ __forceinline__ u32x4 pack8(const float (&f)[8]) { u32x4 w; w.x = cvt_pk_bf16(f[0], f[1]); w.y = cvt_pk_bf16(f[2], f[3]); w.z = cvt_pk_bf16(f[4], f[5]); w.w = cvt_pk_bf16(f[6], f[7]); return w; }
__device__ __forceinline__ float wave_sum(float v) {
#pragma unroll
    for (int o = 1; o < 64; o <<= 1) v += __shfl_xor(v, o);
    return v;
}
__device__ __forceinline__ float sum16(float v) {
    v += __shfl_xor(v, 1); v += __shfl_xor(v, 2); v += __shfl_xor(v, 4); v += __shfl_xor(v, 8); return v;
}
__device__ __forceinline__ float sigmoidf_(float x) { return __builtin_amdgcn_rcpf(1.0f + __expf(-x)); }
__device__ __forceinline__ float gelu_tanh(float x) {
    constexpr float K1 = -2.0f * 0.7978845608028654f * 1.4426950408889634f, K2 = K1 * 0.044715f;
    const float t = x * __builtin_fmaf(x * x, K2, K1);
    return x * __builtin_amdgcn_rcpf(1.0f + __builtin_amdgcn_exp2f(t));
}
__device__ __forceinline__ int opaque_tid() { int t = threadIdx.x; asm volatile("" : "+v"(t)); return t; }
typedef float f32x2 __attribute__((ext_vector_type(2)));
__device__ __forceinline__ f32x2 gelu_mul2(f32x2 g, f32x2 v) {
    constexpr float K1 = -2.0f * 0.7978845608028654f * 1.4426950408889634f, K2 = K1 * 0.044715f;
    const f32x2 t = g * ((g * g) * K2 + K1);
    f32x2 e; e.x = __builtin_amdgcn_exp2f(t.x); e.y = __builtin_amdgcn_exp2f(t.y);
    const f32x2 d = e + 1.0f;
    f32x2 r; r.x = __builtin_amdgcn_rcpf(d.x); r.y = __builtin_amdgcn_rcpf(d.y);
    return (g * v) * r;
}
template <int CTRL> __device__ __forceinline__ float dppf(float old, float src) {
    return __builtin_bit_cast(float, __builtin_amdgcn_update_dpp(__builtin_bit_cast(int, old), __builtin_bit_cast(int, src), CTRL, 0xF, 0xF, false));
}
__device__ __forceinline__ void row_decode(int r, int& is_s, int& seq, int& t) {
    if (r < MPR) { seq = (r >= TP) + (r >= 2 * TP) + (r >= 3 * TP); t = r - seq * TP; is_s = 0; }
    else { const int q = r - MPR; seq = q >> 3; t = q & 7; is_s = 1; }
}
__device__ __forceinline__ const float* x_row_ptr(const float* xp, const float* xs, const float* meta, int r) {
    int is_s, seq, t; row_decode(r, is_s, seq, t);
    if (is_s) return xs + (size_t)(r - MPR) * D;
    return t < NMETA ? meta + (size_t)t * D : xp + ((size_t)seq * SEQ + (t - NMETA)) * D;
}
__device__ __forceinline__ float* y_row_ptr(float* out, int r) {
    if (r >= M) return nullptr;
    int is_s, seq, t; row_decode(r, is_s, seq, t);
    if (is_s) return out + O_YS + (size_t)(r - MPR) * D;
    return t < NMETA ? nullptr : out + O_YP + ((size_t)seq * SEQ + (t - NMETA)) * D;
}

namespace pg8 {
constexpr int BM = 256, BK = 64, HALF = 128, HTB = HALF * BK * 2, STAGE_BYTES = 8 * HTB, NXCD = 8, WGM = 2;
__host__ __device__ __forceinline__ int lds_byte(int r, int c) { const int st = (r >> 4) * 2 + (c >> 5), rr = r & 15, cc = c & 31, ob = rr * 64 + cc * 2; return st * 1024 + (ob ^ (((ob >> 9) & 1) << 5)); }
__host__ __device__ __forceinline__ void stage_rc(int b, int& R, int& C) { const int st = b / 1024, sb = b % 1024, swz = sb ^ (((sb >> 9) & 1) << 5); R = (st >> 1) * 16 + swz / 64; C = (st & 1) * 32 + (swz % 64) / 2; }
struct Unit { int pm, pn, kb, nk, piece, lu, idx; };
struct Gemm { const bf16_t* A; const bf16_t* Bt; int nM, nN, K; size_t a_tstep, a_hstep; };
struct StaticOrder {
    int nM, nN, nwg, G, c, nt, split, nfull, nleft, limit = 1 << 20, first = 0;
    __device__ __forceinline__ void init(int nM_, int nN_, int G_, int c_, int nt_, int split_) { nM = nM_; nN = nN_; nwg = nM * nN; G = G_; c = c_; nt = nt_; nfull = (nwg / G) * G; nleft = nwg - nfull;
        split = (split_ > 1 && nleft > 0 && nleft * split_ <= G && (nt / split_) * split_ == nt && ((nt / split_) & 1) == 0) ? split_ : 1; }
    __device__ __forceinline__ void map(int L, Unit& u) const {
        int wgid = L; { const int q = nwg / NXCD, r = nwg % NXCD, xcd = wgid % NXCD, off = wgid / NXCD; wgid = (xcd < r ? xcd * (q + 1) : r * (q + 1) + (xcd - r) * q) + off; }
        const int nig = WGM * nN, gid = wgid / nig, rem = wgid - gid * nig, fm = gid * WGM, glast = nM % WGM;
        if (nM - fm >= WGM || glast == 0) { u.pm = fm + (rem & (WGM - 1)); u.pn = rem / WGM; }
        else { u.pm = fm + rem % glast; u.pn = rem / glast; }
    }
    __device__ __forceinline__ bool next(int i, Unit& u) const {
        u.kb = 0; u.nk = nt; u.piece = -1; u.lu = 0; u.idx = i;
        i += first; if (i >= limit) return false;
        const long L = (long)i * G + c;
        if (L < nfull || split == 1) { if (L >= nwg) return false; map((int)L, u); return true; }
        if (L >= nfull + G || c >= nleft * split) return false;
        u.lu = c % nleft; u.piece = c / nleft; u.nk = nt / split; u.kb = u.piece * u.nk; map(nfull + u.lu, u); return true;
    }
};

template <int P, int A, int Mi>
__device__ __forceinline__ void reduce_rowgroup(f32x4 (&acc)[2][2][4][2], const unsigned char* slab0, int tid) {
    const unsigned char* sp = slab0 + (size_t)((A * 4 + Mi) * 4) * 16384 + tid * 16;
#pragma unroll
    for (int b = 0; b < 2; ++b) {
        f32x4 s0 = (f32x4){0.f, 0.f, 0.f, 0.f}, s1 = s0;
#pragma unroll
        for (int src = 0; src < 4; ++src) {
            if (src == P) { s0 += acc[A][b][Mi][0]; s1 += acc[A][b][Mi][1]; }
            else { float f[8]; unpack8(*(const u32x4*)(sp + (size_t)src * 16384 + b * 8192), f); s0 += (f32x4){f[0], f[1], f[2], f[3]}; s1 += (f32x4){f[4], f[5], f[6], f[7]}; }
        }
        acc[A][b][Mi][0] = s0; acc[A][b][Mi][1] = s1;
    }
}
template <class Epi, bool FFNMAP, bool ALIGN_EPI, bool SP2>
__device__ __forceinline__ void gemm_phase(LAS unsigned char* lds, const Gemm g, const StaticOrder& S, const Epi& E, float* slabs, unsigned* tickets, bool dry = false) {
    int tid = threadIdx.x; asm volatile("" : "+v"(tid));
    const int wid = __builtin_amdgcn_readfirstlane(tid >> 6), lane = tid & 63, wr = wid >> 2, wc = wid & 3, fr = lane & 15, fq = lane >> 4;
    const int K = g.K;
    unsigned voffA[2], voffB[2];
#pragma unroll
    for (int i = 0; i < 2; ++i) { int R, C; stage_rc(tid * 16 + i * 8192, R, C); const int Ra = FFNMAP ? (126 * (R >> 6) + 4 * (R & 15) + ((R >> 4) & 3)) : R;
        voffA[i] = (unsigned)(Ra * K + C) * 2u; voffB[i] = (unsigned)(R * K + C) * 2u; }
    const size_t kstep = (size_t)(BK * 2);
    const size_t hstepA = g.a_hstep, tstepA = g.a_tstep;
    const size_t hstepB = (size_t)HALF * K * 2, tstepB = 2 * hstepB;
    const unsigned ldsw = (unsigned)wid * 1024u;
    const int aoff = lds_byte(wr * 64 + fr, fq * 8), boff = lds_byte(wc * 32 + fr, fq * 8);
#define PG8_SA(b, h) (((b) * 2 + (h)) * HTB)
#define PG8_SB(b, h) ((4 + (b) * 2 + (h)) * HTB)
#define PG8_STAGE(bufoff, gbase, voff) do { _Pragma("unroll") for (int _i = 0; _i < 2; ++_i) \
        __builtin_amdgcn_global_load_lds((const unsigned*)((const char*)(gbase) + (voff)[_i]), (LAS unsigned*)(lds + (bufoff) + ldsw + _i * 8192), 16, 0, 0); } while (0)
#define PG8_LDA(dst, b, h) do { _Pragma("unroll") for (int m = 0; m < 4; ++m) _Pragma("unroll") for (int k = 0; k < 2; ++k) dst[m][k] = *(const LAS bf16x8*)(lds + PG8_SA(b, h) + aoff + m * 2048 + k * 1024); } while (0)
#define PG8_LDB(dst, b, h) do { _Pragma("unroll") for (int n = 0; n < 2; ++n) _Pragma("unroll") for (int k = 0; k < 2; ++k) dst[n][k] = *(const LAS bf16x8*)(lds + PG8_SB(b, h) + boff + n * 2048 + k * 1024); } while (0)
#define PG8_MMA(ai, bj, At, Bt) do { __builtin_amdgcn_s_setprio(1); _Pragma("unroll") for (int m = 0; m < 4; ++m) _Pragma("unroll") for (int n = 0; n < 2; ++n) _Pragma("unroll") for (int k = 0; k < 2; ++k) \
        acc[ai][bj][m][n] = __builtin_amdgcn_mfma_f32_16x16x32_bf16(Bt[n][k], At[m][k], acc[ai][bj][m][n], 0, 0, 0); __builtin_amdgcn_s_setprio(0); } while (0)
#define PG8_WAIT_V(n) asm volatile("s_waitcnt vmcnt(" #n ")" ::: "memory")
#define PG8_WAIT_L(n) asm volatile("s_waitcnt lgkmcnt(" #n ")" ::: "memory")
#define PG8_BAR __builtin_amdgcn_s_barrier()
#define PG8_SCHED __builtin_amdgcn_sched_barrier(0)
    Unit cur, nxt; int ui = 0;
    if (!S.next(0, cur)) return;
    f32x4 acc[2][2][4][2];
#pragma unroll
    for (int a = 0; a < 2; ++a)
#pragma unroll
        for (int b = 0; b < 2; ++b)
#pragma unroll
            for (int m = 0; m < 4; ++m)
#pragma unroll
                for (int n = 0; n < 2; ++n) acc[a][b][m][n] = (f32x4){0.f, 0.f, 0.f, 0.f};
    bf16x8 At[4][2], B0[2][2], B1[2][2];
    const char* cA = (const char*)g.A + (size_t)cur.pm * tstepA + (size_t)cur.kb * kstep; const char* cB = (const char*)g.Bt + (size_t)cur.pn * tstepB + (size_t)cur.kb * kstep;
    if constexpr (SP2) {
        PG8_STAGE(PG8_SB(0, 0), cB, voffB); PG8_STAGE(PG8_SB(0, 1), cB + hstepB, voffB); PG8_STAGE(PG8_SA(0, 0), cA, voffA); PG8_STAGE(PG8_SA(0, 1), cA + hstepA, voffA);
        if (wr == 1) PG8_BAR;
        PG8_WAIT_V(2); PG8_BAR;
        PG8_STAGE(PG8_SB(1, 0), cB + kstep, voffB); PG8_STAGE(PG8_SA(1, 0), cA + kstep, voffA); PG8_STAGE(PG8_SB(1, 1), cB + hstepB + kstep, voffB);
        PG8_WAIT_V(6); PG8_BAR;
    } else {
        PG8_STAGE(PG8_SB(0, 0), cB, voffB); PG8_STAGE(PG8_SA(0, 0), cA, voffA); PG8_STAGE(PG8_SB(0, 1), cB + hstepB, voffB); PG8_STAGE(PG8_SA(0, 1), cA + hstepA, voffA);
        if (wr == 1) PG8_BAR;
        PG8_WAIT_V(4); PG8_BAR;
        PG8_STAGE(PG8_SB(1, 0), cB + kstep, voffB); PG8_STAGE(PG8_SA(1, 0), cA + kstep, voffA); PG8_STAGE(PG8_SB(1, 1), cB + hstepB + kstep, voffB);
        PG8_WAIT_V(6); PG8_BAR;
    }
    for (;;) {
        const bool has_next = S.next(ui + 1, nxt);
        const char* nA = has_next ? (const char*)g.A + (size_t)nxt.pm * tstepA + (size_t)nxt.kb * kstep : cA; const char* nB = has_next ? (const char*)g.Bt + (size_t)nxt.pn * tstepB + (size_t)nxt.kb * kstep : cB;
        const int nt = cur.nk;
        for (int t = 0; t < nt; t += 2) {
            const bool last = (t == nt - 2);
            const char* a1 = cA + (size_t)(t + 1) * kstep;
            const char* a2 = last ? nA : cA + (size_t)(t + 2) * kstep; const char* b2 = last ? nB : cB + (size_t)(t + 2) * kstep;
            const char* a3 = a2 + kstep; const char* b3 = b2 + kstep;
            if constexpr (SP2) {
            PG8_LDB(B0, 0, 0); PG8_LDB(B1, 0, 1); PG8_SCHED; PG8_LDA(At, 0, 0); PG8_STAGE(PG8_SA(1, 1), a1 + hstepA, voffA);
            PG8_WAIT_V(8); PG8_WAIT_L(0); PG8_BAR; PG8_MMA(0, 0, At, B0); PG8_MMA(0, 1, At, B1); PG8_BAR; PG8_SCHED;
            PG8_LDA(At, 0, 1); PG8_STAGE(PG8_SB(0, 0), b2, voffB); PG8_STAGE(PG8_SB(0, 1), b2 + hstepB, voffB); PG8_STAGE(PG8_SA(0, 0), a2, voffA);
            PG8_WAIT_V(8); PG8_WAIT_L(0); PG8_BAR; PG8_MMA(1, 0, At, B0); PG8_MMA(1, 1, At, B1); PG8_BAR; PG8_SCHED;
            PG8_LDB(B0, 1, 0); PG8_LDB(B1, 1, 1); PG8_SCHED; PG8_LDA(At, 1, 0); PG8_STAGE(PG8_SA(0, 1), a2 + hstepA, voffA);
            PG8_WAIT_V(8); PG8_WAIT_L(0); PG8_BAR; PG8_MMA(0, 0, At, B0); PG8_MMA(0, 1, At, B1); PG8_BAR; PG8_SCHED;
            PG8_LDA(At, 1, 1); PG8_STAGE(PG8_SB(1, 0), b3, voffB); PG8_STAGE(PG8_SB(1, 1), b3 + hstepB, voffB); PG8_STAGE(PG8_SA(1, 0), a3, voffA);
            PG8_WAIT_V(8); PG8_WAIT_L(0); PG8_BAR; PG8_MMA(1, 0, At, B0); PG8_MMA(1, 1, At, B1); PG8_BAR; PG8_SCHED;
            } else {
            PG8_LDB(B0, 0, 0); PG8_SCHED; PG8_LDA(At, 0, 0); PG8_STAGE(PG8_SA(1, 1), a1 + hstepA, voffA);
            PG8_WAIT_L(8); PG8_BAR; PG8_WAIT_L(0); PG8_MMA(0, 0, At, B0); PG8_BAR; PG8_SCHED;
            PG8_LDB(B1, 0, 1); PG8_STAGE(PG8_SB(0, 0), b2, voffB);
            PG8_BAR; PG8_WAIT_L(0); PG8_MMA(0, 1, At, B1); PG8_BAR;
            PG8_LDA(At, 0, 1); PG8_STAGE(PG8_SA(0, 0), a2, voffA);
            PG8_BAR; PG8_WAIT_L(0); PG8_MMA(1, 0, At, B0); PG8_BAR; PG8_SCHED;
            PG8_STAGE(PG8_SB(0, 1), b2 + hstepB, voffB);
            PG8_WAIT_V(6); PG8_BAR; PG8_MMA(1, 1, At, B1); PG8_BAR;
            PG8_LDB(B0, 1, 0); PG8_SCHED; PG8_LDA(At, 1, 0); PG8_STAGE(PG8_SA(0, 1), a2 + hstepA, voffA);
            PG8_WAIT_L(8); PG8_BAR; PG8_WAIT_L(0); PG8_MMA(0, 0, At, B0); PG8_BAR; PG8_SCHED;
            PG8_LDB(B1, 1, 1); PG8_STAGE(PG8_SB(1, 0), b3, voffB);
            PG8_BAR; PG8_WAIT_L(0); PG8_MMA(0, 1, At, B1); PG8_BAR;
            PG8_LDA(At, 1, 1); PG8_STAGE(PG8_SA(1, 0), a3, voffA);
            PG8_BAR; PG8_WAIT_L(0); PG8_MMA(1, 0, At, B0); PG8_BAR; PG8_SCHED;
            PG8_STAGE(PG8_SB(1, 1), b3 + hstepB, voffB);
            PG8_WAIT_V(6); PG8_BAR; PG8_MMA(1, 1, At, B1); PG8_BAR;
            }
        }
        if constexpr (ALIGN_EPI) { if (wr == 0) PG8_BAR; }
        if (cur.piece < 0 && !dry) E(acc, cur, wr, wc, fr, fq);
        if (!has_next) break;
#pragma unroll
        for (int a = 0; a < 2; ++a)
#pragma unroll
            for (int b = 0; b < 2; ++b)
#pragma unroll
                for (int m = 0; m < 4; ++m)
#pragma unroll
                    for (int n = 0; n < 2; ++n) acc[a][b][m][n] = (f32x4){0.f, 0.f, 0.f, 0.f};
        cur = nxt; cA = nA; cB = nB; ++ui;
        if constexpr (ALIGN_EPI) { if (wr == 1) PG8_BAR; }
    }
    PG8_WAIT_V(0);
    if constexpr (!ALIGN_EPI) { if (wr == 0) PG8_BAR; }
    PG8_BAR;
    if constexpr (Epi::SPLIT) {
    if (cur.piece >= 0 && !dry) {
        unsigned char* slab0 = (unsigned char*)slabs + (size_t)cur.lu * (8 * 4 * 16384);
        {
            const __amdgpu_buffer_rsrc_t rs = __builtin_amdgcn_make_buffer_rsrc((void*)slab0, (short)0, 8 * 4 * 16384, 0x00020000);
#pragma unroll
            for (int a = 0; a < 2; ++a)
#pragma unroll
                for (int m = 0; m < 4; ++m) {
                    const int gq = a * 4 + m;
                    if ((gq >> 1) != cur.piece) {
#pragma unroll
                        for (int b = 0; b < 2; ++b) { const f32x4 v0 = acc[a][b][m][0], v1 = acc[a][b][m][1];
                            u32x4 w; w.x = cvt_pk_bf16(v0[0], v0[1]); w.y = cvt_pk_bf16(v0[2], v0[3]); w.z = cvt_pk_bf16(v1[0], v1[1]); w.w = cvt_pk_bf16(v1[2], v1[3]);
                            __builtin_amdgcn_raw_buffer_store_b128(w, rs, (gq * 4 + cur.piece) * 16384 + b * 8192 + tid * 16, 0, 16); }
                    }
                }
        }
        asm volatile("s_waitcnt vmcnt(0)" ::: "memory");
        __syncthreads();
        if (tid == 0) {
            __hip_atomic_fetch_add(tickets + 64 * cur.lu, 1u, __ATOMIC_RELAXED, __HIP_MEMORY_SCOPE_AGENT);
            unsigned sp = 0;
            while (__hip_atomic_load(tickets + 64 * cur.lu, __ATOMIC_RELAXED, __HIP_MEMORY_SCOPE_AGENT) < 4u) { __builtin_amdgcn_s_sleep(2); if (++sp > (1u << 20)) break; }
            __builtin_amdgcn_fence(__ATOMIC_ACQUIRE, "agent"); asm volatile("s_waitcnt vmcnt(0)" ::: "memory");
        }
        __syncthreads();
        switch (cur.piece) {
            case 0: reduce_rowgroup<0, 0, 0>(acc, slab0, tid); reduce_rowgroup<0, 0, 1>(acc, slab0, tid); break;
            case 1: reduce_rowgroup<1, 0, 2>(acc, slab0, tid); reduce_rowgroup<1, 0, 3>(acc, slab0, tid); break;
            case 2: reduce_rowgroup<2, 1, 0>(acc, slab0, tid); reduce_rowgroup<2, 1, 1>(acc, slab0, tid); break;
            default: reduce_rowgroup<3, 1, 2>(acc, slab0, tid); reduce_rowgroup<3, 1, 3>(acc, slab0, tid); break;
        }
        E(acc, cur, wr, wc, fr, fq, 3u << (2 * cur.piece));
    }
    }
#undef PG8_SA
#undef PG8_SB
#undef PG8_STAGE
#undef PG8_LDA
#undef PG8_LDB
#undef PG8_MMA
#undef PG8_WAIT_V
#undef PG8_WAIT_L
#undef PG8_BAR
#undef PG8_SCHED
}
}

typedef f32x4 Acc[2][2][4][2];

struct EpiZ {
    static constexpr bool SPLIT = false;
    const LAS float* rstab; bf16_t* z; float* out;
    __device__ __forceinline__ void operator()(const Acc& acc, const pg8::Unit& u, int wr, int wc, int fr, int fq) const {
        asm volatile("" : "+v"(fr), "+v"(fq));
        const int col0 = u.pn * 256 + wc * 32 + 8 * fq;
#pragma unroll
        for (int ai = 0; ai < 2; ++ai)
#pragma unroll
            for (int m = 0; m < 4; ++m) {
                const int r = u.pm * 256 + ai * 128 + wr * 64 + m * 16 + fr;
                if (r < M) {
                    const float rs = rstab[u.idx * 256 + ai * 128 + wr * 64 + m * 16 + fr];
                    int is_s, seq, t; row_decode(r, is_s, seq, t);
                    float* so = nullptr;
                    if (u.pn < 6) { if (is_s) { if (t >= TS - 3) so = out + O_SRC + ((size_t)seq * 3 + (t - (TS - 3))) * DA; } else { if (t >= TP - 3) so = out + O_PRC + ((size_t)seq * 3 + (t - (TP - 3))) * DA; } }
#pragma unroll
                    for (int bj = 0; bj < 2; ++bj) {
                        const f32x4 v0 = acc[ai][bj][m][0] * rs, v1 = acc[ai][bj][m][1] * rs;
                        u32x4 w; w.x = cvt_pk_bf16(v0[0], v0[1]); w.y = cvt_pk_bf16(v0[2], v0[3]); w.z = cvt_pk_bf16(v1[0], v1[1]); w.w = cvt_pk_bf16(v1[2], v1[3]);
                        *(u32x4*)(z + (size_t)r * DIN + col0 + bj * 128) = w;
                        if (so) { *(f32x4*)(so + col0 + bj * 128) = v0; *(f32x4*)(so + col0 + bj * 128 + 4) = v1; }
                    }
                }
            }
    }
};
__device__ __forceinline__ void rstd1_table(const float* rstd1, LAS float* tab, const pg8::StaticOrder& S) {
    const int tid = opaque_tid(), q = tid & 255;
    pg8::Unit u;
    for (int i = tid >> 8; S.next(i, u); i += 2) { const int r = u.pm * 256 + q; tab[i * 256 + q] = r < M ? rstd1[r] : 0.f; }
}
struct EpiX1 {
    static constexpr bool SPLIT = true;
    bf16_t* xb; float* ssq;
    __device__ __forceinline__ void operator()(const Acc& acc, const pg8::Unit& u, int wr, int wc, int fr, int fq, unsigned gmask = 0xffu) const {
        asm volatile("" : "+v"(fr), "+v"(fq));
        const int col0 = u.pn * 256 + wc * 32 + 8 * fq;
#pragma unroll
        for (int ai = 0; ai < 2; ++ai) {
            if (!((gmask >> (ai * 4)) & 0xfu)) continue;
            u32x4 xv[4][2];
#pragma unroll
            for (int m = 0; m < 4; ++m) {
                const int r = u.pm * 256 + ai * 128 + wr * 64 + m * 16 + fr;
                const bf16_t* xr = xb + (size_t)(r < M ? r : 0) * D + col0;
#pragma unroll
                for (int bj = 0; bj < 2; ++bj) xv[m][bj] = *(const u32x4*)(xr + bj * 128);
            }
#pragma unroll
            for (int m = 0; m < 4; ++m) {
                if (!((gmask >> (ai * 4 + m)) & 1u)) continue;
                const int r = u.pm * 256 + ai * 128 + wr * 64 + m * 16 + fr;
                const bool valid = r < M;
                float ss = 0.f;
#pragma unroll
                for (int bj = 0; bj < 2; ++bj) {
                    float xf[8]; unpack8(xv[m][bj], xf);
                    const f32x4 a0 = acc[ai][bj][m][0], a1 = acc[ai][bj][m][1];
                    const f32x4 v0 = (f32x4){a0[0] + xf[0], a0[1] + xf[1], a0[2] + xf[2], a0[3] + xf[3]}, v1 = (f32x4){a1[0] + xf[4], a1[1] + xf[5], a1[2] + xf[6], a1[3] + xf[7]};
                    ss += (v0[0] * v0[0] + v0[1] * v0[1]) + (v0[2] * v0[2] + v0[3] * v0[3]) + (v1[0] * v1[0] + v1[1] * v1[1]) + (v1[2] * v1[2] + v1[3] * v1[3]);
                    if (valid) { u32x4 w; w.x = cvt_pk_bf16(v0[0], v0[1]); w.y = cvt_pk_bf16(v0[2], v0[3]); w.z = cvt_pk_bf16(v1[0], v1[1]); w.w = cvt_pk_bf16(v1[2], v1[3]);
                        *(u32x4*)(xb + (size_t)r * D + col0 + bj * 128) = w; }
                }
                ss += __shfl_xor(ss, 16); ss += __shfl_xor(ss, 32);
                if (valid && fq == 0) ssq[(size_t)r * 32 + u.pn * 4 + wc] = ss;
            }
        }
    }
};
struct EpiOut {
    static constexpr bool SPLIT = true;
    const bf16_t* x1b; bf16_t* x2b;
    __device__ __forceinline__ void operator()(const Acc& acc, const pg8::Unit& u, int wr, int wc, int fr, int fq, unsigned gmask = 0xffu) const {
        asm volatile("" : "+v"(fr), "+v"(fq));
        const int col0 = u.pn * 256 + wc * 32 + 8 * fq;
#pragma unroll
        for (int ai = 0; ai < 2; ++ai) {
            if (!((gmask >> (ai * 4)) & 0xfu)) continue;
            u32x4 xv[4][2];
#pragma unroll
            for (int m = 0; m < 4; ++m) {
                const int r = u.pm * 256 + ai * 128 + wr * 64 + m * 16 + fr;
                const bf16_t* xr = x1b + (size_t)(r < M ? r : 0) * D + col0;
#pragma unroll
                for (int bj = 0; bj < 2; ++bj) xv[m][bj] = *(const u32x4*)(xr + bj * 128);
            }
#pragma unroll
            for (int m = 0; m < 4; ++m) {
                if (!((gmask >> (ai * 4 + m)) & 1u)) continue;
                const int r = u.pm * 256 + ai * 128 + wr * 64 + m * 16 + fr;
                if (r < M) {
#pragma unroll
                    for (int bj = 0; bj < 2; ++bj) {
                        float xf[8]; unpack8(xv[m][bj], xf);
                        const f32x4 a0 = acc[ai][bj][m][0], a1 = acc[ai][bj][m][1];
                        u32x4 w; w.x = cvt_pk_bf16(a0[0] + xf[0], a0[1] + xf[1]); w.y = cvt_pk_bf16(a0[2] + xf[2], a0[3] + xf[3]); w.z = cvt_pk_bf16(a1[0] + xf[4], a1[1] + xf[5]); w.w = cvt_pk_bf16(a1[2] + xf[6], a1[3] + xf[7]);
                        *(u32x4*)(x2b + (size_t)r * D + col0 + bj * 128) = w;
                    }
                }
            }
        }
    }
};
struct EpiFFN {
    static constexpr bool SPLIT = false;
    const float* st_fc; bf16_t* hid; float* out; const LAS float* rstab; const LAS float* wtab;
    template <bool PLAIN>
    __device__ __forceinline__ void body(Acc& acc, const pg8::Unit& u, int wr, int wc, int fr, int fq, int gbase, int f0,
                                         const f32x4 (&wv)[4][2]) const {
#pragma unroll
        for (int ai = 0; ai < 2; ++ai) {
            f32x4 s3[2], s2[2];
#pragma unroll
            for (int n = 0; n < 2; ++n)
#pragma unroll
                for (int e = 0; e < 4; ++e) {
                    const float o3 = ai == 0 ? 0.f : dppf<0x121>(0.f, acc[0][0][3][n][e]), o2 = ai == 0 ? 0.f : dppf<0x121>(0.f, acc[0][0][2][n][e]);
                    s3[n][e] = dppf<0x111>(o3, acc[ai][0][3][n][e]); s2[n][e] = dppf<0x111>(o2, acc[ai][0][2][n][e]);
                }
#pragma unroll
            for (int m = 0; m < 4; ++m) {
                const int j = 64 * ai + 4 * fr + m, r = gbase + j;
                const f32x4 c0 = acc[ai][0][m][0], c1 = acc[ai][0][m][1];
                f32x4 p1a = m == 0 ? s3[0] : acc[ai][0][m == 0 ? 0 : m - 1][0], p1b = m == 0 ? s3[1] : acc[ai][0][m == 0 ? 0 : m - 1][1];
                f32x4 p2a = m == 0 ? s2[0] : (m == 1 ? s3[0] : acc[ai][0][m < 2 ? 0 : m - 2][0]), p2b = m == 0 ? s2[1] : (m == 1 ? s3[1] : acc[ai][0][m < 2 ? 0 : m - 2][1]);
                bool valid = j >= 2;
                int is_s = 0, seq = 0, t = 2;
                if constexpr (!PLAIN) {
                    valid = valid && (r < M);
                    row_decode(valid ? r : 0, is_s, seq, t);
                    if (valid && t < 2) {
                        f32x4 s0a = (f32x4){0.f, 0.f, 0.f, 0.f}, s0b = s0a, s1a = s0a, s1b = s0a;
                        if (is_s) { const float* sp = st_fc + (size_t)seq * 2 * DFF + f0; s0a = *(const f32x4*)sp; s0b = *(const f32x4*)(sp + 4); s1a = *(const f32x4*)(sp + DFF); s1b = *(const f32x4*)(sp + DFF + 4); }
                        if (t == 0) { p1a = s1a; p1b = s1b; p2a = s0a; p2b = s0b; } else { p2a = s1a; p2b = s1b; }
                    }
                }
                const f32x4 ga = wv[0][0] * p2a + wv[1][0] * p1a + wv[2][0] * c0 + wv[3][0], gb = wv[0][1] * p2b + wv[1][1] * p1b + wv[2][1] * c1 + wv[3][1];
                const f32x4 va = acc[ai][1][m][0], vb = acc[ai][1][m][1];
                if (valid) {
                    u32x4 w;
                    const f32x2 h0 = gelu_mul2((f32x2){ga[0], ga[1]}, (f32x2){va[0], va[1]}), h1 = gelu_mul2((f32x2){ga[2], ga[3]}, (f32x2){va[2], va[3]});
                    const f32x2 h2 = gelu_mul2((f32x2){gb[0], gb[1]}, (f32x2){vb[0], vb[1]}), h3 = gelu_mul2((f32x2){gb[2], gb[3]}, (f32x2){vb[2], vb[3]});
                    w.x = cvt_pk_bf16(h0.x, h0.y); w.y = cvt_pk_bf16(h1.x, h1.y); w.z = cvt_pk_bf16(h2.x, h2.y); w.w = cvt_pk_bf16(h3.x, h3.y);
                    *(u32x4*)(hid + (size_t)r * DFF + f0) = w;
                    if constexpr (!PLAIN) {
                        const int T = is_s ? TS : TP;
                        if (t >= T - 2) { float* so = out + (is_s ? O_SFC : O_PFC) + ((size_t)seq * 2 + (t - (T - 2))) * DFF + f0; *(f32x4*)so = c0; *(f32x4*)(so + 4) = c1; }
                    }
                }
            }
            __builtin_amdgcn_sched_barrier(0);
        }
    }
    __device__ __forceinline__ void operator()(Acc& acc, const pg8::Unit& u, int wr, int wc, int fr, int fq) const {
        asm volatile("" : "+v"(fr), "+v"(fq));
        const int gbase = 252 * u.pm - 2 + 126 * wr;
        const int f0 = 128 * u.pn + 32 * wc + 8 * fq;
        const LAS float* wt = wtab + u.idx * 512 + 32 * wc + 8 * fq;
        f32x4 wv[4][2];
#pragma unroll
        for (int k = 0; k < 4; ++k) { wv[k][0] = *(const LAS f32x4*)(wt + 128 * k); wv[k][1] = *(const LAS f32x4*)(wt + 128 * k + 4); }
        const LAS float* rt = rstab + u.idx * 256 + wr * 128 + 4 * fr;
#pragma unroll
        for (int ai = 0; ai < 2; ++ai) {
            const f32x4 rs4 = *(const LAS f32x4*)(rt + 64 * ai);
#pragma unroll
            for (int m = 0; m < 4; ++m)
#pragma unroll
                for (int bj = 0; bj < 2; ++bj)
#pragma unroll
                    for (int n = 0; n < 2; ++n) acc[ai][bj][m][n] *= rs4[m];
        }
        const int lo = gbase, hi = gbase + 127;
        bool plain = hi < MPR && lo >= 0;
#pragma unroll
        for (int b2 = 0; b2 < NB; ++b2) { const int s0 = b2 * TP; if (lo <= s0 + 1 && hi >= s0) plain = false; if (lo <= s0 + TP - 1 && hi >= s0 + TP - 2) plain = false; }
        if (plain) body<true>(acc, u, wr, wc, fr, fq, gbase, f0, wv); else body<false>(acc, u, wr, wc, fr, fq, gbase, f0, wv);
    }
};
__device__ __forceinline__ void ffn_rstd_table(const float* ssq, const float* cw, const float* cb, LAS float* tab, LAS float* wtab, const pg8::StaticOrder& S) {
    const int tid = opaque_tid(), q = tid >> 1, half = tid & 1;
    pg8::Unit u;
    for (int i = 0; S.next(i, u); ++i) {
        { const int k = tid >> 7, c = tid & 127, f = 128 * u.pn + c; wtab[i * 512 + tid] = k < 3 ? cw[k * DFF + f] : cb[f]; }
        int r = 252 * u.pm - 2 + 126 * (q >> 7) + (q & 127); r = r < 0 ? 0 : (r >= M ? M - 1 : r);
        const float* sp = ssq + (size_t)r * 32 + 16 * half;
        const f32x4 a = *(const f32x4*)sp, b = *(const f32x4*)(sp + 4), c = *(const f32x4*)(sp + 8), d = *(const f32x4*)(sp + 12);
        float sm = (((a[0] + a[1]) + (a[2] + a[3])) + ((b[0] + b[1]) + (b[2] + b[3]))) + (((c[0] + c[1]) + (c[2] + c[3])) + ((d[0] + d[1]) + (d[2] + d[3])));
        sm += __shfl_xor(sm, 1);
        if (half == 0) tab[i * 256 + q] = __builtin_amdgcn_rsqf(sm * (1.0f / D) + EPS);
    }
}

__device__ __forceinline__ int invperm32(int q) { return 16 * ((q >> 2) & 1) + 4 * (q >> 3) + (q & 3); }
__device__ __forceinline__ void p0_transpose_item(const float* W, int K, int N, const float* kscale, bf16_t* WT, int mode, LAS float* scr, int item, int lane) {
    const int nblk = N / 32, kb = item / nblk, nb = item % nblk, k0 = 64 * kb, n0 = 32 * nb;
    float v[32];
    const float* src = W + (size_t)(k0 + (lane >> 5)) * N + n0 + (lane & 31);
#pragma unroll
    for (int i = 0; i < 32; ++i) v[i] = src[(size_t)(2 * i) * N];
#pragma unroll
    for (int i = 0; i < 32; ++i) scr[(2 * i + (lane >> 5)) * 33 + (lane & 31)] = v[i];
    asm volatile("s_waitcnt lgkmcnt(0)" ::: "memory");
    int rbase = n0;
    if (mode == 1) { const int bj = n0 >= DFF ? 1 : 0, f = n0 - bj * DFF; rbase = 256 * (f >> 7) + 128 * bj + (f & 96); }
    const int c = lane & 7;
    f32x4 ks0 = (f32x4){1.f, 1.f, 1.f, 1.f}, ks1 = ks0;
    if (kscale) { ks0 = *(const f32x4*)(kscale + k0 + 8 * c); ks1 = *(const f32x4*)(kscale + k0 + 8 * c + 4); }
#pragma unroll
    for (int j = 0; j < 4; ++j) { const int n = (lane >> 3) + 8 * j; const LAS float* sp = scr + (8 * c) * 33 + n;
        u32x4 o; o.x = cvt_pk_bf16(sp[0 * 33] * ks0[0], sp[1 * 33] * ks0[1]); o.y = cvt_pk_bf16(sp[2 * 33] * ks0[2], sp[3 * 33] * ks0[3]);
        o.z = cvt_pk_bf16(sp[4 * 33] * ks1[0], sp[5 * 33] * ks1[1]); o.w = cvt_pk_bf16(sp[6 * 33] * ks1[2], sp[7 * 33] * ks1[3]);
        *(u32x4*)(WT + (size_t)(rbase + (mode == 2 ? n : invperm32(n))) * K + k0 + 8 * c) = o; }
    asm volatile("s_waitcnt lgkmcnt(0)" ::: "memory");
}
constexpr int I_IN = (D / 64) * (DIN / 32), I_O = (DMIX / 64) * (D / 32), I_UP = (D / 64) * (2 * DFF / 32), I_DN = (DFF / 64) * (D / 32), I_G = 2 * NH * 8;
constexpr int IT_O = I_IN, IT_UP = IT_O + I_O, IT_DN = IT_UP + I_UP, IT_G = IT_DN + I_DN, IT_END = IT_G + I_G;
__device__ __forceinline__ void convert_items(PRef p, LAS unsigned char* lds, int rank, int nwaves, int lo, int hi) {
    const int tid_ = opaque_tid(), lane = tid_ & 63, wave = tid_ >> 6;
    unsigned char* ws = p.ws;
    LAS float* scr = (LAS float*)(lds + wave * 16384);
    for (int it = lo + rank; it < hi; it += nwaves) {
        int r = it;
        if (r < I_IN) { p0_transpose_item(p.w_in, D, DIN, p.g_mix, (bf16_t*)(ws + WS_WIN), 0, scr, r, lane); continue; } r -= I_IN;
        if (r < I_O) { p0_transpose_item(p.w_o, DMIX, D, nullptr, (bf16_t*)(ws + WS_WO), 0, scr, r, lane); continue; } r -= I_O;
        if (r < I_UP) { p0_transpose_item(p.w_up, D, 2 * DFF, p.g_ffn, (bf16_t*)(ws + WS_WUP), 1, scr, r, lane); continue; } r -= I_UP;
        if (r < I_DN) { p0_transpose_item(p.w_down, DFF, D, nullptr, (bf16_t*)(ws + WS_WDN), 0, scr, r, lane); continue; } r -= I_DN;
        { const int mat = r >> 3, sub = r & 7, gsel = mat / NH, n = mat % NH;
          p0_transpose_item((gsel ? p.w_gate_x : p.w_gate_a) + (size_t)n * 128 * 128, 128, 128, nullptr, (bf16_t*)(ws + WS_WG) + (size_t)mat * 128 * 128, 0, scr, sub, lane); }
    }
}
constexpr int P1_TAIL_WG0 = (888 % 256), P4_TAIL_WG0 = (296 % 256) * P4_SPLIT, MIX_IDLE_WG0 = 228, IT_S1 = IT_O + 10600, IT_S2 = IT_S1 + 1600, IT_S3 = IT_S2 + 1600;
__device__ __forceinline__ void phase0(PRef p, LAS unsigned char* lds, int G) {
    const int tid = opaque_tid(), lane = tid & 63, wave = tid >> 6;
    unsigned char* ws = p.ws;
    const int gw = blockIdx.x * 8 + wave, NGW = G * 8;
    convert_items(p, lds, gw, NGW, 0, IT_O);
    convert_items(p, lds, gw, NGW, IT_G, IT_END);
    { bf16_t* xb = (bf16_t*)(ws + WS_XB) + (size_t)16 * D; float* rstd1 = (float*)(ws + WS_RS1);
      for (int m = gw; m < M; m += NGW) {
          const f32x4* xr = (const f32x4*)x_row_ptr(p.x_prompt, p.x_sample, p.meta, m) + lane;
          f32x4 v[8]; float s = 0.f;
#pragma unroll
          for (int j = 0; j < 8; ++j) { v[j] = xr[64 * j]; s += (v[j][0] * v[j][0] + v[j][1] * v[j][1]) + (v[j][2] * v[j][2] + v[j][3] * v[j][3]); }
          s = wave_sum(s);
          if (lane == 0) rstd1[m] = __builtin_amdgcn_rsqf(s * (1.0f / D) + EPS);
          u32x2* o = (u32x2*)(xb + (size_t)m * D) + lane;
#pragma unroll
          for (int j = 0; j < 8; ++j) { u32x2 w; w.x = cvt_pk_bf16(v[j][0], v[j][1]); w.y = cvt_pk_bf16(v[j][2], v[j][3]); o[64 * j] = w; }
      } }
}

__device__ __forceinline__ void branch_b(PRef p, int G) {
    const bf16_t* z = (const bf16_t*)(p.ws + WS_Z); bf16_t* ym = (bf16_t*)(p.ws + WS_YM);
    const int total = (M / 4) * 128;
    for (int idx = blockIdx.x * 512 + opaque_tid(); idx < total; idx += G * 512) {
        const int m0 = (idx >> 7) * 4, g = idx & 127, ch = 8 * g;
        int is_s, seq, t0; row_decode(m0, is_s, seq, t0);
        u32x4 rc[6], rv[6], rg[4];
#pragma unroll
        for (int k = 0; k < 6; ++k) {
            const int mm = (t0 - 2 + k >= 0) ? m0 - 2 + k : m0;
            rc[k] = *(const u32x4*)(z + (size_t)mm * DIN + 4096 + ch); rv[k] = *(const u32x4*)(z + (size_t)mm * DIN + 5120 + ch);
        }
#pragma unroll
        for (int k = 0; k < 4; ++k) rg[k] = *(const u32x4*)(z + (size_t)(m0 + k) * DIN + 3072 + ch);
        const f32x4 w0a = *(const f32x4*)(p.conv_b_w + ch), w0b = *(const f32x4*)(p.conv_b_w + ch + 4), w1a = *(const f32x4*)(p.conv_b_w + DB + ch), w1b = *(const f32x4*)(p.conv_b_w + DB + ch + 4),
                    w2a = *(const f32x4*)(p.conv_b_w + 2 * DB + ch), w2b = *(const f32x4*)(p.conv_b_w + 2 * DB + ch + 4), goa = *(const f32x4*)(p.g_out_b + ch), gob = *(const f32x4*)(p.g_out_b + ch + 4);
        float u[6][8];
#pragma unroll
        for (int k = 0; k < 6; ++k) {
            float a[8], b[8]; unpack8(rc[k], a); unpack8(rv[k], b);
#pragma unroll
            for (int e = 0; e < 8; ++e) u[k][e] = a[e] * b[e];
        }
        if (t0 == 0) {
#pragma unroll
            for (int k = 0; k < 2; ++k) {
                f32x4 a = (f32x4){0.f, 0.f, 0.f, 0.f}, b = a;
                if (is_s) { const float* sp = p.st_sc + ((size_t)seq * 2 + k) * DB + ch; a = *(const f32x4*)sp; b = *(const f32x4*)(sp + 4); }
#pragma unroll
                for (int e = 0; e < 4; ++e) { u[k][e] = a[e]; u[k][4 + e] = b[e]; }
            }
        }
        const int T = is_s ? TS : TP;
#pragma unroll
        for (int k = 0; k < 4; ++k) {
            float gb[8]; unpack8(rg[k], gb);
            float y[8]; float ss = 0.f;
#pragma unroll
            for (int e = 0; e < 8; ++e) {
                const float uc = (e < 4 ? w0a[e & 3] : w0b[e & 3]) * u[k][e] + (e < 4 ? w1a[e & 3] : w1b[e & 3]) * u[k + 1][e] + (e < 4 ? w2a[e & 3] : w2b[e & 3]) * u[k + 2][e];
                y[e] = gb[e] * uc; ss += y[e] * y[e];
            }
            ss = sum16(ss);
            const float rn = __builtin_amdgcn_rsqf(ss * (1.0f / 128.0f) + EPS);
#pragma unroll
            for (int e = 0; e < 8; ++e) y[e] = y[e] * rn * (e < 4 ? goa[e & 3] : gob[e & 3]);
            *(u32x4*)(ym + (size_t)(m0 + k) * DMIX + DA + ch) = pack8(y);
            const int t = t0 + k;
            if (t >= T - 2) { float* so = p.out + (is_s ? O_SSC : O_PSC) + ((size_t)seq * 2 + (t - (T - 2))) * DB + ch;
                *(f32x4*)so = (f32x4){u[k + 2][0], u[k + 2][1], u[k + 2][2], u[k + 2][3]}; *(f32x4*)(so + 4) = (f32x4){u[k + 2][4], u[k + 2][5], u[k + 2][6], u[k + 2][7]}; }
        }
    }
}

constexpr int LW_STRIDE = 272, L_WA = 0, L_WX = 128 * LW_STRIDE, L_CT = 2 * 128 * LW_STRIDE, L_LRU_END = L_CT + 9 * 128 * 4;
static_assert(L_LRU_END <= 131072, "mixer LDS");
constexpr int LRU_WG_PER_HEAD = 19, LRU_NSEG = 33, LRU_PITEMS = NB * LRU_NSEG, LRU_SITEMS = MSR / 64;
static_assert(LRU_WG_PER_HEAD * 8 >= LRU_PITEMS + LRU_SITEMS, "waves per head");

template <int CTRL, int BANK> __device__ __forceinline__ float dppfb(float old, float src) {
    return __builtin_bit_cast(float, __builtin_amdgcn_update_dpp(__builtin_bit_cast(int, old), __builtin_bit_cast(int, src), CTRL, 0xF, BANK, false));
}
__device__ __forceinline__ float bcast15(float x, int lane) {
    return __builtin_bit_cast(float, __builtin_amdgcn_ds_bpermute(((lane & 48) | 15) << 2, __builtin_bit_cast(int, x)));
}
__device__ __forceinline__ void scan16(float& P, float& S) {
    float Sd, Pd;
    Sd = dppf<0x111>(0.f, S); Pd = dppf<0x111>(1.f, P); S = __builtin_fmaf(P, Sd, S); P *= Pd;
    Sd = dppf<0x112>(0.f, S); Pd = dppf<0x112>(1.f, P); S = __builtin_fmaf(P, Sd, S); P *= Pd;
    Sd = dppf<0x114>(0.f, S); Pd = dppf<0x114>(1.f, P); S = __builtin_fmaf(P, Sd, S); P *= Pd;
    Sd = dppf<0x118>(0.f, S); Pd = dppf<0x118>(1.f, P); S = __builtin_fmaf(P, Sd, S); P *= Pd;
}
__device__ __forceinline__ void scan16x2(float& P1, float& S1, float& P2, float& S2) {
    asm volatile(
        "s_nop 1\n\t"
        "v_fmac_f32_dpp %1, %1, %0 row_shr:1 row_mask:0xf bank_mask:0xf bound_ctrl:1\n\t"
        "v_fmac_f32_dpp %3, %3, %2 row_shr:1 row_mask:0xf bank_mask:0xf bound_ctrl:1\n\t"
        "v_mul_f32_dpp %0, %0, %0 row_shr:1 row_mask:0xf bank_mask:0xf\n\t"
        "v_mul_f32_dpp %2, %2, %2 row_shr:1 row_mask:0xf bank_mask:0xf\n\t"
        "v_fmac_f32_dpp %1, %1, %0 row_shr:2 row_mask:0xf bank_mask:0xf bound_ctrl:1\n\t"
        "v_fmac_f32_dpp %3, %3, %2 row_shr:2 row_mask:0xf bank_mask:0xf bound_ctrl:1\n\t"
        "v_mul_f32_dpp %0, %0, %0 row_shr:2 row_mask:0xf bank_mask:0xf\n\t"
        "v_mul_f32_dpp %2, %2, %2 row_shr:2 row_mask:0xf bank_mask:0xf\n\t"
        "v_fmac_f32_dpp %1, %1, %0 row_shr:4 row_mask:0xf bank_mask:0xf bound_ctrl:1\n\t"
        "v_fmac_f32_dpp %3, %3, %2 row_shr:4 row_mask:0xf bank_mask:0xf bound_ctrl:1\n\t"
        "v_mul_f32_dpp %0, %0, %0 row_shr:4 row_mask:0xf bank_mask:0xf\n\t"
        "v_mul_f32_dpp %2, %2, %2 row_shr:4 row_mask:0xf bank_mask:0xf\n\t"
        "v_fmac_f32_dpp %1, %1, %0 row_shr:8 row_mask:0xf bank_mask:0xf bound_ctrl:1\n\t"
        "v_fmac_f32_dpp %3, %3, %2 row_shr:8 row_mask:0xf bank_mask:0xf bound_ctrl:1\n\t"
        "v_mul_f32_dpp %0, %0, %0 row_shr:8 row_mask:0xf bank_mask:0xf\n\t"
        "v_mul_f32_dpp %2, %2, %2 row_shr:8 row_mask:0xf bank_mask:0xf\n\t"
        "s_nop 0"
        : "+v"(P1), "+v"(S1), "+v"(P2), "+v"(S2));
}
__device__ __forceinline__ void scan8(float& P, float& S, int t) {
    float Sd, Pd;
    Sd = dppf<0x111>(0.f, S); Pd = dppf<0x111>(1.f, P); if (t < 1) { Sd = 0.f; Pd = 1.f; } S = __builtin_fmaf(P, Sd, S); P *= Pd;
    Sd = dppf<0x112>(0.f, S); Pd = dppf<0x112>(1.f, P); if (t < 2) { Sd = 0.f; Pd = 1.f; } S = __builtin_fmaf(P, Sd, S); P *= Pd;
    Sd = dppfb<0x114, 0xA>(0.f, S); Pd = dppfb<0x114, 0xA>(1.f, P); S = __builtin_fmaf(P, Sd, S); P *= Pd;
}

template <int PASS, bool IS_S>
__device__ __forceinline__ void lru_wave_item(PRef p, LAS unsigned char* lds, int n, int b, int seg) {
    const int lane = opaque_tid() & 63, fr = lane & 15, fq = lane >> 4;
    const bf16_t* z = (const bf16_t*)(p.ws + WS_Z);
    bf16_t* ym = (bf16_t*)(p.ws + WS_YM);
    float* tot = (float*)(p.ws + WS_TOT);
    const LAS float* CT = (const LAS float*)(lds + L_CT) + 8 * fq;
    const int gch = n * 128 + 8 * fq;
    const int r0 = IS_S ? MPR + b * 64 : b * TP + seg * 64;
    const int nblk = IS_S ? 4 : (seg == LRU_NSEG - 1 ? 1 : 4);
    float hin[4][8], Pt[4][8];
    u32x4 prevx[4];
#pragma unroll
    for (int ks = 0; ks < 4; ++ks) {
#pragma unroll
        for (int e = 0; e < 8; ++e) { hin[ks][e] = 0.f; Pt[ks][e] = 1.f; }
        prevx[ks] = (u32x4){0u, 0u, 0u, 0u};
    }
    if constexpr (!IS_S) {
        if (seg > 0) {
#pragma unroll
            for (int ks = 0; ks < 4; ++ks) prevx[ks] = *(const u32x4*)(z + (size_t)(r0 - 16 + fr) * DIN + gch + 32 * ks);
            if constexpr (PASS == 2) {
#pragma unroll 1
                for (int round = 0; round < 2; ++round) {
                    const int s = 16 * round + fr;
                    if (16 * round >= seg) break;
                    const bool have = s < seg;
                    const float* tp = tot + ((size_t)(b * LRU_NSEG + (have ? s : 0)) * 2) * DA + gch;
#pragma unroll
                    for (int ks = 0; ks < 4; ++ks) {
                        const f32x4 P0 = *(const f32x4*)(tp + 32 * ks), P1 = *(const f32x4*)(tp + 32 * ks + 4), S0 = *(const f32x4*)(tp + DA + 32 * ks), S1 = *(const f32x4*)(tp + DA + 32 * ks + 4);
#pragma unroll
                        for (int e = 0; e < 8; e += 2) {
                            float Pa = have ? (e < 4 ? P0[e & 3] : P1[e & 3]) : 1.f, Sa = have ? (e < 4 ? S0[e & 3] : S1[e & 3]) : 0.f;
                            float Pb = have ? (e < 4 ? P0[(e + 1) & 3] : P1[(e + 1) & 3]) : 1.f, Sb = have ? (e < 4 ? S0[(e + 1) & 3] : S1[(e + 1) & 3]) : 0.f;
                            scan16x2(Pa, Sa, Pb, Sb);
                            hin[ks][e] = __builtin_fmaf(bcast15(Pa, lane), hin[ks][e], bcast15(Sa, lane));
                            hin[ks][e + 1] = __builtin_fmaf(bcast15(Pb, lane), hin[ks][e + 1], bcast15(Sb, lane));
                        }
                    }
                }
            }
        }
    }
    u32x4 xnext[4];
#pragma unroll
    for (int ks = 0; ks < 4; ++ks) xnext[ks] = *(const u32x4*)(z + (size_t)(r0 + fr) * DIN + gch + 32 * ks);
#pragma unroll 1
    for (int blk = 0; blk < nblk; ++blk) {
        const int r = r0 + 16 * blk + fr;
        const int t8 = fr & 7, sq = (r - MPR) >> 3;
        u32x4 x4[4], g4[4];
#pragma unroll
        for (int ks = 0; ks < 4; ++ks) { x4[ks] = xnext[ks]; if constexpr (PASS == 2) g4[ks] = *(const u32x4*)(z + (size_t)r * DIN + DA + gch + 32 * ks); }
        { const int rn_ = (blk + 1 < nblk) ? r + 16 : r;
#pragma unroll
          for (int ks = 0; ks < 4; ++ks) xnext[ks] = *(const u32x4*)(z + (size_t)rn_ * DIN + gch + 32 * ks); }
        float xc[4][8];
        bf16x8 bfrag[4];
#pragma unroll
        for (int ks = 0; ks < 4; ++ks) {
            float xf[8]; unpack8(x4[ks], xf);
            const f32x4 w0a = *(const LAS f32x4*)(CT + 0 * 128 + 32 * ks), w0b = *(const LAS f32x4*)(CT + 0 * 128 + 32 * ks + 4);
            const f32x4 w1a = *(const LAS f32x4*)(CT + 1 * 128 + 32 * ks), w1b = *(const LAS f32x4*)(CT + 1 * 128 + 32 * ks + 4);
            const f32x4 w2a = *(const LAS f32x4*)(CT + 2 * 128 + 32 * ks), w2b = *(const LAS f32x4*)(CT + 2 * 128 + 32 * ks + 4);
            const f32x4 w3a = *(const LAS f32x4*)(CT + 3 * 128 + 32 * ks), w3b = *(const LAS f32x4*)(CT + 3 * 128 + 32 * ks + 4);
            const f32x4 cba = *(const LAS f32x4*)(CT + 4 * 128 + 32 * ks), cbb = *(const LAS f32x4*)(CT + 4 * 128 + 32 * ks + 4);
            if constexpr (IS_S) {
                const float* sp = p.st_rc + (size_t)sq * 3 * DA + gch + 32 * ks;
                const f32x4 b0a = *(const f32x4*)sp, b0b = *(const f32x4*)(sp + 4), b1a = *(const f32x4*)(sp + DA), b1b = *(const f32x4*)(sp + DA + 4), b2a = *(const f32x4*)(sp + 2 * DA), b2b = *(const f32x4*)(sp + 2 * DA + 4);
#pragma unroll
                for (int e = 0; e < 8; ++e) {
                    const float bb0 = e < 4 ? b0a[e & 3] : b0b[e & 3], bb1 = e < 4 ? b1a[e & 3] : b1b[e & 3], bb2 = e < 4 ? b2a[e & 3] : b2b[e & 3];
                    const float s1 = dppf<0x111>(0.f, xf[e]), s2 = dppf<0x112>(0.f, xf[e]), s3 = dppf<0x113>(0.f, xf[e]);
                    const float x1 = t8 >= 1 ? s1 : bb2;
                    const float x2 = t8 >= 2 ? s2 : (t8 == 1 ? bb2 : bb1);
                    const float x3 = t8 >= 3 ? s3 : (t8 == 2 ? bb2 : (t8 == 1 ? bb1 : bb0));
                    const float w0 = e < 4 ? w0a[e & 3] : w0b[e & 3], w1 = e < 4 ? w1a[e & 3] : w1b[e & 3], w2 = e < 4 ? w2a[e & 3] : w2b[e & 3], w3 = e < 4 ? w3a[e & 3] : w3b[e & 3];
                    xc[ks][e] = (e < 4 ? cba[e & 3] : cbb[e & 3]) + w3 * xf[e] + w2 * x1 + w1 * x2 + w0 * x3;
                }
            } else {
                float pf[8]; unpack8(prevx[ks], pf);
#pragma unroll
                for (int e = 0; e < 8; e += 2) {
                    f32x2 x0, x1, x2, x3;
#pragma unroll
                    for (int q = 0; q < 2; ++q) {
                        x0[q] = xf[e + q];
                        x1[q] = dppf<0x111>(dppf<0x121>(0.f, pf[e + q]), xf[e + q]);
                        x2[q] = dppf<0x112>(dppf<0x122>(0.f, pf[e + q]), xf[e + q]);
                        x3[q] = dppf<0x113>(dppf<0x123>(0.f, pf[e + q]), xf[e + q]);
                    }
                    const int c = e & 3;
                    const f32x2 w0 = e < 4 ? (f32x2){w0a[c], w0a[c + 1]} : (f32x2){w0b[c], w0b[c + 1]}, w1 = e < 4 ? (f32x2){w1a[c], w1a[c + 1]} : (f32x2){w1b[c], w1b[c + 1]};
                    const f32x2 w2 = e < 4 ? (f32x2){w2a[c], w2a[c + 1]} : (f32x2){w2b[c], w2b[c + 1]}, w3 = e < 4 ? (f32x2){w3a[c], w3a[c + 1]} : (f32x2){w3b[c], w3b[c + 1]};
                    const f32x2 cbv = e < 4 ? (f32x2){cba[c], cba[c + 1]} : (f32x2){cbb[c], cbb[c + 1]};
                    const f32x2 r = cbv + w3 * x0 + w2 * x1 + w1 * x2 + w0 * x3;
                    xc[ks][e] = r.x; xc[ks][e + 1] = r.y;
                }
                prevx[ks] = x4[ks];
            }
            bfrag[ks] = __builtin_bit_cast(bf16x8, pack8(xc[ks]));
        }
        f32x4 aa[8], ax[8];
#pragma unroll
        for (int nb = 0; nb < 8; ++nb) { aa[nb] = (f32x4){0.f, 0.f, 0.f, 0.f}; ax[nb] = (f32x4){0.f, 0.f, 0.f, 0.f}; }
#pragma unroll
        for (int ks = 0; ks < 4; ++ks)
#pragma unroll
            for (int nb = 0; nb < 8; ++nb) {
                const bf16x8 wa = *(const LAS bf16x8*)(lds + L_WA + (16 * nb + fr) * LW_STRIDE + (32 * ks + 8 * fq) * 2);
                const bf16x8 wx = *(const LAS bf16x8*)(lds + L_WX + (16 * nb + fr) * LW_STRIDE + (32 * ks + 8 * fq) * 2);
                aa[nb] = __builtin_amdgcn_mfma_f32_16x16x32_bf16(wa, bfrag[ks], aa[nb], 0, 0, 0);
                ax[nb] = __builtin_amdgcn_mfma_f32_16x16x32_bf16(wx, bfrag[ks], ax[nb], 0, 0, 0);
            }
        float y[4][8]; float ss = 0.f;
#pragma unroll
        for (int ks = 0; ks < 4; ++ks) {
            const f32x4 bga0 = *(const LAS f32x4*)(CT + 5 * 128 + 32 * ks), bga1 = *(const LAS f32x4*)(CT + 5 * 128 + 32 * ks + 4);
            const f32x4 bgx0 = *(const LAS f32x4*)(CT + 6 * 128 + 32 * ks), bgx1 = *(const LAS f32x4*)(CT + 6 * 128 + 32 * ks + 4);
            const f32x4 sp0 = *(const LAS f32x4*)(CT + 7 * 128 + 32 * ks), sp1 = *(const LAS f32x4*)(CT + 7 * 128 + 32 * ks + 4);
            float gav[8];
            if constexpr (PASS == 2) unpack8(g4[ks], gav);
            f32x4 h0a, h0b;
            if constexpr (IS_S) { const float* hp = p.st_h + (size_t)sq * DA + gch + 32 * ks; h0a = *(const f32x4*)hp; h0b = *(const f32x4*)(hp + 4); }
            float hv[8], Pv[8], Sv[8];
#pragma unroll
            for (int e = 0; e < 8; e += 2) {
                const int nb = 2 * ks + (e >> 2), rg = e & 3;
                const f32x2 ba = e < 4 ? (f32x2){bga0[rg], bga0[rg + 1]} : (f32x2){bga1[rg], bga1[rg + 1]}, bx = e < 4 ? (f32x2){bgx0[rg], bgx0[rg + 1]} : (f32x2){bgx1[rg], bgx1[rg + 1]};
                const f32x2 spv = e < 4 ? (f32x2){sp0[rg], sp0[rg + 1]} : (f32x2){sp1[rg], sp1[rg + 1]};
                const f32x2 ta = (f32x2){aa[nb][rg], aa[nb][rg + 1]} * -1.4426950408889634f + ba, tx = (f32x2){ax[nb][rg], ax[nb][rg + 1]} * -1.4426950408889634f + bx;
                f32x2 ea, ex; ea.x = __builtin_amdgcn_exp2f(ta.x); ea.y = __builtin_amdgcn_exp2f(ta.y); ex.x = __builtin_amdgcn_exp2f(tx.x); ex.y = __builtin_amdgcn_exp2f(tx.y);
                ea = ea + 1.0f; ex = ex + 1.0f;
                f32x2 rr, ii; rr.x = __builtin_amdgcn_rcpf(ea.x); rr.y = __builtin_amdgcn_rcpf(ea.y); ii.x = __builtin_amdgcn_rcpf(ex.x); ii.y = __builtin_amdgcn_rcpf(ex.y);
                const f32x2 la = rr * spv;
                f32x2 a; a.x = __builtin_amdgcn_exp2f(la.x); a.y = __builtin_amdgcn_exp2f(la.y);
                const f32x2 om = 1.0f - a * a;
                f32x2 sq; sq.x = __builtin_amdgcn_sqrtf(om.x > 0.f ? om.x : 0.f); sq.y = __builtin_amdgcn_sqrtf(om.y > 0.f ? om.y : 0.f);
                const f32x2 uu = sq * (ii * (f32x2){xc[ks][e], xc[ks][e + 1]});
                Pv[e] = a.x; Pv[e + 1] = a.y; Sv[e] = uu.x; Sv[e + 1] = uu.y;
            }
            if constexpr (IS_S) {
#pragma unroll
                for (int e = 0; e < 8; ++e) { scan8(Pv[e], Sv[e], t8); hv[e] = __builtin_fmaf(Pv[e], e < 4 ? h0a[e & 3] : h0b[e & 3], Sv[e]); }
            } else {
#pragma unroll
                for (int e = 0; e < 8; e += 2) scan16x2(Pv[e], Sv[e], Pv[e + 1], Sv[e + 1]);
#pragma unroll
                for (int e = 0; e < 8; ++e) {
                    hv[e] = __builtin_fmaf(Pv[e], hin[ks][e], Sv[e]);
                    hin[ks][e] = bcast15(hv[e], lane);
                    if constexpr (PASS == 1) Pt[ks][e] *= bcast15(Pv[e], lane);
                }
            }
            if constexpr (PASS == 2) {
#pragma unroll
                for (int e = 0; e < 8; e += 2) { const f32x2 yy = gelu_mul2((f32x2){gav[e], gav[e + 1]}, (f32x2){hv[e], hv[e + 1]}); y[ks][e] = yy.x; y[ks][e + 1] = yy.y; ss += yy.x * yy.x + yy.y * yy.y; }
            }
            if constexpr (PASS == 2) {
                if (IS_S ? (t8 == 7) : (seg == LRU_NSEG - 1 && fr == 15)) {
                    float* ho = p.out + (IS_S ? O_SH + (size_t)sq * DA : O_PH + (size_t)b * DA) + gch + 32 * ks;
                    *(f32x4*)ho = (f32x4){hv[0], hv[1], hv[2], hv[3]}; *(f32x4*)(ho + 4) = (f32x4){hv[4], hv[5], hv[6], hv[7]};
                }
            }
        }
        if constexpr (PASS == 2) {
            ss += __shfl_xor(ss, 16); ss += __shfl_xor(ss, 32);
            const float rn = __builtin_amdgcn_rsqf(ss * (1.0f / 128.0f) + EPS);
#pragma unroll
            for (int ks = 0; ks < 4; ++ks) {
                const f32x4 g0 = *(const LAS f32x4*)(CT + 8 * 128 + 32 * ks), g1 = *(const LAS f32x4*)(CT + 8 * 128 + 32 * ks + 4);
                float o[8];
#pragma unroll
                for (int e = 0; e < 8; ++e) o[e] = y[ks][e] * rn * (e < 4 ? g0[e & 3] : g1[e & 3]);
                *(u32x4*)(ym + (size_t)r * DMIX + gch + 32 * ks) = pack8(o);
            }
        }
    }
    if constexpr (PASS == 1 && !IS_S) {
        if (fr == 0) {
            float* tp = tot + ((size_t)(b * LRU_NSEG + seg) * 2) * DA + gch;
#pragma unroll
            for (int ks = 0; ks < 4; ++ks) {
                *(f32x4*)(tp + 32 * ks) = (f32x4){Pt[ks][0], Pt[ks][1], Pt[ks][2], Pt[ks][3]}; *(f32x4*)(tp + 32 * ks + 4) = (f32x4){Pt[ks][4], Pt[ks][5], Pt[ks][6], Pt[ks][7]};
                *(f32x4*)(tp + DA + 32 * ks) = (f32x4){hin[ks][0], hin[ks][1], hin[ks][2], hin[ks][3]}; *(f32x4*)(tp + DA + 32 * ks + 4) = (f32x4){hin[ks][4], hin[ks][5], hin[ks][6], hin[ks][7]};
            }
        }
    }
}
template <int PASS>
__device__ __forceinline__ void mixer_phase(PRef p, LAS unsigned char* lds, int G) {
    const int tid = opaque_tid(), wave = __builtin_amdgcn_readfirstlane(tid >> 6);
    for (int v = blockIdx.x; v < NH * LRU_WG_PER_HEAD; v += G) {
        const int n = v / LRU_WG_PER_HEAD;
        __syncthreads();
        if (!(PASS == 2 && G == GRID && p.ph_lo <= 2))
        {
            const bf16_t* wg = (const bf16_t*)(p.ws + WS_WG);
            for (int i = tid; i < 2 * 128 * 16; i += 512) { const int g = i >> 11, row = (i >> 4) & 127, c16 = i & 15;
                *(LAS u32x4*)(lds + g * L_WX + row * LW_STRIDE + c16 * 16) = *(const u32x4*)(wg + (((size_t)g * NH + n) * 128 + row) * 128 + c16 * 8); }
            LAS float* CTw = (LAS float*)(lds + L_CT);
            for (int i = tid; i < 9 * 128; i += 512) { const int k = i >> 7, c = i & 127, ch = n * 128 + c;
                float vv;
                if (k < 4) vv = p.conv_a_w[k * DA + ch]; else if (k == 4) vv = p.conv_a_b[ch]; else if (k == 5) vv = -1.4426950408889634f * p.b_gate_a[ch]; else if (k == 6) vv = -1.4426950408889634f * p.b_gate_x[ch];
                else if (k == 7) vv = -8.0f * 1.4426950408889634f * log1pf(__expf(-p.lam[ch])); else vv = p.g_out_a[ch];
                CTw[i] = vv; }
        }
        __syncthreads();
        const int wi = (v % LRU_WG_PER_HEAD) * 8 + wave;
        if (wi < LRU_PITEMS) lru_wave_item<PASS, false>(p, lds, n, wi / LRU_NSEG, wi % LRU_NSEG);
        else if (PASS == 2 && wi < LRU_PITEMS + LRU_SITEMS) lru_wave_item<PASS, true>(p, lds, n, wi - LRU_PITEMS, 0);
    }
    if (G == 256 && (int)blockIdx.x >= MIX_IDLE_WG0) convert_items(p, lds, ((int)blockIdx.x - MIX_IDLE_WG0) * 8 + wave, (G - MIX_IDLE_WG0) * 8, PASS == 1 ? IT_S1 : IT_S2, PASS == 1 ? IT_S2 : IT_S3);
    if (PASS == 1) { branch_b(p, G); if ((REP_MASK >> 11) & 1) branch_b(p, G); }
}

__device__ __forceinline__ void final_phase(PRef p, int G) {
    const int tid_ = opaque_tid(), lane = tid_ & 63, gw = blockIdx.x * 8 + (tid_ >> 6), NGW = G * 8;
    const bf16_t* x2b = (const bf16_t*)(p.ws + WS_YM);
    f32x4 gf[8];
#pragma unroll
    for (int j = 0; j < 8; ++j) gf[j] = ((const f32x4*)p.g_final)[lane + 64 * j];
    for (int o = gw; o < NB * SEQ + MSR; o += NGW) {
        const int r = o < NB * SEQ ? (o / SEQ) * TP + NMETA + (o % SEQ) : MPR + (o - NB * SEQ);
        const u32x2* xr = (const u32x2*)(x2b + (size_t)r * D) + lane;
        f32x4 v[8]; float s = 0.f;
#pragma unroll
        for (int j = 0; j < 8; ++j) { const u32x2 w = xr[64 * j]; v[j] = (f32x4){bf_lo(w.x), bf_hi(w.x), bf_lo(w.y), bf_hi(w.y)};
            s += (v[j][0] * v[j][0] + v[j][1] * v[j][1]) + (v[j][2] * v[j][2] + v[j][3] * v[j][3]); }
        s = wave_sum(s);
        const float rs = __builtin_amdgcn_rsqf(s * (1.0f / D) + EPS);
        f32x4* yo = (f32x4*)(p.out + (size_t)o * D) + lane;
#pragma unroll
        for (int j = 0; j < 8; ++j) yo[64 * j] = v[j] * rs * gf[j];
    }
}

#define XB_TMO      128
#define XB_XCNT(j)  (256  + 64 * (j))
#define XB_XSUB(j)  (1280 + 64 * (j))
#define XB_XGEN(j)  (2304 + 64 * (j))
#define XB_TOP      3328
#define XB_TOPGEN   3392
#define XCD_BAR_WORDS 3456
#define XB_SPIN_CAP (1u << 18)
__device__ __forceinline__ unsigned xb_ld(unsigned* p)              { return __hip_atomic_load(p, __ATOMIC_RELAXED, __HIP_MEMORY_SCOPE_AGENT); }
__device__ __forceinline__ unsigned xb_add(unsigned* p, unsigned v) { return __hip_atomic_fetch_add(p, v, __ATOMIC_RELAXED, __HIP_MEMORY_SCOPE_AGENT); }
__device__ __forceinline__ unsigned xb_xcc_id() { return (unsigned)__builtin_amdgcn_s_getreg((3 << 11) | 20) & 0xFu; }
#define XB_SPIN(cond, bar) do { unsigned _sp = 0; while (cond) { __builtin_amdgcn_s_sleep(1); \
    if ((++_sp & 255u) == 0u) { if (xb_ld(&(bar)[XB_TMO])) break; if (_sp > XB_SPIN_CAP) { atomicAdd(&(bar)[XB_TMO], 1u); break; } } } } while (0)
struct XcdBarrier { unsigned* bar; unsigned x; volatile LAS unsigned* st; };
__device__ __forceinline__ XcdBarrier xcd_barrier_post(unsigned* bar, volatile LAS unsigned* st) {
    XcdBarrier b; b.bar = bar; b.x = xb_xcc_id(); b.st = st;
    if (threadIdx.x == 0) (void)xb_add(&bar[XB_XCNT(b.x)], 1u);
    return b;
}
__device__ __forceinline__ void xcd_barrier_complete(unsigned* bar, unsigned x, unsigned& nloc, unsigned& nx) {
    const unsigned G = gridDim.x * gridDim.y * gridDim.z;
    unsigned sum, cnt, mine, sp = 0u;
    for (;;) {
        sum = 0u; cnt = 0u; mine = 0u;
#pragma unroll
        for (unsigned j = 0; j < 16; ++j) { const unsigned c = xb_ld(&bar[XB_XCNT(j)]); sum += c; cnt += (c > 0u) ? 1u : 0u; mine = (j == x) ? c : mine; }
        if (sum == G) break;
        __builtin_amdgcn_s_sleep(1);
        if ((++sp & 255u) == 0u) { if (xb_ld(&bar[XB_TMO])) break; if (sp > XB_SPIN_CAP) { atomicAdd(&bar[XB_TMO], 1u); break; } }
    }
    nloc = mine > 0u ? mine : 1u; nx = cnt > 0u ? cnt : 1u;
}
__device__ __forceinline__ void xcd_barrier(const XcdBarrier& b) {
    asm volatile("s_waitcnt vmcnt(0)" ::: "memory");
    __syncthreads();
    if (threadIdx.x == 0) {
        unsigned* bar = b.bar;
        __builtin_amdgcn_s_waitcnt(0);
        unsigned nloc = b.st[0], nx = b.st[1];
        if (nloc == 0u) { xcd_barrier_complete(bar, b.x, nloc, nx); b.st[0] = nloc; b.st[1] = nx; }
        const unsigned old = xb_add(&bar[XB_XSUB(b.x)], 1u);
        const unsigned gen = old / nloc;
        if (old + 1u == (gen + 1u) * nloc) {
            __builtin_amdgcn_fence(__ATOMIC_RELEASE, "agent");
            asm volatile("s_waitcnt vmcnt(0)" ::: "memory");
            const unsigned og = xb_add(&bar[XB_TOP], 1u);
            const unsigned tg = og / nx;
            if (og + 1u == (tg + 1u) * nx) xb_add(&bar[XB_TOPGEN], 1u);
            else XB_SPIN(xb_ld(&bar[XB_TOPGEN]) == tg, bar);
            __builtin_amdgcn_fence(__ATOMIC_ACQUIRE, "agent");
            xb_add(&bar[XB_XGEN(b.x)], 1u);
            asm volatile("s_waitcnt vmcnt(0)" ::: "memory");
        } else {
            XB_SPIN(xb_ld(&bar[XB_XGEN(b.x)]) == gen, bar);
            __builtin_amdgcn_fence(__ATOMIC_ACQUIRE, "agent");
            asm volatile("s_waitcnt vmcnt(0)" ::: "memory");
        }
    }
    __syncthreads();
}

constexpr int LDS_BYTES = 131072 + 1024 + 8 * 1024 + 8 * 2048;
constexpr int N_PHASES = 8;
__global__ void __launch_bounds__(512, 2) hymba_fwd(Params p) {
    extern __shared__ __attribute__((aligned(16))) unsigned char lds_raw[];
    LAS unsigned char* lds = (LAS unsigned char*)lds_raw;
    constexpr int G = GRID;
    if ((int)gridDim.x != GRID) return;
    const CAS Params* kp = (const CAS Params*)__builtin_amdgcn_kernarg_segment_ptr();
#define P_HERE (*({ const CAS Params* q_ = kp; asm volatile("" : "+s"(q_)); q_; }))
    unsigned char* ws = p.ws;
    volatile LAS unsigned* misc = (volatile LAS unsigned*)(lds + 131072);
    if (threadIdx.x < 8) misc[threadIdx.x] = 0u;
    __syncthreads();
    XcdBarrier bar = xcd_barrier_post((unsigned*)ws, misc);
    const int lo = p.ph_lo, hi = p.ph_hi;
#ifndef PH_MASK
#define PH_MASK 0xff
#endif
#define IN(k) (((PH_MASK >> (k)) & 1) && lo <= (k) && (k) < hi)
#define SEAM(k) do { if (IN(k) && IN((k) + 1)) xcd_barrier(bar); } while (0)
#define REPEAT(k) _Pragma("nounroll") for (int rep_ = 0; rep_ < ((((REP_MASK) >> (k)) & 1) ? 2 : 1); ++rep_, (rep_ < ((((REP_MASK) >> (k)) & 1) ? 2 : 1) ? xcd_barrier(bar) : (void)0))
    if ((REP_MASK >> 12) & 1) { xcd_barrier(bar); xcd_barrier(bar); xcd_barrier(bar); xcd_barrier(bar); }
    if (IN(0)) REPEAT(0) phase0(P_HERE, lds, G);
    SEAM(0);
    if (IN(1)) REPEAT(1) {
        pg8::Gemm g{(const bf16_t*)(ws + WS_XB) + (size_t)16 * D, (const bf16_t*)(ws + WS_WIN), MP / 256, DIN / 256, D, (size_t)256 * D * 2, (size_t)128 * D * 2};
        pg8::StaticOrder S; S.init(g.nM, g.nN, G, (int)blockIdx.x, D / 64, 1);
        LAS float* rstab1 = (LAS float*)(lds + 131072 + 1024);
        rstd1_table((const float*)(ws + WS_RS1), rstab1, S); __syncthreads();
        PRef q = P_HERE; EpiZ E{rstab1, (bf16_t*)(ws + WS_Z), q.out};
        pg8::gemm_phase<EpiZ, false, true, true>(lds, g, S, E, nullptr, nullptr);
        if ((int)blockIdx.x >= P1_TAIL_WG0 && G == 256) convert_items(P_HERE, lds, ((int)blockIdx.x - P1_TAIL_WG0) * 8 + (opaque_tid() >> 6), (G - P1_TAIL_WG0) * 8, IT_O, IT_S1);
        else if (G != 256) convert_items(P_HERE, lds, (int)blockIdx.x * 8 + (opaque_tid() >> 6), G * 8, IT_O, IT_S3);
    }
    SEAM(1);
    if (IN(2)) REPEAT(2) mixer_phase<1>(P_HERE, lds, G);
    SEAM(2);
    if (IN(3)) REPEAT(3) mixer_phase<2>(P_HERE, lds, G);
    SEAM(3);
    if (IN(4)) REPEAT(4) {
        pg8::Gemm g{(const bf16_t*)(ws + WS_YM), (const bf16_t*)(ws + WS_WO), MP / 256, D / 256, DMIX, (size_t)256 * DMIX * 2, (size_t)128 * DMIX * 2};
        pg8::StaticOrder S; S.init(g.nM, g.nN, G, (int)blockIdx.x, DMIX / 64, P4_SPLIT);
        EpiX1 E{(bf16_t*)(ws + WS_XB) + (size_t)16 * D, (float*)(ws + WS_SSQ)};
        pg8::gemm_phase<EpiX1, false, true, true>(lds, g, S, E, (float*)(ws + WS_Z), (unsigned*)ws + CW_TK4 + rep_ * 128 * 64);
        if ((int)blockIdx.x >= P4_TAIL_WG0 && G == 256) convert_items(P_HERE, lds, ((int)blockIdx.x - P4_TAIL_WG0) * 8 + (opaque_tid() >> 6), (G - P4_TAIL_WG0) * 8, IT_S3, IT_G);
        else if (G != 256) convert_items(P_HERE, lds, (int)blockIdx.x * 8 + (opaque_tid() >> 6), G * 8, IT_S3, IT_G);
    }
    SEAM(4);
    if (IN(5)) REPEAT(5) {
        pg8::Gemm g{(const bf16_t*)(ws + WS_XB) + (size_t)14 * D, (const bf16_t*)(ws + WS_WUP), 37, 2 * DFF / 256, D, (size_t)252 * D * 2, (size_t)64 * D * 2};
        pg8::StaticOrder S; S.init(g.nM, g.nN, G, (int)blockIdx.x, D / 64, 1);
        LAS float* rstab = (LAS float*)(lds + 131072 + 1024); LAS float* wtab = rstab + 8 * 256;
        PRef q = P_HERE; ffn_rstd_table((const float*)(ws + WS_SSQ), q.conv_f_w, q.conv_f_b, rstab, wtab, S); __syncthreads();
        EpiFFN E{q.st_fc, (bf16_t*)(ws + WS_Z), q.out, rstab, wtab};
        pg8::gemm_phase<EpiFFN, true, true, true>(lds, g, S, E, nullptr, nullptr);
    }
    SEAM(5);
    if (IN(6)) {
        pg8::Gemm g{(const bf16_t*)(ws + WS_Z), (const bf16_t*)(ws + WS_WDN), MP / 256, D / 256, DFF, (size_t)256 * DFF * 2, (size_t)128 * DFF * 2};
        pg8::StaticOrder S; S.init(g.nM, g.nN, G, (int)blockIdx.x, DFF / 64, P6_SPLIT);
        EpiOut E{(const bf16_t*)(ws + WS_XB) + (size_t)16 * D, (bf16_t*)(ws + WS_YM)};
        pg8::gemm_phase<EpiOut, false, true, true>(lds, g, S, E, (float*)(ws + WS_WIN), (unsigned*)ws + CW_TK6);
    }
    SEAM(6);
    if (IN(7)) REPEAT(7) final_phase(P_HERE, G);
#undef IN
#undef SEAM
}

extern "C" void kernel_launch(void* const* d_in, const int* in_sizes, int n_in, void* d_out, int out_size, void* d_ws, size_t ws_size, hipStream_t stream) {
    static int grid = 0;
    if (grid == 0) {
        if (n_in != 26 || (size_t)out_size != O_END || ws_size < WS_END) { fprintf(stderr, "kernel_launch: unexpected problem (n_in %d, out %d, ws %zu; need ws >= %zu)\n", n_in, out_size, ws_size, (size_t)WS_END); grid = -1; return; }
        int dev = 0, cus = 0, per_cu = 0;
        hipGetDevice(&dev); hipDeviceGetAttribute(&cus, hipDeviceAttributeMultiprocessorCount, dev);
        if (hipFuncSetAttribute((const void*)hymba_fwd, hipFuncAttributeMaxDynamicSharedMemorySize, LDS_BYTES) != hipSuccess) { fprintf(stderr, "kernel_launch: hipFuncSetAttribute failed\n"); grid = -1; return; }
        if (hipOccupancyMaxActiveBlocksPerMultiprocessor(&per_cu, (const void*)hymba_fwd, 512, LDS_BYTES) != hipSuccess || per_cu < 1) { fprintf(stderr, "kernel_launch: occupancy query says %d\n", per_cu); grid = -1; return; }
        if (cus < GRID) { fprintf(stderr, "kernel_launch: built for a %d-CU device, found %d CUs\n", GRID, cus); grid = -1; return; }
        grid = GRID;
    }
    if (grid < 0) return;
    Params p{};
    const float** f = (const float**)&p;
    for (int i = 0; i < 26; ++i) f[i] = (const float*)d_in[i];
    p.out = (float*)d_out; p.ws = (unsigned char*)d_ws;
    if (hipMemsetAsync(d_ws, 0, CTL_WORDS * 4, stream) != hipSuccess) { fprintf(stderr, "kernel_launch: memset failed\n"); return; }
    if (MK_N_LAUNCHES == 1) {
        p.ph_lo = 0; p.ph_hi = N_PHASES;
        hipLaunchKernelGGL(hymba_fwd, dim3(grid), dim3(512), LDS_BYTES, stream, p);
    } else {
        for (int k = 0; k < N_PHASES; ++k) { p.ph_lo = k; p.ph_hi = k + 1; hipLaunchKernelGGL(hymba_fwd, dim3(grid), dim3(512), LDS_BYTES, stream, p); }
    }
}
```

```cpp
#include <hip/hip_runtime.h>
#include <cstdio>

#ifndef REP_MASK
#define REP_MASK 0x00
#endif
#ifndef MK_N_LAUNCHES
#define MK_N_LAUNCHES 1
#endif

#define LAS __attribute__((address_space(3)))
#define CAS __attribute__((address_space(4)))
typedef unsigned short bf16_t;
typedef short bf16x8 __attribute__((ext_vector_type(8)));
typedef float f32x4 __attribute__((ext_vector_type(4)));
typedef unsigned u32x4 __attribute__((ext_vector_type(4)));
typedef unsigned u32x2 __attribute__((ext_vector_type(2)));

constexpr int D = 2048, NMETA = 16, SEQ = 2048, TP = SEQ + NMETA, NB = 4, MPR = NB * TP;
constexpr int NS = 128, TS = 8, MSR = NS * TS, M = MPR + MSR;
constexpr int MP = 9472;
constexpr int DA = 1536, DB = 1024, DIN = 6144, DMIX = 2560, DFF = 6144, NH = 12;
constexpr float EPS = 1e-6f;
constexpr int NCH = 33;
constexpr size_t O_YP = 0, O_YS = O_YP + (size_t)NB * SEQ * D, O_PH = O_YS + (size_t)MSR * D, O_PRC = O_PH + NB * DA,
                 O_PSC = O_PRC + NB * 3 * DA, O_PFC = O_PSC + NB * 2 * DB, O_SH = O_PFC + NB * 2 * DFF, O_SRC = O_SH + NS * DA,
                 O_SSC = O_SRC + (size_t)NS * 3 * DA, O_SFC = O_SSC + (size_t)NS * 2 * DB, O_END = O_SFC + (size_t)NS * 2 * DFF;
constexpr size_t MiB = 1u << 20;
constexpr int CW_TK6 = 4096, CTL_WORDS = 4096 + 256 * 64;
constexpr int P6_SPLIT = 4, P4_SPLIT = 4, CW_TK4 = CW_TK6 + 64 * 64;
constexpr int GRID = 256;
constexpr size_t WS_WIN = 1 * MiB;
constexpr size_t WS_WO = WS_WIN + (size_t)DIN * D * 2;
constexpr size_t WS_WUP = WS_WO + (size_t)D * DMIX * 2;
constexpr size_t WS_WDN = WS_WUP + (size_t)2 * DFF * D * 2;
constexpr size_t WS_WG = WS_WDN + (size_t)D * DFF * 2;
constexpr size_t WS_XB = WS_WG + (size_t)2 * NH * 128 * 128 * 2;
constexpr size_t XB_ROWS = 9600;
constexpr size_t WS_Z = WS_XB + XB_ROWS * D * 2;
constexpr size_t WS_YM = WS_Z + (size_t)MP * DIN * 2;
constexpr size_t WS_RS1 = WS_YM + (size_t)MP * DMIX * 2;
constexpr size_t WS_SSQ = WS_RS1 + (size_t)MP * 4;
constexpr size_t WS_TOT = WS_SSQ + (size_t)MP * 32 * 4;
constexpr size_t WS_LA = WS_TOT + (size_t)NB * NCH * DA * 2 * 4;
constexpr size_t WS_UU = WS_LA + (size_t)MPR * DA * 2;
constexpr size_t WS_END = WS_UU + (size_t)MPR * DA * 2;

struct Params;
typedef const CAS Params& PRef;
struct Params {
    const float *x_prompt, *x_sample, *st_h, *st_rc, *st_sc, *st_fc, *meta, *g_mix, *w_in, *conv_a_w, *conv_a_b, *w_gate_a, *b_gate_a,
        *w_gate_x, *b_gate_x, *lam, *conv_b_w, *g_out_a, *g_out_b, *w_o, *g_ffn, *w_up, *conv_f_w, *conv_f_b, *w_down, *g_final;
    float* out; unsigned char* ws; int ph_lo, ph_hi;
};

__device__ __forceinline__ unsigned cvt_pk_bf16(float lo, float hi) { unsigned r; asm volatile("v_cvt_pk_bf16_f32 %0, %1, %2" : "=v"(r) : "v"(lo), "v"(hi)); return r; }
__device__ __forceinline__ float bf_lo(unsigned w) { return __builtin_bit_cast(float, w << 16); }
__device__ __forceinline__ float bf_hi(unsigned w) { return __builtin_bit_cast(float, w & 0xffff0000u); }
__device__ __forceinline__ void unpack8(const u32x4 w, float (&f)[8]) { f[0] = bf_lo(w.x); f[1] = bf_hi(w.x); f[2] = bf_lo(w.y); f[3] = bf_hi(w.y); f[4] = bf_lo(w.z); f[5] = bf_hi(w.z); f[6] = bf_lo(w.w); f[7] = bf_hi(w.w); }
__device__ __forceinline__ u32x4 pack8(const float (&f)[8]) { u32x4 w; w.x = cvt_pk_bf16(f[0], f[1]); w.y = cvt_pk_bf16(f[2], f[3]); w.z = cvt_pk_bf16(f[4], f[5]); w.w = cvt_pk_bf16(f[6], f[7]); return w; }
__device__ __forceinline__ float wave_sum(float v) {
#pragma unroll
    for (int o = 1; o < 64; o <<= 1) v += __shfl_xor(v, o);
    return v;
}
__device__ __forceinline__ float sum16(float v) {
    v += __shfl_xor(v, 1); v += __shfl_xor(v, 2); v += __shfl_xor(v, 4); v += __shfl_xor(v, 8); return v;
}
__device__ __forceinline__ float sigmoidf_(float x) { return __builtin_amdgcn_rcpf(1.0f + __expf(-x)); }
__device__ __forceinline__ float gelu_tanh(float x) {
    constexpr float K1 = -2.0f * 0.7978845608028654f * 1.4426950408889634f, K2 = K1 * 0.044715f;
    const float t = x * __builtin_fmaf(x * x, K2, K1);
    return x * __builtin_amdgcn_rcpf(1.0f + __builtin_amdgcn_exp2f(t));
}
__device__ __forceinline__ int opaque_tid() { int t = threadIdx.x; asm volatile("" : "+v"(t)); return t; }
typedef float f32x2 __attribute__((ext_vector_type(2)));
__device__ __forceinline__ f32x2 gelu_mul2(f32x2 g, f32x2 v) {
    constexpr float K1 = -2.0f * 0.7978845608028654f * 1.4426950408889634f, K2 = K1 * 0.044715f;
    const f32x2 t = g * ((g * g) * K2 + K1);
    f32x2 e; e.x = __builtin_amdgcn_exp2f(t.x); e.y = __builtin_amdgcn_exp2f(t.y);
    const f32x2 d = e + 1.0f;
    f32x2 r; r.x = __builtin_amdgcn_rcpf(d.x); r.y = __builtin_amdgcn_rcpf(d.y);
    return (g * v) * r;
}
template <int CTRL> __device__ __forceinline__ float dppf(float old, float src) {
    return __builtin_bit_cast(float, __builtin_amdgcn_update_dpp(__builtin_bit_cast(int, old), __builtin_bit_cast(int, src), CTRL, 0xF, 0xF, false));
}
__device__ __forceinline__ void row_decode(int r, int& is_s, int& seq, int& t) {
    if (r < MPR) { seq = (r >= TP) + (r >= 2 * TP) + (r >= 3 * TP); t = r - seq * TP; is_s = 0; }
    else { const int q = r - MPR; seq = q >> 3; t = q & 7; is_s = 1; }
}
__device__ __forceinline__ const float* x_row_ptr(const float* xp, const float* xs, const float* meta, int r) {
    int is_s, seq, t; row_decode(r, is_s, seq, t);
    if (is_s) return xs + (size_t)(r - MPR) * D;
    return t < NMETA ? meta + (size_t)t * D : xp + ((size_t)seq * SEQ + (t - NMETA)) * D;
}
__device__ __forceinline__ float* y_row_ptr(float* out, int r) {
    if (r >= M) return nullptr;
    int is_s, seq, t; row_decode(r, is_s, seq, t);
    if (is_s) return out + O_YS + (size_t)(r - MPR) * D;
    return t < NMETA ? nullptr : out + O_YP + ((size_t)seq * SEQ + (t - NMETA)) * D;
}

namespace pg8 {
constexpr int BM = 256, BK = 64, HALF = 128, HTB = HALF * BK * 2, STAGE_BYTES = 8 * HTB, NXCD = 8, WGM = 2;
__host__ __device__ __forceinline__ int lds_byte(int r, int c) { const int st = (r >> 4) * 2 + (c >> 5), rr = r & 15, cc = c & 31, ob = rr * 64 + cc * 2; return st * 1024 + (ob ^ (((ob >> 9) & 1) << 5)); }
__host__ __device__ __forceinline__ void stage_rc(int b, int& R, int& C) { const int st = b / 1024, sb = b % 1024, swz = sb ^ (((sb >> 9) & 1) << 5); R = (st >> 1) * 16 + swz / 64; C = (st & 1) * 32 + (swz % 64) / 2; }
struct Unit { int pm, pn, kb, nk, piece, lu, idx; };
struct Gemm { const bf16_t* A; const bf16_t* Bt; int nM, nN, K; size_t a_tstep, a_hstep; };
struct StaticOrder {
    int nM, nN, nwg, G, c, nt, split, nfull, nleft, limit = 1 << 20, first = 0;
    __device__ __forceinline__ void init(int nM_, int nN_, int G_, int c_, int nt_, int split_) { nM = nM_; nN = nN_; nwg = nM * nN; G = G_; c = c_; nt = nt_; nfull = (nwg / G) * G; nleft = nwg - nfull;
        split = (split_ > 1 && nleft > 0 && nleft * split_ <= G && (nt / split_) * split_ == nt && ((nt / split_) & 1) == 0) ? split_ : 1; }
    __device__ __forceinline__ void map(int L, Unit& u) const {
        int wgid = L; { const int q = nwg / NXCD, r = nwg % NXCD, xcd = wgid % NXCD, off = wgid / NXCD; wgid = (xcd < r ? xcd * (q + 1) : r * (q + 1) + (xcd - r) * q) + off; }
        const int nig = WGM * nN, gid = wgid / nig, rem = wgid - gid * nig, fm = gid * WGM, glast = nM % WGM;
        if (nM - fm >= WGM || glast == 0) { u.pm = fm + (rem & (WGM - 1)); u.pn = rem / WGM; }
        else { u.pm = fm + rem % glast; u.pn = rem / glast; }
    }
    __device__ __forceinline__ bool next(int i, Unit& u) const {
        u.kb = 0; u.nk = nt; u.piece = -1; u.lu = 0; u.idx = i;
        i += first; if (i >= limit) return false;
        const long L = (long)i * G + c;
        if (L < nfull || split == 1) { if (L >= nwg) return false; map((int)L, u); return true; }
        if (L >= nfull + G || c >= nleft * split) return false;
        u.lu = c % nleft; u.piece = c / nleft; u.nk = nt / split; u.kb = u.piece * u.nk; map(nfull + u.lu, u); return true;
    }
};

template <int P, int A, int Mi>
__device__ __forceinline__ void reduce_rowgroup(f32x4 (&acc)[2][2][4][2], const unsigned char* slab0, int tid) {
    const unsigned char* sp = slab0 + (size_t)((A * 4 + Mi) * 4) * 16384 + tid * 16;
#pragma unroll
    for (int b = 0; b < 2; ++b) {
        f32x4 s0 = (f32x4){0.f, 0.f, 0.f, 0.f}, s1 = s0;
#pragma unroll
        for (int src = 0; src < 4; ++src) {
            if (src == P) { s0 += acc[A][b][Mi][0]; s1 += acc[A][b][Mi][1]; }
            else { float f[8]; unpack8(*(const u32x4*)(sp + (size_t)src * 16384 + b * 8192), f); s0 += (f32x4){f[0], f[1], f[2], f[3]}; s1 += (f32x4){f[4], f[5], f[6], f[7]}; }
        }
        acc[A][b][Mi][0] = s0; acc[A][b][Mi][1] = s1;
    }
}
template <class Epi, bool FFNMAP, bool ALIGN_EPI, bool SP2>
__device__ __forceinline__ void gemm_phase(LAS unsigned char* lds, const Gemm g, const StaticOrder& S, const Epi& E, float* slabs, unsigned* tickets, bool dry = false) {
    int tid = threadIdx.x; asm volatile("" : "+v"(tid));
    const int wid = __builtin_amdgcn_readfirstlane(tid >> 6), lane = tid & 63, wr = wid >> 2, wc = wid & 3, fr = lane & 15, fq = lane >> 4;
    const int K = g.K;
    unsigned voffA[2], voffB[2];
#pragma unroll
    for (int i = 0; i < 2; ++i) { int R, C; stage_rc(tid * 16 + i * 8192, R, C); const int Ra = FFNMAP ? (126 * (R >> 6) + 4 * (R & 15) + ((R >> 4) & 3)) : R;
        voffA[i] = (unsigned)(Ra * K + C) * 2u; voffB[i] = (unsigned)(R * K + C) * 2u; }
    const size_t kstep = (size_t)(BK * 2);
    const size_t hstepA = g.a_hstep, tstepA = g.a_tstep;
    const size_t hstepB = (size_t)HALF * K * 2, tstepB = 2 * hstepB;
    const unsigned ldsw = (unsigned)wid * 1024u;
    const int aoff = lds_byte(wr * 64 + fr, fq * 8), boff = lds_byte(wc * 32 + fr, fq * 8);
#define PG8_SA(b, h) (((b) * 2 + (h)) * HTB)
#define PG8_SB(b, h) ((4 + (b) * 2 + (h)) * HTB)
#define PG8_STAGE(bufoff, gbase, voff) do { _Pragma("unroll") for (int _i = 0; _i < 2; ++_i) \
        __builtin_amdgcn_global_load_lds((const unsigned*)((const char*)(gbase) + (voff)[_i]), (LAS unsigned*)(lds + (bufoff) + ldsw + _i * 8192), 16, 0, 0); } while (0)
#define PG8_LDA(dst, b, h) do { _Pragma("unroll") for (int m = 0; m < 4; ++m) _Pragma("unroll") for (int k = 0; k < 2; ++k) dst[m][k] = *(const LAS bf16x8*)(lds + PG8_SA(b, h) + aoff + m * 2048 + k * 1024); } while (0)
#define PG8_LDB(dst, b, h) do { _Pragma("unroll") for (int n = 0; n < 2; ++n) _Pragma("unroll") for (int k = 0; k < 2; ++k) dst[n][k] = *(const LAS bf16x8*)(lds + PG8_SB(b, h) + boff + n * 2048 + k * 1024); } while (0)
#define PG8_MMA(ai, bj, At, Bt) do { __builtin_amdgcn_s_setprio(1); _Pragma("unroll") for (int m = 0; m < 4; ++m) _Pragma("unroll") for (int n = 0; n < 2; ++n) _Pragma("unroll") for (int k = 0; k < 2; ++k) \
        acc[ai][bj][m][n] = __builtin_amdgcn_mfma_f32_16x16x32_bf16(Bt[n][k], At[m][k], acc[ai][bj][m][n], 0, 0, 0); __builtin_amdgcn_s_setprio(0); } while (0)
#define PG8_WAIT_V(n) asm volatile("s_waitcnt vmcnt(" #n ")" ::: "memory")
#define PG8_WAIT_L(n) asm volatile("s_waitcnt lgkmcnt(" #n ")" ::: "memory")
#define PG8_BAR __builtin_amdgcn_s_barrier()
#define PG8_SCHED __builtin_amdgcn_sched_barrier(0)
    Unit cur, nxt; int ui = 0;
    if (!S.next(0, cur)) return;
    f32x4 acc[2][2][4][2];
#pragma unroll
    for (int a = 0; a < 2; ++a)
#pragma unroll
        for (int b = 0; b < 2; ++b)
#pragma unroll
            for (int m = 0; m < 4; ++m)
#pragma unroll
                for (int n = 0; n < 2; ++n) acc[a][b][m][n] = (f32x4){0.f, 0.f, 0.f, 0.f};
    bf16x8 At[4][2], B0[2][2], B1[2][2];
    const char* cA = (const char*)g.A + (size_t)cur.pm * tstepA + (size_t)cur.kb * kstep; const char* cB = (const char*)g.Bt + (size_t)cur.pn * tstepB + (size_t)cur.kb * kstep;
    if constexpr (SP2) {
        PG8_STAGE(PG8_SB(0, 0), cB, voffB); PG8_STAGE(PG8_SB(0, 1), cB + hstepB, voffB); PG8_STAGE(PG8_SA(0, 0), cA, voffA); PG8_STAGE(PG8_SA(0, 1), cA + hstepA, voffA);
        if (wr == 1) PG8_BAR;
        PG8_WAIT_V(2); PG8_BAR;
        PG8_STAGE(PG8_SB(1, 0), cB + kstep, voffB); PG8_STAGE(PG8_SA(1, 0), cA + kstep, voffA); PG8_STAGE(PG8_SB(1, 1), cB + hstepB + kstep, voffB);
        PG8_WAIT_V(6); PG8_BAR;
    } else {
        PG8_STAGE(PG8_SB(0, 0), cB, voffB); PG8_STAGE(PG8_SA(0, 0), cA, voffA); PG8_STAGE(PG8_SB(0, 1), cB + hstepB, voffB); PG8_STAGE(PG8_SA(0, 1), cA + hstepA, voffA);
        if (wr == 1) PG8_BAR;
        PG8_WAIT_V(4); PG8_BAR;
        PG8_STAGE(PG8_SB(1, 0), cB + kstep, voffB); PG8_STAGE(PG8_SA(1, 0), cA + kstep, voffA); PG8_STAGE(PG8_SB(1, 1), cB + hstepB + kstep, voffB);
        PG8_WAIT_V(6); PG8_BAR;
    }
    for (;;) {
        const bool has_next = S.next(ui + 1, nxt);
        const char* nA = has_next ? (const char*)g.A + (size_t)nxt.pm * tstepA + (size_t)nxt.kb * kstep : cA; const char* nB = has_next ? (const char*)g.Bt + (size_t)nxt.pn * tstepB + (size_t)nxt.kb * kstep : cB;
        const int nt = cur.nk;
        for (int t = 0; t < nt; t += 2) {
            const bool last = (t == nt - 2);
            const char* a1 = cA + (size_t)(t + 1) * kstep;
            const char* a2 = last ? nA : cA + (size_t)(t + 2) * kstep; const char* b2 = last ? nB : cB + (size_t)(t + 2) * kstep;
            const char* a3 = a2 + kstep; const char* b3 = b2 + kstep;
            if constexpr (SP2) {
            PG8_LDB(B0, 0, 0); PG8_LDB(B1, 0, 1); PG8_SCHED; PG8_LDA(At, 0, 0); PG8_STAGE(PG8_SA(1, 1), a1 + hstepA, voffA);
            PG8_WAIT_V(8); PG8_WAIT_L(0); PG8_BAR; PG8_MMA(0, 0, At, B0); PG8_MMA(0, 1, At, B1); PG8_BAR; PG8_SCHED;
            PG8_LDA(At, 0, 1); PG8_STAGE(PG8_SB(0, 0), b2, voffB); PG8_STAGE(PG8_SB(0, 1), b2 + hstepB, voffB); PG8_STAGE(PG8_SA(0, 0), a2, voffA);
            PG8_WAIT_V(8); PG8_WAIT_L(0); PG8_BAR; PG8_MMA(1, 0, At, B0); PG8_MMA(1, 1, At, B1); PG8_BAR; PG8_SCHED;
            PG8_LDB(B0, 1, 0); PG8_LDB(B1, 1, 1); PG8_SCHED; PG8_LDA(At, 1, 0); PG8_STAGE(PG8_SA(0, 1), a2 + hstepA, voffA);
            PG8_WAIT_V(8); PG8_WAIT_L(0); PG8_BAR; PG8_MMA(0, 0, At, B0); PG8_MMA(0, 1, At, B1); PG8_BAR; PG8_SCHED;
            PG8_LDA(At, 1, 1); PG8_STAGE(PG8_SB(1, 0), b3, voffB); PG8_STAGE(PG8_SB(1, 1), b3 + hstepB, voffB); PG8_STAGE(PG8_SA(1, 0), a3, voffA);
            PG8_WAIT_V(8); PG8_WAIT_L(0); PG8_BAR; PG8_MMA(1, 0, At, B0); PG8_MMA(1, 1, At, B1); PG8_BAR; PG8_SCHED;
            } else {
            PG8_LDB(B0, 0, 0); PG8_SCHED; PG8_LDA(At, 0, 0); PG8_STAGE(PG8_SA(1, 1), a1 + hstepA, voffA);
            PG8_WAIT_L(8); PG8_BAR; PG8_WAIT_L(0); PG8_MMA(0, 0, At, B0); PG8_BAR; PG8_SCHED;
            PG8_LDB(B1, 0, 1); PG8_STAGE(PG8_SB(0, 0), b2, voffB);
            PG8_BAR; PG8_WAIT_L(0); PG8_MMA(0, 1, At, B1); PG8_BAR;
            PG8_LDA(At, 0, 1); PG8_STAGE(PG8_SA(0, 0), a2, voffA);
            PG8_BAR; PG8_WAIT_L(0); PG8_MMA(1, 0, At, B0); PG8_BAR; PG8_SCHED;
            PG8_STAGE(PG8_SB(0, 1), b2 + hstepB, voffB);
            PG8_WAIT_V(6); PG8_BAR; PG8_MMA(1, 1, At, B1); PG8_BAR;
            PG8_LDB(B0, 1, 0); PG8_SCHED; PG8_LDA(At, 1, 0); PG8_STAGE(PG8_SA(0, 1), a2 + hstepA, voffA);
            PG8_WAIT_L(8); PG8_BAR; PG8_WAIT_L(0); PG8_MMA(0, 0, At, B0); PG8_BAR; PG8_SCHED;
            PG8_LDB(B1, 1, 1); PG8_STAGE(PG8_SB(1, 0), b3, voffB);
            PG8_BAR; PG8_WAIT_L(0); PG8_MMA(0, 1, At, B1); PG8_BAR;
            PG8_LDA(At, 1, 1); PG8_STAGE(PG8_SA(1, 0), a3, voffA);
            PG8_BAR; PG8_WAIT_L(0); PG8_MMA(1, 0, At, B0); PG8_BAR; PG8_SCHED;
            PG8_STAGE(PG8_SB(1, 1), b3 + hstepB, voffB);
            PG8_WAIT_V(6); PG8_BAR; PG8_MMA(1, 1, At, B1); PG8_BAR;
            }
        }
        if constexpr (ALIGN_EPI) { if (wr == 0) PG8_BAR; }
        if (cur.piece < 0 && !dry) E(acc, cur, wr, wc, fr, fq);
        if (!has_next) break;
#pragma unroll
        for (int a = 0; a < 2; ++a)
#pragma unroll
            for (int b = 0; b < 2; ++b)
#pragma unroll
                for (int m = 0; m < 4; ++m)
#pragma unroll
                    for (int n = 0; n < 2; ++n) acc[a][b][m][n] = (f32x4){0.f, 0.f, 0.f, 0.f};
        cur = nxt; cA = nA; cB = nB; ++ui;
        if constexpr (ALIGN_EPI) { if (wr == 1) PG8_BAR; }
    }
    PG8_WAIT_V(0);
    if constexpr (!ALIGN_EPI) { if (wr == 0) PG8_BAR; }
    PG8_BAR;
    if constexpr (Epi::SPLIT) {
    if (cur.piece >= 0 && !dry) {
        unsigned char* slab0 = (unsigned char*)slabs + (size_t)cur.lu * (8 * 4 * 16384);
        {
            const __amdgpu_buffer_rsrc_t rs = __builtin_amdgcn_make_buffer_rsrc((void*)slab0, (short)0, 8 * 4 * 16384, 0x00020000);
#pragma unroll
            for (int a = 0; a < 2; ++a)
#pragma unroll
                for (int m = 0; m < 4; ++m) {
                    const int gq = a * 4 + m;
                    if ((gq >> 1) != cur.piece) {
#pragma unroll
                        for (int b = 0; b < 2; ++b) { const f32x4 v0 = acc[a][b][m][0], v1 = acc[a][b][m][1];
                            u32x4 w; w.x = cvt_pk_bf16(v0[0], v0[1]); w.y = cvt_pk_bf16(v0[2], v0[3]); w.z = cvt_pk_bf16(v1[0], v1[1]); w.w = cvt_pk_bf16(v1[2], v1[3]);
                            __builtin_amdgcn_raw_buffer_store_b128(w, rs, (gq * 4 + cur.piece) * 16384 + b * 8192 + tid * 16, 0, 16); }
                    }
                }
        }
        asm volatile("s_waitcnt vmcnt(0)" ::: "memory");
        __syncthreads();
        if (tid == 0) {
            __hip_atomic_fetch_add(tickets + 64 * cur.lu, 1u, __ATOMIC_RELAXED, __HIP_MEMORY_SCOPE_AGENT);
            unsigned sp = 0;
            while (__hip_atomic_load(tickets + 64 * cur.lu, __ATOMIC_RELAXED, __HIP_MEMORY_SCOPE_AGENT) < 4u) { __builtin_amdgcn_s_sleep(2); if (++sp > (1u << 20)) break; }
            __builtin_amdgcn_fence(__ATOMIC_ACQUIRE, "agent"); asm volatile("s_waitcnt vmcnt(0)" ::: "memory");
        }
        __syncthreads();
        switch (cur.piece) {
            case 0: reduce_rowgroup<0, 0, 0>(acc, slab0, tid); reduce_rowgroup<0, 0, 1>(acc, slab0, tid); break;
            case 1: reduce_rowgroup<1, 0, 2>(acc, slab0, tid); reduce_rowgroup<1, 0, 3>(acc, slab0, tid); break;
            case 2: reduce_rowgroup<2, 1, 0>(acc, slab0, tid); reduce_rowgroup<2, 1, 1>(acc, slab0, tid); break;
            default: reduce_rowgroup<3, 1, 2>(acc, slab0, tid); reduce_rowgroup<3, 1, 3>(acc, slab0, tid); break;
        }
        E(acc, cur, wr, wc, fr, fq, 3u << (2 * cur.piece));
    }
    }
#undef PG8_SA
#undef PG8_SB
#undef PG8_STAGE
#undef PG8_LDA
#undef PG8_LDB
#undef PG8_MMA
#undef PG8_WAIT_V
#undef PG8_WAIT_L
#undef PG8_BAR
#undef PG8_SCHED
}
}

typedef f32x4 Acc[2][2][4][2];

struct EpiZ {
    static constexpr bool SPLIT = false;
    const LAS float* rstab; bf16_t* z; float* out;
    __device__ __forceinline__ void operator()(const Acc& acc, const pg8::Unit& u, int wr, int wc, int fr, int fq) const {
        asm volatile("" : "+v"(fr), "+v"(fq));
        const int col0 = u.pn * 256 + wc * 32 + 8 * fq;
#pragma unroll
        for (int ai = 0; ai < 2; ++ai)
#pragma unroll
            for (int m = 0; m < 4; ++m) {
                const int r = u.pm * 256 + ai * 128 + wr * 64 + m * 16 + fr;
                if (r < M) {
                    const float rs = rstab[u.idx * 256 + ai * 128 + wr * 64 + m * 16 + fr];
                    int is_s, seq, t; row_decode(r, is_s, seq, t);
                    float* so = nullptr;
                    if (u.pn < 6) { if (is_s) { if (t >= TS - 3) so = out + O_SRC + ((size_t)seq * 3 + (t - (TS - 3))) * DA; } else { if (t >= TP - 3) so = out + O_PRC + ((size_t)seq * 3 + (t - (TP - 3))) * DA; } }
#pragma unroll
                    for (int bj = 0; bj < 2; ++bj) {
                        const f32x4 v0 = acc[ai][bj][m][0] * rs, v1 = acc[ai][bj][m][1] * rs;
                        u32x4 w; w.x = cvt_pk_bf16(v0[0], v0[1]); w.y = cvt_pk_bf16(v0[2], v0[3]); w.z = cvt_pk_bf16(v1[0], v1[1]); w.w = cvt_pk_bf16(v1[2], v1[3]);
                        *(u32x4*)(z + (size_t)r * DIN + col0 + bj * 128) = w;
                        if (so) { *(f32x4*)(so + col0 + bj * 128) = v0; *(f32x4*)(so + col0 + bj * 128 + 4) = v1; }
                    }
                }
            }
    }
};
__device__ __forceinline__ void rstd1_table(const float* rstd1, LAS float* tab, const pg8::StaticOrder& S) {
    const int tid = opaque_tid(), q = tid & 255;
    pg8::Unit u;
    for (int i = tid >> 8; S.next(i, u); i += 2) { const int r = u.pm * 256 + q; tab[i * 256 + q] = r < M ? rstd1[r] : 0.f; }
}
struct EpiX1 {
    static constexpr bool SPLIT = true;
    bf16_t* xb; float* ssq;
    __device__ __forceinline__ void operator()(const Acc& acc, const pg8::Unit& u, int wr, int wc, int fr, int fq, unsigned gmask = 0xffu) const {
        asm volatile("" : "+v"(fr), "+v"(fq));
        const int col0 = u.pn * 256 + wc * 32 + 8 * fq;
#pragma unroll
        for (int ai = 0; ai < 2; ++ai) {
            if (!((gmask >> (ai * 4)) & 0xfu)) continue;
            u32x4 xv[4][2];
#pragma unroll
            for (int m = 0; m < 4; ++m) {
                const int r = u.pm * 256 + ai * 128 + wr * 64 + m * 16 + fr;
                const bf16_t* xr = xb + (size_t)(r < M ? r : 0) * D + col0;
#pragma unroll
                for (int bj = 0; bj < 2; ++bj) xv[m][bj] = *(const u32x4*)(xr + bj * 128);
            }
#pragma unroll
            for (int m = 0; m < 4; ++m) {
                if (!((gmask >> (ai * 4 + m)) & 1u)) continue;
                const int r = u.pm * 256 + ai * 128 + wr * 64 + m * 16 + fr;
                const bool valid = r < M;
                float ss = 0.f;
#pragma unroll
                for (int bj = 0; bj < 2; ++bj) {
                    float xf[8]; unpack8(xv[m][bj], xf);
                    const f32x4 a0 = acc[ai][bj][m][0], a1 = acc[ai][bj][m][1];
                    const f32x4 v0 = (f32x4){a0[0] + xf[0], a0[1] + xf[1], a0[2] + xf[2], a0[3] + xf[3]}, v1 = (f32x4){a1[0] + xf[4], a1[1] + xf[5], a1[2] + xf[6], a1[3] + xf[7]};
                    ss += (v0[0] * v0[0] + v0[1] * v0[1]) + (v0[2] * v0[2] + v0[3] * v0[3]) + (v1[0] * v1[0] + v1[1] * v1[1]) + (v1[2] * v1[2] + v1[3] * v1[3]);
                    if (valid) { u32x4 w; w.x = cvt_pk_bf16(v0[0], v0[1]); w.y = cvt_pk_bf16(v0[2], v0[3]); w.z = cvt_pk_bf16(v1[0], v1[1]); w.w = cvt_pk_bf16(v1[2], v1[3]);
                        *(u32x4*)(xb + (size_t)r * D + col0 + bj * 128) = w; }
                }
                ss += __shfl_xor(ss, 16); ss += __shfl_xor(ss, 32);
                if (valid && fq == 0) ssq[(size_t)r * 32 + u.pn * 4 + wc] = ss;
            }
        }
    }
};
struct EpiOut {
    static constexpr bool SPLIT = true;
    const bf16_t* x1b; bf16_t* x2b;
    __device__ __forceinline__ void operator()(const Acc& acc, const pg8::Unit& u, int wr, int wc, int fr, int fq, unsigned gmask = 0xffu) const {
        asm volatile("" : "+v"(fr), "+v"(fq));
        const int col0 = u.pn * 256 + wc * 32 + 8 * fq;
#pragma unroll
        for (int ai = 0; ai < 2; ++ai) {
            if (!((gmask >> (ai * 4)) & 0xfu)) continue;
            u32x4 xv[4][2];
#pragma unroll
            for (int m = 0; m < 4; ++m) {
                const int r = u.pm * 256 + ai * 128 + wr * 64 + m * 16 + fr;
                const bf16_t* xr = x1b + (size_t)(r < M ? r : 0) * D + col0;
#pragma unroll
                for (int bj = 0; bj < 2; ++bj) xv[m][bj] = *(const u32x4*)(xr + bj * 128);
            }
#pragma unroll
            for (int m = 0; m < 4; ++m) {
                if (!((gmask >> (ai * 4 + m)) & 1u)) continue;
                const int r = u.pm * 256 + ai * 128 + wr * 64 + m * 16 + fr;
                if (r < M) {
#pragma unroll
                    for (int bj = 0; bj < 2; ++bj) {
                        float xf[8]; unpack8(xv[m][bj], xf);
                        const f32x4 a0 = acc[ai][bj][m][0], a1 = acc[ai][bj][m][1];
                        u32x4 w; w.x = cvt_pk_bf16(a0[0] + xf[0], a0[1] + xf[1]); w.y = cvt_pk_bf16(a0[2] + xf[2], a0[3] + xf[3]); w.z = cvt_pk_bf16(a1[0] + xf[4], a1[1] + xf[5]); w.w = cvt_pk_bf16(a1[2] + xf[6], a1[3] + xf[7]);
                        *(u32x4*)(x2b + (size_t)r * D + col0 + bj * 128) = w;
                    }
                }
            }
        }
    }
};
struct EpiFFN {
    static constexpr bool SPLIT = false;
    const float* st_fc; bf16_t* hid; float* out; const LAS float* rstab; const LAS float* wtab;
    template <bool PLAIN>
    __device__ __forceinline__ void body(Acc& acc, const pg8::Unit& u, int wr, int wc, int fr, int fq, int gbase, int f0,
                                         const f32x4 (&wv)[4][2]) const {
#pragma unroll
        for (int ai = 0; ai < 2; ++ai) {
            f32x4 s3[2], s2[2];
#pragma unroll
            for (int n = 0; n < 2; ++n)
#pragma unroll
                for (int e = 0; e < 4; ++e) {
                    const float o3 = ai == 0 ? 0.f : dppf<0x121>(0.f, acc[0][0][3][n][e]), o2 = ai == 0 ? 0.f : dppf<0x121>(0.f, acc[0][0][2][n][e]);
                    s3[n][e] = dppf<0x111>(o3, acc[ai][0][3][n][e]); s2[n][e] = dppf<0x111>(o2, acc[ai][0][2][n][e]);
                }
#pragma unroll
            for (int m = 0; m < 4; ++m) {
                const int j = 64 * ai + 4 * fr + m, r = gbase + j;
                const f32x4 c0 = acc[ai][0][m][0], c1 = acc[ai][0][m][1];
                f32x4 p1a = m == 0 ? s3[0] : acc[ai][0][m == 0 ? 0 : m - 1][0], p1b = m == 0 ? s3[1] : acc[ai][0][m == 0 ? 0 : m - 1][1];
                f32x4 p2a = m == 0 ? s2[0] : (m == 1 ? s3[0] : acc[ai][0][m < 2 ? 0 : m - 2][0]), p2b = m == 0 ? s2[1] : (m == 1 ? s3[1] : acc[ai][0][m < 2 ? 0 : m - 2][1]);
                bool valid = j >= 2;
                int is_s = 0, seq = 0, t = 2;
                if constexpr (!PLAIN) {
                    valid = valid && (r < M);
                    row_decode(valid ? r : 0, is_s, seq, t);
                    if (valid && t < 2) {
                        f32x4 s0a = (f32x4){0.f, 0.f, 0.f, 0.f}, s0b = s0a, s1a = s0a, s1b = s0a;
                        if (is_s) { const float* sp = st_fc + (size_t)seq * 2 * DFF + f0; s0a = *(const f32x4*)sp; s0b = *(const f32x4*)(sp + 4); s1a = *(const f32x4*)(sp + DFF); s1b = *(const f32x4*)(sp + DFF + 4); }
                        if (t == 0) { p1a = s1a; p1b = s1b; p2a = s0a; p2b = s0b; } else { p2a = s1a; p2b = s1b; }
                    }
                }
                const f32x4 ga = wv[0][0] * p2a + wv[1][0] * p1a + wv[2][0] * c0 + wv[3][0], gb = wv[0][1] * p2b + wv[1][1] * p1b + wv[2][1] * c1 + wv[3][1];
                const f32x4 va = acc[ai][1][m][0], vb = acc[ai][1][m][1];
                if (valid) {
                    u32x4 w;
                    const f32x2 h0 = gelu_mul2((f32x2){ga[0], ga[1]}, (f32x2){va[0], va[1]}), h1 = gelu_mul2((f32x2){ga[2], ga[3]}, (f32x2){va[2], va[3]});
                    const f32x2 h2 = gelu_mul2((f32x2){gb[0], gb[1]}, (f32x2){vb[0], vb[1]}), h3 = gelu_mul2((f32x2){gb[2], gb[3]}, (f32x2){vb[2], vb[3]});
                    w.x = cvt_pk_bf16(h0.x, h0.y); w.y = cvt_pk_bf16(h1.x, h1.y); w.z = cvt_pk_bf16(h2.x, h2.y); w.w = cvt_pk_bf16(h3.x, h3.y);
                    *(u32x4*)(hid + (size_t)r * DFF + f0) = w;
                    if constexpr (!PLAIN) {
                        const int T = is_s ? TS : TP;
                        if (t >= T - 2) { float* so = out + (is_s ? O_SFC : O_PFC) + ((size_t)seq * 2 + (t - (T - 2))) * DFF + f0; *(f32x4*)so = c0; *(f32x4*)(so + 4) = c1; }
                    }
                }
            }
            __builtin_amdgcn_sched_barrier(0);
        }
    }
    __device__ __forceinline__ void operator()(Acc& acc, const pg8::Unit& u, int wr, int wc, int fr, int fq) const {
        asm volatile("" : "+v"(fr), "+v"(fq));
        const int gbase = 252 * u.pm - 2 + 126 * wr;
        const int f0 = 128 * u.pn + 32 * wc + 8 * fq;
        const LAS float* wt = wtab + u.idx * 512 + 32 * wc + 8 * fq;
        f32x4 wv[4][2];
#pragma unroll
        for (int k = 0; k < 4; ++k) { wv[k][0] = *(const LAS f32x4*)(wt + 128 * k); wv[k][1] = *(const LAS f32x4*)(wt + 128 * k + 4); }
        const LAS float* rt = rstab + u.idx * 256 + wr * 128 + 4 * fr;
#pragma unroll
        for (int ai = 0; ai < 2; ++ai) {
            const f32x4 rs4 = *(const LAS f32x4*)(rt + 64 * ai);
#pragma unroll
            for (int m = 0; m < 4; ++m)
#pragma unroll
                for (int bj = 0; bj < 2; ++bj)
#pragma unroll
                    for (int n = 0; n < 2; ++n) acc[ai][bj][m][n] *= rs4[m];
        }
        const int lo = gbase, hi = gbase + 127;
        bool plain = hi < MPR && lo >= 0;
#pragma unroll
        for (int b2 = 0; b2 < NB; ++b2) { const int s0 = b2 * TP; if (lo <= s0 + 1 && hi >= s0) plain = false; if (lo <= s0 + TP - 1 && hi >= s0 + TP - 2) plain = false; }
        if (plain) body<true>(acc, u, wr, wc, fr, fq, gbase, f0, wv); else body<false>(acc, u, wr, wc, fr, fq, gbase, f0, wv);
    }
};
__device__ __forceinline__ void ffn_rstd_table(const float* ssq, const float* cw, const float* cb, LAS float* tab, LAS float* wtab, const pg8::StaticOrder& S) {
    const int tid = opaque_tid(), q = tid >> 1, half = tid & 1;
    pg8::Unit u;
    for (int i = 0; S.next(i, u); ++i) {
        { const int k = tid >> 7, c = tid & 127, f = 128 * u.pn + c; wtab[i * 512 + tid] = k < 3 ? cw[k * DFF + f] : cb[f]; }
        int r = 252 * u.pm - 2 + 126 * (q >> 7) + (q & 127); r = r < 0 ? 0 : (r >= M ? M - 1 : r);
        const float* sp = ssq + (size_t)r * 32 + 16 * half;
        const f32x4 a = *(const f32x4*)sp, b = *(const f32x4*)(sp + 4), c = *(const f32x4*)(sp + 8), d = *(const f32x4*)(sp + 12);
        float sm = (((a[0] + a[1]) + (a[2] + a[3])) + ((b[0] + b[1]) + (b[2] + b[3]))) + (((c[0] + c[1]) + (c[2] + c[3])) + ((d[0] + d[1]) + (d[2] + d[3])));
        sm += __shfl_xor(sm, 1);
        if (half == 0) tab[i * 256 + q] = __builtin_amdgcn_rsqf(sm * (1.0f / D) + EPS);
    }
}

__device__ __forceinline__ int invperm32(int q) { return 16 * ((q >> 2) & 1) + 4 * (q >> 3) + (q & 3); }
__device__ __forceinline__ void p0_transpose_item(const float* W, int K, int N, const float* kscale, bf16_t* WT, int mode, LAS float* scr, int item, int lane) {
    const int nblk = N / 32, kb = item / nblk, nb = item % nblk, k0 = 64 * kb, n0 = 32 * nb;
    float v[32];
    const float* src = W + (size_t)(k0 + (lane >> 5)) * N + n0 + (lane & 31);
#pragma unroll
    for (int i = 0; i < 32; ++i) v[i] = src[(size_t)(2 * i) * N];
#pragma unroll
    for (int i = 0; i < 32; ++i) scr[(2 * i + (lane >> 5)) * 33 + (lane & 31)] = v[i];
    asm volatile("s_waitcnt lgkmcnt(0)" ::: "memory");
    int rbase = n0;
    if (mode == 1) { const int bj = n0 >= DFF ? 1 : 0, f = n0 - bj * DFF; rbase = 256 * (f >> 7) + 128 * bj + (f & 96); }
    const int c = lane & 7;
    f32x4 ks0 = (f32x4){1.f, 1.f, 1.f, 1.f}, ks1 = ks0;
    if (kscale) { ks0 = *(const f32x4*)(kscale + k0 + 8 * c); ks1 = *(const f32x4*)(kscale + k0 + 8 * c + 4); }
#pragma unroll
    for (int j = 0; j < 4; ++j) { const int n = (lane >> 3) + 8 * j; const LAS float* sp = scr + (8 * c) * 33 + n;
        u32x4 o; o.x = cvt_pk_bf16(sp[0 * 33] * ks0[0], sp[1 * 33] * ks0[1]); o.y = cvt_pk_bf16(sp[2 * 33] * ks0[2], sp[3 * 33] * ks0[3]);
        o.z = cvt_pk_bf16(sp[4 * 33] * ks1[0], sp[5 * 33] * ks1[1]); o.w = cvt_pk_bf16(sp[6 * 33] * ks1[2], sp[7 * 33] * ks1[3]);
        *(u32x4*)(WT + (size_t)(rbase + (mode == 2 ? n : invperm32(n))) * K + k0 + 8 * c) = o; }
    asm volatile("s_waitcnt lgkmcnt(0)" ::: "memory");
}
constexpr int I_IN = (D / 64) * (DIN / 32), I_O = (DMIX / 64) * (D / 32), I_UP = (D / 64) * (2 * DFF / 32), I_DN = (DFF / 64) * (D / 32), I_G = 2 * NH * 8;
constexpr int IT_O = I_IN, IT_UP = IT_O + I_O, IT_DN = IT_UP + I_UP, IT_G = IT_DN + I_DN, IT_END = IT_G + I_G;
__device__ __forceinline__ void convert_items(PRef p, LAS unsigned char* lds, int rank, int nwaves, int lo, int hi) {
    const int tid_ = opaque_tid(), lane = tid_ & 63, wave = tid_ >> 6;
    unsigned char* ws = p.ws;
    LAS float* scr = (LAS float*)(lds + wave * 16384);
    for (int it = lo + rank; it < hi; it += nwaves) {
        int r = it;
        if (r < I_IN) { p0_transpose_item(p.w_in, D, DIN, p.g_mix, (bf16_t*)(ws + WS_WIN), 0, scr, r, lane); continue; } r -= I_IN;
        if (r < I_O) { p0_transpose_item(p.w_o, DMIX, D, nullptr, (bf16_t*)(ws + WS_WO), 0, scr, r, lane); continue; } r -= I_O;
        if (r < I_UP) { p0_transpose_item(p.w_up, D, 2 * DFF, p.g_ffn, (bf16_t*)(ws + WS_WUP), 1, scr, r, lane); continue; } r -= I_UP;
        if (r < I_DN) { p0_transpose_item(p.w_down, DFF, D, nullptr, (bf16_t*)(ws + WS_WDN), 0, scr, r, lane); continue; } r -= I_DN;
        { const int mat = r >> 3, sub = r & 7, gsel = mat / NH, n = mat % NH;
          p0_transpose_item((gsel ? p.w_gate_x : p.w_gate_a) + (size_t)n * 128 * 128, 128, 128, nullptr, (bf16_t*)(ws + WS_WG) + (size_t)mat * 128 * 128, 0, scr, sub, lane); }
    }
}
constexpr int P1_TAIL_WG0 = (888 % 256), P4_TAIL_WG0 = (296 % 256) * P4_SPLIT, IT_S1 = IT_O + 10600, IT_S2 = IT_S1 + 300, IT_S3 = IT_S2 + 2400;
__device__ __forceinline__ void phase0(PRef p, LAS unsigned char* lds, int G) {
    const int tid = opaque_tid(), lane = tid & 63, wave = tid >> 6;
    unsigned char* ws = p.ws;
    const int gw = blockIdx.x * 8 + wave, NGW = G * 8;
    convert_items(p, lds, gw, NGW, 0, IT_O);
    convert_items(p, lds, gw, NGW, IT_G, IT_END);
    { bf16_t* xb = (bf16_t*)(ws + WS_XB) + (size_t)16 * D; float* rstd1 = (float*)(ws + WS_RS1);
      for (int m = gw; m < M; m += NGW) {
          const f32x4* xr = (const f32x4*)x_row_ptr(p.x_prompt, p.x_sample, p.meta, m) + lane;
          f32x4 v[8]; float s = 0.f;
#pragma unroll
          for (int j = 0; j < 8; ++j) { v[j] = xr[64 * j]; s += (v[j][0] * v[j][0] + v[j][1] * v[j][1]) + (v[j][2] * v[j][2] + v[j][3] * v[j][3]); }
          s = wave_sum(s);
          if (lane == 0) rstd1[m] = __builtin_amdgcn_rsqf(s * (1.0f / D) + EPS);
          u32x2* o = (u32x2*)(xb + (size_t)m * D) + lane;
#pragma unroll
          for (int j = 0; j < 8; ++j) { u32x2 w; w.x = cvt_pk_bf16(v[j][0], v[j][1]); w.y = cvt_pk_bf16(v[j][2], v[j][3]); o[64 * j] = w; }
      } }
}

__device__ __forceinline__ void branch_b(PRef p, int G) {
    const bf16_t* z = (const bf16_t*)(p.ws + WS_Z); bf16_t* ym = (bf16_t*)(p.ws + WS_YM);
    const int total = (M / 4) * 128;
    for (int idx = blockIdx.x * 512 + opaque_tid(); idx < total; idx += G * 512) {
        const int m0 = (idx >> 7) * 4, g = idx & 127, ch = 8 * g;
        int is_s, seq, t0; row_decode(m0, is_s, seq, t0);
        u32x4 rc[6], rv[6], rg[4];
#pragma unroll
        for (int k = 0; k < 6; ++k) {
            const int mm = (t0 - 2 + k >= 0) ? m0 - 2 + k : m0;
            rc[k] = *(const u32x4*)(z + (size_t)mm * DIN + 4096 + ch); rv[k] = *(const u32x4*)(z + (size_t)mm * DIN + 5120 + ch);
        }
#pragma unroll
        for (int k = 0; k < 4; ++k) rg[k] = *(const u32x4*)(z + (size_t)(m0 + k) * DIN + 3072 + ch);
        const f32x4 w0a = *(const f32x4*)(p.conv_b_w + ch), w0b = *(const f32x4*)(p.conv_b_w + ch + 4), w1a = *(const f32x4*)(p.conv_b_w + DB + ch), w1b = *(const f32x4*)(p.conv_b_w + DB + ch + 4),
                    w2a = *(const f32x4*)(p.conv_b_w + 2 * DB + ch), w2b = *(const f32x4*)(p.conv_b_w + 2 * DB + ch + 4), goa = *(const f32x4*)(p.g_out_b + ch), gob = *(const f32x4*)(p.g_out_b + ch + 4);
        float u[6][8];
#pragma unroll
        for (int k = 0; k < 6; ++k) {
            float a[8], b[8]; unpack8(rc[k], a); unpack8(rv[k], b);
#pragma unroll
            for (int e = 0; e < 8; ++e) u[k][e] = a[e] * b[e];
        }
        if (t0 == 0) {
#pragma unroll
            for (int k = 0; k < 2; ++k) {
                f32x4 a = (f32x4){0.f, 0.f, 0.f, 0.f}, b = a;
                if (is_s) { const float* sp = p.st_sc + ((size_t)seq * 2 + k) * DB + ch; a = *(const f32x4*)sp; b = *(const f32x4*)(sp + 4); }
#pragma unroll
                for (int e = 0; e < 4; ++e) { u[k][e] = a[e]; u[k][4 + e] = b[e]; }
            }
        }
        const int T = is_s ? TS : TP;
#pragma unroll
        for (int k = 0; k < 4; ++k) {
            float gb[8]; unpack8(rg[k], gb);
            float y[8]; float ss = 0.f;
#pragma unroll
            for (int e = 0; e < 8; ++e) {
                const float uc = (e < 4 ? w0a[e & 3] : w0b[e & 3]) * u[k][e] + (e < 4 ? w1a[e & 3] : w1b[e & 3]) * u[k + 1][e] + (e < 4 ? w2a[e & 3] : w2b[e & 3]) * u[k + 2][e];
                y[e] = gb[e] * uc; ss += y[e] * y[e];
            }
            ss = sum16(ss);
            const float rn = __builtin_amdgcn_rsqf(ss * (1.0f / 128.0f) + EPS);
#pragma unroll
            for (int e = 0; e < 8; ++e) y[e] = y[e] * rn * (e < 4 ? goa[e & 3] : gob[e & 3]);
            *(u32x4*)(ym + (size_t)(m0 + k) * DMIX + DA + ch) = pack8(y);
            const int t = t0 + k;
            if (t >= T - 2) { float* so = p.out + (is_s ? O_SSC : O_PSC) + ((size_t)seq * 2 + (t - (T - 2))) * DB + ch;
                *(f32x4*)so = (f32x4){u[k + 2][0], u[k + 2][1], u[k + 2][2], u[k + 2][3]}; *(f32x4*)(so + 4) = (f32x4){u[k + 2][4], u[k + 2][5], u[k + 2][6], u[k + 2][7]}; }
        }
    }
}

constexpr int LW_STRIDE = 272, L_WA = 0, L_WX = 128 * LW_STRIDE, L_CT = 2 * 128 * LW_STRIDE, L_LRU_END = L_CT + 9 * 128 * 4;
static_assert(L_LRU_END <= 131072, "mixer LDS");
constexpr int LRU_WG_PER_HEAD = 21, LRU_NSEG = 33, LRU_PITEMS = NB * LRU_NSEG, LRU_SBLK = 2, LRU_SITEMS = MSR / (16 * LRU_SBLK);
constexpr int LRU_IDLE_J0 = (LRU_PITEMS + 7) / 8;
static_assert(LRU_WG_PER_HEAD * 8 >= LRU_PITEMS + LRU_SITEMS, "waves per head");

template <int CTRL, int BANK> __device__ __forceinline__ float dppfb(float old, float src) {
    return __builtin_bit_cast(float, __builtin_amdgcn_update_dpp(__builtin_bit_cast(int, old), __builtin_bit_cast(int, src), CTRL, 0xF, BANK, false));
}
__device__ __forceinline__ float bcast15(float x, int lane) {
    return __builtin_bit_cast(float, __builtin_amdgcn_ds_bpermute(((lane & 48) | 15) << 2, __builtin_bit_cast(int, x)));
}
__device__ __forceinline__ void scan16(float& P, float& S) {
    float Sd, Pd;
    Sd = dppf<0x111>(0.f, S); Pd = dppf<0x111>(1.f, P); S = __builtin_fmaf(P, Sd, S); P *= Pd;
    Sd = dppf<0x112>(0.f, S); Pd = dppf<0x112>(1.f, P); S = __builtin_fmaf(P, Sd, S); P *= Pd;
    Sd = dppf<0x114>(0.f, S); Pd = dppf<0x114>(1.f, P); S = __builtin_fmaf(P, Sd, S); P *= Pd;
    Sd = dppf<0x118>(0.f, S); Pd = dppf<0x118>(1.f, P); S = __builtin_fmaf(P, Sd, S); P *= Pd;
}
__device__ __forceinline__ void scan16x2(float& P1, float& S1, float& P2, float& S2) {
    asm volatile(
        "s_nop 1\n\t"
        "v_fmac_f32_dpp %1, %1, %0 row_shr:1 row_mask:0xf bank_mask:0xf bound_ctrl:1\n\t"
        "v_fmac_f32_dpp %3, %3, %2 row_shr:1 row_mask:0xf bank_mask:0xf bound_ctrl:1\n\t"
        "v_mul_f32_dpp %0, %0, %0 row_shr:1 row_mask:0xf bank_mask:0xf\n\t"
        "v_mul_f32_dpp %2, %2, %2 row_shr:1 row_mask:0xf bank_mask:0xf\n\t"
        "v_fmac_f32_dpp %1, %1, %0 row_shr:2 row_mask:0xf bank_mask:0xf bound_ctrl:1\n\t"
        "v_fmac_f32_dpp %3, %3, %2 row_shr:2 row_mask:0xf bank_mask:0xf bound_ctrl:1\n\t"
        "v_mul_f32_dpp %0, %0, %0 row_shr:2 row_mask:0xf bank_mask:0xf\n\t"
        "v_mul_f32_dpp %2, %2, %2 row_shr:2 row_mask:0xf bank_mask:0xf\n\t"
        "v_fmac_f32_dpp %1, %1, %0 row_shr:4 row_mask:0xf bank_mask:0xf bound_ctrl:1\n\t"
        "v_fmac_f32_dpp %3, %3, %2 row_shr:4 row_mask:0xf bank_mask:0xf bound_ctrl:1\n\t"
        "v_mul_f32_dpp %0, %0, %0 row_shr:4 row_mask:0xf bank_mask:0xf\n\t"
        "v_mul_f32_dpp %2, %2, %2 row_shr:4 row_mask:0xf bank_mask:0xf\n\t"
        "v_fmac_f32_dpp %1, %1, %0 row_shr:8 row_mask:0xf bank_mask:0xf bound_ctrl:1\n\t"
        "v_fmac_f32_dpp %3, %3, %2 row_shr:8 row_mask:0xf bank_mask:0xf bound_ctrl:1\n\t"
        "v_mul_f32_dpp %0, %0, %0 row_shr:8 row_mask:0xf bank_mask:0xf\n\t"
        "v_mul_f32_dpp %2, %2, %2 row_shr:8 row_mask:0xf bank_mask:0xf\n\t"
        "s_nop 0"
        : "+v"(P1), "+v"(S1), "+v"(P2), "+v"(S2));
}
__device__ __forceinline__ void scan8(float& P, float& S, int t) {
    float Sd, Pd;
    Sd = dppf<0x111>(0.f, S); Pd = dppf<0x111>(1.f, P); if (t < 1) { Sd = 0.f; Pd = 1.f; } S = __builtin_fmaf(P, Sd, S); P *= Pd;
    Sd = dppf<0x112>(0.f, S); Pd = dppf<0x112>(1.f, P); if (t < 2) { Sd = 0.f; Pd = 1.f; } S = __builtin_fmaf(P, Sd, S); P *= Pd;
    Sd = dppfb<0x114, 0xA>(0.f, S); Pd = dppfb<0x114, 0xA>(1.f, P); S = __builtin_fmaf(P, Sd, S); P *= Pd;
}

template <int PASS, bool IS_S>
__device__ __forceinline__ void lru_wave_item(PRef p, LAS unsigned char* lds, int n, int b, int seg) {
    const int lane = opaque_tid() & 63, fr = lane & 15, fq = lane >> 4;
    const bf16_t* z = (const bf16_t*)(p.ws + WS_Z);
    bf16_t* ym = (bf16_t*)(p.ws + WS_YM);
    float* tot = (float*)(p.ws + WS_TOT);
    const LAS float* CT = (const LAS float*)(lds + L_CT) + 8 * fq;
    const int gch = n * 128 + 8 * fq;
    const int r0 = IS_S ? MPR + b * (16 * LRU_SBLK) : b * TP + seg * 64;
    const int nblk = IS_S ? LRU_SBLK : (seg == LRU_NSEG - 1 ? 1 : 4);
    float hin[4][8], Pt[4][8];
    u32x4 prevx[4];
#pragma unroll
    for (int ks = 0; ks < 4; ++ks) {
#pragma unroll
        for (int e = 0; e < 8; ++e) { hin[ks][e] = 0.f; Pt[ks][e] = 1.f; }
        prevx[ks] = (u32x4){0u, 0u, 0u, 0u};
    }
    if constexpr (!IS_S) {
        if (seg > 0) {
#pragma unroll
            for (int ks = 0; ks < 4; ++ks) prevx[ks] = *(const u32x4*)(z + (size_t)(r0 - 16 + fr) * DIN + gch + 32 * ks);
            if constexpr (PASS == 2) {
#pragma unroll 1
                for (int round = 0; round < 2; ++round) {
                    const int s = 16 * round + fr;
                    if (16 * round >= seg) break;
                    const bool have = s < seg;
                    const float* tp = tot + ((size_t)(b * LRU_NSEG + (have ? s : 0)) * 2) * DA + gch;
#pragma unroll
                    for (int ks = 0; ks < 4; ++ks) {
                        const f32x4 P0 = *(const f32x4*)(tp + 32 * ks), P1 = *(const f32x4*)(tp + 32 * ks + 4), S0 = *(const f32x4*)(tp + DA + 32 * ks), S1 = *(const f32x4*)(tp + DA + 32 * ks + 4);
#pragma unroll
                        for (int e = 0; e < 8; e += 2) {
                            float Pa = have ? (e < 4 ? P0[e & 3] : P1[e & 3]) : 1.f, Sa = have ? (e < 4 ? S0[e & 3] : S1[e & 3]) : 0.f;
                            float Pb = have ? (e < 4 ? P0[(e + 1) & 3] : P1[(e + 1) & 3]) : 1.f, Sb = have ? (e < 4 ? S0[(e + 1) & 3] : S1[(e + 1) & 3]) : 0.f;
                            scan16x2(Pa, Sa, Pb, Sb);
                            hin[ks][e] = __builtin_fmaf(bcast15(Pa, lane), hin[ks][e], bcast15(Sa, lane));
                            hin[ks][e + 1] = __builtin_fmaf(bcast15(Pb, lane), hin[ks][e + 1], bcast15(Sb, lane));
                        }
                    }
                }
            }
        }
    }
    u32x4 xnext[4];
    if constexpr (!IS_S) {
#pragma unroll
        for (int ks = 0; ks < 4; ++ks) xnext[ks] = *(const u32x4*)(z + (size_t)(r0 + fr) * DIN + gch + 32 * ks);
    }
#pragma unroll 1
    for (int blk = 0; blk < nblk; ++blk) {
        const int r = r0 + 16 * blk + fr;
        const int t8 = fr & 7, sq = (r - MPR) >> 3;
        u32x4 x4[4], g4[4];
#pragma unroll
        for (int ks = 0; ks < 4; ++ks) { if constexpr (IS_S) x4[ks] = *(const u32x4*)(z + (size_t)r * DIN + gch + 32 * ks); else x4[ks] = xnext[ks];
            if constexpr (PASS == 2) g4[ks] = *(const u32x4*)(z + (size_t)r * DIN + DA + gch + 32 * ks); }
        if constexpr (!IS_S) { const int rn_ = (blk + 1 < nblk) ? r + 16 : r;
#pragma unroll
          for (int ks = 0; ks < 4; ++ks) xnext[ks] = *(const u32x4*)(z + (size_t)rn_ * DIN + gch + 32 * ks); }
        float xc[4][8];
        bf16x8 bfrag[4];
#pragma unroll
        for (int ks = 0; ks < 4; ++ks) {
            float xf[8]; unpack8(x4[ks], xf);
            const f32x4 w0a = *(const LAS f32x4*)(CT + 0 * 128 + 32 * ks), w0b = *(const LAS f32x4*)(CT + 0 * 128 + 32 * ks + 4);
            const f32x4 w1a = *(const LAS f32x4*)(CT + 1 * 128 + 32 * ks), w1b = *(const LAS f32x4*)(CT + 1 * 128 + 32 * ks + 4);
            const f32x4 w2a = *(const LAS f32x4*)(CT + 2 * 128 + 32 * ks), w2b = *(const LAS f32x4*)(CT + 2 * 128 + 32 * ks + 4);
            const f32x4 w3a = *(const LAS f32x4*)(CT + 3 * 128 + 32 * ks), w3b = *(const LAS f32x4*)(CT + 3 * 128 + 32 * ks + 4);
            const f32x4 cba = *(const LAS f32x4*)(CT + 4 * 128 + 32 * ks), cbb = *(const LAS f32x4*)(CT + 4 * 128 + 32 * ks + 4);
            if constexpr (IS_S) {
                const float* sp = p.st_rc + (size_t)sq * 3 * DA + gch + 32 * ks;
                const f32x4 b0a = *(const f32x4*)sp, b0b = *(const f32x4*)(sp + 4), b1a = *(const f32x4*)(sp + DA), b1b = *(const f32x4*)(sp + DA + 4), b2a = *(const f32x4*)(sp + 2 * DA), b2b = *(const f32x4*)(sp + 2 * DA + 4);
#pragma unroll
                for (int e = 0; e < 8; ++e) {
                    const float bb0 = e < 4 ? b0a[e & 3] : b0b[e & 3], bb1 = e < 4 ? b1a[e & 3] : b1b[e & 3], bb2 = e < 4 ? b2a[e & 3] : b2b[e & 3];
                    const float s1 = dppf<0x111>(0.f, xf[e]), s2 = dppf<0x112>(0.f, xf[e]), s3 = dppf<0x113>(0.f, xf[e]);
                    const float x1 = t8 >= 1 ? s1 : bb2;
                    const float x2 = t8 >= 2 ? s2 : (t8 == 1 ? bb2 : bb1);
                    const float x3 = t8 >= 3 ? s3 : (t8 == 2 ? bb2 : (t8 == 1 ? bb1 : bb0));
                    const float w0 = e < 4 ? w0a[e & 3] : w0b[e & 3], w1 = e < 4 ? w1a[e & 3] : w1b[e & 3], w2 = e < 4 ? w2a[e & 3] : w2b[e & 3], w3 = e < 4 ? w3a[e & 3] : w3b[e & 3];
                    xc[ks][e] = (e < 4 ? cba[e & 3] : cbb[e & 3]) + w3 * xf[e] + w2 * x1 + w1 * x2 + w0 * x3;
                }
            } else {
                float pf[8]; unpack8(prevx[ks], pf);
#pragma unroll
                for (int e = 0; e < 8; e += 2) {
                    f32x2 x0, x1, x2, x3;
#pragma unroll
                    for (int q = 0; q < 2; ++q) {
                        x0[q] = xf[e + q];
                        x1[q] = dppf<0x111>(dppf<0x121>(0.f, pf[e + q]), xf[e + q]);
                        x2[q] = dppf<0x112>(dppf<0x122>(0.f, pf[e + q]), xf[e + q]);
                        x3[q] = dppf<0x113>(dppf<0x123>(0.f, pf[e + q]), xf[e + q]);
                    }
                    const int c = e & 3;
                    const f32x2 w0 = e < 4 ? (f32x2){w0a[c], w0a[c + 1]} : (f32x2){w0b[c], w0b[c + 1]}, w1 = e < 4 ? (f32x2){w1a[c], w1a[c + 1]} : (f32x2){w1b[c], w1b[c + 1]};
                    const f32x2 w2 = e < 4 ? (f32x2){w2a[c], w2a[c + 1]} : (f32x2){w2b[c], w2b[c + 1]}, w3 = e < 4 ? (f32x2){w3a[c], w3a[c + 1]} : (f32x2){w3b[c], w3b[c + 1]};
                    const f32x2 cbv = e < 4 ? (f32x2){cba[c], cba[c + 1]} : (f32x2){cbb[c], cbb[c + 1]};
                    const f32x2 r = cbv + w3 * x0 + w2 * x1 + w1 * x2 + w0 * x3;
                    xc[ks][e] = r.x; xc[ks][e + 1] = r.y;
                }
                prevx[ks] = x4[ks];
            }
            bfrag[ks] = __builtin_bit_cast(bf16x8, pack8(xc[ks]));
            if constexpr (IS_S) __builtin_amdgcn_sched_barrier(0);
        }
        f32x4 aa[8], ax[8];
#pragma unroll
        for (int nb = 0; nb < 8; ++nb) { aa[nb] = (f32x4){0.f, 0.f, 0.f, 0.f}; ax[nb] = (f32x4){0.f, 0.f, 0.f, 0.f}; }
#pragma unroll
        for (int ks = 0; ks < 4; ++ks)
#pragma unroll
            for (int nb = 0; nb < 8; ++nb) {
                const bf16x8 wa = *(const LAS bf16x8*)(lds + L_WA + (16 * nb + fr) * LW_STRIDE + (32 * ks + 8 * fq) * 2);
                const bf16x8 wx = *(const LAS bf16x8*)(lds + L_WX + (16 * nb + fr) * LW_STRIDE + (32 * ks + 8 * fq) * 2);
                aa[nb] = __builtin_amdgcn_mfma_f32_16x16x32_bf16(wa, bfrag[ks], aa[nb], 0, 0, 0);
                ax[nb] = __builtin_amdgcn_mfma_f32_16x16x32_bf16(wx, bfrag[ks], ax[nb], 0, 0, 0);
            }
        float y[4][8]; float ss = 0.f;
#pragma unroll
        for (int ks = 0; ks < 4; ++ks) {
            const f32x4 bga0 = *(const LAS f32x4*)(CT + 5 * 128 + 32 * ks), bga1 = *(const LAS f32x4*)(CT + 5 * 128 + 32 * ks + 4);
            const f32x4 bgx0 = *(const LAS f32x4*)(CT + 6 * 128 + 32 * ks), bgx1 = *(const LAS f32x4*)(CT + 6 * 128 + 32 * ks + 4);
            const f32x4 sp0 = *(const LAS f32x4*)(CT + 7 * 128 + 32 * ks), sp1 = *(const LAS f32x4*)(CT + 7 * 128 + 32 * ks + 4);
            float gav[8];
            if constexpr (PASS == 2) unpack8(g4[ks], gav);
            f32x4 h0a, h0b;
            if constexpr (IS_S) { const float* hp = p.st_h + (size_t)sq * DA + gch + 32 * ks; h0a = *(const f32x4*)hp; h0b = *(const f32x4*)(hp + 4); }
            float hv[8], Pv[8], Sv[8], lav[8];
#pragma unroll
            for (int e = 0; e < 8; e += 2) {
                const int nb = 2 * ks + (e >> 2), rg = e & 3;
                const f32x2 ba = e < 4 ? (f32x2){bga0[rg], bga0[rg + 1]} : (f32x2){bga1[rg], bga1[rg + 1]}, bx = e < 4 ? (f32x2){bgx0[rg], bgx0[rg + 1]} : (f32x2){bgx1[rg], bgx1[rg + 1]};
                const f32x2 spv = e < 4 ? (f32x2){sp0[rg], sp0[rg + 1]} : (f32x2){sp1[rg], sp1[rg + 1]};
                const f32x2 ta = (f32x2){aa[nb][rg], aa[nb][rg + 1]} * -1.4426950408889634f + ba, tx = (f32x2){ax[nb][rg], ax[nb][rg + 1]} * -1.4426950408889634f + bx;
                f32x2 ea, ex; ea.x = __builtin_amdgcn_exp2f(ta.x); ea.y = __builtin_amdgcn_exp2f(ta.y); ex.x = __builtin_amdgcn_exp2f(tx.x); ex.y = __builtin_amdgcn_exp2f(tx.y);
                ea = ea + 1.0f; ex = ex + 1.0f;
                f32x2 rr, ii; rr.x = __builtin_amdgcn_rcpf(ea.x); rr.y = __builtin_amdgcn_rcpf(ea.y); ii.x = __builtin_amdgcn_rcpf(ex.x); ii.y = __builtin_amdgcn_rcpf(ex.y);
                const f32x2 la = rr * spv;
                f32x2 a; a.x = __builtin_amdgcn_exp2f(la.x); a.y = __builtin_amdgcn_exp2f(la.y);
                const f32x2 om = 1.0f - a * a;
                f32x2 sq; sq.x = __builtin_amdgcn_sqrtf(om.x > 0.f ? om.x : 0.f); sq.y = __builtin_amdgcn_sqrtf(om.y > 0.f ? om.y : 0.f);
                const f32x2 uu = sq * (ii * (f32x2){xc[ks][e], xc[ks][e + 1]});
                Pv[e] = a.x; Pv[e + 1] = a.y; Sv[e] = uu.x; Sv[e + 1] = uu.y; lav[e] = la.x; lav[e + 1] = la.y;
            }
            if constexpr (PASS == 1 && !IS_S) {
                *(u32x4*)((bf16_t*)(p.ws + WS_LA) + (size_t)r * DA + gch + 32 * ks) = pack8(lav);
                *(u32x4*)((bf16_t*)(p.ws + WS_UU) + (size_t)r * DA + gch + 32 * ks) = pack8(Sv);
            }
            if constexpr (IS_S) {
#pragma unroll
                for (int e = 0; e < 8; ++e) { scan8(Pv[e], Sv[e], t8); hv[e] = __builtin_fmaf(Pv[e], e < 4 ? h0a[e & 3] : h0b[e & 3], Sv[e]); }
            } else {
#pragma unroll
                for (int e = 0; e < 8; e += 2) scan16x2(Pv[e], Sv[e], Pv[e + 1], Sv[e + 1]);
#pragma unroll
                for (int e = 0; e < 8; ++e) {
                    hv[e] = __builtin_fmaf(Pv[e], hin[ks][e], Sv[e]);
                    hin[ks][e] = bcast15(hv[e], lane);
                    if constexpr (PASS == 1) Pt[ks][e] *= bcast15(Pv[e], lane);
                }
            }
            if constexpr (PASS == 2) {
#pragma unroll
                for (int e = 0; e < 8; e += 2) { const f32x2 yy = gelu_mul2((f32x2){gav[e], gav[e + 1]}, (f32x2){hv[e], hv[e + 1]}); y[ks][e] = yy.x; y[ks][e + 1] = yy.y; ss += yy.x * yy.x + yy.y * yy.y; }
            }
            if constexpr (PASS == 2) {
                if (IS_S ? (t8 == 7) : (seg == LRU_NSEG - 1 && fr == 15)) {
                    float* ho = p.out + (IS_S ? O_SH + (size_t)sq * DA : O_PH + (size_t)b * DA) + gch + 32 * ks;
                    *(f32x4*)ho = (f32x4){hv[0], hv[1], hv[2], hv[3]}; *(f32x4*)(ho + 4) = (f32x4){hv[4], hv[5], hv[6], hv[7]};
                }
            }
        }
        if constexpr (PASS == 2) {
            ss += __shfl_xor(ss, 16); ss += __shfl_xor(ss, 32);
            const float rn = __builtin_amdgcn_rsqf(ss * (1.0f / 128.0f) + EPS);
#pragma unroll
            for (int ks = 0; ks < 4; ++ks) {
                const f32x4 g0 = *(const LAS f32x4*)(CT + 8 * 128 + 32 * ks), g1 = *(const LAS f32x4*)(CT + 8 * 128 + 32 * ks + 4);
                float o[8];
#pragma unroll
                for (int e = 0; e < 8; ++e) o[e] = y[ks][e] * rn * (e < 4 ? g0[e & 3] : g1[e & 3]);
                *(u32x4*)(ym + (size_t)r * DMIX + gch + 32 * ks) = pack8(o);
            }
        }
    }
    if constexpr (PASS == 1 && !IS_S) {
        if (fr == 0) {
            float* tp = tot + ((size_t)(b * LRU_NSEG + seg) * 2) * DA + gch;
#pragma unroll
            for (int ks = 0; ks < 4; ++ks) {
                *(f32x4*)(tp + 32 * ks) = (f32x4){Pt[ks][0], Pt[ks][1], Pt[ks][2], Pt[ks][3]}; *(f32x4*)(tp + 32 * ks + 4) = (f32x4){Pt[ks][4], Pt[ks][5], Pt[ks][6], Pt[ks][7]};
                *(f32x4*)(tp + DA + 32 * ks) = (f32x4){hin[ks][0], hin[ks][1], hin[ks][2], hin[ks][3]}; *(f32x4*)(tp + DA + 32 * ks + 4) = (f32x4){hin[ks][4], hin[ks][5], hin[ks][6], hin[ks][7]};
            }
        }
    }
}

__device__ __forceinline__ void lru_finish_item(PRef p, LAS unsigned char* lds, int n, int b, int seg) {
    const int lane = opaque_tid() & 63, fr = lane & 15, fq = lane >> 4;
    const bf16_t* z = (const bf16_t*)(p.ws + WS_Z);
    const bf16_t* lab = (const bf16_t*)(p.ws + WS_LA); const bf16_t* uub = (const bf16_t*)(p.ws + WS_UU);
    bf16_t* ym = (bf16_t*)(p.ws + WS_YM);
    const float* tot = (const float*)(p.ws + WS_TOT);
    const LAS float* CT = (const LAS float*)(lds + L_CT) + 8 * fq;
    const int gch = n * 128 + 8 * fq;
    const int r0 = b * TP + seg * 64;
    const int nblk = seg == LRU_NSEG - 1 ? 1 : 4;
    float hin[4][8];
#pragma unroll
    for (int ks = 0; ks < 4; ++ks)
#pragma unroll
        for (int e = 0; e < 8; ++e) hin[ks][e] = 0.f;
    u32x4 ln[4], un[4], gn[4];
#pragma unroll
    for (int ks = 0; ks < 4; ++ks) { ln[ks] = *(const u32x4*)(lab + (size_t)(r0 + fr) * DA + gch + 32 * ks); un[ks] = *(const u32x4*)(uub + (size_t)(r0 + fr) * DA + gch + 32 * ks);
        gn[ks] = *(const u32x4*)(z + (size_t)(r0 + fr) * DIN + DA + gch + 32 * ks); }
    if (seg > 0) {
#pragma unroll 1
        for (int round = 0; round < 2; ++round) {
            const int s = 16 * round + fr;
            if (16 * round >= seg) break;
            const bool have = s < seg;
            const float* tp = tot + ((size_t)(b * LRU_NSEG + (have ? s : 0)) * 2) * DA + gch;
#pragma unroll
            for (int ks = 0; ks < 4; ++ks) {
                const f32x4 P0 = *(const f32x4*)(tp + 32 * ks), P1 = *(const f32x4*)(tp + 32 * ks + 4), S0 = *(const f32x4*)(tp + DA + 32 * ks), S1 = *(const f32x4*)(tp + DA + 32 * ks + 4);
#pragma unroll
                for (int e = 0; e < 8; e += 2) {
                    float Pa = have ? (e < 4 ? P0[e & 3] : P1[e & 3]) : 1.f, Sa = have ? (e < 4 ? S0[e & 3] : S1[e & 3]) : 0.f;
                    float Pb = have ? (e < 4 ? P0[(e + 1) & 3] : P1[(e + 1) & 3]) : 1.f, Sb = have ? (e < 4 ? S0[(e + 1) & 3] : S1[(e + 1) & 3]) : 0.f;
                    scan16x2(Pa, Sa, Pb, Sb);
                    hin[ks][e] = __builtin_fmaf(bcast15(Pa, lane), hin[ks][e], bcast15(Sa, lane));
                    hin[ks][e + 1] = __builtin_fmaf(bcast15(Pb, lane), hin[ks][e + 1], bcast15(Sb, lane));
                }
            }
        }
    }
#pragma unroll 1
    for (int blk = 0; blk < nblk; ++blk) {
        const int r = r0 + 16 * blk + fr;
        u32x4 l4[4], u4[4], g4[4];
#pragma unroll
        for (int ks = 0; ks < 4; ++ks) { l4[ks] = ln[ks]; u4[ks] = un[ks]; g4[ks] = gn[ks]; }
        { const int rn_ = (blk + 1 < nblk) ? r + 16 : r;
#pragma unroll
          for (int ks = 0; ks < 4; ++ks) { ln[ks] = *(const u32x4*)(lab + (size_t)rn_ * DA + gch + 32 * ks); un[ks] = *(const u32x4*)(uub + (size_t)rn_ * DA + gch + 32 * ks);
              gn[ks] = *(const u32x4*)(z + (size_t)rn_ * DIN + DA + gch + 32 * ks); } }
        float y[4][8]; float ss = 0.f;
#pragma unroll
        for (int ks = 0; ks < 4; ++ks) {
            float Pv[8], Sv[8], gav[8], hv[8];
            unpack8(l4[ks], Pv); unpack8(u4[ks], Sv); unpack8(g4[ks], gav);
#pragma unroll
            for (int e = 0; e < 8; ++e) Pv[e] = __builtin_amdgcn_exp2f(Pv[e]);
#pragma unroll
            for (int e = 0; e < 8; e += 2) scan16x2(Pv[e], Sv[e], Pv[e + 1], Sv[e + 1]);
#pragma unroll
            for (int e = 0; e < 8; ++e) { hv[e] = __builtin_fmaf(Pv[e], hin[ks][e], Sv[e]); hin[ks][e] = bcast15(hv[e], lane); }
#pragma unroll
            for (int e = 0; e < 8; e += 2) { const f32x2 yy = gelu_mul2((f32x2){gav[e], gav[e + 1]}, (f32x2){hv[e], hv[e + 1]}); y[ks][e] = yy.x; y[ks][e + 1] = yy.y; ss += yy.x * yy.x + yy.y * yy.y; }
            if (seg == LRU_NSEG - 1 && fr == 15) {
                float* ho = p.out + O_PH + (size_t)b * DA + gch + 32 * ks;
                *(f32x4*)ho = (f32x4){hv[0], hv[1], hv[2], hv[3]}; *(f32x4*)(ho + 4) = (f32x4){hv[4], hv[5], hv[6], hv[7]};
            }
        }
        ss += __shfl_xor(ss, 16); ss += __shfl_xor(ss, 32);
        const float rn = __builtin_amdgcn_rsqf(ss * (1.0f / 128.0f) + EPS);
#pragma unroll
        for (int ks = 0; ks < 4; ++ks) {
            const f32x4 g0 = *(const LAS f32x4*)(CT + 8 * 128 + 32 * ks), g1 = *(const LAS f32x4*)(CT + 8 * 128 + 32 * ks + 4);
            float o[8];
#pragma unroll
            for (int e = 0; e < 8; ++e) o[e] = y[ks][e] * rn * (e < 4 ? g0[e & 3] : g1[e & 3]);
            *(u32x4*)(ym + (size_t)r * DMIX + gch + 32 * ks) = pack8(o);
        }
    }
}
template <int PASS>
__device__ __forceinline__ void mixer_phase(PRef p, LAS unsigned char* lds, int G) {
    const int tid = opaque_tid(), wave = __builtin_amdgcn_readfirstlane(tid >> 6);
    static_assert(NH * LRU_WG_PER_HEAD <= GRID, "one head group per workgroup");
    const int v = blockIdx.x, n = v / LRU_WG_PER_HEAD, jg = v % LRU_WG_PER_HEAD;
    const bool lru_wg = v < NH * LRU_WG_PER_HEAD && (PASS == 1 || jg < LRU_IDLE_J0);
    if (lru_wg) {
        __syncthreads();
        if (!(PASS == 2 && G == GRID && p.ph_lo <= 2))
        {
            const bf16_t* wg = (const bf16_t*)(p.ws + WS_WG);
            for (int i = tid; i < 2 * 128 * 16; i += 512) { const int g = i >> 11, row = (i >> 4) & 127, c16 = i & 15;
                *(LAS u32x4*)(lds + g * L_WX + row * LW_STRIDE + c16 * 16) = *(const u32x4*)(wg + (((size_t)g * NH + n) * 128 + row) * 128 + c16 * 8); }
            LAS float* CTw = (LAS float*)(lds + L_CT);
            for (int i = tid; i < 9 * 128; i += 512) { const int k = i >> 7, c = i & 127, ch = n * 128 + c;
                float vv;
                if (k < 4) vv = p.conv_a_w[k * DA + ch]; else if (k == 4) vv = p.conv_a_b[ch]; else if (k == 5) vv = -1.4426950408889634f * p.b_gate_a[ch]; else if (k == 6) vv = -1.4426950408889634f * p.b_gate_x[ch];
                else if (k == 7) vv = -8.0f * 1.4426950408889634f * log1pf(__expf(-p.lam[ch])); else vv = p.g_out_a[ch];
                CTw[i] = vv; }
        }
        __syncthreads();
        const int wi = jg * 8 + wave;
        if (wi < LRU_PITEMS) { if constexpr (PASS == 1) lru_wave_item<1, false>(p, lds, n, wi / LRU_NSEG, wi % LRU_NSEG); else lru_finish_item(p, lds, n, wi / LRU_NSEG, wi % LRU_NSEG); }
        else if (PASS == 1 && wi < LRU_PITEMS + LRU_SITEMS) lru_wave_item<2, true>(p, lds, n, wi - LRU_PITEMS, 0);
    } else if (G == GRID) {
        constexpr int NIDLE1 = GRID - NH * LRU_WG_PER_HEAD, PER_HEAD = LRU_WG_PER_HEAD - LRU_IDLE_J0, NIDLE2 = NIDLE1 + NH * PER_HEAD;
        const int idx = v >= NH * LRU_WG_PER_HEAD ? v - NH * LRU_WG_PER_HEAD : NIDLE1 + n * PER_HEAD + (jg - LRU_IDLE_J0);
        convert_items(p, lds, idx * 8 + wave, (PASS == 1 ? NIDLE1 : NIDLE2) * 8, PASS == 1 ? IT_S1 : IT_S2, PASS == 1 ? IT_S2 : IT_S3);
    }
    if (PASS == 1) { branch_b(p, G); if ((REP_MASK >> 11) & 1) branch_b(p, G); }
}

__device__ __forceinline__ void final_phase(PRef p, int G) {
    const int tid_ = opaque_tid(), lane = tid_ & 63, gw = blockIdx.x * 8 + (tid_ >> 6), NGW = G * 8;
    const bf16_t* x2b = (const bf16_t*)(p.ws + WS_YM);
    f32x4 gf[8];
#pragma unroll
    for (int j = 0; j < 8; ++j) gf[j] = ((const f32x4*)p.g_final)[lane + 64 * j];
    for (int o = gw; o < NB * SEQ + MSR; o += NGW) {
        const int r = o < NB * SEQ ? (o / SEQ) * TP + NMETA + (o % SEQ) : MPR + (o - NB * SEQ);
        const u32x2* xr = (const u32x2*)(x2b + (size_t)r * D) + lane;
        f32x4 v[8]; float s = 0.f;
#pragma unroll
        for (int j = 0; j < 8; ++j) { const u32x2 w = xr[64 * j]; v[j] = (f32x4){bf_lo(w.x), bf_hi(w.x), bf_lo(w.y), bf_hi(w.y)};
            s += (v[j][0] * v[j][0] + v[j][1] * v[j][1]) + (v[j][2] * v[j][2] + v[j][3] * v[j][3]); }
        s = wave_sum(s);
        const float rs = __builtin_amdgcn_rsqf(s * (1.0f / D) + EPS);
        f32x4* yo = (f32x4*)(p.out + (size_t)o * D) + lane;
#pragma unroll
        for (int j = 0; j < 8; ++j) yo[64 * j] = v[j] * rs * gf[j];
    }
}

#define XB_TMO      128
#define XB_XCNT(j)  (256  + 64 * (j))
#define XB_XSUB(j)  (1280 + 64 * (j))
#define XB_XGEN(j)  (2304 + 64 * (j))
#define XB_TOP      3328
#define XB_TOPGEN   3392
#define XCD_BAR_WORDS 3456
#define XB_SPIN_CAP (1u << 18)
__device__ __forceinline__ unsigned xb_ld(unsigned* p)              { return __hip_atomic_load(p, __ATOMIC_RELAXED, __HIP_MEMORY_SCOPE_AGENT); }
__device__ __forceinline__ unsigned xb_add(unsigned* p, unsigned v) { return __hip_atomic_fetch_add(p, v, __ATOMIC_RELAXED, __HIP_MEMORY_SCOPE_AGENT); }
__device__ __forceinline__ unsigned xb_xcc_id() { return (unsigned)__builtin_amdgcn_s_getreg((3 << 11) | 20) & 0xFu; }
#define XB_SPIN(cond, bar) do { unsigned _sp = 0; while (cond) { __builtin_amdgcn_s_sleep(1); \
    if ((++_sp & 255u) == 0u) { if (xb_ld(&(bar)[XB_TMO])) break; if (_sp > XB_SPIN_CAP) { atomicAdd(&(bar)[XB_TMO], 1u); break; } } } } while (0)
struct XcdBarrier { unsigned* bar; unsigned x; volatile LAS unsigned* st; };
__device__ __forceinline__ XcdBarrier xcd_barrier_post(unsigned* bar, volatile LAS unsigned* st) {
    XcdBarrier b; b.bar = bar; b.x = xb_xcc_id(); b.st = st;
    if (threadIdx.x == 0) (void)xb_add(&bar[XB_XCNT(b.x)], 1u);
    return b;
}
__device__ __forceinline__ void xcd_barrier_complete(unsigned* bar, unsigned x, unsigned& nloc, unsigned& nx) {
    const unsigned G = gridDim.x * gridDim.y * gridDim.z;
    unsigned sum, cnt, mine, sp = 0u;
    for (;;) {
        sum = 0u; cnt = 0u; mine = 0u;
#pragma unroll
        for (unsigned j = 0; j < 16; ++j) { const unsigned c = xb_ld(&bar[XB_XCNT(j)]); sum += c; cnt += (c > 0u) ? 1u : 0u; mine = (j == x) ? c : mine; }
        if (sum == G) break;
        __builtin_amdgcn_s_sleep(1);
        if ((++sp & 255u) == 0u) { if (xb_ld(&bar[XB_TMO])) break; if (sp > XB_SPIN_CAP) { atomicAdd(&bar[XB_TMO], 1u); break; } }
    }
    nloc = mine > 0u ? mine : 1u; nx = cnt > 0u ? cnt : 1u;
}
__device__ __forceinline__ void xcd_barrier(const XcdBarrier& b) {
    asm volatile("s_waitcnt vmcnt(0)" ::: "memory");
    __syncthreads();
    if (threadIdx.x == 0) {
        unsigned* bar = b.bar;
        __builtin_amdgcn_s_waitcnt(0);
        unsigned nloc = b.st[0], nx = b.st[1];
        if (nloc == 0u) { xcd_barrier_complete(bar, b.x, nloc, nx); b.st[0] = nloc; b.st[1] = nx; }
        const unsigned old = xb_add(&bar[XB_XSUB(b.x)], 1u);
        const unsigned gen = old / nloc;
        if (old + 1u == (gen + 1u) * nloc) {
            __builtin_amdgcn_fence(__ATOMIC_RELEASE, "agent");
            asm volatile("s_waitcnt vmcnt(0)" ::: "memory");
            const unsigned og = xb_add(&bar[XB_TOP], 1u);
            const unsigned tg = og / nx;
            if (og + 1u == (tg + 1u) * nx) xb_add(&bar[XB_TOPGEN], 1u);
            else XB_SPIN(xb_ld(&bar[XB_TOPGEN]) == tg, bar);
            __builtin_amdgcn_fence(__ATOMIC_ACQUIRE, "agent");
            xb_add(&bar[XB_XGEN(b.x)], 1u);
            asm volatile("s_waitcnt vmcnt(0)" ::: "memory");
        } else {
            XB_SPIN(xb_ld(&bar[XB_XGEN(b.x)]) == gen, bar);
            __builtin_amdgcn_fence(__ATOMIC_ACQUIRE, "agent");
            asm volatile("s_waitcnt vmcnt(0)" ::: "memory");
        }
    }
    __syncthreads();
}

constexpr int LDS_BYTES = 131072 + 1024 + 8 * 1024 + 8 * 2048;
constexpr int N_PHASES = 8;
__global__ void __launch_bounds__(512, 2) hymba_fwd(Params p) {
    extern __shared__ __attribute__((aligned(16))) unsigned char lds_raw[];
    LAS unsigned char* lds = (LAS unsigned char*)lds_raw;
    constexpr int G = GRID;
    if ((int)gridDim.x != GRID) return;
    const CAS Params* kp = (const CAS Params*)__builtin_amdgcn_kernarg_segment_ptr();
#define P_HERE (*({ const CAS Params* q_ = kp; asm volatile("" : "+s"(q_)); q_; }))
    unsigned char* ws = p.ws;
    volatile LAS unsigned* misc = (volatile LAS unsigned*)(lds + 131072);
    if (threadIdx.x < 8) misc[threadIdx.x] = 0u;
    __syncthreads();
    XcdBarrier bar = xcd_barrier_post((unsigned*)ws, misc);
    const int lo = p.ph_lo, hi = p.ph_hi;
#ifndef PH_MASK
#define PH_MASK 0xff
#endif
#define IN(k) (((PH_MASK >> (k)) & 1) && lo <= (k) && (k) < hi)
#define SEAM(k) do { if (IN(k) && IN((k) + 1)) xcd_barrier(bar); } while (0)
#define REPEAT(k) _Pragma("nounroll") for (int rep_ = 0; rep_ < ((((REP_MASK) >> (k)) & 1) ? 2 : 1); ++rep_, (rep_ < ((((REP_MASK) >> (k)) & 1) ? 2 : 1) ? xcd_barrier(bar) : (void)0))
    if ((REP_MASK >> 12) & 1) { xcd_barrier(bar); xcd_barrier(bar); xcd_barrier(bar); xcd_barrier(bar); }
    if (IN(0)) REPEAT(0) phase0(P_HERE, lds, G);
    SEAM(0);
    if (IN(1)) REPEAT(1) {
        pg8::Gemm g{(const bf16_t*)(ws + WS_XB) + (size_t)16 * D, (const bf16_t*)(ws + WS_WIN), MP / 256, DIN / 256, D, (size_t)256 * D * 2, (size_t)128 * D * 2};
        pg8::StaticOrder S; S.init(g.nM, g.nN, G, (int)blockIdx.x, D / 64, 1);
        LAS float* rstab1 = (LAS float*)(lds + 131072 + 1024);
        rstd1_table((const float*)(ws + WS_RS1), rstab1, S); __syncthreads();
        PRef q = P_HERE; EpiZ E{rstab1, (bf16_t*)(ws + WS_Z), q.out};
        pg8::gemm_phase<EpiZ, false, true, true>(lds, g, S, E, nullptr, nullptr);
        if ((int)blockIdx.x >= P1_TAIL_WG0 && G == 256) convert_items(P_HERE, lds, ((int)blockIdx.x - P1_TAIL_WG0) * 8 + (opaque_tid() >> 6), (G - P1_TAIL_WG0) * 8, IT_O, IT_S1);
        else if (G != 256) convert_items(P_HERE, lds, (int)blockIdx.x * 8 + (opaque_tid() >> 6), G * 8, IT_O, IT_S3);
    }
    SEAM(1);
    if (IN(2)) REPEAT(2) mixer_phase<1>(P_HERE, lds, G);
    SEAM(2);
    if (IN(3)) REPEAT(3) mixer_phase<2>(P_HERE, lds, G);
    SEAM(3);
    if (IN(4)) REPEAT(4) {
        pg8::Gemm g{(const bf16_t*)(ws + WS_YM), (const bf16_t*)(ws + WS_WO), MP / 256, D / 256, DMIX, (size_t)256 * DMIX * 2, (size_t)128 * DMIX * 2};
        pg8::StaticOrder S; S.init(g.nM, g.nN, G, (int)blockIdx.x, DMIX / 64, P4_SPLIT);
        EpiX1 E{(bf16_t*)(ws + WS_XB) + (size_t)16 * D, (float*)(ws + WS_SSQ)};
        pg8::gemm_phase<EpiX1, false, true, true>(lds, g, S, E, (float*)(ws + WS_Z), (unsigned*)ws + CW_TK4 + rep_ * 128 * 64);
        if ((int)blockIdx.x >= P4_TAIL_WG0 && G == 256) convert_items(P_HERE, lds, ((int)blockIdx.x - P4_TAIL_WG0) * 8 + (opaque_tid() >> 6), (G - P4_TAIL_WG0) * 8, IT_S3, IT_G);
        else if (G != 256) convert_items(P_HERE, lds, (int)blockIdx.x * 8 + (opaque_tid() >> 6), G * 8, IT_S3, IT_G);
    }
    SEAM(4);
    if (IN(5)) REPEAT(5) {
        pg8::Gemm g{(const bf16_t*)(ws + WS_XB) + (size_t)14 * D, (const bf16_t*)(ws + WS_WUP), 37, 2 * DFF / 256, D, (size_t)252 * D * 2, (size_t)64 * D * 2};
        pg8::StaticOrder S; S.init(g.nM, g.nN, G, (int)blockIdx.x, D / 64, 1);
        LAS float* rstab = (LAS float*)(lds + 131072 + 1024); LAS float* wtab = rstab + 8 * 256;
        PRef q = P_HERE; ffn_rstd_table((const float*)(ws + WS_SSQ), q.conv_f_w, q.conv_f_b, rstab, wtab, S); __syncthreads();
        EpiFFN E{q.st_fc, (bf16_t*)(ws + WS_Z), q.out, rstab, wtab};
        pg8::gemm_phase<EpiFFN, true, true, true>(lds, g, S, E, nullptr, nullptr);
    }
    SEAM(5);
    if (IN(6)) {
        pg8::Gemm g{(const bf16_t*)(ws + WS_Z), (const bf16_t*)(ws + WS_WDN), MP / 256, D / 256, DFF, (size_t)256 * DFF * 2, (size_t)128 * DFF * 2};
        pg8::StaticOrder S; S.init(g.nM, g.nN, G, (int)blockIdx.x, DFF / 64, P6_SPLIT);
        EpiOut E{(const bf16_t*)(ws + WS_XB) + (size_t)16 * D, (bf16_t*)(ws + WS_YM)};
        pg8::gemm_phase<EpiOut, false, true, true>(lds, g, S, E, (float*)(ws + WS_WIN), (unsigned*)ws + CW_TK6);
    }
    SEAM(6);
    if (IN(7)) REPEAT(7) final_phase(P_HERE, G);
#undef IN
#undef SEAM
}

extern "C" void kernel_launch(void* const* d_in, const int* in_sizes, int n_in, void* d_out, int out_size, void* d_ws, size_t ws_size, hipStream_t stream) {
    static int grid = 0;
    if (grid == 0) {
        if (n_in != 26 || (size_t)out_size != O_END || ws_size < WS_END) { fprintf(stderr, "kernel_launch: unexpected problem (n_in %d, out %d, ws %zu; need ws >= %zu)\n", n_in, out_size, ws_size, (size_t)WS_END); grid = -1; return; }
        int dev = 0, cus = 0, per_cu = 0;
        hipGetDevice(&dev); hipDeviceGetAttribute(&cus, hipDeviceAttributeMultiprocessorCount, dev);
        if (hipFuncSetAttribute((const void*)hymba_fwd, hipFuncAttributeMaxDynamicSharedMemorySize, LDS_BYTES) != hipSuccess) { fprintf(stderr, "kernel_launch: hipFuncSetAttribute failed\n"); grid = -1; return; }
        if (hipOccupancyMaxActiveBlocksPerMultiprocessor(&per_cu, (const void*)hymba_fwd, 512, LDS_BYTES) != hipSuccess || per_cu < 1) { fprintf(stderr, "kernel_launch: occupancy query says %d\n", per_cu); grid = -1; return; }
        if (cus < GRID) { fprintf(stderr, "kernel_launch: built for a %d-CU device, found %d CUs\n", GRID, cus); grid = -1; return; }
        grid = GRID;
    }
    if (grid < 0) return;
    Params p{};
    const float** f = (const float**)&p;
    for (int i = 0; i < 26; ++i) f[i] = (const float*)d_in[i];
    p.out = (float*)d_out; p.ws = (unsigned char*)d_ws;
    if (hipMemsetAsync(d_ws, 0, CTL_WORDS * 4, stream) != hipSuccess) { fprintf(stderr, "kernel_launch: memset failed\n"); return; }
    if (MK_N_LAUNCHES == 1) {
        p.ph_lo = 0; p.ph_hi = N_PHASES;
        hipLaunchKernelGGL(hymba_fwd, dim3(grid), dim3(512), LDS_BYTES, stream, p);
    } else {
        for (int k = 0; k < N_PHASES; ++k) { p.ph_lo = k; p.ph_hi = k + 1; hipLaunchKernelGGL(hymba_fwd, dim3(grid), dim3(512), LDS_BYTES, stream, p); }
    }
}
```

```cpp
#include <hip/hip_runtime.h>
#include <cstdio>

#ifndef REP_MASK
#define REP_MASK 0x00
#endif
#ifndef MK_N_LAUNCHES
#define MK_N_LAUNCHES 1
#endif

#define LAS __attribute__((address_space(3)))
#define CAS __attribute__((address_space(4)))
typedef unsigned short bf16_t;
typedef short bf16x8 __attribute__((ext_vector_type(8)));
typedef float f32x4 __attribute__((ext_vector_type(4)));
typedef unsigned u32x4 __attribute__((ext_vector_type(4)));
typedef unsigned u32x2 __attribute__((ext_vector_type(2)));

constexpr int D = 2048, NMETA = 16, SEQ = 2048, TP = SEQ + NMETA, NB = 4, MPR = NB * TP;
constexpr int NS = 128, TS = 8, MSR = NS * TS, M = MPR + MSR;
constexpr int MP = 9472;
constexpr int DA = 1536, DB = 1024, DIN = 6144, DMIX = 2560, DFF = 6144, NH = 12;
constexpr float EPS = 1e-6f;
constexpr int NCH = 33;
constexpr size_t O_YP = 0, O_YS = O_YP + (size_t)NB * SEQ * D, O_PH = O_YS + (size_t)MSR * D, O_PRC = O_PH + NB * DA,
                 O_PSC = O_PRC + NB * 3 * DA, O_PFC = O_PSC + NB * 2 * DB, O_SH = O_PFC + NB * 2 * DFF, O_SRC = O_SH + NS * DA,
                 O_SSC = O_SRC + (size_t)NS * 3 * DA, O_SFC = O_SSC + (size_t)NS * 2 * DB, O_END = O_SFC + (size_t)NS * 2 * DFF;
constexpr size_t MiB = 1u << 20;
constexpr int CW_TK6 = 4096, CTL_WORDS = 4096 + 256 * 64;
constexpr int P6_SPLIT = 6, P4_SPLIT = 4, CW_TK4 = CW_TK6 + 64 * 64;
constexpr int GRID = 256;
constexpr size_t WS_WIN = 1 * MiB;
constexpr size_t WS_WO = WS_WIN + (size_t)DIN * D * 2;
constexpr size_t WS_WUP = WS_WO + (size_t)D * DMIX * 2;
constexpr size_t WS_WDN = WS_WUP + (size_t)2 * DFF * D * 2;
constexpr size_t WS_WG = WS_WDN + (size_t)D * DFF * 2;
constexpr size_t WS_XB = WS_WG + (size_t)2 * NH * 128 * 128 * 2;
constexpr size_t XB_ROWS = 9600;
constexpr size_t WS_Z = WS_XB + XB_ROWS * D * 2;
constexpr size_t WS_YM = WS_Z + (size_t)MP * DIN * 2;
constexpr size_t WS_RS1 = WS_YM + (size_t)MP * DMIX * 2;
constexpr size_t WS_SSQ = WS_RS1 + (size_t)MP * 4;
constexpr size_t WS_TOT = WS_SSQ + (size_t)MP * 32 * 4;
constexpr size_t WS_LA = WS_TOT + (size_t)NB * NCH * DA * 2 * 4;
constexpr size_t WS_UU = WS_LA + (size_t)MPR * DA * 2;
constexpr size_t WS_END = WS_UU + (size_t)MPR * DA * 2;

struct Params;
typedef const CAS Params& PRef;
struct Params {
    const float *x_prompt, *x_sample, *st_h, *st_rc, *st_sc, *st_fc, *meta, *g_mix, *w_in, *conv_a_w, *conv_a_b, *w_gate_a, *b_gate_a,
        *w_gate_x, *b_gate_x, *lam, *conv_b_w, *g_out_a, *g_out_b, *w_o, *g_ffn, *w_up, *conv_f_w, *conv_f_b, *w_down, *g_final;
    float* out; unsigned char* ws; int ph_lo, ph_hi;
};

__device__ __forceinline__ unsigned cvt_pk_bf16(float lo, float hi) { unsigned r; asm volatile("v_cvt_pk_bf16_f32 %0, %1, %2" : "=v"(r) : "v"(lo), "v"(hi)); return r; }
__device__ __forceinline__ float bf_lo(unsigned w) { return __builtin_bit_cast(float, w << 16); }
__device__ __forceinline__ float bf_hi(unsigned w) { return __builtin_bit_cast(float, w & 0xffff0000u); }
__device__ __forceinline__ void unpack8(const u32x4 w, float (&f)[8]) { f[0] = bf_lo(w.x); f[1] = bf_hi(w.x); f[2] = bf_lo(w.y); f[3] = bf_hi(w.y); f[4] = bf_lo(w.z); f[5] = bf_hi(w.z); f[6] = bf_lo(w.w); f[7] = bf_hi(w.w); }
__device__ __forceinline__ u32x4 pack8(const float (&f)[8]) { u32x4 w; w.x = cvt_pk_bf16(f[0], f[1]); w.y = cvt_pk_bf16(f[2], f[3]); w.z = cvt_pk_bf16(f[4], f[5]); w.w = cvt_pk_bf16(f[6], f[7]); return w; }
__device__ __forceinline__ float wave_sum(float v) {
#pragma unroll
    for (int o = 1; o < 64; o <<= 1) v += __shfl_xor(v, o);
    return v;
}
__device__ __forceinline__ float sum16(float v) {
    v += __shfl_xor(v, 1); v += __shfl_xor(v, 2); v += __shfl_xor(v, 4); v += __shfl_xor(v, 8); return v;
}
__device__ __forceinline__ float sigmoidf_(float x) { return __builtin_amdgcn_rcpf(1.0f + __expf(-x)); }
__device__ __forceinline__ float gelu_tanh(float x) {
    constexpr float K1 = -2.0f * 0.7978845608028654f * 1.4426950408889634f, K2 = K1 * 0.044715f;
    const float t = x * __builtin_fmaf(x * x, K2, K1);
    return x * __builtin_amdgcn_rcpf(1.0f + __builtin_amdgcn_exp2f(t));
}
__device__ __forceinline__ int opaque_tid() { int t = threadIdx.x; asm volatile("" : "+v"(t)); return t; }
typedef float f32x2 __attribute__((ext_vector_type(2)));
__device__ __forceinline__ f32x2 gelu_mul2(f32x2 g, f32x2 v) {
    constexpr float K1 = -2.0f * 0.7978845608028654f * 1.4426950408889634f, K2 = K1 * 0.044715f;
    const f32x2 t = g * ((g * g) * K2 + K1);
    f32x2 e; e.x = __builtin_amdgcn_exp2f(t.x); e.y = __builtin_amdgcn_exp2f(t.y);
    const f32x2 d = e + 1.0f;
    f32x2 r; r.x = __builtin_amdgcn_rcpf(d.x); r.y = __builtin_amdgcn_rcpf(d.y);
    return (g * v) * r;
}
template <int CTRL> __device__ __forceinline__ float dppf(float old, float src) {
    return __builtin_bit_cast(float, __builtin_amdgcn_update_dpp(__builtin_bit_cast(int, old), __builtin_bit_cast(int, src), CTRL, 0xF, 0xF, false));
}
__device__ __forceinline__ void row_decode(int r, int& is_s, int& seq, int& t) {
    if (r < MPR) { seq = (r >= TP) + (r >= 2 * TP) + (r >= 3 * TP); t = r - seq * TP; is_s = 0; }
    else { const int q = r - MPR; seq = q >> 3; t = q & 7; is_s = 1; }
}
__device__ __forceinline__ const float* x_row_ptr(const float* xp, const float* xs, const float* meta, int r) {
    int is_s, seq, t; row_decode(r, is_s, seq, t);
    if (is_s) return xs + (size_t)(r - MPR) * D;
    return t < NMETA ? meta + (size_t)t * D : xp + ((size_t)seq * SEQ + (t - NMETA)) * D;
}
__device__ __forceinline__ float* y_row_ptr(float* out, int r) {
    if (r >= M) return nullptr;
    int is_s, seq, t; row_decode(r, is_s, seq, t);
    if (is_s) return out + O_YS + (size_t)(r - MPR) * D;
    return t < NMETA ? nullptr : out + O_YP + ((size_t)seq * SEQ + (t - NMETA)) * D;
}

namespace pg8 {
constexpr int BM = 256, BK = 64, HALF = 128, HTB = HALF * BK * 2, STAGE_BYTES = 8 * HTB, NXCD = 8, WGM = 2;
__host__ __device__ __forceinline__ int lds_byte(int r, int c) { const int st = (r >> 4) * 2 + (c >> 5), rr = r & 15, cc = c & 31, ob = rr * 64 + cc * 2; return st * 1024 + (ob ^ (((ob >> 9) & 1) << 5)); }
__host__ __device__ __forceinline__ void stage_rc(int b, int& R, int& C) { const int st = b / 1024, sb = b % 1024, swz = sb ^ (((sb >> 9) & 1) << 5); R = (st >> 1) * 16 + swz / 64; C = (st & 1) * 32 + (swz % 64) / 2; }
struct Unit { int pm, pn, kb, nk, piece, lu, idx; };
struct Gemm { const bf16_t* A; const bf16_t* Bt; int nM, nN, K; size_t a_tstep, a_hstep; };
struct StaticOrder {
    int nM, nN, nwg, G, c, nt, split, nfull, nleft, limit = 1 << 20, first = 0;
    __device__ __forceinline__ void init(int nM_, int nN_, int G_, int c_, int nt_, int split_) { nM = nM_; nN = nN_; nwg = nM * nN; G = G_; c = c_; nt = nt_; nfull = (nwg / G) * G; nleft = nwg - nfull;
        split = (split_ > 1 && nleft > 0 && nleft * split_ <= G && (nt / split_) * split_ == nt && ((nt / split_) & 1) == 0) ? split_ : 1; }
    __device__ __forceinline__ void map(int L, Unit& u) const {
        int wgid = L; { const int q = nwg / NXCD, r = nwg % NXCD, xcd = wgid % NXCD, off = wgid / NXCD; wgid = (xcd < r ? xcd * (q + 1) : r * (q + 1) + (xcd - r) * q) + off; }
        const int nig = WGM * nN, gid = wgid / nig, rem = wgid - gid * nig, fm = gid * WGM, glast = nM % WGM;
        if (nM - fm >= WGM || glast == 0) { u.pm = fm + (rem & (WGM - 1)); u.pn = rem / WGM; }
        else { u.pm = fm + rem % glast; u.pn = rem / glast; }
    }
    __device__ __forceinline__ bool next(int i, Unit& u) const {
        u.kb = 0; u.nk = nt; u.piece = -1; u.lu = 0; u.idx = i;
        i += first; if (i >= limit) return false;
        const long L = (long)i * G + c;
        if (L < nfull || split == 1) { if (L >= nwg) return false; map((int)L, u); return true; }
        if (L >= nfull + G || c >= nleft * split) return false;
        u.lu = c % nleft; u.piece = c / nleft; u.nk = nt / split; u.kb = u.piece * u.nk; map(nfull + u.lu, u); return true;
    }
};

constexpr int SLAB_SLOTS = 6;
template <int P, int A, int Mi>
__device__ __forceinline__ void reduce_rowgroup(f32x4 (&acc)[2][2][4][2], const unsigned char* slab0, int tid, int nsl) {
    const unsigned char* sp = slab0 + (size_t)((A * 4 + Mi) * SLAB_SLOTS) * 16384 + tid * 16;
#pragma unroll
    for (int b = 0; b < 2; ++b) {
        f32x4 s0 = (f32x4){0.f, 0.f, 0.f, 0.f}, s1 = s0;
#pragma unroll
        for (int src = 0; src < SLAB_SLOTS; ++src) {
            if (src == P) { s0 += acc[A][b][Mi][0]; s1 += acc[A][b][Mi][1]; }
            else if (src < 4 || src < nsl) { float f[8]; unpack8(*(const u32x4*)(sp + (size_t)src * 16384 + b * 8192), f); s0 += (f32x4){f[0], f[1], f[2], f[3]}; s1 += (f32x4){f[4], f[5], f[6], f[7]}; }
        }
        acc[A][b][Mi][0] = s0; acc[A][b][Mi][1] = s1;
    }
}
template <class Epi, bool FFNMAP, bool ALIGN_EPI, bool SP2>
__device__ __forceinline__ void gemm_phase(LAS unsigned char* lds, const Gemm g, const StaticOrder& S, const Epi& E, float* slabs, unsigned* tickets, bool dry = false) {
    int tid = threadIdx.x; asm volatile("" : "+v"(tid));
    const int wid = __builtin_amdgcn_readfirstlane(tid >> 6), lane = tid & 63, wr = wid >> 2, wc = wid & 3, fr = lane & 15, fq = lane >> 4;
    const int K = g.K;
    unsigned voffA[2], voffB[2];
#pragma unroll
    for (int i = 0; i < 2; ++i) { int R, C; stage_rc(tid * 16 + i * 8192, R, C); const int Ra = FFNMAP ? (126 * (R >> 6) + 4 * (R & 15) + ((R >> 4) & 3)) : R;
        voffA[i] = (unsigned)(Ra * K + C) * 2u; voffB[i] = (unsigned)(R * K + C) * 2u; }
    const size_t kstep = (size_t)(BK * 2);
    const size_t hstepA = g.a_hstep, tstepA = g.a_tstep;
    const size_t hstepB = (size_t)HALF * K * 2, tstepB = 2 * hstepB;
    const unsigned ldsw = (unsigned)wid * 1024u;
    const int aoff = lds_byte(wr * 64 + fr, fq * 8), boff = lds_byte(wc * 32 + fr, fq * 8);
#define PG8_SA(b, h) (((b) * 2 + (h)) * HTB)
#define PG8_SB(b, h) ((4 + (b) * 2 + (h)) * HTB)
#define PG8_STAGE(bufoff, gbase, voff) do { _Pragma("unroll") for (int _i = 0; _i < 2; ++_i) \
        __builtin_amdgcn_global_load_lds((const unsigned*)((const char*)(gbase) + (voff)[_i]), (LAS unsigned*)(lds + (bufoff) + ldsw + _i * 8192), 16, 0, 0); } while (0)
#define PG8_LDA(dst, b, h) do { _Pragma("unroll") for (int m = 0; m < 4; ++m) _Pragma("unroll") for (int k = 0; k < 2; ++k) dst[m][k] = *(const LAS bf16x8*)(lds + PG8_SA(b, h) + aoff + m * 2048 + k * 1024); } while (0)
#define PG8_LDB(dst, b, h) do { _Pragma("unroll") for (int n = 0; n < 2; ++n) _Pragma("unroll") for (int k = 0; k < 2; ++k) dst[n][k] = *(const LAS bf16x8*)(lds + PG8_SB(b, h) + boff + n * 2048 + k * 1024); } while (0)
#define PG8_MMA(ai, bj, At, Bt) do { __builtin_amdgcn_s_setprio(1); _Pragma("unroll") for (int m = 0; m < 4; ++m) _Pragma("unroll") for (int n = 0; n < 2; ++n) _Pragma("unroll") for (int k = 0; k < 2; ++k) \
        acc[ai][bj][m][n] = __builtin_amdgcn_mfma_f32_16x16x32_bf16(Bt[n][k], At[m][k], acc[ai][bj][m][n], 0, 0, 0); __builtin_amdgcn_s_setprio(0); } while (0)
#define PG8_WAIT_V(n) asm volatile("s_waitcnt vmcnt(" #n ")" ::: "memory")
#define PG8_WAIT_L(n) asm volatile("s_waitcnt lgkmcnt(" #n ")" ::: "memory")
#define PG8_BAR __builtin_amdgcn_s_barrier()
#define PG8_SCHED __builtin_amdgcn_sched_barrier(0)
    Unit cur, nxt; int ui = 0;
    if (!S.next(0, cur)) return;
    f32x4 acc[2][2][4][2];
#pragma unroll
    for (int a = 0; a < 2; ++a)
#pragma unroll
        for (int b = 0; b < 2; ++b)
#pragma unroll
            for (int m = 0; m < 4; ++m)
#pragma unroll
                for (int n = 0; n < 2; ++n) acc[a][b][m][n] = (f32x4){0.f, 0.f, 0.f, 0.f};
    bf16x8 At[4][2], B0[2][2], B1[2][2];
    const char* cA = (const char*)g.A + (size_t)cur.pm * tstepA + (size_t)cur.kb * kstep; const char* cB = (const char*)g.Bt + (size_t)cur.pn * tstepB + (size_t)cur.kb * kstep;
    if constexpr (SP2) {
        PG8_STAGE(PG8_SB(0, 0), cB, voffB); PG8_STAGE(PG8_SB(0, 1), cB + hstepB, voffB); PG8_STAGE(PG8_SA(0, 0), cA, voffA); PG8_STAGE(PG8_SA(0, 1), cA + hstepA, voffA);
        if (wr == 1) PG8_BAR;
        PG8_WAIT_V(2); PG8_BAR;
        PG8_STAGE(PG8_SB(1, 0), cB + kstep, voffB); PG8_STAGE(PG8_SA(1, 0), cA + kstep, voffA); PG8_STAGE(PG8_SB(1, 1), cB + hstepB + kstep, voffB);
        PG8_WAIT_V(6); PG8_BAR;
    } else {
        PG8_STAGE(PG8_SB(0, 0), cB, voffB); PG8_STAGE(PG8_SA(0, 0), cA, voffA); PG8_STAGE(PG8_SB(0, 1), cB + hstepB, voffB); PG8_STAGE(PG8_SA(0, 1), cA + hstepA, voffA);
        if (wr == 1) PG8_BAR;
        PG8_WAIT_V(4); PG8_BAR;
        PG8_STAGE(PG8_SB(1, 0), cB + kstep, voffB); PG8_STAGE(PG8_SA(1, 0), cA + kstep, voffA); PG8_STAGE(PG8_SB(1, 1), cB + hstepB + kstep, voffB);
        PG8_WAIT_V(6); PG8_BAR;
    }
    for (;;) {
        const bool has_next = S.next(ui + 1, nxt);
        const char* nA = has_next ? (const char*)g.A + (size_t)nxt.pm * tstepA + (size_t)nxt.kb * kstep : cA; const char* nB = has_next ? (const char*)g.Bt + (size_t)nxt.pn * tstepB + (size_t)nxt.kb * kstep : cB;
        const int nt = cur.nk;
        for (int t = 0; t < nt; t += 2) {
            const bool last = (t == nt - 2);
            const char* a1 = cA + (size_t)(t + 1) * kstep;
            const char* a2 = last ? nA : cA + (size_t)(t + 2) * kstep; const char* b2 = last ? nB : cB + (size_t)(t + 2) * kstep;
            const char* a3 = a2 + kstep; const char* b3 = b2 + kstep;
            if constexpr (SP2) {
            PG8_LDB(B0, 0, 0); PG8_LDB(B1, 0, 1); PG8_SCHED; PG8_LDA(At, 0, 0); PG8_STAGE(PG8_SA(1, 1), a1 + hstepA, voffA);
            PG8_WAIT_V(8); PG8_WAIT_L(0); PG8_BAR; PG8_MMA(0, 0, At, B0); PG8_MMA(0, 1, At, B1); PG8_BAR; PG8_SCHED;
            PG8_LDA(At, 0, 1); PG8_STAGE(PG8_SB(0, 0), b2, voffB); PG8_STAGE(PG8_SB(0, 1), b2 + hstepB, voffB); PG8_STAGE(PG8_SA(0, 0), a2, voffA);
            PG8_WAIT_V(8); PG8_WAIT_L(0); PG8_BAR; PG8_MMA(1, 0, At, B0); PG8_MMA(1, 1, At, B1); PG8_BAR; PG8_SCHED;
            PG8_LDB(B0, 1, 0); PG8_LDB(B1, 1, 1); PG8_SCHED; PG8_LDA(At, 1, 0); PG8_STAGE(PG8_SA(0, 1), a2 + hstepA, voffA);
            PG8_WAIT_V(8); PG8_WAIT_L(0); PG8_BAR; PG8_MMA(0, 0, At, B0); PG8_MMA(0, 1, At, B1); PG8_BAR; PG8_SCHED;
            PG8_LDA(At, 1, 1); PG8_STAGE(PG8_SB(1, 0), b3, voffB); PG8_STAGE(PG8_SB(1, 1), b3 + hstepB, voffB); PG8_STAGE(PG8_SA(1, 0), a3, voffA);
            PG8_WAIT_V(8); PG8_WAIT_L(0); PG8_BAR; PG8_MMA(1, 0, At, B0); PG8_MMA(1, 1, At, B1); PG8_BAR; PG8_SCHED;
            } else {
            PG8_LDB(B0, 0, 0); PG8_SCHED; PG8_LDA(At, 0, 0); PG8_STAGE(PG8_SA(1, 1), a1 + hstepA, voffA);
            PG8_WAIT_L(8); PG8_BAR; PG8_WAIT_L(0); PG8_MMA(0, 0, At, B0); PG8_BAR; PG8_SCHED;
            PG8_LDB(B1, 0, 1); PG8_STAGE(PG8_SB(0, 0), b2, voffB);
            PG8_BAR; PG8_WAIT_L(0); PG8_MMA(0, 1, At, B1); PG8_BAR;
            PG8_LDA(At, 0, 1); PG8_STAGE(PG8_SA(0, 0), a2, voffA);
            PG8_BAR; PG8_WAIT_L(0); PG8_MMA(1, 0, At, B0); PG8_BAR; PG8_SCHED;
            PG8_STAGE(PG8_SB(0, 1), b2 + hstepB, voffB);
            PG8_WAIT_V(6); PG8_BAR; PG8_MMA(1, 1, At, B1); PG8_BAR;
            PG8_LDB(B0, 1, 0); PG8_SCHED; PG8_LDA(At, 1, 0); PG8_STAGE(PG8_SA(0, 1), a2 + hstepA, voffA);
            PG8_WAIT_L(8); PG8_BAR; PG8_WAIT_L(0); PG8_MMA(0, 0, At, B0); PG8_BAR; PG8_SCHED;
            PG8_LDB(B1, 1, 1); PG8_STAGE(PG8_SB(1, 0), b3, voffB);
            PG8_BAR; PG8_WAIT_L(0); PG8_MMA(0, 1, At, B1); PG8_BAR;
            PG8_LDA(At, 1, 1); PG8_STAGE(PG8_SA(1, 0), a3, voffA);
            PG8_BAR; PG8_WAIT_L(0); PG8_MMA(1, 0, At, B0); PG8_BAR; PG8_SCHED;
            PG8_STAGE(PG8_SB(1, 1), b3 + hstepB, voffB);
            PG8_WAIT_V(6); PG8_BAR; PG8_MMA(1, 1, At, B1); PG8_BAR;
            }
        }
        if constexpr (ALIGN_EPI) { if (wr == 0) PG8_BAR; }
        if (cur.piece < 0 && !dry) E(acc, cur, wr, wc, fr, fq);
        if (!has_next) break;
#pragma unroll
        for (int a = 0; a < 2; ++a)
#pragma unroll
            for (int b = 0; b < 2; ++b)
#pragma unroll
                for (int m = 0; m < 4; ++m)
#pragma unroll
                    for (int n = 0; n < 2; ++n) acc[a][b][m][n] = (f32x4){0.f, 0.f, 0.f, 0.f};
        cur = nxt; cA = nA; cB = nB; ++ui;
        if constexpr (ALIGN_EPI) { if (wr == 1) PG8_BAR; }
    }
    PG8_WAIT_V(0);
    if constexpr (!ALIGN_EPI) { if (wr == 0) PG8_BAR; }
    PG8_BAR;
    if constexpr (Epi::SPLIT) {
    if (cur.piece >= 0 && !dry) {
        unsigned char* slab0 = (unsigned char*)slabs + (size_t)cur.lu * (8 * SLAB_SLOTS * 16384);
        {
            const __amdgpu_buffer_rsrc_t rs = __builtin_amdgcn_make_buffer_rsrc((void*)slab0, (short)0, 8 * SLAB_SLOTS * 16384, 0x00020000);
#pragma unroll
            for (int a = 0; a < 2; ++a)
#pragma unroll
                for (int m = 0; m < 4; ++m) {
                    const int gq = a * 4 + m;
                    if ((gq >> 1) != cur.piece) {
#pragma unroll
                        for (int b = 0; b < 2; ++b) { const f32x4 v0 = acc[a][b][m][0], v1 = acc[a][b][m][1];
                            u32x4 w; w.x = cvt_pk_bf16(v0[0], v0[1]); w.y = cvt_pk_bf16(v0[2], v0[3]); w.z = cvt_pk_bf16(v1[0], v1[1]); w.w = cvt_pk_bf16(v1[2], v1[3]);
                            __builtin_amdgcn_raw_buffer_store_b128(w, rs, (gq * SLAB_SLOTS + cur.piece) * 16384 + b * 8192 + tid * 16, 0, 16); }
                    }
                }
        }
        asm volatile("s_waitcnt vmcnt(0)" ::: "memory");
        __syncthreads();
        const int nsl = S.split;
        if (tid == 0) {
            __hip_atomic_fetch_add(tickets + 64 * cur.lu, 1u, __ATOMIC_RELAXED, __HIP_MEMORY_SCOPE_AGENT);
            if (cur.piece < 4) {
                unsigned sp = 0;
                while (__hip_atomic_load(tickets + 64 * cur.lu, __ATOMIC_RELAXED, __HIP_MEMORY_SCOPE_AGENT) < (unsigned)nsl) { __builtin_amdgcn_s_sleep(2); if (++sp > (1u << 20)) break; }
                __builtin_amdgcn_fence(__ATOMIC_ACQUIRE, "agent"); asm volatile("s_waitcnt vmcnt(0)" ::: "memory");
            }
        }
        __syncthreads();
        if (cur.piece < 4) {
            switch (cur.piece) {
                case 0: reduce_rowgroup<0, 0, 0>(acc, slab0, tid, nsl); reduce_rowgroup<0, 0, 1>(acc, slab0, tid, nsl); break;
                case 1: reduce_rowgroup<1, 0, 2>(acc, slab0, tid, nsl); reduce_rowgroup<1, 0, 3>(acc, slab0, tid, nsl); break;
                case 2: reduce_rowgroup<2, 1, 0>(acc, slab0, tid, nsl); reduce_rowgroup<2, 1, 1>(acc, slab0, tid, nsl); break;
                default: reduce_rowgroup<3, 1, 2>(acc, slab0, tid, nsl); reduce_rowgroup<3, 1, 3>(acc, slab0, tid, nsl); break;
            }
            E(acc, cur, wr, wc, fr, fq, 3u << (2 * cur.piece));
        }
    }
    }
#undef PG8_SA
#undef PG8_SB
#undef PG8_STAGE
#undef PG8_LDA
#undef PG8_LDB
#undef PG8_MMA
#undef PG8_WAIT_V
#undef PG8_WAIT_L
#undef PG8_BAR
#undef PG8_SCHED
}
}

typedef f32x4 Acc[2][2][4][2];

struct EpiZ {
    static constexpr bool SPLIT = false;
    const LAS float* rstab; bf16_t* z; float* out;
    __device__ __forceinline__ void operator()(const Acc& acc, const pg8::Unit& u, int wr, int wc, int fr, int fq) const {
        asm volatile("" : "+v"(fr), "+v"(fq));
        const int col0 = u.pn * 256 + wc * 32 + 8 * fq;
#pragma unroll
        for (int ai = 0; ai < 2; ++ai)
#pragma unroll
            for (int m = 0; m < 4; ++m) {
                const int r = u.pm * 256 + ai * 128 + wr * 64 + m * 16 + fr;
                if (r < M) {
                    const float rs = rstab[u.idx * 256 + ai * 128 + wr * 64 + m * 16 + fr];
                    int is_s, seq, t; row_decode(r, is_s, seq, t);
                    float* so = nullptr;
                    if (u.pn < 6) { if (is_s) { if (t >= TS - 3) so = out + O_SRC + ((size_t)seq * 3 + (t - (TS - 3))) * DA; } else { if (t >= TP - 3) so = out + O_PRC + ((size_t)seq * 3 + (t - (TP - 3))) * DA; } }
#pragma unroll
                    for (int bj = 0; bj < 2; ++bj) {
                        const f32x4 v0 = acc[ai][bj][m][0] * rs, v1 = acc[ai][bj][m][1] * rs;
                        u32x4 w; w.x = cvt_pk_bf16(v0[0], v0[1]); w.y = cvt_pk_bf16(v0[2], v0[3]); w.z = cvt_pk_bf16(v1[0], v1[1]); w.w = cvt_pk_bf16(v1[2], v1[3]);
                        *(u32x4*)(z + (size_t)r * DIN + col0 + bj * 128) = w;
                        if (so) { *(f32x4*)(so + col0 + bj * 128) = v0; *(f32x4*)(so + col0 + bj * 128 + 4) = v1; }
                    }
                }
            }
    }
};
__device__ __forceinline__ void rstd1_table(const float* rstd1, LAS float* tab, const pg8::StaticOrder& S) {
    const int tid = opaque_tid(), q = tid & 255;
    pg8::Unit u;
    for (int i = tid >> 8; S.next(i, u); i += 2) { const int r = u.pm * 256 + q; tab[i * 256 + q] = r < M ? rstd1[r] : 0.f; }
}
struct EpiX1 {
    static constexpr bool SPLIT = true;
    bf16_t* xb; float* ssq;
    __device__ __forceinline__ void operator()(const Acc& acc, const pg8::Unit& u, int wr, int wc, int fr, int fq, unsigned gmask = 0xffu) const {
        asm volatile("" : "+v"(fr), "+v"(fq));
        const int col0 = u.pn * 256 + wc * 32 + 8 * fq;
#pragma unroll
        for (int ai = 0; ai < 2; ++ai) {
            if (!((gmask >> (ai * 4)) & 0xfu)) continue;
            u32x4 xv[4][2];
#pragma unroll
            for (int m = 0; m < 4; ++m) {
                const int r = u.pm * 256 + ai * 128 + wr * 64 + m * 16 + fr;
                const bf16_t* xr = xb + (size_t)(r < M ? r : 0) * D + col0;
#pragma unroll
                for (int bj = 0; bj < 2; ++bj) xv[m][bj] = *(const u32x4*)(xr + bj * 128);
            }
#pragma unroll
            for (int m = 0; m < 4; ++m) {
                if (!((gmask >> (ai * 4 + m)) & 1u)) continue;
                const int r = u.pm * 256 + ai * 128 + wr * 64 + m * 16 + fr;
                const bool valid = r < M;
                float ss = 0.f;
#pragma unroll
                for (int bj = 0; bj < 2; ++bj) {
                    float xf[8]; unpack8(xv[m][bj], xf);
                    const f32x4 a0 = acc[ai][bj][m][0], a1 = acc[ai][bj][m][1];
                    const f32x4 v0 = (f32x4){a0[0] + xf[0], a0[1] + xf[1], a0[2] + xf[2], a0[3] + xf[3]}, v1 = (f32x4){a1[0] + xf[4], a1[1] + xf[5], a1[2] + xf[6], a1[3] + xf[7]};
                    ss += (v0[0] * v0[0] + v0[1] * v0[1]) + (v0[2] * v0[2] + v0[3] * v0[3]) + (v1[0] * v1[0] + v1[1] * v1[1]) + (v1[2] * v1[2] + v1[3] * v1[3]);
                    if (valid) { u32x4 w; w.x = cvt_pk_bf16(v0[0], v0[1]); w.y = cvt_pk_bf16(v0[2], v0[3]); w.z = cvt_pk_bf16(v1[0], v1[1]); w.w = cvt_pk_bf16(v1[2], v1[3]);
                        *(u32x4*)(xb + (size_t)r * D + col0 + bj * 128) = w; }
                }
                ss += __shfl_xor(ss, 16); ss += __shfl_xor(ss, 32);
                if (valid && fq == 0) ssq[(size_t)r * 32 + u.pn * 4 + wc] = ss;
            }
        }
    }
};
struct EpiOut {
    static constexpr bool SPLIT = true;
    const bf16_t* x1b; bf16_t* x2b;
    __device__ __forceinline__ void operator()(const Acc& acc, const pg8::Unit& u, int wr, int wc, int fr, int fq, unsigned gmask = 0xffu) const {
        asm volatile("" : "+v"(fr), "+v"(fq));
        const int col0 = u.pn * 256 + wc * 32 + 8 * fq;
#pragma unroll
        for (int ai = 0; ai < 2; ++ai) {
            if (!((gmask >> (ai * 4)) & 0xfu)) continue;
            u32x4 xv[4][2];
#pragma unroll
            for (int m = 0; m < 4; ++m) {
                const int r = u.pm * 256 + ai * 128 + wr * 64 + m * 16 + fr;
                const bf16_t* xr = x1b + (size_t)(r < M ? r : 0) * D + col0;
#pragma unroll
                for (int bj = 0; bj < 2; ++bj) xv[m][bj] = *(const u32x4*)(xr + bj * 128);
            }
#pragma unroll
            for (int m = 0; m < 4; ++m) {
                if (!((gmask >> (ai * 4 + m)) & 1u)) continue;
                const int r = u.pm * 256 + ai * 128 + wr * 64 + m * 16 + fr;
                if (r < M) {
#pragma unroll
                    for (int bj = 0; bj < 2; ++bj) {
                        float xf[8]; unpack8(xv[m][bj], xf);
                        const f32x4 a0 = acc[ai][bj][m][0], a1 = acc[ai][bj][m][1];
                        u32x4 w; w.x = cvt_pk_bf16(a0[0] + xf[0], a0[1] + xf[1]); w.y = cvt_pk_bf16(a0[2] + xf[2], a0[3] + xf[3]); w.z = cvt_pk_bf16(a1[0] + xf[4], a1[1] + xf[5]); w.w = cvt_pk_bf16(a1[2] + xf[6], a1[3] + xf[7]);
                        *(u32x4*)(x2b + (size_t)r * D + col0 + bj * 128) = w;
                    }
                }
            }
        }
    }
};
struct EpiFFN {
    static constexpr bool SPLIT = false;
    const float* st_fc; bf16_t* hid; float* out; const LAS float* rstab; const LAS float* wtab;
    template <bool PLAIN>
    __device__ __forceinline__ void body(Acc& acc, const pg8::Unit& u, int wr, int wc, int fr, int fq, int gbase, int f0,
                                         const f32x4 (&wv)[4][2]) const {
#pragma unroll
        for (int ai = 0; ai < 2; ++ai) {
            f32x4 s3[2], s2[2];
#pragma unroll
            for (int n = 0; n < 2; ++n)
#pragma unroll
                for (int e = 0; e < 4; ++e) {
                    const float o3 = ai == 0 ? 0.f : dppf<0x121>(0.f, acc[0][0][3][n][e]), o2 = ai == 0 ? 0.f : dppf<0x121>(0.f, acc[0][0][2][n][e]);
                    s3[n][e] = dppf<0x111>(o3, acc[ai][0][3][n][e]); s2[n][e] = dppf<0x111>(o2, acc[ai][0][2][n][e]);
                }
#pragma unroll
            for (int m = 0; m < 4; ++m) {
                const int j = 64 * ai + 4 * fr + m, r = gbase + j;
                const f32x4 c0 = acc[ai][0][m][0], c1 = acc[ai][0][m][1];
                f32x4 p1a = m == 0 ? s3[0] : acc[ai][0][m == 0 ? 0 : m - 1][0], p1b = m == 0 ? s3[1] : acc[ai][0][m == 0 ? 0 : m - 1][1];
                f32x4 p2a = m == 0 ? s2[0] : (m == 1 ? s3[0] : acc[ai][0][m < 2 ? 0 : m - 2][0]), p2b = m == 0 ? s2[1] : (m == 1 ? s3[1] : acc[ai][0][m < 2 ? 0 : m - 2][1]);
                bool valid = j >= 2;
                int is_s = 0, seq = 0, t = 2;
                if constexpr (!PLAIN) {
                    valid = valid && (r < M);
                    row_decode(valid ? r : 0, is_s, seq, t);
                    if (valid && t < 2) {
                        f32x4 s0a = (f32x4){0.f, 0.f, 0.f, 0.f}, s0b = s0a, s1a = s0a, s1b = s0a;
                        if (is_s) { const float* sp = st_fc + (size_t)seq * 2 * DFF + f0; s0a = *(const f32x4*)sp; s0b = *(const f32x4*)(sp + 4); s1a = *(const f32x4*)(sp + DFF); s1b = *(const f32x4*)(sp + DFF + 4); }
                        if (t == 0) { p1a = s1a; p1b = s1b; p2a = s0a; p2b = s0b; } else { p2a = s1a; p2b = s1b; }
                    }
                }
                const f32x4 ga = wv[0][0] * p2a + wv[1][0] * p1a + wv[2][0] * c0 + wv[3][0], gb = wv[0][1] * p2b + wv[1][1] * p1b + wv[2][1] * c1 + wv[3][1];
                const f32x4 va = acc[ai][1][m][0], vb = acc[ai][1][m][1];
                if (valid) {
                    u32x4 w;
                    const f32x2 h0 = gelu_mul2((f32x2){ga[0], ga[1]}, (f32x2){va[0], va[1]}), h1 = gelu_mul2((f32x2){ga[2], ga[3]}, (f32x2){va[2], va[3]});
                    const f32x2 h2 = gelu_mul2((f32x2){gb[0], gb[1]}, (f32x2){vb[0], vb[1]}), h3 = gelu_mul2((f32x2){gb[2], gb[3]}, (f32x2){vb[2], vb[3]});
                    w.x = cvt_pk_bf16(h0.x, h0.y); w.y = cvt_pk_bf16(h1.x, h1.y); w.z = cvt_pk_bf16(h2.x, h2.y); w.w = cvt_pk_bf16(h3.x, h3.y);
                    *(u32x4*)(hid + (size_t)r * DFF + f0) = w;
                    if constexpr (!PLAIN) {
                        const int T = is_s ? TS : TP;
                        if (t >= T - 2) { float* so = out + (is_s ? O_SFC : O_PFC) + ((size_t)seq * 2 + (t - (T - 2))) * DFF + f0; *(f32x4*)so = c0; *(f32x4*)(so + 4) = c1; }
                    }
                }
            }
            __builtin_amdgcn_sched_barrier(0);
        }
    }
    __device__ __forceinline__ void operator()(Acc& acc, const pg8::Unit& u, int wr, int wc, int fr, int fq) const {
        asm volatile("" : "+v"(fr), "+v"(fq));
        const int gbase = 252 * u.pm - 2 + 126 * wr;
        const int f0 = 128 * u.pn + 32 * wc + 8 * fq;
        const LAS float* wt = wtab + u.idx * 512 + 32 * wc + 8 * fq;
        f32x4 wv[4][2];
#pragma unroll
        for (int k = 0; k < 4; ++k) { wv[k][0] = *(const LAS f32x4*)(wt + 128 * k); wv[k][1] = *(const LAS f32x4*)(wt + 128 * k + 4); }
        const LAS float* rt = rstab + u.idx * 256 + wr * 128 + 4 * fr;
#pragma unroll
        for (int ai = 0; ai < 2; ++ai) {
            const f32x4 rs4 = *(const LAS f32x4*)(rt + 64 * ai);
#pragma unroll
            for (int m = 0; m < 4; ++m)
#pragma unroll
                for (int bj = 0; bj < 2; ++bj)
#pragma unroll
                    for (int n = 0; n < 2; ++n) acc[ai][bj][m][n] *= rs4[m];
        }
        const int lo = gbase, hi = gbase + 127;
        bool plain = hi < MPR && lo >= 0;
#pragma unroll
        for (int b2 = 0; b2 < NB; ++b2) { const int s0 = b2 * TP; if (lo <= s0 + 1 && hi >= s0) plain = false; if (lo <= s0 + TP - 1 && hi >= s0 + TP - 2) plain = false; }
        if (plain) body<true>(acc, u, wr, wc, fr, fq, gbase, f0, wv); else body<false>(acc, u, wr, wc, fr, fq, gbase, f0, wv);
    }
};
__device__ __forceinline__ void ffn_rstd_table(const float* ssq, const float* cw, const float* cb, LAS float* tab, LAS float* wtab, const pg8::StaticOrder& S) {
    const int tid = opaque_tid(), q = tid >> 1, half = tid & 1;
    pg8::Unit u;
    for (int i = 0; S.next(i, u); ++i) {
        { const int k = tid >> 7, c = tid & 127, f = 128 * u.pn + c; wtab[i * 512 + tid] = k < 3 ? cw[k * DFF + f] : cb[f]; }
        int r = 252 * u.pm - 2 + 126 * (q >> 7) + (q & 127); r = r < 0 ? 0 : (r >= M ? M - 1 : r);
        const float* sp = ssq + (size_t)r * 32 + 16 * half;
        const f32x4 a = *(const f32x4*)sp, b = *(const f32x4*)(sp + 4), c = *(const f32x4*)(sp + 8), d = *(const f32x4*)(sp + 12);
        float sm = (((a[0] + a[1]) + (a[2] + a[3])) + ((b[0] + b[1]) + (b[2] + b[3]))) + (((c[0] + c[1]) + (c[2] + c[3])) + ((d[0] + d[1]) + (d[2] + d[3])));
        sm += __shfl_xor(sm, 1);
        if (half == 0) tab[i * 256 + q] = __builtin_amdgcn_rsqf(sm * (1.0f / D) + EPS);
    }
}

__device__ __forceinline__ int invperm32(int q) { return 16 * ((q >> 2) & 1) + 4 * (q >> 3) + (q & 3); }
__device__ __forceinline__ void p0_transpose_item(const float* W, int K, int N, const float* kscale, bf16_t* WT, int mode, LAS float* scr, int item, int lane) {
    const int nblk = N / 32, kb = item / nblk, nb = item % nblk, k0 = 64 * kb, n0 = 32 * nb;
    float v[32];
    const float* src = W + (size_t)(k0 + (lane >> 5)) * N + n0 + (lane & 31);
#pragma unroll
    for (int i = 0; i < 32; ++i) v[i] = src[(size_t)(2 * i) * N];
#pragma unroll
    for (int i = 0; i < 32; ++i) scr[(2 * i + (lane >> 5)) * 33 + (lane & 31)] = v[i];
    asm volatile("s_waitcnt lgkmcnt(0)" ::: "memory");
    int rbase = n0;
    if (mode == 1) { const int bj = n0 >= DFF ? 1 : 0, f = n0 - bj * DFF; rbase = 256 * (f >> 7) + 128 * bj + (f & 96); }
    const int c = lane & 7;
    f32x4 ks0 = (f32x4){1.f, 1.f, 1.f, 1.f}, ks1 = ks0;
    if (kscale) { ks0 = *(const f32x4*)(kscale + k0 + 8 * c); ks1 = *(const f32x4*)(kscale + k0 + 8 * c + 4); }
#pragma unroll
    for (int j = 0; j < 4; ++j) { const int n = (lane >> 3) + 8 * j; const LAS float* sp = scr + (8 * c) * 33 + n;
        u32x4 o; o.x = cvt_pk_bf16(sp[0 * 33] * ks0[0], sp[1 * 33] * ks0[1]); o.y = cvt_pk_bf16(sp[2 * 33] * ks0[2], sp[3 * 33] * ks0[3]);
        o.z = cvt_pk_bf16(sp[4 * 33] * ks1[0], sp[5 * 33] * ks1[1]); o.w = cvt_pk_bf16(sp[6 * 33] * ks1[2], sp[7 * 33] * ks1[3]);
        *(u32x4*)(WT + (size_t)(rbase + (mode == 2 ? n : invperm32(n))) * K + k0 + 8 * c) = o; }
    asm volatile("s_waitcnt lgkmcnt(0)" ::: "memory");
}
constexpr int I_IN = (D / 64) * (DIN / 32), I_O = (DMIX / 64) * (D / 32), I_UP = (D / 64) * (2 * DFF / 32), I_DN = (DFF / 64) * (D / 32), I_G = 2 * NH * 8;
constexpr int IT_O = I_IN, IT_UP = IT_O + I_O, IT_DN = IT_UP + I_UP, IT_G = IT_DN + I_DN, IT_END = IT_G + I_G;
__device__ __forceinline__ void convert_items(PRef p, LAS unsigned char* lds, int rank, int nwaves, int lo, int hi) {
    const int tid_ = opaque_tid(), lane = tid_ & 63, wave = tid_ >> 6;
    unsigned char* ws = p.ws;
    LAS float* scr = (LAS float*)(lds + wave * 16384);
    for (int it = lo + rank; it < hi; it += nwaves) {
        int r = it;
        if (r < I_IN) { p0_transpose_item(p.w_in, D, DIN, p.g_mix, (bf16_t*)(ws + WS_WIN), 0, scr, r, lane); continue; } r -= I_IN;
        if (r < I_O) { p0_transpose_item(p.w_o, DMIX, D, nullptr, (bf16_t*)(ws + WS_WO), 0, scr, r, lane); continue; } r -= I_O;
        if (r < I_UP) { p0_transpose_item(p.w_up, D, 2 * DFF, p.g_ffn, (bf16_t*)(ws + WS_WUP), 1, scr, r, lane); continue; } r -= I_UP;
        if (r < I_DN) { p0_transpose_item(p.w_down, DFF, D, nullptr, (bf16_t*)(ws + WS_WDN), 0, scr, r, lane); continue; } r -= I_DN;
        { const int mat = r >> 3, sub = r & 7, gsel = mat / NH, n = mat % NH;
          p0_transpose_item((gsel ? p.w_gate_x : p.w_gate_a) + (size_t)n * 128 * 128, 128, 128, nullptr, (bf16_t*)(ws + WS_WG) + (size_t)mat * 128 * 128, 0, scr, sub, lane); }
    }
}
constexpr int P1_TAIL_WG0 = (888 % 256), P4_TAIL_WG0 = (296 % 256) * P4_SPLIT, IT_S1 = IT_O + 10600, IT_S2 = IT_S1 + 300, IT_S3 = IT_S2 + 2400;
__device__ __forceinline__ void phase0(PRef p, LAS unsigned char* lds, int G) {
    const int tid = opaque_tid(), lane = tid & 63, wave = tid >> 6;
    unsigned char* ws = p.ws;
    const int gw = blockIdx.x * 8 + wave, NGW = G * 8;
    convert_items(p, lds, gw, NGW, 0, IT_O);
    convert_items(p, lds, gw, NGW, IT_G, IT_END);
    { bf16_t* xb = (bf16_t*)(ws + WS_XB) + (size_t)16 * D; float* rstd1 = (float*)(ws + WS_RS1);
      for (int m = gw; m < M; m += NGW) {
          const f32x4* xr = (const f32x4*)x_row_ptr(p.x_prompt, p.x_sample, p.meta, m) + lane;
          f32x4 v[8]; float s = 0.f;
#pragma unroll
          for (int j = 0; j < 8; ++j) { v[j] = xr[64 * j]; s += (v[j][0] * v[j][0] + v[j][1] * v[j][1]) + (v[j][2] * v[j][2] + v[j][3] * v[j][3]); }
          s = wave_sum(s);
          if (lane == 0) rstd1[m] = __builtin_amdgcn_rsqf(s * (1.0f / D) + EPS);
          u32x2* o = (u32x2*)(xb + (size_t)m * D) + lane;
#pragma unroll
          for (int j = 0; j < 8; ++j) { u32x2 w; w.x = cvt_pk_bf16(v[j][0], v[j][1]); w.y = cvt_pk_bf16(v[j][2], v[j][3]); o[64 * j] = w; }
      } }
}

__device__ __forceinline__ void branch_b(PRef p, int G) {
    const bf16_t* z = (const bf16_t*)(p.ws + WS_Z); bf16_t* ym = (bf16_t*)(p.ws + WS_YM);
    const int total = (M / 4) * 128;
    for (int idx = blockIdx.x * 512 + opaque_tid(); idx < total; idx += G * 512) {
        const int m0 = (idx >> 7) * 4, g = idx & 127, ch = 8 * g;
        int is_s, seq, t0; row_decode(m0, is_s, seq, t0);
        u32x4 rc[6], rv[6], rg[4];
#pragma unroll
        for (int k = 0; k < 6; ++k) {
            const int mm = (t0 - 2 + k >= 0) ? m0 - 2 + k : m0;
            rc[k] = *(const u32x4*)(z + (size_t)mm * DIN + 4096 + ch); rv[k] = *(const u32x4*)(z + (size_t)mm * DIN + 5120 + ch);
        }
#pragma unroll
        for (int k = 0; k < 4; ++k) rg[k] = *(const u32x4*)(z + (size_t)(m0 + k) * DIN + 3072 + ch);
        const f32x4 w0a = *(const f32x4*)(p.conv_b_w + ch), w0b = *(const f32x4*)(p.conv_b_w + ch + 4), w1a = *(const f32x4*)(p.conv_b_w + DB + ch), w1b = *(const f32x4*)(p.conv_b_w + DB + ch + 4),
                    w2a = *(const f32x4*)(p.conv_b_w + 2 * DB + ch), w2b = *(const f32x4*)(p.conv_b_w + 2 * DB + ch + 4), goa = *(const f32x4*)(p.g_out_b + ch), gob = *(const f32x4*)(p.g_out_b + ch + 4);
        float u[6][8];
#pragma unroll
        for (int k = 0; k < 6; ++k) {
            float a[8], b[8]; unpack8(rc[k], a); unpack8(rv[k], b);
#pragma unroll
            for (int e = 0; e < 8; ++e) u[k][e] = a[e] * b[e];
        }
        if (t0 == 0) {
#pragma unroll
            for (int k = 0; k < 2; ++k) {
                f32x4 a = (f32x4){0.f, 0.f, 0.f, 0.f}, b = a;
                if (is_s) { const float* sp = p.st_sc + ((size_t)seq * 2 + k) * DB + ch; a = *(const f32x4*)sp; b = *(const f32x4*)(sp + 4); }
#pragma unroll
                for (int e = 0; e < 4; ++e) { u[k][e] = a[e]; u[k][4 + e] = b[e]; }
            }
        }
        const int T = is_s ? TS : TP;
#pragma unroll
        for (int k = 0; k < 4; ++k) {
            float gb[8]; unpack8(rg[k], gb);
            float y[8]; float ss = 0.f;
#pragma unroll
            for (int e = 0; e < 8; ++e) {
                const float uc = (e < 4 ? w0a[e & 3] : w0b[e & 3]) * u[k][e] + (e < 4 ? w1a[e & 3] : w1b[e & 3]) * u[k + 1][e] + (e < 4 ? w2a[e & 3] : w2b[e & 3]) * u[k + 2][e];
                y[e] = gb[e] * uc; ss += y[e] * y[e];
            }
            ss = sum16(ss);
            const float rn = __builtin_amdgcn_rsqf(ss * (1.0f / 128.0f) + EPS);
#pragma unroll
            for (int e = 0; e < 8; ++e) y[e] = y[e] * rn * (e < 4 ? goa[e & 3] : gob[e & 3]);
            *(u32x4*)(ym + (size_t)(m0 + k) * DMIX + DA + ch) = pack8(y);
            const int t = t0 + k;
            if (t >= T - 2) { float* so = p.out + (is_s ? O_SSC : O_PSC) + ((size_t)seq * 2 + (t - (T - 2))) * DB + ch;
                *(f32x4*)so = (f32x4){u[k + 2][0], u[k + 2][1], u[k + 2][2], u[k + 2][3]}; *(f32x4*)(so + 4) = (f32x4){u[k + 2][4], u[k + 2][5], u[k + 2][6], u[k + 2][7]}; }
        }
    }
}

constexpr int LW_STRIDE = 272, L_WA = 0, L_WX = 128 * LW_STRIDE, L_CT = 2 * 128 * LW_STRIDE, L_LRU_END = L_CT + 9 * 128 * 4;
static_assert(L_LRU_END <= 131072, "mixer LDS");
constexpr int LRU_WG_PER_HEAD = 21, LRU_NSEG = 33, LRU_PITEMS = NB * LRU_NSEG, LRU_SBLK = 2, LRU_SITEMS = MSR / (16 * LRU_SBLK);
constexpr int LRU_IDLE_J0 = (LRU_PITEMS + 7) / 8;
static_assert(LRU_WG_PER_HEAD * 8 >= LRU_PITEMS + LRU_SITEMS, "waves per head");

template <int CTRL, int BANK> __device__ __forceinline__ float dppfb(float old, float src) {
    return __builtin_bit_cast(float, __builtin_amdgcn_update_dpp(__builtin_bit_cast(int, old), __builtin_bit_cast(int, src), CTRL, 0xF, BANK, false));
}
__device__ __forceinline__ float bcast15(float x, int lane) {
    return __builtin_bit_cast(float, __builtin_amdgcn_ds_bpermute(((lane & 48) | 15) << 2, __builtin_bit_cast(int, x)));
}
__device__ __forceinline__ void scan16(float& P, float& S) {
    float Sd, Pd;
    Sd = dppf<0x111>(0.f, S); Pd = dppf<0x111>(1.f, P); S = __builtin_fmaf(P, Sd, S); P *= Pd;
    Sd = dppf<0x112>(0.f, S); Pd = dppf<0x112>(1.f, P); S = __builtin_fmaf(P, Sd, S); P *= Pd;
    Sd = dppf<0x114>(0.f, S); Pd = dppf<0x114>(1.f, P); S = __builtin_fmaf(P, Sd, S); P *= Pd;
    Sd = dppf<0x118>(0.f, S); Pd = dppf<0x118>(1.f, P); S = __builtin_fmaf(P, Sd, S); P *= Pd;
}
__device__ __forceinline__ void scan16x2(float& P1, float& S1, float& P2, float& S2) {
    asm volatile(
        "s_nop 1\n\t"
        "v_fmac_f32_dpp %1, %1, %0 row_shr:1 row_mask:0xf bank_mask:0xf bound_ctrl:1\n\t"
        "v_fmac_f32_dpp %3, %3, %2 row_shr:1 row_mask:0xf bank_mask:0xf bound_ctrl:1\n\t"
        "v_mul_f32_dpp %0, %0, %0 row_shr:1 row_mask:0xf bank_mask:0xf\n\t"
        "v_mul_f32_dpp %2, %2, %2 row_shr:1 row_mask:0xf bank_mask:0xf\n\t"
        "v_fmac_f32_dpp %1, %1, %0 row_shr:2 row_mask:0xf bank_mask:0xf bound_ctrl:1\n\t"
        "v_fmac_f32_dpp %3, %3, %2 row_shr:2 row_mask:0xf bank_mask:0xf bound_ctrl:1\n\t"
        "v_mul_f32_dpp %0, %0, %0 row_shr:2 row_mask:0xf bank_mask:0xf\n\t"
        "v_mul_f32_dpp %2, %2, %2 row_shr:2 row_mask:0xf bank_mask:0xf\n\t"
        "v_fmac_f32_dpp %1, %1, %0 row_shr:4 row_mask:0xf bank_mask:0xf bound_ctrl:1\n\t"
        "v_fmac_f32_dpp %3, %3, %2 row_shr:4 row_mask:0xf bank_mask:0xf bound_ctrl:1\n\t"
        "v_mul_f32_dpp %0, %0, %0 row_shr:4 row_mask:0xf bank_mask:0xf\n\t"
        "v_mul_f32_dpp %2, %2, %2 row_shr:4 row_mask:0xf bank_mask:0xf\n\t"
        "v_fmac_f32_dpp %1, %1, %0 row_shr:8 row_mask:0xf bank_mask:0xf bound_ctrl:1\n\t"
        "v_fmac_f32_dpp %3, %3, %2 row_shr:8 row_mask:0xf bank_mask:0xf bound_ctrl:1\n\t"
        "v_mul_f32_dpp %0, %0, %0 row_shr:8 row_mask:0xf bank_mask:0xf\n\t"
        "v_mul_f32_dpp %2, %2, %2 row_shr:8 row_mask:0xf bank_mask:0xf\n\t"
        "s_nop 0"
        : "+v"(P1), "+v"(S1), "+v"(P2), "+v"(S2));
}
__device__ __forceinline__ void scan8(float& P, float& S, int t) {
    float Sd, Pd;
    Sd = dppf<0x111>(0.f, S); Pd = dppf<0x111>(1.f, P); if (t < 1) { Sd = 0.f; Pd = 1.f; } S = __builtin_fmaf(P, Sd, S); P *= Pd;
    Sd = dppf<0x112>(0.f, S); Pd = dppf<0x112>(1.f, P); if (t < 2) { Sd = 0.f; Pd = 1.f; } S = __builtin_fmaf(P, Sd, S); P *= Pd;
    Sd = dppfb<0x114, 0xA>(0.f, S); Pd = dppfb<0x114, 0xA>(1.f, P); S = __builtin_fmaf(P, Sd, S); P *= Pd;
}

template <int PASS, bool IS_S>
__device__ __forceinline__ void lru_wave_item(PRef p, LAS unsigned char* lds, int n, int b, int seg) {
    const int lane = opaque_tid() & 63, fr = lane & 15, fq = lane >> 4;
    const bf16_t* z = (const bf16_t*)(p.ws + WS_Z);
    bf16_t* ym = (bf16_t*)(p.ws + WS_YM);
    float* tot = (float*)(p.ws + WS_TOT);
    const LAS float* CT = (const LAS float*)(lds + L_CT) + 8 * fq;
    const int gch = n * 128 + 8 * fq;
    const int r0 = IS_S ? MPR + b * (16 * LRU_SBLK) : b * TP + seg * 64;
    const int nblk = IS_S ? LRU_SBLK : (seg == LRU_NSEG - 1 ? 1 : 4);
    float hin[4][8], Pt[4][8];
    u32x4 prevx[4];
#pragma unroll
    for (int ks = 0; ks < 4; ++ks) {
#pragma unroll
        for (int e = 0; e < 8; ++e) { hin[ks][e] = 0.f; Pt[ks][e] = 1.f; }
        prevx[ks] = (u32x4){0u, 0u, 0u, 0u};
    }
    if constexpr (!IS_S) {
        if (seg > 0) {
#pragma unroll
            for (int ks = 0; ks < 4; ++ks) prevx[ks] = *(const u32x4*)(z + (size_t)(r0 - 16 + fr) * DIN + gch + 32 * ks);
            if constexpr (PASS == 2) {
#pragma unroll 1
                for (int round = 0; round < 2; ++round) {
                    const int s = 16 * round + fr;
                    if (16 * round >= seg) break;
                    const bool have = s < seg;
                    const float* tp = tot + ((size_t)(b * LRU_NSEG + (have ? s : 0)) * 2) * DA + gch;
#pragma unroll
                    for (int ks = 0; ks < 4; ++ks) {
                        const f32x4 P0 = *(const f32x4*)(tp + 32 * ks), P1 = *(const f32x4*)(tp + 32 * ks + 4), S0 = *(const f32x4*)(tp + DA + 32 * ks), S1 = *(const f32x4*)(tp + DA + 32 * ks + 4);
#pragma unroll
                        for (int e = 0; e < 8; e += 2) {
                            float Pa = have ? (e < 4 ? P0[e & 3] : P1[e & 3]) : 1.f, Sa = have ? (e < 4 ? S0[e & 3] : S1[e & 3]) : 0.f;
                            float Pb = have ? (e < 4 ? P0[(e + 1) & 3] : P1[(e + 1) & 3]) : 1.f, Sb = have ? (e < 4 ? S0[(e + 1) & 3] : S1[(e + 1) & 3]) : 0.f;
                            scan16x2(Pa, Sa, Pb, Sb);
                            hin[ks][e] = __builtin_fmaf(bcast15(Pa, lane), hin[ks][e], bcast15(Sa, lane));
                            hin[ks][e + 1] = __builtin_fmaf(bcast15(Pb, lane), hin[ks][e + 1], bcast15(Sb, lane));
                        }
                    }
                }
            }
        }
    }
    u32x4 xnext[4];
    if constexpr (!IS_S) {
#pragma unroll
        for (int ks = 0; ks < 4; ++ks) xnext[ks] = *(const u32x4*)(z + (size_t)(r0 + fr) * DIN + gch + 32 * ks);
    }
#pragma unroll 1
    for (int blk = 0; blk < nblk; ++blk) {
        const int r = r0 + 16 * blk + fr;
        const int t8 = fr & 7, sq = (r - MPR) >> 3;
        u32x4 x4[4], g4[4];
#pragma unroll
        for (int ks = 0; ks < 4; ++ks) { if constexpr (IS_S) x4[ks] = *(const u32x4*)(z + (size_t)r * DIN + gch + 32 * ks); else x4[ks] = xnext[ks];
            if constexpr (PASS == 2) g4[ks] = *(const u32x4*)(z + (size_t)r * DIN + DA + gch + 32 * ks); }
        if constexpr (!IS_S) { const int rn_ = (blk + 1 < nblk) ? r + 16 : r;
#pragma unroll
          for (int ks = 0; ks < 4; ++ks) xnext[ks] = *(const u32x4*)(z + (size_t)rn_ * DIN + gch + 32 * ks); }
        float xc[4][8];
        bf16x8 bfrag[4];
#pragma unroll
        for (int ks = 0; ks < 4; ++ks) {
            float xf[8]; unpack8(x4[ks], xf);
            const f32x4 w0a = *(const LAS f32x4*)(CT + 0 * 128 + 32 * ks), w0b = *(const LAS f32x4*)(CT + 0 * 128 + 32 * ks + 4);
            const f32x4 w1a = *(const LAS f32x4*)(CT + 1 * 128 + 32 * ks), w1b = *(const LAS f32x4*)(CT + 1 * 128 + 32 * ks + 4);
            const f32x4 w2a = *(const LAS f32x4*)(CT + 2 * 128 + 32 * ks), w2b = *(const LAS f32x4*)(CT + 2 * 128 + 32 * ks + 4);
            const f32x4 w3a = *(const LAS f32x4*)(CT + 3 * 128 + 32 * ks), w3b = *(const LAS f32x4*)(CT + 3 * 128 + 32 * ks + 4);
            const f32x4 cba = *(const LAS f32x4*)(CT + 4 * 128 + 32 * ks), cbb = *(const LAS f32x4*)(CT + 4 * 128 + 32 * ks + 4);
            if constexpr (IS_S) {
                const float* sp = p.st_rc + (size_t)sq * 3 * DA + gch + 32 * ks;
                const f32x4 b0a = *(const f32x4*)sp, b0b = *(const f32x4*)(sp + 4), b1a = *(const f32x4*)(sp + DA), b1b = *(const f32x4*)(sp + DA + 4), b2a = *(const f32x4*)(sp + 2 * DA), b2b = *(const f32x4*)(sp + 2 * DA + 4);
#pragma unroll
                for (int e = 0; e < 8; ++e) {
                    const float bb0 = e < 4 ? b0a[e & 3] : b0b[e & 3], bb1 = e < 4 ? b1a[e & 3] : b1b[e & 3], bb2 = e < 4 ? b2a[e & 3] : b2b[e & 3];
                    const float s1 = dppf<0x111>(0.f, xf[e]), s2 = dppf<0x112>(0.f, xf[e]), s3 = dppf<0x113>(0.f, xf[e]);
                    const float x1 = t8 >= 1 ? s1 : bb2;
                    const float x2 = t8 >= 2 ? s2 : (t8 == 1 ? bb2 : bb1);
                    const float x3 = t8 >= 3 ? s3 : (t8 == 2 ? bb2 : (t8 == 1 ? bb1 : bb0));
                    const float w0 = e < 4 ? w0a[e & 3] : w0b[e & 3], w1 = e < 4 ? w1a[e & 3] : w1b[e & 3], w2 = e < 4 ? w2a[e & 3] : w2b[e & 3], w3 = e < 4 ? w3a[e & 3] : w3b[e & 3];
                    xc[ks][e] = (e < 4 ? cba[e & 3] : cbb[e & 3]) + w3 * xf[e] + w2 * x1 + w1 * x2 + w0 * x3;
                }
            } else {
                float pf[8]; unpack8(prevx[ks], pf);
#pragma unroll
                for (int e = 0; e < 8; e += 2) {
                    f32x2 x0, x1, x2, x3;
#pragma unroll
                    for (int q = 0; q < 2; ++q) {
                        x0[q] = xf[e + q];
                        x1[q] = dppf<0x111>(dppf<0x121>(0.f, pf[e + q]), xf[e + q]);
                        x2[q] = dppf<0x112>(dppf<0x122>(0.f, pf[e + q]), xf[e + q]);
                        x3[q] = dppf<0x113>(dppf<0x123>(0.f, pf[e + q]), xf[e + q]);
                    }
                    const int c = e & 3;
                    const f32x2 w0 = e < 4 ? (f32x2){w0a[c], w0a[c + 1]} : (f32x2){w0b[c], w0b[c + 1]}, w1 = e < 4 ? (f32x2){w1a[c], w1a[c + 1]} : (f32x2){w1b[c], w1b[c + 1]};
                    const f32x2 w2 = e < 4 ? (f32x2){w2a[c], w2a[c + 1]} : (f32x2){w2b[c], w2b[c + 1]}, w3 = e < 4 ? (f32x2){w3a[c], w3a[c + 1]} : (f32x2){w3b[c], w3b[c + 1]};
                    const f32x2 cbv = e < 4 ? (f32x2){cba[c], cba[c + 1]} : (f32x2){cbb[c], cbb[c + 1]};
                    const f32x2 r = cbv + w3 * x0 + w2 * x1 + w1 * x2 + w0 * x3;
                    xc[ks][e] = r.x; xc[ks][e + 1] = r.y;
                }
                prevx[ks] = x4[ks];
            }
            bfrag[ks] = __builtin_bit_cast(bf16x8, pack8(xc[ks]));
            if constexpr (IS_S) __builtin_amdgcn_sched_barrier(0);
        }
        f32x4 aa[8], ax[8];
#pragma unroll
        for (int nb = 0; nb < 8; ++nb) { aa[nb] = (f32x4){0.f, 0.f, 0.f, 0.f}; ax[nb] = (f32x4){0.f, 0.f, 0.f, 0.f}; }
#pragma unroll
        for (int ks = 0; ks < 4; ++ks)
#pragma unroll
            for (int nb = 0; nb < 8; ++nb) {
                const bf16x8 wa = *(const LAS bf16x8*)(lds + L_WA + (16 * nb + fr) * LW_STRIDE + (32 * ks + 8 * fq) * 2);
                const bf16x8 wx = *(const LAS bf16x8*)(lds + L_WX + (16 * nb + fr) * LW_STRIDE + (32 * ks + 8 * fq) * 2);
                aa[nb] = __builtin_amdgcn_mfma_f32_16x16x32_bf16(wa, bfrag[ks], aa[nb], 0, 0, 0);
                ax[nb] = __builtin_amdgcn_mfma_f32_16x16x32_bf16(wx, bfrag[ks], ax[nb], 0, 0, 0);
            }
        float y[4][8]; float ss = 0.f;
#pragma unroll
        for (int ks = 0; ks < 4; ++ks) {
            const f32x4 bga0 = *(const LAS f32x4*)(CT + 5 * 128 + 32 * ks), bga1 = *(const LAS f32x4*)(CT + 5 * 128 + 32 * ks + 4);
            const f32x4 bgx0 = *(const LAS f32x4*)(CT + 6 * 128 + 32 * ks), bgx1 = *(const LAS f32x4*)(CT + 6 * 128 + 32 * ks + 4);
            const f32x4 sp0 = *(const LAS f32x4*)(CT + 7 * 128 + 32 * ks), sp1 = *(const LAS f32x4*)(CT + 7 * 128 + 32 * ks + 4);
            float gav[8];
            if constexpr (PASS == 2) unpack8(g4[ks], gav);
            f32x4 h0a, h0b;
            if constexpr (IS_S) { const float* hp = p.st_h + (size_t)sq * DA + gch + 32 * ks; h0a = *(const f32x4*)hp; h0b = *(const f32x4*)(hp + 4); }
            float hv[8], Pv[8], Sv[8], lav[8];
#pragma unroll
            for (int e = 0; e < 8; e += 2) {
                const int nb = 2 * ks + (e >> 2), rg = e & 3;
                const f32x2 ba = e < 4 ? (f32x2){bga0[rg], bga0[rg + 1]} : (f32x2){bga1[rg], bga1[rg + 1]}, bx = e < 4 ? (f32x2){bgx0[rg], bgx0[rg + 1]} : (f32x2){bgx1[rg], bgx1[rg + 1]};
                const f32x2 spv = e < 4 ? (f32x2){sp0[rg], sp0[rg + 1]} : (f32x2){sp1[rg], sp1[rg + 1]};
                const f32x2 ta = (f32x2){aa[nb][rg], aa[nb][rg + 1]} * -1.4426950408889634f + ba, tx = (f32x2){ax[nb][rg], ax[nb][rg + 1]} * -1.4426950408889634f + bx;
                f32x2 ea, ex; ea.x = __builtin_amdgcn_exp2f(ta.x); ea.y = __builtin_amdgcn_exp2f(ta.y); ex.x = __builtin_amdgcn_exp2f(tx.x); ex.y = __builtin_amdgcn_exp2f(tx.y);
                ea = ea + 1.0f; ex = ex + 1.0f;
                f32x2 rr, ii; rr.x = __builtin_amdgcn_rcpf(ea.x); rr.y = __builtin_amdgcn_rcpf(ea.y); ii.x = __builtin_amdgcn_rcpf(ex.x); ii.y = __builtin_amdgcn_rcpf(ex.y);
                const f32x2 la = rr * spv;
                f32x2 a; a.x = __builtin_amdgcn_exp2f(la.x); a.y = __builtin_amdgcn_exp2f(la.y);
                const f32x2 om = 1.0f - a * a;
                f32x2 sq; sq.x = __builtin_amdgcn_sqrtf(om.x > 0.f ? om.x : 0.f); sq.y = __builtin_amdgcn_sqrtf(om.y > 0.f ? om.y : 0.f);
                const f32x2 uu = sq * (ii * (f32x2){xc[ks][e], xc[ks][e + 1]});
                Pv[e] = a.x; Pv[e + 1] = a.y; Sv[e] = uu.x; Sv[e + 1] = uu.y; lav[e] = la.x; lav[e + 1] = la.y;
            }
            if constexpr (PASS == 1 && !IS_S) {
                *(u32x4*)((bf16_t*)(p.ws + WS_LA) + (size_t)r * DA + gch + 32 * ks) = pack8(lav);
                *(u32x4*)((bf16_t*)(p.ws + WS_UU) + (size_t)r * DA + gch + 32 * ks) = pack8(Sv);
            }
            if constexpr (IS_S) {
#pragma unroll
                for (int e = 0; e < 8; ++e) { scan8(Pv[e], Sv[e], t8); hv[e] = __builtin_fmaf(Pv[e], e < 4 ? h0a[e & 3] : h0b[e & 3], Sv[e]); }
            } else {
#pragma unroll
                for (int e = 0; e < 8; e += 2) scan16x2(Pv[e], Sv[e], Pv[e + 1], Sv[e + 1]);
#pragma unroll
                for (int e = 0; e < 8; ++e) {
                    hv[e] = __builtin_fmaf(Pv[e], hin[ks][e], Sv[e]);
                    hin[ks][e] = bcast15(hv[e], lane);
                    if constexpr (PASS == 1) Pt[ks][e] *= bcast15(Pv[e], lane);
                }
            }
            if constexpr (PASS == 2) {
#pragma unroll
                for (int e = 0; e < 8; e += 2) { const f32x2 yy = gelu_mul2((f32x2){gav[e], gav[e + 1]}, (f32x2){hv[e], hv[e + 1]}); y[ks][e] = yy.x; y[ks][e + 1] = yy.y; ss += yy.x * yy.x + yy.y * yy.y; }
            }
            if constexpr (PASS == 2) {
                if (IS_S ? (t8 == 7) : (seg == LRU_NSEG - 1 && fr == 15)) {
                    float* ho = p.out + (IS_S ? O_SH + (size_t)sq * DA : O_PH + (size_t)b * DA) + gch + 32 * ks;
                    *(f32x4*)ho = (f32x4){hv[0], hv[1], hv[2], hv[3]}; *(f32x4*)(ho + 4) = (f32x4){hv[4], hv[5], hv[6], hv[7]};
                }
            }
        }
        if constexpr (PASS == 2) {
            ss += __shfl_xor(ss, 16); ss += __shfl_xor(ss, 32);
            const float rn = __builtin_amdgcn_rsqf(ss * (1.0f / 128.0f) + EPS);
#pragma unroll
            for (int ks = 0; ks < 4; ++ks) {
                const f32x4 g0 = *(const LAS f32x4*)(CT + 8 * 128 + 32 * ks), g1 = *(const LAS f32x4*)(CT + 8 * 128 + 32 * ks + 4);
                float o[8];
#pragma unroll
                for (int e = 0; e < 8; ++e) o[e] = y[ks][e] * rn * (e < 4 ? g0[e & 3] : g1[e & 3]);
                *(u32x4*)(ym + (size_t)r * DMIX + gch + 32 * ks) = pack8(o);
            }
        }
    }
    if constexpr (PASS == 1 && !IS_S) {
        if (fr == 0) {
            float* tp = tot + ((size_t)(b * LRU_NSEG + seg) * 2) * DA + gch;
#pragma unroll
            for (int ks = 0; ks < 4; ++ks) {
                *(f32x4*)(tp + 32 * ks) = (f32x4){Pt[ks][0], Pt[ks][1], Pt[ks][2], Pt[ks][3]}; *(f32x4*)(tp + 32 * ks + 4) = (f32x4){Pt[ks][4], Pt[ks][5], Pt[ks][6], Pt[ks][7]};
                *(f32x4*)(tp + DA + 32 * ks) = (f32x4){hin[ks][0], hin[ks][1], hin[ks][2], hin[ks][3]}; *(f32x4*)(tp + DA + 32 * ks + 4) = (f32x4){hin[ks][4], hin[ks][5], hin[ks][6], hin[ks][7]};
            }
        }
    }
}

__device__ __forceinline__ void lru_finish_item(PRef p, LAS unsigned char* lds, int n, int b, int seg) {
    const int lane = opaque_tid() & 63, fr = lane & 15, fq = lane >> 4;
    const bf16_t* z = (const bf16_t*)(p.ws + WS_Z);
    const bf16_t* lab = (const bf16_t*)(p.ws + WS_LA); const bf16_t* uub = (const bf16_t*)(p.ws + WS_UU);
    bf16_t* ym = (bf16_t*)(p.ws + WS_YM);
    const float* tot = (const float*)(p.ws + WS_TOT);
    const LAS float* CT = (const LAS float*)(lds + L_CT) + 8 * fq;
    const int gch = n * 128 + 8 * fq;
    const int r0 = b * TP + seg * 64;
    const int nblk = seg == LRU_NSEG - 1 ? 1 : 4;
    float hin[4][8];
#pragma unroll
    for (int ks = 0; ks < 4; ++ks)
#pragma unroll
        for (int e = 0; e < 8; ++e) hin[ks][e] = 0.f;
    u32x4 ln[4], un[4], gn[4];
#pragma unroll
    for (int ks = 0; ks < 4; ++ks) { ln[ks] = *(const u32x4*)(lab + (size_t)(r0 + fr) * DA + gch + 32 * ks); un[ks] = *(const u32x4*)(uub + (size_t)(r0 + fr) * DA + gch + 32 * ks);
        gn[ks] = *(const u32x4*)(z + (size_t)(r0 + fr) * DIN + DA + gch + 32 * ks); }
    if (seg > 0) {
#pragma unroll 1
        for (int round = 0; round < 2; ++round) {
            const int s = 16 * round + fr;
            if (16 * round >= seg) break;
            const bool have = s < seg;
            const float* tp = tot + ((size_t)(b * LRU_NSEG + (have ? s : 0)) * 2) * DA + gch;
#pragma unroll
            for (int ks = 0; ks < 4; ++ks) {
                const f32x4 P0 = *(const f32x4*)(tp + 32 * ks), P1 = *(const f32x4*)(tp + 32 * ks + 4), S0 = *(const f32x4*)(tp + DA + 32 * ks), S1 = *(const f32x4*)(tp + DA + 32 * ks + 4);
#pragma unroll
                for (int e = 0; e < 8; e += 2) {
                    float Pa = have ? (e < 4 ? P0[e & 3] : P1[e & 3]) : 1.f, Sa = have ? (e < 4 ? S0[e & 3] : S1[e & 3]) : 0.f;
                    float Pb = have ? (e < 4 ? P0[(e + 1) & 3] : P1[(e + 1) & 3]) : 1.f, Sb = have ? (e < 4 ? S0[(e + 1) & 3] : S1[(e + 1) & 3]) : 0.f;
                    scan16x2(Pa, Sa, Pb, Sb);
                    hin[ks][e] = __builtin_fmaf(bcast15(Pa, lane), hin[ks][e], bcast15(Sa, lane));
                    hin[ks][e + 1] = __builtin_fmaf(bcast15(Pb, lane), hin[ks][e + 1], bcast15(Sb, lane));
                }
            }
        }
    }
#pragma unroll 1
    for (int blk = 0; blk < nblk; ++blk) {
        const int r = r0 + 16 * blk + fr;
        u32x4 l4[4], u4[4], g4[4];
#pragma unroll
        for (int ks = 0; ks < 4; ++ks) { l4[ks] = ln[ks]; u4[ks] = un[ks]; g4[ks] = gn[ks]; }
        { const int rn_ = (blk + 1 < nblk) ? r + 16 : r;
#pragma unroll
          for (int ks = 0; ks < 4; ++ks) { ln[ks] = *(const u32x4*)(lab + (size_t)rn_ * DA + gch + 32 * ks); un[ks] = *(const u32x4*)(uub + (size_t)rn_ * DA + gch + 32 * ks);
              gn[ks] = *(const u32x4*)(z + (size_t)rn_ * DIN + DA + gch + 32 * ks); } }
        float y[4][8]; float ss = 0.f;
#pragma unroll
        for (int ks = 0; ks < 4; ++ks) {
            float Pv[8], Sv[8], gav[8], hv[8];
            unpack8(l4[ks], Pv); unpack8(u4[ks], Sv); unpack8(g4[ks], gav);
#pragma unroll
            for (int e = 0; e < 8; ++e) Pv[e] = __builtin_amdgcn_exp2f(Pv[e]);
#pragma unroll
            for (int e = 0; e < 8; e += 2) scan16x2(Pv[e], Sv[e], Pv[e + 1], Sv[e + 1]);
#pragma unroll
            for (int e = 0; e < 8; ++e) { hv[e] = __builtin_fmaf(Pv[e], hin[ks][e], Sv[e]); hin[ks][e] = bcast15(hv[e], lane); }
#pragma unroll
            for (int e = 0; e < 8; e += 2) { const f32x2 yy = gelu_mul2((f32x2){gav[e], gav[e + 1]}, (f32x2){hv[e], hv[e + 1]}); y[ks][e] = yy.x; y[ks][e + 1] = yy.y; ss += yy.x * yy.x + yy.y * yy.y; }
            if (seg == LRU_NSEG - 1 && fr == 15) {
                float* ho = p.out + O_PH + (size_t)b * DA + gch + 32 * ks;
                *(f32x4*)ho = (f32x4){hv[0], hv[1], hv[2], hv[3]}; *(f32x4*)(ho + 4) = (f32x4){hv[4], hv[5], hv[6], hv[7]};
            }
        }
        ss += __shfl_xor(ss, 16); ss += __shfl_xor(ss, 32);
        const float rn = __builtin_amdgcn_rsqf(ss * (1.0f / 128.0f) + EPS);
#pragma unroll
        for (int ks = 0; ks < 4; ++ks) {
            const f32x4 g0 = *(const LAS f32x4*)(CT + 8 * 128 + 32 * ks), g1 = *(const LAS f32x4*)(CT + 8 * 128 + 32 * ks + 4);
            float o[8];
#pragma unroll
            for (int e = 0; e < 8; ++e) o[e] = y[ks][e] * rn * (e < 4 ? g0[e & 3] : g1[e & 3]);
            *(u32x4*)(ym + (size_t)r * DMIX + gch + 32 * ks) = pack8(o);
        }
    }
}
template <int PASS>
__device__ __forceinline__ void mixer_phase(PRef p, LAS unsigned char* lds, int G) {
    const int tid = opaque_tid(), wave = __builtin_amdgcn_readfirstlane(tid >> 6);
    static_assert(NH * LRU_WG_PER_HEAD <= GRID, "one head group per workgroup");
    const int v = blockIdx.x, n = v / LRU_WG_PER_HEAD, jg = v % LRU_WG_PER_HEAD;
    const bool lru_wg = v < NH * LRU_WG_PER_HEAD && (PASS == 1 || jg < LRU_IDLE_J0);
    if (lru_wg) {
        __syncthreads();
        if (!(PASS == 2 && G == GRID && p.ph_lo <= 2))
        {
            const bf16_t* wg = (const bf16_t*)(p.ws + WS_WG);
            for (int i = tid; i < 2 * 128 * 16; i += 512) { const int g = i >> 11, row = (i >> 4) & 127, c16 = i & 15;
                *(LAS u32x4*)(lds + g * L_WX + row * LW_STRIDE + c16 * 16) = *(const u32x4*)(wg + (((size_t)g * NH + n) * 128 + row) * 128 + c16 * 8); }
            LAS float* CTw = (LAS float*)(lds + L_CT);
            for (int i = tid; i < 9 * 128; i += 512) { const int k = i >> 7, c = i & 127, ch = n * 128 + c;
                float vv;
                if (k < 4) vv = p.conv_a_w[k * DA + ch]; else if (k == 4) vv = p.conv_a_b[ch]; else if (k == 5) vv = -1.4426950408889634f * p.b_gate_a[ch]; else if (k == 6) vv = -1.4426950408889634f * p.b_gate_x[ch];
                else if (k == 7) vv = -8.0f * 1.4426950408889634f * log1pf(__expf(-p.lam[ch])); else vv = p.g_out_a[ch];
                CTw[i] = vv; }
        }
        __syncthreads();
        const int wi = jg * 8 + wave;
        if (wi < LRU_PITEMS) { if constexpr (PASS == 1) lru_wave_item<1, false>(p, lds, n, wi / LRU_NSEG, wi % LRU_NSEG); else lru_finish_item(p, lds, n, wi / LRU_NSEG, wi % LRU_NSEG); }
        else if (PASS == 1 && wi < LRU_PITEMS + LRU_SITEMS) lru_wave_item<2, true>(p, lds, n, wi - LRU_PITEMS, 0);
    } else if (G == GRID) {
        constexpr int NIDLE1 = GRID - NH * LRU_WG_PER_HEAD, PER_HEAD = LRU_WG_PER_HEAD - LRU_IDLE_J0, NIDLE2 = NIDLE1 + NH * PER_HEAD;
        const int idx = v >= NH * LRU_WG_PER_HEAD ? v - NH * LRU_WG_PER_HEAD : NIDLE1 + n * PER_HEAD + (jg - LRU_IDLE_J0);
        convert_items(p, lds, idx * 8 + wave, (PASS == 1 ? NIDLE1 : NIDLE2) * 8, PASS == 1 ? IT_S1 : IT_S2, PASS == 1 ? IT_S2 : IT_S3);
    }
    if (PASS == 1) { branch_b(p, G); if ((REP_MASK >> 11) & 1) branch_b(p, G); }
}

__device__ __forceinline__ void final_phase(PRef p, int G) {
    const int tid_ = opaque_tid(), lane = tid_ & 63, gw = blockIdx.x * 8 + (tid_ >> 6), NGW = G * 8;
    const bf16_t* x2b = (const bf16_t*)(p.ws + WS_YM);
    f32x4 gf[8];
#pragma unroll
    for (int j = 0; j < 8; ++j) gf[j] = ((const f32x4*)p.g_final)[lane + 64 * j];
    for (int o = gw; o < NB * SEQ + MSR; o += NGW) {
        const int r = o < NB * SEQ ? (o / SEQ) * TP + NMETA + (o % SEQ) : MPR + (o - NB * SEQ);
        const u32x2* xr = (const u32x2*)(x2b + (size_t)r * D) + lane;
        f32x4 v[8]; float s = 0.f;
#pragma unroll
        for (int j = 0; j < 8; ++j) { const u32x2 w = xr[64 * j]; v[j] = (f32x4){bf_lo(w.x), bf_hi(w.x), bf_lo(w.y), bf_hi(w.y)};
            s += (v[j][0] * v[j][0] + v[j][1] * v[j][1]) + (v[j][2] * v[j][2] + v[j][3] * v[j][3]); }
        s = wave_sum(s);
        const float rs = __builtin_amdgcn_rsqf(s * (1.0f / D) + EPS);
        f32x4* yo = (f32x4*)(p.out + (size_t)o * D) + lane;
#pragma unroll
        for (int j = 0; j < 8; ++j) yo[64 * j] = v[j] * rs * gf[j];
    }
}

#define XB_TMO      128
#define XB_XCNT(j)  (256  + 64 * (j))
#define XB_XSUB(j)  (1280 + 64 * (j))
#define XB_XGEN(j)  (2304 + 64 * (j))
#define XB_TOP      3328
#define XB_TOPGEN   3392
#define XCD_BAR_WORDS 3456
#define XB_SPIN_CAP (1u << 18)
__device__ __forceinline__ unsigned xb_ld(unsigned* p)              { return __hip_atomic_load(p, __ATOMIC_RELAXED, __HIP_MEMORY_SCOPE_AGENT); }
__device__ __forceinline__ unsigned xb_add(unsigned* p, unsigned v) { return __hip_atomic_fetch_add(p, v, __ATOMIC_RELAXED, __HIP_MEMORY_SCOPE_AGENT); }
__device__ __forceinline__ unsigned xb_xcc_id() { return (unsigned)__builtin_amdgcn_s_getreg((3 << 11) | 20) & 0xFu; }
#define XB_SPIN(cond, bar) do { unsigned _sp = 0; while (cond) { __builtin_amdgcn_s_sleep(1); \
    if ((++_sp & 255u) == 0u) { if (xb_ld(&(bar)[XB_TMO])) break; if (_sp > XB_SPIN_CAP) { atomicAdd(&(bar)[XB_TMO], 1u); break; } } } } while (0)
struct XcdBarrier { unsigned* bar; unsigned x; volatile LAS unsigned* st; };
__device__ __forceinline__ XcdBarrier xcd_barrier_post(unsigned* bar, volatile LAS unsigned* st) {
    XcdBarrier b; b.bar = bar; b.x = xb_xcc_id(); b.st = st;
    if (threadIdx.x == 0) (void)xb_add(&bar[XB_XCNT(b.x)], 1u);
    return b;
}
__device__ __forceinline__ void xcd_barrier_complete(unsigned* bar, unsigned x, unsigned& nloc, unsigned& nx) {
    const unsigned G = gridDim.x * gridDim.y * gridDim.z;
    unsigned sum, cnt, mine, sp = 0u;
    for (;;) {
        sum = 0u; cnt = 0u; mine = 0u;
#pragma unroll
        for (unsigned j = 0; j < 16; ++j) { const unsigned c = xb_ld(&bar[XB_XCNT(j)]); sum += c; cnt += (c > 0u) ? 1u : 0u; mine = (j == x) ? c : mine; }
        if (sum == G) break;
        __builtin_amdgcn_s_sleep(1);
        if ((++sp & 255u) == 0u) { if (xb_ld(&bar[XB_TMO])) break; if (sp > XB_SPIN_CAP) { atomicAdd(&bar[XB_TMO], 1u); break; } }
    }
    nloc = mine > 0u ? mine : 1u; nx = cnt > 0u ? cnt : 1u;
}
__device__ __forceinline__ void xcd_barrier(const XcdBarrier& b) {
    asm volatile("s_waitcnt vmcnt(0)" ::: "memory");
    __syncthreads();
    if (threadIdx.x == 0) {
        unsigned* bar = b.bar;
        __builtin_amdgcn_s_waitcnt(0);
        unsigned nloc = b.st[0], nx = b.st[1];
        if (nloc == 0u) { xcd_barrier_complete(bar, b.x, nloc, nx); b.st[0] = nloc; b.st[1] = nx; }
        const unsigned old = xb_add(&bar[XB_XSUB(b.x)], 1u);
        const unsigned gen = old / nloc;
        if (old + 1u == (gen + 1u) * nloc) {
            __builtin_amdgcn_fence(__ATOMIC_RELEASE, "agent");
            asm volatile("s_waitcnt vmcnt(0)" ::: "memory");
            const unsigned og = xb_add(&bar[XB_TOP], 1u);
            const unsigned tg = og / nx;
            if (og + 1u == (tg + 1u) * nx) xb_add(&bar[XB_TOPGEN], 1u);
            else XB_SPIN(xb_ld(&bar[XB_TOPGEN]) == tg, bar);
            __builtin_amdgcn_fence(__ATOMIC_ACQUIRE, "agent");
            xb_add(&bar[XB_XGEN(b.x)], 1u);
            asm volatile("s_waitcnt vmcnt(0)" ::: "memory");
        } else {
            XB_SPIN(xb_ld(&bar[XB_XGEN(b.x)]) == gen, bar);
            __builtin_amdgcn_fence(__ATOMIC_ACQUIRE, "agent");
            asm volatile("s_waitcnt vmcnt(0)" ::: "memory");
        }
    }
    __syncthreads();
}

constexpr int LDS_BYTES = 131072 + 1024 + 8 * 1024 + 8 * 2048;
constexpr int N_PHASES = 8;
__global__ void __launch_bounds__(512, 2) hymba_fwd(Params p) {
    extern __shared__ __attribute__((aligned(16))) unsigned char lds_raw[];
    LAS unsigned char* lds = (LAS unsigned char*)lds_raw;
    constexpr int G = GRID;
    if ((int)gridDim.x != GRID) return;
    const CAS Params* kp = (const CAS Params*)__builtin_amdgcn_kernarg_segment_ptr();
#define P_HERE (*({ const CAS Params* q_ = kp; asm volatile("" : "+s"(q_)); q_; }))
    unsigned char* ws = p.ws;
    volatile LAS unsigned* misc = (volatile LAS unsigned*)(lds + 131072);
    if (threadIdx.x < 8) misc[threadIdx.x] = 0u;
    __syncthreads();
    XcdBarrier bar = xcd_barrier_post((unsigned*)ws, misc);
    const int lo = p.ph_lo, hi = p.ph_hi;
#ifndef PH_MASK
#define PH_MASK 0xff
#endif
#define IN(k) (((PH_MASK >> (k)) & 1) && lo <= (k) && (k) < hi)
#define SEAM(k) do { if (IN(k) && IN((k) + 1)) xcd_barrier(bar); } while (0)
#define REPEAT(k) _Pragma("nounroll") for (int rep_ = 0; rep_ < ((((REP_MASK) >> (k)) & 1) ? 2 : 1); ++rep_, (rep_ < ((((REP_MASK) >> (k)) & 1) ? 2 : 1) ? xcd_barrier(bar) : (void)0))
    if ((REP_MASK >> 12) & 1) { xcd_barrier(bar); xcd_barrier(bar); xcd_barrier(bar); xcd_barrier(bar); }
    if (IN(0)) REPEAT(0) phase0(P_HERE, lds, G);
    SEAM(0);
    if (IN(1)) REPEAT(1) {
        pg8::Gemm g{(const bf16_t*)(ws + WS_XB) + (size_t)16 * D, (const bf16_t*)(ws + WS_WIN), MP / 256, DIN / 256, D, (size_t)256 * D * 2, (size_t)128 * D * 2};
        pg8::StaticOrder S; S.init(g.nM, g.nN, G, (int)blockIdx.x, D / 64, 1);
        LAS float* rstab1 = (LAS float*)(lds + 131072 + 1024);
        rstd1_table((const float*)(ws + WS_RS1), rstab1, S); __syncthreads();
        PRef q = P_HERE; EpiZ E{rstab1, (bf16_t*)(ws + WS_Z), q.out};
        pg8::gemm_phase<EpiZ, false, true, true>(lds, g, S, E, nullptr, nullptr);
        if ((int)blockIdx.x >= P1_TAIL_WG0 && G == 256) convert_items(P_HERE, lds, ((int)blockIdx.x - P1_TAIL_WG0) * 8 + (opaque_tid() >> 6), (G - P1_TAIL_WG0) * 8, IT_O, IT_S1);
        else if (G != 256) convert_items(P_HERE, lds, (int)blockIdx.x * 8 + (opaque_tid() >> 6), G * 8, IT_O, IT_S3);
    }
    SEAM(1);
    if (IN(2)) REPEAT(2) mixer_phase<1>(P_HERE, lds, G);
    SEAM(2);
    if (IN(3)) REPEAT(3) mixer_phase<2>(P_HERE, lds, G);
    SEAM(3);
    if (IN(4)) REPEAT(4) {
        pg8::Gemm g{(const bf16_t*)(ws + WS_YM), (const bf16_t*)(ws + WS_WO), MP / 256, D / 256, DMIX, (size_t)256 * DMIX * 2, (size_t)128 * DMIX * 2};
        pg8::StaticOrder S; S.init(g.nM, g.nN, G, (int)blockIdx.x, DMIX / 64, P4_SPLIT);
        EpiX1 E{(bf16_t*)(ws + WS_XB) + (size_t)16 * D, (float*)(ws + WS_SSQ)};
        pg8::gemm_phase<EpiX1, false, true, true>(lds, g, S, E, (float*)(ws + WS_Z), (unsigned*)ws + CW_TK4 + rep_ * 128 * 64);
        if ((int)blockIdx.x >= P4_TAIL_WG0 && G == 256) convert_items(P_HERE, lds, ((int)blockIdx.x - P4_TAIL_WG0) * 8 + (opaque_tid() >> 6), (G - P4_TAIL_WG0) * 8, IT_S3, IT_G);
        else if (G != 256) convert_items(P_HERE, lds, (int)blockIdx.x * 8 + (opaque_tid() >> 6), G * 8, IT_S3, IT_G);
    }
    SEAM(4);
    if (IN(5)) REPEAT(5) {
        pg8::Gemm g{(const bf16_t*)(ws + WS_XB) + (size_t)14 * D, (const bf16_t*)(ws + WS_WUP), 37, 2 * DFF / 256, D, (size_t)252 * D * 2, (size_t)64 * D * 2};
        pg8::StaticOrder S; S.init(g.nM, g.nN, G, (int)blockIdx.x, D / 64, 1);
        LAS float* rstab = (LAS float*)(lds + 131072 + 1024); LAS float* wtab = rstab + 8 * 256;
        PRef q = P_HERE; ffn_rstd_table((const float*)(ws + WS_SSQ), q.conv_f_w, q.conv_f_b, rstab, wtab, S); __syncthreads();
        EpiFFN E{q.st_fc, (bf16_t*)(ws + WS_Z), q.out, rstab, wtab};
        pg8::gemm_phase<EpiFFN, true, true, true>(lds, g, S, E, nullptr, nullptr);
    }
    SEAM(5);
    if (IN(6)) {
        pg8::Gemm g{(const bf16_t*)(ws + WS_Z), (const bf16_t*)(ws + WS_WDN), MP / 256, D / 256, DFF, (size_t)256 * DFF * 2, (size_t)128 * DFF * 2};
        pg8::StaticOrder S; S.init(g.nM, g.nN, G, (int)blockIdx.x, DFF / 64, P6_SPLIT);
        EpiOut E{(const bf16_t*)(ws + WS_XB) + (size_t)16 * D, (bf16_t*)(ws + WS_YM)};
        pg8::gemm_phase<EpiOut, false, true, true>(lds, g, S, E, (float*)(ws + WS_WIN), (unsigned*)ws + CW_TK6);
    }
    SEAM(6);
    if (IN(7)) REPEAT(7) final_phase(P_HERE, G);
#undef IN
#undef SEAM
}

extern "C" void kernel_launch(void* const* d_in, const int* in_sizes, int n_in, void* d_out, int out_size, void* d_ws, size_t ws_size, hipStream_t stream) {
    static int grid = 0;
    if (grid == 0) {
        if (n_in != 26 || (size_t)out_size != O_END || ws_size < WS_END) { fprintf(stderr, "kernel_launch: unexpected problem (n_in %d, out %d, ws %zu; need ws >= %zu)\n", n_in, out_size, ws_size, (size_t)WS_END); grid = -1; return; }
        int dev = 0, cus = 0, per_cu = 0;
        hipGetDevice(&dev); hipDeviceGetAttribute(&cus, hipDeviceAttributeMultiprocessorCount, dev);
        if (hipFuncSetAttribute((const void*)hymba_fwd, hipFuncAttributeMaxDynamicSharedMemorySize, LDS_BYTES) != hipSuccess) { fprintf(stderr, "kernel_launch: hipFuncSetAttribute failed\n"); grid = -1; return; }
        if (hipOccupancyMaxActiveBlocksPerMultiprocessor(&per_cu, (const void*)hymba_fwd, 512, LDS_BYTES) != hipSuccess || per_cu < 1) { fprintf(stderr, "kernel_launch: occupancy query says %d\n", per_cu); grid = -1; return; }
        if (cus < GRID) { fprintf(stderr, "kernel_launch: built for a %d-CU device, found %d CUs\n", GRID, cus); grid = -1; return; }
        grid = GRID;
    }
    if (grid < 0) return;
    Params p{};
    const float** f = (const float**)&p;
    for (int i = 0; i < 26; ++i) f[i] = (const float*)d_in[i];
    p.out = (float*)d_out; p.ws = (unsigned char*)d_ws;
    if (hipMemsetAsync(d_ws, 0, CTL_WORDS * 4, stream) != hipSuccess) { fprintf(stderr, "kernel_launch: memset failed\n"); return; }
    if (MK_N_LAUNCHES == 1) {
        p.ph_lo = 0; p.ph_hi = N_PHASES;
        hipLaunchKernelGGL(hymba_fwd, dim3(grid), dim3(512), LDS_BYTES, stream, p);
    } else {
        for (int k = 0; k < N_PHASES; ++k) { p.ph_lo = k; p.ph_hi = k + 1; hipLaunchKernelGGL(hymba_fwd, dim3(grid), dim3(512), LDS_BYTES, stream, p); }
    }
}
```

```cpp
#include <hip/hip_runtime.h>
#include <cstdio>

#ifndef REP_MASK
#define REP_MASK 0x00
#endif
#ifndef MK_N_LAUNCHES
#define MK_N_LAUNCHES 1
#endif

#define LAS __attribute__((address_space(3)))
#define CAS __attribute__((address_space(4)))
typedef unsigned short bf16_t;
typedef short bf16x8 __attribute__((ext_vector_type(8)));
typedef float f32x4 __attribute__((ext_vector_type(4)));
typedef unsigned u32x4 __attribute__((ext_vector_type(4)));
typedef unsigned u32x2 __attribute__((ext_vector_type(2)));

constexpr int D = 2048, NMETA = 16, SEQ = 2048, TP = SEQ + NMETA, NB = 4, MPR = NB * TP;
constexpr int NS = 128, TS = 8, MSR = NS * TS, M = MPR + MSR;
constexpr int MP = 9472;
constexpr int DA = 1536, DB = 1024, DIN = 6144, DMIX = 2560, DFF = 6144, NH = 12;
constexpr float EPS = 1e-6f;
constexpr int NCH = 33;
constexpr size_t O_YP = 0, O_YS = O_YP + (size_t)NB * SEQ * D, O_PH = O_YS + (size_t)MSR * D, O_PRC = O_PH + NB * DA,
                 O_PSC = O_PRC + NB * 3 * DA, O_PFC = O_PSC + NB * 2 * DB, O_SH = O_PFC + NB * 2 * DFF, O_SRC = O_SH + NS * DA,
                 O_SSC = O_SRC + (size_t)NS * 3 * DA, O_SFC = O_SSC + (size_t)NS * 2 * DB, O_END = O_SFC + (size_t)NS * 2 * DFF;
constexpr size_t MiB = 1u << 20;
constexpr int CW_TK6 = 4096, CTL_WORDS = 4096 + 256 * 64;
constexpr int P6_SPLIT = 6, P4_SPLIT = 4, CW_TK4 = CW_TK6 + 64 * 64;
constexpr int GRID = 256;
constexpr size_t WS_WIN = 1 * MiB;
constexpr size_t WS_WO = WS_WIN + (size_t)DIN * D * 2;
constexpr size_t WS_WUP = WS_WO + (size_t)D * DMIX * 2;
constexpr size_t WS_WDN = WS_WUP + (size_t)2 * DFF * D * 2;
constexpr size_t WS_WG = WS_WDN + (size_t)D * DFF * 2;
constexpr size_t WS_XB = WS_WG + (size_t)2 * NH * 128 * 128 * 2;
constexpr size_t XB_ROWS = 9600;
constexpr size_t WS_Z = WS_XB + XB_ROWS * D * 2;
constexpr size_t WS_YM = WS_Z + (size_t)MP * DIN * 2;
constexpr size_t WS_RS1 = WS_YM + (size_t)MP * DMIX * 2;
constexpr size_t WS_SSQ = WS_RS1 + (size_t)MP * 4;
constexpr size_t WS_TOT = WS_SSQ + (size_t)MP * 32 * 4;
constexpr size_t WS_LA = WS_TOT + (size_t)NB * NCH * DA * 2 * 4;
constexpr size_t WS_UU = WS_LA + (size_t)MPR * DA * 2;
constexpr size_t WS_END = WS_UU + (size_t)MPR * DA * 2;

struct Params;
typedef const CAS Params& PRef;
struct Params {
    const float *x_prompt, *x_sample, *st_h, *st_rc, *st_sc, *st_fc, *meta, *g_mix, *w_in, *conv_a_w, *conv_a_b, *w_gate_a, *b_gate_a,
        *w_gate_x, *b_gate_x, *lam, *conv_b_w, *g_out_a, *g_out_b, *w_o, *g_ffn, *w_up, *conv_f_w, *conv_f_b, *w_down, *g_final;
    float* out; unsigned char* ws; int ph_lo, ph_hi;
};

__device__ __forceinline__ unsigned cvt_pk_bf16(float lo, float hi) { unsigned r; asm volatile("v_cvt_pk_bf16_f32 %0, %1, %2" : "=v"(r) : "v"(lo), "v"(hi)); return r; }
__device__ __forceinline__ float bf_lo(unsigned w) { return __builtin_bit_cast(float, w << 16); }
__device__ __forceinline__ float bf_hi(unsigned w) { return __builtin_bit_cast(float, w & 0xffff0000u); }
__device__ __forceinline__ void unpack8(const u32x4 w, float (&f)[8]) { f[0] = bf_lo(w.x); f[1] = bf_hi(w.x); f[2] = bf_lo(w.y); f[3] = bf_hi(w.y); f[4] = bf_lo(w.z); f[5] = bf_hi(w.z); f[6] = bf_lo(w.w); f[7] = bf_hi(w.w); }
__device__ __forceinline__ u32x4 pack8(const float (&f)[8]) { u32x4 w; w.x = cvt_pk_bf16(f[0], f[1]); w.y = cvt_pk_bf16(f[2], f[3]); w.z = cvt_pk_bf16(f[4], f[5]); w.w = cvt_pk_bf16(f[6], f[7]); return w; }
__device__ __forceinline__ float wave_sum(float v) {
#pragma unroll
    for (int o = 1; o < 64; o <<= 1) v += __shfl_xor(v, o);
    return v;
}
__device__ __forceinline__ float sum16(float v) {
    v += __shfl_xor(v, 1); v += __shfl_xor(v, 2); v += __shfl_xor(v, 4); v += __shfl_xor(v, 8); return v;
}
__device__ __forceinline__ float sigmoidf_(float x) { return __builtin_amdgcn_rcpf(1.0f + __expf(-x)); }
__device__ __forceinline__ float gelu_tanh(float x) {
    constexpr float K1 = -2.0f * 0.7978845608028654f * 1.4426950408889634f, K2 = K1 * 0.044715f;
    const float t = x * __builtin_fmaf(x * x, K2, K1);
    return x * __builtin_amdgcn_rcpf(1.0f + __builtin_amdgcn_exp2f(t));
}
__device__ __forceinline__ int opaque_tid() { int t = threadIdx.x; asm volatile("" : "+v"(t)); return t; }
typedef float f32x2 __attribute__((ext_vector_type(2)));
__device__ __forceinline__ f32x2 gelu_mul2(f32x2 g, f32x2 v) {
    constexpr float K1 = -2.0f * 0.7978845608028654f * 1.4426950408889634f, K2 = K1 * 0.044715f;
    const f32x2 t = g * ((g * g) * K2 + K1);
    f32x2 e; e.x = __builtin_amdgcn_exp2f(t.x); e.y = __builtin_amdgcn_exp2f(t.y);
    const f32x2 d = e + 1.0f;
    f32x2 r; r.x = __builtin_amdgcn_rcpf(d.x); r.y = __builtin_amdgcn_rcpf(d.y);
    return (g * v) * r;
}
template <int CTRL> __device__ __forceinline__ float dppf(float old, float src) {
    return __builtin_bit_cast(float, __builtin_amdgcn_update_dpp(__builtin_bit_cast(int, old), __builtin_bit_cast(int, src), CTRL, 0xF, 0xF, false));
}
__device__ __forceinline__ void row_decode(int r, int& is_s, int& seq, int& t) {
    if (r < MPR) { seq = (r >= TP) + (r >= 2 * TP) + (r >= 3 * TP); t = r - seq * TP; is_s = 0; }
    else { const int q = r - MPR; seq = q >> 3; t = q & 7; is_s = 1; }
}
__device__ __forceinline__ const float* x_row_ptr(const float* xp, const float* xs, const float* meta, int r) {
    int is_s, seq, t; row_decode(r, is_s, seq, t);
    if (is_s) return xs + (size_t)(r - MPR) * D;
    return t < NMETA ? meta + (size_t)t * D : xp + ((size_t)seq * SEQ + (t - NMETA)) * D;
}
__device__ __forceinline__ float* y_row_ptr(float* out, int r) {
    if (r >= M) return nullptr;
    int is_s, seq, t; row_decode(r, is_s, seq, t);
    if (is_s) return out + O_YS + (size_t)(r - MPR) * D;
    return t < NMETA ? nullptr : out + O_YP + ((size_t)seq * SEQ + (t - NMETA)) * D;
}

namespace pg8 {
constexpr int BM = 256, BK = 64, HALF = 128, HTB = HALF * BK * 2, STAGE_BYTES = 8 * HTB, NXCD = 8, WGM = 2;
__host__ __device__ __forceinline__ int lds_byte(int r, int c) { const int st = (r >> 4) * 2 + (c >> 5), rr = r & 15, cc = c & 31, ob = rr * 64 + cc * 2; return st * 1024 + (ob ^ (((ob >> 9) & 1) << 5)); }
__host__ __device__ __forceinline__ void stage_rc(int b, int& R, int& C) { const int st = b / 1024, sb = b % 1024, swz = sb ^ (((sb >> 9) & 1) << 5); R = (st >> 1) * 16 + swz / 64; C = (st & 1) * 32 + (swz % 64) / 2; }
struct Unit { int pm, pn, kb, nk, piece, lu, idx; };
struct Gemm { const bf16_t* A; const bf16_t* Bt; int nM, nN, K; size_t a_tstep, a_hstep; };
struct StaticOrder {
    int nM, nN, nwg, G, c, nt, split, nfull, nleft, limit = 1 << 20, first = 0;
    __device__ __forceinline__ void init(int nM_, int nN_, int G_, int c_, int nt_, int split_) { nM = nM_; nN = nN_; nwg = nM * nN; G = G_; c = c_; nt = nt_; nfull = (nwg / G) * G; nleft = nwg - nfull;
        split = (split_ > 1 && nleft > 0 && nleft * split_ <= G && (nt / split_) * split_ == nt && ((nt / split_) & 1) == 0) ? split_ : 1; }
    __device__ __forceinline__ void map(int L, Unit& u) const {
        int wgid = L; { const int q = nwg / NXCD, r = nwg % NXCD, xcd = wgid % NXCD, off = wgid / NXCD; wgid = (xcd < r ? xcd * (q + 1) : r * (q + 1) + (xcd - r) * q) + off; }
        const int nig = WGM * nN, gid = wgid / nig, rem = wgid - gid * nig, fm = gid * WGM, glast = nM % WGM;
        if (nM - fm >= WGM || glast == 0) { u.pm = fm + (rem & (WGM - 1)); u.pn = rem / WGM; }
        else { u.pm = fm + rem % glast; u.pn = rem / glast; }
    }
    __device__ __forceinline__ bool next(int i, Unit& u) const {
        u.kb = 0; u.nk = nt; u.piece = -1; u.lu = 0; u.idx = i;
        i += first; if (i >= limit) return false;
        const long L = (long)i * G + c;
        if (L < nfull || split == 1) { if (L >= nwg) return false; map((int)L, u); return true; }
        if (L >= nfull + G || c >= nleft * split) return false;
        u.lu = c % nleft; u.piece = c / nleft; u.nk = nt / split; u.kb = u.piece * u.nk; map(nfull + u.lu, u); return true;
    }
};

constexpr int SLAB_SLOTS = 6;
template <int P, int A, int Mi>
__device__ __forceinline__ void reduce_rowgroup(f32x4 (&acc)[2][2][4][2], const unsigned char* slab0, int tid, int nsl) {
    const unsigned char* sp = slab0 + (size_t)((A * 4 + Mi) * SLAB_SLOTS) * 16384 + tid * 16;
#pragma unroll
    for (int b = 0; b < 2; ++b) {
        f32x4 s0 = (f32x4){0.f, 0.f, 0.f, 0.f}, s1 = s0;
#pragma unroll
        for (int src = 0; src < SLAB_SLOTS; ++src) {
            if (src == P) { s0 += acc[A][b][Mi][0]; s1 += acc[A][b][Mi][1]; }
            else if (src < 4 || src < nsl) { float f[8]; unpack8(*(const u32x4*)(sp + (size_t)src * 16384 + b * 8192), f); s0 += (f32x4){f[0], f[1], f[2], f[3]}; s1 += (f32x4){f[4], f[5], f[6], f[7]}; }
        }
        acc[A][b][Mi][0] = s0; acc[A][b][Mi][1] = s1;
    }
}
template <class Epi, bool FFNMAP, bool ALIGN_EPI, bool SP2>
__device__ __forceinline__ void gemm_phase(LAS unsigned char* lds, const Gemm g, const StaticOrder& S, const Epi& E, float* slabs, unsigned* tickets, bool dry = false) {
    int tid = threadIdx.x; asm volatile("" : "+v"(tid));
    const int wid = __builtin_amdgcn_readfirstlane(tid >> 6), lane = tid & 63, wr = wid >> 2, wc = wid & 3, fr = lane & 15, fq = lane >> 4;
    const int K = g.K;
    unsigned voffA[2], voffB[2];
#pragma unroll
    for (int i = 0; i < 2; ++i) { int R, C; stage_rc(tid * 16 + i * 8192, R, C); const int Ra = FFNMAP ? (126 * (R >> 6) + 4 * (R & 15) + ((R >> 4) & 3)) : R;
        voffA[i] = (unsigned)(Ra * K + C) * 2u; voffB[i] = (unsigned)(R * K + C) * 2u; }
    const size_t kstep = (size_t)(BK * 2);
    const size_t hstepA = g.a_hstep, tstepA = g.a_tstep;
    const size_t hstepB = (size_t)HALF * K * 2, tstepB = 2 * hstepB;
    const unsigned ldsw = (unsigned)wid * 1024u;
    const int aoff = lds_byte(wr * 64 + fr, fq * 8), boff = lds_byte(wc * 32 + fr, fq * 8);
#define PG8_SA(b, h) (((b) * 2 + (h)) * HTB)
#define PG8_SB(b, h) ((4 + (b) * 2 + (h)) * HTB)
#define PG8_STAGE(bufoff, gbase, voff) do { _Pragma("unroll") for (int _i = 0; _i < 2; ++_i) \
        __builtin_amdgcn_global_load_lds((const unsigned*)((const char*)(gbase) + (voff)[_i]), (LAS unsigned*)(lds + (bufoff) + ldsw + _i * 8192), 16, 0, 0); } while (0)
#define PG8_LDA(dst, b, h) do { _Pragma("unroll") for (int m = 0; m < 4; ++m) _Pragma("unroll") for (int k = 0; k < 2; ++k) dst[m][k] = *(const LAS bf16x8*)(lds + PG8_SA(b, h) + aoff + m * 2048 + k * 1024); } while (0)
#define PG8_LDB(dst, b, h) do { _Pragma("unroll") for (int n = 0; n < 2; ++n) _Pragma("unroll") for (int k = 0; k < 2; ++k) dst[n][k] = *(const LAS bf16x8*)(lds + PG8_SB(b, h) + boff + n * 2048 + k * 1024); } while (0)
#define PG8_MMA(ai, bj, At, Bt) do { __builtin_amdgcn_s_setprio(1); _Pragma("unroll") for (int m = 0; m < 4; ++m) _Pragma("unroll") for (int n = 0; n < 2; ++n) _Pragma("unroll") for (int k = 0; k < 2; ++k) \
        acc[ai][bj][m][n] = __builtin_amdgcn_mfma_f32_16x16x32_bf16(Bt[n][k], At[m][k], acc[ai][bj][m][n], 0, 0, 0); __builtin_amdgcn_s_setprio(0); } while (0)
#define PG8_WAIT_V(n) asm volatile("s_waitcnt vmcnt(" #n ")" ::: "memory")
#define PG8_WAIT_L(n) asm volatile("s_waitcnt lgkmcnt(" #n ")" ::: "memory")
#define PG8_BAR __builtin_amdgcn_s_barrier()
#define PG8_SCHED __builtin_amdgcn_sched_barrier(0)
    Unit cur, nxt; int ui = 0;
    if (!S.next(0, cur)) return;
    f32x4 acc[2][2][4][2];
#pragma unroll
    for (int a = 0; a < 2; ++a)
#pragma unroll
        for (int b = 0; b < 2; ++b)
#pragma unroll
            for (int m = 0; m < 4; ++m)
#pragma unroll
                for (int n = 0; n < 2; ++n) acc[a][b][m][n] = (f32x4){0.f, 0.f, 0.f, 0.f};
    bf16x8 At[4][2], B0[2][2], B1[2][2];
    const char* cA = (const char*)g.A + (size_t)cur.pm * tstepA + (size_t)cur.kb * kstep; const char* cB = (const char*)g.Bt + (size_t)cur.pn * tstepB + (size_t)cur.kb * kstep;
    if constexpr (SP2) {
        PG8_STAGE(PG8_SB(0, 0), cB, voffB); PG8_STAGE(PG8_SB(0, 1), cB + hstepB, voffB); PG8_STAGE(PG8_SA(0, 0), cA, voffA); PG8_STAGE(PG8_SA(0, 1), cA + hstepA, voffA);
        if (wr == 1) PG8_BAR;
        PG8_WAIT_V(2); PG8_BAR;
        PG8_STAGE(PG8_SB(1, 0), cB + kstep, voffB); PG8_STAGE(PG8_SA(1, 0), cA + kstep, voffA); PG8_STAGE(PG8_SB(1, 1), cB + hstepB + kstep, voffB);
        PG8_WAIT_V(6); PG8_BAR;
    } else {
        PG8_STAGE(PG8_SB(0, 0), cB, voffB); PG8_STAGE(PG8_SA(0, 0), cA, voffA); PG8_STAGE(PG8_SB(0, 1), cB + hstepB, voffB); PG8_STAGE(PG8_SA(0, 1), cA + hstepA, voffA);
        if (wr == 1) PG8_BAR;
        PG8_WAIT_V(4); PG8_BAR;
        PG8_STAGE(PG8_SB(1, 0), cB + kstep, voffB); PG8_STAGE(PG8_SA(1, 0), cA + kstep, voffA); PG8_STAGE(PG8_SB(1, 1), cB + hstepB + kstep, voffB);
        PG8_WAIT_V(6); PG8_BAR;
    }
    for (;;) {
        const bool has_next = S.next(ui + 1, nxt);
        const char* nA = has_next ? (const char*)g.A + (size_t)nxt.pm * tstepA + (size_t)nxt.kb * kstep : cA; const char* nB = has_next ? (const char*)g.Bt + (size_t)nxt.pn * tstepB + (size_t)nxt.kb * kstep : cB;
        const int nt = cur.nk;
        for (int t = 0; t < nt; t += 2) {
            const bool last = (t == nt - 2);
            const char* a1 = cA + (size_t)(t + 1) * kstep;
            const char* a2 = last ? nA : cA + (size_t)(t + 2) * kstep; const char* b2 = last ? nB : cB + (size_t)(t + 2) * kstep;
            const char* a3 = a2 + kstep; const char* b3 = b2 + kstep;
            if constexpr (SP2) {
            PG8_LDB(B0, 0, 0); PG8_LDB(B1, 0, 1); PG8_SCHED; PG8_LDA(At, 0, 0); PG8_STAGE(PG8_SA(1, 1), a1 + hstepA, voffA);
            PG8_WAIT_V(8); PG8_WAIT_L(0); PG8_BAR; PG8_MMA(0, 0, At, B0); PG8_MMA(0, 1, At, B1); PG8_BAR; PG8_SCHED;
            PG8_LDA(At, 0, 1); PG8_STAGE(PG8_SB(0, 0), b2, voffB); PG8_STAGE(PG8_SB(0, 1), b2 + hstepB, voffB); PG8_STAGE(PG8_SA(0, 0), a2, voffA);
            PG8_WAIT_V(8); PG8_WAIT_L(0); PG8_BAR; PG8_MMA(1, 0, At, B0); PG8_MMA(1, 1, At, B1); PG8_BAR; PG8_SCHED;
            PG8_LDB(B0, 1, 0); PG8_LDB(B1, 1, 1); PG8_SCHED; PG8_LDA(At, 1, 0); PG8_STAGE(PG8_SA(0, 1), a2 + hstepA, voffA);
            PG8_WAIT_V(8); PG8_WAIT_L(0); PG8_BAR; PG8_MMA(0, 0, At, B0); PG8_MMA(0, 1, At, B1); PG8_BAR; PG8_SCHED;
            PG8_LDA(At, 1, 1); PG8_STAGE(PG8_SB(1, 0), b3, voffB); PG8_STAGE(PG8_SB(1, 1), b3 + hstepB, voffB); PG8_STAGE(PG8_SA(1, 0), a3, voffA);
            PG8_WAIT_V(8); PG8_WAIT_L(0); PG8_BAR; PG8_MMA(1, 0, At, B0); PG8_MMA(1, 1, At, B1); PG8_BAR; PG8_SCHED;
            } else {
            PG8_LDB(B0, 0, 0); PG8_SCHED; PG8_LDA(At, 0, 0); PG8_STAGE(PG8_SA(1, 1), a1 + hstepA, voffA);
            PG8_WAIT_L(8); PG8_BAR; PG8_WAIT_L(0); PG8_MMA(0, 0, At, B0); PG8_BAR; PG8_SCHED;
            PG8_LDB(B1, 0, 1); PG8_STAGE(PG8_SB(0, 0), b2, voffB);
            PG8_BAR; PG8_WAIT_L(0); PG8_MMA(0, 1, At, B1); PG8_BAR;
            PG8_LDA(At, 0, 1); PG8_STAGE(PG8_SA(0, 0), a2, voffA);
            PG8_BAR; PG8_WAIT_L(0); PG8_MMA(1, 0, At, B0); PG8_BAR; PG8_SCHED;
            PG8_STAGE(PG8_SB(0, 1), b2 + hstepB, voffB);
            PG8_WAIT_V(6); PG8_BAR; PG8_MMA(1, 1, At, B1); PG8_BAR;
            PG8_LDB(B0, 1, 0); PG8_SCHED; PG8_LDA(At, 1, 0); PG8_STAGE(PG8_SA(0, 1), a2 + hstepA, voffA);
            PG8_WAIT_L(8); PG8_BAR; PG8_WAIT_L(0); PG8_MMA(0, 0, At, B0); PG8_BAR; PG8_SCHED;
            PG8_LDB(B1, 1, 1); PG8_STAGE(PG8_SB(1, 0), b3, voffB);
            PG8_BAR; PG8_WAIT_L(0); PG8_MMA(0, 1, At, B1); PG8_BAR;
            PG8_LDA(At, 1, 1); PG8_STAGE(PG8_SA(1, 0), a3, voffA);
            PG8_BAR; PG8_WAIT_L(0); PG8_MMA(1, 0, At, B0); PG8_BAR; PG8_SCHED;
            PG8_STAGE(PG8_SB(1, 1), b3 + hstepB, voffB);
            PG8_WAIT_V(6); PG8_BAR; PG8_MMA(1, 1, At, B1); PG8_BAR;
            }
        }
        if constexpr (ALIGN_EPI) { if (wr == 0) PG8_BAR; }
        if (cur.piece < 0 && !dry) E(acc, cur, wr, wc, fr, fq);
        if (!has_next) break;
#pragma unroll
        for (int a = 0; a < 2; ++a)
#pragma unroll
            for (int b = 0; b < 2; ++b)
#pragma unroll
                for (int m = 0; m < 4; ++m)
#pragma unroll
                    for (int n = 0; n < 2; ++n) acc[a][b][m][n] = (f32x4){0.f, 0.f, 0.f, 0.f};
        cur = nxt; cA = nA; cB = nB; ++ui;
        if constexpr (ALIGN_EPI) { if (wr == 1) PG8_BAR; }
    }
    PG8_WAIT_V(0);
    if constexpr (!ALIGN_EPI) { if (wr == 0) PG8_BAR; }
    PG8_BAR;
    if constexpr (Epi::SPLIT) {
    if (cur.piece >= 0 && !dry) {
        unsigned char* slab0 = (unsigned char*)slabs + (size_t)cur.lu * (8 * SLAB_SLOTS * 16384);
        {
            const __amdgpu_buffer_rsrc_t rs = __builtin_amdgcn_make_buffer_rsrc((void*)slab0, (short)0, 8 * SLAB_SLOTS * 16384, 0x00020000);
#pragma unroll
            for (int a = 0; a < 2; ++a)
#pragma unroll
                for (int m = 0; m < 4; ++m) {
                    const int gq = a * 4 + m;
                    if ((gq >> 1) != cur.piece) {
#pragma unroll
                        for (int b = 0; b < 2; ++b) { const f32x4 v0 = acc[a][b][m][0], v1 = acc[a][b][m][1];
                            u32x4 w; w.x = cvt_pk_bf16(v0[0], v0[1]); w.y = cvt_pk_bf16(v0[2], v0[3]); w.z = cvt_pk_bf16(v1[0], v1[1]); w.w = cvt_pk_bf16(v1[2], v1[3]);
                            __builtin_amdgcn_raw_buffer_store_b128(w, rs, (gq * SLAB_SLOTS + cur.piece) * 16384 + b * 8192 + tid * 16, 0, 16); }
                    }
                }
        }
        asm volatile("s_waitcnt vmcnt(0)" ::: "memory");
        __syncthreads();
        const int nsl = S.split;
        if (tid == 0) {
            __hip_atomic_fetch_add(tickets + 64 * cur.lu, 1u, __ATOMIC_RELAXED, __HIP_MEMORY_SCOPE_AGENT);
            if (cur.piece < 4) {
                unsigned sp = 0;
                while (__hip_atomic_load(tickets + 64 * cur.lu, __ATOMIC_RELAXED, __HIP_MEMORY_SCOPE_AGENT) < (unsigned)nsl) { __builtin_amdgcn_s_sleep(2); if (++sp > (1u << 20)) break; }
                __builtin_amdgcn_fence(__ATOMIC_ACQUIRE, "agent"); asm volatile("s_waitcnt vmcnt(0)" ::: "memory");
            }
        }
        __syncthreads();
        if (cur.piece < 4) {
            switch (cur.piece) {
                case 0: reduce_rowgroup<0, 0, 0>(acc, slab0, tid, nsl); reduce_rowgroup<0, 0, 1>(acc, slab0, tid, nsl); break;
                case 1: reduce_rowgroup<1, 0, 2>(acc, slab0, tid, nsl); reduce_rowgroup<1, 0, 3>(acc, slab0, tid, nsl); break;
                case 2: reduce_rowgroup<2, 1, 0>(acc, slab0, tid, nsl); reduce_rowgroup<2, 1, 1>(acc, slab0, tid, nsl); break;
                default: reduce_rowgroup<3, 1, 2>(acc, slab0, tid, nsl); reduce_rowgroup<3, 1, 3>(acc, slab0, tid, nsl); break;
            }
            E(acc, cur, wr, wc, fr, fq, 3u << (2 * cur.piece));
        }
    }
    }
#undef PG8_SA
#undef PG8_SB
#undef PG8_STAGE
#undef PG8_LDA
#undef PG8_LDB
#undef PG8_MMA
#undef PG8_WAIT_V
#undef PG8_WAIT_L
#undef PG8_BAR
#undef PG8_SCHED
}
}

typedef f32x4 Acc[2][2][4][2];

struct EpiZ {
    static constexpr bool SPLIT = false;
    const LAS float* rstab; bf16_t* z; float* out;
    __device__ __forceinline__ void operator()(const Acc& acc, const pg8::Unit& u, int wr, int wc, int fr, int fq) const {
        asm volatile("" : "+v"(fr), "+v"(fq));
        const int col0 = u.pn * 256 + wc * 32 + 8 * fq;
#pragma unroll
        for (int ai = 0; ai < 2; ++ai)
#pragma unroll
            for (int m = 0; m < 4; ++m) {
                const int r = u.pm * 256 + ai * 128 + wr * 64 + m * 16 + fr;
                if (r < M) {
                    const float rs = rstab[u.idx * 256 + ai * 128 + wr * 64 + m * 16 + fr];
                    int is_s, seq, t; row_decode(r, is_s, seq, t);
                    float* so = nullptr;
                    if (u.pn < 6) { if (is_s) { if (t >= TS - 3) so = out + O_SRC + ((size_t)seq * 3 + (t - (TS - 3))) * DA; } else { if (t >= TP - 3) so = out + O_PRC + ((size_t)seq * 3 + (t - (TP - 3))) * DA; } }
#pragma unroll
                    for (int bj = 0; bj < 2; ++bj) {
                        const f32x4 v0 = acc[ai][bj][m][0] * rs, v1 = acc[ai][bj][m][1] * rs;
                        u32x4 w; w.x = cvt_pk_bf16(v0[0], v0[1]); w.y = cvt_pk_bf16(v0[2], v0[3]); w.z = cvt_pk_bf16(v1[0], v1[1]); w.w = cvt_pk_bf16(v1[2], v1[3]);
                        *(u32x4*)(z + (size_t)r * DIN + col0 + bj * 128) = w;
                        if (so) { *(f32x4*)(so + col0 + bj * 128) = v0; *(f32x4*)(so + col0 + bj * 128 + 4) = v1; }
                    }
                }
            }
    }
};
__device__ __forceinline__ void rstd1_table(const float* rstd1, LAS float* tab, const pg8::StaticOrder& S) {
    const int tid = opaque_tid(), q = tid & 255;
    pg8::Unit u;
    for (int i = tid >> 8; S.next(i, u); i += 2) { const int r = u.pm * 256 + q; tab[i * 256 + q] = r < M ? rstd1[r] : 0.f; }
}
struct EpiX1 {
    static constexpr bool SPLIT = true;
    bf16_t* xb; float* ssq;
    __device__ __forceinline__ void operator()(const Acc& acc, const pg8::Unit& u, int wr, int wc, int fr, int fq, unsigned gmask = 0xffu) const {
        asm volatile("" : "+v"(fr), "+v"(fq));
        const int col0 = u.pn * 256 + wc * 32 + 8 * fq;
#pragma unroll
        for (int ai = 0; ai < 2; ++ai) {
            if (!((gmask >> (ai * 4)) & 0xfu)) continue;
            u32x4 xv[4][2];
#pragma unroll
            for (int m = 0; m < 4; ++m) {
                const int r = u.pm * 256 + ai * 128 + wr * 64 + m * 16 + fr;
                const bf16_t* xr = xb + (size_t)(r < M ? r : 0) * D + col0;
#pragma unroll
                for (int bj = 0; bj < 2; ++bj) xv[m][bj] = *(const u32x4*)(xr + bj * 128);
            }
#pragma unroll
            for (int m = 0; m < 4; ++m) {
                if (!((gmask >> (ai * 4 + m)) & 1u)) continue;
                const int r = u.pm * 256 + ai * 128 + wr * 64 + m * 16 + fr;
                const bool valid = r < M;
                float ss = 0.f;
#pragma unroll
                for (int bj = 0; bj < 2; ++bj) {
                    float xf[8]; unpack8(xv[m][bj], xf);
                    const f32x4 a0 = acc[ai][bj][m][0], a1 = acc[ai][bj][m][1];
                    const f32x4 v0 = (f32x4){a0[0] + xf[0], a0[1] + xf[1], a0[2] + xf[2], a0[3] + xf[3]}, v1 = (f32x4){a1[0] + xf[4], a1[1] + xf[5], a1[2] + xf[6], a1[3] + xf[7]};
                    ss += (v0[0] * v0[0] + v0[1] * v0[1]) + (v0[2] * v0[2] + v0[3] * v0[3]) + (v1[0] * v1[0] + v1[1] * v1[1]) + (v1[2] * v1[2] + v1[3] * v1[3]);
                    if (valid) { u32x4 w; w.x = cvt_pk_bf16(v0[0], v0[1]); w.y = cvt_pk_bf16(v0[2], v0[3]); w.z = cvt_pk_bf16(v1[0], v1[1]); w.w = cvt_pk_bf16(v1[2], v1[3]);
                        *(u32x4*)(xb + (size_t)r * D + col0 + bj * 128) = w; }
                }
                ss += __shfl_xor(ss, 16); ss += __shfl_xor(ss, 32);
                if (valid && fq == 0) ssq[(size_t)r * 32 + u.pn * 4 + wc] = ss;
            }
        }
    }
};
struct EpiOut {
    static constexpr bool SPLIT = true;
    const bf16_t* x1b; bf16_t* x2b;
    __device__ __forceinline__ void operator()(const Acc& acc, const pg8::Unit& u, int wr, int wc, int fr, int fq, unsigned gmask = 0xffu) const {
        asm volatile("" : "+v"(fr), "+v"(fq));
        const int col0 = u.pn * 256 + wc * 32 + 8 * fq;
#pragma unroll
        for (int ai = 0; ai < 2; ++ai) {
            if (!((gmask >> (ai * 4)) & 0xfu)) continue;
            u32x4 xv[4][2];
#pragma unroll
            for (int m = 0; m < 4; ++m) {
                const int r = u.pm * 256 + ai * 128 + wr * 64 + m * 16 + fr;
                const bf16_t* xr = x1b + (size_t)(r < M ? r : 0) * D + col0;
#pragma unroll
                for (int bj = 0; bj < 2; ++bj) xv[m][bj] = *(const u32x4*)(xr + bj * 128);
            }
#pragma unroll
            for (int m = 0; m < 4; ++m) {
                if (!((gmask >> (ai * 4 + m)) & 1u)) continue;
                const int r = u.pm * 256 + ai * 128 + wr * 64 + m * 16 + fr;
                if (r < M) {
#pragma unroll
                    for (int bj = 0; bj < 2; ++bj) {
                        float xf[8]; unpack8(xv[m][bj], xf);
                        const f32x4 a0 = acc[ai][bj][m][0], a1 = acc[ai][bj][m][1];
                        u32x4 w; w.x = cvt_pk_bf16(a0[0] + xf[0], a0[1] + xf[1]); w.y = cvt_pk_bf16(a0[2] + xf[2], a0[3] + xf[3]); w.z = cvt_pk_bf16(a1[0] + xf[4], a1[1] + xf[5]); w.w = cvt_pk_bf16(a1[2] + xf[6], a1[3] + xf[7]);
                        *(u32x4*)(x2b + (size_t)r * D + col0 + bj * 128) = w;
                    }
                }
            }
        }
    }
};
struct EpiFFN {
    static constexpr bool SPLIT = false;
    const float* st_fc; bf16_t* hid; float* out; const LAS float* rstab; const LAS float* wtab;
    template <bool PLAIN>
    __device__ __forceinline__ void body(Acc& acc, const pg8::Unit& u, int wr, int wc, int fr, int fq, int gbase, int f0,
                                         const f32x4 (&wv)[4][2]) const {
#pragma unroll
        for (int ai = 0; ai < 2; ++ai) {
            f32x4 s3[2], s2[2];
#pragma unroll
            for (int n = 0; n < 2; ++n)
#pragma unroll
                for (int e = 0; e < 4; ++e) {
                    const float o3 = ai == 0 ? 0.f : dppf<0x121>(0.f, acc[0][0][3][n][e]), o2 = ai == 0 ? 0.f : dppf<0x121>(0.f, acc[0][0][2][n][e]);
                    s3[n][e] = dppf<0x111>(o3, acc[ai][0][3][n][e]); s2[n][e] = dppf<0x111>(o2, acc[ai][0][2][n][e]);
                }
#pragma unroll
            for (int m = 0; m < 4; ++m) {
                const int j = 64 * ai + 4 * fr + m, r = gbase + j;
                const f32x4 c0 = acc[ai][0][m][0], c1 = acc[ai][0][m][1];
                f32x4 p1a = m == 0 ? s3[0] : acc[ai][0][m == 0 ? 0 : m - 1][0], p1b = m == 0 ? s3[1] : acc[ai][0][m == 0 ? 0 : m - 1][1];
                f32x4 p2a = m == 0 ? s2[0] : (m == 1 ? s3[0] : acc[ai][0][m < 2 ? 0 : m - 2][0]), p2b = m == 0 ? s2[1] : (m == 1 ? s3[1] : acc[ai][0][m < 2 ? 0 : m - 2][1]);
                bool valid = j >= 2;
                int is_s = 0, seq = 0, t = 2;
                if constexpr (!PLAIN) {
                    valid = valid && (r < M);
                    row_decode(valid ? r : 0, is_s, seq, t);
                    if (valid && t < 2) {
                        f32x4 s0a = (f32x4){0.f, 0.f, 0.f, 0.f}, s0b = s0a, s1a = s0a, s1b = s0a;
                        if (is_s) { const float* sp = st_fc + (size_t)seq * 2 * DFF + f0; s0a = *(const f32x4*)sp; s0b = *(const f32x4*)(sp + 4); s1a = *(const f32x4*)(sp + DFF); s1b = *(const f32x4*)(sp + DFF + 4); }
                        if (t == 0) { p1a = s1a; p1b = s1b; p2a = s0a; p2b = s0b; } else { p2a = s1a; p2b = s1b; }
                    }
                }
                const f32x4 ga = wv[0][0] * p2a + wv[1][0] * p1a + wv[2][0] * c0 + wv[3][0], gb = wv[0][1] * p2b + wv[1][1] * p1b + wv[2][1] * c1 + wv[3][1];
                const f32x4 va = acc[ai][1][m][0], vb = acc[ai][1][m][1];
                if (valid) {
                    u32x4 w;
                    const f32x2 h0 = gelu_mul2((f32x2){ga[0], ga[1]}, (f32x2){va[0], va[1]}), h1 = gelu_mul2((f32x2){ga[2], ga[3]}, (f32x2){va[2], va[3]});
                    const f32x2 h2 = gelu_mul2((f32x2){gb[0], gb[1]}, (f32x2){vb[0], vb[1]}), h3 = gelu_mul2((f32x2){gb[2], gb[3]}, (f32x2){vb[2], vb[3]});
                    w.x = cvt_pk_bf16(h0.x, h0.y); w.y = cvt_pk_bf16(h1.x, h1.y); w.z = cvt_pk_bf16(h2.x, h2.y); w.w = cvt_pk_bf16(h3.x, h3.y);
                    *(u32x4*)(hid + (size_t)r * DFF + f0) = w;
                    if constexpr (!PLAIN) {
                        const int T = is_s ? TS : TP;
                        if (t >= T - 2) { float* so = out + (is_s ? O_SFC : O_PFC) + ((size_t)seq * 2 + (t - (T - 2))) * DFF + f0; *(f32x4*)so = c0; *(f32x4*)(so + 4) = c1; }
                    }
                }
            }
            __builtin_amdgcn_sched_barrier(0);
        }
    }
    __device__ __forceinline__ void operator()(Acc& acc, const pg8::Unit& u, int wr, int wc, int fr, int fq) const {
        asm volatile("" : "+v"(fr), "+v"(fq));
        const int gbase = 252 * u.pm - 2 + 126 * wr;
        const int f0 = 128 * u.pn + 32 * wc + 8 * fq;
        const LAS float* wt = wtab + u.idx * 512 + 32 * wc + 8 * fq;
        f32x4 wv[4][2];
#pragma unroll
        for (int k = 0; k < 4; ++k) { wv[k][0] = *(const LAS f32x4*)(wt + 128 * k); wv[k][1] = *(const LAS f32x4*)(wt + 128 * k + 4); }
        const LAS float* rt = rstab + u.idx * 256 + wr * 128 + 4 * fr;
#pragma unroll
        for (int ai = 0; ai < 2; ++ai) {
            const f32x4 rs4 = *(const LAS f32x4*)(rt + 64 * ai);
#pragma unroll
            for (int m = 0; m < 4; ++m)
#pragma unroll
                for (int bj = 0; bj < 2; ++bj)
#pragma unroll
                    for (int n = 0; n < 2; ++n) acc[ai][bj][m][n] *= rs4[m];
        }
        const int lo = gbase, hi = gbase + 127;
        bool plain = hi < MPR && lo >= 0;
#pragma unroll
        for (int b2 = 0; b2 < NB; ++b2) { const int s0 = b2 * TP; if (lo <= s0 + 1 && hi >= s0) plain = false; if (lo <= s0 + TP - 1 && hi >= s0 + TP - 2) plain = false; }
        if (plain) body<true>(acc, u, wr, wc, fr, fq, gbase, f0, wv); else body<false>(acc, u, wr, wc, fr, fq, gbase, f0, wv);
    }
};
__device__ __forceinline__ void ffn_rstd_table(const float* ssq, const float* cw, const float* cb, LAS float* tab, LAS float* wtab, const pg8::StaticOrder& S) {
    const int tid = opaque_tid(), q = tid >> 1, half = tid & 1;
    pg8::Unit u;
    for (int i = 0; S.next(i, u); ++i) {
        { const int k = tid >> 7, c = tid & 127, f = 128 * u.pn + c; wtab[i * 512 + tid] = k < 3 ? cw[k * DFF + f] : cb[f]; }
        int r = 252 * u.pm - 2 + 126 * (q >> 7) + (q & 127); r = r < 0 ? 0 : (r >= M ? M - 1 : r);
        const float* sp = ssq + (size_t)r * 32 + 16 * half;
        const f32x4 a = *(const f32x4*)sp, b = *(const f32x4*)(sp + 4), c = *(const f32x4*)(sp + 8), d = *(const f32x4*)(sp + 12);
        float sm = (((a[0] + a[1]) + (a[2] + a[3])) + ((b[0] + b[1]) + (b[2] + b[3]))) + (((c[0] + c[1]) + (c[2] + c[3])) + ((d[0] + d[1]) + (d[2] + d[3])));
        sm += __shfl_xor(sm, 1);
        if (half == 0) tab[i * 256 + q] = __builtin_amdgcn_rsqf(sm * (1.0f / D) + EPS);
    }
}

__device__ __forceinline__ int invperm32(int q) { return 16 * ((q >> 2) & 1) + 4 * (q >> 3) + (q & 3); }
__device__ __forceinline__ void p0_transpose_item(const float* W, int K, int N, const float* kscale, bf16_t* WT, int mode, LAS float* scr, int item, int lane) {
    const int nblk = N / 32, kb = item / nblk, nb = item % nblk, k0 = 64 * kb, n0 = 32 * nb;
    float v[32];
    const float* src = W + (size_t)(k0 + (lane >> 5)) * N + n0 + (lane & 31);
#pragma unroll
    for (int i = 0; i < 32; ++i) v[i] = __builtin_nontemporal_load(src + (size_t)(2 * i) * N);
#pragma unroll
    for (int i = 0; i < 32; ++i) scr[(2 * i + (lane >> 5)) * 33 + (lane & 31)] = v[i];
    asm volatile("s_waitcnt lgkmcnt(0)" ::: "memory");
    int rbase = n0;
    if (mode == 1) { const int bj = n0 >= DFF ? 1 : 0, f = n0 - bj * DFF; rbase = 256 * (f >> 7) + 128 * bj + (f & 96); }
    const int c = lane & 7;
    f32x4 ks0 = (f32x4){1.f, 1.f, 1.f, 1.f}, ks1 = ks0;
    if (kscale) { ks0 = *(const f32x4*)(kscale + k0 + 8 * c); ks1 = *(const f32x4*)(kscale + k0 + 8 * c + 4); }
#pragma unroll
    for (int j = 0; j < 4; ++j) { const int n = (lane >> 3) + 8 * j; const LAS float* sp = scr + (8 * c) * 33 + n;
        u32x4 o; o.x = cvt_pk_bf16(sp[0 * 33] * ks0[0], sp[1 * 33] * ks0[1]); o.y = cvt_pk_bf16(sp[2 * 33] * ks0[2], sp[3 * 33] * ks0[3]);
        o.z = cvt_pk_bf16(sp[4 * 33] * ks1[0], sp[5 * 33] * ks1[1]); o.w = cvt_pk_bf16(sp[6 * 33] * ks1[2], sp[7 * 33] * ks1[3]);
        *(u32x4*)(WT + (size_t)(rbase + (mode == 2 ? n : invperm32(n))) * K + k0 + 8 * c) = o; }
    asm volatile("s_waitcnt lgkmcnt(0)" ::: "memory");
}
constexpr int I_IN = (D / 64) * (DIN / 32), I_O = (DMIX / 64) * (D / 32), I_UP = (D / 64) * (2 * DFF / 32), I_DN = (DFF / 64) * (D / 32), I_G = 2 * NH * 8;
constexpr int IT_O = I_IN, IT_UP = IT_O + I_O, IT_DN = IT_UP + I_UP, IT_G = IT_DN + I_DN, IT_END = IT_G + I_G;
__device__ __forceinline__ void convert_items(PRef p, LAS unsigned char* lds, int rank, int nwaves, int lo, int hi) {
    const int tid_ = opaque_tid(), lane = tid_ & 63, wave = tid_ >> 6;
    unsigned char* ws = p.ws;
    LAS float* scr = (LAS float*)(lds + wave * 16384);
    for (int it = lo + rank; it < hi; it += nwaves) {
        int r = it;
        if (r < I_IN) { p0_transpose_item(p.w_in, D, DIN, p.g_mix, (bf16_t*)(ws + WS_WIN), 0, scr, r, lane); continue; } r -= I_IN;
        if (r < I_O) { p0_transpose_item(p.w_o, DMIX, D, nullptr, (bf16_t*)(ws + WS_WO), 0, scr, r, lane); continue; } r -= I_O;
        if (r < I_UP) { p0_transpose_item(p.w_up, D, 2 * DFF, p.g_ffn, (bf16_t*)(ws + WS_WUP), 1, scr, r, lane); continue; } r -= I_UP;
        if (r < I_DN) { p0_transpose_item(p.w_down, DFF, D, nullptr, (bf16_t*)(ws + WS_WDN), 0, scr, r, lane); continue; } r -= I_DN;
        { const int mat = r >> 3, sub = r & 7, gsel = mat / NH, n = mat % NH;
          p0_transpose_item((gsel ? p.w_gate_x : p.w_gate_a) + (size_t)n * 128 * 128, 128, 128, nullptr, (bf16_t*)(ws + WS_WG) + (size_t)mat * 128 * 128, 0, scr, sub, lane); }
    }
}
constexpr int P1_TAIL_WG0 = (888 % 256), P4_TAIL_WG0 = (296 % 256) * P4_SPLIT, IT_S1 = IT_O + 10600, IT_S2 = IT_S1 + 300, IT_S3 = IT_S2 + 2400;
__device__ __forceinline__ void phase0(PRef p, LAS unsigned char* lds, int G) {
    const int tid = opaque_tid(), lane = tid & 63, wave = tid >> 6;
    unsigned char* ws = p.ws;
    const int gw = blockIdx.x * 8 + wave, NGW = G * 8;
    convert_items(p, lds, gw, NGW, 0, IT_O);
    convert_items(p, lds, gw, NGW, IT_G, IT_END);
    { bf16_t* xb = (bf16_t*)(ws + WS_XB) + (size_t)16 * D; float* rstd1 = (float*)(ws + WS_RS1);
      for (int m = gw; m < M; m += NGW) {
          const f32x4* xr = (const f32x4*)x_row_ptr(p.x_prompt, p.x_sample, p.meta, m) + lane;
          f32x4 v[8]; float s = 0.f;
#pragma unroll
          for (int j = 0; j < 8; ++j) { v[j] = __builtin_nontemporal_load(xr + 64 * j); s += (v[j][0] * v[j][0] + v[j][1] * v[j][1]) + (v[j][2] * v[j][2] + v[j][3] * v[j][3]); }
          s = wave_sum(s);
          if (lane == 0) rstd1[m] = __builtin_amdgcn_rsqf(s * (1.0f / D) + EPS);
          u32x2* o = (u32x2*)(xb + (size_t)m * D) + lane;
#pragma unroll
          for (int j = 0; j < 8; ++j) { u32x2 w; w.x = cvt_pk_bf16(v[j][0], v[j][1]); w.y = cvt_pk_bf16(v[j][2], v[j][3]); o[64 * j] = w; }
      } }
}

__device__ __forceinline__ void branch_b(PRef p, int G) {
    const bf16_t* z = (const bf16_t*)(p.ws + WS_Z); bf16_t* ym = (bf16_t*)(p.ws + WS_YM);
    const int total = (M / 4) * 128;
    for (int idx = blockIdx.x * 512 + opaque_tid(); idx < total; idx += G * 512) {
        const int m0 = (idx >> 7) * 4, g = idx & 127, ch = 8 * g;
        int is_s, seq, t0; row_decode(m0, is_s, seq, t0);
        u32x4 rc[6], rv[6], rg[4];
#pragma unroll
        for (int k = 0; k < 6; ++k) {
            const int mm = (t0 - 2 + k >= 0) ? m0 - 2 + k : m0;
            rc[k] = *(const u32x4*)(z + (size_t)mm * DIN + 4096 + ch); rv[k] = *(const u32x4*)(z + (size_t)mm * DIN + 5120 + ch);
        }
#pragma unroll
        for (int k = 0; k < 4; ++k) rg[k] = *(const u32x4*)(z + (size_t)(m0 + k) * DIN + 3072 + ch);
        const f32x4 w0a = *(const f32x4*)(p.conv_b_w + ch), w0b = *(const f32x4*)(p.conv_b_w + ch + 4), w1a = *(const f32x4*)(p.conv_b_w + DB + ch), w1b = *(const f32x4*)(p.conv_b_w + DB + ch + 4),
                    w2a = *(const f32x4*)(p.conv_b_w + 2 * DB + ch), w2b = *(const f32x4*)(p.conv_b_w + 2 * DB + ch + 4), goa = *(const f32x4*)(p.g_out_b + ch), gob = *(const f32x4*)(p.g_out_b + ch + 4);
        float u[6][8];
#pragma unroll
        for (int k = 0; k < 6; ++k) {
            float a[8], b[8]; unpack8(rc[k], a); unpack8(rv[k], b);
#pragma unroll
            for (int e = 0; e < 8; ++e) u[k][e] = a[e] * b[e];
        }
        if (t0 == 0) {
#pragma unroll
            for (int k = 0; k < 2; ++k) {
                f32x4 a = (f32x4){0.f, 0.f, 0.f, 0.f}, b = a;
                if (is_s) { const float* sp = p.st_sc + ((size_t)seq * 2 + k) * DB + ch; a = *(const f32x4*)sp; b = *(const f32x4*)(sp + 4); }
#pragma unroll
                for (int e = 0; e < 4; ++e) { u[k][e] = a[e]; u[k][4 + e] = b[e]; }
            }
        }
        const int T = is_s ? TS : TP;
#pragma unroll
        for (int k = 0; k < 4; ++k) {
            float gb[8]; unpack8(rg[k], gb);
            float y[8]; float ss = 0.f;
#pragma unroll
            for (int e = 0; e < 8; ++e) {
                const float uc = (e < 4 ? w0a[e & 3] : w0b[e & 3]) * u[k][e] + (e < 4 ? w1a[e & 3] : w1b[e & 3]) * u[k + 1][e] + (e < 4 ? w2a[e & 3] : w2b[e & 3]) * u[k + 2][e];
                y[e] = gb[e] * uc; ss += y[e] * y[e];
            }
            ss = sum16(ss);
            const float rn = __builtin_amdgcn_rsqf(ss * (1.0f / 128.0f) + EPS);
#pragma unroll
            for (int e = 0; e < 8; ++e) y[e] = y[e] * rn * (e < 4 ? goa[e & 3] : gob[e & 3]);
            *(u32x4*)(ym + (size_t)(m0 + k) * DMIX + DA + ch) = pack8(y);
            const int t = t0 + k;
            if (t >= T - 2) { float* so = p.out + (is_s ? O_SSC : O_PSC) + ((size_t)seq * 2 + (t - (T - 2))) * DB + ch;
                *(f32x4*)so = (f32x4){u[k + 2][0], u[k + 2][1], u[k + 2][2], u[k + 2][3]}; *(f32x4*)(so + 4) = (f32x4){u[k + 2][4], u[k + 2][5], u[k + 2][6], u[k + 2][7]}; }
        }
    }
}

constexpr int LW_STRIDE = 272, L_WA = 0, L_WX = 128 * LW_STRIDE, L_CT = 2 * 128 * LW_STRIDE, L_LRU_END = L_CT + 9 * 128 * 4;
static_assert(L_LRU_END <= 131072, "mixer LDS");
constexpr int LRU_WG_PER_HEAD = 21, LRU_NSEG = 33, LRU_PITEMS = NB * LRU_NSEG, LRU_SBLK = 2, LRU_SITEMS = MSR / (16 * LRU_SBLK);
constexpr int LRU_IDLE_J0 = (LRU_PITEMS + 7) / 8;
static_assert(LRU_WG_PER_HEAD * 8 >= LRU_PITEMS + LRU_SITEMS, "waves per head");

template <int CTRL, int BANK> __device__ __forceinline__ float dppfb(float old, float src) {
    return __builtin_bit_cast(float, __builtin_amdgcn_update_dpp(__builtin_bit_cast(int, old), __builtin_bit_cast(int, src), CTRL, 0xF, BANK, false));
}
__device__ __forceinline__ float bcast15(float x, int lane) {
    return __builtin_bit_cast(float, __builtin_amdgcn_ds_bpermute(((lane & 48) | 15) << 2, __builtin_bit_cast(int, x)));
}
__device__ __forceinline__ void scan16(float& P, float& S) {
    float Sd, Pd;
    Sd = dppf<0x111>(0.f, S); Pd = dppf<0x111>(1.f, P); S = __builtin_fmaf(P, Sd, S); P *= Pd;
    Sd = dppf<0x112>(0.f, S); Pd = dppf<0x112>(1.f, P); S = __builtin_fmaf(P, Sd, S); P *= Pd;
    Sd = dppf<0x114>(0.f, S); Pd = dppf<0x114>(1.f, P); S = __builtin_fmaf(P, Sd, S); P *= Pd;
    Sd = dppf<0x118>(0.f, S); Pd = dppf<0x118>(1.f, P); S = __builtin_fmaf(P, Sd, S); P *= Pd;
}
__device__ __forceinline__ void scan16x2(float& P1, float& S1, float& P2, float& S2) {
    asm volatile(
        "s_nop 1\n\t"
        "v_fmac_f32_dpp %1, %1, %0 row_shr:1 row_mask:0xf bank_mask:0xf bound_ctrl:1\n\t"
        "v_fmac_f32_dpp %3, %3, %2 row_shr:1 row_mask:0xf bank_mask:0xf bound_ctrl:1\n\t"
        "v_mul_f32_dpp %0, %0, %0 row_shr:1 row_mask:0xf bank_mask:0xf\n\t"
        "v_mul_f32_dpp %2, %2, %2 row_shr:1 row_mask:0xf bank_mask:0xf\n\t"
        "v_fmac_f32_dpp %1, %1, %0 row_shr:2 row_mask:0xf bank_mask:0xf bound_ctrl:1\n\t"
        "v_fmac_f32_dpp %3, %3, %2 row_shr:2 row_mask:0xf bank_mask:0xf bound_ctrl:1\n\t"
        "v_mul_f32_dpp %0, %0, %0 row_shr:2 row_mask:0xf bank_mask:0xf\n\t"
        "v_mul_f32_dpp %2, %2, %2 row_shr:2 row_mask:0xf bank_mask:0xf\n\t"
        "v_fmac_f32_dpp %1, %1, %0 row_shr:4 row_mask:0xf bank_mask:0xf bound_ctrl:1\n\t"
        "v_fmac_f32_dpp %3, %3, %2 row_shr:4 row_mask:0xf bank_mask:0xf bound_ctrl:1\n\t"
        "v_mul_f32_dpp %0, %0, %0 row_shr:4 row_mask:0xf bank_mask:0xf\n\t"
        "v_mul_f32_dpp %2, %2, %2 row_shr:4 row_mask:0xf bank_mask:0xf\n\t"
        "v_fmac_f32_dpp %1, %1, %0 row_shr:8 row_mask:0xf bank_mask:0xf bound_ctrl:1\n\t"
        "v_fmac_f32_dpp %3, %3, %2 row_shr:8 row_mask:0xf bank_mask:0xf bound_ctrl:1\n\t"
        "v_mul_f32_dpp %0, %0, %0 row_shr:8 row_mask:0xf bank_mask:0xf\n\t"
        "v_mul_f32_dpp %2, %2, %2 row_shr:8 row_mask:0xf bank_mask:0xf\n\t"
        "s_nop 0"
        : "+v"(P1), "+v"(S1), "+v"(P2), "+v"(S2));
}
__device__ __forceinline__ void scan8(float& P, float& S, int t) {
    float Sd, Pd;
    Sd = dppf<0x111>(0.f, S); Pd = dppf<0x111>(1.f, P); if (t < 1) { Sd = 0.f; Pd = 1.f; } S = __builtin_fmaf(P, Sd, S); P *= Pd;
    Sd = dppf<0x112>(0.f, S); Pd = dppf<0x112>(1.f, P); if (t < 2) { Sd = 0.f; Pd = 1.f; } S = __builtin_fmaf(P, Sd, S); P *= Pd;
    Sd = dppfb<0x114, 0xA>(0.f, S); Pd = dppfb<0x114, 0xA>(1.f, P); S = __builtin_fmaf(P, Sd, S); P *= Pd;
}

template <int PASS, bool IS_S>
__device__ __forceinline__ void lru_wave_item(PRef p, LAS unsigned char* lds, int n, int b, int seg) {
    const int lane = opaque_tid() & 63, fr = lane & 15, fq = lane >> 4;
    const bf16_t* z = (const bf16_t*)(p.ws + WS_Z);
    bf16_t* ym = (bf16_t*)(p.ws + WS_YM);
    float* tot = (float*)(p.ws + WS_TOT);
    const LAS float* CT = (const LAS float*)(lds + L_CT) + 8 * fq;
    const int gch = n * 128 + 8 * fq;
    const int r0 = IS_S ? MPR + b * (16 * LRU_SBLK) : b * TP + seg * 64;
    const int nblk = IS_S ? LRU_SBLK : (seg == LRU_NSEG - 1 ? 1 : 4);
    float hin[4][8], Pt[4][8];
    u32x4 prevx[4];
#pragma unroll
    for (int ks = 0; ks < 4; ++ks) {
#pragma unroll
        for (int e = 0; e < 8; ++e) { hin[ks][e] = 0.f; Pt[ks][e] = 1.f; }
        prevx[ks] = (u32x4){0u, 0u, 0u, 0u};
    }
    if constexpr (!IS_S) {
        if (seg > 0) {
#pragma unroll
            for (int ks = 0; ks < 4; ++ks) prevx[ks] = *(const u32x4*)(z + (size_t)(r0 - 16 + fr) * DIN + gch + 32 * ks);
            if constexpr (PASS == 2) {
#pragma unroll 1
                for (int round = 0; round < 2; ++round) {
                    const int s = 16 * round + fr;
                    if (16 * round >= seg) break;
                    const bool have = s < seg;
                    const float* tp = tot + ((size_t)(b * LRU_NSEG + (have ? s : 0)) * 2) * DA + gch;
#pragma unroll
                    for (int ks = 0; ks < 4; ++ks) {
                        const f32x4 P0 = *(const f32x4*)(tp + 32 * ks), P1 = *(const f32x4*)(tp + 32 * ks + 4), S0 = *(const f32x4*)(tp + DA + 32 * ks), S1 = *(const f32x4*)(tp + DA + 32 * ks + 4);
#pragma unroll
                        for (int e = 0; e < 8; e += 2) {
                            float Pa = have ? (e < 4 ? P0[e & 3] : P1[e & 3]) : 1.f, Sa = have ? (e < 4 ? S0[e & 3] : S1[e & 3]) : 0.f;
                            float Pb = have ? (e < 4 ? P0[(e + 1) & 3] : P1[(e + 1) & 3]) : 1.f, Sb = have ? (e < 4 ? S0[(e + 1) & 3] : S1[(e + 1) & 3]) : 0.f;
                            scan16x2(Pa, Sa, Pb, Sb);
                            hin[ks][e] = __builtin_fmaf(bcast15(Pa, lane), hin[ks][e], bcast15(Sa, lane));
                            hin[ks][e + 1] = __builtin_fmaf(bcast15(Pb, lane), hin[ks][e + 1], bcast15(Sb, lane));
                        }
                    }
                }
            }
        }
    }
    u32x4 xnext[4];
    if constexpr (!IS_S) {
#pragma unroll
        for (int ks = 0; ks < 4; ++ks) xnext[ks] = *(const u32x4*)(z + (size_t)(r0 + fr) * DIN + gch + 32 * ks);
    }
#pragma unroll 1
    for (int blk = 0; blk < nblk; ++blk) {
        const int r = r0 + 16 * blk + fr;
        const int t8 = fr & 7, sq = (r - MPR) >> 3;
        u32x4 x4[4], g4[4];
#pragma unroll
        for (int ks = 0; ks < 4; ++ks) { if constexpr (IS_S) x4[ks] = *(const u32x4*)(z + (size_t)r * DIN + gch + 32 * ks); else x4[ks] = xnext[ks];
            if constexpr (PASS == 2) g4[ks] = *(const u32x4*)(z + (size_t)r * DIN + DA + gch + 32 * ks); }
        if constexpr (!IS_S) { const int rn_ = (blk + 1 < nblk) ? r + 16 : r;
#pragma unroll
          for (int ks = 0; ks < 4; ++ks) xnext[ks] = *(const u32x4*)(z + (size_t)rn_ * DIN + gch + 32 * ks); }
        float xc[4][8];
        bf16x8 bfrag[4];
#pragma unroll
        for (int ks = 0; ks < 4; ++ks) {
            float xf[8]; unpack8(x4[ks], xf);
            const f32x4 w0a = *(const LAS f32x4*)(CT + 0 * 128 + 32 * ks), w0b = *(const LAS f32x4*)(CT + 0 * 128 + 32 * ks + 4);
            const f32x4 w1a = *(const LAS f32x4*)(CT + 1 * 128 + 32 * ks), w1b = *(const LAS f32x4*)(CT + 1 * 128 + 32 * ks + 4);
            const f32x4 w2a = *(const LAS f32x4*)(CT + 2 * 128 + 32 * ks), w2b = *(const LAS f32x4*)(CT + 2 * 128 + 32 * ks + 4);
            const f32x4 w3a = *(const LAS f32x4*)(CT + 3 * 128 + 32 * ks), w3b = *(const LAS f32x4*)(CT + 3 * 128 + 32 * ks + 4);
            const f32x4 cba = *(const LAS f32x4*)(CT + 4 * 128 + 32 * ks), cbb = *(const LAS f32x4*)(CT + 4 * 128 + 32 * ks + 4);
            if constexpr (IS_S) {
                const float* sp = p.st_rc + (size_t)sq * 3 * DA + gch + 32 * ks;
                const f32x4 b0a = *(const f32x4*)sp, b0b = *(const f32x4*)(sp + 4), b1a = *(const f32x4*)(sp + DA), b1b = *(const f32x4*)(sp + DA + 4), b2a = *(const f32x4*)(sp + 2 * DA), b2b = *(const f32x4*)(sp + 2 * DA + 4);
#pragma unroll
                for (int e = 0; e < 8; ++e) {
                    const float bb0 = e < 4 ? b0a[e & 3] : b0b[e & 3], bb1 = e < 4 ? b1a[e & 3] : b1b[e & 3], bb2 = e < 4 ? b2a[e & 3] : b2b[e & 3];
                    const float s1 = dppf<0x111>(0.f, xf[e]), s2 = dppf<0x112>(0.f, xf[e]), s3 = dppf<0x113>(0.f, xf[e]);
                    const float x1 = t8 >= 1 ? s1 : bb2;
                    const float x2 = t8 >= 2 ? s2 : (t8 == 1 ? bb2 : bb1);
                    const float x3 = t8 >= 3 ? s3 : (t8 == 2 ? bb2 : (t8 == 1 ? bb1 : bb0));
                    const float w0 = e < 4 ? w0a[e & 3] : w0b[e & 3], w1 = e < 4 ? w1a[e & 3] : w1b[e & 3], w2 = e < 4 ? w2a[e & 3] : w2b[e & 3], w3 = e < 4 ? w3a[e & 3] : w3b[e & 3];
                    xc[ks][e] = (e < 4 ? cba[e & 3] : cbb[e & 3]) + w3 * xf[e] + w2 * x1 + w1 * x2 + w0 * x3;
                }
            } else {
                float pf[8]; unpack8(prevx[ks], pf);
#pragma unroll
                for (int e = 0; e < 8; e += 2) {
                    f32x2 x0, x1, x2, x3;
#pragma unroll
                    for (int q = 0; q < 2; ++q) {
                        x0[q] = xf[e + q];
                        x1[q] = dppf<0x111>(dppf<0x121>(0.f, pf[e + q]), xf[e + q]);
                        x2[q] = dppf<0x112>(dppf<0x122>(0.f, pf[e + q]), xf[e + q]);
                        x3[q] = dppf<0x113>(dppf<0x123>(0.f, pf[e + q]), xf[e + q]);
                    }
                    const int c = e & 3;
                    const f32x2 w0 = e < 4 ? (f32x2){w0a[c], w0a[c + 1]} : (f32x2){w0b[c], w0b[c + 1]}, w1 = e < 4 ? (f32x2){w1a[c], w1a[c + 1]} : (f32x2){w1b[c], w1b[c + 1]};
                    const f32x2 w2 = e < 4 ? (f32x2){w2a[c], w2a[c + 1]} : (f32x2){w2b[c], w2b[c + 1]}, w3 = e < 4 ? (f32x2){w3a[c], w3a[c + 1]} : (f32x2){w3b[c], w3b[c + 1]};
                    const f32x2 cbv = e < 4 ? (f32x2){cba[c], cba[c + 1]} : (f32x2){cbb[c], cbb[c + 1]};
                    const f32x2 r = cbv + w3 * x0 + w2 * x1 + w1 * x2 + w0 * x3;
                    xc[ks][e] = r.x; xc[ks][e + 1] = r.y;
                }
                prevx[ks] = x4[ks];
            }
            bfrag[ks] = __builtin_bit_cast(bf16x8, pack8(xc[ks]));
            if constexpr (IS_S) __builtin_amdgcn_sched_barrier(0);
        }
        f32x4 aa[8], ax[8];
#pragma unroll
        for (int nb = 0; nb < 8; ++nb) { aa[nb] = (f32x4){0.f, 0.f, 0.f, 0.f}; ax[nb] = (f32x4){0.f, 0.f, 0.f, 0.f}; }
#pragma unroll
        for (int ks = 0; ks < 4; ++ks)
#pragma unroll
            for (int nb = 0; nb < 8; ++nb) {
                const bf16x8 wa = *(const LAS bf16x8*)(lds + L_WA + (16 * nb + fr) * LW_STRIDE + (32 * ks + 8 * fq) * 2);
                const bf16x8 wx = *(const LAS bf16x8*)(lds + L_WX + (16 * nb + fr) * LW_STRIDE + (32 * ks + 8 * fq) * 2);
                aa[nb] = __builtin_amdgcn_mfma_f32_16x16x32_bf16(wa, bfrag[ks], aa[nb], 0, 0, 0);
                ax[nb] = __builtin_amdgcn_mfma_f32_16x16x32_bf16(wx, bfrag[ks], ax[nb], 0, 0, 0);
            }
        float y[4][8]; float ss = 0.f;
#pragma unroll
        for (int ks = 0; ks < 4; ++ks) {
            const f32x4 bga0 = *(const LAS f32x4*)(CT + 5 * 128 + 32 * ks), bga1 = *(const LAS f32x4*)(CT + 5 * 128 + 32 * ks + 4);
            const f32x4 bgx0 = *(const LAS f32x4*)(CT + 6 * 128 + 32 * ks), bgx1 = *(const LAS f32x4*)(CT + 6 * 128 + 32 * ks + 4);
            const f32x4 sp0 = *(const LAS f32x4*)(CT + 7 * 128 + 32 * ks), sp1 = *(const LAS f32x4*)(CT + 7 * 128 + 32 * ks + 4);
            float gav[8];
            if constexpr (PASS == 2) unpack8(g4[ks], gav);
            f32x4 h0a, h0b;
            if constexpr (IS_S) { const float* hp = p.st_h + (size_t)sq * DA + gch + 32 * ks; h0a = *(const f32x4*)hp; h0b = *(const f32x4*)(hp + 4); }
            float hv[8], Pv[8], Sv[8], lav[8];
#pragma unroll
            for (int e = 0; e < 8; e += 2) {
                const int nb = 2 * ks + (e >> 2), rg = e & 3;
                const f32x2 ba = e < 4 ? (f32x2){bga0[rg], bga0[rg + 1]} : (f32x2){bga1[rg], bga1[rg + 1]}, bx = e < 4 ? (f32x2){bgx0[rg], bgx0[rg + 1]} : (f32x2){bgx1[rg], bgx1[rg + 1]};
                const f32x2 spv = e < 4 ? (f32x2){sp0[rg], sp0[rg + 1]} : (f32x2){sp1[rg], sp1[rg + 1]};
                const f32x2 ta = (f32x2){aa[nb][rg], aa[nb][rg + 1]} * -1.4426950408889634f + ba, tx = (f32x2){ax[nb][rg], ax[nb][rg + 1]} * -1.4426950408889634f + bx;
                f32x2 ea, ex; ea.x = __builtin_amdgcn_exp2f(ta.x); ea.y = __builtin_amdgcn_exp2f(ta.y); ex.x = __builtin_amdgcn_exp2f(tx.x); ex.y = __builtin_amdgcn_exp2f(tx.y);
                ea = ea + 1.0f; ex = ex + 1.0f;
                f32x2 rr, ii; rr.x = __builtin_amdgcn_rcpf(ea.x); rr.y = __builtin_amdgcn_rcpf(ea.y); ii.x = __builtin_amdgcn_rcpf(ex.x); ii.y = __builtin_amdgcn_rcpf(ex.y);
                const f32x2 la = rr * spv;
                f32x2 a; a.x = __builtin_amdgcn_exp2f(la.x); a.y = __builtin_amdgcn_exp2f(la.y);
                const f32x2 om = 1.0f - a * a;
                f32x2 sq; sq.x = __builtin_amdgcn_sqrtf(om.x > 0.f ? om.x : 0.f); sq.y = __builtin_amdgcn_sqrtf(om.y > 0.f ? om.y : 0.f);
                const f32x2 uu = sq * (ii * (f32x2){xc[ks][e], xc[ks][e + 1]});
                Pv[e] = a.x; Pv[e + 1] = a.y; Sv[e] = uu.x; Sv[e + 1] = uu.y; lav[e] = la.x; lav[e + 1] = la.y;
            }
            if constexpr (PASS == 1 && !IS_S) {
                *(u32x4*)((bf16_t*)(p.ws + WS_LA) + (size_t)r * DA + gch + 32 * ks) = pack8(lav);
                *(u32x4*)((bf16_t*)(p.ws + WS_UU) + (size_t)r * DA + gch + 32 * ks) = pack8(Sv);
            }
            if constexpr (IS_S) {
#pragma unroll
                for (int e = 0; e < 8; ++e) { scan8(Pv[e], Sv[e], t8); hv[e] = __builtin_fmaf(Pv[e], e < 4 ? h0a[e & 3] : h0b[e & 3], Sv[e]); }
            } else {
#pragma unroll
                for (int e = 0; e < 8; e += 2) scan16x2(Pv[e], Sv[e], Pv[e + 1], Sv[e + 1]);
#pragma unroll
                for (int e = 0; e < 8; ++e) {
                    hv[e] = __builtin_fmaf(Pv[e], hin[ks][e], Sv[e]);
                    hin[ks][e] = bcast15(hv[e], lane);
                    if constexpr (PASS == 1) Pt[ks][e] *= bcast15(Pv[e], lane);
                }
            }
            if constexpr (PASS == 2) {
#pragma unroll
                for (int e = 0; e < 8; e += 2) { const f32x2 yy = gelu_mul2((f32x2){gav[e], gav[e + 1]}, (f32x2){hv[e], hv[e + 1]}); y[ks][e] = yy.x; y[ks][e + 1] = yy.y; ss += yy.x * yy.x + yy.y * yy.y; }
            }
            if constexpr (PASS == 2) {
                if (IS_S ? (t8 == 7) : (seg == LRU_NSEG - 1 && fr == 15)) {
                    float* ho = p.out + (IS_S ? O_SH + (size_t)sq * DA : O_PH + (size_t)b * DA) + gch + 32 * ks;
                    *(f32x4*)ho = (f32x4){hv[0], hv[1], hv[2], hv[3]}; *(f32x4*)(ho + 4) = (f32x4){hv[4], hv[5], hv[6], hv[7]};
                }
            }
        }
        if constexpr (PASS == 2) {
            ss += __shfl_xor(ss, 16); ss += __shfl_xor(ss, 32);
            const float rn = __builtin_amdgcn_rsqf(ss * (1.0f / 128.0f) + EPS);
#pragma unroll
            for (int ks = 0; ks < 4; ++ks) {
                const f32x4 g0 = *(const LAS f32x4*)(CT + 8 * 128 + 32 * ks), g1 = *(const LAS f32x4*)(CT + 8 * 128 + 32 * ks + 4);
                float o[8];
#pragma unroll
                for (int e = 0; e < 8; ++e) o[e] = y[ks][e] * rn * (e < 4 ? g0[e & 3] : g1[e & 3]);
                *(u32x4*)(ym + (size_t)r * DMIX + gch + 32 * ks) = pack8(o);
            }
        }
    }
    if constexpr (PASS == 1 && !IS_S) {
        if (fr == 0) {
            float* tp = tot + ((size_t)(b * LRU_NSEG + seg) * 2) * DA + gch;
#pragma unroll
            for (int ks = 0; ks < 4; ++ks) {
                *(f32x4*)(tp + 32 * ks) = (f32x4){Pt[ks][0], Pt[ks][1], Pt[ks][2], Pt[ks][3]}; *(f32x4*)(tp + 32 * ks + 4) = (f32x4){Pt[ks][4], Pt[ks][5], Pt[ks][6], Pt[ks][7]};
                *(f32x4*)(tp + DA + 32 * ks) = (f32x4){hin[ks][0], hin[ks][1], hin[ks][2], hin[ks][3]}; *(f32x4*)(tp + DA + 32 * ks + 4) = (f32x4){hin[ks][4], hin[ks][5], hin[ks][6], hin[ks][7]};
            }
        }
    }
}

__device__ __forceinline__ void lru_finish_item(PRef p, LAS unsigned char* lds, int n, int b, int seg) {
    const int lane = opaque_tid() & 63, fr = lane & 15, fq = lane >> 4;
    const bf16_t* z = (const bf16_t*)(p.ws + WS_Z);
    const bf16_t* lab = (const bf16_t*)(p.ws + WS_LA); const bf16_t* uub = (const bf16_t*)(p.ws + WS_UU);
    bf16_t* ym = (bf16_t*)(p.ws + WS_YM);
    const float* tot = (const float*)(p.ws + WS_TOT);
    const LAS float* CT = (const LAS float*)(lds + L_CT) + 8 * fq;
    const int gch = n * 128 + 8 * fq;
    const int r0 = b * TP + seg * 64;
    const int nblk = seg == LRU_NSEG - 1 ? 1 : 4;
    float hin[4][8];
#pragma unroll
    for (int ks = 0; ks < 4; ++ks)
#pragma unroll
        for (int e = 0; e < 8; ++e) hin[ks][e] = 0.f;
    u32x4 ln[4], un[4], gn[4];
#pragma unroll
    for (int ks = 0; ks < 4; ++ks) { ln[ks] = *(const u32x4*)(lab + (size_t)(r0 + fr) * DA + gch + 32 * ks); un[ks] = *(const u32x4*)(uub + (size_t)(r0 + fr) * DA + gch + 32 * ks);
        gn[ks] = *(const u32x4*)(z + (size_t)(r0 + fr) * DIN + DA + gch + 32 * ks); }
    if (seg > 0) {
#pragma unroll 1
        for (int round = 0; round < 2; ++round) {
            const int s = 16 * round + fr;
            if (16 * round >= seg) break;
            const bool have = s < seg;
            const float* tp = tot + ((size_t)(b * LRU_NSEG + (have ? s : 0)) * 2) * DA + gch;
#pragma unroll
            for (int ks = 0; ks < 4; ++ks) {
                const f32x4 P0 = *(const f32x4*)(tp + 32 * ks), P1 = *(const f32x4*)(tp + 32 * ks + 4), S0 = *(const f32x4*)(tp + DA + 32 * ks), S1 = *(const f32x4*)(tp + DA + 32 * ks + 4);
#pragma unroll
                for (int e = 0; e < 8; e += 2) {
                    float Pa = have ? (e < 4 ? P0[e & 3] : P1[e & 3]) : 1.f, Sa = have ? (e < 4 ? S0[e & 3] : S1[e & 3]) : 0.f;
                    float Pb = have ? (e < 4 ? P0[(e + 1) & 3] : P1[(e + 1) & 3]) : 1.f, Sb = have ? (e < 4 ? S0[(e + 1) & 3] : S1[(e + 1) & 3]) : 0.f;
                    scan16x2(Pa, Sa, Pb, Sb);
                    hin[ks][e] = __builtin_fmaf(bcast15(Pa, lane), hin[ks][e], bcast15(Sa, lane));
                    hin[ks][e + 1] = __builtin_fmaf(bcast15(Pb, lane), hin[ks][e + 1], bcast15(Sb, lane));
                }
            }
        }
    }
#pragma unroll 1
    for (int blk = 0; blk < nblk; ++blk) {
        const int r = r0 + 16 * blk + fr;
        u32x4 l4[4], u4[4], g4[4];
#pragma unroll
        for (int ks = 0; ks < 4; ++ks) { l4[ks] = ln[ks]; u4[ks] = un[ks]; g4[ks] = gn[ks]; }
        { const int rn_ = (blk + 1 < nblk) ? r + 16 : r;
#pragma unroll
          for (int ks = 0; ks < 4; ++ks) { ln[ks] = *(const u32x4*)(lab + (size_t)rn_ * DA + gch + 32 * ks); un[ks] = *(const u32x4*)(uub + (size_t)rn_ * DA + gch + 32 * ks);
              gn[ks] = *(const u32x4*)(z + (size_t)rn_ * DIN + DA + gch + 32 * ks); } }
        float y[4][8]; float ss = 0.f;
#pragma unroll
        for (int ks = 0; ks < 4; ++ks) {
            float Pv[8], Sv[8], gav[8], hv[8];
            unpack8(l4[ks], Pv); unpack8(u4[ks], Sv); unpack8(g4[ks], gav);
#pragma unroll
            for (int e = 0; e < 8; ++e) Pv[e] = __builtin_amdgcn_exp2f(Pv[e]);
#pragma unroll
            for (int e = 0; e < 8; e += 2) scan16x2(Pv[e], Sv[e], Pv[e + 1], Sv[e + 1]);
#pragma unroll
            for (int e = 0; e < 8; ++e) { hv[e] = __builtin_fmaf(Pv[e], hin[ks][e], Sv[e]); hin[ks][e] = bcast15(hv[e], lane); }
#pragma unroll
            for (int e = 0; e < 8; e += 2) { const f32x2 yy = gelu_mul2((f32x2){gav[e], gav[e + 1]}, (f32x2){hv[e], hv[e + 1]}); y[ks][e] = yy.x; y[ks][e + 1] = yy.y; ss += yy.x * yy.x + yy.y * yy.y; }
            if (seg == LRU_NSEG - 1 && fr == 15) {
                float* ho = p.out + O_PH + (size_t)b * DA + gch + 32 * ks;
                *(f32x4*)ho = (f32x4){hv[0], hv[1], hv[2], hv[3]}; *(f32x4*)(ho + 4) = (f32x4){hv[4], hv[5], hv[6], hv[7]};
            }
        }
        ss += __shfl_xor(ss, 16); ss += __shfl_xor(ss, 32);
        const float rn = __builtin_amdgcn_rsqf(ss * (1.0f / 128.0f) + EPS);
#pragma unroll
        for (int ks = 0; ks < 4; ++ks) {
            const f32x4 g0 = *(const LAS f32x4*)(CT + 8 * 128 + 32 * ks), g1 = *(const LAS f32x4*)(CT + 8 * 128 + 32 * ks + 4);
            float o[8];
#pragma unroll
            for (int e = 0; e < 8; ++e) o[e] = y[ks][e] * rn * (e < 4 ? g0[e & 3] : g1[e & 3]);
            *(u32x4*)(ym + (size_t)r * DMIX + gch + 32 * ks) = pack8(o);
        }
    }
}
template <int PASS>
__device__ __forceinline__ void mixer_phase(PRef p, LAS unsigned char* lds, int G) {
    const int tid = opaque_tid(), wave = __builtin_amdgcn_readfirstlane(tid >> 6);
    static_assert(NH * LRU_WG_PER_HEAD <= GRID, "one head group per workgroup");
    const int v = blockIdx.x, n = v / LRU_WG_PER_HEAD, jg = v % LRU_WG_PER_HEAD;
    const bool lru_wg = v < NH * LRU_WG_PER_HEAD && (PASS == 1 || jg < LRU_IDLE_J0);
    if (lru_wg) {
        __syncthreads();
        if (!(PASS == 2 && G == GRID && p.ph_lo <= 2))
        {
            const bf16_t* wg = (const bf16_t*)(p.ws + WS_WG);
            for (int i = tid; i < 2 * 128 * 16; i += 512) { const int g = i >> 11, row = (i >> 4) & 127, c16 = i & 15;
                *(LAS u32x4*)(lds + g * L_WX + row * LW_STRIDE + c16 * 16) = *(const u32x4*)(wg + (((size_t)g * NH + n) * 128 + row) * 128 + c16 * 8); }
            LAS float* CTw = (LAS float*)(lds + L_CT);
            for (int i = tid; i < 9 * 128; i += 512) { const int k = i >> 7, c = i & 127, ch = n * 128 + c;
                float vv;
                if (k < 4) vv = p.conv_a_w[k * DA + ch]; else if (k == 4) vv = p.conv_a_b[ch]; else if (k == 5) vv = -1.4426950408889634f * p.b_gate_a[ch]; else if (k == 6) vv = -1.4426950408889634f * p.b_gate_x[ch];
                else if (k == 7) vv = -8.0f * 1.4426950408889634f * log1pf(__expf(-p.lam[ch])); else vv = p.g_out_a[ch];
                CTw[i] = vv; }
        }
        __syncthreads();
        const int wi = jg * 8 + wave;
        if (wi < LRU_PITEMS) { if constexpr (PASS == 1) lru_wave_item<1, false>(p, lds, n, wi / LRU_NSEG, wi % LRU_NSEG); else lru_finish_item(p, lds, n, wi / LRU_NSEG, wi % LRU_NSEG); }
        else if (PASS == 1 && wi < LRU_PITEMS + LRU_SITEMS) lru_wave_item<2, true>(p, lds, n, wi - LRU_PITEMS, 0);
    } else if (G == GRID) {
        constexpr int NIDLE1 = GRID - NH * LRU_WG_PER_HEAD, PER_HEAD = LRU_WG_PER_HEAD - LRU_IDLE_J0, NIDLE2 = NIDLE1 + NH * PER_HEAD;
        const int idx = v >= NH * LRU_WG_PER_HEAD ? v - NH * LRU_WG_PER_HEAD : NIDLE1 + n * PER_HEAD + (jg - LRU_IDLE_J0);
        convert_items(p, lds, idx * 8 + wave, (PASS == 1 ? NIDLE1 : NIDLE2) * 8, PASS == 1 ? IT_S1 : IT_S2, PASS == 1 ? IT_S2 : IT_S3);
    }
    if (PASS == 1) { branch_b(p, G); if ((REP_MASK >> 11) & 1) branch_b(p, G); }
}

__device__ __forceinline__ void final_phase(PRef p, int G) {
    const int tid_ = opaque_tid(), lane = tid_ & 63, gw = blockIdx.x * 8 + (tid_ >> 6), NGW = G * 8;
    const bf16_t* x2b = (const bf16_t*)(p.ws + WS_YM);
    f32x4 gf[8];
#pragma unroll
    for (int j = 0; j < 8; ++j) gf[j] = ((const f32x4*)p.g_final)[lane + 64 * j];
    for (int o = gw; o < NB * SEQ + MSR; o += NGW) {
        const int r = o < NB * SEQ ? (o / SEQ) * TP + NMETA + (o % SEQ) : MPR + (o - NB * SEQ);
        const u32x2* xr = (const u32x2*)(x2b + (size_t)r * D) + lane;
        f32x4 v[8]; float s = 0.f;
#pragma unroll
        for (int j = 0; j < 8; ++j) { const u32x2 w = xr[64 * j]; v[j] = (f32x4){bf_lo(w.x), bf_hi(w.x), bf_lo(w.y), bf_hi(w.y)};
            s += (v[j][0] * v[j][0] + v[j][1] * v[j][1]) + (v[j][2] * v[j][2] + v[j][3] * v[j][3]); }
        s = wave_sum(s);
        const float rs = __builtin_amdgcn_rsqf(s * (1.0f / D) + EPS);
        f32x4* yo = (f32x4*)(p.out + (size_t)o * D) + lane;
#pragma unroll
        for (int j = 0; j < 8; ++j) __builtin_nontemporal_store(v[j] * rs * gf[j], yo + 64 * j);
    }
}

#define XB_TMO      128
#define XB_XCNT(j)  (256  + 64 * (j))
#define XB_XSUB(j)  (1280 + 64 * (j))
#define XB_XGEN(j)  (2304 + 64 * (j))
#define XB_TOP      3328
#define XB_TOPGEN   3392
#define XCD_BAR_WORDS 3456
#define XB_SPIN_CAP (1u << 18)
__device__ __forceinline__ unsigned xb_ld(unsigned* p)              { return __hip_atomic_load(p, __ATOMIC_RELAXED, __HIP_MEMORY_SCOPE_AGENT); }
__device__ __forceinline__ unsigned xb_add(unsigned* p, unsigned v) { return __hip_atomic_fetch_add(p, v, __ATOMIC_RELAXED, __HIP_MEMORY_SCOPE_AGENT); }
__device__ __forceinline__ unsigned xb_xcc_id() { return (unsigned)__builtin_amdgcn_s_getreg((3 << 11) | 20) & 0xFu; }
#define XB_SPIN(cond, bar) do { unsigned _sp = 0; while (cond) { __builtin_amdgcn_s_sleep(1); \
    if ((++_sp & 255u) == 0u) { if (xb_ld(&(bar)[XB_TMO])) break; if (_sp > XB_SPIN_CAP) { atomicAdd(&(bar)[XB_TMO], 1u); break; } } } } while (0)
struct XcdBarrier { unsigned* bar; unsigned x; volatile LAS unsigned* st; };
__device__ __forceinline__ XcdBarrier xcd_barrier_post(unsigned* bar, volatile LAS unsigned* st) {
    XcdBarrier b; b.bar = bar; b.x = xb_xcc_id(); b.st = st;
    if (threadIdx.x == 0) (void)xb_add(&bar[XB_XCNT(b.x)], 1u);
    return b;
}
__device__ __forceinline__ void xcd_barrier_complete(unsigned* bar, unsigned x, unsigned& nloc, unsigned& nx) {
    const unsigned G = gridDim.x * gridDim.y * gridDim.z;
    unsigned sum, cnt, mine, sp = 0u;
    for (;;) {
        sum = 0u; cnt = 0u; mine = 0u;
#pragma unroll
        for (unsigned j = 0; j < 16; ++j) { const unsigned c = xb_ld(&bar[XB_XCNT(j)]); sum += c; cnt += (c > 0u) ? 1u : 0u; mine = (j == x) ? c : mine; }
        if (sum == G) break;
        __builtin_amdgcn_s_sleep(1);
        if ((++sp & 255u) == 0u) { if (xb_ld(&bar[XB_TMO])) break; if (sp > XB_SPIN_CAP) { atomicAdd(&bar[XB_TMO], 1u); break; } }
    }
    nloc = mine > 0u ? mine : 1u; nx = cnt > 0u ? cnt : 1u;
}
__device__ __forceinline__ void xcd_barrier(const XcdBarrier& b) {
    asm volatile("s_waitcnt vmcnt(0)" ::: "memory");
    __syncthreads();
    if (threadIdx.x == 0) {
        unsigned* bar = b.bar;
        __builtin_amdgcn_s_waitcnt(0);
        unsigned nloc = b.st[0], nx = b.st[1];
        if (nloc == 0u) { xcd_barrier_complete(bar, b.x, nloc, nx); b.st[0] = nloc; b.st[1] = nx; }
        const unsigned old = xb_add(&bar[XB_XSUB(b.x)], 1u);
        const unsigned gen = old / nloc;
        if (old + 1u == (gen + 1u) * nloc) {
            __builtin_amdgcn_fence(__ATOMIC_RELEASE, "agent");
            asm volatile("s_waitcnt vmcnt(0)" ::: "memory");
            const unsigned og = xb_add(&bar[XB_TOP], 1u);
            const unsigned tg = og / nx;
            if (og + 1u == (tg + 1u) * nx) xb_add(&bar[XB_TOPGEN], 1u);
            else XB_SPIN(xb_ld(&bar[XB_TOPGEN]) == tg, bar);
            __builtin_amdgcn_fence(__ATOMIC_ACQUIRE, "agent");
            xb_add(&bar[XB_XGEN(b.x)], 1u);
            asm volatile("s_waitcnt vmcnt(0)" ::: "memory");
        } else {
            XB_SPIN(xb_ld(&bar[XB_XGEN(b.x)]) == gen, bar);
            __builtin_amdgcn_fence(__ATOMIC_ACQUIRE, "agent");
            asm volatile("s_waitcnt vmcnt(0)" ::: "memory");
        }
    }
    __syncthreads();
}

constexpr int LDS_BYTES = 131072 + 1024 + 8 * 1024 + 8 * 2048;
constexpr int N_PHASES = 8;
__global__ void __launch_bounds__(512, 2) hymba_fwd(Params p) {
    extern __shared__ __attribute__((aligned(16))) unsigned char lds_raw[];
    LAS unsigned char* lds = (LAS unsigned char*)lds_raw;
    constexpr int G = GRID;
    if ((int)gridDim.x != GRID) return;
    const CAS Params* kp = (const CAS Params*)__builtin_amdgcn_kernarg_segment_ptr();
#define P_HERE (*({ const CAS Params* q_ = kp; asm volatile("" : "+s"(q_)); q_; }))
    unsigned char* ws = p.ws;
    volatile LAS unsigned* misc = (volatile LAS unsigned*)(lds + 131072);
    if (threadIdx.x < 8) misc[threadIdx.x] = 0u;
    __syncthreads();
    XcdBarrier bar = xcd_barrier_post((unsigned*)ws, misc);
    const int lo = p.ph_lo, hi = p.ph_hi;
#ifndef PH_MASK
#define PH_MASK 0xff
#endif
#define IN(k) (((PH_MASK >> (k)) & 1) && lo <= (k) && (k) < hi)
#define SEAM(k) do { if (IN(k) && IN((k) + 1)) xcd_barrier(bar); } while (0)
#define REPEAT(k) _Pragma("nounroll") for (int rep_ = 0; rep_ < ((((REP_MASK) >> (k)) & 1) ? 2 : 1); ++rep_, (rep_ < ((((REP_MASK) >> (k)) & 1) ? 2 : 1) ? xcd_barrier(bar) : (void)0))
    if ((REP_MASK >> 12) & 1) { xcd_barrier(bar); xcd_barrier(bar); xcd_barrier(bar); xcd_barrier(bar); }
    if (IN(0)) REPEAT(0) phase0(P_HERE, lds, G);
    SEAM(0);
    if (IN(1)) REPEAT(1) {
        pg8::Gemm g{(const bf16_t*)(ws + WS_XB) + (size_t)16 * D, (const bf16_t*)(ws + WS_WIN), MP / 256, DIN / 256, D, (size_t)256 * D * 2, (size_t)128 * D * 2};
        pg8::StaticOrder S; S.init(g.nM, g.nN, G, (int)blockIdx.x, D / 64, 1);
        LAS float* rstab1 = (LAS float*)(lds + 131072 + 1024);
        rstd1_table((const float*)(ws + WS_RS1), rstab1, S); __syncthreads();
        PRef q = P_HERE; EpiZ E{rstab1, (bf16_t*)(ws + WS_Z), q.out};
        pg8::gemm_phase<EpiZ, false, true, true>(lds, g, S, E, nullptr, nullptr);
        if ((int)blockIdx.x >= P1_TAIL_WG0 && G == 256) convert_items(P_HERE, lds, ((int)blockIdx.x - P1_TAIL_WG0) * 8 + (opaque_tid() >> 6), (G - P1_TAIL_WG0) * 8, IT_O, IT_S1);
        else if (G != 256) convert_items(P_HERE, lds, (int)blockIdx.x * 8 + (opaque_tid() >> 6), G * 8, IT_O, IT_S3);
    }
    SEAM(1);
    if (IN(2)) REPEAT(2) mixer_phase<1>(P_HERE, lds, G);
    SEAM(2);
    if (IN(3)) REPEAT(3) mixer_phase<2>(P_HERE, lds, G);
    SEAM(3);
    if (IN(4)) REPEAT(4) {
        pg8::Gemm g{(const bf16_t*)(ws + WS_YM), (const bf16_t*)(ws + WS_WO), MP / 256, D / 256, DMIX, (size_t)256 * DMIX * 2, (size_t)128 * DMIX * 2};
        pg8::StaticOrder S; S.init(g.nM, g.nN, G, (int)blockIdx.x, DMIX / 64, P4_SPLIT);
        EpiX1 E{(bf16_t*)(ws + WS_XB) + (size_t)16 * D, (float*)(ws + WS_SSQ)};
        pg8::gemm_phase<EpiX1, false, true, true>(lds, g, S, E, (float*)(ws + WS_Z), (unsigned*)ws + CW_TK4 + rep_ * 128 * 64);
        if ((int)blockIdx.x >= P4_TAIL_WG0 && G == 256) convert_items(P_HERE, lds, ((int)blockIdx.x - P4_TAIL_WG0) * 8 + (opaque_tid() >> 6), (G - P4_TAIL_WG0) * 8, IT_S3, IT_G);
        else if (G != 256) convert_items(P_HERE, lds, (int)blockIdx.x * 8 + (opaque_tid() >> 6), G * 8, IT_S3, IT_G);
    }
    SEAM(4);
    if (IN(5)) REPEAT(5) {
        pg8::Gemm g{(const bf16_t*)(ws + WS_XB) + (size_t)14 * D, (const bf16_t*)(ws + WS_WUP), 37, 2 * DFF / 256, D, (size_t)252 * D * 2, (size_t)64 * D * 2};
        pg8::StaticOrder S; S.init(g.nM, g.nN, G, (int)blockIdx.x, D / 64, 1);
        LAS float* rstab = (LAS float*)(lds + 131072 + 1024); LAS float* wtab = rstab + 8 * 256;
        PRef q = P_HERE; ffn_rstd_table((const float*)(ws + WS_SSQ), q.conv_f_w, q.conv_f_b, rstab, wtab, S); __syncthreads();
        EpiFFN E{q.st_fc, (bf16_t*)(ws + WS_Z), q.out, rstab, wtab};
        pg8::gemm_phase<EpiFFN, true, true, true>(lds, g, S, E, nullptr, nullptr);
    }
    SEAM(5);
    if (IN(6)) {
        pg8::Gemm g{(const bf16_t*)(ws + WS_Z), (const bf16_t*)(ws + WS_WDN), MP / 256, D / 256, DFF, (size_t)256 * DFF * 2, (size_t)128 * DFF * 2};
        pg8::StaticOrder S; S.init(g.nM, g.nN, G, (int)blockIdx.x, DFF / 64, P6_SPLIT);
        EpiOut E{(const bf16_t*)(ws + WS_XB) + (size_t)16 * D, (bf16_t*)(ws + WS_YM)};
        pg8::gemm_phase<EpiOut, false, true, true>(lds, g, S, E, (float*)(ws + WS_WIN), (unsigned*)ws + CW_TK6);
    }
    SEAM(6);
    if (IN(7)) REPEAT(7) final_phase(P_HERE, G);
#undef IN
#undef SEAM
}

extern "C" void kernel_launch(void* const* d_in, const int* in_sizes, int n_in, void* d_out, int out_size, void* d_ws, size_t ws_size, hipStream_t stream) {
    static int grid = 0;
    if (grid == 0) {
        if (n_in != 26 || (size_t)out_size != O_END || ws_size < WS_END) { fprintf(stderr, "kernel_launch: unexpected problem (n_in %d, out %d, ws %zu; need ws >= %zu)\n", n_in, out_size, ws_size, (size_t)WS_END); grid = -1; return; }
        int dev = 0, cus = 0, per_cu = 0;
        hipGetDevice(&dev); hipDeviceGetAttribute(&cus, hipDeviceAttributeMultiprocessorCount, dev);
        if (hipFuncSetAttribute((const void*)hymba_fwd, hipFuncAttributeMaxDynamicSharedMemorySize, LDS_BYTES) != hipSuccess) { fprintf(stderr, "kernel_launch: hipFuncSetAttribute failed\n"); grid = -1; return; }
        if (hipOccupancyMaxActiveBlocksPerMultiprocessor(&per_cu, (const void*)hymba_fwd, 512, LDS_BYTES) != hipSuccess || per_cu < 1) { fprintf(stderr, "kernel_launch: occupancy query says %d\n", per_cu); grid = -1; return; }
        if (cus < GRID) { fprintf(stderr, "kernel_launch: built for a %d-CU device, found %d CUs\n", GRID, cus); grid = -1; return; }
        grid = GRID;
    }
    if (grid < 0) return;
    Params p{};
    const float** f = (const float**)&p;
    for (int i = 0; i < 26; ++i) f[i] = (const float*)d_in[i];
    p.out = (float*)d_out; p.ws = (unsigned char*)d_ws;
    if (hipMemsetAsync(d_ws, 0, CTL_WORDS * 4, stream) != hipSuccess) { fprintf(stderr, "kernel_launch: memset failed\n"); return; }
    if (MK_N_LAUNCHES == 1) {
        p.ph_lo = 0; p.ph_hi = N_PHASES;
        hipLaunchKernelGGL(hymba_fwd, dim3(grid), dim3(512), LDS_BYTES, stream, p);
    } else {
        for (int k = 0; k < N_PHASES; ++k) { p.ph_lo = k; p.ph_hi = k + 1; hipLaunchKernelGGL(hymba_fwd, dim3(grid), dim3(512), LDS_BYTES, stream, p); }
    }
}
```

```cpp
#include <hip/hip_runtime.h>
#include <cstdio>

#ifndef REP_MASK
#define REP_MASK 0x00
#endif
#ifndef MK_N_LAUNCHES
#define MK_N_LAUNCHES 1
#endif

#define LAS __attribute__((address_space(3)))
#define CAS __attribute__((address_space(4)))
typedef unsigned short bf16_t;
typedef short bf16x8 __attribute__((ext_vector_type(8)));
typedef float f32x4 __attribute__((ext_vector_type(4)));
typedef unsigned u32x4 __attribute__((ext_vector_type(4)));
typedef unsigned u32x2 __attribute__((ext_vector_type(2)));

constexpr int D = 2048, NMETA = 16, SEQ = 2048, TP = SEQ + NMETA, NB = 4, MPR = NB * TP;
constexpr int NS = 128, TS = 8, MSR = NS * TS, M = MPR + MSR;
constexpr int MP = 9472;
constexpr int DA = 1536, DB = 1024, DIN = 6144, DMIX = 2560, DFF = 6144, NH = 12;
constexpr float EPS = 1e-6f;
constexpr int NCH = 33;
constexpr size_t O_YP = 0, O_YS = O_YP + (size_t)NB * SEQ * D, O_PH = O_YS + (size_t)MSR * D, O_PRC = O_PH + NB * DA,
                 O_PSC = O_PRC + NB * 3 * DA, O_PFC = O_PSC + NB * 2 * DB, O_SH = O_PFC + NB * 2 * DFF, O_SRC = O_SH + NS * DA,
                 O_SSC = O_SRC + (size_t)NS * 3 * DA, O_SFC = O_SSC + (size_t)NS * 2 * DB, O_END = O_SFC + (size_t)NS * 2 * DFF;
constexpr size_t MiB = 1u << 20;
constexpr int CW_QB = 4096 + 256 * 64;
constexpr int CW_TK6 = 4096, CTL_WORDS = 4096 + 256 * 64 + 8 * 64;
constexpr int P6_SPLIT = 6, P4_SPLIT = 4, CW_TK4 = CW_TK6 + 64 * 64;
constexpr int CW_Q0 = 3904, CW_Q7 = 3968;
constexpr int CW_LRU_DONE = 3520;
constexpr int GRID = 256;
constexpr size_t WS_WIN = 1 * MiB;
constexpr size_t WS_WO = WS_WIN + (size_t)DIN * D * 2;
constexpr size_t WS_WUP = WS_WO + (size_t)D * DMIX * 2;
constexpr size_t WS_WDN = WS_WUP + (size_t)2 * DFF * D * 2;
constexpr size_t WS_WG = WS_WDN + (size_t)D * DFF * 2;
constexpr size_t WS_XB = WS_WG + (size_t)2 * NH * 128 * 128 * 2;
constexpr size_t XB_ROWS = 9600;
constexpr size_t WS_Z = WS_XB + XB_ROWS * D * 2;
constexpr size_t WS_YM = WS_Z + (size_t)MP * DIN * 2;
constexpr size_t WS_RS1 = WS_YM + (size_t)MP * DMIX * 2;
constexpr size_t WS_SSQ = WS_RS1 + (size_t)MP * 4;
constexpr size_t WS_TOT = WS_SSQ + (size_t)MP * 32 * 4;
constexpr size_t WS_LA = WS_TOT + (size_t)NB * NCH * DA * 2 * 4;
constexpr size_t WS_UU = WS_LA + (size_t)MPR * DA * 2;
constexpr size_t WS_END = WS_UU + (size_t)MPR * DA * 2;

struct Params;
typedef const CAS Params& PRef;
struct Params {
    const float *x_prompt, *x_sample, *st_h, *st_rc, *st_sc, *st_fc, *meta, *g_mix, *w_in, *conv_a_w, *conv_a_b, *w_gate_a, *b_gate_a,
        *w_gate_x, *b_gate_x, *lam, *conv_b_w, *g_out_a, *g_out_b, *w_o, *g_ffn, *w_up, *conv_f_w, *conv_f_b, *w_down, *g_final;
    float* out; unsigned char* ws; int ph_lo, ph_hi;
};

__device__ __forceinline__ unsigned cvt_pk_bf16(float lo, float hi) { unsigned r; asm volatile("v_cvt_pk_bf16_f32 %0, %1, %2" : "=v"(r) : "v"(lo), "v"(hi)); return r; }
__device__ __forceinline__ float bf_lo(unsigned w) { return __builtin_bit_cast(float, w << 16); }
__device__ __forceinline__ float bf_hi(unsigned w) { return __builtin_bit_cast(float, w & 0xffff0000u); }
__device__ __forceinline__ void unpack8(const u32x4 w, float (&f)[8]) { f[0] = bf_lo(w.x); f[1] = bf_hi(w.x); f[2] = bf_lo(w.y); f[3] = bf_hi(w.y); f[4] = bf_lo(w.z); f[5] = bf_hi(w.z); f[6] = bf_lo(w.w); f[7] = bf_hi(w.w); }
__device__ __forceinline__ u32x4 pack8(const float (&f)[8]) { u32x4 w; w.x = cvt_pk_bf16(f[0], f[1]); w.y = cvt_pk_bf16(f[2], f[3]); w.z = cvt_pk_bf16(f[4], f[5]); w.w = cvt_pk_bf16(f[6], f[7]); return w; }
__device__ __forceinline__ float wave_sum(float v) {
#pragma unroll
    for (int o = 1; o < 64; o <<= 1) v += __shfl_xor(v, o);
    return v;
}
__device__ __forceinline__ float sum16(float v) {
    v += __shfl_xor(v, 1); v += __shfl_xor(v, 2); v += __shfl_xor(v, 4); v += __shfl_xor(v, 8); return v;
}
__device__ __forceinline__ float sigmoidf_(float x) { return __builtin_amdgcn_rcpf(1.0f + __expf(-x)); }
__device__ __forceinline__ float gelu_tanh(float x) {
    constexpr float K1 = -2.0f * 0.7978845608028654f * 1.4426950408889634f, K2 = K1 * 0.044715f;
    const float t = x * __builtin_fmaf(x * x, K2, K1);
    return x * __builtin_amdgcn_rcpf(1.0f + __builtin_amdgcn_exp2f(t));
}
__device__ __forceinline__ int opaque_tid() { int t = threadIdx.x; asm volatile("" : "+v"(t)); return t; }
typedef float f32x2 __attribute__((ext_vector_type(2)));
__device__ __forceinline__ f32x2 gelu_mul2(f32x2 g, f32x2 v) {
    constexpr float K1 = -2.0f * 0.7978845608028654f * 1.4426950408889634f, K2 = K1 * 0.044715f;
    const f32x2 t = g * ((g * g) * K2 + K1);
    f32x2 e; e.x = __builtin_amdgcn_exp2f(t.x); e.y = __builtin_amdgcn_exp2f(t.y);
    const f32x2 d = e + 1.0f;
    f32x2 r; r.x = __builtin_amdgcn_rcpf(d.x); r.y = __builtin_amdgcn_rcpf(d.y);
    return (g * v) * r;
}
template <int CTRL> __device__ __forceinline__ float dppf(float old, float src) {
    return __builtin_bit_cast(float, __builtin_amdgcn_update_dpp(__builtin_bit_cast(int, old), __builtin_bit_cast(int, src), CTRL, 0xF, 0xF, false));
}
__device__ __forceinline__ void row_decode(int r, int& is_s, int& seq, int& t) {
    if (r < MPR) { seq = (r >= TP) + (r >= 2 * TP) + (r >= 3 * TP); t = r - seq * TP; is_s = 0; }
    else { const int q = r - MPR; seq = q >> 3; t = q & 7; is_s = 1; }
}
__device__ __forceinline__ const float* x_row_ptr(const float* xp, const float* xs, const float* meta, int r) {
    int is_s, seq, t; row_decode(r, is_s, seq, t);
    if (is_s) return xs + (size_t)(r - MPR) * D;
    return t < NMETA ? meta + (size_t)t * D : xp + ((size_t)seq * SEQ + (t - NMETA)) * D;
}
__device__ __forceinline__ float* y_row_ptr(float* out, int r) {
    if (r >= M) return nullptr;
    int is_s, seq, t; row_decode(r, is_s, seq, t);
    if (is_s) return out + O_YS + (size_t)(r - MPR) * D;
    return t < NMETA ? nullptr : out + O_YP + ((size_t)seq * SEQ + (t - NMETA)) * D;
}

namespace pg8 {
constexpr int BM = 256, BK = 64, HALF = 128, HTB = HALF * BK * 2, STAGE_BYTES = 8 * HTB, NXCD = 8, WGM = 2;
__host__ __device__ __forceinline__ int lds_byte(int r, int c) { const int st = (r >> 4) * 2 + (c >> 5), rr = r & 15, cc = c & 31, ob = rr * 64 + cc * 2; return st * 1024 + (ob ^ (((ob >> 9) & 1) << 5)); }
__host__ __device__ __forceinline__ void stage_rc(int b, int& R, int& C) { const int st = b / 1024, sb = b % 1024, swz = sb ^ (((sb >> 9) & 1) << 5); R = (st >> 1) * 16 + swz / 64; C = (st & 1) * 32 + (swz % 64) / 2; }
struct Unit { int pm, pn, kb, nk, piece, lu, idx; };
struct Gemm { const bf16_t* A; const bf16_t* Bt; int nM, nN, K; size_t a_tstep, a_hstep; };
struct StaticOrder {
    int nM, nN, nwg, G, c, nt, split, nfull, nleft, limit = 1 << 20, first = 0; bool sf = false, ffn = false;
    __device__ __forceinline__ void init(int nM_, int nN_, int G_, int c_, int nt_, int split_, bool sf_ = false) { sf = sf_; nM = nM_; nN = nN_; nwg = nM * nN; G = G_; c = c_; nt = nt_; nfull = (nwg / G) * G; nleft = nwg - nfull;
        split = (split_ > 1 && nleft > 0 && nleft * split_ <= G && (nt / split_) * split_ == nt && ((nt / split_) & 1) == 0) ? split_ : 1; }
    __device__ __forceinline__ void map2(int L, int nwg_, int nM_, Unit& u) const {
        int wgid = L; { const int q = nwg_ / NXCD, r = nwg_ % NXCD, xcd = wgid % NXCD, off = wgid / NXCD; wgid = (xcd < r ? xcd * (q + 1) : r * (q + 1) + (xcd - r) * q) + off; }
        const int nig = WGM * nN, gid = wgid / nig, rem = wgid - gid * nig, fm = gid * WGM, glast = nM_ % WGM;
        if (nM_ - fm >= WGM || glast == 0) { u.pm = fm + (rem & (WGM - 1)); u.pn = rem / WGM; }
        else { u.pm = fm + rem % glast; u.pn = rem / glast; }
    }
    __device__ __forceinline__ void map(int L, Unit& u) const {
        if (!ffn) { map2(L, nwg, nM, u); return; }
        constexpr int NPLAIN = 28 * 48;
        if (L < NPLAIN) { map2(L, NPLAIN, 28, u); u.pm = u.pm + 1 + u.pm / 7; }
        else { const int lu = L - NPLAIN, ps = lu / 48; u.pn = lu - ps * 48; u.pm = ps < 4 ? 8 * ps : 28 + ps; }
    }
    __device__ __forceinline__ bool next(int i, Unit& u) const {
        u.kb = 0; u.nk = nt; u.piece = -1; u.lu = 0; u.idx = i;
        i += first; if (i >= limit) return false;
        if (sf) {
            if (split > 1 && c < nleft * split) {
                if (i == 0) { u.lu = c % nleft; u.piece = c / nleft; u.nk = nt / split; u.kb = u.piece * u.nk; map(nfull + u.lu, u); return true; }
                --i;
            }
            const long L = (long)i * G + c;
            if (L >= (split > 1 ? nfull : nwg)) return false;
            map((int)L, u); return true;
        }
        const long L = (long)i * G + c;
        if (L < nfull || split == 1) { if (L >= nwg) return false; map((int)L, u); return true; }
        if (L >= nfull + G || c >= nleft * split) return false;
        u.lu = c % nleft; u.piece = c / nleft; u.nk = nt / split; u.kb = u.piece * u.nk; map(nfull + u.lu, u); return true;
    }
};

constexpr int SLAB_SLOTS = 6;
template <int P, int A, int Mi>
__device__ __forceinline__ void reduce_rowgroup(f32x4 (&acc)[2][2][4][2], const unsigned char* slab0, int tid, int nsl) {
    const unsigned char* sp = slab0 + (size_t)((A * 4 + Mi) * SLAB_SLOTS) * 16384 + tid * 16;
#pragma unroll
    for (int b = 0; b < 2; ++b) {
        f32x4 s0 = (f32x4){0.f, 0.f, 0.f, 0.f}, s1 = s0;
#pragma unroll
        for (int src = 0; src < SLAB_SLOTS; ++src) {
            if (src == P) { s0 += acc[A][b][Mi][0]; s1 += acc[A][b][Mi][1]; }
            else if (src < 4 || src < nsl) { float f[8]; unpack8(*(const u32x4*)(sp + (size_t)src * 16384 + b * 8192), f); s0 += (f32x4){f[0], f[1], f[2], f[3]}; s1 += (f32x4){f[4], f[5], f[6], f[7]}; }
        }
        acc[A][b][Mi][0] = s0; acc[A][b][Mi][1] = s1;
    }
}
struct NoPre { __device__ __forceinline__ void operator()() const {} };
template <class Epi, bool FFNMAP, bool ALIGN_EPI, bool SP2, class Pre = NoPre>
__device__ __forceinline__ void gemm_phase(LAS unsigned char* lds, const Gemm g, const StaticOrder& S, const Epi& E, float* slabs, unsigned* tickets, bool dry = false, const Pre& pre = Pre()) {
    int tid = threadIdx.x; asm volatile("" : "+v"(tid));
    const int wid = __builtin_amdgcn_readfirstlane(tid >> 6), lane = tid & 63, wr = wid >> 2, wc = wid & 3, fr = lane & 15, fq = lane >> 4;
    const int K = g.K;
    unsigned voffA[2], voffB[2];
#pragma unroll
    for (int i = 0; i < 2; ++i) { int R, C; stage_rc(tid * 16 + i * 8192, R, C); const int Ra = FFNMAP ? (126 * (R >> 6) + 4 * (R & 15) + ((R >> 4) & 3)) : R;
        voffA[i] = (unsigned)(Ra * K + C) * 2u; voffB[i] = (unsigned)(R * BK + C) * 2u; }
    const size_t kstep = (size_t)(BK * 2), kstepB = (size_t)BM * BK * 2;
    const size_t hstepA = g.a_hstep, tstepA = g.a_tstep;
    const size_t hstepB = (size_t)HALF * BK * 2, tstepB = (size_t)(K / BK) * kstepB;
    const unsigned ldsw = (unsigned)wid * 1024u;
    const int aoff = lds_byte(wr * 64 + fr, fq * 8), boff = lds_byte(wc * 32 + fr, fq * 8);
#define PG8_SA(b, h) (((b) * 2 + (h)) * HTB)
#define PG8_SB(b, h) ((4 + (b) * 2 + (h)) * HTB)
#define PG8_STAGE(bufoff, gbase, voff) do { _Pragma("unroll") for (int _i = 0; _i < 2; ++_i) \
        __builtin_amdgcn_global_load_lds((const unsigned*)((const char*)(gbase) + (voff)[_i]), (LAS unsigned*)(lds + (bufoff) + ldsw + _i * 8192), 16, 0, 0); } while (0)
#define PG8_LDA(dst, b, h) do { _Pragma("unroll") for (int m = 0; m < 4; ++m) _Pragma("unroll") for (int k = 0; k < 2; ++k) dst[m][k] = *(const LAS bf16x8*)(lds + PG8_SA(b, h) + aoff + m * 2048 + k * 1024); } while (0)
#define PG8_LDB(dst, b, h) do { _Pragma("unroll") for (int n = 0; n < 2; ++n) _Pragma("unroll") for (int k = 0; k < 2; ++k) dst[n][k] = *(const LAS bf16x8*)(lds + PG8_SB(b, h) + boff + n * 2048 + k * 1024); } while (0)
#define PG8_MMA(ai, bj, At, Bt) do { __builtin_amdgcn_s_setprio(1); _Pragma("unroll") for (int m = 0; m < 4; ++m) _Pragma("unroll") for (int n = 0; n < 2; ++n) _Pragma("unroll") for (int k = 0; k < 2; ++k) \
        acc[ai][bj][m][n] = __builtin_amdgcn_mfma_f32_16x16x32_bf16(Bt[n][k], At[m][k], acc[ai][bj][m][n], 0, 0, 0); __builtin_amdgcn_s_setprio(0); } while (0)
#define PG8_WAIT_V(n) asm volatile("s_waitcnt vmcnt(" #n ")" ::: "memory")
#define PG8_WAIT_L(n) asm volatile("s_waitcnt lgkmcnt(" #n ")" ::: "memory")
#define PG8_BAR __builtin_amdgcn_s_barrier()
#define PG8_SCHED __builtin_amdgcn_sched_barrier(0)
    Unit cur, nxt, sl; int ui = 0; bool signalled = false;
    sl.piece = -1; sl.lu = 0; sl.pm = 0; sl.pn = 0; sl.kb = 0; sl.nk = 0; sl.idx = 0;
    if (!S.next(0, cur)) return;
    f32x4 acc[2][2][4][2];
#pragma unroll
    for (int a = 0; a < 2; ++a)
#pragma unroll
        for (int b = 0; b < 2; ++b)
#pragma unroll
            for (int m = 0; m < 4; ++m)
#pragma unroll
                for (int n = 0; n < 2; ++n) acc[a][b][m][n] = (f32x4){0.f, 0.f, 0.f, 0.f};
    bf16x8 At[4][2], B0[2][2], B1[2][2];
    const char* cA = (const char*)g.A + (size_t)cur.pm * tstepA + (size_t)cur.kb * kstep; const char* cB = (const char*)g.Bt + (size_t)cur.pn * tstepB + (size_t)cur.kb * kstepB;
    if constexpr (SP2) {
        PG8_STAGE(PG8_SB(0, 0), cB, voffB); PG8_STAGE(PG8_SB(0, 1), cB + hstepB, voffB); PG8_STAGE(PG8_SA(0, 0), cA, voffA); PG8_STAGE(PG8_SA(0, 1), cA + hstepA, voffA);
        pre();
        if (wr == 1) PG8_BAR;
        PG8_WAIT_V(2); PG8_BAR;
        PG8_STAGE(PG8_SB(1, 0), cB + kstepB, voffB); PG8_STAGE(PG8_SA(1, 0), cA + kstep, voffA); PG8_STAGE(PG8_SB(1, 1), cB + hstepB + kstepB, voffB);
        PG8_WAIT_V(6); PG8_BAR;
    } else {
        PG8_STAGE(PG8_SB(0, 0), cB, voffB); PG8_STAGE(PG8_SA(0, 0), cA, voffA); PG8_STAGE(PG8_SB(0, 1), cB + hstepB, voffB); PG8_STAGE(PG8_SA(0, 1), cA + hstepA, voffA);
        if (wr == 1) PG8_BAR;
        PG8_WAIT_V(4); PG8_BAR;
        PG8_STAGE(PG8_SB(1, 0), cB + kstepB, voffB); PG8_STAGE(PG8_SA(1, 0), cA + kstep, voffA); PG8_STAGE(PG8_SB(1, 1), cB + hstepB + kstepB, voffB);
        PG8_WAIT_V(6); PG8_BAR;
    }
    for (;;) {
        const bool has_next = S.next(ui + 1, nxt);
        const char* nA = has_next ? (const char*)g.A + (size_t)nxt.pm * tstepA + (size_t)nxt.kb * kstep : cA; const char* nB = has_next ? (const char*)g.Bt + (size_t)nxt.pn * tstepB + (size_t)nxt.kb * kstepB : cB;
        const int nt = cur.nk;
        for (int t = 0; t < nt; t += 2) {
            const bool last = (t == nt - 2);
            const char* a1 = cA + (size_t)(t + 1) * kstep;
            const char* a2 = last ? nA : cA + (size_t)(t + 2) * kstep; const char* b2 = last ? nB : cB + (size_t)(t + 2) * kstepB;
            const char* a3 = a2 + kstep; const char* b3 = b2 + kstepB;
            if constexpr (SP2) {
            PG8_LDB(B0, 0, 0); PG8_LDB(B1, 0, 1); PG8_SCHED; PG8_LDA(At, 0, 0); PG8_STAGE(PG8_SA(1, 1), a1 + hstepA, voffA);
            PG8_WAIT_V(8); PG8_WAIT_L(0); PG8_BAR; PG8_MMA(0, 0, At, B0); PG8_MMA(0, 1, At, B1); PG8_BAR; PG8_SCHED;
            PG8_LDA(At, 0, 1); PG8_STAGE(PG8_SB(0, 0), b2, voffB); PG8_STAGE(PG8_SB(0, 1), b2 + hstepB, voffB); PG8_STAGE(PG8_SA(0, 0), a2, voffA);
            PG8_WAIT_V(8); PG8_WAIT_L(0); PG8_BAR; PG8_MMA(1, 0, At, B0); PG8_MMA(1, 1, At, B1); PG8_BAR; PG8_SCHED;
            PG8_LDB(B0, 1, 0); PG8_LDB(B1, 1, 1); PG8_SCHED; PG8_LDA(At, 1, 0); PG8_STAGE(PG8_SA(0, 1), a2 + hstepA, voffA);
            PG8_WAIT_V(8); PG8_WAIT_L(0); PG8_BAR; PG8_MMA(0, 0, At, B0); PG8_MMA(0, 1, At, B1); PG8_BAR; PG8_SCHED;
            PG8_LDA(At, 1, 1); PG8_STAGE(PG8_SB(1, 0), b3, voffB); PG8_STAGE(PG8_SB(1, 1), b3 + hstepB, voffB); PG8_STAGE(PG8_SA(1, 0), a3, voffA);
            PG8_WAIT_V(8); PG8_WAIT_L(0); PG8_BAR; PG8_MMA(1, 0, At, B0); PG8_MMA(1, 1, At, B1); PG8_BAR; PG8_SCHED;
            } else {
            PG8_LDB(B0, 0, 0); PG8_SCHED; PG8_LDA(At, 0, 0); PG8_STAGE(PG8_SA(1, 1), a1 + hstepA, voffA);
            PG8_WAIT_L(8); PG8_BAR; PG8_WAIT_L(0); PG8_MMA(0, 0, At, B0); PG8_BAR; PG8_SCHED;
            PG8_LDB(B1, 0, 1); PG8_STAGE(PG8_SB(0, 0), b2, voffB);
            PG8_BAR; PG8_WAIT_L(0); PG8_MMA(0, 1, At, B1); PG8_BAR;
            PG8_LDA(At, 0, 1); PG8_STAGE(PG8_SA(0, 0), a2, voffA);
            PG8_BAR; PG8_WAIT_L(0); PG8_MMA(1, 0, At, B0); PG8_BAR; PG8_SCHED;
            PG8_STAGE(PG8_SB(0, 1), b2 + hstepB, voffB);
            PG8_WAIT_V(6); PG8_BAR; PG8_MMA(1, 1, At, B1); PG8_BAR;
            PG8_LDB(B0, 1, 0); PG8_SCHED; PG8_LDA(At, 1, 0); PG8_STAGE(PG8_SA(0, 1), a2 + hstepA, voffA);
            PG8_WAIT_L(8); PG8_BAR; PG8_WAIT_L(0); PG8_MMA(0, 0, At, B0); PG8_BAR; PG8_SCHED;
            PG8_LDB(B1, 1, 1); PG8_STAGE(PG8_SB(1, 0), b3, voffB);
            PG8_BAR; PG8_WAIT_L(0); PG8_MMA(0, 1, At, B1); PG8_BAR;
            PG8_LDA(At, 1, 1); PG8_STAGE(PG8_SA(1, 0), a3, voffA);
            PG8_BAR; PG8_WAIT_L(0); PG8_MMA(1, 0, At, B0); PG8_BAR; PG8_SCHED;
            PG8_STAGE(PG8_SB(1, 1), b3 + hstepB, voffB);
            PG8_WAIT_V(6); PG8_BAR; PG8_MMA(1, 1, At, B1); PG8_BAR;
            }
        }
        if constexpr (ALIGN_EPI) { if (wr == 0) PG8_BAR; }
        if constexpr (Epi::SPLIT && Epi::SLICE_FIRST) {
            if (cur.piece >= 0) {
                if (!dry) {
                    const __amdgpu_buffer_rsrc_t rs = __builtin_amdgcn_make_buffer_rsrc((void*)((unsigned char*)slabs + (size_t)cur.lu * (8 * SLAB_SLOTS * 16384)), (short)0, 8 * SLAB_SLOTS * 16384, 0x00020000);
#pragma unroll
                    for (int a = 0; a < 2; ++a)
#pragma unroll
                        for (int m = 0; m < 4; ++m)
#pragma unroll
                            for (int b = 0; b < 2; ++b) { const f32x4 v0 = acc[a][b][m][0], v1 = acc[a][b][m][1];
                                u32x4 w; w.x = cvt_pk_bf16(v0[0], v0[1]); w.y = cvt_pk_bf16(v0[2], v0[3]); w.z = cvt_pk_bf16(v1[0], v1[1]); w.w = cvt_pk_bf16(v1[2], v1[3]);
                                __builtin_amdgcn_raw_buffer_store_b128(w, rs, ((a * 4 + m) * SLAB_SLOTS + cur.piece) * 16384 + b * 8192 + tid * 16, 0, 16); }
                }
                sl = cur;
            } else {
                if (!has_next && sl.piece >= 0) {
                    PG8_WAIT_V(0); PG8_BAR;
                    if (tid == 0) __hip_atomic_fetch_add(tickets + 64 * sl.lu, 1u, __ATOMIC_RELAXED, __HIP_MEMORY_SCOPE_AGENT);
                    signalled = true;
                }
                if (!dry) E(acc, cur, wr, wc, fr, fq);
            }
        } else { if (cur.piece < 0 && !dry) E(acc, cur, wr, wc, fr, fq); }
        if (!has_next) break;
#pragma unroll
        for (int a = 0; a < 2; ++a)
#pragma unroll
            for (int b = 0; b < 2; ++b)
#pragma unroll
                for (int m = 0; m < 4; ++m)
#pragma unroll
                    for (int n = 0; n < 2; ++n) acc[a][b][m][n] = (f32x4){0.f, 0.f, 0.f, 0.f};
        cur = nxt; cA = nA; cB = nB; ++ui;
        if constexpr (ALIGN_EPI) { if (wr == 1) PG8_BAR; }
    }
    PG8_WAIT_V(0);
    if constexpr (!ALIGN_EPI) { if (wr == 0) PG8_BAR; }
    PG8_BAR;
    if constexpr (Epi::SPLIT && !Epi::SLICE_FIRST) {
    if (cur.piece >= 0 && !dry) {
        unsigned char* slab0 = (unsigned char*)slabs + (size_t)cur.lu * (8 * SLAB_SLOTS * 16384);
        {
            const __amdgpu_buffer_rsrc_t rs = __builtin_amdgcn_make_buffer_rsrc((void*)slab0, (short)0, 8 * SLAB_SLOTS * 16384, 0x00020000);
#pragma unroll
            for (int a = 0; a < 2; ++a)
#pragma unroll
                for (int m = 0; m < 4; ++m) {
                    const int gq = a * 4 + m;
                    if ((gq >> 1) != cur.piece) {
#pragma unroll
                        for (int b = 0; b < 2; ++b) { const f32x4 v0 = acc[a][b][m][0], v1 = acc[a][b][m][1];
                            u32x4 w; w.x = cvt_pk_bf16(v0[0], v0[1]); w.y = cvt_pk_bf16(v0[2], v0[3]); w.z = cvt_pk_bf16(v1[0], v1[1]); w.w = cvt_pk_bf16(v1[2], v1[3]);
                            __builtin_amdgcn_raw_buffer_store_b128(w, rs, (gq * SLAB_SLOTS + cur.piece) * 16384 + b * 8192 + tid * 16, 0, 16); }
                    }
                }
        }
        asm volatile("s_waitcnt vmcnt(0)" ::: "memory");
        __syncthreads();
        const int nsl = S.split;
        if (tid == 0) {
            __hip_atomic_fetch_add(tickets + 64 * cur.lu, 1u, __ATOMIC_RELAXED, __HIP_MEMORY_SCOPE_AGENT);
            if (cur.piece < 4) {
                unsigned sp = 0;
                while (__hip_atomic_load(tickets + 64 * cur.lu, __ATOMIC_RELAXED, __HIP_MEMORY_SCOPE_AGENT) < (unsigned)nsl) { __builtin_amdgcn_s_sleep(2); if (++sp > (1u << 20)) break; }
                __builtin_amdgcn_fence(__ATOMIC_ACQUIRE, "agent"); asm volatile("s_waitcnt vmcnt(0)" ::: "memory");
            }
        }
        __syncthreads();
        if (cur.piece < 4) {
            switch (cur.piece) {
                case 0: reduce_rowgroup<0, 0, 0>(acc, slab0, tid, nsl); reduce_rowgroup<0, 0, 1>(acc, slab0, tid, nsl); break;
                case 1: reduce_rowgroup<1, 0, 2>(acc, slab0, tid, nsl); reduce_rowgroup<1, 0, 3>(acc, slab0, tid, nsl); break;
                case 2: reduce_rowgroup<2, 1, 0>(acc, slab0, tid, nsl); reduce_rowgroup<2, 1, 1>(acc, slab0, tid, nsl); break;
                default: reduce_rowgroup<3, 1, 2>(acc, slab0, tid, nsl); reduce_rowgroup<3, 1, 3>(acc, slab0, tid, nsl); break;
            }
            E(acc, cur, wr, wc, fr, fq, 3u << (2 * cur.piece));
        }
    }
    }
    if constexpr (Epi::SPLIT && Epi::SLICE_FIRST) {
    if (sl.piece >= 0 && !dry) {
        const unsigned char* slab0 = (const unsigned char*)slabs + (size_t)sl.lu * (8 * SLAB_SLOTS * 16384);
        const int nsl = S.split;
        if (tid == 0) {
            if (!signalled) __hip_atomic_fetch_add(tickets + 64 * sl.lu, 1u, __ATOMIC_RELAXED, __HIP_MEMORY_SCOPE_AGENT);
            if (sl.piece < 4) {
                unsigned sp = 0;
                while (__hip_atomic_load(tickets + 64 * sl.lu, __ATOMIC_RELAXED, __HIP_MEMORY_SCOPE_AGENT) < (unsigned)nsl) { __builtin_amdgcn_s_sleep(2); if (++sp > (1u << 20)) break; }
                __builtin_amdgcn_fence(__ATOMIC_ACQUIRE, "agent"); asm volatile("s_waitcnt vmcnt(0)" ::: "memory");
            }
        }
        __syncthreads();
        if (sl.piece < 4) {
            constexpr int NSL = Epi::NSL;
            const int A = sl.piece >> 1, Mi0 = (sl.piece & 1) * 2;
            const unsigned char* sp = slab0 + (size_t)((A * 4 + Mi0) * SLAB_SLOTS) * 16384 + tid * 16;
            u32x4 pv[2][2][NSL];
#pragma unroll
            for (int mi = 0; mi < 2; ++mi)
#pragma unroll
                for (int b = 0; b < 2; ++b)
#pragma unroll
                    for (int src = 0; src < NSL; ++src) pv[mi][b][src] = *(const u32x4*)(sp + (size_t)(mi * SLAB_SLOTS + src) * 16384 + b * 8192);
#pragma unroll
            for (int mi = 0; mi < 2; ++mi)
#pragma unroll
                for (int b = 0; b < 2; ++b) {
                    f32x4 s0 = (f32x4){0.f, 0.f, 0.f, 0.f}, s1 = s0;
#pragma unroll
                    for (int src = 0; src < NSL; ++src) { float f[8]; unpack8(pv[mi][b][src], f); s0 += (f32x4){f[0], f[1], f[2], f[3]}; s1 += (f32x4){f[4], f[5], f[6], f[7]}; }
                    acc[0][b][mi][0] = s0; acc[0][b][mi][1] = s1;
                }
            E(acc, sl, wr, wc, fr, fq, 0x3u, A * 128 + Mi0 * 16);
        }
    }
    }
#undef PG8_SA
#undef PG8_SB
#undef PG8_STAGE
#undef PG8_LDA
#undef PG8_LDB
#undef PG8_MMA
#undef PG8_WAIT_V
#undef PG8_WAIT_L
#undef PG8_BAR
#undef PG8_SCHED
}
}

typedef f32x4 Acc[2][2][4][2];

struct EpiZ {
    static constexpr bool SPLIT = false, SLICE_FIRST = false;
    const LAS float* rstab; bf16_t* z; float* out;
    __device__ __forceinline__ void operator()(const Acc& acc, const pg8::Unit& u, int wr, int wc, int fr, int fq) const {
        asm volatile("" : "+v"(fr), "+v"(fq));
        const int col0 = u.pn * 256 + wc * 32 + 8 * fq;
#pragma unroll
        for (int ai = 0; ai < 2; ++ai)
#pragma unroll
            for (int m = 0; m < 4; ++m) {
                const int r = u.pm * 256 + ai * 128 + wr * 64 + m * 16 + fr;
                if (r < M) {
                    const float rs = rstab[u.idx * 256 + ai * 128 + wr * 64 + m * 16 + fr];
                    int is_s, seq, t; row_decode(r, is_s, seq, t);
                    float* so = nullptr;
                    if (u.pn < 6) { if (is_s) { if (t >= TS - 3) so = out + O_SRC + ((size_t)seq * 3 + (t - (TS - 3))) * DA; } else { if (t >= TP - 3) so = out + O_PRC + ((size_t)seq * 3 + (t - (TP - 3))) * DA; } }
#pragma unroll
                    for (int bj = 0; bj < 2; ++bj) {
                        const f32x4 v0 = acc[ai][bj][m][0] * rs, v1 = acc[ai][bj][m][1] * rs;
                        u32x4 w; w.x = cvt_pk_bf16(v0[0], v0[1]); w.y = cvt_pk_bf16(v0[2], v0[3]); w.z = cvt_pk_bf16(v1[0], v1[1]); w.w = cvt_pk_bf16(v1[2], v1[3]);
                        *(u32x4*)(z + (size_t)r * DIN + col0 + bj * 128) = w;
                        if (so) { *(f32x4*)(so + col0 + bj * 128) = v0; *(f32x4*)(so + col0 + bj * 128 + 4) = v1; }
                    }
                }
            }
    }
};
__device__ __forceinline__ void rstd1_table(const float* rstd1, LAS float* tab, const pg8::StaticOrder& S) {
    const int tid = opaque_tid(), q = tid & 255;
    pg8::Unit u;
    for (int i = tid >> 8; S.next(i, u); i += 2) { const int r = u.pm * 256 + q; tab[i * 256 + q] = r < M ? rstd1[r] : 0.f; }
}
struct EpiX1 {
    static constexpr bool SPLIT = true, SLICE_FIRST = true; static constexpr int NSL = P4_SPLIT;
    bf16_t* xb; float* ssq;
    __device__ __forceinline__ void operator()(const Acc& acc, const pg8::Unit& u, int wr, int wc, int fr, int fq, unsigned gmask = 0xffu, int rowoff = 0) const {
        asm volatile("" : "+v"(fr), "+v"(fq));
        const int col0 = u.pn * 256 + wc * 32 + 8 * fq;
#pragma unroll
        for (int ai = 0; ai < 2; ++ai) {
            if (!((gmask >> (ai * 4)) & 0xfu)) continue;
            u32x4 xv[4][2];
#pragma unroll
            for (int m = 0; m < 4; ++m) {
                const int r = u.pm * 256 + rowoff + ai * 128 + wr * 64 + m * 16 + fr;
                const bf16_t* xr = xb + (size_t)(r < M ? r : 0) * D + col0;
#pragma unroll
                for (int bj = 0; bj < 2; ++bj) xv[m][bj] = *(const u32x4*)(xr + bj * 128);
            }
#pragma unroll
            for (int m = 0; m < 4; ++m) {
                if (!((gmask >> (ai * 4 + m)) & 1u)) continue;
                const int r = u.pm * 256 + rowoff + ai * 128 + wr * 64 + m * 16 + fr;
                const bool valid = r < M;
                float ss = 0.f;
#pragma unroll
                for (int bj = 0; bj < 2; ++bj) {
                    float xf[8]; unpack8(xv[m][bj], xf);
                    const f32x4 a0 = acc[ai][bj][m][0], a1 = acc[ai][bj][m][1];
                    const f32x4 v0 = (f32x4){a0[0] + xf[0], a0[1] + xf[1], a0[2] + xf[2], a0[3] + xf[3]}, v1 = (f32x4){a1[0] + xf[4], a1[1] + xf[5], a1[2] + xf[6], a1[3] + xf[7]};
                    ss += (v0[0] * v0[0] + v0[1] * v0[1]) + (v0[2] * v0[2] + v0[3] * v0[3]) + (v1[0] * v1[0] + v1[1] * v1[1]) + (v1[2] * v1[2] + v1[3] * v1[3]);
                    if (valid) { u32x4 w; w.x = cvt_pk_bf16(v0[0], v0[1]); w.y = cvt_pk_bf16(v0[2], v0[3]); w.z = cvt_pk_bf16(v1[0], v1[1]); w.w = cvt_pk_bf16(v1[2], v1[3]);
                        *(u32x4*)(xb + (size_t)r * D + col0 + bj * 128) = w; }
                }
                ss += __shfl_xor(ss, 16); ss += __shfl_xor(ss, 32);
                if (valid && fq == 0) ssq[(size_t)r * 32 + u.pn * 4 + wc] = ss;
            }
        }
    }
};
struct EpiOut {
    static constexpr bool SPLIT = true, SLICE_FIRST = false; static constexpr int NSL = P6_SPLIT;
    const bf16_t* x1b; bf16_t* x2b;
    __device__ __forceinline__ void operator()(const Acc& acc, const pg8::Unit& u, int wr, int wc, int fr, int fq, unsigned gmask = 0xffu, int rowoff = 0) const {
        asm volatile("" : "+v"(fr), "+v"(fq));
        const int col0 = u.pn * 256 + wc * 32 + 8 * fq;
        u32x4 xva[2][4][2];
#pragma unroll
        for (int ai = 0; ai < 2; ++ai) {
            if (!((gmask >> (ai * 4)) & 0xfu)) continue;
#pragma unroll
            for (int m = 0; m < 4; ++m) {
                const int r = u.pm * 256 + rowoff + ai * 128 + wr * 64 + m * 16 + fr;
                const bf16_t* xr = x1b + (size_t)(r < M ? r : 0) * D + col0;
#pragma unroll
                for (int bj = 0; bj < 2; ++bj) xva[ai][m][bj] = *(const u32x4*)(xr + bj * 128);
            }
        }
#pragma unroll
        for (int ai = 0; ai < 2; ++ai) {
            if (!((gmask >> (ai * 4)) & 0xfu)) continue;
            u32x4 (&xv)[4][2] = xva[ai];
#pragma unroll
            for (int m = 0; m < 4; ++m) {
                if (!((gmask >> (ai * 4 + m)) & 1u)) continue;
                const int r = u.pm * 256 + rowoff + ai * 128 + wr * 64 + m * 16 + fr;
                if (r < M) {
#pragma unroll
                    for (int bj = 0; bj < 2; ++bj) {
                        float xf[8]; unpack8(xv[m][bj], xf);
                        const f32x4 a0 = acc[ai][bj][m][0], a1 = acc[ai][bj][m][1];
                        u32x4 w; w.x = cvt_pk_bf16(a0[0] + xf[0], a0[1] + xf[1]); w.y = cvt_pk_bf16(a0[2] + xf[2], a0[3] + xf[3]); w.z = cvt_pk_bf16(a1[0] + xf[4], a1[1] + xf[5]); w.w = cvt_pk_bf16(a1[2] + xf[6], a1[3] + xf[7]);
                        *(u32x4*)(x2b + (size_t)r * D + col0 + bj * 128) = w;
                    }
                }
            }
        }
    }
};
struct EpiFFN {
    static constexpr bool SPLIT = false, SLICE_FIRST = false;
    const float* st_fc; bf16_t* hid; float* out; const LAS float* rstab; const LAS float* wtab;
    template <bool PLAIN>
    __device__ __forceinline__ void body(Acc& acc, const pg8::Unit& u, int wr, int wc, int fr, int fq, int gbase, int f0,
                                         const f32x4 (&wv)[4][2]) const {
#pragma unroll
        for (int ai = 0; ai < 2; ++ai) {
            f32x4 s3[2], s2[2];
#pragma unroll
            for (int n = 0; n < 2; ++n)
#pragma unroll
                for (int e = 0; e < 4; ++e) {
                    const float o3 = ai == 0 ? 0.f : dppf<0x121>(0.f, acc[0][0][3][n][e]), o2 = ai == 0 ? 0.f : dppf<0x121>(0.f, acc[0][0][2][n][e]);
                    s3[n][e] = dppf<0x111>(o3, acc[ai][0][3][n][e]); s2[n][e] = dppf<0x111>(o2, acc[ai][0][2][n][e]);
                }
#pragma unroll
            for (int m = 0; m < 4; ++m) {
                const int j = 64 * ai + 4 * fr + m, r = gbase + j;
                const f32x4 c0 = acc[ai][0][m][0], c1 = acc[ai][0][m][1];
                f32x4 p1a = m == 0 ? s3[0] : acc[ai][0][m == 0 ? 0 : m - 1][0], p1b = m == 0 ? s3[1] : acc[ai][0][m == 0 ? 0 : m - 1][1];
                f32x4 p2a = m == 0 ? s2[0] : (m == 1 ? s3[0] : acc[ai][0][m < 2 ? 0 : m - 2][0]), p2b = m == 0 ? s2[1] : (m == 1 ? s3[1] : acc[ai][0][m < 2 ? 0 : m - 2][1]);
                bool valid = j >= 2;
                int is_s = 0, seq = 0, t = 2;
                if constexpr (!PLAIN) {
                    valid = valid && (r < M);
                    row_decode(valid ? r : 0, is_s, seq, t);
                    if (valid && t < 2) {
                        f32x4 s0a = (f32x4){0.f, 0.f, 0.f, 0.f}, s0b = s0a, s1a = s0a, s1b = s0a;
                        if (is_s) { const float* sp = st_fc + (size_t)seq * 2 * DFF + f0; s0a = *(const f32x4*)sp; s0b = *(const f32x4*)(sp + 4); s1a = *(const f32x4*)(sp + DFF); s1b = *(const f32x4*)(sp + DFF + 4); }
                        if (t == 0) { p1a = s1a; p1b = s1b; p2a = s0a; p2b = s0b; } else { p2a = s1a; p2b = s1b; }
                    }
                }
                const f32x4 ga = wv[0][0] * p2a + (wv[1][0] * p1a + (wv[2][0] * c0 + wv[3][0])), gb = wv[0][1] * p2b + (wv[1][1] * p1b + (wv[2][1] * c1 + wv[3][1]));
                const f32x4 va = acc[ai][1][m][0], vb = acc[ai][1][m][1];
                if (valid) {
                    u32x4 w;
                    const f32x2 h0 = gelu_mul2((f32x2){ga[0], ga[1]}, (f32x2){va[0], va[1]}), h1 = gelu_mul2((f32x2){ga[2], ga[3]}, (f32x2){va[2], va[3]});
                    const f32x2 h2 = gelu_mul2((f32x2){gb[0], gb[1]}, (f32x2){vb[0], vb[1]}), h3 = gelu_mul2((f32x2){gb[2], gb[3]}, (f32x2){vb[2], vb[3]});
                    w.x = cvt_pk_bf16(h0.x, h0.y); w.y = cvt_pk_bf16(h1.x, h1.y); w.z = cvt_pk_bf16(h2.x, h2.y); w.w = cvt_pk_bf16(h3.x, h3.y);
                    *(u32x4*)(hid + (size_t)r * DFF + f0) = w;
                    if constexpr (!PLAIN) {
                        const int T = is_s ? TS : TP;
                        if (t >= T - 2) { float* so = out + (is_s ? O_SFC : O_PFC) + ((size_t)seq * 2 + (t - (T - 2))) * DFF + f0; *(f32x4*)so = c0; *(f32x4*)(so + 4) = c1; }
                    }
                }
            }
            __builtin_amdgcn_sched_barrier(0);
        }
    }
    __device__ __forceinline__ void operator()(Acc& acc, const pg8::Unit& u, int wr, int wc, int fr, int fq) const {
        asm volatile("" : "+v"(fr), "+v"(fq));
        const int gbase = 252 * u.pm - 2 + 126 * wr;
        const int f0 = 128 * u.pn + 32 * wc + 8 * fq;
        const LAS float* wt = wtab + u.idx * 512 + 32 * wc + 8 * fq;
        f32x4 wv[4][2];
#pragma unroll
        for (int k = 0; k < 4; ++k) { wv[k][0] = *(const LAS f32x4*)(wt + 128 * k); wv[k][1] = *(const LAS f32x4*)(wt + 128 * k + 4); }
        const LAS float* rt = rstab + u.idx * 256 + wr * 128 + 4 * fr;
#pragma unroll
        for (int ai = 0; ai < 2; ++ai) {
            const f32x4 rs4 = *(const LAS f32x4*)(rt + 64 * ai);
#pragma unroll
            for (int m = 0; m < 4; ++m)
#pragma unroll
                for (int bj = 0; bj < 2; ++bj)
#pragma unroll
                    for (int n = 0; n < 2; ++n) acc[ai][bj][m][n] *= rs4[m];
        }
        const int lo = gbase, hi = gbase + 127;
        bool plain = hi < MPR && lo >= 0;
#pragma unroll
        for (int b2 = 0; b2 < NB; ++b2) { const int s0 = b2 * TP; if (lo <= s0 + 1 && hi >= s0) plain = false; if (lo <= s0 + TP - 1 && hi >= s0 + TP - 2) plain = false; }
        if (plain) body<true>(acc, u, wr, wc, fr, fq, gbase, f0, wv); else body<false>(acc, u, wr, wc, fr, fq, gbase, f0, wv);
    }
};
__device__ __forceinline__ void ffn_rstd_table(const float* ssq, const float* cw, const float* cb, LAS float* tab, LAS float* wtab, const pg8::StaticOrder& S) {
    const int tid = opaque_tid(), q = tid >> 1, half = tid & 1;
    pg8::Unit u;
    for (int i = 0; S.next(i, u); ++i) {
        { const int k = tid >> 7, c = tid & 127, f = 128 * u.pn + c; wtab[i * 512 + tid] = k < 3 ? cw[k * DFF + f] : cb[f]; }
        int r = 252 * u.pm - 2 + 126 * (q >> 7) + (q & 127); r = r < 0 ? 0 : (r >= M ? M - 1 : r);
        const float* sp = ssq + (size_t)r * 32 + 16 * half;
        const f32x4 a = *(const f32x4*)sp, b = *(const f32x4*)(sp + 4), c = *(const f32x4*)(sp + 8), d = *(const f32x4*)(sp + 12);
        float sm = (((a[0] + a[1]) + (a[2] + a[3])) + ((b[0] + b[1]) + (b[2] + b[3]))) + (((c[0] + c[1]) + (c[2] + c[3])) + ((d[0] + d[1]) + (d[2] + d[3])));
        sm += __shfl_xor(sm, 1);
        if (half == 0) tab[i * 256 + q] = __builtin_amdgcn_rsqf(sm * (1.0f / D) + EPS);
    }
}

struct ChunkQueue {
    unsigned* head; volatile LAS int* slot; int nchunks; unsigned nxt;
    __device__ __forceinline__ void start(int tid) { if (tid == 0) nxt = __hip_atomic_fetch_add(head, 1u, __ATOMIC_RELAXED, __HIP_MEMORY_SCOPE_AGENT); }
    __device__ __forceinline__ int pull(int tid) {
        __syncthreads();
        if (tid == 0) { slot[0] = (int)nxt; if ((int)nxt < nchunks) nxt = __hip_atomic_fetch_add(head, 1u, __ATOMIC_RELAXED, __HIP_MEMORY_SCOPE_AGENT); }
        __syncthreads();
        const int q = slot[0];
        return q < nchunks ? q : -1;
    }
};
__device__ __forceinline__ int invperm32(int q) { return 16 * ((q >> 2) & 1) + 4 * (q >> 3) + (q & 3); }
__device__ __forceinline__ void p0_transpose_item(const float* W, int K, int N, const float* kscale, bf16_t* WT, int mode, LAS float* scr, int item, int lane, bool tiled) {
    const int nblk = N / 32, kb = item / nblk, nb = item % nblk, k0 = 64 * kb, n0 = 32 * nb;
    float v[32];
    const float* src = W + (size_t)(k0 + (lane >> 5)) * N + n0 + (lane & 31);
#pragma unroll
    for (int i = 0; i < 32; ++i) v[i] = __builtin_nontemporal_load(src + (size_t)(2 * i) * N);
#pragma unroll
    for (int i = 0; i < 32; ++i) scr[(2 * i + (lane >> 5)) * 33 + (lane & 31)] = v[i];
    asm volatile("s_waitcnt lgkmcnt(0)" ::: "memory");
    int rbase = n0;
    if (mode == 1) { const int bj = n0 >= DFF ? 1 : 0, f = n0 - bj * DFF; rbase = 256 * (f >> 7) + 128 * bj + (f & 96); }
    const int c = lane & 7;
    f32x4 ks0 = (f32x4){1.f, 1.f, 1.f, 1.f}, ks1 = ks0;
    if (kscale) { ks0 = *(const f32x4*)(kscale + k0 + 8 * c); ks1 = *(const f32x4*)(kscale + k0 + 8 * c + 4); }
#pragma unroll
    for (int j = 0; j < 4; ++j) { const int n = (lane >> 3) + 8 * j; const LAS float* sp = scr + (8 * c) * 33 + n;
        u32x4 o; o.x = cvt_pk_bf16(sp[0 * 33] * ks0[0], sp[1 * 33] * ks0[1]); o.y = cvt_pk_bf16(sp[2 * 33] * ks0[2], sp[3 * 33] * ks0[3]);
        o.z = cvt_pk_bf16(sp[4 * 33] * ks1[0], sp[5 * 33] * ks1[1]); o.w = cvt_pk_bf16(sp[6 * 33] * ks1[2], sp[7 * 33] * ks1[3]);
        const int row = rbase + (mode == 2 ? n : invperm32(n));
        const size_t off = tiled ? (((size_t)(row >> 8) * (K / 64) + kb) * 256 + (row & 255)) * 64 + 8 * c : (size_t)row * K + k0 + 8 * c;
        *(u32x4*)(WT + off) = o; }
    asm volatile("s_waitcnt lgkmcnt(0)" ::: "memory");
}
constexpr int I_IN = (D / 64) * (DIN / 32), I_O = (DMIX / 64) * (D / 32), I_UP = (D / 64) * (2 * DFF / 32), I_DN = (DFF / 64) * (D / 32), I_G = 2 * NH * 8;
constexpr int IT_O = I_IN, IT_UP = IT_O + I_O, IT_DN = IT_UP + I_UP, IT_G = IT_DN + I_DN, IT_END = IT_G + I_G;
__device__ __forceinline__ void convert_items(PRef p, LAS unsigned char* lds, int rank, int nwaves, int lo, int hi) {
    const int tid_ = opaque_tid(), lane = tid_ & 63, wave = tid_ >> 6;
    unsigned char* ws = p.ws;
    LAS float* scr = (LAS float*)(lds + wave * 16384);
    for (int it = lo + rank; it < hi; it += nwaves) {
        int r = it;
        if (r < I_IN) { p0_transpose_item(p.w_in, D, DIN, p.g_mix, (bf16_t*)(ws + WS_WIN), 0, scr, r, lane, true); continue; } r -= I_IN;
        if (r < I_O) { p0_transpose_item(p.w_o, DMIX, D, nullptr, (bf16_t*)(ws + WS_WO), 0, scr, r, lane, true); continue; } r -= I_O;
        if (r < I_UP) { p0_transpose_item(p.w_up, D, 2 * DFF, p.g_ffn, (bf16_t*)(ws + WS_WUP), 1, scr, r, lane, true); continue; } r -= I_UP;
        if (r < I_DN) { p0_transpose_item(p.w_down, DFF, D, nullptr, (bf16_t*)(ws + WS_WDN), 0, scr, r, lane, true); continue; } r -= I_DN;
        { const int mat = r >> 3, sub = r & 7, gsel = mat / NH, n = mat % NH;
          p0_transpose_item((gsel ? p.w_gate_x : p.w_gate_a) + (size_t)n * 128 * 128, 128, 128, nullptr, (bf16_t*)(ws + WS_WG) + (size_t)mat * 128 * 128, 0, scr, sub, lane, false); }
    }
}
constexpr int P1_TAIL_WG0 = (888 % 256), P4_TAIL_WG0 = (296 % 256) * P4_SPLIT, IT_S1 = IT_O + 12000, IT_S2 = IT_S1 + 300, IT_S3 = IT_S2 + 3400, IT_S4 = IT_G - 2000, P5_IDLE_WG0 = (37 * 48) % 256;
__device__ __forceinline__ void phase0(PRef p, LAS unsigned char* lds, int G) {
    const int tid = opaque_tid(), lane = tid & 63, wave = tid >> 6;
    unsigned char* ws = p.ws;
    const int gw = blockIdx.x * 8 + wave, NGW = G * 8;
    constexpr int P0_CSTATIC = 2 * GRID * 8, P0_CCH = (IT_O - P0_CSTATIC) / 8, P0_GCH = (IT_END - IT_G) / 8;
    static_assert(P0_CSTATIC + 8 * P0_CCH == IT_O && 8 * P0_GCH == IT_END - IT_G, "P0 conversion chunks");
    convert_items(p, lds, gw, NGW, 0, P0_CSTATIC);
    { bf16_t* xb = (bf16_t*)(ws + WS_XB) + (size_t)16 * D; float* rstd1 = (float*)(ws + WS_RS1);
      constexpr int P0_STATIC = 2 * GRID * 8, P0_NCH = (M - P0_STATIC) / 8;
      static_assert(P0_STATIC + 8 * P0_NCH == M, "P0 tail chunks");
      ChunkQueue Q{(unsigned*)ws + CW_Q0, (volatile LAS int*)(lds + 131072 + 64), P0_CCH + P0_GCH + P0_NCH, 0u};
      Q.start(tid);
      int m = gw, k_ = 0;
      for (;;) {
          if (m < 0) break;
          {
          const f32x4* xr = (const f32x4*)x_row_ptr(p.x_prompt, p.x_sample, p.meta, m) + lane;
          f32x4 v[8]; float s = 0.f;
#pragma unroll
          for (int j = 0; j < 8; ++j) { v[j] = __builtin_nontemporal_load(xr + 64 * j); s += (v[j][0] * v[j][0] + v[j][1] * v[j][1]) + (v[j][2] * v[j][2] + v[j][3] * v[j][3]); }
          s = wave_sum(s);
          if (lane == 0) rstd1[m] = __builtin_amdgcn_rsqf(s * (1.0f / D) + EPS);
          u32x2* o = (u32x2*)(xb + (size_t)m * D) + lane;
#pragma unroll
          for (int j = 0; j < 8; ++j) { u32x2 w; w.x = cvt_pk_bf16(v[j][0], v[j][1]); w.y = cvt_pk_bf16(v[j][2], v[j][3]); o[64 * j] = w; }
          }
          if (++k_ < 2) m += NGW;
          else {
              int q;
              while ((q = Q.pull(tid)) >= 0 && q < P0_CCH + P0_GCH) {
                  const int it = q < P0_CCH ? P0_CSTATIC + 8 * q + wave : IT_G + 8 * (q - P0_CCH) + wave;
                  convert_items(p, lds, 0, 1, it, it + 1);
              }
              m = q < 0 ? -1 : P0_STATIC + 8 * (q - P0_CCH - P0_GCH) + wave;
          }
      } }
}

__device__ __forceinline__ void branch_b(PRef p, int G) {
    const bf16_t* z = (const bf16_t*)(p.ws + WS_Z); bf16_t* ym = (bf16_t*)(p.ws + WS_YM);
    constexpr int total = (M / 4) * 128, NCHUNK = total / 64, PER_HEAD = NCHUNK / 8;
    static_assert(PER_HEAD * 8 * 64 == total, "branch_b chunks");
    const int lane_ = opaque_tid() & 63, qh_ = (int)blockIdx.x & 7;
    unsigned* head_ = (unsigned*)p.ws + CW_QB + 64 * qh_;
    unsigned nxt_ = 0; if (lane_ == 0) nxt_ = __hip_atomic_fetch_add(head_, 1u, __ATOMIC_RELAXED, __HIP_MEMORY_SCOPE_AGENT);
    for (;;) {
        const int cur_ = __builtin_amdgcn_readfirstlane((int)nxt_);
        if (cur_ >= PER_HEAD) break;
        if (lane_ == 0) nxt_ = __hip_atomic_fetch_add(head_, 1u, __ATOMIC_RELAXED, __HIP_MEMORY_SCOPE_AGENT);
        const int idx = (qh_ * PER_HEAD + cur_) * 64 + lane_;
        const int m0 = (idx >> 7) * 4, g = idx & 127, ch = 8 * g;
        int is_s, seq, t0; row_decode(m0, is_s, seq, t0);
        u32x4 rc[6], rv[6], rg[4];
#pragma unroll
        for (int k = 0; k < 6; ++k) {
            const int mm = (t0 - 2 + k >= 0) ? m0 - 2 + k : m0;
            rc[k] = *(const u32x4*)(z + (size_t)mm * DIN + 4096 + ch); rv[k] = *(const u32x4*)(z + (size_t)mm * DIN + 5120 + ch);
        }
#pragma unroll
        for (int k = 0; k < 4; ++k) rg[k] = *(const u32x4*)(z + (size_t)(m0 + k) * DIN + 3072 + ch);
        const f32x4 w0a = *(const f32x4*)(p.conv_b_w + ch), w0b = *(const f32x4*)(p.conv_b_w + ch + 4), w1a = *(const f32x4*)(p.conv_b_w + DB + ch), w1b = *(const f32x4*)(p.conv_b_w + DB + ch + 4),
                    w2a = *(const f32x4*)(p.conv_b_w + 2 * DB + ch), w2b = *(const f32x4*)(p.conv_b_w + 2 * DB + ch + 4), goa = *(const f32x4*)(p.g_out_b + ch), gob = *(const f32x4*)(p.g_out_b + ch + 4);
        float u[6][8];
#pragma unroll
        for (int k = 0; k < 6; ++k) {
            float a[8], b[8]; unpack8(rc[k], a); unpack8(rv[k], b);
#pragma unroll
            for (int e = 0; e < 8; ++e) u[k][e] = a[e] * b[e];
        }
        if (t0 == 0) {
#pragma unroll
            for (int k = 0; k < 2; ++k) {
                f32x4 a = (f32x4){0.f, 0.f, 0.f, 0.f}, b = a;
                if (is_s) { const float* sp = p.st_sc + ((size_t)seq * 2 + k) * DB + ch; a = *(const f32x4*)sp; b = *(const f32x4*)(sp + 4); }
#pragma unroll
                for (int e = 0; e < 4; ++e) { u[k][e] = a[e]; u[k][4 + e] = b[e]; }
            }
        }
        const int T = is_s ? TS : TP;
#pragma unroll
        for (int k = 0; k < 4; ++k) {
            float gb[8]; unpack8(rg[k], gb);
            float y[8]; float ss = 0.f;
#pragma unroll
            for (int e = 0; e < 8; ++e) {
                const float uc = (e < 4 ? w0a[e & 3] : w0b[e & 3]) * u[k][e] + (e < 4 ? w1a[e & 3] : w1b[e & 3]) * u[k + 1][e] + (e < 4 ? w2a[e & 3] : w2b[e & 3]) * u[k + 2][e];
                y[e] = gb[e] * uc; ss += y[e] * y[e];
            }
            ss = sum16(ss);
            const float rn = __builtin_amdgcn_rsqf(ss * (1.0f / 128.0f) + EPS);
#pragma unroll
            for (int e = 0; e < 8; ++e) y[e] = y[e] * rn * (e < 4 ? goa[e & 3] : gob[e & 3]);
            *(u32x4*)(ym + (size_t)(m0 + k) * DMIX + DA + ch) = pack8(y);
            const int t = t0 + k;
            if (t >= T - 2) { float* so = p.out + (is_s ? O_SSC : O_PSC) + ((size_t)seq * 2 + (t - (T - 2))) * DB + ch;
                *(f32x4*)so = (f32x4){u[k + 2][0], u[k + 2][1], u[k + 2][2], u[k + 2][3]}; *(f32x4*)(so + 4) = (f32x4){u[k + 2][4], u[k + 2][5], u[k + 2][6], u[k + 2][7]}; }
        }
    }
}

constexpr int LW_STRIDE = 272, L_WA = 0, L_WX = 128 * LW_STRIDE, L_CT = 2 * 128 * LW_STRIDE, L_LRU_END = L_CT + 9 * 128 * 4;
static_assert(L_LRU_END <= 131072, "mixer LDS");
constexpr int LRU_WG_PER_HEAD = 21, LRU_NSEG = 33, LRU_PITEMS = NB * LRU_NSEG, LRU_SBLK = 2, LRU_SITEMS = MSR / (16 * LRU_SBLK);
constexpr int LRU_IDLE_J0 = (LRU_PITEMS + 7) / 8;
static_assert(LRU_WG_PER_HEAD * 8 >= LRU_PITEMS + LRU_SITEMS, "waves per head");

template <int CTRL, int BANK> __device__ __forceinline__ float dppfb(float old, float src) {
    return __builtin_bit_cast(float, __builtin_amdgcn_update_dpp(__builtin_bit_cast(int, old), __builtin_bit_cast(int, src), CTRL, 0xF, BANK, false));
}
__device__ __forceinline__ float bcast15(float x, int lane) {
    return __builtin_bit_cast(float, __builtin_amdgcn_ds_bpermute(((lane & 48) | 15) << 2, __builtin_bit_cast(int, x)));
}
__device__ __forceinline__ void scan16(float& P, float& S) {
    float Sd, Pd;
    Sd = dppf<0x111>(0.f, S); Pd = dppf<0x111>(1.f, P); S = __builtin_fmaf(P, Sd, S); P *= Pd;
    Sd = dppf<0x112>(0.f, S); Pd = dppf<0x112>(1.f, P); S = __builtin_fmaf(P, Sd, S); P *= Pd;
    Sd = dppf<0x114>(0.f, S); Pd = dppf<0x114>(1.f, P); S = __builtin_fmaf(P, Sd, S); P *= Pd;
    Sd = dppf<0x118>(0.f, S); Pd = dppf<0x118>(1.f, P); S = __builtin_fmaf(P, Sd, S); P *= Pd;
}
__device__ __forceinline__ void scan16x2(float& P1, float& S1, float& P2, float& S2) {
    asm volatile(
        "s_nop 1\n\t"
        "v_fmac_f32_dpp %1, %1, %0 row_shr:1 row_mask:0xf bank_mask:0xf bound_ctrl:1\n\t"
        "v_fmac_f32_dpp %3, %3, %2 row_shr:1 row_mask:0xf bank_mask:0xf bound_ctrl:1\n\t"
        "v_mul_f32_dpp %0, %0, %0 row_shr:1 row_mask:0xf bank_mask:0xf\n\t"
        "v_mul_f32_dpp %2, %2, %2 row_shr:1 row_mask:0xf bank_mask:0xf\n\t"
        "v_fmac_f32_dpp %1, %1, %0 row_shr:2 row_mask:0xf bank_mask:0xf bound_ctrl:1\n\t"
        "v_fmac_f32_dpp %3, %3, %2 row_shr:2 row_mask:0xf bank_mask:0xf bound_ctrl:1\n\t"
        "v_mul_f32_dpp %0, %0, %0 row_shr:2 row_mask:0xf bank_mask:0xf\n\t"
        "v_mul_f32_dpp %2, %2, %2 row_shr:2 row_mask:0xf bank_mask:0xf\n\t"
        "v_fmac_f32_dpp %1, %1, %0 row_shr:4 row_mask:0xf bank_mask:0xf bound_ctrl:1\n\t"
        "v_fmac_f32_dpp %3, %3, %2 row_shr:4 row_mask:0xf bank_mask:0xf bound_ctrl:1\n\t"
        "v_mul_f32_dpp %0, %0, %0 row_shr:4 row_mask:0xf bank_mask:0xf\n\t"
        "v_mul_f32_dpp %2, %2, %2 row_shr:4 row_mask:0xf bank_mask:0xf\n\t"
        "v_fmac_f32_dpp %1, %1, %0 row_shr:8 row_mask:0xf bank_mask:0xf bound_ctrl:1\n\t"
        "v_fmac_f32_dpp %3, %3, %2 row_shr:8 row_mask:0xf bank_mask:0xf bound_ctrl:1\n\t"
        "v_mul_f32_dpp %0, %0, %0 row_shr:8 row_mask:0xf bank_mask:0xf\n\t"
        "v_mul_f32_dpp %2, %2, %2 row_shr:8 row_mask:0xf bank_mask:0xf\n\t"
        "s_nop 0"
        : "+v"(P1), "+v"(S1), "+v"(P2), "+v"(S2));
}
__device__ __forceinline__ void scan8(float& P, float& S, int t) {
    float Sd, Pd;
    Sd = dppf<0x111>(0.f, S); Pd = dppf<0x111>(1.f, P); if (t < 1) { Sd = 0.f; Pd = 1.f; } S = __builtin_fmaf(P, Sd, S); P *= Pd;
    Sd = dppf<0x112>(0.f, S); Pd = dppf<0x112>(1.f, P); if (t < 2) { Sd = 0.f; Pd = 1.f; } S = __builtin_fmaf(P, Sd, S); P *= Pd;
    Sd = dppfb<0x114, 0xA>(0.f, S); Pd = dppfb<0x114, 0xA>(1.f, P); S = __builtin_fmaf(P, Sd, S); P *= Pd;
}

template <int PASS, bool IS_S>
__device__ __forceinline__ void lru_wave_item(PRef p, LAS unsigned char* lds, int n, int b, int seg) {
    const int lane = opaque_tid() & 63, fr = lane & 15, fq = lane >> 4;
    const bf16_t* z = (const bf16_t*)(p.ws + WS_Z);
    bf16_t* ym = (bf16_t*)(p.ws + WS_YM);
    float* tot = (float*)(p.ws + WS_TOT);
    const LAS float* CT = (const LAS float*)(lds + L_CT) + 8 * fq;
    const int gch = n * 128 + 8 * fq;
    const int r0 = IS_S ? MPR + b * (16 * LRU_SBLK) : b * TP + seg * 64;
    const int nblk = IS_S ? LRU_SBLK : (seg == LRU_NSEG - 1 ? 1 : 4);
    float hin[4][8], Pt[4][8];
    u32x4 prevx[4];
#pragma unroll
    for (int ks = 0; ks < 4; ++ks) {
#pragma unroll
        for (int e = 0; e < 8; ++e) { hin[ks][e] = 0.f; Pt[ks][e] = 1.f; }
        prevx[ks] = (u32x4){0u, 0u, 0u, 0u};
    }
    if constexpr (!IS_S) {
        if (seg > 0) {
#pragma unroll
            for (int ks = 0; ks < 4; ++ks) prevx[ks] = *(const u32x4*)(z + (size_t)(r0 - 16 + fr) * DIN + gch + 32 * ks);
            if constexpr (PASS == 2) {
#pragma unroll 1
                for (int round = 0; round < 2; ++round) {
                    const int s = 16 * round + fr;
                    if (16 * round >= seg) break;
                    const bool have = s < seg;
                    const float* tp = tot + ((size_t)(b * LRU_NSEG + (have ? s : 0)) * 2) * DA + gch;
#pragma unroll
                    for (int ks = 0; ks < 4; ++ks) {
                        const f32x4 P0 = *(const f32x4*)(tp + 32 * ks), P1 = *(const f32x4*)(tp + 32 * ks + 4), S0 = *(const f32x4*)(tp + DA + 32 * ks), S1 = *(const f32x4*)(tp + DA + 32 * ks + 4);
#pragma unroll
                        for (int e = 0; e < 8; e += 2) {
                            float Pa = have ? (e < 4 ? P0[e & 3] : P1[e & 3]) : 1.f, Sa = have ? (e < 4 ? S0[e & 3] : S1[e & 3]) : 0.f;
                            float Pb = have ? (e < 4 ? P0[(e + 1) & 3] : P1[(e + 1) & 3]) : 1.f, Sb = have ? (e < 4 ? S0[(e + 1) & 3] : S1[(e + 1) & 3]) : 0.f;
                            scan16x2(Pa, Sa, Pb, Sb);
                            hin[ks][e] = __builtin_fmaf(bcast15(Pa, lane), hin[ks][e], bcast15(Sa, lane));
                            hin[ks][e + 1] = __builtin_fmaf(bcast15(Pb, lane), hin[ks][e + 1], bcast15(Sb, lane));
                        }
                    }
                }
            }
        }
    }
    u32x4 xnext[4];
    if constexpr (!IS_S) {
#pragma unroll
        for (int ks = 0; ks < 4; ++ks) xnext[ks] = *(const u32x4*)(z + (size_t)(r0 + fr) * DIN + gch + 32 * ks);
    }
#pragma unroll 1
    for (int blk = 0; blk < nblk; ++blk) {
        const int r = r0 + 16 * blk + fr;
        const int t8 = fr & 7, sq = (r - MPR) >> 3;
        u32x4 x4[4], g4[4];
#pragma unroll
        for (int ks = 0; ks < 4; ++ks) { if constexpr (IS_S) x4[ks] = *(const u32x4*)(z + (size_t)r * DIN + gch + 32 * ks); else x4[ks] = xnext[ks];
            if constexpr (PASS == 2) g4[ks] = *(const u32x4*)(z + (size_t)r * DIN + DA + gch + 32 * ks); }
        if constexpr (!IS_S) { const int rn_ = (blk + 1 < nblk) ? r + 16 : r;
#pragma unroll
          for (int ks = 0; ks < 4; ++ks) xnext[ks] = *(const u32x4*)(z + (size_t)rn_ * DIN + gch + 32 * ks); }
        float xc[4][8];
        bf16x8 bfrag[4];
#pragma unroll
        for (int ks = 0; ks < 4; ++ks) {
            float xf[8]; unpack8(x4[ks], xf);
            const f32x4 w0a = *(const LAS f32x4*)(CT + 0 * 128 + 32 * ks), w0b = *(const LAS f32x4*)(CT + 0 * 128 + 32 * ks + 4);
            const f32x4 w1a = *(const LAS f32x4*)(CT + 1 * 128 + 32 * ks), w1b = *(const LAS f32x4*)(CT + 1 * 128 + 32 * ks + 4);
            const f32x4 w2a = *(const LAS f32x4*)(CT + 2 * 128 + 32 * ks), w2b = *(const LAS f32x4*)(CT + 2 * 128 + 32 * ks + 4);
            const f32x4 w3a = *(const LAS f32x4*)(CT + 3 * 128 + 32 * ks), w3b = *(const LAS f32x4*)(CT + 3 * 128 + 32 * ks + 4);
            const f32x4 cba = *(const LAS f32x4*)(CT + 4 * 128 + 32 * ks), cbb = *(const LAS f32x4*)(CT + 4 * 128 + 32 * ks + 4);
            if constexpr (IS_S) {
                const float* sp = p.st_rc + (size_t)sq * 3 * DA + gch + 32 * ks;
                const f32x4 b0a = *(const f32x4*)sp, b0b = *(const f32x4*)(sp + 4), b1a = *(const f32x4*)(sp + DA), b1b = *(const f32x4*)(sp + DA + 4), b2a = *(const f32x4*)(sp + 2 * DA), b2b = *(const f32x4*)(sp + 2 * DA + 4);
#pragma unroll
                for (int e = 0; e < 8; ++e) {
                    const float bb0 = e < 4 ? b0a[e & 3] : b0b[e & 3], bb1 = e < 4 ? b1a[e & 3] : b1b[e & 3], bb2 = e < 4 ? b2a[e & 3] : b2b[e & 3];
                    const float s1 = dppf<0x111>(0.f, xf[e]), s2 = dppf<0x112>(0.f, xf[e]), s3 = dppf<0x113>(0.f, xf[e]);
                    const float x1 = t8 >= 1 ? s1 : bb2;
                    const float x2 = t8 >= 2 ? s2 : (t8 == 1 ? bb2 : bb1);
                    const float x3 = t8 >= 3 ? s3 : (t8 == 2 ? bb2 : (t8 == 1 ? bb1 : bb0));
                    const float w0 = e < 4 ? w0a[e & 3] : w0b[e & 3], w1 = e < 4 ? w1a[e & 3] : w1b[e & 3], w2 = e < 4 ? w2a[e & 3] : w2b[e & 3], w3 = e < 4 ? w3a[e & 3] : w3b[e & 3];
                    xc[ks][e] = (e < 4 ? cba[e & 3] : cbb[e & 3]) + w3 * xf[e] + w2 * x1 + w1 * x2 + w0 * x3;
                }
            } else {
                float pf[8]; unpack8(prevx[ks], pf);
#pragma unroll
                for (int e = 0; e < 8; e += 2) {
                    f32x2 x0, x1, x2, x3;
#pragma unroll
                    for (int q = 0; q < 2; ++q) {
                        x0[q] = xf[e + q];
                        x1[q] = dppf<0x111>(dppf<0x121>(0.f, pf[e + q]), xf[e + q]);
                        x2[q] = dppf<0x112>(dppf<0x122>(0.f, pf[e + q]), xf[e + q]);
                        x3[q] = dppf<0x113>(dppf<0x123>(0.f, pf[e + q]), xf[e + q]);
                    }
                    const int c = e & 3;
                    const f32x2 w0 = e < 4 ? (f32x2){w0a[c], w0a[c + 1]} : (f32x2){w0b[c], w0b[c + 1]}, w1 = e < 4 ? (f32x2){w1a[c], w1a[c + 1]} : (f32x2){w1b[c], w1b[c + 1]};
                    const f32x2 w2 = e < 4 ? (f32x2){w2a[c], w2a[c + 1]} : (f32x2){w2b[c], w2b[c + 1]}, w3 = e < 4 ? (f32x2){w3a[c], w3a[c + 1]} : (f32x2){w3b[c], w3b[c + 1]};
                    const f32x2 cbv = e < 4 ? (f32x2){cba[c], cba[c + 1]} : (f32x2){cbb[c], cbb[c + 1]};
                    const f32x2 r = cbv + w3 * x0 + w2 * x1 + w1 * x2 + w0 * x3;
                    xc[ks][e] = r.x; xc[ks][e + 1] = r.y;
                }
                prevx[ks] = x4[ks];
            }
            bfrag[ks] = __builtin_bit_cast(bf16x8, pack8(xc[ks]));
            if constexpr (IS_S) __builtin_amdgcn_sched_barrier(0);
        }
        f32x4 aa[8], ax[8];
#pragma unroll
        for (int nb = 0; nb < 8; ++nb) { aa[nb] = (f32x4){0.f, 0.f, 0.f, 0.f}; ax[nb] = (f32x4){0.f, 0.f, 0.f, 0.f}; }
#pragma unroll
        for (int ks = 0; ks < 4; ++ks)
#pragma unroll
            for (int nb = 0; nb < 8; ++nb) {
                const bf16x8 wa = *(const LAS bf16x8*)(lds + L_WA + (16 * nb + fr) * LW_STRIDE + (32 * ks + 8 * fq) * 2);
                const bf16x8 wx = *(const LAS bf16x8*)(lds + L_WX + (16 * nb + fr) * LW_STRIDE + (32 * ks + 8 * fq) * 2);
                aa[nb] = __builtin_amdgcn_mfma_f32_16x16x32_bf16(wa, bfrag[ks], aa[nb], 0, 0, 0);
                ax[nb] = __builtin_amdgcn_mfma_f32_16x16x32_bf16(wx, bfrag[ks], ax[nb], 0, 0, 0);
            }
        float y[4][8]; float ss = 0.f;
#pragma unroll
        for (int ks = 0; ks < 4; ++ks) {
            const f32x4 bga0 = *(const LAS f32x4*)(CT + 5 * 128 + 32 * ks), bga1 = *(const LAS f32x4*)(CT + 5 * 128 + 32 * ks + 4);
            const f32x4 bgx0 = *(const LAS f32x4*)(CT + 6 * 128 + 32 * ks), bgx1 = *(const LAS f32x4*)(CT + 6 * 128 + 32 * ks + 4);
            const f32x4 sp0 = *(const LAS f32x4*)(CT + 7 * 128 + 32 * ks), sp1 = *(const LAS f32x4*)(CT + 7 * 128 + 32 * ks + 4);
            float gav[8];
            if constexpr (PASS == 2) unpack8(g4[ks], gav);
            f32x4 h0a, h0b;
            if constexpr (IS_S) { const float* hp = p.st_h + (size_t)sq * DA + gch + 32 * ks; h0a = *(const f32x4*)hp; h0b = *(const f32x4*)(hp + 4); }
            float hv[8], Pv[8], Sv[8], lav[8];
#pragma unroll
            for (int e = 0; e < 8; e += 2) {
                const int nb = 2 * ks + (e >> 2), rg = e & 3;
                const f32x2 ba = e < 4 ? (f32x2){bga0[rg], bga0[rg + 1]} : (f32x2){bga1[rg], bga1[rg + 1]}, bx = e < 4 ? (f32x2){bgx0[rg], bgx0[rg + 1]} : (f32x2){bgx1[rg], bgx1[rg + 1]};
                const f32x2 spv = e < 4 ? (f32x2){sp0[rg], sp0[rg + 1]} : (f32x2){sp1[rg], sp1[rg + 1]};
                const f32x2 ta = (f32x2){aa[nb][rg], aa[nb][rg + 1]} * -1.4426950408889634f + ba, tx = (f32x2){ax[nb][rg], ax[nb][rg + 1]} * -1.4426950408889634f + bx;
                f32x2 ea, ex; ea.x = __builtin_amdgcn_exp2f(ta.x); ea.y = __builtin_amdgcn_exp2f(ta.y); ex.x = __builtin_amdgcn_exp2f(tx.x); ex.y = __builtin_amdgcn_exp2f(tx.y);
                ea = ea + 1.0f; ex = ex + 1.0f;
                f32x2 rr, ii; rr.x = __builtin_amdgcn_rcpf(ea.x); rr.y = __builtin_amdgcn_rcpf(ea.y); ii.x = __builtin_amdgcn_rcpf(ex.x); ii.y = __builtin_amdgcn_rcpf(ex.y);
                const f32x2 la = rr * spv;
                f32x2 a; a.x = __builtin_amdgcn_exp2f(la.x); a.y = __builtin_amdgcn_exp2f(la.y);
                const f32x2 om = 1.0f - a * a;
                f32x2 sq; sq.x = __builtin_amdgcn_sqrtf(om.x > 0.f ? om.x : 0.f); sq.y = __builtin_amdgcn_sqrtf(om.y > 0.f ? om.y : 0.f);
                const f32x2 uu = sq * (ii * (f32x2){xc[ks][e], xc[ks][e + 1]});
                Pv[e] = a.x; Pv[e + 1] = a.y; Sv[e] = uu.x; Sv[e + 1] = uu.y; lav[e] = la.x; lav[e + 1] = la.y;
            }
            if constexpr (PASS == 1 && !IS_S) {
                *(u32x4*)((bf16_t*)(p.ws + WS_LA) + (size_t)r * DA + gch + 32 * ks) = pack8(lav);
                *(u32x4*)((bf16_t*)(p.ws + WS_UU) + (size_t)r * DA + gch + 32 * ks) = pack8(Sv);
            }
            if constexpr (IS_S) {
#pragma unroll
                for (int e = 0; e < 8; ++e) { scan8(Pv[e], Sv[e], t8); hv[e] = __builtin_fmaf(Pv[e], e < 4 ? h0a[e & 3] : h0b[e & 3], Sv[e]); }
            } else {
#pragma unroll
                for (int e = 0; e < 8; e += 2) scan16x2(Pv[e], Sv[e], Pv[e + 1], Sv[e + 1]);
#pragma unroll
                for (int e = 0; e < 8; ++e) {
                    hv[e] = __builtin_fmaf(Pv[e], hin[ks][e], Sv[e]);
                    hin[ks][e] = bcast15(hv[e], lane);
                    if constexpr (PASS == 1) Pt[ks][e] *= bcast15(Pv[e], lane);
                }
            }
            if constexpr (PASS == 2) {
#pragma unroll
                for (int e = 0; e < 8; e += 2) { const f32x2 yy = gelu_mul2((f32x2){gav[e], gav[e + 1]}, (f32x2){hv[e], hv[e + 1]}); y[ks][e] = yy.x; y[ks][e + 1] = yy.y; ss += yy.x * yy.x + yy.y * yy.y; }
            }
            if constexpr (PASS == 2) {
                if (IS_S ? (t8 == 7) : (seg == LRU_NSEG - 1 && fr == 15)) {
                    float* ho = p.out + (IS_S ? O_SH + (size_t)sq * DA : O_PH + (size_t)b * DA) + gch + 32 * ks;
                    *(f32x4*)ho = (f32x4){hv[0], hv[1], hv[2], hv[3]}; *(f32x4*)(ho + 4) = (f32x4){hv[4], hv[5], hv[6], hv[7]};
                }
            }
        }
        if constexpr (PASS == 2) {
            ss += __shfl_xor(ss, 16); ss += __shfl_xor(ss, 32);
            const float rn = __builtin_amdgcn_rsqf(ss * (1.0f / 128.0f) + EPS);
#pragma unroll
            for (int ks = 0; ks < 4; ++ks) {
                const f32x4 g0 = *(const LAS f32x4*)(CT + 8 * 128 + 32 * ks), g1 = *(const LAS f32x4*)(CT + 8 * 128 + 32 * ks + 4);
                float o[8];
#pragma unroll
                for (int e = 0; e < 8; ++e) o[e] = y[ks][e] * rn * (e < 4 ? g0[e & 3] : g1[e & 3]);
                *(u32x4*)(ym + (size_t)r * DMIX + gch + 32 * ks) = pack8(o);
            }
        }
    }
    if constexpr (PASS == 1 && !IS_S) {
        const __amdgpu_buffer_rsrc_t trs = __builtin_amdgcn_make_buffer_rsrc((void*)tot, (short)0, (int)((size_t)NB * NCH * DA * 2 * 4), 0x00020000);
        if (fr == 0) {
            const unsigned tb = (unsigned)((((size_t)(b * LRU_NSEG + seg) * 2) * DA + gch) * 4);
#pragma unroll
            for (int ks = 0; ks < 4; ++ks) {
                __builtin_amdgcn_raw_buffer_store_b128(__builtin_bit_cast(u32x4, (f32x4){Pt[ks][0], Pt[ks][1], Pt[ks][2], Pt[ks][3]}), trs, tb + (32 * ks) * 4, 0, 16);
                __builtin_amdgcn_raw_buffer_store_b128(__builtin_bit_cast(u32x4, (f32x4){Pt[ks][4], Pt[ks][5], Pt[ks][6], Pt[ks][7]}), trs, tb + (32 * ks + 4) * 4, 0, 16);
                __builtin_amdgcn_raw_buffer_store_b128(__builtin_bit_cast(u32x4, (f32x4){hin[ks][0], hin[ks][1], hin[ks][2], hin[ks][3]}), trs, tb + (DA + 32 * ks) * 4, 0, 16);
                __builtin_amdgcn_raw_buffer_store_b128(__builtin_bit_cast(u32x4, (f32x4){hin[ks][4], hin[ks][5], hin[ks][6], hin[ks][7]}), trs, tb + (DA + 32 * ks + 4) * 4, 0, 16);
            }
        }
        asm volatile("s_waitcnt vmcnt(0)" ::: "memory");
        if (lane == 0) __hip_atomic_fetch_add((unsigned*)p.ws + CW_LRU_DONE + 8 * (4 * n + b), 1u, __ATOMIC_RELAXED, __HIP_MEMORY_SCOPE_AGENT);
    }
}

__device__ __forceinline__ void lru_finish_item(PRef p, LAS unsigned char* lds, int n, int b, int seg) {
    const int lane = opaque_tid() & 63, fr = lane & 15, fq = lane >> 4;
    const bf16_t* z = (const bf16_t*)(p.ws + WS_Z);
    const bf16_t* lab = (const bf16_t*)(p.ws + WS_LA); const bf16_t* uub = (const bf16_t*)(p.ws + WS_UU);
    bf16_t* ym = (bf16_t*)(p.ws + WS_YM);
    const float* tot = (const float*)(p.ws + WS_TOT);
    const LAS float* CT = (const LAS float*)(lds + L_CT) + 8 * fq;
    const int gch = n * 128 + 8 * fq;
    const int r0 = b * TP + seg * 64;
    const int nblk = seg == LRU_NSEG - 1 ? 1 : 4;
    float hin[4][8];
#pragma unroll
    for (int ks = 0; ks < 4; ++ks)
#pragma unroll
        for (int e = 0; e < 8; ++e) hin[ks][e] = 0.f;
    u32x4 ln[4], un[4], gn[4];
#pragma unroll
    for (int ks = 0; ks < 4; ++ks) { ln[ks] = *(const u32x4*)(lab + (size_t)(r0 + fr) * DA + gch + 32 * ks); un[ks] = *(const u32x4*)(uub + (size_t)(r0 + fr) * DA + gch + 32 * ks);
        gn[ks] = *(const u32x4*)(z + (size_t)(r0 + fr) * DIN + DA + gch + 32 * ks); }
    if (seg > 0) {
#pragma unroll 1
        for (int round = 0; round < 2; ++round) {
            const int s = 16 * round + fr;
            if (16 * round >= seg) break;
            const bool have = s < seg;
            const float* tp = tot + ((size_t)(b * LRU_NSEG + (have ? s : 0)) * 2) * DA + gch;
#pragma unroll
            for (int ks = 0; ks < 4; ++ks) {
                const f32x4 P0 = *(const f32x4*)(tp + 32 * ks), P1 = *(const f32x4*)(tp + 32 * ks + 4), S0 = *(const f32x4*)(tp + DA + 32 * ks), S1 = *(const f32x4*)(tp + DA + 32 * ks + 4);
#pragma unroll
                for (int e = 0; e < 8; e += 2) {
                    float Pa = have ? (e < 4 ? P0[e & 3] : P1[e & 3]) : 1.f, Sa = have ? (e < 4 ? S0[e & 3] : S1[e & 3]) : 0.f;
                    float Pb = have ? (e < 4 ? P0[(e + 1) & 3] : P1[(e + 1) & 3]) : 1.f, Sb = have ? (e < 4 ? S0[(e + 1) & 3] : S1[(e + 1) & 3]) : 0.f;
                    scan16x2(Pa, Sa, Pb, Sb);
                    hin[ks][e] = __builtin_fmaf(bcast15(Pa, lane), hin[ks][e], bcast15(Sa, lane));
                    hin[ks][e + 1] = __builtin_fmaf(bcast15(Pb, lane), hin[ks][e + 1], bcast15(Sb, lane));
                }
            }
        }
    }
#pragma unroll 1
    for (int blk = 0; blk < nblk; ++blk) {
        const int r = r0 + 16 * blk + fr;
        u32x4 l4[4], u4[4], g4[4];
#pragma unroll
        for (int ks = 0; ks < 4; ++ks) { l4[ks] = ln[ks]; u4[ks] = un[ks]; g4[ks] = gn[ks]; }
        { const int rn_ = (blk + 1 < nblk) ? r + 16 : r;
#pragma unroll
          for (int ks = 0; ks < 4; ++ks) { ln[ks] = *(const u32x4*)(lab + (size_t)rn_ * DA + gch + 32 * ks); un[ks] = *(const u32x4*)(uub + (size_t)rn_ * DA + gch + 32 * ks);
              gn[ks] = *(const u32x4*)(z + (size_t)rn_ * DIN + DA + gch + 32 * ks); } }
        float y[4][8]; float ss = 0.f;
#pragma unroll
        for (int ks = 0; ks < 4; ++ks) {
            float Pv[8], Sv[8], gav[8], hv[8];
            unpack8(l4[ks], Pv); unpack8(u4[ks], Sv); unpack8(g4[ks], gav);
#pragma unroll
            for (int e = 0; e < 8; ++e) Pv[e] = __builtin_amdgcn_exp2f(Pv[e]);
#pragma unroll
            for (int e = 0; e < 8; e += 2) scan16x2(Pv[e], Sv[e], Pv[e + 1], Sv[e + 1]);
#pragma unroll
            for (int e = 0; e < 8; ++e) { hv[e] = __builtin_fmaf(Pv[e], hin[ks][e], Sv[e]); hin[ks][e] = bcast15(hv[e], lane); }
#pragma unroll
            for (int e = 0; e < 8; e += 2) { const f32x2 yy = gelu_mul2((f32x2){gav[e], gav[e + 1]}, (f32x2){hv[e], hv[e + 1]}); y[ks][e] = yy.x; y[ks][e + 1] = yy.y; ss += yy.x * yy.x + yy.y * yy.y; }
            if (seg == LRU_NSEG - 1 && fr == 15) {
                float* ho = p.out + O_PH + (size_t)b * DA + gch + 32 * ks;
                *(f32x4*)ho = (f32x4){hv[0], hv[1], hv[2], hv[3]}; *(f32x4*)(ho + 4) = (f32x4){hv[4], hv[5], hv[6], hv[7]};
            }
        }
        ss += __shfl_xor(ss, 16); ss += __shfl_xor(ss, 32);
        const float rn = __builtin_amdgcn_rsqf(ss * (1.0f / 128.0f) + EPS);
#pragma unroll
        for (int ks = 0; ks < 4; ++ks) {
            const f32x4 g0 = *(const LAS f32x4*)(CT + 8 * 128 + 32 * ks), g1 = *(const LAS f32x4*)(CT + 8 * 128 + 32 * ks + 4);
            float o[8];
#pragma unroll
            for (int e = 0; e < 8; ++e) o[e] = y[ks][e] * rn * (e < 4 ? g0[e & 3] : g1[e & 3]);
            *(u32x4*)(ym + (size_t)r * DMIX + gch + 32 * ks) = pack8(o);
        }
    }
}
template <int PASS>
__device__ __forceinline__ void mixer_phase(PRef p, LAS unsigned char* lds, int G) {
    const int tid = opaque_tid(), wave = __builtin_amdgcn_readfirstlane(tid >> 6);
    static_assert(NH * LRU_WG_PER_HEAD <= GRID, "one head group per workgroup");
    const int v = blockIdx.x, n = v / LRU_WG_PER_HEAD, jg = v % LRU_WG_PER_HEAD;
    const bool lru_wg = v < NH * LRU_WG_PER_HEAD && (PASS == 1 || jg < LRU_IDLE_J0);
    if (lru_wg) {
        if constexpr (PASS == 2) {
            if (tid == 0) {
                const int w0 = jg * 8, w1 = (w0 + 7 < LRU_PITEMS - 1) ? w0 + 7 : LRU_PITEMS - 1;
                for (int bb = w0 / LRU_NSEG; bb <= w1 / LRU_NSEG; ++bb) {
                    unsigned sp = 0;
                    while (__hip_atomic_load((unsigned*)p.ws + CW_LRU_DONE + 8 * (4 * n + bb), __ATOMIC_RELAXED, __HIP_MEMORY_SCOPE_AGENT) < (unsigned)LRU_NSEG) { __builtin_amdgcn_s_sleep(2); if (++sp > (1u << 22)) break; }
                }
                __builtin_amdgcn_fence(__ATOMIC_ACQUIRE, "agent"); asm volatile("s_waitcnt vmcnt(0)" ::: "memory");
            }
        }
        __syncthreads();
        if (!(PASS == 2 && G == GRID && p.ph_lo <= 2))
        {
            const bf16_t* wg = (const bf16_t*)(p.ws + WS_WG);
            for (int i = tid; i < 2 * 128 * 16; i += 512) { const int g = i >> 11, row = (i >> 4) & 127, c16 = i & 15;
                *(LAS u32x4*)(lds + g * L_WX + row * LW_STRIDE + c16 * 16) = *(const u32x4*)(wg + (((size_t)g * NH + n) * 128 + row) * 128 + c16 * 8); }
            LAS float* CTw = (LAS float*)(lds + L_CT);
            for (int i = tid; i < 9 * 128; i += 512) { const int k = i >> 7, c = i & 127, ch = n * 128 + c;
                float vv;
                if (k < 4) vv = p.conv_a_w[k * DA + ch]; else if (k == 4) vv = p.conv_a_b[ch]; else if (k == 5) vv = -1.4426950408889634f * p.b_gate_a[ch]; else if (k == 6) vv = -1.4426950408889634f * p.b_gate_x[ch];
                else if (k == 7) vv = -8.0f * 1.4426950408889634f * log1pf(__expf(-p.lam[ch])); else vv = p.g_out_a[ch];
                CTw[i] = vv; }
        }
        __syncthreads();
        const int wi = jg * 8 + wave;
        if (wi < LRU_PITEMS) { if constexpr (PASS == 1) lru_wave_item<1, false>(p, lds, n, wi / LRU_NSEG, wi % LRU_NSEG); else lru_finish_item(p, lds, n, wi / LRU_NSEG, wi % LRU_NSEG); }
        else if (PASS == 1 && wi < LRU_PITEMS + LRU_SITEMS) lru_wave_item<2, true>(p, lds, n, wi - LRU_PITEMS, 0);
    } else if (G == GRID) {
        __syncthreads();
        constexpr int NIDLE1 = GRID - NH * LRU_WG_PER_HEAD, PER_HEAD = LRU_WG_PER_HEAD - LRU_IDLE_J0, NIDLE2 = NIDLE1 + NH * PER_HEAD;
        const int idx = v >= NH * LRU_WG_PER_HEAD ? v - NH * LRU_WG_PER_HEAD : NIDLE1 + n * PER_HEAD + (jg - LRU_IDLE_J0);
        convert_items(p, lds, idx * 8 + wave, (PASS == 1 ? NIDLE1 : NIDLE2) * 8, PASS == 1 ? IT_S1 : IT_S2, PASS == 1 ? IT_S2 : IT_S3);
    }
    if (PASS == 1) { branch_b(p, G); if ((REP_MASK >> 11) & 1) branch_b(p, G); }
}

__device__ __forceinline__ void final_phase(PRef p, int G, LAS unsigned char* lds) {
    const int tid_ = opaque_tid(), lane = tid_ & 63, gw = blockIdx.x * 8 + (tid_ >> 6), NGW = G * 8;
    const bf16_t* x2b = (const bf16_t*)(p.ws + WS_YM);
    f32x4 gf[8];
#pragma unroll
    for (int j = 0; j < 8; ++j) gf[j] = ((const f32x4*)p.g_final)[lane + 64 * j];
    constexpr int P7_ROWS = NB * SEQ + MSR, P7_STATIC = 2 * GRID * 8, P7_NCH = (P7_ROWS - P7_STATIC) / 8;
    static_assert(P7_STATIC + 8 * P7_NCH == P7_ROWS, "P7 tail chunks");
    ChunkQueue Q{(unsigned*)p.ws + CW_Q7, (volatile LAS int*)lds, P7_NCH, 0u};
    Q.start(tid_);
    int o = gw, k_ = 0;
    for (;;) {
        if (o < 0) break;
        {
        const int r = o < NB * SEQ ? (o / SEQ) * TP + NMETA + (o % SEQ) : MPR + (o - NB * SEQ);
        const u32x2* xr = (const u32x2*)(x2b + (size_t)r * D) + lane;
        f32x4 v[8]; float s = 0.f;
#pragma unroll
        for (int j = 0; j < 8; ++j) { const u32x2 w = xr[64 * j]; v[j] = (f32x4){bf_lo(w.x), bf_hi(w.x), bf_lo(w.y), bf_hi(w.y)};
            s += (v[j][0] * v[j][0] + v[j][1] * v[j][1]) + (v[j][2] * v[j][2] + v[j][3] * v[j][3]); }
        s = wave_sum(s);
        const float rs = __builtin_amdgcn_rsqf(s * (1.0f / D) + EPS);
        f32x4* yo = (f32x4*)(p.out + (size_t)o * D) + lane;
#pragma unroll
        for (int j = 0; j < 8; ++j) __builtin_nontemporal_store(v[j] * rs * gf[j], yo + 64 * j);
        }
        if (++k_ < 2) o += NGW;
        else { const int q = Q.pull(tid_); o = q < 0 ? -1 : P7_STATIC + 8 * q + (tid_ >> 6); }
    }
}

#define XB_TMO      128
#define XB_XCNT(j)  (256  + 64 * (j))
#define XB_XSUB(j)  (1280 + 64 * (j))
#define XB_XGEN(j)  (2304 + 64 * (j))
#define XB_TOP      3328
#define XB_TOPGEN   3392
#define XCD_BAR_WORDS 3456
#define XB_SPIN_CAP (1u << 18)
__device__ __forceinline__ unsigned xb_ld(unsigned* p)              { return __hip_atomic_load(p, __ATOMIC_RELAXED, __HIP_MEMORY_SCOPE_AGENT); }
__device__ __forceinline__ unsigned xb_add(unsigned* p, unsigned v) { return __hip_atomic_fetch_add(p, v, __ATOMIC_RELAXED, __HIP_MEMORY_SCOPE_AGENT); }
__device__ __forceinline__ unsigned xb_xcc_id() { return (unsigned)__builtin_amdgcn_s_getreg((3 << 11) | 20) & 0xFu; }
#define XB_SPIN(cond, bar) do { unsigned _sp = 0; while (cond) { __builtin_amdgcn_s_sleep(1); \
    if ((++_sp & 255u) == 0u) { if (xb_ld(&(bar)[XB_TMO])) break; if (_sp > XB_SPIN_CAP) { atomicAdd(&(bar)[XB_TMO], 1u); break; } } } } while (0)
struct XcdBarrier { unsigned* bar; unsigned x; volatile LAS unsigned* st; };
__device__ __forceinline__ XcdBarrier xcd_barrier_post(unsigned* bar, volatile LAS unsigned* st) {
    XcdBarrier b; b.bar = bar; b.x = xb_xcc_id(); b.st = st;
    if (threadIdx.x == 0) (void)xb_add(&bar[XB_XCNT(b.x)], 1u);
    return b;
}
__device__ __forceinline__ void xcd_barrier_complete(unsigned* bar, unsigned x, unsigned& nloc, unsigned& nx) {
    const unsigned G = gridDim.x * gridDim.y * gridDim.z;
    unsigned sum, cnt, mine, sp = 0u;
    for (;;) {
        sum = 0u; cnt = 0u; mine = 0u;
#pragma unroll
        for (unsigned j = 0; j < 16; ++j) { const unsigned c = xb_ld(&bar[XB_XCNT(j)]); sum += c; cnt += (c > 0u) ? 1u : 0u; mine = (j == x) ? c : mine; }
        if (sum == G) break;
        __builtin_amdgcn_s_sleep(1);
        if ((++sp & 255u) == 0u) { if (xb_ld(&bar[XB_TMO])) break; if (sp > XB_SPIN_CAP) { atomicAdd(&bar[XB_TMO], 1u); break; } }
    }
    nloc = mine > 0u ? mine : 1u; nx = cnt > 0u ? cnt : 1u;
}
__device__ __forceinline__ void xcd_barrier(const XcdBarrier& b) {
    asm volatile("s_waitcnt vmcnt(0)" ::: "memory");
    __syncthreads();
    if (threadIdx.x == 0) {
        unsigned* bar = b.bar;
        __builtin_amdgcn_s_waitcnt(0);
        unsigned nloc = b.st[0], nx = b.st[1];
        if (nloc == 0u) { xcd_barrier_complete(bar, b.x, nloc, nx); b.st[0] = nloc; b.st[1] = nx; }
        const unsigned old = xb_add(&bar[XB_XSUB(b.x)], 1u);
        const unsigned gen = old / nloc;
        if (old + 1u == (gen + 1u) * nloc) {
            __builtin_amdgcn_fence(__ATOMIC_RELEASE, "agent");
            asm volatile("s_waitcnt vmcnt(0)" ::: "memory");
            const unsigned og = xb_add(&bar[XB_TOP], 1u);
            const unsigned tg = og / nx;
            if (og + 1u == (tg + 1u) * nx) xb_add(&bar[XB_TOPGEN], 1u);
            else XB_SPIN(xb_ld(&bar[XB_TOPGEN]) == tg, bar);
            __builtin_amdgcn_fence(__ATOMIC_ACQUIRE, "agent");
            asm volatile("s_waitcnt vmcnt(0)" ::: "memory");
        } else {
            XB_SPIN(xb_ld(&bar[XB_TOPGEN]) == gen, bar);
            __builtin_amdgcn_fence(__ATOMIC_ACQUIRE, "agent");
            asm volatile("s_waitcnt vmcnt(0)" ::: "memory");
        }
    }
    __syncthreads();
}

constexpr int LDS_BYTES = 131072 + 1024 + 8 * 1024 + 8 * 2048;
constexpr int N_PHASES = 8;
__global__ void __launch_bounds__(512, 2) hymba_fwd(Params p) {
    extern __shared__ __attribute__((aligned(16))) unsigned char lds_raw[];
    LAS unsigned char* lds = (LAS unsigned char*)lds_raw;
    constexpr int G = GRID;
    if ((int)gridDim.x != GRID) return;
    const CAS Params* kp = (const CAS Params*)__builtin_amdgcn_kernarg_segment_ptr();
#define P_HERE (*({ const CAS Params* q_ = kp; asm volatile("" : "+s"(q_)); q_; }))
    unsigned char* ws = p.ws;
    volatile LAS unsigned* misc = (volatile LAS unsigned*)(lds + 131072);
    if (threadIdx.x < 8) misc[threadIdx.x] = 0u;
    __syncthreads();
    XcdBarrier bar = xcd_barrier_post((unsigned*)ws, misc);
    const int lo = p.ph_lo, hi = p.ph_hi;
#ifndef PH_MASK
#define PH_MASK 0xff
#endif
#define IN(k) (((PH_MASK >> (k)) & 1) && lo <= (k) && (k) < hi)
#define SEAM(k) do { if (IN(k) && IN((k) + 1)) xcd_barrier(bar); } while (0)
#define REPEAT(k) _Pragma("nounroll") for (int rep_ = 0; rep_ < ((((REP_MASK) >> (k)) & 1) ? 2 : 1); ++rep_, (rep_ < ((((REP_MASK) >> (k)) & 1) ? 2 : 1) ? xcd_barrier(bar) : (void)0))
    if ((REP_MASK >> 12) & 1) { xcd_barrier(bar); xcd_barrier(bar); xcd_barrier(bar); xcd_barrier(bar); }
    if (IN(0)) REPEAT(0) phase0(P_HERE, lds, G);
    SEAM(0);
    if (IN(1)) REPEAT(1) {
        pg8::Gemm g{(const bf16_t*)(ws + WS_XB) + (size_t)16 * D, (const bf16_t*)(ws + WS_WIN), MP / 256, DIN / 256, D, (size_t)256 * D * 2, (size_t)128 * D * 2};
        pg8::StaticOrder S; S.init(g.nM, g.nN, G, (int)blockIdx.x, D / 64, 1);
        LAS float* rstab1 = (LAS float*)(lds + 131072 + 1024);
        PRef q = P_HERE; EpiZ E{rstab1, (bf16_t*)(ws + WS_Z), q.out};
        auto pre1 = [&]() { rstd1_table((const float*)(ws + WS_RS1), rstab1, S); __syncthreads(); };
        pg8::gemm_phase<EpiZ, false, true, true>(lds, g, S, E, nullptr, nullptr, false, pre1);
        if ((int)blockIdx.x >= P1_TAIL_WG0 && G == 256) convert_items(P_HERE, lds, ((int)blockIdx.x - P1_TAIL_WG0) * 8 + (opaque_tid() >> 6), (G - P1_TAIL_WG0) * 8, IT_O, IT_S1);
        else if (G != 256) convert_items(P_HERE, lds, (int)blockIdx.x * 8 + (opaque_tid() >> 6), G * 8, IT_O, IT_S3);
    }
    SEAM(1);
    if (IN(2)) mixer_phase<1>(P_HERE, lds, G);
    if (IN(3)) mixer_phase<2>(P_HERE, lds, G);
    SEAM(3);
    if (IN(4)) REPEAT(4) {
        pg8::Gemm g{(const bf16_t*)(ws + WS_YM), (const bf16_t*)(ws + WS_WO), MP / 256, D / 256, DMIX, (size_t)256 * DMIX * 2, (size_t)128 * DMIX * 2};
        pg8::StaticOrder S; S.init(g.nM, g.nN, G, (int)blockIdx.x, DMIX / 64, P4_SPLIT, true);
        EpiX1 E{(bf16_t*)(ws + WS_XB) + (size_t)16 * D, (float*)(ws + WS_SSQ)};
        pg8::gemm_phase<EpiX1, false, true, true>(lds, g, S, E, (float*)(ws + WS_Z), (unsigned*)ws + CW_TK4 + rep_ * 128 * 64);
        if ((int)blockIdx.x >= P4_TAIL_WG0 && G == 256) convert_items(P_HERE, lds, ((int)blockIdx.x - P4_TAIL_WG0) * 8 + (opaque_tid() >> 6), (G - P4_TAIL_WG0) * 8, IT_S3, IT_S4);
        else if (G != 256) convert_items(P_HERE, lds, (int)blockIdx.x * 8 + (opaque_tid() >> 6), G * 8, IT_S3, IT_G);
    }
    SEAM(4);
    if (IN(5)) REPEAT(5) {
        pg8::Gemm g{(const bf16_t*)(ws + WS_XB) + (size_t)14 * D, (const bf16_t*)(ws + WS_WUP), 37, 2 * DFF / 256, D, (size_t)252 * D * 2, (size_t)64 * D * 2};
        pg8::StaticOrder S; S.init(g.nM, g.nN, G, (int)blockIdx.x, D / 64, 1); S.ffn = true;
        LAS float* rstab = (LAS float*)(lds + 131072 + 1024); LAS float* wtab = rstab + 8 * 256;
        PRef q = P_HERE;
        EpiFFN E{q.st_fc, (bf16_t*)(ws + WS_Z), q.out, rstab, wtab};
        auto pre5 = [&]() { ffn_rstd_table((const float*)(ws + WS_SSQ), q.conv_f_w, q.conv_f_b, rstab, wtab, S); __syncthreads(); };
        pg8::gemm_phase<EpiFFN, true, true, true>(lds, g, S, E, nullptr, nullptr, false, pre5);
        if ((int)blockIdx.x >= P5_IDLE_WG0 && G == 256) convert_items(P_HERE, lds, ((int)blockIdx.x - P5_IDLE_WG0) * 8 + (opaque_tid() >> 6), (G - P5_IDLE_WG0) * 8, IT_S4, IT_G);
    }
    SEAM(5);
    if (IN(6)) {
        pg8::Gemm g{(const bf16_t*)(ws + WS_Z), (const bf16_t*)(ws + WS_WDN), MP / 256, D / 256, DFF, (size_t)256 * DFF * 2, (size_t)128 * DFF * 2};
        pg8::StaticOrder S; S.init(g.nM, g.nN, G, (int)blockIdx.x, DFF / 64, P6_SPLIT);
        EpiOut E{(const bf16_t*)(ws + WS_XB) + (size_t)16 * D, (bf16_t*)(ws + WS_YM)};
        pg8::gemm_phase<EpiOut, false, true, true>(lds, g, S, E, (float*)(ws + WS_WIN), (unsigned*)ws + CW_TK6);
    }
    SEAM(6);
    if (IN(7)) final_phase(P_HERE, G, lds);
#undef IN
#undef SEAM
}

extern "C" void kernel_launch(void* const* d_in, const int* in_sizes, int n_in, void* d_out, int out_size, void* d_ws, size_t ws_size, hipStream_t stream) {
    static int grid = 0;
    if (grid == 0) {
        if (n_in != 26 || (size_t)out_size != O_END || ws_size < WS_END) { fprintf(stderr, "kernel_launch: unexpected problem (n_in %d, out %d, ws %zu; need ws >= %zu)\n", n_in, out_size, ws_size, (size_t)WS_END); grid = -1; return; }
        int dev = 0, cus = 0, per_cu = 0;
        hipGetDevice(&dev); hipDeviceGetAttribute(&cus, hipDeviceAttributeMultiprocessorCount, dev);
        if (hipFuncSetAttribute((const void*)hymba_fwd, hipFuncAttributeMaxDynamicSharedMemorySize, LDS_BYTES) != hipSuccess) { fprintf(stderr, "kernel_launch: hipFuncSetAttribute failed\n"); grid = -1; return; }
        if (hipOccupancyMaxActiveBlocksPerMultiprocessor(&per_cu, (const void*)hymba_fwd, 512, LDS_BYTES) != hipSuccess || per_cu < 1) { fprintf(stderr, "kernel_launch: occupancy query says %d\n", per_cu); grid = -1; return; }
        if (cus < GRID) { fprintf(stderr, "kernel_launch: built for a %d-CU device, found %d CUs\n", GRID, cus); grid = -1; return; }
        grid = GRID;
    }
    if (grid < 0) return;
    Params p{};
    const float** f = (const float**)&p;
    for (int i = 0; i < 26; ++i) f[i] = (const float*)d_in[i];
    p.out = (float*)d_out; p.ws = (unsigned char*)d_ws;
    if (hipMemsetAsync(d_ws, 0, CTL_WORDS * 4, stream) != hipSuccess) { fprintf(stderr, "kernel_launch: memset failed\n"); return; }
    if (MK_N_LAUNCHES == 1) {
        p.ph_lo = 0; p.ph_hi = N_PHASES;
        hipLaunchKernelGGL(hymba_fwd, dim3(grid), dim3(512), LDS_BYTES, stream, p);
    } else {
        for (int k = 0; k < N_PHASES; ++k) { p.ph_lo = k; p.ph_hi = k + 1; hipLaunchKernelGGL(hymba_fwd, dim3(grid), dim3(512), LDS_BYTES, stream, p); }
    }
}
```
